# Optimizing an MI355X kernel written in HIP

```python
import math
import jax, jax.numpy as jnp
from jax import lax
import numpy as np

D_MODEL = 1024
BATCH = 1
SEQ = 16384
DEPTH = 1

CHUNK = 64
HEAD_DIM = 64
ROPE_THETA = 10000.0
SWA_Q_HEADS = (D_MODEL // 2) // HEAD_DIM
SWA_KV_HEADS = max(1, SWA_Q_HEADS // 4)
SWA_WINDOW = 128
SWA_WIN_CHUNKS = -(-SWA_WINDOW // CHUNK)
DIFF_V_DIM = 2 * HEAD_DIM
DIFF_HEADS = (D_MODEL // 2) // DIFF_V_DIM
DIFF_Q_BLOCK = 128
IN_SPLITS = (SWA_Q_HEADS * HEAD_DIM, SWA_KV_HEADS * HEAD_DIM, SWA_KV_HEADS * HEAD_DIM,
             DIFF_HEADS * 2 * HEAD_DIM, DIFF_HEADS * 2 * HEAD_DIM, DIFF_HEADS * DIFF_V_DIM)
IN_WIDTH = sum(IN_SPLITS)
MIX_WIDTH = SWA_Q_HEADS * HEAD_DIM + DIFF_HEADS * DIFF_V_DIM
N_EXPERTS = 256
TOP_K = 8
N_GROUPS = 8
TOPK_GROUPS = 4
EXPERT_FF = 256
SHARED_FF = 256
ROUTED_SCALE = 2.5
MOE_BLOCK = 128
DEEPNORM_ALPHA = (2.0 * DEPTH) ** 0.25
DEEPNORM_BETA = (8.0 * DEPTH) ** -0.25
NORM_EPS = 1e-5

kernel_name = "hybrid_swa_sink_diffattn_moe_deepnorm"


def layer_norm(x, g, b):
    xf = x.astype(jnp.float32)
    mu = xf.mean(-1, keepdims=True)
    var = jnp.square(xf - mu).mean(-1, keepdims=True)
    y = (xf - mu) * lax.rsqrt(var + NORM_EPS) * g.astype(jnp.float32) + b.astype(jnp.float32)
    return y.astype(x.dtype)


def rms_norm(x, g):
    xf = x.astype(jnp.float32)
    y = xf * lax.rsqrt(jnp.square(xf).mean(-1, keepdims=True) + NORM_EPS) * g.astype(jnp.float32)
    return y.astype(x.dtype)


def rope_tables(seq):
    inv = 1.0 / (ROPE_THETA ** (jnp.arange(0, HEAD_DIM, 2, dtype=jnp.float32) / HEAD_DIM))
    ang = jnp.arange(seq, dtype=jnp.float32)[:, None] * inv[None, :]
    return jnp.cos(ang), jnp.sin(ang)


def apply_rope(t, cos, sin):
    half = t.shape[-1] // 2
    shp = (1, t.shape[1]) + (1,) * (t.ndim - 3) + (half,)
    c, s = cos.reshape(shp), sin.reshape(shp)
    tf = t.astype(jnp.float32)
    t1, t2 = tf[..., :half], tf[..., half:]
    return jnp.concatenate([t1 * c - t2 * s, t2 * c + t1 * s], axis=-1).astype(t.dtype)


def swa_sink_attention(q, k, v, sinks):
    B, S, Hq, d = q.shape
    Hkv = k.shape[2]
    G = Hq // Hkv
    NC = S // CHUNK
    W = SWA_WIN_CHUNKS
    qc = q.reshape(B, NC, CHUNK, Hkv, G, d)

    def windows(t):
        tc = t.reshape(B, NC, CHUNK, Hkv, d)
        tp = jnp.pad(tc, ((0, 0), (W, 0), (0, 0), (0, 0), (0, 0)))
        return jnp.concatenate([tp[:, i:i + NC] for i in range(W + 1)], axis=2)

    kw, vw = windows(k), windows(v)
    key_chunk = jnp.arange(NC)[:, None] - W + jnp.arange((W + 1) * CHUNK)[None, :] // CHUNK
    valid = key_chunk >= 0
    s = jnp.einsum('bnqkgd,bnskd->bnkgqs', qc, kw).astype(jnp.float32) * (d ** -0.5)
    s = jnp.where(valid[None, :, None, None, None, :], s, -jnp.inf)
    sink = sinks.astype(jnp.float32).reshape(1, 1, Hkv, G, 1, 1)
    m = jnp.maximum(s.max(-1, keepdims=True), sink)
    p = jnp.exp(s - m)
    p = (p / (p.sum(-1, keepdims=True) + jnp.exp(sink - m))).astype(v.dtype)
    o = jnp.einsum('bnkgqs,bnskd->bnqkgd', p, vw)
    return o.reshape(B, S, Hq * d)


def diff_attention(q, k, v, lam, lam_init, sub_g):
    B, S, H, _, d = q.shape
    NQ = S // DIFF_Q_BLOCK
    qb = q.reshape(B, NQ, DIFF_Q_BLOCK, H, 2, d).transpose(1, 0, 2, 3, 4, 5)
    key_chunk = jnp.arange(S) // CHUNK
    scale = d ** -0.5

    def block(args):
        qi, i = args
        q_chunk = (i * DIFF_Q_BLOCK + jnp.arange(DIFF_Q_BLOCK)) // CHUNK
        mask = key_chunk[None, :] <= q_chunk[:, None]
        s = jnp.einsum('bqhmd,bshmd->bhmqs', qi, k).astype(jnp.float32) * scale
        a = jax.nn.softmax(jnp.where(mask, s, -jnp.inf), axis=-1)
        w = (a[:, :, 0] - lam * a[:, :, 1]).astype(v.dtype)
        return jnp.einsum('bhqs,bshe->bqhe', w, v)

    o = lax.map(block, (qb, jnp.arange(NQ)))
    o = o.transpose(1, 0, 2, 3, 4).reshape(B, S, H, 2 * d)
    o = rms_norm(o, sub_g) * (1.0 - lam_init)
    return o.reshape(B, S, H * 2 * d)


def hybrid_mixer(x, w_in, b_in, sinks, lam_q1, lam_k1, lam_q2, lam_k2, sub_g, w_out, lam_init, cos, sin):
    B, S, _ = x.shape
    proj = x @ w_in + b_in
    offs = np.cumsum(IN_SPLITS)[:-1].tolist()
    qa, ka, va, qd, kd, vd = jnp.split(proj, offs, axis=-1)
    qa = apply_rope(qa.reshape(B, S, SWA_Q_HEADS, HEAD_DIM), cos, sin)
    ka = apply_rope(ka.reshape(B, S, SWA_KV_HEADS, HEAD_DIM), cos, sin)
    va = va.reshape(B, S, SWA_KV_HEADS, HEAD_DIM)
    out_a = swa_sink_attention(qa, ka, va, sinks)

    qd = apply_rope(qd.reshape(B, S, DIFF_HEADS, 2, HEAD_DIM), cos, sin)
    kd = apply_rope(kd.reshape(B, S, DIFF_HEADS, 2, HEAD_DIM), cos, sin)
    vd = vd.reshape(B, S, DIFF_HEADS, DIFF_V_DIM)
    lam = (jnp.exp(jnp.sum(lam_q1.astype(jnp.float32) * lam_k1.astype(jnp.float32)))
           - jnp.exp(jnp.sum(lam_q2.astype(jnp.float32) * lam_k2.astype(jnp.float32))) + lam_init)
    out_b = diff_attention(qd, kd, vd, lam, lam_init, sub_g)
    return jnp.concatenate([out_a, out_b], axis=-1) @ w_out


def swiglu(h, wg, wu, wd):
    return (jax.nn.silu(h @ wg) * (h @ wu)) @ wd


def moe(h, w_router, r_bias, w_g, w_u, w_d, ws_g, ws_u, ws_d):
    B, S, D = h.shape
    T = B * S
    hf = h.reshape(T, D)
    scores = jax.nn.sigmoid((hf @ w_router).astype(jnp.float32))
    sel = scores + r_bias.astype(jnp.float32)
    grp = sel.reshape(T, N_GROUPS, N_EXPERTS // N_GROUPS)
    grp_score = lax.top_k(grp, 2)[0].sum(-1)
    top_g = lax.top_k(grp_score, TOPK_GROUPS)[1]
    gmask = jnp.any(top_g[:, :, None] == jnp.arange(N_GROUPS)[None, None, :], axis=1)
    sel = jnp.where(jnp.repeat(gmask, N_EXPERTS // N_GROUPS, axis=1), sel, -jnp.inf)
    top_e = lax.top_k(sel, TOP_K)[1]
    gate = jnp.take_along_axis(scores, top_e, axis=1)
    gate = gate / gate.sum(-1, keepdims=True) * ROUTED_SCALE

    A = T * TOP_K
    NB = (A + N_EXPERTS * (MOE_BLOCK - 1) + MOE_BLOCK - 1) // MOE_BLOCK
    P = NB * MOE_BLOCK
    e_flat = top_e.reshape(A)
    tok_flat = jnp.repeat(jnp.arange(T, dtype=jnp.int32), TOP_K)
    g_flat = gate.reshape(A)
    order = jnp.argsort(e_flat)
    e_s, tok_s, g_s = e_flat[order], tok_flat[order], g_flat[order]
    counts = jnp.bincount(e_flat, length=N_EXPERTS)
    padded = (counts + MOE_BLOCK - 1) // MOE_BLOCK * MOE_BLOCK
    starts = jnp.cumsum(counts) - counts
    pends = jnp.cumsum(padded)
    pstarts = pends - padded
    dest = pstarts[e_s] + (jnp.arange(A) - starts[e_s])
    tok_buf = jnp.zeros((P,), jnp.int32).at[dest].set(tok_s)
    g_buf = jnp.zeros((P,), hf.dtype).at[dest].set(g_s.astype(hf.dtype))
    block_e = jnp.minimum(jnp.searchsorted(pends, jnp.arange(NB) * MOE_BLOCK, side='right'), N_EXPERTS - 1)

    def expert_block(args):
        tok, g, e = args
        xb = hf[tok]
        return swiglu(xb, w_g[e], w_u[e], w_d[e]) * g[:, None]

    y = lax.map(expert_block, (tok_buf.reshape(NB, MOE_BLOCK), g_buf.reshape(NB, MOE_BLOCK), block_e))
    routed = jnp.zeros((T, D), hf.dtype).at[tok_buf].add(y.reshape(P, D))
    return (routed + swiglu(hf, ws_g, ws_u, ws_d)).reshape(B, S, D)


def setup_inputs(seed: int = 0) -> dict:
    key = jax.random.key(seed)
    ks = jax.random.split(key, 24)
    L, D, E = DEPTH, D_MODEL, N_EXPERTS

    def nrm(k, shape, scale):
        return jax.random.normal(k, shape, jnp.float32) * scale

    col_scale = jnp.asarray(np.concatenate([
        np.full((w,), DEEPNORM_BETA if i in (2, 5) else 1.0, np.float32) for i, w in enumerate(IN_SPLITS)]))
    return {
        "x": nrm(ks[0], (BATCH, SEQ, D), 1.0),
        "w_in": nrm(ks[1], (L, D, IN_WIDTH), D ** -0.5) * col_scale,
        "b_in": nrm(ks[2], (L, IN_WIDTH), 0.02),
        "sinks": nrm(ks[3], (L, SWA_Q_HEADS), 1.0),
        "lam_q1": nrm(ks[4], (L, HEAD_DIM), 0.1),
        "lam_k1": nrm(ks[5], (L, HEAD_DIM), 0.1),
        "lam_q2": nrm(ks[6], (L, HEAD_DIM), 0.1),
        "lam_k2": nrm(ks[7], (L, HEAD_DIM), 0.1),
        "diff_norm_g": 1.0 + nrm(ks[8], (L, DIFF_V_DIM), 0.02),
        "w_out": nrm(ks[9], (L, MIX_WIDTH, D), MIX_WIDTH ** -0.5 * DEEPNORM_BETA),
        "ln1_g": 1.0 + nrm(ks[10], (L, D), 0.02),
        "ln1_b": nrm(ks[11], (L, D), 0.02),
        "w_router": nrm(ks[12], (L, D, E), D ** -0.5),
        "router_bias": nrm(ks[13], (L, E), 0.01),
        "w_gate": nrm(ks[14], (L, E, D, EXPERT_FF), D ** -0.5),
        "w_up": nrm(ks[15], (L, E, D, EXPERT_FF), D ** -0.5),
        "w_down": nrm(ks[16], (L, E, EXPERT_FF, D), EXPERT_FF ** -0.5 * DEEPNORM_BETA),
        "ws_gate": nrm(ks[17], (L, D, SHARED_FF), D ** -0.5),
        "ws_up": nrm(ks[18], (L, D, SHARED_FF), D ** -0.5),
        "ws_down": nrm(ks[19], (L, SHARED_FF, D), SHARED_FF ** -0.5 * DEEPNORM_BETA),
        "ln2_g": 1.0 + nrm(ks[20], (L, D), 0.02),
        "ln2_b": nrm(ks[21], (L, D), 0.02),
    }


def reference(x, w_in, b_in, sinks, lam_q1, lam_k1, lam_q2, lam_k2, diff_norm_g, w_out, ln1_g, ln1_b,
              w_router, router_bias, w_gate, w_up, w_down, ws_gate, ws_up, ws_down, ln2_g, ln2_b):
    cos, sin = rope_tables(x.shape[1])
    for l in range(DEPTH):
        lam_init = 0.8 - 0.6 * math.exp(-0.3 * l)
        mix = hybrid_mixer(x, w_in[l], b_in[l], sinks[l], lam_q1[l], lam_k1[l], lam_q2[l], lam_k2[l],
                           diff_norm_g[l], w_out[l], lam_init, cos, sin)
        x = layer_norm(DEEPNORM_ALPHA * x + mix, ln1_g[l], ln1_b[l])
        ffn = moe(x, w_router[l], router_bias[l], w_gate[l], w_up[l], w_down[l], ws_gate[l], ws_up[l], ws_down[l])
        x = layer_norm(DEEPNORM_ALPHA * x + ffn, ln2_g[l], ln2_b[l])
    return x
```

```cpp
#include <hip/hip_runtime.h>
#include <hip/hip_cooperative_groups.h>
#include <cstdio>
#include <cstdint>
namespace cg = cooperative_groups;

#ifndef MK_ONE_LAUNCH
#define MK_ONE_LAUNCH 0
#endif

constexpr int S = 16384, D = 1024, INW = 2304, NE = 256, FF = 256;
constexpr int NTHREADS = 512;
constexpr int CAP = 16384;
constexpr float ALPHA = 1.189207115002721f;
constexpr float LN_EPS = 1e-5f;
constexpr float QSCALE = 0.125f * 1.4426950408889634f;
constexpr float LOG2E = 1.4426950408889634f;
constexpr int C_AQ = 0, C_AK = 512, C_AV = 640, C_BQ = 768, C_BK = 1280, C_BV = 1792;

constexpr size_t MiB = 1ull << 20;
constexpr size_t WS_CTL = 0;
constexpr size_t CTL_BYTES = 64 * 1024;
constexpr size_t WS_ROPE = 1 * MiB;
constexpr size_t WS_PROJ = 8 * MiB;
constexpr size_t WS_ATT = 80 * MiB;
constexpr size_t WS_PRELN = 112 * MiB;
constexpr size_t WS_X1F = 176 * MiB;
constexpr size_t WS_X1B = 240 * MiB;
constexpr size_t WS_LIST = 272 * MiB;
constexpr size_t WS_GATE = 288 * MiB;
constexpr size_t WS_ACT = 290 * MiB;
constexpr size_t WS_Y = 368 * MiB;
constexpr size_t WS_END = 660 * MiB;

constexpr int LDS_BYTES = 147456;
constexpr int LDS_MISC = 131072;

typedef unsigned short bf16_t;
typedef short bf16x8 __attribute__((ext_vector_type(8)));
typedef short s16x4 __attribute__((ext_vector_type(4)));
typedef float f32x4 __attribute__((ext_vector_type(4)));
typedef float f32x16 __attribute__((ext_vector_type(16)));
typedef unsigned u32x4 __attribute__((ext_vector_type(4)));
typedef unsigned u32x2 __attribute__((ext_vector_type(2)));

struct Params {
    const float* x; const float* w_in; const float* b_in; const float* sinks;
    const float* lq1; const float* lk1; const float* lq2; const float* lk2; const float* subg;
    const float* w_out; const float* ln1g; const float* ln1b; const float* w_r; const float* r_bias;
    const float* w_g; const float* w_u; const float* w_d; const float* ws_g; const float* ws_u; const float* ws_d;
    const float* ln2g; const float* ln2b;
    float* out; unsigned char* ws;
    int ph_lo, ph_hi;
};

__device__ __forceinline__ unsigned cvt_pk(float lo, float hi) { unsigned r; asm volatile("v_cvt_pk_bf16_f32 %0, %1, %2" : "=v"(r) : "v"(lo), "v"(hi)); return r; }
__device__ __forceinline__ float bf_lo(unsigned u) { return __uint_as_float(u << 16); }
__device__ __forceinline__ float bf_hi(unsigned u) { return __uint_as_float(u & 0xffff0000u); }
__device__ __forceinline__ float wave_sum(float v) {
#pragma unroll
    for (int o = 1; o < 64; o <<= 1) v += __shfl_xor(v, o);
    return v;
}
__device__ __forceinline__ float half_max(float v) { auto rr = __builtin_amdgcn_permlane32_swap(__float_as_uint(v), __float_as_uint(v), false, false); return fmaxf(__uint_as_float(rr[0]), __uint_as_float(rr[1])); }
__device__ __forceinline__ float half_sum(float v) { auto rr = __builtin_amdgcn_permlane32_swap(__float_as_uint(v), __float_as_uint(v), false, false); return __uint_as_float(rr[0]) + __uint_as_float(rr[1]); }

__device__ __forceinline__ int swz(int r, int c) { const int f = (r & 7) ^ (((r >> 3) & 1) << 1) ^ ((r >> 4) & 1); return r * 128 + ((c ^ f) << 4); }

constexpr int G_A0 = 0, G_A1 = 16384, G_B0 = 32768, G_B1 = 65536;
struct GemmArgs {
    const char* a0; const char* a1;
    const float* b;
    int ldb; int nk;
};
template <int AF32, class Epi>
__device__ __forceinline__ void gemm_tile(char* lds, const GemmArgs g, const Epi& epi) {
    const int tid = threadIdx.x, lane = tid & 63, w = tid >> 6, wr = w >> 2, wc = w & 3, fr = lane & 15, fq = lane >> 4;
    f32x4 acc[4][4];
#pragma unroll
    for (int i = 0; i < 4; ++i)
#pragma unroll
        for (int j = 0; j < 4; ++j) acc[i][j] = (f32x4){0.f, 0.f, 0.f, 0.f};
    const int aw0 = swz(tid >> 3, tid & 7), aw1 = swz(64 + (tid >> 3), tid & 7);
    int bw[4];
#pragma unroll
    for (int j = 0; j < 4; ++j) bw[j] = swz(4 * lane + j, w);
    u32x4 ar0, ar1; f32x4 af0a, af0b, af1a, af1b; f32x4 br[8];
    const char* pa0 = g.a0; const char* pa1 = g.a1; const float* pb = g.b;
#define G_LOAD() do { \
        if (AF32) { af0a = *(const f32x4*)pa0; af0b = *(const f32x4*)(pa0 + 16); af1a = *(const f32x4*)pa1; af1b = *(const f32x4*)(pa1 + 16); pa0 += 256; pa1 += 256; } \
        else { ar0 = *(const u32x4*)pa0; ar1 = *(const u32x4*)pa1; pa0 += 128; pa1 += 128; } \
        _Pragma("unroll") for (int i = 0; i < 8; ++i) br[i] = *(const f32x4*)(pb + (size_t)i * g.ldb); \
        pb += (size_t)64 * g.ldb; } while (0)
#define G_WRITE(AOFF, BOFF) do { \
        if (AF32) { ar0 = (u32x4){cvt_pk(af0a[0], af0a[1]), cvt_pk(af0a[2], af0a[3]), cvt_pk(af0b[0], af0b[1]), cvt_pk(af0b[2], af0b[3])}; \
                    ar1 = (u32x4){cvt_pk(af1a[0], af1a[1]), cvt_pk(af1a[2], af1a[3]), cvt_pk(af1b[0], af1b[1]), cvt_pk(af1b[2], af1b[3])}; } \
        *(u32x4*)(lds + (AOFF) + aw0) = ar0; *(u32x4*)(lds + (AOFF) + aw1) = ar1; \
        _Pragma("unroll") for (int j = 0; j < 4; ++j) { \
            u32x4 v = {cvt_pk(br[0][j], br[1][j]), cvt_pk(br[2][j], br[3][j]), cvt_pk(br[4][j], br[5][j]), cvt_pk(br[6][j], br[7][j])}; \
            *(u32x4*)(lds + (BOFF) + bw[j]) = v; } } while (0)
    G_LOAD(); G_WRITE(G_A0, G_B0); __syncthreads();
    for (int kt = 0; kt < g.nk; ++kt) {
        const int aoff = (kt & 1) ? G_A1 : G_A0, boff = (kt & 1) ? G_B1 : G_B0;
        const bool more = (kt + 1 < g.nk);
        if (more) G_LOAD();
#pragma unroll
        for (int ks = 0; ks < 2; ++ks) {
            bf16x8 af[4], bfr[4];
#pragma unroll
            for (int mt = 0; mt < 4; ++mt) af[mt] = *(const bf16x8*)(lds + aoff + swz(wr * 64 + mt * 16 + fr, ks * 4 + fq));
#pragma unroll
            for (int nt = 0; nt < 4; ++nt) bfr[nt] = *(const bf16x8*)(lds + boff + swz(wc * 64 + nt * 16 + fr, ks * 4 + fq));
#pragma unroll
            for (int mt = 0; mt < 4; ++mt)
#pragma unroll
                for (int nt = 0; nt < 4; ++nt) acc[mt][nt] = __builtin_amdgcn_mfma_f32_16x16x32_bf16(bfr[nt], af[mt], acc[mt][nt], 0, 0, 0);
        }
        if (more) { if (kt & 1) G_WRITE(G_A0, G_B0); else G_WRITE(G_A1, G_B1); }
        __syncthreads();
    }
#undef G_LOAD
#undef G_WRITE
    epi(acc, wr, wc, fr, fq);
}

__device__ __forceinline__ void phase_rope(const Params& p, int vb, int G) {
    float* cs = (float*)(p.ws + WS_ROPE); float* sn = cs + (size_t)S * 32;
    for (int idx = vb * NTHREADS + threadIdx.x; idx < S * 32; idx += G * NTHREADS) {
        const int pos = idx >> 5, i = idx & 31;
        const float pw = (float)pow(10000.0, (double)i / 32.0);
        const float inv = 1.0f / pw;
        const float angf = __fmul_rn((float)pos, inv);
        const double a = (double)angf;
        const double q = rint(a * 0.63661977236758134308);
        double r = fma(-q, 1.57079632679489655800, a); r = fma(-q, 6.12323399573676603587e-17, r);
        const double r2 = r * r;
        double sp = r * (1.0 + r2 * (-1.0 / 6 + r2 * (1.0 / 120 + r2 * (-1.0 / 5040 + r2 * (1.0 / 362880 + r2 * (-1.0 / 39916800))))));
        double cp = 1.0 + r2 * (-0.5 + r2 * (1.0 / 24 + r2 * (-1.0 / 720 + r2 * (1.0 / 40320 + r2 * (-1.0 / 3628800 + r2 * (1.0 / 479001600))))));
        const int qi = ((int)((long long)q)) & 3;
        double sv, cv;
        if (qi == 0) { sv = sp; cv = cp; } else if (qi == 1) { sv = cp; cv = -sp; } else if (qi == 2) { sv = -sp; cv = -cp; } else { sv = -cp; cv = sp; }
        cs[idx] = (float)cv; sn[idx] = (float)sv;
    }
}

struct EpiProj {
    const float* bias; const float* cs; const float* sn; bf16_t* out; int row0, col0;
    __device__ __forceinline__ void operator()(f32x4 (&acc)[4][4], int wr, int wc, int fr, int fq) const {
        const int hb = col0 + wc * 64;
        const bool is_q = (hb < C_AK) || (hb >= C_BQ && hb < C_BK);
        const bool is_rope = is_q || (hb >= C_AK && hb < C_AV) || (hb >= C_BK && hb < C_BV);
        const float sc = is_q ? QSCALE : 1.0f;
#pragma unroll
        for (int mt = 0; mt < 4; ++mt) {
            const int row = row0 + wr * 64 + mt * 16 + fr;
            f32x4 v[4];
#pragma unroll
            for (int nt = 0; nt < 4; ++nt) v[nt] = acc[mt][nt] + *(const f32x4*)(bias + hb + nt * 16 + 4 * fq);
            if (is_rope) {
#pragma unroll
                for (int nt = 0; nt < 2; ++nt) {
                    const f32x4 c = *(const f32x4*)(cs + (size_t)row * 32 + nt * 16 + 4 * fq), s = *(const f32x4*)(sn + (size_t)row * 32 + nt * 16 + 4 * fq);
                    const f32x4 t1 = v[nt], t2 = v[nt + 2];
                    v[nt] = t1 * c - t2 * s; v[nt + 2] = t2 * c + t1 * s;
                }
            }
#pragma unroll
            for (int nt = 0; nt < 4; ++nt) {
                const f32x4 o = v[nt] * sc;
                u32x2 pk = {cvt_pk(o[0], o[1]), cvt_pk(o[2], o[3])};
                *(u32x2*)(out + (size_t)row * INW + hb + nt * 16 + 4 * fq) = pk;
            }
        }
    }
};
__device__ __forceinline__ void phase_proj(const Params& p, char* lds, int vb, int G) {
    const int tid = threadIdx.x, lane = tid & 63, w = tid >> 6;
    constexpr int NTN = INW / 256, NU = (S / 128) * NTN;
    const float* cs = (const float*)(p.ws + WS_ROPE); const float* sn = cs + (size_t)S * 32;
    for (int u = vb; u < NU; u += G) {
        const int tm = u / NTN, tn = u % NTN;
        GemmArgs g;
        g.a0 = (const char*)(p.x + (size_t)(tm * 128 + (tid >> 3)) * D + (tid & 7) * 8);
        g.a1 = (const char*)(p.x + (size_t)(tm * 128 + 64 + (tid >> 3)) * D + (tid & 7) * 8);
        g.b = p.w_in + (size_t)(w * 8) * INW + tn * 256 + 4 * lane; g.ldb = INW; g.nk = D / 64;
        EpiProj e{p.b_in, cs, sn, (bf16_t*)(p.ws + WS_PROJ), tm * 128, tn * 256};
        gemm_tile<1>(lds, g, e);
    }
}

template <int OFF> __device__ __forceinline__ s16x4 tr_read(int vb) { s16x4 r; asm volatile("ds_read_b64_tr_b16 %0, %1 offset:%2" : "=&v"(r) : "v"(vb), "i"(OFF) : "memory"); return r; }
__device__ __forceinline__ int v_off(int k, int c, int ndb) { return ((k >> 3) * ndb + (c >> 5)) * 512 + ((k & 7) * 32 + (c & 31)) * 2; }

constexpr int AT_STAGE = 32768;
template <int NDB, int T, int KB, int KS> struct PvStep {
    static __device__ __forceinline__ void run(f32x16& o, int vbase, const bf16x8& pf) {
        constexpr int off = ((KB * 4 + KS * 2) * NDB + T) * 512;
        const s16x4 lo = tr_read<off>(vbase), hi = tr_read<off + NDB * 512>(vbase);
        asm volatile("s_waitcnt lgkmcnt(0)" ::: "memory"); __builtin_amdgcn_sched_barrier(0);
        const bf16x8 vf = {lo[0], lo[1], lo[2], lo[3], hi[0], hi[1], hi[2], hi[3]};
        o = __builtin_amdgcn_mfma_f32_32x32x16_bf16(vf, pf, o, 0, 0, 0);
    }
};
template <int NDB>
__device__ __forceinline__ void attn_tile(char* lds, int kof, int vbase, const bf16x8 (&qf)[4], f32x16 (&o)[NDB], float& m, float& l, int r32, int hi) {
    f32x16 s0 = {}, s1 = {};
#pragma unroll
    for (int ds = 0; ds < 4; ++ds) {
        const bf16x8 k0 = *(const bf16x8*)(lds + kof + swz(r32, ds * 2 + hi)), k1 = *(const bf16x8*)(lds + kof + swz(32 + r32, ds * 2 + hi));
        s0 = __builtin_amdgcn_mfma_f32_32x32x16_bf16(k0, qf[ds], s0, 0, 0, 0);
        s1 = __builtin_amdgcn_mfma_f32_32x32x16_bf16(k1, qf[ds], s1, 0, 0, 0);
    }
    float mx = s0[0];
#pragma unroll
    for (int r = 1; r < 16; ++r) mx = fmaxf(mx, s0[r]);
#pragma unroll
    for (int r = 0; r < 16; ++r) mx = fmaxf(mx, s1[r]);
    mx = half_max(mx);
    const float mn = fmaxf(m, mx), alpha = __builtin_amdgcn_exp2f(m - mn);
    m = mn;
    float ps = 0.f;
#pragma unroll
    for (int r = 0; r < 16; ++r) { s0[r] = __builtin_amdgcn_exp2f(s0[r] - mn); ps += s0[r]; }
#pragma unroll
    for (int r = 0; r < 16; ++r) { s1[r] = __builtin_amdgcn_exp2f(s1[r] - mn); ps += s1[r]; }
    ps = half_sum(ps);
    l = l * alpha + ps;
    if (!__all(alpha == 1.0f)) {
#pragma unroll
        for (int t = 0; t < NDB; ++t)
#pragma unroll
            for (int r = 0; r < 16; ++r) o[t][r] *= alpha;
    }
    bf16x8 pf[4];
#pragma unroll
    for (int s = 0; s < 2; ++s) {
        u32x4 a = {cvt_pk(s0[8 * s + 0], s0[8 * s + 1]), cvt_pk(s0[8 * s + 2], s0[8 * s + 3]), cvt_pk(s0[8 * s + 4], s0[8 * s + 5]), cvt_pk(s0[8 * s + 6], s0[8 * s + 7])};
        u32x4 b = {cvt_pk(s1[8 * s + 0], s1[8 * s + 1]), cvt_pk(s1[8 * s + 2], s1[8 * s + 3]), cvt_pk(s1[8 * s + 4], s1[8 * s + 5]), cvt_pk(s1[8 * s + 6], s1[8 * s + 7])};
        pf[s] = *(bf16x8*)&a; pf[2 + s] = *(bf16x8*)&b;
    }
    if constexpr (NDB == 4) {
        PvStep<4, 0, 0, 0>::run(o[0], vbase, pf[0]); PvStep<4, 1, 0, 0>::run(o[1], vbase, pf[0]); PvStep<4, 2, 0, 0>::run(o[2], vbase, pf[0]); PvStep<4, 3, 0, 0>::run(o[3], vbase, pf[0]);
        PvStep<4, 0, 0, 1>::run(o[0], vbase, pf[1]); PvStep<4, 1, 0, 1>::run(o[1], vbase, pf[1]); PvStep<4, 2, 0, 1>::run(o[2], vbase, pf[1]); PvStep<4, 3, 0, 1>::run(o[3], vbase, pf[1]);
        PvStep<4, 0, 1, 0>::run(o[0], vbase, pf[2]); PvStep<4, 1, 1, 0>::run(o[1], vbase, pf[2]); PvStep<4, 2, 1, 0>::run(o[2], vbase, pf[2]); PvStep<4, 3, 1, 0>::run(o[3], vbase, pf[2]);
        PvStep<4, 0, 1, 1>::run(o[0], vbase, pf[3]); PvStep<4, 1, 1, 1>::run(o[1], vbase, pf[3]); PvStep<4, 2, 1, 1>::run(o[2], vbase, pf[3]); PvStep<4, 3, 1, 1>::run(o[3], vbase, pf[3]);
    } else {
        PvStep<2, 0, 0, 0>::run(o[0], vbase, pf[0]); PvStep<2, 1, 0, 0>::run(o[1], vbase, pf[0]);
        PvStep<2, 0, 0, 1>::run(o[0], vbase, pf[1]); PvStep<2, 1, 0, 1>::run(o[1], vbase, pf[1]);
        PvStep<2, 0, 1, 0>::run(o[0], vbase, pf[2]); PvStep<2, 1, 1, 0>::run(o[1], vbase, pf[2]);
        PvStep<2, 0, 1, 1>::run(o[0], vbase, pf[3]); PvStep<2, 1, 1, 1>::run(o[1], vbase, pf[3]);
    }
}

__device__ __forceinline__ void attn_diff_unit(const Params& p, char* lds, int h, int qb, float lam) {
    const int tid = threadIdx.x, lane = tid & 63, w = tid >> 6, r32 = lane & 31, hi = lane >> 5, mp = w >> 2, wq = w & 3;
    const bf16_t* proj = (const bf16_t*)(p.ws + WS_PROJ);
    const int NT = 2 * qb + 2, myNT = (wq < 2) ? NT - 1 : NT;
    bf16x8 qf[4];
    { const bf16_t* qp = proj + (size_t)(qb * 128 + wq * 32 + r32) * INW + C_BQ + h * 128 + mp * 64 + hi * 8;
#pragma unroll
      for (int ds = 0; ds < 4; ++ds) qf[ds] = *(const bf16x8*)(qp + ds * 16); }
    f32x16 o[4] = {}; float m = -1e30f, l = 0.f;
    const bf16_t* gk0 = proj + (size_t)(tid >> 3) * INW + C_BK + h * 128 + (tid & 7) * 8;
    const bf16_t* gv0 = proj + (size_t)(tid >> 4) * INW + C_BV + h * 128 + (tid & 15) * 8;
    const int wk = swz(tid >> 3, tid & 7), wv0 = v_off(tid >> 4, (tid & 15) * 8, 4), wv1 = v_off(32 + (tid >> 4), (tid & 15) * 8, 4);
    const int vlane = ((lane & 3) << 3) | (((lane >> 2) & 3) << 6) | (((lane >> 4) & 1) << 5) | (((lane >> 5) & 1) << 8);
    u32x4 st0, st1, st2, st3;
#define D_LOAD(t) do { const size_t ko = (size_t)(t) * 64 * INW; st0 = *(const u32x4*)(gk0 + ko); st1 = *(const u32x4*)(gk0 + ko + 64); st2 = *(const u32x4*)(gv0 + ko); st3 = *(const u32x4*)(gv0 + ko + (size_t)32 * INW); } while (0)
#define D_WRITE(b) do { char* sb = lds + (b) * AT_STAGE; *(u32x4*)(sb + wk) = st0; *(u32x4*)(sb + 8192 + wk) = st1; *(u32x4*)(sb + 16384 + wv0) = st2; *(u32x4*)(sb + 16384 + wv1) = st3; } while (0)
    D_LOAD(0); D_WRITE(0); __syncthreads();
    for (int t = 0; t < NT; ++t) {
        const int b = t & 1;
        if (t + 1 < NT) D_LOAD(t + 1);
        if (t < myNT) attn_tile<4>(lds, b * AT_STAGE + mp * 8192, (int)(uintptr_t)(lds + b * AT_STAGE + 16384) + vlane, qf, o, m, l, r32, hi);
        if (t + 1 < NT) D_WRITE(b ^ 1);
        __syncthreads();
    }
#undef D_LOAD
#undef D_WRITE
    float* xb = (float*)lds;
    const float il = 1.0f / l;
    if (mp == 1) {
        const float f = il * lam;
#pragma unroll
        for (int t = 0; t < 4; ++t)
#pragma unroll
            for (int r = 0; r < 16; ++r) xb[(wq * 64 + t * 16 + r) * 64 + lane] = o[t][r] * f;
    }
    __syncthreads();
    if (mp == 0) {
        float ss = 0.f;
#pragma unroll
        for (int t = 0; t < 4; ++t)
#pragma unroll
            for (int r = 0; r < 16; ++r) { const float v = o[t][r] * il - xb[(wq * 64 + t * 16 + r) * 64 + lane]; o[t][r] = v; ss += v * v; }
        ss = half_sum(ss);
        const float rs = rsqrtf(ss * (1.0f / 128.0f) + LN_EPS) * 0.8f;
        bf16_t* op = (bf16_t*)(p.ws + WS_ATT) + (size_t)(qb * 128 + wq * 32 + r32) * D + 512 + h * 128;
#pragma unroll
        for (int t = 0; t < 4; ++t)
#pragma unroll
            for (int rr = 0; rr < 4; ++rr) {
                const int dv0 = 32 * t + 8 * rr + 4 * hi;
                const f32x4 gg = *(const f32x4*)(p.subg + dv0);
                u32x2 pk = {cvt_pk(o[t][4 * rr] * rs * gg[0], o[t][4 * rr + 1] * rs * gg[1]), cvt_pk(o[t][4 * rr + 2] * rs * gg[2], o[t][4 * rr + 3] * rs * gg[3])};
                *(u32x2*)(op + dv0) = pk;
            }
    }
    __syncthreads();
}
__device__ __forceinline__ void attn_swa_unit(const Params& p, char* lds, int kvh, int n) {
    const int tid = threadIdx.x, lane = tid & 63, w = tid >> 6, r32 = lane & 31, hi = lane >> 5, g = w >> 1, hq = kvh * 4 + g;
    const bf16_t* proj = (const bf16_t*)(p.ws + WS_PROJ);
    const int c0 = (n >= 2) ? n - 2 : 0, NT = n - c0 + 1;
    const int tok = n * 64 + (w & 1) * 32 + r32;
    bf16x8 qf[4];
    { const bf16_t* qp = proj + (size_t)tok * INW + C_AQ + hq * 64 + hi * 8;
#pragma unroll
      for (int ds = 0; ds < 4; ++ds) qf[ds] = *(const bf16x8*)(qp + ds * 16); }
    f32x16 o[2] = {}; float m = p.sinks[hq] * LOG2E, l = 1.0f;
    const bf16_t* gk = proj + (size_t)(c0 * 64 + (tid >> 3)) * INW + C_AK + kvh * 64 + (tid & 7) * 8;
    const bf16_t* gv = proj + (size_t)(c0 * 64 + (tid >> 3)) * INW + C_AV + kvh * 64 + (tid & 7) * 8;
    const int wk = swz(tid >> 3, tid & 7), wv = v_off(tid >> 3, (tid & 7) * 8, 2);
    const int vlane = ((lane & 3) << 3) | (((lane >> 2) & 3) << 6) | (((lane >> 4) & 1) << 5) | (((lane >> 5) & 1) << 8);
    u32x4 st0, st1;
#define W_LOAD(t) do { const size_t ko = (size_t)(t) * 64 * INW; st0 = *(const u32x4*)(gk + ko); st1 = *(const u32x4*)(gv + ko); } while (0)
#define W_WRITE(b) do { char* sb = lds + (b) * AT_STAGE; *(u32x4*)(sb + wk) = st0; *(u32x4*)(sb + 8192 + wv) = st1; } while (0)
    W_LOAD(0); W_WRITE(0); __syncthreads();
    for (int t = 0; t < NT; ++t) {
        const int b = t & 1;
        if (t + 1 < NT) W_LOAD(t + 1);
        attn_tile<2>(lds, b * AT_STAGE, (int)(uintptr_t)(lds + b * AT_STAGE + 8192) + vlane, qf, o, m, l, r32, hi);
        if (t + 1 < NT) W_WRITE(b ^ 1);
        __syncthreads();
    }
#undef W_LOAD
#undef W_WRITE
    const float il = 1.0f / l;
    bf16_t* op = (bf16_t*)(p.ws + WS_ATT) + (size_t)tok * D + hq * 64;
#pragma unroll
    for (int t = 0; t < 2; ++t)
#pragma unroll
        for (int rr = 0; rr < 4; ++rr) {
            const int dv0 = 32 * t + 8 * rr + 4 * hi;
            u32x2 pk = {cvt_pk(o[t][4 * rr] * il, o[t][4 * rr + 1] * il), cvt_pk(o[t][4 * rr + 2] * il, o[t][4 * rr + 3] * il)};
            *(u32x2*)(op + dv0) = pk;
        }
}
__device__ __forceinline__ void phase_attn(const Params& p, char* lds, int vb, int G) {
    const int lane = threadIdx.x & 63;
    const float d1 = wave_sum(p.lq1[lane] * p.lk1[lane]), d2 = wave_sum(p.lq2[lane] * p.lk2[lane]);
    const float lam = expf(d1) - expf(d2) + 0.2f;
    for (int u = vb; u < 1024; u += G) {
        if (u < 256) attn_diff_unit(p, lds, u >> 6, 127 - (u & 63), lam);
        else if (u < 512) attn_diff_unit(p, lds, (u - 256) >> 6, (u - 256) & 63, lam);
        else attn_swa_unit(p, lds, (u - 512) >> 8, (u - 512) & 255);
    }
}

struct EpiPreLn {
    const float* x; float* out; int row0, col0;
    __device__ __forceinline__ void operator()(f32x4 (&acc)[4][4], int wr, int wc, int fr, int fq) const {
#pragma unroll
        for (int mt = 0; mt < 4; ++mt) {
            const size_t ro = (size_t)(row0 + wr * 64 + mt * 16 + fr) * D + col0 + wc * 64 + 4 * fq;
#pragma unroll
            for (int nt = 0; nt < 4; ++nt) { const f32x4 xv = *(const f32x4*)(x + ro + nt * 16); *(f32x4*)(out + ro + nt * 16) = xv * ALPHA + acc[mt][nt]; }
        }
    }
};
__device__ __forceinline__ void phase_wout(const Params& p, char* lds, int vb, int G) {
    const int tid = threadIdx.x, lane = tid & 63, w = tid >> 6;
    const bf16_t* att = (const bf16_t*)(p.ws + WS_ATT);
    for (int u = vb; u < (S / 128) * 4; u += G) {
        const int tm = u >> 2, tn = u & 3;
        GemmArgs g;
        g.a0 = (const char*)(att + (size_t)(tm * 128 + (tid >> 3)) * D + (tid & 7) * 8);
        g.a1 = (const char*)(att + (size_t)(tm * 128 + 64 + (tid >> 3)) * D + (tid & 7) * 8);
        g.b = p.w_out + (size_t)(w * 8) * D + tn * 256 + 4 * lane; g.ldb = D; g.nk = D / 64;
        EpiPreLn e{p.x, (float*)(p.ws + WS_PRELN), tm * 128, tn * 256};
        gemm_tile<0>(lds, g, e);
    }
}

struct EpiLogits {
    float* L;
    __device__ __forceinline__ void operator()(f32x4 (&acc)[4][4], int wr, int wc, int fr, int fq) const {
#pragma unroll
        for (int mt = 0; mt < 4; ++mt)
#pragma unroll
            for (int nt = 0; nt < 4; ++nt) *(f32x4*)(L + (wr * 64 + mt * 16 + fr) * 256 + wc * 64 + nt * 16 + 4 * fq) = acc[mt][nt];
    }
};
__device__ __forceinline__ void phase_router(const Params& p, char* lds, int vb, int G) {
    const int tid = threadIdx.x, lane = tid & 63, w = tid >> 6;
    const float* preln = (const float*)(p.ws + WS_PRELN);
    float* x1f = (float*)(p.ws + WS_X1F); bf16_t* x1b = (bf16_t*)(p.ws + WS_X1B);
    unsigned* cnt = (unsigned*)(p.ws + WS_CTL); int* list = (int*)(p.ws + WS_LIST); float* gates = (float*)(p.ws + WS_GATE);
    for (int u = vb; u < S / 128; u += G) {
        for (int i = 0; i < 16; ++i) {
            const int row = u * 128 + w * 16 + i;
            const f32x4* xr = (const f32x4*)(preln + (size_t)row * D) + lane;
            f32x4 v[4]; float s = 0.f;
#pragma unroll
            for (int j = 0; j < 4; ++j) { v[j] = xr[64 * j]; s += (v[j][0] + v[j][1]) + (v[j][2] + v[j][3]); }
            const float mean = wave_sum(s) * (1.0f / D); float s2 = 0.f;
#pragma unroll
            for (int j = 0; j < 4; ++j) { v[j] = v[j] - mean; s2 += (v[j][0] * v[j][0] + v[j][1] * v[j][1]) + (v[j][2] * v[j][2] + v[j][3] * v[j][3]); }
            const float rstd = rsqrtf(wave_sum(s2) * (1.0f / D) + LN_EPS);
#pragma unroll
            for (int j = 0; j < 4; ++j) {
                const f32x4 gg = *((const f32x4*)p.ln1g + lane + 64 * j), bb = *((const f32x4*)p.ln1b + lane + 64 * j);
                const f32x4 y = v[j] * rstd * gg + bb;
                *((f32x4*)(x1f + (size_t)row * D) + lane + 64 * j) = y;
                u32x2 pk = {cvt_pk(y[0], y[1]), cvt_pk(y[2], y[3])};
                *((u32x2*)(x1b + (size_t)row * D) + lane + 64 * j) = pk;
            }
        }
        asm volatile("s_waitcnt vmcnt(0)" ::: "memory");
        __syncthreads();
        GemmArgs g;
        g.a0 = (const char*)(x1b + (size_t)(u * 128 + (tid >> 3)) * D + (tid & 7) * 8);
        g.a1 = (const char*)(x1b + (size_t)(u * 128 + 64 + (tid >> 3)) * D + (tid & 7) * 8);
        g.b = p.w_r + (size_t)(w * 8) * NE + 4 * lane; g.ldb = NE; g.nk = D / 64;
        EpiLogits e{(float*)lds};
        gemm_tile<0>(lds, g, e);
        __syncthreads();
        const f32x4 rb = *((const f32x4*)p.r_bias + lane);
        const float NEG = -__builtin_inff();
        for (int i = 0; i < 16; ++i) {
            const int tl = w * 16 + i, t = u * 128 + tl;
            const f32x4 lg = *((const f32x4*)((const float*)lds + tl * 256) + lane);
            float sc[4], cand[4];
#pragma unroll
            for (int j = 0; j < 4; ++j) { sc[j] = 1.0f / (1.0f + expf(-lg[j])); cand[j] = sc[j] + rb[j]; }
            float a1, a2;
            { const float m01 = fmaxf(cand[0], cand[1]), n01 = fminf(cand[0], cand[1]), m23 = fmaxf(cand[2], cand[3]), n23 = fminf(cand[2], cand[3]);
              a1 = fmaxf(m01, m23); a2 = fmaxf(fminf(m01, m23), fmaxf(n01, n23)); }
#pragma unroll
            for (int off = 1; off < 8; off <<= 1) { const float b1 = __shfl_xor(a1, off), b2 = __shfl_xor(a2, off); const float n1 = fmaxf(a1, b1), n2 = fmaxf(fminf(a1, b1), fmaxf(a2, b2)); a1 = n1; a2 = n2; }
            const float gs = a1 + a2; const int mygrp = lane >> 3; int rank = 0;
#pragma unroll
            for (int g2 = 0; g2 < 8; ++g2) { const float v = __shfl(gs, g2 * 8); rank += (v > gs || (v == gs && g2 < mygrp)) ? 1 : 0; }
            if (rank >= 4) {
#pragma unroll
                for (int j = 0; j < 4; ++j) cand[j] = NEG;
            }
            int my_e = 0; float my_s = 0.f, gsum = 0.f;
#pragma unroll
            for (int k = 0; k < 8; ++k) {
                float bv = cand[0]; int bi = 0;
#pragma unroll
                for (int j = 1; j < 4; ++j) if (cand[j] > bv) { bv = cand[j]; bi = j; }
                int idx = 4 * lane + bi;
#pragma unroll
                for (int off = 32; off >= 1; off >>= 1) { const float ov = __shfl_xor(bv, off); const int oi = __shfl_xor(idx, off); if (ov > bv || (ov == bv && oi < idx)) { bv = ov; idx = oi; } }
                const int owner = idx >> 2, sub = idx & 3;
                float scv = sc[0];
#pragma unroll
                for (int j = 1; j < 4; ++j) scv = (sub == j) ? sc[j] : scv;
                if (lane == owner) {
#pragma unroll
                    for (int j = 0; j < 4; ++j) if (sub == j) cand[j] = NEG;
                }
                const float gsc = __shfl(scv, owner);
                if (lane == k) { my_e = idx; my_s = gsc; }
                gsum += gsc;
            }
            if (lane < 8) {
                const float gate = my_s / gsum * 2.5f;
                const unsigned pos = atomicAdd(cnt + my_e, 1u);
                list[(size_t)my_e * CAP + pos] = t * 8 + lane;
                gates[t * 8 + lane] = gate;
            }
        }
        __syncthreads();
    }
}

struct EpiAct {
    bf16_t* act; const int* slots; int ncol0;
    __device__ __forceinline__ void operator()(f32x4 (&acc)[4][4], int wr, int wc, int fr, int fq) const {
#pragma unroll
        for (int mt = 0; mt < 4; ++mt) {
            const int ar = slots[wr * 64 + mt * 16 + fr];
            if (ar >= 0) {
#pragma unroll
                for (int nt = 0; nt < 2; ++nt) {
                    const f32x4 gv = acc[mt][nt], uv = acc[mt][nt + 2]; float a[4];
#pragma unroll
                    for (int j = 0; j < 4; ++j) a[j] = gv[j] / (1.0f + __expf(-gv[j])) * uv[j];
                    u32x2 pk = {cvt_pk(a[0], a[1]), cvt_pk(a[2], a[3])};
                    *(u32x2*)(act + (size_t)ar * FF + ncol0 + wc * 32 + nt * 16 + 4 * fq) = pk;
                }
            }
        }
    }
};
struct EpiY {
    bf16_t* y; const int* yrows; const float* gl; int col0;
    __device__ __forceinline__ void operator()(f32x4 (&acc)[4][4], int wr, int wc, int fr, int fq) const {
#pragma unroll
        for (int mt = 0; mt < 4; ++mt) {
            const int r = wr * 64 + mt * 16 + fr, yr = yrows[r];
            if (yr >= 0) {
                const float gt = gl[r];
#pragma unroll
                for (int nt = 0; nt < 4; ++nt) {
                    const f32x4 v = acc[mt][nt] * gt;
                    u32x2 pk = {cvt_pk(v[0], v[1]), cvt_pk(v[2], v[3])};
                    *(u32x2*)(y + (size_t)yr * D + col0 + wc * 64 + nt * 16 + 4 * fq) = pk;
                }
            }
        }
    }
};
__device__ __forceinline__ void phase_experts(const Params& p, char* lds, int vb, int G) {
    const int tid = threadIdx.x, lane = tid & 63, w = tid >> 6;
    const bf16_t* x1b = (const bf16_t*)(p.ws + WS_X1B);
    const unsigned* cnt = (const unsigned*)(p.ws + WS_CTL); const int* list = (const int*)(p.ws + WS_LIST); const float* gates = (const float*)(p.ws + WS_GATE);
    bf16_t* act = (bf16_t*)(p.ws + WS_ACT); bf16_t* ybuf = (bf16_t*)(p.ws + WS_Y);
    int* nts = (int*)(lds + LDS_MISC); int* pre = nts + 256;
    int* s_arow = pre + 260; int* s_yrow = s_arow + 128; int* s_tok = s_yrow + 128; float* s_gate = (float*)(s_tok + 128);
    if (tid < 256) nts[tid] = (int)((__hip_atomic_load(cnt + tid, __ATOMIC_RELAXED, __HIP_MEMORY_SCOPE_AGENT) + 127u) >> 7);
    __syncthreads();
    if (tid < 257) { int s = 0; for (int e = 0; e < tid; ++e) s += nts[e]; pre[tid] = s; }
    __syncthreads();
    const int NR = pre[256], NU = NR + S / 128;
    for (int u = vb; u < NU; u += G) {
        __syncthreads();
        const float *wg, *wu, *wd;
        if (u < NR) {
            int lo = 0, hi = 255;
            while (lo < hi) { const int mid = (lo + hi + 1) >> 1; if (pre[mid] <= u) lo = mid; else hi = mid - 1; }
            const int e = lo, tile = u - pre[e], n = (int)__hip_atomic_load(cnt + e, __ATOMIC_RELAXED, __HIP_MEMORY_SCOPE_AGENT);
            if (tid < 128) {
                const int idx = tile * 128 + tid;
                if (idx < n) { const int slot = list[(size_t)e * CAP + idx]; s_arow[tid] = slot; s_yrow[tid] = slot + (slot >> 3); s_tok[tid] = slot >> 3; s_gate[tid] = gates[slot]; }
                else { s_arow[tid] = -1; s_yrow[tid] = -1; s_tok[tid] = 0; s_gate[tid] = 0.f; }
            }
            wg = p.w_g + (size_t)e * D * FF; wu = p.w_u + (size_t)e * D * FF; wd = p.w_d + (size_t)e * FF * D;
        } else {
            const int tile = u - NR;
            if (tid < 128) { const int tk = tile * 128 + tid; s_arow[tid] = S * 8 + tk; s_yrow[tid] = tk * 9 + 8; s_tok[tid] = tk; s_gate[tid] = 1.0f; }
            wg = p.ws_g; wu = p.ws_u; wd = p.ws_d;
        }
        __syncthreads();
        const int r0 = tid >> 3, r1 = 64 + (tid >> 3);
        for (int np = 0; np < 2; ++np) {
            GemmArgs g;
            g.a0 = (const char*)(x1b + (size_t)s_tok[r0] * D + (tid & 7) * 8);
            g.a1 = (const char*)(x1b + (size_t)s_tok[r1] * D + (tid & 7) * 8);
            const int n0 = 4 * lane, bwc = n0 >> 6, sub = n0 & 63;
            const float* bsrc = (sub < 32) ? (wg + np * 128 + bwc * 32 + sub) : (wu + np * 128 + bwc * 32 + (sub - 32));
            g.b = bsrc + (size_t)(w * 8) * FF; g.ldb = FF; g.nk = D / 64;
            EpiAct e{act, s_arow, np * 128};
            gemm_tile<0>(lds, g, e);
        }
        asm volatile("s_waitcnt vmcnt(0)" ::: "memory");
        __syncthreads();
        const int ar0 = s_arow[r0] < 0 ? 0 : s_arow[r0], ar1 = s_arow[r1] < 0 ? 0 : s_arow[r1];
        for (int np = 0; np < 4; ++np) {
            GemmArgs g;
            g.a0 = (const char*)(act + (size_t)ar0 * FF + (tid & 7) * 8);
            g.a1 = (const char*)(act + (size_t)ar1 * FF + (tid & 7) * 8);
            g.b = wd + (size_t)(w * 8) * D + np * 256 + 4 * lane; g.ldb = D; g.nk = FF / 64;
            EpiY e{ybuf, s_yrow, s_gate, np * 256};
            gemm_tile<0>(lds, g, e);
        }
    }
}

__device__ __forceinline__ void phase_final(const Params& p, int vb, int G) {
    const int lane = threadIdx.x & 63, w = threadIdx.x >> 6;
    const float* x1f = (const float*)(p.ws + WS_X1F); const bf16_t* ybuf = (const bf16_t*)(p.ws + WS_Y);
    for (int row = vb * 8 + w; row < S; row += G * 8) {
        f32x4 v[4]; float s = 0.f;
#pragma unroll
        for (int j = 0; j < 4; ++j) v[j] = *((const f32x4*)(x1f + (size_t)row * D) + lane + 64 * j) * ALPHA;
#pragma unroll
        for (int k = 0; k < 9; ++k) {
            const u32x2* yr = (const u32x2*)(ybuf + (size_t)(row * 9 + k) * D) + lane;
#pragma unroll
            for (int j = 0; j < 4; ++j) { const u32x2 q = yr[64 * j]; v[j][0] += bf_lo(q[0]); v[j][1] += bf_hi(q[0]); v[j][2] += bf_lo(q[1]); v[j][3] += bf_hi(q[1]); }
        }
#pragma unroll
        for (int j = 0; j < 4; ++j) s += (v[j][0] + v[j][1]) + (v[j][2] + v[j][3]);
        const float mean = wave_sum(s) * (1.0f / D); float s2 = 0.f;
#pragma unroll
        for (int j = 0; j < 4; ++j) { v[j] = v[j] - mean; s2 += (v[j][0] * v[j][0] + v[j][1] * v[j][1]) + (v[j][2] * v[j][2] + v[j][3] * v[j][3]); }
        const float rstd = rsqrtf(wave_sum(s2) * (1.0f / D) + LN_EPS);
#pragma unroll
        for (int j = 0; j < 4; ++j) {
            const f32x4 gg = *((const f32x4*)p.ln2g + lane + 64 * j), bb = *((const f32x4*)p.ln2b + lane + 64 * j);
            *((f32x4*)(p.out + (size_t)row * D) + lane + 64 * j) = v[j] * rstd * gg + bb;
        }
    }
}

__global__ void __launch_bounds__(NTHREADS) mega(Params p) {
    extern __shared__ __attribute__((aligned(16))) char lds[];
    const int G = gridDim.x, bx = blockIdx.x;
    const int vb = (G % 8 == 0) ? (bx % 8) * (G / 8) + bx / 8 : bx;
#define SEAM(k) do { if (p.ph_lo <= (k) && (k) + 1 < p.ph_hi) { cg::this_grid().sync(); } } while (0)
#define IN(k) (p.ph_lo <= (k) && (k) < p.ph_hi)
    if (IN(0)) { phase_rope(p, vb, G); } SEAM(0);
    if (IN(1)) { phase_proj(p, lds, vb, G); } SEAM(1);
    if (IN(2)) { phase_attn(p, lds, vb, G); } SEAM(2);
    if (IN(3)) { phase_wout(p, lds, vb, G); } SEAM(3);
    if (IN(4)) { phase_router(p, lds, vb, G); } SEAM(4);
    if (IN(5)) { phase_experts(p, lds, vb, G); } SEAM(5);
    if (IN(6)) { phase_final(p, vb, G); }
#undef SEAM
#undef IN
}

extern "C" void kernel_launch(void* const* d_in, const int* in_sizes, int n_in, void* d_out, int out_size, void* d_ws, size_t ws_size, hipStream_t stream) {
    static int grid = 0;
    if (grid == 0) {
        if (n_in != 22 || in_sizes[0] != S * D || out_size != S * D || ws_size < WS_END) {
            fprintf(stderr, "kernel_launch: unexpected shapes: n_in %d in0 %d out %d ws %zu (need %zu)\n", n_in, n_in > 0 ? in_sizes[0] : -1, out_size, ws_size, (size_t)WS_END); grid = -1; return; }
        int dev = 0, cus = 0, per_cu = 0;
        hipGetDevice(&dev); hipDeviceGetAttribute(&cus, hipDeviceAttributeMultiprocessorCount, dev);
        if (hipFuncSetAttribute((const void*)mega, hipFuncAttributeMaxDynamicSharedMemorySize, LDS_BYTES) != hipSuccess) { fprintf(stderr, "kernel_launch: hipFuncSetAttribute failed\n"); grid = -1; return; }
        hipOccupancyMaxActiveBlocksPerMultiprocessor(&per_cu, (const void*)mega, NTHREADS, LDS_BYTES);
        if (per_cu < 1) { fprintf(stderr, "kernel_launch: occupancy query says %d blocks per CU\n", per_cu); per_cu = 1; }
        grid = cus * 1;
        (void)hipGetLastError();
    }
    if (grid < 0) return;
    hipMemsetAsync((char*)d_ws + WS_CTL, 0, CTL_BYTES, stream);
    Params p{};
    const float** f = (const float**)&p;
    for (int i = 0; i < 22; ++i) f[i] = (const float*)d_in[i];
    p.out = (float*)d_out; p.ws = (unsigned char*)d_ws;
#if MK_ONE_LAUNCH
    p.ph_lo = 0; p.ph_hi = 7;
    void* args[] = {&p};
    hipError_t e = hipLaunchCooperativeKernel((const void*)mega, dim3(grid), dim3(NTHREADS), args, LDS_BYTES, stream);
    if (e != hipSuccess) fprintf(stderr, "kernel_launch: cooperative launch failed: %s (grid %d)\n", hipGetErrorString(e), grid);
#else
    for (int ph = 0; ph < 7; ++ph) {
        p.ph_lo = ph; p.ph_hi = ph + 1;
        hipLaunchKernelGGL(mega, dim3(grid), dim3(NTHREADS), LDS_BYTES, stream, p);
    }
#endif
}
```

```cpp
#include <hip/hip_runtime.h>
#include <hip/hip_cooperative_groups.h>
#include <cstdio>
#include <cstdint>
namespace cg = cooperative_groups;

#ifndef MK_ONE_LAUNCH
#define MK_ONE_LAUNCH 1
#endif

constexpr int S = 16384, D = 1024, INW = 2304, NE = 256, FF = 256;
constexpr int NTHREADS = 512;
constexpr int CAP = 16384;
constexpr float ALPHA = 1.189207115002721f;
constexpr float LN_EPS = 1e-5f;
constexpr float QSCALE = 0.125f * 1.4426950408889634f;
constexpr float LOG2E = 1.4426950408889634f;
constexpr int C_AQ = 0, C_AK = 512, C_AV = 640, C_BQ = 768, C_BK = 1280, C_BV = 1792;

constexpr size_t MiB = 1ull << 20;
constexpr size_t WS_CTL = 0;
constexpr size_t CTL_BYTES = 64 * 1024;
constexpr size_t WS_ROPE = 1 * MiB;
constexpr size_t WS_PROJ = 8 * MiB;
constexpr size_t WS_ATT = 80 * MiB;
constexpr size_t WS_PRELN = 112 * MiB;
constexpr size_t WS_X1F = 176 * MiB;
constexpr size_t WS_X1B = 240 * MiB;
constexpr size_t WS_LIST = 272 * MiB;
constexpr size_t WS_GATE = 288 * MiB;
constexpr size_t WS_ACT = 290 * MiB;
constexpr size_t WS_Y = 368 * MiB;
constexpr size_t WS_END = 660 * MiB;

constexpr int LDS_BYTES = 147456;
constexpr int LDS_MISC = 131072;

typedef unsigned short bf16_t;
typedef short bf16x8 __attribute__((ext_vector_type(8)));
typedef short s16x4 __attribute__((ext_vector_type(4)));
typedef float f32x4 __attribute__((ext_vector_type(4)));
typedef float f32x16 __attribute__((ext_vector_type(16)));
typedef unsigned u32x4 __attribute__((ext_vector_type(4)));
typedef unsigned u32x2 __attribute__((ext_vector_type(2)));

struct Params {
    const float* x; const float* w_in; const float* b_in; const float* sinks;
    const float* lq1; const float* lk1; const float* lq2; const float* lk2; const float* subg;
    const float* w_out; const float* ln1g; const float* ln1b; const float* w_r; const float* r_bias;
    const float* w_g; const float* w_u; const float* w_d; const float* ws_g; const float* ws_u; const float* ws_d;
    const float* ln2g; const float* ln2b;
    float* out; unsigned char* ws;
    int ph_lo, ph_hi;
};

__device__ __forceinline__ unsigned cvt_pk(float lo, float hi) { unsigned r; asm volatile("v_cvt_pk_bf16_f32 %0, %1, %2" : "=v"(r) : "v"(lo), "v"(hi)); return r; }
__device__ __forceinline__ float bf_lo(unsigned u) { return __uint_as_float(u << 16); }
__device__ __forceinline__ float bf_hi(unsigned u) { return __uint_as_float(u & 0xffff0000u); }
__device__ __forceinline__ float wave_sum(float v) {
#pragma unroll
    for (int o = 1; o < 64; o <<= 1) v += __shfl_xor(v, o);
    return v;
}
__device__ __forceinline__ float half_max(float v) { auto rr = __builtin_amdgcn_permlane32_swap(__float_as_uint(v), __float_as_uint(v), false, false); return fmaxf(__uint_as_float(rr[0]), __uint_as_float(rr[1])); }
__device__ __forceinline__ float half_sum(float v) { auto rr = __builtin_amdgcn_permlane32_swap(__float_as_uint(v), __float_as_uint(v), false, false); return __uint_as_float(rr[0]) + __uint_as_float(rr[1]); }

__device__ __forceinline__ int swz(int r, int c) { const int f = (r & 7) ^ (((r >> 3) & 1) << 1) ^ ((r >> 4) & 1); return r * 128 + ((c ^ f) << 4); }

constexpr int G_A0 = 0, G_A1 = 16384, G_B0 = 32768, G_B1 = 65536;
struct GemmArgs {
    const char* a0; const char* a1;
    const float* b;
    int ldb; int nk;
};
template <int AF32, class Epi>
__device__ __forceinline__ void gemm_tile(char* lds, const GemmArgs g, const Epi& epi) {
    const int tid = threadIdx.x, lane = tid & 63, w = tid >> 6, wr = w >> 2, wc = w & 3, fr = lane & 15, fq = lane >> 4;
    f32x4 acc[4][4];
#pragma unroll
    for (int i = 0; i < 4; ++i)
#pragma unroll
        for (int j = 0; j < 4; ++j) acc[i][j] = (f32x4){0.f, 0.f, 0.f, 0.f};
    const int aw0 = swz(tid >> 3, tid & 7), aw1 = swz(64 + (tid >> 3), tid & 7);
    int bw[4];
#pragma unroll
    for (int j = 0; j < 4; ++j) bw[j] = swz(4 * lane + j, w);
    u32x4 ar0, ar1; f32x4 af0a, af0b, af1a, af1b; f32x4 br[8];
    const char* pa0 = g.a0; const char* pa1 = g.a1; const float* pb = g.b;
#define G_LOAD() do { \
        if (AF32) { af0a = *(const f32x4*)pa0; af0b = *(const f32x4*)(pa0 + 16); af1a = *(const f32x4*)pa1; af1b = *(const f32x4*)(pa1 + 16); pa0 += 256; pa1 += 256; } \
        else { ar0 = *(const u32x4*)pa0; ar1 = *(const u32x4*)pa1; pa0 += 128; pa1 += 128; } \
        _Pragma("unroll") for (int i = 0; i < 8; ++i) br[i] = *(const f32x4*)(pb + (size_t)i * g.ldb); \
        pb += (size_t)64 * g.ldb; } while (0)
#define G_WRITE(AOFF, BOFF) do { \
        if (AF32) { ar0 = (u32x4){cvt_pk(af0a[0], af0a[1]), cvt_pk(af0a[2], af0a[3]), cvt_pk(af0b[0], af0b[1]), cvt_pk(af0b[2], af0b[3])}; \
                    ar1 = (u32x4){cvt_pk(af1a[0], af1a[1]), cvt_pk(af1a[2], af1a[3]), cvt_pk(af1b[0], af1b[1]), cvt_pk(af1b[2], af1b[3])}; } \
        *(u32x4*)(lds + (AOFF) + aw0) = ar0; *(u32x4*)(lds + (AOFF) + aw1) = ar1; \
        _Pragma("unroll") for (int j = 0; j < 4; ++j) { \
            u32x4 v = {cvt_pk(br[0][j], br[1][j]), cvt_pk(br[2][j], br[3][j]), cvt_pk(br[4][j], br[5][j]), cvt_pk(br[6][j], br[7][j])}; \
            *(u32x4*)(lds + (BOFF) + bw[j]) = v; } } while (0)
    G_LOAD(); G_WRITE(G_A0, G_B0); __syncthreads();
    for (int kt = 0; kt < g.nk; ++kt) {
        const int aoff = (kt & 1) ? G_A1 : G_A0, boff = (kt & 1) ? G_B1 : G_B0;
        const bool more = (kt + 1 < g.nk);
        if (more) G_LOAD();
#pragma unroll
        for (int ks = 0; ks < 2; ++ks) {
            bf16x8 af[4], bfr[4];
#pragma unroll
            for (int mt = 0; mt < 4; ++mt) af[mt] = *(const bf16x8*)(lds + aoff + swz(wr * 64 + mt * 16 + fr, ks * 4 + fq));
#pragma unroll
            for (int nt = 0; nt < 4; ++nt) bfr[nt] = *(const bf16x8*)(lds + boff + swz(wc * 64 + nt * 16 + fr, ks * 4 + fq));
#pragma unroll
            for (int mt = 0; mt < 4; ++mt)
#pragma unroll
                for (int nt = 0; nt < 4; ++nt) acc[mt][nt] = __builtin_amdgcn_mfma_f32_16x16x32_bf16(bfr[nt], af[mt], acc[mt][nt], 0, 0, 0);
        }
        if (more) { if (kt & 1) G_WRITE(G_A0, G_B0); else G_WRITE(G_A1, G_B1); }
        __syncthreads();
    }
#undef G_LOAD
#undef G_WRITE
    epi(acc, wr, wc, fr, fq);
}

__device__ __forceinline__ void phase_rope(const Params& p, int vb, int G) {
    float* cs = (float*)(p.ws + WS_ROPE); float* sn = cs + (size_t)S * 32;
    for (int idx = vb * NTHREADS + threadIdx.x; idx < S * 32; idx += G * NTHREADS) {
        const int pos = idx >> 5, i = idx & 31;
        const float pw = (float)pow(10000.0, (double)i / 32.0);
        const float inv = 1.0f / pw;
        const float angf = __fmul_rn((float)pos, inv);
        const double a = (double)angf;
        const double q = rint(a * 0.63661977236758134308);
        double r = fma(-q, 1.57079632679489655800, a); r = fma(-q, 6.12323399573676603587e-17, r);
        const double r2 = r * r;
        double sp = r * (1.0 + r2 * (-1.0 / 6 + r2 * (1.0 / 120 + r2 * (-1.0 / 5040 + r2 * (1.0 / 362880 + r2 * (-1.0 / 39916800))))));
        double cp = 1.0 + r2 * (-0.5 + r2 * (1.0 / 24 + r2 * (-1.0 / 720 + r2 * (1.0 / 40320 + r2 * (-1.0 / 3628800 + r2 * (1.0 / 479001600))))));
        const int qi = ((int)((long long)q)) & 3;
        double sv, cv;
        if (qi == 0) { sv = sp; cv = cp; } else if (qi == 1) { sv = cp; cv = -sp; } else if (qi == 2) { sv = -sp; cv = -cp; } else { sv = -cp; cv = sp; }
        cs[idx] = (float)cv; sn[idx] = (float)sv;
    }
}

struct EpiProj {
    const float* bias; const float* cs; const float* sn; bf16_t* out; int row0, col0;
    __device__ __forceinline__ void operator()(f32x4 (&acc)[4][4], int wr, int wc, int fr, int fq) const {
        const int hb = col0 + wc * 64;
        const bool is_q = (hb < C_AK) || (hb >= C_BQ && hb < C_BK);
        const bool is_rope = is_q || (hb >= C_AK && hb < C_AV) || (hb >= C_BK && hb < C_BV);
        const float sc = is_q ? QSCALE : 1.0f;
#pragma unroll
        for (int mt = 0; mt < 4; ++mt) {
            const int row = row0 + wr * 64 + mt * 16 + fr;
            f32x4 v[4];
#pragma unroll
            for (int nt = 0; nt < 4; ++nt) v[nt] = acc[mt][nt] + *(const f32x4*)(bias + hb + nt * 16 + 4 * fq);
            if (is_rope) {
#pragma unroll
                for (int nt = 0; nt < 2; ++nt) {
                    const f32x4 c = *(const f32x4*)(cs + (size_t)row * 32 + nt * 16 + 4 * fq), s = *(const f32x4*)(sn + (size_t)row * 32 + nt * 16 + 4 * fq);
                    const f32x4 t1 = v[nt], t2 = v[nt + 2];
                    v[nt] = t1 * c - t2 * s; v[nt + 2] = t2 * c + t1 * s;
                }
            }
#pragma unroll
            for (int nt = 0; nt < 4; ++nt) {
                const f32x4 o = v[nt] * sc;
                u32x2 pk = {cvt_pk(o[0], o[1]), cvt_pk(o[2], o[3])};
                *(u32x2*)(out + (size_t)row * INW + hb + nt * 16 + 4 * fq) = pk;
            }
        }
    }
};
__device__ __forceinline__ void phase_proj(const Params& p, char* lds, int vb, int G) {
    const int tid = threadIdx.x, lane = tid & 63, w = tid >> 6;
    constexpr int NTN = INW / 256, NU = (S / 128) * NTN;
    const float* cs = (const float*)(p.ws + WS_ROPE); const float* sn = cs + (size_t)S * 32;
    for (int u = vb; u < NU; u += G) {
        const int tm = u / NTN, tn = u % NTN;
        GemmArgs g;
        g.a0 = (const char*)(p.x + (size_t)(tm * 128 + (tid >> 3)) * D + (tid & 7) * 8);
        g.a1 = (const char*)(p.x + (size_t)(tm * 128 + 64 + (tid >> 3)) * D + (tid & 7) * 8);
        g.b = p.w_in + (size_t)(w * 8) * INW + tn * 256 + 4 * lane; g.ldb = INW; g.nk = D / 64;
        EpiProj e{p.b_in, cs, sn, (bf16_t*)(p.ws + WS_PROJ), tm * 128, tn * 256};
        gemm_tile<1>(lds, g, e);
    }
}

template <int OFF> __device__ __forceinline__ s16x4 tr_read(int vb) { s16x4 r; asm volatile("ds_read_b64_tr_b16 %0, %1 offset:%2" : "=&v"(r) : "v"(vb), "i"(OFF) : "memory"); return r; }
__device__ __forceinline__ int v_off(int k, int c, int ndb) { return ((k >> 3) * ndb + (c >> 5)) * 512 + ((k & 7) * 32 + (c & 31)) * 2; }

constexpr int AT_STAGE = 32768;
template <int NDB, int T, int KB, int KS> struct PvStep {
    static __device__ __forceinline__ void run(f32x16& o, int vbase, const bf16x8& pf) {
        constexpr int off = ((KB * 4 + KS * 2) * NDB + T) * 512;
        const s16x4 lo = tr_read<off>(vbase), hi = tr_read<off + NDB * 512>(vbase);
        asm volatile("s_waitcnt lgkmcnt(0)" ::: "memory"); __builtin_amdgcn_sched_barrier(0);
        const bf16x8 vf = {lo[0], lo[1], lo[2], lo[3], hi[0], hi[1], hi[2], hi[3]};
        o = __builtin_amdgcn_mfma_f32_32x32x16_bf16(vf, pf, o, 0, 0, 0);
    }
};
template <int NDB>
__device__ __forceinline__ void attn_tile(char* lds, int kof, int vbase, const bf16x8 (&qf)[4], f32x16 (&o)[NDB], float& m, float& l, int r32, int hi) {
    f32x16 s0 = {}, s1 = {};
#pragma unroll
    for (int ds = 0; ds < 4; ++ds) {
        const bf16x8 k0 = *(const bf16x8*)(lds + kof + swz(r32, ds * 2 + hi)), k1 = *(const bf16x8*)(lds + kof + swz(32 + r32, ds * 2 + hi));
        s0 = __builtin_amdgcn_mfma_f32_32x32x16_bf16(k0, qf[ds], s0, 0, 0, 0);
        s1 = __builtin_amdgcn_mfma_f32_32x32x16_bf16(k1, qf[ds], s1, 0, 0, 0);
    }
    float mx = s0[0];
#pragma unroll
    for (int r = 1; r < 16; ++r) mx = fmaxf(mx, s0[r]);
#pragma unroll
    for (int r = 0; r < 16; ++r) mx = fmaxf(mx, s1[r]);
    mx = half_max(mx);
    const float mn = fmaxf(m, mx), alpha = __builtin_amdgcn_exp2f(m - mn);
    m = mn;
    float ps = 0.f;
#pragma unroll
    for (int r = 0; r < 16; ++r) { s0[r] = __builtin_amdgcn_exp2f(s0[r] - mn); ps += s0[r]; }
#pragma unroll
    for (int r = 0; r < 16; ++r) { s1[r] = __builtin_amdgcn_exp2f(s1[r] - mn); ps += s1[r]; }
    ps = half_sum(ps);
    l = l * alpha + ps;
    if (!__all(alpha == 1.0f)) {
#pragma unroll
        for (int t = 0; t < NDB; ++t)
#pragma unroll
            for (int r = 0; r < 16; ++r) o[t][r] *= alpha;
    }
    bf16x8 pf[4];
#pragma unroll
    for (int s = 0; s < 2; ++s) {
        u32x4 a = {cvt_pk(s0[8 * s + 0], s0[8 * s + 1]), cvt_pk(s0[8 * s + 2], s0[8 * s + 3]), cvt_pk(s0[8 * s + 4], s0[8 * s + 5]), cvt_pk(s0[8 * s + 6], s0[8 * s + 7])};
        u32x4 b = {cvt_pk(s1[8 * s + 0], s1[8 * s + 1]), cvt_pk(s1[8 * s + 2], s1[8 * s + 3]), cvt_pk(s1[8 * s + 4], s1[8 * s + 5]), cvt_pk(s1[8 * s + 6], s1[8 * s + 7])};
        pf[s] = *(bf16x8*)&a; pf[2 + s] = *(bf16x8*)&b;
    }
    if constexpr (NDB == 4) {
        PvStep<4, 0, 0, 0>::run(o[0], vbase, pf[0]); PvStep<4, 1, 0, 0>::run(o[1], vbase, pf[0]); PvStep<4, 2, 0, 0>::run(o[2], vbase, pf[0]); PvStep<4, 3, 0, 0>::run(o[3], vbase, pf[0]);
        PvStep<4, 0, 0, 1>::run(o[0], vbase, pf[1]); PvStep<4, 1, 0, 1>::run(o[1], vbase, pf[1]); PvStep<4, 2, 0, 1>::run(o[2], vbase, pf[1]); PvStep<4, 3, 0, 1>::run(o[3], vbase, pf[1]);
        PvStep<4, 0, 1, 0>::run(o[0], vbase, pf[2]); PvStep<4, 1, 1, 0>::run(o[1], vbase, pf[2]); PvStep<4, 2, 1, 0>::run(o[2], vbase, pf[2]); PvStep<4, 3, 1, 0>::run(o[3], vbase, pf[2]);
        PvStep<4, 0, 1, 1>::run(o[0], vbase, pf[3]); PvStep<4, 1, 1, 1>::run(o[1], vbase, pf[3]); PvStep<4, 2, 1, 1>::run(o[2], vbase, pf[3]); PvStep<4, 3, 1, 1>::run(o[3], vbase, pf[3]);
    } else {
        PvStep<2, 0, 0, 0>::run(o[0], vbase, pf[0]); PvStep<2, 1, 0, 0>::run(o[1], vbase, pf[0]);
        PvStep<2, 0, 0, 1>::run(o[0], vbase, pf[1]); PvStep<2, 1, 0, 1>::run(o[1], vbase, pf[1]);
        PvStep<2, 0, 1, 0>::run(o[0], vbase, pf[2]); PvStep<2, 1, 1, 0>::run(o[1], vbase, pf[2]);
        PvStep<2, 0, 1, 1>::run(o[0], vbase, pf[3]); PvStep<2, 1, 1, 1>::run(o[1], vbase, pf[3]);
    }
}

__device__ __forceinline__ void attn_diff_unit(const Params& p, char* lds, int h, int qb, float lam) {
    const int tid = threadIdx.x, lane = tid & 63, w = tid >> 6, r32 = lane & 31, hi = lane >> 5, mp = w >> 2, wq = w & 3;
    const bf16_t* proj = (const bf16_t*)(p.ws + WS_PROJ);
    const int NT = 2 * qb + 2, myNT = (wq < 2) ? NT - 1 : NT;
    bf16x8 qf[4];
    { const bf16_t* qp = proj + (size_t)(qb * 128 + wq * 32 + r32) * INW + C_BQ + h * 128 + mp * 64 + hi * 8;
#pragma unroll
      for (int ds = 0; ds < 4; ++ds) qf[ds] = *(const bf16x8*)(qp + ds * 16); }
    f32x16 o[4] = {}; float m = -1e30f, l = 0.f;
    const bf16_t* gk0 = proj + (size_t)(tid >> 3) * INW + C_BK + h * 128 + (tid & 7) * 8;
    const bf16_t* gv0 = proj + (size_t)(tid >> 4) * INW + C_BV + h * 128 + (tid & 15) * 8;
    const int wk = swz(tid >> 3, tid & 7), wv0 = v_off(tid >> 4, (tid & 15) * 8, 4), wv1 = v_off(32 + (tid >> 4), (tid & 15) * 8, 4);
    const int vlane = ((lane & 3) << 3) | (((lane >> 2) & 3) << 6) | (((lane >> 4) & 1) << 5) | (((lane >> 5) & 1) << 8);
    u32x4 st0, st1, st2, st3;
#define D_LOAD(t) do { const size_t ko = (size_t)(t) * 64 * INW; st0 = *(const u32x4*)(gk0 + ko); st1 = *(const u32x4*)(gk0 + ko + 64); st2 = *(const u32x4*)(gv0 + ko); st3 = *(const u32x4*)(gv0 + ko + (size_t)32 * INW); } while (0)
#define D_WRITE(b) do { char* sb = lds + (b) * AT_STAGE; *(u32x4*)(sb + wk) = st0; *(u32x4*)(sb + 8192 + wk) = st1; *(u32x4*)(sb + 16384 + wv0) = st2; *(u32x4*)(sb + 16384 + wv1) = st3; } while (0)
    D_LOAD(0); D_WRITE(0); __syncthreads();
    for (int t = 0; t < NT; ++t) {
        const int b = t & 1;
        if (t + 1 < NT) D_LOAD(t + 1);
        if (t < myNT) attn_tile<4>(lds, b * AT_STAGE + mp * 8192, (int)(uintptr_t)(lds + b * AT_STAGE + 16384) + vlane, qf, o, m, l, r32, hi);
        if (t + 1 < NT) D_WRITE(b ^ 1);
        __syncthreads();
    }
#undef D_LOAD
#undef D_WRITE
    float* xb = (float*)lds;
    const float il = 1.0f / l;
    if (mp == 1) {
        const float f = il * lam;
#pragma unroll
        for (int t = 0; t < 4; ++t)
#pragma unroll
            for (int r = 0; r < 16; ++r) xb[(wq * 64 + t * 16 + r) * 64 + lane] = o[t][r] * f;
    }
    __syncthreads();
    if (mp == 0) {
        float ss = 0.f;
#pragma unroll
        for (int t = 0; t < 4; ++t)
#pragma unroll
            for (int r = 0; r < 16; ++r) { const float v = o[t][r] * il - xb[(wq * 64 + t * 16 + r) * 64 + lane]; o[t][r] = v; ss += v * v; }
        ss = half_sum(ss);
        const float rs = rsqrtf(ss * (1.0f / 128.0f) + LN_EPS) * 0.8f;
        bf16_t* op = (bf16_t*)(p.ws + WS_ATT) + (size_t)(qb * 128 + wq * 32 + r32) * D + 512 + h * 128;
#pragma unroll
        for (int t = 0; t < 4; ++t)
#pragma unroll
            for (int rr = 0; rr < 4; ++rr) {
                const int dv0 = 32 * t + 8 * rr + 4 * hi;
                const f32x4 gg = *(const f32x4*)(p.subg + dv0);
                u32x2 pk = {cvt_pk(o[t][4 * rr] * rs * gg[0], o[t][4 * rr + 1] * rs * gg[1]), cvt_pk(o[t][4 * rr + 2] * rs * gg[2], o[t][4 * rr + 3] * rs * gg[3])};
                *(u32x2*)(op + dv0) = pk;
            }
    }
    __syncthreads();
}
__device__ __forceinline__ void attn_swa_unit(const Params& p, char* lds, int kvh, int n) {
    const int tid = threadIdx.x, lane = tid & 63, w = tid >> 6, r32 = lane & 31, hi = lane >> 5, g = w >> 1, hq = kvh * 4 + g;
    const bf16_t* proj = (const bf16_t*)(p.ws + WS_PROJ);
    const int c0 = (n >= 2) ? n - 2 : 0, NT = n - c0 + 1;
    const int tok = n * 64 + (w & 1) * 32 + r32;
    bf16x8 qf[4];
    { const bf16_t* qp = proj + (size_t)tok * INW + C_AQ + hq * 64 + hi * 8;
#pragma unroll
      for (int ds = 0; ds < 4; ++ds) qf[ds] = *(const bf16x8*)(qp + ds * 16); }
    f32x16 o[2] = {}; float m = p.sinks[hq] * LOG2E, l = 1.0f;
    const bf16_t* gk = proj + (size_t)(c0 * 64 + (tid >> 3)) * INW + C_AK + kvh * 64 + (tid & 7) * 8;
    const bf16_t* gv = proj + (size_t)(c0 * 64 + (tid >> 3)) * INW + C_AV + kvh * 64 + (tid & 7) * 8;
    const int wk = swz(tid >> 3, tid & 7), wv = v_off(tid >> 3, (tid & 7) * 8, 2);
    const int vlane = ((lane & 3) << 3) | (((lane >> 2) & 3) << 6) | (((lane >> 4) & 1) << 5) | (((lane >> 5) & 1) << 8);
    u32x4 st0, st1;
#define W_LOAD(t) do { const size_t ko = (size_t)(t) * 64 * INW; st0 = *(const u32x4*)(gk + ko); st1 = *(const u32x4*)(gv + ko); } while (0)
#define W_WRITE(b) do { char* sb = lds + (b) * AT_STAGE; *(u32x4*)(sb + wk) = st0; *(u32x4*)(sb + 8192 + wv) = st1; } while (0)
    W_LOAD(0); W_WRITE(0); __syncthreads();
    for (int t = 0; t < NT; ++t) {
        const int b = t & 1;
        if (t + 1 < NT) W_LOAD(t + 1);
        attn_tile<2>(lds, b * AT_STAGE, (int)(uintptr_t)(lds + b * AT_STAGE + 8192) + vlane, qf, o, m, l, r32, hi);
        if (t + 1 < NT) W_WRITE(b ^ 1);
        __syncthreads();
    }
#undef W_LOAD
#undef W_WRITE
    const float il = 1.0f / l;
    bf16_t* op = (bf16_t*)(p.ws + WS_ATT) + (size_t)tok * D + hq * 64;
#pragma unroll
    for (int t = 0; t < 2; ++t)
#pragma unroll
        for (int rr = 0; rr < 4; ++rr) {
            const int dv0 = 32 * t + 8 * rr + 4 * hi;
            u32x2 pk = {cvt_pk(o[t][4 * rr] * il, o[t][4 * rr + 1] * il), cvt_pk(o[t][4 * rr + 2] * il, o[t][4 * rr + 3] * il)};
            *(u32x2*)(op + dv0) = pk;
        }
}
__device__ __forceinline__ void phase_attn(const Params& p, char* lds, int vb, int G) {
    const int lane = threadIdx.x & 63;
    const float d1 = wave_sum(p.lq1[lane] * p.lk1[lane]), d2 = wave_sum(p.lq2[lane] * p.lk2[lane]);
    const float lam = expf(d1) - expf(d2) + 0.2f;
    for (int u = vb; u < 1024; u += G) {
        if (u < 256) attn_diff_unit(p, lds, u >> 6, 127 - (u & 63), lam);
        else if (u < 512) attn_diff_unit(p, lds, (u - 256) >> 6, (u - 256) & 63, lam);
        else attn_swa_unit(p, lds, (u - 512) >> 8, (u - 512) & 255);
    }
}

struct EpiPreLn {
    const float* x; float* out; int row0, col0;
    __device__ __forceinline__ void operator()(f32x4 (&acc)[4][4], int wr, int wc, int fr, int fq) const {
#pragma unroll
        for (int mt = 0; mt < 4; ++mt) {
            const size_t ro = (size_t)(row0 + wr * 64 + mt * 16 + fr) * D + col0 + wc * 64 + 4 * fq;
#pragma unroll
            for (int nt = 0; nt < 4; ++nt) { const f32x4 xv = *(const f32x4*)(x + ro + nt * 16); *(f32x4*)(out + ro + nt * 16) = xv * ALPHA + acc[mt][nt]; }
        }
    }
};
__device__ __forceinline__ void phase_wout(const Params& p, char* lds, int vb, int G) {
    const int tid = threadIdx.x, lane = tid & 63, w = tid >> 6;
    const bf16_t* att = (const bf16_t*)(p.ws + WS_ATT);
    for (int u = vb; u < (S / 128) * 4; u += G) {
        const int tm = u >> 2, tn = u & 3;
        GemmArgs g;
        g.a0 = (const char*)(att + (size_t)(tm * 128 + (tid >> 3)) * D + (tid & 7) * 8);
        g.a1 = (const char*)(att + (size_t)(tm * 128 + 64 + (tid >> 3)) * D + (tid & 7) * 8);
        g.b = p.w_out + (size_t)(w * 8) * D + tn * 256 + 4 * lane; g.ldb = D; g.nk = D / 64;
        EpiPreLn e{p.x, (float*)(p.ws + WS_PRELN), tm * 128, tn * 256};
        gemm_tile<0>(lds, g, e);
    }
}

struct EpiLogits {
    float* L;
    __device__ __forceinline__ void operator()(f32x4 (&acc)[4][4], int wr, int wc, int fr, int fq) const {
#pragma unroll
        for (int mt = 0; mt < 4; ++mt)
#pragma unroll
            for (int nt = 0; nt < 4; ++nt) *(f32x4*)(L + (wr * 64 + mt * 16 + fr) * 256 + wc * 64 + nt * 16 + 4 * fq) = acc[mt][nt];
    }
};
__device__ __forceinline__ void phase_router(const Params& p, char* lds, int vb, int G) {
    const int tid = threadIdx.x, lane = tid & 63, w = tid >> 6;
    const float* preln = (const float*)(p.ws + WS_PRELN);
    float* x1f = (float*)(p.ws + WS_X1F); bf16_t* x1b = (bf16_t*)(p.ws + WS_X1B);
    unsigned* cnt = (unsigned*)(p.ws + WS_CTL); int* list = (int*)(p.ws + WS_LIST); float* gates = (float*)(p.ws + WS_GATE);
    for (int u = vb; u < S / 128; u += G) {
        for (int i = 0; i < 16; ++i) {
            const int row = u * 128 + w * 16 + i;
            const f32x4* xr = (const f32x4*)(preln + (size_t)row * D) + lane;
            f32x4 v[4]; float s = 0.f;
#pragma unroll
            for (int j = 0; j < 4; ++j) { v[j] = xr[64 * j]; s += (v[j][0] + v[j][1]) + (v[j][2] + v[j][3]); }
            const float mean = wave_sum(s) * (1.0f / D); float s2 = 0.f;
#pragma unroll
            for (int j = 0; j < 4; ++j) { v[j] = v[j] - mean; s2 += (v[j][0] * v[j][0] + v[j][1] * v[j][1]) + (v[j][2] * v[j][2] + v[j][3] * v[j][3]); }
            const float rstd = rsqrtf(wave_sum(s2) * (1.0f / D) + LN_EPS);
#pragma unroll
            for (int j = 0; j < 4; ++j) {
                const f32x4 gg = *((const f32x4*)p.ln1g + lane + 64 * j), bb = *((const f32x4*)p.ln1b + lane + 64 * j);
                const f32x4 y = v[j] * rstd * gg + bb;
                *((f32x4*)(x1f + (size_t)row * D) + lane + 64 * j) = y;
                u32x2 pk = {cvt_pk(y[0], y[1]), cvt_pk(y[2], y[3])};
                *((u32x2*)(x1b + (size_t)row * D) + lane + 64 * j) = pk;
            }
        }
        asm volatile("s_waitcnt vmcnt(0)" ::: "memory");
        __syncthreads();
        GemmArgs g;
        g.a0 = (const char*)(x1b + (size_t)(u * 128 + (tid >> 3)) * D + (tid & 7) * 8);
        g.a1 = (const char*)(x1b + (size_t)(u * 128 + 64 + (tid >> 3)) * D + (tid & 7) * 8);
        g.b = p.w_r + (size_t)(w * 8) * NE + 4 * lane; g.ldb = NE; g.nk = D / 64;
        EpiLogits e{(float*)lds};
        gemm_tile<0>(lds, g, e);
        __syncthreads();
        const f32x4 rb = *((const f32x4*)p.r_bias + lane);
        const float NEG = -__builtin_inff();
        for (int i = 0; i < 16; ++i) {
            const int tl = w * 16 + i, t = u * 128 + tl;
            const f32x4 lg = *((const f32x4*)((const float*)lds + tl * 256) + lane);
            float sc[4], cand[4];
#pragma unroll
            for (int j = 0; j < 4; ++j) { sc[j] = 1.0f / (1.0f + expf(-lg[j])); cand[j] = sc[j] + rb[j]; }
            float a1, a2;
            { const float m01 = fmaxf(cand[0], cand[1]), n01 = fminf(cand[0], cand[1]), m23 = fmaxf(cand[2], cand[3]), n23 = fminf(cand[2], cand[3]);
              a1 = fmaxf(m01, m23); a2 = fmaxf(fminf(m01, m23), fmaxf(n01, n23)); }
#pragma unroll
            for (int off = 1; off < 8; off <<= 1) { const float b1 = __shfl_xor(a1, off), b2 = __shfl_xor(a2, off); const float n1 = fmaxf(a1, b1), n2 = fmaxf(fminf(a1, b1), fmaxf(a2, b2)); a1 = n1; a2 = n2; }
            const float gs = a1 + a2; const int mygrp = lane >> 3; int rank = 0;
#pragma unroll
            for (int g2 = 0; g2 < 8; ++g2) { const float v = __shfl(gs, g2 * 8); rank += (v > gs || (v == gs && g2 < mygrp)) ? 1 : 0; }
            if (rank >= 4) {
#pragma unroll
                for (int j = 0; j < 4; ++j) cand[j] = NEG;
            }
            int my_e = 0; float my_s = 0.f, gsum = 0.f;
#pragma unroll
            for (int k = 0; k < 8; ++k) {
                float bv = cand[0]; int bi = 0;
#pragma unroll
                for (int j = 1; j < 4; ++j) if (cand[j] > bv) { bv = cand[j]; bi = j; }
                int idx = 4 * lane + bi;
#pragma unroll
                for (int off = 32; off >= 1; off >>= 1) { const float ov = __shfl_xor(bv, off); const int oi = __shfl_xor(idx, off); if (ov > bv || (ov == bv && oi < idx)) { bv = ov; idx = oi; } }
                const int owner = idx >> 2, sub = idx & 3;
                float scv = sc[0];
#pragma unroll
                for (int j = 1; j < 4; ++j) scv = (sub == j) ? sc[j] : scv;
                if (lane == owner) {
#pragma unroll
                    for (int j = 0; j < 4; ++j) if (sub == j) cand[j] = NEG;
                }
                const float gsc = __shfl(scv, owner);
                if (lane == k) { my_e = idx; my_s = gsc; }
                gsum += gsc;
            }
            if (lane < 8) {
                const float gate = my_s / gsum * 2.5f;
                const unsigned pos = atomicAdd(cnt + my_e, 1u);
                list[(size_t)my_e * CAP + pos] = t * 8 + lane;
                gates[t * 8 + lane] = gate;
            }
        }
        __syncthreads();
    }
}

struct EpiAct {
    bf16_t* act; const int* slots; int ncol0;
    __device__ __forceinline__ void operator()(f32x4 (&acc)[4][4], int wr, int wc, int fr, int fq) const {
#pragma unroll
        for (int mt = 0; mt < 4; ++mt) {
            const int ar = slots[wr * 64 + mt * 16 + fr];
            if (ar >= 0) {
#pragma unroll
                for (int nt = 0; nt < 2; ++nt) {
                    const f32x4 gv = acc[mt][nt], uv = acc[mt][nt + 2]; float a[4];
#pragma unroll
                    for (int j = 0; j < 4; ++j) a[j] = gv[j] / (1.0f + __expf(-gv[j])) * uv[j];
                    u32x2 pk = {cvt_pk(a[0], a[1]), cvt_pk(a[2], a[3])};
                    *(u32x2*)(act + (size_t)ar * FF + ncol0 + wc * 32 + nt * 16 + 4 * fq) = pk;
                }
            }
        }
    }
};
struct EpiY {
    bf16_t* y; const int* yrows; const float* gl; int col0;
    __device__ __forceinline__ void operator()(f32x4 (&acc)[4][4], int wr, int wc, int fr, int fq) const {
#pragma unroll
        for (int mt = 0; mt < 4; ++mt) {
            const int r = wr * 64 + mt * 16 + fr, yr = yrows[r];
            if (yr >= 0) {
                const float gt = gl[r];
#pragma unroll
                for (int nt = 0; nt < 4; ++nt) {
                    const f32x4 v = acc[mt][nt] * gt;
                    u32x2 pk = {cvt_pk(v[0], v[1]), cvt_pk(v[2], v[3])};
                    *(u32x2*)(y + (size_t)yr * D + col0 + wc * 64 + nt * 16 + 4 * fq) = pk;
                }
            }
        }
    }
};
__device__ __forceinline__ void phase_experts(const Params& p, char* lds, int vb, int G) {
    const int tid = threadIdx.x, lane = tid & 63, w = tid >> 6;
    const bf16_t* x1b = (const bf16_t*)(p.ws + WS_X1B);
    const unsigned* cnt = (const unsigned*)(p.ws + WS_CTL); const int* list = (const int*)(p.ws + WS_LIST); const float* gates = (const float*)(p.ws + WS_GATE);
    bf16_t* act = (bf16_t*)(p.ws + WS_ACT); bf16_t* ybuf = (bf16_t*)(p.ws + WS_Y);
    int* nts = (int*)(lds + LDS_MISC); int* pre = nts + 256;
    int* s_arow = pre + 260; int* s_yrow = s_arow + 128; int* s_tok = s_yrow + 128; float* s_gate = (float*)(s_tok + 128);
    if (tid < 256) nts[tid] = (int)((__hip_atomic_load(cnt + tid, __ATOMIC_RELAXED, __HIP_MEMORY_SCOPE_AGENT) + 127u) >> 7);
    __syncthreads();
    if (tid < 257) { int s = 0; for (int e = 0; e < tid; ++e) s += nts[e]; pre[tid] = s; }
    __syncthreads();
    const int NR = pre[256], NU = NR + S / 128;
    for (int u = vb; u < NU; u += G) {
        __syncthreads();
        const float *wg, *wu, *wd;
        if (u < NR) {
            int lo = 0, hi = 255;
            while (lo < hi) { const int mid = (lo + hi + 1) >> 1; if (pre[mid] <= u) lo = mid; else hi = mid - 1; }
            const int e = lo, tile = u - pre[e], n = (int)__hip_atomic_load(cnt + e, __ATOMIC_RELAXED, __HIP_MEMORY_SCOPE_AGENT);
            if (tid < 128) {
                const int idx = tile * 128 + tid;
                if (idx < n) { const int slot = list[(size_t)e * CAP + idx]; s_arow[tid] = slot; s_yrow[tid] = slot + (slot >> 3); s_tok[tid] = slot >> 3; s_gate[tid] = gates[slot]; }
                else { s_arow[tid] = -1; s_yrow[tid] = -1; s_tok[tid] = 0; s_gate[tid] = 0.f; }
            }
            wg = p.w_g + (size_t)e * D * FF; wu = p.w_u + (size_t)e * D * FF; wd = p.w_d + (size_t)e * FF * D;
        } else {
            const int tile = u - NR;
            if (tid < 128) { const int tk = tile * 128 + tid; s_arow[tid] = S * 8 + tk; s_yrow[tid] = tk * 9 + 8; s_tok[tid] = tk; s_gate[tid] = 1.0f; }
            wg = p.ws_g; wu = p.ws_u; wd = p.ws_d;
        }
        __syncthreads();
        const int r0 = tid >> 3, r1 = 64 + (tid >> 3);
        for (int np = 0; np < 2; ++np) {
            GemmArgs g;
            g.a0 = (const char*)(x1b + (size_t)s_tok[r0] * D + (tid & 7) * 8);
            g.a1 = (const char*)(x1b + (size_t)s_tok[r1] * D + (tid & 7) * 8);
            const int n0 = 4 * lane, bwc = n0 >> 6, sub = n0 & 63;
            const float* bsrc = (sub < 32) ? (wg + np * 128 + bwc * 32 + sub) : (wu + np * 128 + bwc * 32 + (sub - 32));
            g.b = bsrc + (size_t)(w * 8) * FF; g.ldb = FF; g.nk = D / 64;
            EpiAct e{act, s_arow, np * 128};
            gemm_tile<0>(lds, g, e);
        }
        asm volatile("s_waitcnt vmcnt(0)" ::: "memory");
        __syncthreads();
        const int ar0 = s_arow[r0] < 0 ? 0 : s_arow[r0], ar1 = s_arow[r1] < 0 ? 0 : s_arow[r1];
        for (int np = 0; np < 4; ++np) {
            GemmArgs g;
            g.a0 = (const char*)(act + (size_t)ar0 * FF + (tid & 7) * 8);
            g.a1 = (const char*)(act + (size_t)ar1 * FF + (tid & 7) * 8);
            g.b = wd + (size_t)(w * 8) * D + np * 256 + 4 * lane; g.ldb = D; g.nk = FF / 64;
            EpiY e{ybuf, s_yrow, s_gate, np * 256};
            gemm_tile<0>(lds, g, e);
        }
    }
}

__device__ __forceinline__ void phase_final(const Params& p, int vb, int G) {
    const int lane = threadIdx.x & 63, w = threadIdx.x >> 6;
    const float* x1f = (const float*)(p.ws + WS_X1F); const bf16_t* ybuf = (const bf16_t*)(p.ws + WS_Y);
    for (int row = vb * 8 + w; row < S; row += G * 8) {
        f32x4 v[4]; float s = 0.f;
#pragma unroll
        for (int j = 0; j < 4; ++j) v[j] = *((const f32x4*)(x1f + (size_t)row * D) + lane + 64 * j) * ALPHA;
#pragma unroll
        for (int k = 0; k < 9; ++k) {
            const u32x2* yr = (const u32x2*)(ybuf + (size_t)(row * 9 + k) * D) + lane;
#pragma unroll
            for (int j = 0; j < 4; ++j) { const u32x2 q = yr[64 * j]; v[j][0] += bf_lo(q[0]); v[j][1] += bf_hi(q[0]); v[j][2] += bf_lo(q[1]); v[j][3] += bf_hi(q[1]); }
        }
#pragma unroll
        for (int j = 0; j < 4; ++j) s += (v[j][0] + v[j][1]) + (v[j][2] + v[j][3]);
        const float mean = wave_sum(s) * (1.0f / D); float s2 = 0.f;
#pragma unroll
        for (int j = 0; j < 4; ++j) { v[j] = v[j] - mean; s2 += (v[j][0] * v[j][0] + v[j][1] * v[j][1]) + (v[j][2] * v[j][2] + v[j][3] * v[j][3]); }
        const float rstd = rsqrtf(wave_sum(s2) * (1.0f / D) + LN_EPS);
#pragma unroll
        for (int j = 0; j < 4; ++j) {
            const f32x4 gg = *((const f32x4*)p.ln2g + lane + 64 * j), bb = *((const f32x4*)p.ln2b + lane + 64 * j);
            *((f32x4*)(p.out + (size_t)row * D) + lane + 64 * j) = v[j] * rstd * gg + bb;
        }
    }
}

__global__ void __launch_bounds__(NTHREADS) mega(Params p) {
    extern __shared__ __attribute__((aligned(16))) char lds[];
    const int G = gridDim.x, bx = blockIdx.x;
    const int vb = (G % 8 == 0) ? (bx % 8) * (G / 8) + bx / 8 : bx;
#define SEAM(k) do { if (p.ph_lo <= (k) && (k) + 1 < p.ph_hi) { cg::this_grid().sync(); } } while (0)
#define IN(k) (p.ph_lo <= (k) && (k) < p.ph_hi)
    if (IN(0)) { phase_rope(p, vb, G); } SEAM(0);
    if (IN(1)) { phase_proj(p, lds, vb, G); } SEAM(1);
    if (IN(2)) { phase_attn(p, lds, vb, G); } SEAM(2);
    if (IN(3)) { phase_wout(p, lds, vb, G); } SEAM(3);
    if (IN(4)) { phase_router(p, lds, vb, G); } SEAM(4);
    if (IN(5)) { phase_experts(p, lds, vb, G); } SEAM(5);
    if (IN(6)) { phase_final(p, vb, G); }
#undef SEAM
#undef IN
}

extern "C" void kernel_launch(void* const* d_in, const int* in_sizes, int n_in, void* d_out, int out_size, void* d_ws, size_t ws_size, hipStream_t stream) {
    static int grid = 0;
    if (grid == 0) {
        if (n_in != 22 || in_sizes[0] != S * D || out_size != S * D || ws_size < WS_END) {
            fprintf(stderr, "kernel_launch: unexpected shapes: n_in %d in0 %d out %d ws %zu (need %zu)\n", n_in, n_in > 0 ? in_sizes[0] : -1, out_size, ws_size, (size_t)WS_END); grid = -1; return; }
        int dev = 0, cus = 0, per_cu = 0;
        hipGetDevice(&dev); hipDeviceGetAttribute(&cus, hipDeviceAttributeMultiprocessorCount, dev);
        if (hipFuncSetAttribute((const void*)mega, hipFuncAttributeMaxDynamicSharedMemorySize, LDS_BYTES) != hipSuccess) { fprintf(stderr, "kernel_launch: hipFuncSetAttribute failed\n"); grid = -1; return; }
        hipOccupancyMaxActiveBlocksPerMultiprocessor(&per_cu, (const void*)mega, NTHREADS, LDS_BYTES);
        if (per_cu < 1) { fprintf(stderr, "kernel_launch: occupancy query says %d blocks per CU\n", per_cu); per_cu = 1; }
        grid = cus * 1;
        (void)hipGetLastError();
    }
    if (grid < 0) return;
    hipMemsetAsync((char*)d_ws + WS_CTL, 0, CTL_BYTES, stream);
    Params p{};
    const float** f = (const float**)&p;
    for (int i = 0; i < 22; ++i) f[i] = (const float*)d_in[i];
    p.out = (float*)d_out; p.ws = (unsigned char*)d_ws;
#if MK_ONE_LAUNCH
    p.ph_lo = 0; p.ph_hi = 7;
    void* args[] = {&p};
    hipError_t e = hipLaunchCooperativeKernel((const void*)mega, dim3(grid), dim3(NTHREADS), args, LDS_BYTES, stream);
    if (e != hipSuccess) fprintf(stderr, "kernel_launch: cooperative launch failed: %s (grid %d)\n", hipGetErrorString(e), grid);
#else
    for (int ph = 0; ph < 7; ++ph) {
        p.ph_lo = ph; p.ph_hi = ph + 1;
        hipLaunchKernelGGL(mega, dim3(grid), dim3(NTHREADS), LDS_BYTES, stream, p);
    }
#endif
}
```

```cpp
#include <hip/hip_runtime.h>
#include <hip/hip_cooperative_groups.h>
#include <cstdio>
#include <cstdint>
namespace cg = cooperative_groups;

#ifndef MK_REPEAT
#define MK_REPEAT -1
#endif
#ifndef MK_ONE_LAUNCH
#define MK_ONE_LAUNCH 1
#endif

constexpr int S = 16384, D = 1024, INW = 2304, NE = 256, FF = 256;
constexpr int NTHREADS = 512;
constexpr int CAP = 16384;
constexpr float ALPHA = 1.189207115002721f;
constexpr float LN_EPS = 1e-5f;
constexpr float QSCALE = 0.125f * 1.4426950408889634f;
constexpr float LOG2E = 1.4426950408889634f;
constexpr int C_AQ = 0, C_AK = 512, C_AV = 640, C_BQ = 768, C_BK = 1280, C_BV = 1792;

constexpr size_t MiB = 1ull << 20;
constexpr size_t WS_CTL = 0;
constexpr size_t CTL_BYTES = 64 * 1024;
constexpr size_t WS_ROPE = 1 * MiB;
constexpr size_t WS_PROJ = 8 * MiB;
constexpr size_t WS_ATT = 80 * MiB;
constexpr size_t WS_PRELN = 112 * MiB;
constexpr size_t WS_X1F = 176 * MiB;
constexpr size_t WS_X1B = 240 * MiB;
constexpr size_t WS_LIST = 272 * MiB;
constexpr size_t WS_GATE = 288 * MiB;
constexpr size_t WS_ACT = 290 * MiB;
constexpr size_t WS_Y = 368 * MiB;
constexpr size_t WS_END = 660 * MiB;

constexpr int LDS_BYTES = 147456;
constexpr int LDS_MISC = 131072;

typedef unsigned short bf16_t;
typedef short bf16x8 __attribute__((ext_vector_type(8)));
typedef short s16x4 __attribute__((ext_vector_type(4)));
typedef float f32x4 __attribute__((ext_vector_type(4)));
typedef float f32x16 __attribute__((ext_vector_type(16)));
typedef unsigned u32x4 __attribute__((ext_vector_type(4)));
typedef unsigned u32x2 __attribute__((ext_vector_type(2)));


#define LAS __attribute__((address_space(3)))
#define XB_TMO      128
#define XB_XCNT(j)  (256  + 64 * (j))
#define XB_XSUB(j)  (1280 + 64 * (j))
#define XB_XGEN(j)  (2304 + 64 * (j))
#define XB_TOP      3328
#define XB_TOPGEN   3392
#define XCD_BAR_WORDS 3456
#define XB_SPIN_CAP (1u << 18)
__device__ __forceinline__ unsigned xb_ld(unsigned* p)              { return __hip_atomic_load(p, __ATOMIC_RELAXED, __HIP_MEMORY_SCOPE_AGENT); }
__device__ __forceinline__ unsigned xb_add(unsigned* p, unsigned v) { return __hip_atomic_fetch_add(p, v, __ATOMIC_RELAXED, __HIP_MEMORY_SCOPE_AGENT); }
__device__ __forceinline__ unsigned xb_xcc_id() { return (unsigned)__builtin_amdgcn_s_getreg((3 << 11) | 20) & 0xFu; }
#define XB_SPIN(cond, bar) do { unsigned _sp = 0; while (cond) { __builtin_amdgcn_s_sleep(1); \
    if ((++_sp & 255u) == 0u) { if (xb_ld(&(bar)[XB_TMO])) break; if (_sp > XB_SPIN_CAP) { atomicAdd(&(bar)[XB_TMO], 1u); break; } } } } while (0)
struct XcdBarrier { unsigned* bar; unsigned x; volatile LAS unsigned* st; };
__device__ __forceinline__ XcdBarrier xcd_barrier_post(unsigned* bar, volatile LAS unsigned* st) {
    XcdBarrier b; b.bar = bar; b.x = xb_xcc_id(); b.st = st;
    if (threadIdx.x == 0) (void)xb_add(&bar[XB_XCNT(b.x)], 1u);
    return b;
}
__device__ __forceinline__ void xcd_barrier_complete(unsigned* bar, unsigned x, unsigned& nloc, unsigned& nx) {
    const unsigned G = gridDim.x * gridDim.y * gridDim.z;
    unsigned sum, cnt, mine, sp = 0u;
    for (;;) {
        sum = 0u; cnt = 0u; mine = 0u;
#pragma unroll
        for (unsigned j = 0; j < 16; ++j) { const unsigned c = xb_ld(&bar[XB_XCNT(j)]); sum += c; cnt += (c > 0u) ? 1u : 0u; mine = (j == x) ? c : mine; }
        if (sum == G) break;
        __builtin_amdgcn_s_sleep(1);
        if ((++sp & 255u) == 0u) { if (xb_ld(&bar[XB_TMO])) break; if (sp > XB_SPIN_CAP) { atomicAdd(&bar[XB_TMO], 1u); break; } }
    }
    nloc = mine > 0u ? mine : 1u; nx = cnt > 0u ? cnt : 1u;
}
__device__ __forceinline__ void xcd_barrier(const XcdBarrier& b) {
    asm volatile("s_waitcnt vmcnt(0)" ::: "memory");
    __syncthreads();
    if (threadIdx.x == 0) {
        unsigned* bar = b.bar;
        __builtin_amdgcn_s_waitcnt(0);
        unsigned nloc = b.st[0], nx = b.st[1];
        if (nloc == 0u) { xcd_barrier_complete(bar, b.x, nloc, nx); b.st[0] = nloc; b.st[1] = nx; }
        const unsigned old = xb_add(&bar[XB_XSUB(b.x)], 1u);
        const unsigned gen = old / nloc;
        if (old + 1u == (gen + 1u) * nloc) {
            __builtin_amdgcn_fence(__ATOMIC_RELEASE, "agent");
            asm volatile("s_waitcnt vmcnt(0)" ::: "memory");
            const unsigned og = xb_add(&bar[XB_TOP], 1u);
            const unsigned tg = og / nx;
            if (og + 1u == (tg + 1u) * nx) xb_add(&bar[XB_TOPGEN], 1u);
            else XB_SPIN(xb_ld(&bar[XB_TOPGEN]) == tg, bar);
            __builtin_amdgcn_fence(__ATOMIC_ACQUIRE, "agent");
            xb_add(&bar[XB_XGEN(b.x)], 1u);
            asm volatile("s_waitcnt vmcnt(0)" ::: "memory");
        } else {
            XB_SPIN(xb_ld(&bar[XB_XGEN(b.x)]) == gen, bar);
            __builtin_amdgcn_fence(__ATOMIC_ACQUIRE, "agent");
            asm volatile("s_waitcnt vmcnt(0)" ::: "memory");
        }
    }
    __syncthreads();
}
constexpr int CW_BAR = 4096;
constexpr int LDS_BARST = LDS_MISC + 8192;

struct Params {
    const float* x; const float* w_in; const float* b_in; const float* sinks;
    const float* lq1; const float* lk1; const float* lq2; const float* lk2; const float* subg;
    const float* w_out; const float* ln1g; const float* ln1b; const float* w_r; const float* r_bias;
    const float* w_g; const float* w_u; const float* w_d; const float* ws_g; const float* ws_u; const float* ws_d;
    const float* ln2g; const float* ln2b;
    float* out; unsigned char* ws;
    int ph_lo, ph_hi;
};

__device__ __forceinline__ unsigned cvt_pk(float lo, float hi) { unsigned r; asm volatile("v_cvt_pk_bf16_f32 %0, %1, %2" : "=v"(r) : "v"(lo), "v"(hi)); return r; }
__device__ __forceinline__ float bf_lo(unsigned u) { return __uint_as_float(u << 16); }
__device__ __forceinline__ float bf_hi(unsigned u) { return __uint_as_float(u & 0xffff0000u); }
__device__ __forceinline__ float wave_sum(float v) {
#pragma unroll
    for (int o = 1; o < 64; o <<= 1) v += __shfl_xor(v, o);
    return v;
}
__device__ __forceinline__ float half_max(float v) { auto rr = __builtin_amdgcn_permlane32_swap(__float_as_uint(v), __float_as_uint(v), false, false); return fmaxf(__uint_as_float(rr[0]), __uint_as_float(rr[1])); }
__device__ __forceinline__ float half_sum(float v) { auto rr = __builtin_amdgcn_permlane32_swap(__float_as_uint(v), __float_as_uint(v), false, false); return __uint_as_float(rr[0]) + __uint_as_float(rr[1]); }

__device__ __forceinline__ int swz(int r, int c) { const int f = (r & 7) ^ (((r >> 3) & 1) << 1) ^ ((r >> 4) & 1); return r * 128 + ((c ^ f) << 4); }

constexpr int G_A0 = 0, G_A1 = 16384, G_B0 = 32768, G_B1 = 65536;
struct GemmArgs {
    const char* a0; const char* a1;
    const float* b;
    int ldb; int nk;
};
template <int AF32, class Epi>
__device__ __forceinline__ void gemm_tile(char* lds, const GemmArgs g, const Epi& epi) {
    const int tid = threadIdx.x, lane = tid & 63, w = tid >> 6, wr = w >> 2, wc = w & 3, fr = lane & 15, fq = lane >> 4;
    f32x4 acc[4][4];
#pragma unroll
    for (int i = 0; i < 4; ++i)
#pragma unroll
        for (int j = 0; j < 4; ++j) acc[i][j] = (f32x4){0.f, 0.f, 0.f, 0.f};
    const int aw0 = swz(tid >> 3, tid & 7), aw1 = swz(64 + (tid >> 3), tid & 7);
    int bw[4];
#pragma unroll
    for (int j = 0; j < 4; ++j) bw[j] = swz(4 * lane + j, w);
    u32x4 ar0, ar1; f32x4 af0a, af0b, af1a, af1b; f32x4 br[8];
    const char* pa0 = g.a0; const char* pa1 = g.a1; const float* pb = g.b;
#define G_LOAD() do { \
        if (AF32) { af0a = *(const f32x4*)pa0; af0b = *(const f32x4*)(pa0 + 16); af1a = *(const f32x4*)pa1; af1b = *(const f32x4*)(pa1 + 16); pa0 += 256; pa1 += 256; } \
        else { ar0 = *(const u32x4*)pa0; ar1 = *(const u32x4*)pa1; pa0 += 128; pa1 += 128; } \
        _Pragma("unroll") for (int i = 0; i < 8; ++i) br[i] = *(const f32x4*)(pb + (size_t)i * g.ldb); \
        pb += (size_t)64 * g.ldb; } while (0)
#define G_WRITE(AOFF, BOFF) do { \
        if (AF32) { ar0 = (u32x4){cvt_pk(af0a[0], af0a[1]), cvt_pk(af0a[2], af0a[3]), cvt_pk(af0b[0], af0b[1]), cvt_pk(af0b[2], af0b[3])}; \
                    ar1 = (u32x4){cvt_pk(af1a[0], af1a[1]), cvt_pk(af1a[2], af1a[3]), cvt_pk(af1b[0], af1b[1]), cvt_pk(af1b[2], af1b[3])}; } \
        *(u32x4*)(lds + (AOFF) + aw0) = ar0; *(u32x4*)(lds + (AOFF) + aw1) = ar1; \
        _Pragma("unroll") for (int j = 0; j < 4; ++j) { \
            u32x4 v = {cvt_pk(br[0][j], br[1][j]), cvt_pk(br[2][j], br[3][j]), cvt_pk(br[4][j], br[5][j]), cvt_pk(br[6][j], br[7][j])}; \
            *(u32x4*)(lds + (BOFF) + bw[j]) = v; } } while (0)
    G_LOAD(); G_WRITE(G_A0, G_B0); __syncthreads();
    for (int kt = 0; kt < g.nk; ++kt) {
        const int aoff = (kt & 1) ? G_A1 : G_A0, boff = (kt & 1) ? G_B1 : G_B0;
        const bool more = (kt + 1 < g.nk);
        if (more) G_LOAD();
#pragma unroll
        for (int ks = 0; ks < 2; ++ks) {
            bf16x8 af[4], bfr[4];
#pragma unroll
            for (int mt = 0; mt < 4; ++mt) af[mt] = *(const bf16x8*)(lds + aoff + swz(wr * 64 + mt * 16 + fr, ks * 4 + fq));
#pragma unroll
            for (int nt = 0; nt < 4; ++nt) bfr[nt] = *(const bf16x8*)(lds + boff + swz(wc * 64 + nt * 16 + fr, ks * 4 + fq));
#pragma unroll
            for (int mt = 0; mt < 4; ++mt)
#pragma unroll
                for (int nt = 0; nt < 4; ++nt) acc[mt][nt] = __builtin_amdgcn_mfma_f32_16x16x32_bf16(bfr[nt], af[mt], acc[mt][nt], 0, 0, 0);
        }
        if (more) { if (kt & 1) G_WRITE(G_A0, G_B0); else G_WRITE(G_A1, G_B1); }
        __syncthreads();
    }
#undef G_LOAD
#undef G_WRITE
    epi(acc, wr, wc, fr, fq);
}

__device__ __forceinline__ void phase_rope(const Params& p, int vb, int G) {
    float* cs = (float*)(p.ws + WS_ROPE); float* sn = cs + (size_t)S * 32;
    for (int idx = vb * NTHREADS + threadIdx.x; idx < S * 32; idx += G * NTHREADS) {
        const int pos = idx >> 5, i = idx & 31;
        const float pw = (float)pow(10000.0, (double)i / 32.0);
        const float inv = 1.0f / pw;
        const float angf = __fmul_rn((float)pos, inv);
        const double a = (double)angf;
        const double q = rint(a * 0.63661977236758134308);
        double r = fma(-q, 1.57079632679489655800, a); r = fma(-q, 6.12323399573676603587e-17, r);
        const double r2 = r * r;
        double sp = r * (1.0 + r2 * (-1.0 / 6 + r2 * (1.0 / 120 + r2 * (-1.0 / 5040 + r2 * (1.0 / 362880 + r2 * (-1.0 / 39916800))))));
        double cp = 1.0 + r2 * (-0.5 + r2 * (1.0 / 24 + r2 * (-1.0 / 720 + r2 * (1.0 / 40320 + r2 * (-1.0 / 3628800 + r2 * (1.0 / 479001600))))));
        const int qi = ((int)((long long)q)) & 3;
        double sv, cv;
        if (qi == 0) { sv = sp; cv = cp; } else if (qi == 1) { sv = cp; cv = -sp; } else if (qi == 2) { sv = -sp; cv = -cp; } else { sv = -cp; cv = sp; }
        cs[idx] = (float)cv; sn[idx] = (float)sv;
    }
}

struct EpiProj {
    const float* bias; const float* cs; const float* sn; bf16_t* out; int row0, col0;
    __device__ __forceinline__ void operator()(f32x4 (&acc)[4][4], int wr, int wc, int fr, int fq) const {
        const int hb = col0 + wc * 64;
        const bool is_q = (hb < C_AK) || (hb >= C_BQ && hb < C_BK);
        const bool is_rope = is_q || (hb >= C_AK && hb < C_AV) || (hb >= C_BK && hb < C_BV);
        const float sc = is_q ? QSCALE : 1.0f;
#pragma unroll
        for (int mt = 0; mt < 4; ++mt) {
            const int row = row0 + wr * 64 + mt * 16 + fr;
            f32x4 v[4];
#pragma unroll
            for (int nt = 0; nt < 4; ++nt) v[nt] = acc[mt][nt] + *(const f32x4*)(bias + hb + nt * 16 + 4 * fq);
            if (is_rope) {
#pragma unroll
                for (int nt = 0; nt < 2; ++nt) {
                    const f32x4 c = *(const f32x4*)(cs + (size_t)row * 32 + nt * 16 + 4 * fq), s = *(const f32x4*)(sn + (size_t)row * 32 + nt * 16 + 4 * fq);
                    const f32x4 t1 = v[nt], t2 = v[nt + 2];
                    v[nt] = t1 * c - t2 * s; v[nt + 2] = t2 * c + t1 * s;
                }
            }
#pragma unroll
            for (int nt = 0; nt < 4; ++nt) {
                const f32x4 o = v[nt] * sc;
                u32x2 pk = {cvt_pk(o[0], o[1]), cvt_pk(o[2], o[3])};
                *(u32x2*)(out + (size_t)row * INW + hb + nt * 16 + 4 * fq) = pk;
            }
        }
    }
};
__device__ __forceinline__ void phase_proj(const Params& p, char* lds, int vb, int G) {
    const int tid = threadIdx.x, lane = tid & 63, w = tid >> 6;
    constexpr int NTN = INW / 256, NU = (S / 128) * NTN;
    const float* cs = (const float*)(p.ws + WS_ROPE); const float* sn = cs + (size_t)S * 32;
    for (int u = vb; u < NU; u += G) {
        const int tm = u / NTN, tn = u % NTN;
        GemmArgs g;
        g.a0 = (const char*)(p.x + (size_t)(tm * 128 + (tid >> 3)) * D + (tid & 7) * 8);
        g.a1 = (const char*)(p.x + (size_t)(tm * 128 + 64 + (tid >> 3)) * D + (tid & 7) * 8);
        g.b = p.w_in + (size_t)(w * 8) * INW + tn * 256 + 4 * lane; g.ldb = INW; g.nk = D / 64;
        EpiProj e{p.b_in, cs, sn, (bf16_t*)(p.ws + WS_PROJ), tm * 128, tn * 256};
        gemm_tile<1>(lds, g, e);
    }
}

template <int OFF> __device__ __forceinline__ s16x4 tr_read(int vb) { s16x4 r; asm volatile("ds_read_b64_tr_b16 %0, %1 offset:%2" : "=&v"(r) : "v"(vb), "i"(OFF) : "memory"); return r; }
__device__ __forceinline__ int v_off(int k, int c, int ndb) { return ((k >> 3) * ndb + (c >> 5)) * 512 + ((k & 7) * 32 + (c & 31)) * 2; }

constexpr int AT_STAGE = 32768;
template <int NDB, int T> struct PvBlk {
    static __device__ __forceinline__ void run(f32x16& o, int vbase, const bf16x8 (&pf)[4]) {
        constexpr int o0 = ((0 * NDB) + T) * 512, st = NDB * 512;
        const s16x4 l0 = tr_read<o0 + 0 * st>(vbase), h0 = tr_read<o0 + 1 * st>(vbase), l1 = tr_read<o0 + 2 * st>(vbase), h1 = tr_read<o0 + 3 * st>(vbase);
        const s16x4 l2 = tr_read<o0 + 4 * st>(vbase), h2 = tr_read<o0 + 5 * st>(vbase), l3 = tr_read<o0 + 6 * st>(vbase), h3 = tr_read<o0 + 7 * st>(vbase);
        asm volatile("s_waitcnt lgkmcnt(0)" ::: "memory"); __builtin_amdgcn_sched_barrier(0);
#define PKV(L, H) (bf16x8){L[0], L[1], L[2], L[3], H[0], H[1], H[2], H[3]}
        o = __builtin_amdgcn_mfma_f32_32x32x16_bf16(PKV(l0, h0), pf[0], o, 0, 0, 0);
        o = __builtin_amdgcn_mfma_f32_32x32x16_bf16(PKV(l1, h1), pf[1], o, 0, 0, 0);
        o = __builtin_amdgcn_mfma_f32_32x32x16_bf16(PKV(l2, h2), pf[2], o, 0, 0, 0);
        o = __builtin_amdgcn_mfma_f32_32x32x16_bf16(PKV(l3, h3), pf[3], o, 0, 0, 0);
#undef PKV
    }
};
template <int NDB>
__device__ __forceinline__ void attn_tile(char* lds, int kof, int vbase, const bf16x8 (&qf)[4], f32x16 (&o)[NDB], float& m, float& l, int r32, int hi) {
    f32x16 s0 = {}, s1 = {};
#pragma unroll
    for (int ds = 0; ds < 4; ++ds) {
        const bf16x8 k0 = *(const bf16x8*)(lds + kof + swz(r32, ds * 2 + hi)), k1 = *(const bf16x8*)(lds + kof + swz(32 + r32, ds * 2 + hi));
        s0 = __builtin_amdgcn_mfma_f32_32x32x16_bf16(k0, qf[ds], s0, 0, 0, 0);
        s1 = __builtin_amdgcn_mfma_f32_32x32x16_bf16(k1, qf[ds], s1, 0, 0, 0);
    }
    float mx = s0[0];
#pragma unroll
    for (int r = 1; r < 16; ++r) mx = fmaxf(mx, s0[r]);
#pragma unroll
    for (int r = 0; r < 16; ++r) mx = fmaxf(mx, s1[r]);
    mx = half_max(mx);
    const float mn = fmaxf(m, mx), alpha = __builtin_amdgcn_exp2f(m - mn);
    m = mn;
    float ps = 0.f;
#pragma unroll
    for (int r = 0; r < 16; ++r) { s0[r] = __builtin_amdgcn_exp2f(s0[r] - mn); ps += s0[r]; }
#pragma unroll
    for (int r = 0; r < 16; ++r) { s1[r] = __builtin_amdgcn_exp2f(s1[r] - mn); ps += s1[r]; }
    ps = half_sum(ps);
    l = l * alpha + ps;
    if (!__all(alpha == 1.0f)) {
#pragma unroll
        for (int t = 0; t < NDB; ++t)
#pragma unroll
            for (int r = 0; r < 16; ++r) o[t][r] *= alpha;
    }
    bf16x8 pf[4];
#pragma unroll
    for (int s = 0; s < 2; ++s) {
        u32x4 a = {cvt_pk(s0[8 * s + 0], s0[8 * s + 1]), cvt_pk(s0[8 * s + 2], s0[8 * s + 3]), cvt_pk(s0[8 * s + 4], s0[8 * s + 5]), cvt_pk(s0[8 * s + 6], s0[8 * s + 7])};
        u32x4 b = {cvt_pk(s1[8 * s + 0], s1[8 * s + 1]), cvt_pk(s1[8 * s + 2], s1[8 * s + 3]), cvt_pk(s1[8 * s + 4], s1[8 * s + 5]), cvt_pk(s1[8 * s + 6], s1[8 * s + 7])};
        pf[s] = *(bf16x8*)&a; pf[2 + s] = *(bf16x8*)&b;
    }
    if constexpr (NDB == 4) { PvBlk<4, 0>::run(o[0], vbase, pf); PvBlk<4, 1>::run(o[1], vbase, pf); PvBlk<4, 2>::run(o[2], vbase, pf); PvBlk<4, 3>::run(o[3], vbase, pf); }
    else { PvBlk<2, 0>::run(o[0], vbase, pf); PvBlk<2, 1>::run(o[1], vbase, pf); }
}

__device__ __forceinline__ void attn_diff_unit(const Params& p, char* lds, int h, int qb, float lam) {
    const int tid = threadIdx.x, lane = tid & 63, w = tid >> 6, r32 = lane & 31, hi = lane >> 5, mp = w >> 2, wq = w & 3;
    const bf16_t* proj = (const bf16_t*)(p.ws + WS_PROJ);
    const int NT = 2 * qb + 2, myNT = (wq < 2) ? NT - 1 : NT;
    bf16x8 qf[4];
    { const bf16_t* qp = proj + (size_t)(qb * 128 + wq * 32 + r32) * INW + C_BQ + h * 128 + mp * 64 + hi * 8;
#pragma unroll
      for (int ds = 0; ds < 4; ++ds) qf[ds] = *(const bf16x8*)(qp + ds * 16); }
    f32x16 o[4] = {}; float m = -1e30f, l = 0.f;
    const bf16_t* gk0 = proj + (size_t)(tid >> 3) * INW + C_BK + h * 128 + (tid & 7) * 8;
    const bf16_t* gv0 = proj + (size_t)(tid >> 4) * INW + C_BV + h * 128 + (tid & 15) * 8;
    const int wk = swz(tid >> 3, tid & 7), wv0 = v_off(tid >> 4, (tid & 15) * 8, 4), wv1 = v_off(32 + (tid >> 4), (tid & 15) * 8, 4);
    const int vlane = ((lane & 3) << 3) | (((lane >> 2) & 3) << 6) | (((lane >> 4) & 1) << 5) | (((lane >> 5) & 1) << 8);
    u32x4 st0, st1, st2, st3;
#define D_LOAD(t) do { const size_t ko = (size_t)(t) * 64 * INW; st0 = *(const u32x4*)(gk0 + ko); st1 = *(const u32x4*)(gk0 + ko + 64); st2 = *(const u32x4*)(gv0 + ko); st3 = *(const u32x4*)(gv0 + ko + (size_t)32 * INW); } while (0)
#define D_WRITE(b) do { char* sb = lds + (b) * AT_STAGE; *(u32x4*)(sb + wk) = st0; *(u32x4*)(sb + 8192 + wk) = st1; *(u32x4*)(sb + 16384 + wv0) = st2; *(u32x4*)(sb + 16384 + wv1) = st3; } while (0)
    D_LOAD(0); D_WRITE(0); __syncthreads();
    for (int t = 0; t < NT; ++t) {
        const int b = t & 1;
        if (t + 1 < NT) D_LOAD(t + 1);
        if (t < myNT) attn_tile<4>(lds, b * AT_STAGE + mp * 8192, (int)(uintptr_t)(lds + b * AT_STAGE + 16384) + vlane, qf, o, m, l, r32, hi);
        if (t + 1 < NT) D_WRITE(b ^ 1);
        __syncthreads();
    }
#undef D_LOAD
#undef D_WRITE
    float* xb = (float*)lds;
    const float il = 1.0f / l;
    if (mp == 1) {
        const float f = il * lam;
#pragma unroll
        for (int t = 0; t < 4; ++t)
#pragma unroll
            for (int r = 0; r < 16; ++r) xb[(wq * 64 + t * 16 + r) * 64 + lane] = o[t][r] * f;
    }
    __syncthreads();
    if (mp == 0) {
        float ss = 0.f;
#pragma unroll
        for (int t = 0; t < 4; ++t)
#pragma unroll
            for (int r = 0; r < 16; ++r) { const float v = o[t][r] * il - xb[(wq * 64 + t * 16 + r) * 64 + lane]; o[t][r] = v; ss += v * v; }
        ss = half_sum(ss);
        const float rs = rsqrtf(ss * (1.0f / 128.0f) + LN_EPS) * 0.8f;
        bf16_t* op = (bf16_t*)(p.ws + WS_ATT) + (size_t)(qb * 128 + wq * 32 + r32) * D + 512 + h * 128;
#pragma unroll
        for (int t = 0; t < 4; ++t)
#pragma unroll
            for (int rr = 0; rr < 4; ++rr) {
                const int dv0 = 32 * t + 8 * rr + 4 * hi;
                const f32x4 gg = *(const f32x4*)(p.subg + dv0);
                u32x2 pk = {cvt_pk(o[t][4 * rr] * rs * gg[0], o[t][4 * rr + 1] * rs * gg[1]), cvt_pk(o[t][4 * rr + 2] * rs * gg[2], o[t][4 * rr + 3] * rs * gg[3])};
                *(u32x2*)(op + dv0) = pk;
            }
    }
    __syncthreads();
}
__device__ __forceinline__ void attn_swa_unit(const Params& p, char* lds, int kvh, int n) {
    const int tid = threadIdx.x, lane = tid & 63, w = tid >> 6, r32 = lane & 31, hi = lane >> 5, g = w >> 1, hq = kvh * 4 + g;
    const bf16_t* proj = (const bf16_t*)(p.ws + WS_PROJ);
    const int c0 = (n >= 2) ? n - 2 : 0, NT = n - c0 + 1;
    const int tok = n * 64 + (w & 1) * 32 + r32;
    bf16x8 qf[4];
    { const bf16_t* qp = proj + (size_t)tok * INW + C_AQ + hq * 64 + hi * 8;
#pragma unroll
      for (int ds = 0; ds < 4; ++ds) qf[ds] = *(const bf16x8*)(qp + ds * 16); }
    f32x16 o[2] = {}; float m = p.sinks[hq] * LOG2E, l = 1.0f;
    const bf16_t* gk = proj + (size_t)(c0 * 64 + (tid >> 3)) * INW + C_AK + kvh * 64 + (tid & 7) * 8;
    const bf16_t* gv = proj + (size_t)(c0 * 64 + (tid >> 3)) * INW + C_AV + kvh * 64 + (tid & 7) * 8;
    const int wk = swz(tid >> 3, tid & 7), wv = v_off(tid >> 3, (tid & 7) * 8, 2);
    const int vlane = ((lane & 3) << 3) | (((lane >> 2) & 3) << 6) | (((lane >> 4) & 1) << 5) | (((lane >> 5) & 1) << 8);
    u32x4 st0, st1;
#define W_LOAD(t) do { const size_t ko = (size_t)(t) * 64 * INW; st0 = *(const u32x4*)(gk + ko); st1 = *(const u32x4*)(gv + ko); } while (0)
#define W_WRITE(b) do { char* sb = lds + (b) * AT_STAGE; *(u32x4*)(sb + wk) = st0; *(u32x4*)(sb + 8192 + wv) = st1; } while (0)
    W_LOAD(0); W_WRITE(0); __syncthreads();
    for (int t = 0; t < NT; ++t) {
        const int b = t & 1;
        if (t + 1 < NT) W_LOAD(t + 1);
        attn_tile<2>(lds, b * AT_STAGE, (int)(uintptr_t)(lds + b * AT_STAGE + 8192) + vlane, qf, o, m, l, r32, hi);
        if (t + 1 < NT) W_WRITE(b ^ 1);
        __syncthreads();
    }
#undef W_LOAD
#undef W_WRITE
    const float il = 1.0f / l;
    bf16_t* op = (bf16_t*)(p.ws + WS_ATT) + (size_t)tok * D + hq * 64;
#pragma unroll
    for (int t = 0; t < 2; ++t)
#pragma unroll
        for (int rr = 0; rr < 4; ++rr) {
            const int dv0 = 32 * t + 8 * rr + 4 * hi;
            u32x2 pk = {cvt_pk(o[t][4 * rr] * il, o[t][4 * rr + 1] * il), cvt_pk(o[t][4 * rr + 2] * il, o[t][4 * rr + 3] * il)};
            *(u32x2*)(op + dv0) = pk;
        }
}
__device__ __forceinline__ void phase_attn(const Params& p, char* lds, int vb, int G) {
    const int lane = threadIdx.x & 63;
    const float d1 = wave_sum(p.lq1[lane] * p.lk1[lane]), d2 = wave_sum(p.lq2[lane] * p.lk2[lane]);
    const float lam = expf(d1) - expf(d2) + 0.2f;
    for (int u = vb; u < 1024; u += G) {
        if (u < 256) attn_diff_unit(p, lds, u >> 6, 127 - (u & 63), lam);
        else if (u < 512) attn_diff_unit(p, lds, (u - 256) >> 6, (u - 256) & 63, lam);
        else attn_swa_unit(p, lds, (u - 512) >> 8, (u - 512) & 255);
    }
}

struct EpiPreLn {
    const float* x; float* out; int row0, col0;
    __device__ __forceinline__ void operator()(f32x4 (&acc)[4][4], int wr, int wc, int fr, int fq) const {
#pragma unroll
        for (int mt = 0; mt < 4; ++mt) {
            const size_t ro = (size_t)(row0 + wr * 64 + mt * 16 + fr) * D + col0 + wc * 64 + 4 * fq;
#pragma unroll
            for (int nt = 0; nt < 4; ++nt) { const f32x4 xv = *(const f32x4*)(x + ro + nt * 16); *(f32x4*)(out + ro + nt * 16) = xv * ALPHA + acc[mt][nt]; }
        }
    }
};
__device__ __forceinline__ void phase_wout(const Params& p, char* lds, int vb, int G) {
    const int tid = threadIdx.x, lane = tid & 63, w = tid >> 6;
    const bf16_t* att = (const bf16_t*)(p.ws + WS_ATT);
    for (int u = vb; u < (S / 128) * 4; u += G) {
        const int tm = u >> 2, tn = u & 3;
        GemmArgs g;
        g.a0 = (const char*)(att + (size_t)(tm * 128 + (tid >> 3)) * D + (tid & 7) * 8);
        g.a1 = (const char*)(att + (size_t)(tm * 128 + 64 + (tid >> 3)) * D + (tid & 7) * 8);
        g.b = p.w_out + (size_t)(w * 8) * D + tn * 256 + 4 * lane; g.ldb = D; g.nk = D / 64;
        EpiPreLn e{p.x, (float*)(p.ws + WS_PRELN), tm * 128, tn * 256};
        gemm_tile<0>(lds, g, e);
    }
}

struct EpiLogits {
    float* L;
    __device__ __forceinline__ void operator()(f32x4 (&acc)[4][4], int wr, int wc, int fr, int fq) const {
#pragma unroll
        for (int mt = 0; mt < 4; ++mt)
#pragma unroll
            for (int nt = 0; nt < 4; ++nt) *(f32x4*)(L + (wr * 64 + mt * 16 + fr) * 256 + wc * 64 + nt * 16 + 4 * fq) = acc[mt][nt];
    }
};
__device__ __forceinline__ void phase_router(const Params& p, char* lds, int vb, int G, int alt = 0) {
    const int tid = threadIdx.x, lane = tid & 63, w = tid >> 6;
    const float* preln = (const float*)(p.ws + WS_PRELN);
    float* x1f = (float*)(p.ws + WS_X1F); bf16_t* x1b = (bf16_t*)(p.ws + WS_X1B);
    unsigned* cnt = (unsigned*)(p.ws + WS_CTL) + (alt ? 1024 : 0); int* list = (int*)(p.ws + (alt ? WS_Y : WS_LIST)); float* gates = (float*)(p.ws + (alt ? WS_Y + 32 * MiB : WS_GATE));
    for (int u = vb; u < S / 128; u += G) {
        for (int i = 0; i < 16; ++i) {
            const int row = u * 128 + w * 16 + i;
            const f32x4* xr = (const f32x4*)(preln + (size_t)row * D) + lane;
            f32x4 v[4]; float s = 0.f;
#pragma unroll
            for (int j = 0; j < 4; ++j) { v[j] = xr[64 * j]; s += (v[j][0] + v[j][1]) + (v[j][2] + v[j][3]); }
            const float mean = wave_sum(s) * (1.0f / D); float s2 = 0.f;
#pragma unroll
            for (int j = 0; j < 4; ++j) { v[j] = v[j] - mean; s2 += (v[j][0] * v[j][0] + v[j][1] * v[j][1]) + (v[j][2] * v[j][2] + v[j][3] * v[j][3]); }
            const float rstd = rsqrtf(wave_sum(s2) * (1.0f / D) + LN_EPS);
#pragma unroll
            for (int j = 0; j < 4; ++j) {
                const f32x4 gg = *((const f32x4*)p.ln1g + lane + 64 * j), bb = *((const f32x4*)p.ln1b + lane + 64 * j);
                const f32x4 y = v[j] * rstd * gg + bb;
                *((f32x4*)(x1f + (size_t)row * D) + lane + 64 * j) = y;
                u32x2 pk = {cvt_pk(y[0], y[1]), cvt_pk(y[2], y[3])};
                *((u32x2*)(x1b + (size_t)row * D) + lane + 64 * j) = pk;
            }
        }
        asm volatile("s_waitcnt vmcnt(0)" ::: "memory");
        __syncthreads();
        GemmArgs g;
        g.a0 = (const char*)(x1b + (size_t)(u * 128 + (tid >> 3)) * D + (tid & 7) * 8);
        g.a1 = (const char*)(x1b + (size_t)(u * 128 + 64 + (tid >> 3)) * D + (tid & 7) * 8);
        g.b = p.w_r + (size_t)(w * 8) * NE + 4 * lane; g.ldb = NE; g.nk = D / 64;
        EpiLogits e{(float*)lds};
        gemm_tile<0>(lds, g, e);
        __syncthreads();
        const f32x4 rb = *((const f32x4*)p.r_bias + lane);
        const float NEG = -__builtin_inff();
        for (int i = 0; i < 16; ++i) {
            const int tl = w * 16 + i, t = u * 128 + tl;
            const f32x4 lg = *((const f32x4*)((const float*)lds + tl * 256) + lane);
            float sc[4], cand[4];
#pragma unroll
            for (int j = 0; j < 4; ++j) { sc[j] = 1.0f / (1.0f + expf(-lg[j])); cand[j] = sc[j] + rb[j]; }
            float a1, a2;
            { const float m01 = fmaxf(cand[0], cand[1]), n01 = fminf(cand[0], cand[1]), m23 = fmaxf(cand[2], cand[3]), n23 = fminf(cand[2], cand[3]);
              a1 = fmaxf(m01, m23); a2 = fmaxf(fminf(m01, m23), fmaxf(n01, n23)); }
#pragma unroll
            for (int off = 1; off < 8; off <<= 1) { const float b1 = __shfl_xor(a1, off), b2 = __shfl_xor(a2, off); const float n1 = fmaxf(a1, b1), n2 = fmaxf(fminf(a1, b1), fmaxf(a2, b2)); a1 = n1; a2 = n2; }
            const float gs = a1 + a2; const int mygrp = lane >> 3; int rank = 0;
#pragma unroll
            for (int g2 = 0; g2 < 8; ++g2) { const float v = __shfl(gs, g2 * 8); rank += (v > gs || (v == gs && g2 < mygrp)) ? 1 : 0; }
            if (rank >= 4) {
#pragma unroll
                for (int j = 0; j < 4; ++j) cand[j] = NEG;
            }
            int my_e = 0; float my_s = 0.f, gsum = 0.f;
#pragma unroll
            for (int k = 0; k < 8; ++k) {
                float bv = cand[0]; int bi = 0;
#pragma unroll
                for (int j = 1; j < 4; ++j) if (cand[j] > bv) { bv = cand[j]; bi = j; }
                int idx = 4 * lane + bi;
#pragma unroll
                for (int off = 32; off >= 1; off >>= 1) { const float ov = __shfl_xor(bv, off); const int oi = __shfl_xor(idx, off); if (ov > bv || (ov == bv && oi < idx)) { bv = ov; idx = oi; } }
                const int owner = idx >> 2, sub = idx & 3;
                float scv = sc[0];
#pragma unroll
                for (int j = 1; j < 4; ++j) scv = (sub == j) ? sc[j] : scv;
                if (lane == owner) {
#pragma unroll
                    for (int j = 0; j < 4; ++j) if (sub == j) cand[j] = NEG;
                }
                const float gsc = __shfl(scv, owner);
                if (lane == k) { my_e = idx; my_s = gsc; }
                gsum += gsc;
            }
            if (lane < 8) {
                const float gate = my_s / gsum * 2.5f;
                const unsigned pos = atomicAdd(cnt + my_e, 1u);
                list[(size_t)my_e * CAP + pos] = t * 8 + lane;
                gates[t * 8 + lane] = gate;
            }
        }
        __syncthreads();
    }
}

struct EpiAct {
    bf16_t* act; const int* slots; int ncol0;
    __device__ __forceinline__ void operator()(f32x4 (&acc)[4][4], int wr, int wc, int fr, int fq) const {
#pragma unroll
        for (int mt = 0; mt < 4; ++mt) {
            const int ar = slots[wr * 64 + mt * 16 + fr];
            if (ar >= 0) {
#pragma unroll
                for (int nt = 0; nt < 2; ++nt) {
                    const f32x4 gv = acc[mt][nt], uv = acc[mt][nt + 2]; float a[4];
#pragma unroll
                    for (int j = 0; j < 4; ++j) a[j] = gv[j] / (1.0f + __expf(-gv[j])) * uv[j];
                    u32x2 pk = {cvt_pk(a[0], a[1]), cvt_pk(a[2], a[3])};
                    *(u32x2*)(act + (size_t)ar * FF + ncol0 + wc * 32 + nt * 16 + 4 * fq) = pk;
                }
            }
        }
    }
};
struct EpiY {
    bf16_t* y; const int* yrows; const float* gl; int col0;
    __device__ __forceinline__ void operator()(f32x4 (&acc)[4][4], int wr, int wc, int fr, int fq) const {
#pragma unroll
        for (int mt = 0; mt < 4; ++mt) {
            const int r = wr * 64 + mt * 16 + fr, yr = yrows[r];
            if (yr >= 0) {
                const float gt = gl[r];
#pragma unroll
                for (int nt = 0; nt < 4; ++nt) {
                    const f32x4 v = acc[mt][nt] * gt;
                    u32x2 pk = {cvt_pk(v[0], v[1]), cvt_pk(v[2], v[3])};
                    *(u32x2*)(y + (size_t)yr * D + col0 + wc * 64 + nt * 16 + 4 * fq) = pk;
                }
            }
        }
    }
};
__device__ __forceinline__ void phase_experts(const Params& p, char* lds, int vb, int G) {
    const int tid = threadIdx.x, lane = tid & 63, w = tid >> 6;
    const bf16_t* x1b = (const bf16_t*)(p.ws + WS_X1B);
    const unsigned* cnt = (const unsigned*)(p.ws + WS_CTL); const int* list = (const int*)(p.ws + WS_LIST); const float* gates = (const float*)(p.ws + WS_GATE);
    bf16_t* act = (bf16_t*)(p.ws + WS_ACT); bf16_t* ybuf = (bf16_t*)(p.ws + WS_Y);
    int* nts = (int*)(lds + LDS_MISC); int* pre = nts + 256;
    int* s_arow = pre + 260; int* s_yrow = s_arow + 128; int* s_tok = s_yrow + 128; float* s_gate = (float*)(s_tok + 128);
    if (tid < 256) nts[tid] = (int)((__hip_atomic_load(cnt + tid, __ATOMIC_RELAXED, __HIP_MEMORY_SCOPE_AGENT) + 127u) >> 7);
    __syncthreads();
    if (tid < 257) { int s = 0; for (int e = 0; e < tid; ++e) s += nts[e]; pre[tid] = s; }
    __syncthreads();
    const int NR = pre[256], NU = NR + S / 128;
    for (int u = vb; u < NU; u += G) {
        __syncthreads();
        const float *wg, *wu, *wd;
        if (u < NR) {
            int lo = 0, hi = 255;
            while (lo < hi) { const int mid = (lo + hi + 1) >> 1; if (pre[mid] <= u) lo = mid; else hi = mid - 1; }
            const int e = lo, tile = u - pre[e], n = (int)__hip_atomic_load(cnt + e, __ATOMIC_RELAXED, __HIP_MEMORY_SCOPE_AGENT);
            if (tid < 128) {
                const int idx = tile * 128 + tid;
                if (idx < n) { const int slot = list[(size_t)e * CAP + idx]; s_arow[tid] = slot; s_yrow[tid] = slot + (slot >> 3); s_tok[tid] = slot >> 3; s_gate[tid] = gates[slot]; }
                else { s_arow[tid] = -1; s_yrow[tid] = -1; s_tok[tid] = 0; s_gate[tid] = 0.f; }
            }
            wg = p.w_g + (size_t)e * D * FF; wu = p.w_u + (size_t)e * D * FF; wd = p.w_d + (size_t)e * FF * D;
        } else {
            const int tile = u - NR;
            if (tid < 128) { const int tk = tile * 128 + tid; s_arow[tid] = S * 8 + tk; s_yrow[tid] = tk * 9 + 8; s_tok[tid] = tk; s_gate[tid] = 1.0f; }
            wg = p.ws_g; wu = p.ws_u; wd = p.ws_d;
        }
        __syncthreads();
        const int r0 = tid >> 3, r1 = 64 + (tid >> 3);
        for (int np = 0; np < 2; ++np) {
            GemmArgs g;
            g.a0 = (const char*)(x1b + (size_t)s_tok[r0] * D + (tid & 7) * 8);
            g.a1 = (const char*)(x1b + (size_t)s_tok[r1] * D + (tid & 7) * 8);
            const int n0 = 4 * lane, bwc = n0 >> 6, sub = n0 & 63;
            const float* bsrc = (sub < 32) ? (wg + np * 128 + bwc * 32 + sub) : (wu + np * 128 + bwc * 32 + (sub - 32));
            g.b = bsrc + (size_t)(w * 8) * FF; g.ldb = FF; g.nk = D / 64;
            EpiAct e{act, s_arow, np * 128};
            gemm_tile<0>(lds, g, e);
        }
        asm volatile("s_waitcnt vmcnt(0)" ::: "memory");
        __syncthreads();
        const int ar0 = s_arow[r0] < 0 ? 0 : s_arow[r0], ar1 = s_arow[r1] < 0 ? 0 : s_arow[r1];
        for (int np = 0; np < 4; ++np) {
            GemmArgs g;
            g.a0 = (const char*)(act + (size_t)ar0 * FF + (tid & 7) * 8);
            g.a1 = (const char*)(act + (size_t)ar1 * FF + (tid & 7) * 8);
            g.b = wd + (size_t)(w * 8) * D + np * 256 + 4 * lane; g.ldb = D; g.nk = FF / 64;
            EpiY e{ybuf, s_yrow, s_gate, np * 256};
            gemm_tile<0>(lds, g, e);
        }
    }
}

__device__ __forceinline__ void phase_final(const Params& p, int vb, int G) {
    const int lane = threadIdx.x & 63, w = threadIdx.x >> 6;
    const float* x1f = (const float*)(p.ws + WS_X1F); const bf16_t* ybuf = (const bf16_t*)(p.ws + WS_Y);
    for (int row = vb * 8 + w; row < S; row += G * 8) {
        f32x4 v[4]; float s = 0.f;
#pragma unroll
        for (int j = 0; j < 4; ++j) v[j] = *((const f32x4*)(x1f + (size_t)row * D) + lane + 64 * j) * ALPHA;
#pragma unroll
        for (int k = 0; k < 9; ++k) {
            const u32x2* yr = (const u32x2*)(ybuf + (size_t)(row * 9 + k) * D) + lane;
#pragma unroll
            for (int j = 0; j < 4; ++j) { const u32x2 q = yr[64 * j]; v[j][0] += bf_lo(q[0]); v[j][1] += bf_hi(q[0]); v[j][2] += bf_lo(q[1]); v[j][3] += bf_hi(q[1]); }
        }
#pragma unroll
        for (int j = 0; j < 4; ++j) s += (v[j][0] + v[j][1]) + (v[j][2] + v[j][3]);
        const float mean = wave_sum(s) * (1.0f / D); float s2 = 0.f;
#pragma unroll
        for (int j = 0; j < 4; ++j) { v[j] = v[j] - mean; s2 += (v[j][0] * v[j][0] + v[j][1] * v[j][1]) + (v[j][2] * v[j][2] + v[j][3] * v[j][3]); }
        const float rstd = rsqrtf(wave_sum(s2) * (1.0f / D) + LN_EPS);
#pragma unroll
        for (int j = 0; j < 4; ++j) {
            const f32x4 gg = *((const f32x4*)p.ln2g + lane + 64 * j), bb = *((const f32x4*)p.ln2b + lane + 64 * j);
            *((f32x4*)(p.out + (size_t)row * D) + lane + 64 * j) = v[j] * rstd * gg + bb;
        }
    }
}

__global__ void __launch_bounds__(NTHREADS) mega(Params p) {
    extern __shared__ __attribute__((aligned(16))) char lds[];
    const int G = gridDim.x, bx = blockIdx.x;
    const int vb = (G % 8 == 0) ? (bx % 8) * (G / 8) + bx / 8 : bx;
    if (threadIdx.x < 4) ((volatile LAS unsigned*)((LAS char*)lds + LDS_BARST))[threadIdx.x] = 0u;
    __syncthreads();
    XcdBarrier bar; bar.bar = (unsigned*)(p.ws + WS_CTL) + CW_BAR; bar.x = 0; bar.st = nullptr;
    if (p.ph_hi - p.ph_lo > 1) bar = xcd_barrier_post((unsigned*)(p.ws + WS_CTL) + CW_BAR, (volatile LAS unsigned*)((LAS char*)lds + LDS_BARST));
#define SEAM(k) do { if (p.ph_lo <= (k) && (k) + 1 < p.ph_hi) { xcd_barrier(bar); } } while (0)
#define IN(k) (p.ph_lo <= (k) && (k) < p.ph_hi)
    if (IN(0)) { phase_rope(p, vb, G); if (MK_REPEAT == 0) { __syncthreads(); phase_rope(p, vb, G); } } SEAM(0);
    if (IN(1)) { phase_proj(p, lds, vb, G); if (MK_REPEAT == 1) { __syncthreads(); phase_proj(p, lds, vb, G); } } SEAM(1);
    if (IN(2)) { phase_attn(p, lds, vb, G); if (MK_REPEAT == 2) { __syncthreads(); phase_attn(p, lds, vb, G); } } SEAM(2);
    if (IN(3)) { phase_wout(p, lds, vb, G); if (MK_REPEAT == 3) { __syncthreads(); phase_wout(p, lds, vb, G); } } SEAM(3);
    if (IN(4)) { phase_router(p, lds, vb, G); if (MK_REPEAT == 4) { __syncthreads(); phase_router(p, lds, vb, G, 1); } if (MK_REPEAT == 7) { for (int i = 0; i < 10; ++i) xcd_barrier(bar); } } SEAM(4);
    if (IN(5)) { phase_experts(p, lds, vb, G); if (MK_REPEAT == 5) { __syncthreads(); phase_experts(p, lds, vb, G); } } SEAM(5);
    if (IN(6)) { phase_final(p, vb, G); if (MK_REPEAT == 6) { __syncthreads(); phase_final(p, vb, G); } }
#undef SEAM
#undef IN
}

extern "C" void kernel_launch(void* const* d_in, const int* in_sizes, int n_in, void* d_out, int out_size, void* d_ws, size_t ws_size, hipStream_t stream) {
    static int grid = 0;
    if (grid == 0) {
        if (n_in != 22 || in_sizes[0] != S * D || out_size != S * D || ws_size < WS_END) {
            fprintf(stderr, "kernel_launch: unexpected shapes: n_in %d in0 %d out %d ws %zu (need %zu)\n", n_in, n_in > 0 ? in_sizes[0] : -1, out_size, ws_size, (size_t)WS_END); grid = -1; return; }
        int dev = 0, cus = 0, per_cu = 0;
        hipGetDevice(&dev); hipDeviceGetAttribute(&cus, hipDeviceAttributeMultiprocessorCount, dev);
        if (hipFuncSetAttribute((const void*)mega, hipFuncAttributeMaxDynamicSharedMemorySize, LDS_BYTES) != hipSuccess) { fprintf(stderr, "kernel_launch: hipFuncSetAttribute failed\n"); grid = -1; return; }
        hipOccupancyMaxActiveBlocksPerMultiprocessor(&per_cu, (const void*)mega, NTHREADS, LDS_BYTES);
        if (per_cu < 1) { fprintf(stderr, "kernel_launch: occupancy query says %d blocks per CU\n", per_cu); per_cu = 1; }
        grid = cus * 1;
        (void)hipGetLastError();
    }
    if (grid < 0) return;
    hipMemsetAsync((char*)d_ws + WS_CTL, 0, CTL_BYTES, stream);
    Params p{};
    const float** f = (const float**)&p;
    for (int i = 0; i < 22; ++i) f[i] = (const float*)d_in[i];
    p.out = (float*)d_out; p.ws = (unsigned char*)d_ws;
#if MK_ONE_LAUNCH
    p.ph_lo = 0; p.ph_hi = 7;
    void* args[] = {&p};
    hipError_t e = hipLaunchCooperativeKernel((const void*)mega, dim3(grid), dim3(NTHREADS), args, LDS_BYTES, stream);
    if (e != hipSuccess) fprintf(stderr, "kernel_launch: cooperative launch failed: %s (grid %d)\n", hipGetErrorString(e), grid);
#else
    for (int ph = 0; ph < 7; ++ph) {
        p.ph_lo = ph; p.ph_hi = ph + 1;
        hipLaunchKernelGGL(mega, dim3(grid), dim3(NTHREADS), LDS_BYTES, stream, p);
    }
#endif
}
```

```cpp
#include <hip/hip_runtime.h>
#include <hip/hip_cooperative_groups.h>
#include <cstdio>
#include <cstdint>
namespace cg = cooperative_groups;

#ifndef MK_REPEAT
#define MK_REPEAT -1
#endif
#ifndef MK_ONE_LAUNCH
#define MK_ONE_LAUNCH 1
#endif

constexpr int S = 16384, D = 1024, INW = 2304, NE = 256, FF = 256;
constexpr int NTHREADS = 512;
constexpr int CAP = 16384;
constexpr float ALPHA = 1.189207115002721f;
constexpr float LN_EPS = 1e-5f;
constexpr float QSCALE = 0.125f * 1.4426950408889634f;
constexpr float LOG2E = 1.4426950408889634f;
constexpr int C_AQ = 0, C_AK = 512, C_AV = 640, C_BQ = 768, C_BK = 1280, C_BV = 1792;

constexpr size_t MiB = 1ull << 20;
constexpr size_t WS_CTL = 0;
constexpr size_t CTL_BYTES = 64 * 1024;
constexpr size_t WS_ROPE = 1 * MiB;
constexpr size_t WS_PROJ = 8 * MiB;
constexpr size_t WS_ATT = 80 * MiB;
constexpr size_t WS_PRELN = 112 * MiB;
constexpr size_t WS_X1F = 176 * MiB;
constexpr size_t WS_X1B = 240 * MiB;
constexpr size_t WS_LIST = 272 * MiB;
constexpr size_t WS_GATE = 288 * MiB;
constexpr size_t WS_ACT = 290 * MiB;
constexpr size_t WS_Y = 368 * MiB;
constexpr size_t WS_END = 660 * MiB;

constexpr int LDS_BYTES = 147456;
constexpr int LDS_MISC = 131072;

typedef unsigned short bf16_t;
typedef short bf16x8 __attribute__((ext_vector_type(8)));
typedef short s16x4 __attribute__((ext_vector_type(4)));
typedef float f32x4 __attribute__((ext_vector_type(4)));
typedef float f32x16 __attribute__((ext_vector_type(16)));
typedef unsigned u32x4 __attribute__((ext_vector_type(4)));
typedef unsigned u32x2 __attribute__((ext_vector_type(2)));


#define LAS __attribute__((address_space(3)))
#define XB_TMO      128
#define XB_XCNT(j)  (256  + 64 * (j))
#define XB_XSUB(j)  (1280 + 64 * (j))
#define XB_XGEN(j)  (2304 + 64 * (j))
#define XB_TOP      3328
#define XB_TOPGEN   3392
#define XCD_BAR_WORDS 3456
#define XB_SPIN_CAP (1u << 18)
__device__ __forceinline__ unsigned xb_ld(unsigned* p)              { return __hip_atomic_load(p, __ATOMIC_RELAXED, __HIP_MEMORY_SCOPE_AGENT); }
__device__ __forceinline__ unsigned xb_add(unsigned* p, unsigned v) { return __hip_atomic_fetch_add(p, v, __ATOMIC_RELAXED, __HIP_MEMORY_SCOPE_AGENT); }
__device__ __forceinline__ unsigned xb_xcc_id() { return (unsigned)__builtin_amdgcn_s_getreg((3 << 11) | 20) & 0xFu; }
#define XB_SPIN(cond, bar) do { unsigned _sp = 0; while (cond) { __builtin_amdgcn_s_sleep(1); \
    if ((++_sp & 255u) == 0u) { if (xb_ld(&(bar)[XB_TMO])) break; if (_sp > XB_SPIN_CAP) { atomicAdd(&(bar)[XB_TMO], 1u); break; } } } } while (0)
struct XcdBarrier { unsigned* bar; unsigned x; volatile LAS unsigned* st; };
__device__ __forceinline__ XcdBarrier xcd_barrier_post(unsigned* bar, volatile LAS unsigned* st) {
    XcdBarrier b; b.bar = bar; b.x = xb_xcc_id(); b.st = st;
    if (threadIdx.x == 0) (void)xb_add(&bar[XB_XCNT(b.x)], 1u);
    return b;
}
__device__ __forceinline__ void xcd_barrier_complete(unsigned* bar, unsigned x, unsigned& nloc, unsigned& nx) {
    const unsigned G = gridDim.x * gridDim.y * gridDim.z;
    unsigned sum, cnt, mine, sp = 0u;
    for (;;) {
        sum = 0u; cnt = 0u; mine = 0u;
#pragma unroll
        for (unsigned j = 0; j < 16; ++j) { const unsigned c = xb_ld(&bar[XB_XCNT(j)]); sum += c; cnt += (c > 0u) ? 1u : 0u; mine = (j == x) ? c : mine; }
        if (sum == G) break;
        __builtin_amdgcn_s_sleep(1);
        if ((++sp & 255u) == 0u) { if (xb_ld(&bar[XB_TMO])) break; if (sp > XB_SPIN_CAP) { atomicAdd(&bar[XB_TMO], 1u); break; } }
    }
    nloc = mine > 0u ? mine : 1u; nx = cnt > 0u ? cnt : 1u;
}
__device__ __forceinline__ void xcd_barrier(const XcdBarrier& b) {
    asm volatile("s_waitcnt vmcnt(0)" ::: "memory");
    __syncthreads();
    if (threadIdx.x == 0) {
        unsigned* bar = b.bar;
        __builtin_amdgcn_s_waitcnt(0);
        unsigned nloc = b.st[0], nx = b.st[1];
        if (nloc == 0u) { xcd_barrier_complete(bar, b.x, nloc, nx); b.st[0] = nloc; b.st[1] = nx; }
        const unsigned old = xb_add(&bar[XB_XSUB(b.x)], 1u);
        const unsigned gen = old / nloc;
        if (old + 1u == (gen + 1u) * nloc) {
            __builtin_amdgcn_fence(__ATOMIC_RELEASE, "agent");
            asm volatile("s_waitcnt vmcnt(0)" ::: "memory");
            const unsigned og = xb_add(&bar[XB_TOP], 1u);
            const unsigned tg = og / nx;
            if (og + 1u == (tg + 1u) * nx) xb_add(&bar[XB_TOPGEN], 1u);
            else XB_SPIN(xb_ld(&bar[XB_TOPGEN]) == tg, bar);
            __builtin_amdgcn_fence(__ATOMIC_ACQUIRE, "agent");
            xb_add(&bar[XB_XGEN(b.x)], 1u);
            asm volatile("s_waitcnt vmcnt(0)" ::: "memory");
        } else {
            XB_SPIN(xb_ld(&bar[XB_XGEN(b.x)]) == gen, bar);
            __builtin_amdgcn_fence(__ATOMIC_ACQUIRE, "agent");
            asm volatile("s_waitcnt vmcnt(0)" ::: "memory");
        }
    }
    __syncthreads();
}
constexpr int CW_BAR = 4096;
constexpr int LDS_BARST = LDS_MISC + 8192;

struct Params {
    const float* x; const float* w_in; const float* b_in; const float* sinks;
    const float* lq1; const float* lk1; const float* lq2; const float* lk2; const float* subg;
    const float* w_out; const float* ln1g; const float* ln1b; const float* w_r; const float* r_bias;
    const float* w_g; const float* w_u; const float* w_d; const float* ws_g; const float* ws_u; const float* ws_d;
    const float* ln2g; const float* ln2b;
    float* out; unsigned char* ws;
    int ph_lo, ph_hi;
};

__device__ __forceinline__ unsigned cvt_pk(float lo, float hi) { unsigned r; asm volatile("v_cvt_pk_bf16_f32 %0, %1, %2" : "=v"(r) : "v"(lo), "v"(hi)); return r; }
__device__ __forceinline__ float bf_lo(unsigned u) { return __uint_as_float(u << 16); }
__device__ __forceinline__ float bf_hi(unsigned u) { return __uint_as_float(u & 0xffff0000u); }
__device__ __forceinline__ float wave_sum(float v) {
#pragma unroll
    for (int o = 1; o < 64; o <<= 1) v += __shfl_xor(v, o);
    return v;
}
__device__ __forceinline__ float half_max(float v) { auto rr = __builtin_amdgcn_permlane32_swap(__float_as_uint(v), __float_as_uint(v), false, false); return fmaxf(__uint_as_float(rr[0]), __uint_as_float(rr[1])); }
__device__ __forceinline__ float half_sum(float v) { auto rr = __builtin_amdgcn_permlane32_swap(__float_as_uint(v), __float_as_uint(v), false, false); return __uint_as_float(rr[0]) + __uint_as_float(rr[1]); }

__device__ __forceinline__ int swz(int r, int c) { const int f = (r & 7) ^ (((r >> 3) & 1) << 1) ^ ((r >> 4) & 1); return r * 128 + ((c ^ f) << 4); }

constexpr int G_A0 = 0, G_A1 = 16384, G_B0 = 32768, G_B1 = 65536;
struct GemmArgs {
    const char* a0; const char* a1;
    const float* b;
    int ldb; int nk;
};
template <int AF32, class Epi>
__device__ __forceinline__ void gemm_tile(char* lds, const GemmArgs g, const Epi& epi) {
    const int tid = threadIdx.x, lane = tid & 63, w = tid >> 6, wr = w >> 2, wc = w & 3, fr = lane & 15, fq = lane >> 4;
    f32x4 acc[4][4];
#pragma unroll
    for (int i = 0; i < 4; ++i)
#pragma unroll
        for (int j = 0; j < 4; ++j) acc[i][j] = (f32x4){0.f, 0.f, 0.f, 0.f};
    const int aw0 = swz(tid >> 3, tid & 7), aw1 = swz(64 + (tid >> 3), tid & 7);
    int bw[4];
#pragma unroll
    for (int j = 0; j < 4; ++j) bw[j] = swz(4 * lane + j, w);
    u32x4 ar0, ar1; f32x4 af0a, af0b, af1a, af1b; f32x4 br[8];
    const char* pa0 = g.a0; const char* pa1 = g.a1; const float* pb = g.b;
#define G_LOAD() do { \
        if (AF32) { af0a = *(const f32x4*)pa0; af0b = *(const f32x4*)(pa0 + 16); af1a = *(const f32x4*)pa1; af1b = *(const f32x4*)(pa1 + 16); pa0 += 256; pa1 += 256; } \
        else { ar0 = *(const u32x4*)pa0; ar1 = *(const u32x4*)pa1; pa0 += 128; pa1 += 128; } \
        _Pragma("unroll") for (int i = 0; i < 8; ++i) br[i] = *(const f32x4*)(pb + (size_t)i * g.ldb); \
        pb += (size_t)64 * g.ldb; } while (0)
#define G_WRITE(AOFF, BOFF) do { \
        if (AF32) { ar0 = (u32x4){cvt_pk(af0a[0], af0a[1]), cvt_pk(af0a[2], af0a[3]), cvt_pk(af0b[0], af0b[1]), cvt_pk(af0b[2], af0b[3])}; \
                    ar1 = (u32x4){cvt_pk(af1a[0], af1a[1]), cvt_pk(af1a[2], af1a[3]), cvt_pk(af1b[0], af1b[1]), cvt_pk(af1b[2], af1b[3])}; } \
        *(u32x4*)(lds + (AOFF) + aw0) = ar0; *(u32x4*)(lds + (AOFF) + aw1) = ar1; \
        _Pragma("unroll") for (int j = 0; j < 4; ++j) { \
            u32x4 v = {cvt_pk(br[0][j], br[1][j]), cvt_pk(br[2][j], br[3][j]), cvt_pk(br[4][j], br[5][j]), cvt_pk(br[6][j], br[7][j])}; \
            *(u32x4*)(lds + (BOFF) + bw[j]) = v; } } while (0)
    G_LOAD(); G_WRITE(G_A0, G_B0); __syncthreads();
    for (int kt = 0; kt < g.nk; ++kt) {
        const int aoff = (kt & 1) ? G_A1 : G_A0, boff = (kt & 1) ? G_B1 : G_B0;
        const bool more = (kt + 1 < g.nk);
        if (more) G_LOAD();
#pragma unroll
        for (int ks = 0; ks < 2; ++ks) {
            bf16x8 af[4], bfr[4];
#pragma unroll
            for (int mt = 0; mt < 4; ++mt) af[mt] = *(const bf16x8*)(lds + aoff + swz(wr * 64 + mt * 16 + fr, ks * 4 + fq));
#pragma unroll
            for (int nt = 0; nt < 4; ++nt) bfr[nt] = *(const bf16x8*)(lds + boff + swz(wc * 64 + nt * 16 + fr, ks * 4 + fq));
#pragma unroll
            for (int mt = 0; mt < 4; ++mt)
#pragma unroll
                for (int nt = 0; nt < 4; ++nt) acc[mt][nt] = __builtin_amdgcn_mfma_f32_16x16x32_bf16(bfr[nt], af[mt], acc[mt][nt], 0, 0, 0);
        }
        if (more) { if (kt & 1) G_WRITE(G_A0, G_B0); else G_WRITE(G_A1, G_B1); }
        __syncthreads();
    }
#undef G_LOAD
#undef G_WRITE
    epi(acc, wr, wc, fr, fq);
}

__device__ __forceinline__ void phase_rope(const Params& p, int vb, int G) {
    float* cs = (float*)(p.ws + WS_ROPE); float* sn = cs + (size_t)S * 32;
    for (int idx = vb * NTHREADS + threadIdx.x; idx < S * 32; idx += G * NTHREADS) {
        const int pos = idx >> 5, i = idx & 31;
        const float pw = (float)pow(10000.0, (double)i / 32.0);
        const float inv = 1.0f / pw;
        const float angf = __fmul_rn((float)pos, inv);
        const double a = (double)angf;
        const double q = rint(a * 0.63661977236758134308);
        double r = fma(-q, 1.57079632679489655800, a); r = fma(-q, 6.12323399573676603587e-17, r);
        const double r2 = r * r;
        double sp = r * (1.0 + r2 * (-1.0 / 6 + r2 * (1.0 / 120 + r2 * (-1.0 / 5040 + r2 * (1.0 / 362880 + r2 * (-1.0 / 39916800))))));
        double cp = 1.0 + r2 * (-0.5 + r2 * (1.0 / 24 + r2 * (-1.0 / 720 + r2 * (1.0 / 40320 + r2 * (-1.0 / 3628800 + r2 * (1.0 / 479001600))))));
        const int qi = ((int)((long long)q)) & 3;
        double sv, cv;
        if (qi == 0) { sv = sp; cv = cp; } else if (qi == 1) { sv = cp; cv = -sp; } else if (qi == 2) { sv = -sp; cv = -cp; } else { sv = -cp; cv = sp; }
        cs[idx] = (float)cv; sn[idx] = (float)sv;
    }
}

struct EpiProj {
    const float* bias; const float* cs; const float* sn; bf16_t* out; int row0, col0;
    __device__ __forceinline__ void operator()(f32x4 (&acc)[4][4], int wr, int wc, int fr, int fq) const {
        const int hb = col0 + wc * 64;
        const bool is_q = (hb < C_AK) || (hb >= C_BQ && hb < C_BK);
        const bool is_rope = is_q || (hb >= C_AK && hb < C_AV) || (hb >= C_BK && hb < C_BV);
        const float sc = is_q ? QSCALE : 1.0f;
#pragma unroll
        for (int mt = 0; mt < 4; ++mt) {
            const int row = row0 + wr * 64 + mt * 16 + fr;
            f32x4 v[4];
#pragma unroll
            for (int nt = 0; nt < 4; ++nt) v[nt] = acc[mt][nt] + *(const f32x4*)(bias + hb + nt * 16 + 4 * fq);
            if (is_rope) {
#pragma unroll
                for (int nt = 0; nt < 2; ++nt) {
                    const f32x4 c = *(const f32x4*)(cs + (size_t)row * 32 + nt * 16 + 4 * fq), s = *(const f32x4*)(sn + (size_t)row * 32 + nt * 16 + 4 * fq);
                    const f32x4 t1 = v[nt], t2 = v[nt + 2];
                    v[nt] = t1 * c - t2 * s; v[nt + 2] = t2 * c + t1 * s;
                }
            }
#pragma unroll
            for (int nt = 0; nt < 4; ++nt) {
                const f32x4 o = v[nt] * sc;
                u32x2 pk = {cvt_pk(o[0], o[1]), cvt_pk(o[2], o[3])};
                *(u32x2*)(out + (size_t)row * INW + hb + nt * 16 + 4 * fq) = pk;
            }
        }
    }
};
__device__ __forceinline__ void phase_proj(const Params& p, char* lds, int vb, int G) {
    const int tid = threadIdx.x, lane = tid & 63, w = tid >> 6;
    constexpr int NTN = INW / 256, NU = (S / 128) * NTN;
    const float* cs = (const float*)(p.ws + WS_ROPE); const float* sn = cs + (size_t)S * 32;
    for (int u = vb; u < NU; u += G) {
        const int tm = u / NTN, tn = u % NTN;
        GemmArgs g;
        g.a0 = (const char*)(p.x + (size_t)(tm * 128 + (tid >> 3)) * D + (tid & 7) * 8);
        g.a1 = (const char*)(p.x + (size_t)(tm * 128 + 64 + (tid >> 3)) * D + (tid & 7) * 8);
        g.b = p.w_in + (size_t)(w * 8) * INW + tn * 256 + 4 * lane; g.ldb = INW; g.nk = D / 64;
        EpiProj e{p.b_in, cs, sn, (bf16_t*)(p.ws + WS_PROJ), tm * 128, tn * 256};
        gemm_tile<1>(lds, g, e);
    }
}

template <int OFF> __device__ __forceinline__ s16x4 tr_read(int vb) { s16x4 r; asm volatile("ds_read_b64_tr_b16 %0, %1 offset:%2" : "=&v"(r) : "v"(vb), "i"(OFF) : "memory"); return r; }
__device__ __forceinline__ int v_off(int k, int c, int ndb) { return ((k >> 3) * ndb + (c >> 5)) * 512 + ((k & 7) * 32 + (c & 31)) * 2; }

constexpr int AT_STAGE = 32768;
template <int NDB, int KB, int T> struct PvPart {
    static __device__ __forceinline__ void run(f32x16& o, int vbase, const bf16x8& pa, const bf16x8& pb) {
        constexpr int o0 = (KB * 4 * NDB + T) * 512, st = NDB * 512;
        const s16x4 l0 = tr_read<o0 + 0 * st>(vbase), h0 = tr_read<o0 + 1 * st>(vbase), l1 = tr_read<o0 + 2 * st>(vbase), h1 = tr_read<o0 + 3 * st>(vbase);
        asm volatile("s_waitcnt lgkmcnt(0)" ::: "memory"); __builtin_amdgcn_sched_barrier(0);
#define PKV(L, H) (bf16x8){L[0], L[1], L[2], L[3], H[0], H[1], H[2], H[3]}
        o = __builtin_amdgcn_mfma_f32_32x32x16_bf16(PKV(l0, h0), pa, o, 0, 0, 0);
        o = __builtin_amdgcn_mfma_f32_32x32x16_bf16(PKV(l1, h1), pb, o, 0, 0, 0);
#undef PKV
    }
};
template <int NDB, int KB>
__device__ __forceinline__ void pv_half(f32x16 (&o)[NDB], f32x16& ol, int vbase, const bf16x8& pa, const bf16x8& pb) {
    const bf16x8 ones = {16256, 16256, 16256, 16256, 16256, 16256, 16256, 16256};
    ol = __builtin_amdgcn_mfma_f32_32x32x16_bf16(ones, pa, ol, 0, 0, 0);
    ol = __builtin_amdgcn_mfma_f32_32x32x16_bf16(ones, pb, ol, 0, 0, 0);
    PvPart<NDB, KB, 0>::run(o[0], vbase, pa, pb); PvPart<NDB, KB, 1>::run(o[1], vbase, pa, pb);
    if constexpr (NDB == 4) { PvPart<NDB, KB, 2>::run(o[2], vbase, pa, pb); PvPart<NDB, KB, 3>::run(o[3], vbase, pa, pb); }
}
constexpr float ATT_THR = 10.0f;
template <int NDB>
__device__ __forceinline__ void attn_scores(char* lds, int kof, const bf16x8 (&qf)[4], f32x16& s0, f32x16& s1, f32x16 (&o)[NDB], f32x16& ol, f32x16& nm, bool first, int r32, int hi) {
    s0 = nm; s1 = nm;
#pragma unroll
    for (int ds = 0; ds < 4; ++ds) {
        const bf16x8 k0 = *(const bf16x8*)(lds + kof + swz(r32, ds * 2 + hi)), k1 = *(const bf16x8*)(lds + kof + swz(32 + r32, ds * 2 + hi));
        s0 = __builtin_amdgcn_mfma_f32_32x32x16_bf16(k0, qf[ds], s0, 0, 0, 0);
        s1 = __builtin_amdgcn_mfma_f32_32x32x16_bf16(k1, qf[ds], s1, 0, 0, 0);
    }
    float mx = fmaxf(s0[0], s1[0]);
#pragma unroll
    for (int r = 1; r < 16; ++r) mx = fmaxf(fmaxf(mx, s0[r]), s1[r]);
    mx = half_max(mx);
    if (first || __any(mx > ATT_THR)) {
        const float delta = first ? mx : fmaxf(mx, 0.f), alpha = first ? 0.f : __builtin_amdgcn_exp2f(-delta);
#pragma unroll
        for (int r = 0; r < 16; ++r) { s0[r] -= delta; s1[r] -= delta; nm[r] -= delta; ol[r] *= alpha; }
#pragma unroll
        for (int t = 0; t < NDB; ++t)
#pragma unroll
            for (int r = 0; r < 16; ++r) o[t][r] *= alpha;
    }
}
__device__ __forceinline__ void exp_pack(const f32x16& s, bf16x8& pa, bf16x8& pb) {
    float e[16];
#pragma unroll
    for (int r = 0; r < 16; ++r) e[r] = __builtin_amdgcn_exp2f(s[r]);
    u32x4 a = {cvt_pk(e[0], e[1]), cvt_pk(e[2], e[3]), cvt_pk(e[4], e[5]), cvt_pk(e[6], e[7])};
    u32x4 b = {cvt_pk(e[8], e[9]), cvt_pk(e[10], e[11]), cvt_pk(e[12], e[13]), cvt_pk(e[14], e[15])};
    pa = *(bf16x8*)&a; pb = *(bf16x8*)&b;
}

__device__ __forceinline__ void attn_diff_unit(const Params& p, char* lds, int h, int qb, float lam) {
    const int tid = threadIdx.x, lane = tid & 63, w = __builtin_amdgcn_readfirstlane(tid >> 6), r32 = lane & 31, hi = lane >> 5, mp = w >> 2, wq = w & 3;
    const bf16_t* proj = (const bf16_t*)(p.ws + WS_PROJ);
    const int NT = 2 * qb + 2, myNT = (wq < 2) ? NT - 1 : NT;
    bf16x8 qf[4];
    { const bf16_t* qp = proj + (size_t)(qb * 128 + wq * 32 + r32) * INW + C_BQ + h * 128 + mp * 64 + hi * 8;
#pragma unroll
      for (int ds = 0; ds < 4; ++ds) qf[ds] = *(const bf16x8*)(qp + ds * 16); }
    asm volatile("" : "+v"(qf[0]), "+v"(qf[1]), "+v"(qf[2]), "+v"(qf[3]));
    f32x16 o[4] = {}; f32x16 ol = {}, nm = {};
    const bf16_t* gk0 = proj + (size_t)(tid >> 3) * INW + C_BK + h * 128 + (tid & 7) * 8;
    const bf16_t* gv0 = proj + (size_t)(tid >> 4) * INW + C_BV + h * 128 + (tid & 15) * 8;
    const int wk = swz(tid >> 3, tid & 7), wv0 = v_off(tid >> 4, (tid & 15) * 8, 4), wv1 = v_off(32 + (tid >> 4), (tid & 15) * 8, 4);
    const int vlane = ((lane & 3) << 3) | (((lane >> 2) & 3) << 6) | (((lane >> 4) & 1) << 5) | (((lane >> 5) & 1) << 8);
    u32x4 st0, st1, st2, st3;
#define D_LOAD(t) do { const size_t ko = (size_t)(t) * 64 * INW; st0 = *(const u32x4*)(gk0 + ko); st1 = *(const u32x4*)(gk0 + ko + 64); st2 = *(const u32x4*)(gv0 + ko); st3 = *(const u32x4*)(gv0 + ko + (size_t)32 * INW); } while (0)
#define D_WRITE(t) do { char* kb_ = lds + ((t) & 1) * 16384; char* vb_ = lds + 32768 + ((t) % 3) * 16384; *(u32x4*)(kb_ + wk) = st0; *(u32x4*)(kb_ + 8192 + wk) = st1; *(u32x4*)(vb_ + wv0) = st2; *(u32x4*)(vb_ + wv1) = st3; } while (0)
#define D_VB(t) ((int)(uintptr_t)(lds + 32768 + ((t) % 3) * 16384) + vlane)
    bf16x8 p0, p1, p2, p3; f32x16 s0, s1;
    D_LOAD(0); D_WRITE(0); D_LOAD(1); __syncthreads();
    for (int t = 0; t < NT; ++t) {

        if (mp == 1 && t >= 1 && t - 1 < myNT) { const int vb_ = D_VB(t - 1); pv_half<4, 0>(o, ol, vb_, p0, p1); pv_half<4, 1>(o, ol, vb_, p2, p3); }
        if (t < myNT) {
            attn_scores<4>(lds, (t & 1) * 16384 + mp * 8192, qf, s0, s1, o, ol, nm, t == 0, r32, hi);
            exp_pack(s0, p0, p1);
            if (mp == 0) { const int vb_ = D_VB(t); pv_half<4, 0>(o, ol, vb_, p0, p1); exp_pack(s1, p2, p3); pv_half<4, 1>(o, ol, vb_, p2, p3); }
            else exp_pack(s1, p2, p3);
        }
        if (t + 1 < NT) { D_WRITE(t + 1); if (t + 2 < NT) D_LOAD(t + 2); }
        __syncthreads();
    }
    if (mp == 1 && NT - 1 < myNT) { const int vb_ = D_VB(NT - 1); pv_half<4, 0>(o, ol, vb_, p0, p1); pv_half<4, 1>(o, ol, vb_, p2, p3); }
    __syncthreads();
#undef D_LOAD
#undef D_WRITE
#undef D_VB
    float* xb = (float*)lds;
    const float il = 1.0f / ol[0];
    if (mp == 1) {
        const float f = il * lam;
#pragma unroll
        for (int t = 0; t < 4; ++t)
#pragma unroll
            for (int r = 0; r < 16; ++r) xb[(wq * 64 + t * 16 + r) * 64 + lane] = o[t][r] * f;
    }
    __syncthreads();
    if (mp == 0) {
        float ss = 0.f;
#pragma unroll
        for (int t = 0; t < 4; ++t)
#pragma unroll
            for (int r = 0; r < 16; ++r) { const float v = o[t][r] * il - xb[(wq * 64 + t * 16 + r) * 64 + lane]; o[t][r] = v; ss += v * v; }
        ss = half_sum(ss);
        const float rs = rsqrtf(ss * (1.0f / 128.0f) + LN_EPS) * 0.8f;
        bf16_t* op = (bf16_t*)(p.ws + WS_ATT) + (size_t)(qb * 128 + wq * 32 + r32) * D + 512 + h * 128;
#pragma unroll
        for (int t = 0; t < 4; ++t)
#pragma unroll
            for (int rr = 0; rr < 4; ++rr) {
                const int dv0 = 32 * t + 8 * rr + 4 * hi;
                const f32x4 gg = *(const f32x4*)(p.subg + dv0);
                u32x2 pk = {cvt_pk(o[t][4 * rr] * rs * gg[0], o[t][4 * rr + 1] * rs * gg[1]), cvt_pk(o[t][4 * rr + 2] * rs * gg[2], o[t][4 * rr + 3] * rs * gg[3])};
                *(u32x2*)(op + dv0) = pk;
            }
    }
    __syncthreads();
}
__device__ __forceinline__ void attn_swa_unit(const Params& p, char* lds, int kvh, int n) {
    const int tid = threadIdx.x, lane = tid & 63, w = __builtin_amdgcn_readfirstlane(tid >> 6), r32 = lane & 31, hi = lane >> 5, g = w >> 1, hq = kvh * 4 + g;
    const bf16_t* proj = (const bf16_t*)(p.ws + WS_PROJ);
    const int c0 = (n >= 2) ? n - 2 : 0, NT = n - c0 + 1;
    const int tok = n * 64 + (w & 1) * 32 + r32;
    bf16x8 qf[4];
    { const bf16_t* qp = proj + (size_t)tok * INW + C_AQ + hq * 64 + hi * 8;
#pragma unroll
      for (int ds = 0; ds < 4; ++ds) qf[ds] = *(const bf16x8*)(qp + ds * 16); }
    f32x16 o[2] = {}; f32x16 ol, nm;
    { float ms = -p.sinks[hq] * LOG2E; asm volatile("" : "+v"(qf[0]), "+v"(qf[1]), "+v"(qf[2]), "+v"(qf[3]), "+v"(ms));
#pragma unroll
      for (int r = 0; r < 16; ++r) { nm[r] = ms; ol[r] = 1.0f; } }
    const bf16_t* gk = proj + (size_t)(c0 * 64 + (tid >> 3)) * INW + C_AK + kvh * 64 + (tid & 7) * 8;
    const bf16_t* gv = proj + (size_t)(c0 * 64 + (tid >> 3)) * INW + C_AV + kvh * 64 + (tid & 7) * 8;
    const int wk = swz(tid >> 3, tid & 7), wv = v_off(tid >> 3, (tid & 7) * 8, 2);
    const int vlane = ((lane & 3) << 3) | (((lane >> 2) & 3) << 6) | (((lane >> 4) & 1) << 5) | (((lane >> 5) & 1) << 8);
    u32x4 st0, st1;
#define W_LOAD(t) do { const size_t ko = (size_t)(t) * 64 * INW; st0 = *(const u32x4*)(gk + ko); st1 = *(const u32x4*)(gv + ko); } while (0)
#define W_WRITE(b) do { char* sb = lds + (b) * AT_STAGE; *(u32x4*)(sb + wk) = st0; *(u32x4*)(sb + 8192 + wv) = st1; } while (0)
    W_LOAD(0); W_WRITE(0); __syncthreads();
    for (int t = 0; t < NT; ++t) {
        const int b = t & 1;
        if (t + 1 < NT) W_LOAD(t + 1);
        { f32x16 s0, s1; bf16x8 p0, p1, p2, p3; const int vb_ = (int)(uintptr_t)(lds + b * AT_STAGE + 8192) + vlane;
          attn_scores<2>(lds, b * AT_STAGE, qf, s0, s1, o, ol, nm, false, r32, hi);
          exp_pack(s0, p0, p1); pv_half<2, 0>(o, ol, vb_, p0, p1); exp_pack(s1, p2, p3); pv_half<2, 1>(o, ol, vb_, p2, p3); }
        if (t + 1 < NT) W_WRITE(b ^ 1);
        __syncthreads();
    }
#undef W_LOAD
#undef W_WRITE
    const float il = 1.0f / ol[0];
    bf16_t* op = (bf16_t*)(p.ws + WS_ATT) + (size_t)tok * D + hq * 64;
#pragma unroll
    for (int t = 0; t < 2; ++t)
#pragma unroll
        for (int rr = 0; rr < 4; ++rr) {
            const int dv0 = 32 * t + 8 * rr + 4 * hi;
            u32x2 pk = {cvt_pk(o[t][4 * rr] * il, o[t][4 * rr + 1] * il), cvt_pk(o[t][4 * rr + 2] * il, o[t][4 * rr + 3] * il)};
            *(u32x2*)(op + dv0) = pk;
        }
}
__device__ __forceinline__ void phase_attn(const Params& p, char* lds, int vb, int G) {
    const int lane = threadIdx.x & 63;
    const float d1 = wave_sum(p.lq1[lane] * p.lk1[lane]), d2 = wave_sum(p.lq2[lane] * p.lk2[lane]);
    const float lam = expf(d1) - expf(d2) + 0.2f;
    for (int u = vb; u < 1024; u += G) {
        if (u < 256) attn_diff_unit(p, lds, u >> 6, 127 - (u & 63), lam);
        else if (u < 512) attn_diff_unit(p, lds, (u - 256) >> 6, (u - 256) & 63, lam);
        else attn_swa_unit(p, lds, (u - 512) >> 8, (u - 512) & 255);
    }
}

struct EpiPreLn {
    const float* x; float* out; int row0, col0;
    __device__ __forceinline__ void operator()(f32x4 (&acc)[4][4], int wr, int wc, int fr, int fq) const {
#pragma unroll
        for (int mt = 0; mt < 4; ++mt) {
            const size_t ro = (size_t)(row0 + wr * 64 + mt * 16 + fr) * D + col0 + wc * 64 + 4 * fq;
#pragma unroll
            for (int nt = 0; nt < 4; ++nt) { const f32x4 xv = *(const f32x4*)(x + ro + nt * 16); *(f32x4*)(out + ro + nt * 16) = xv * ALPHA + acc[mt][nt]; }
        }
    }
};
__device__ __forceinline__ void phase_wout(const Params& p, char* lds, int vb, int G) {
    const int tid = threadIdx.x, lane = tid & 63, w = tid >> 6;
    const bf16_t* att = (const bf16_t*)(p.ws + WS_ATT);
    for (int u = vb; u < (S / 128) * 4; u += G) {
        const int tm = u >> 2, tn = u & 3;
        GemmArgs g;
        g.a0 = (const char*)(att + (size_t)(tm * 128 + (tid >> 3)) * D + (tid & 7) * 8);
        g.a1 = (const char*)(att + (size_t)(tm * 128 + 64 + (tid >> 3)) * D + (tid & 7) * 8);
        g.b = p.w_out + (size_t)(w * 8) * D + tn * 256 + 4 * lane; g.ldb = D; g.nk = D / 64;
        EpiPreLn e{p.x, (float*)(p.ws + WS_PRELN), tm * 128, tn * 256};
        gemm_tile<0>(lds, g, e);
    }
}

struct EpiLogits {
    float* L;
    __device__ __forceinline__ void operator()(f32x4 (&acc)[4][4], int wr, int wc, int fr, int fq) const {
#pragma unroll
        for (int mt = 0; mt < 4; ++mt)
#pragma unroll
            for (int nt = 0; nt < 4; ++nt) *(f32x4*)(L + (wr * 64 + mt * 16 + fr) * 256 + wc * 64 + nt * 16 + 4 * fq) = acc[mt][nt];
    }
};
__device__ __forceinline__ void phase_router(const Params& p, char* lds, int vb, int G, int alt = 0) {
    const int tid = threadIdx.x, lane = tid & 63, w = tid >> 6;
    const float* preln = (const float*)(p.ws + WS_PRELN);
    float* x1f = (float*)(p.ws + WS_X1F); bf16_t* x1b = (bf16_t*)(p.ws + WS_X1B);
    unsigned* cnt = (unsigned*)(p.ws + WS_CTL) + (alt ? 1024 : 0); int* list = (int*)(p.ws + (alt ? WS_Y : WS_LIST)); float* gates = (float*)(p.ws + (alt ? WS_Y + 32 * MiB : WS_GATE));
    for (int u = vb; u < S / 128; u += G) {
        for (int i = 0; i < 16; ++i) {
            const int row = u * 128 + w * 16 + i;
            const f32x4* xr = (const f32x4*)(preln + (size_t)row * D) + lane;
            f32x4 v[4]; float s = 0.f;
#pragma unroll
            for (int j = 0; j < 4; ++j) { v[j] = xr[64 * j]; s += (v[j][0] + v[j][1]) + (v[j][2] + v[j][3]); }
            const float mean = wave_sum(s) * (1.0f / D); float s2 = 0.f;
#pragma unroll
            for (int j = 0; j < 4; ++j) { v[j] = v[j] - mean; s2 += (v[j][0] * v[j][0] + v[j][1] * v[j][1]) + (v[j][2] * v[j][2] + v[j][3] * v[j][3]); }
            const float rstd = rsqrtf(wave_sum(s2) * (1.0f / D) + LN_EPS);
#pragma unroll
            for (int j = 0; j < 4; ++j) {
                const f32x4 gg = *((const f32x4*)p.ln1g + lane + 64 * j), bb = *((const f32x4*)p.ln1b + lane + 64 * j);
                const f32x4 y = v[j] * rstd * gg + bb;
                *((f32x4*)(x1f + (size_t)row * D) + lane + 64 * j) = y;
                u32x2 pk = {cvt_pk(y[0], y[1]), cvt_pk(y[2], y[3])};
                *((u32x2*)(x1b + (size_t)row * D) + lane + 64 * j) = pk;
            }
        }
        asm volatile("s_waitcnt vmcnt(0)" ::: "memory");
        __syncthreads();
        GemmArgs g;
        g.a0 = (const char*)(x1b + (size_t)(u * 128 + (tid >> 3)) * D + (tid & 7) * 8);
        g.a1 = (const char*)(x1b + (size_t)(u * 128 + 64 + (tid >> 3)) * D + (tid & 7) * 8);
        g.b = p.w_r + (size_t)(w * 8) * NE + 4 * lane; g.ldb = NE; g.nk = D / 64;
        EpiLogits e{(float*)lds};
        gemm_tile<0>(lds, g, e);
        __syncthreads();
        const f32x4 rb = *((const f32x4*)p.r_bias + lane);
        const float NEG = -__builtin_inff();
        for (int i = 0; i < 16; ++i) {
            const int tl = w * 16 + i, t = u * 128 + tl;
            const f32x4 lg = *((const f32x4*)((const float*)lds + tl * 256) + lane);
            float sc[4], cand[4];
#pragma unroll
            for (int j = 0; j < 4; ++j) { sc[j] = 1.0f / (1.0f + expf(-lg[j])); cand[j] = sc[j] + rb[j]; }
            float a1, a2;
            { const float m01 = fmaxf(cand[0], cand[1]), n01 = fminf(cand[0], cand[1]), m23 = fmaxf(cand[2], cand[3]), n23 = fminf(cand[2], cand[3]);
              a1 = fmaxf(m01, m23); a2 = fmaxf(fminf(m01, m23), fmaxf(n01, n23)); }
#pragma unroll
            for (int off = 1; off < 8; off <<= 1) { const float b1 = __shfl_xor(a1, off), b2 = __shfl_xor(a2, off); const float n1 = fmaxf(a1, b1), n2 = fmaxf(fminf(a1, b1), fmaxf(a2, b2)); a1 = n1; a2 = n2; }
            const float gs = a1 + a2; const int mygrp = lane >> 3; int rank = 0;
#pragma unroll
            for (int g2 = 0; g2 < 8; ++g2) { const float v = __shfl(gs, g2 * 8); rank += (v > gs || (v == gs && g2 < mygrp)) ? 1 : 0; }
            if (rank >= 4) {
#pragma unroll
                for (int j = 0; j < 4; ++j) cand[j] = NEG;
            }
            int my_e = 0; float my_s = 0.f, gsum = 0.f;
#pragma unroll
            for (int k = 0; k < 8; ++k) {
                float bv = cand[0]; int bi = 0;
#pragma unroll
                for (int j = 1; j < 4; ++j) if (cand[j] > bv) { bv = cand[j]; bi = j; }
                int idx = 4 * lane + bi;
#pragma unroll
                for (int off = 32; off >= 1; off >>= 1) { const float ov = __shfl_xor(bv, off); const int oi = __shfl_xor(idx, off); if (ov > bv || (ov == bv && oi < idx)) { bv = ov; idx = oi; } }
                const int owner = idx >> 2, sub = idx & 3;
                float scv = sc[0];
#pragma unroll
                for (int j = 1; j < 4; ++j) scv = (sub == j) ? sc[j] : scv;
                if (lane == owner) {
#pragma unroll
                    for (int j = 0; j < 4; ++j) if (sub == j) cand[j] = NEG;
                }
                const float gsc = __shfl(scv, owner);
                if (lane == k) { my_e = idx; my_s = gsc; }
                gsum += gsc;
            }
            if (lane < 8) {
                const float gate = my_s / gsum * 2.5f;
                const unsigned pos = atomicAdd(cnt + my_e, 1u);
                list[(size_t)my_e * CAP + pos] = t * 8 + lane;
                gates[t * 8 + lane] = gate;
            }
        }
        __syncthreads();
    }
}

struct EpiAct {
    bf16_t* act; const int* slots; int ncol0;
    __device__ __forceinline__ void operator()(f32x4 (&acc)[4][4], int wr, int wc, int fr, int fq) const {
#pragma unroll
        for (int mt = 0; mt < 4; ++mt) {
            const int ar = slots[wr * 64 + mt * 16 + fr];
            if (ar >= 0) {
#pragma unroll
                for (int nt = 0; nt < 2; ++nt) {
                    const f32x4 gv = acc[mt][nt], uv = acc[mt][nt + 2]; float a[4];
#pragma unroll
                    for (int j = 0; j < 4; ++j) a[j] = gv[j] / (1.0f + __expf(-gv[j])) * uv[j];
                    u32x2 pk = {cvt_pk(a[0], a[1]), cvt_pk(a[2], a[3])};
                    *(u32x2*)(act + (size_t)ar * FF + ncol0 + wc * 32 + nt * 16 + 4 * fq) = pk;
                }
            }
        }
    }
};
struct EpiY {
    bf16_t* y; const int* yrows; const float* gl; int col0;
    __device__ __forceinline__ void operator()(f32x4 (&acc)[4][4], int wr, int wc, int fr, int fq) const {
#pragma unroll
        for (int mt = 0; mt < 4; ++mt) {
            const int r = wr * 64 + mt * 16 + fr, yr = yrows[r];
            if (yr >= 0) {
                const float gt = gl[r];
#pragma unroll
                for (int nt = 0; nt < 4; ++nt) {
                    const f32x4 v = acc[mt][nt] * gt;
                    u32x2 pk = {cvt_pk(v[0], v[1]), cvt_pk(v[2], v[3])};
                    *(u32x2*)(y + (size_t)yr * D + col0 + wc * 64 + nt * 16 + 4 * fq) = pk;
                }
            }
        }
    }
};
__device__ __forceinline__ void phase_experts(const Params& p, char* lds, int vb, int G) {
    const int tid = threadIdx.x, lane = tid & 63, w = tid >> 6;
    const bf16_t* x1b = (const bf16_t*)(p.ws + WS_X1B);
    const unsigned* cnt = (const unsigned*)(p.ws + WS_CTL); const int* list = (const int*)(p.ws + WS_LIST); const float* gates = (const float*)(p.ws + WS_GATE);
    bf16_t* act = (bf16_t*)(p.ws + WS_ACT); bf16_t* ybuf = (bf16_t*)(p.ws + WS_Y);
    int* nts = (int*)(lds + LDS_MISC); int* pre = nts + 256;
    int* s_arow = pre + 260; int* s_yrow = s_arow + 128; int* s_tok = s_yrow + 128; float* s_gate = (float*)(s_tok + 128);
    if (tid < 256) nts[tid] = (int)((__hip_atomic_load(cnt + tid, __ATOMIC_RELAXED, __HIP_MEMORY_SCOPE_AGENT) + 127u) >> 7);
    __syncthreads();
    if (tid < 257) { int s = 0; for (int e = 0; e < tid; ++e) s += nts[e]; pre[tid] = s; }
    __syncthreads();
    const int NR = pre[256], NU = NR + S / 128;
    for (int u = vb; u < NU; u += G) {
        __syncthreads();
        const float *wg, *wu, *wd;
        if (u < NR) {
            int lo = 0, hi = 255;
            while (lo < hi) { const int mid = (lo + hi + 1) >> 1; if (pre[mid] <= u) lo = mid; else hi = mid - 1; }
            const int e = lo, tile = u - pre[e], n = (int)__hip_atomic_load(cnt + e, __ATOMIC_RELAXED, __HIP_MEMORY_SCOPE_AGENT);
            if (tid < 128) {
                const int idx = tile * 128 + tid;
                if (idx < n) { const int slot = list[(size_t)e * CAP + idx]; s_arow[tid] = slot; s_yrow[tid] = slot + (slot >> 3); s_tok[tid] = slot >> 3; s_gate[tid] = gates[slot]; }
                else { s_arow[tid] = -1; s_yrow[tid] = -1; s_tok[tid] = 0; s_gate[tid] = 0.f; }
            }
            wg = p.w_g + (size_t)e * D * FF; wu = p.w_u + (size_t)e * D * FF; wd = p.w_d + (size_t)e * FF * D;
        } else {
            const int tile = u - NR;
            if (tid < 128) { const int tk = tile * 128 + tid; s_arow[tid] = S * 8 + tk; s_yrow[tid] = tk * 9 + 8; s_tok[tid] = tk; s_gate[tid] = 1.0f; }
            wg = p.ws_g; wu = p.ws_u; wd = p.ws_d;
        }
        __syncthreads();
        const int r0 = tid >> 3, r1 = 64 + (tid >> 3);
        for (int np = 0; np < 2; ++np) {
            GemmArgs g;
            g.a0 = (const char*)(x1b + (size_t)s_tok[r0] * D + (tid & 7) * 8);
            g.a1 = (const char*)(x1b + (size_t)s_tok[r1] * D + (tid & 7) * 8);
            const int n0 = 4 * lane, bwc = n0 >> 6, sub = n0 & 63;
            const float* bsrc = (sub < 32) ? (wg + np * 128 + bwc * 32 + sub) : (wu + np * 128 + bwc * 32 + (sub - 32));
            g.b = bsrc + (size_t)(w * 8) * FF; g.ldb = FF; g.nk = D / 64;
            EpiAct e{act, s_arow, np * 128};
            gemm_tile<0>(lds, g, e);
        }
        asm volatile("s_waitcnt vmcnt(0)" ::: "memory");
        __syncthreads();
        const int ar0 = s_arow[r0] < 0 ? 0 : s_arow[r0], ar1 = s_arow[r1] < 0 ? 0 : s_arow[r1];
        for (int np = 0; np < 4; ++np) {
            GemmArgs g;
            g.a0 = (const char*)(act + (size_t)ar0 * FF + (tid & 7) * 8);
            g.a1 = (const char*)(act + (size_t)ar1 * FF + (tid & 7) * 8);
            g.b = wd + (size_t)(w * 8) * D + np * 256 + 4 * lane; g.ldb = D; g.nk = FF / 64;
            EpiY e{ybuf, s_yrow, s_gate, np * 256};
            gemm_tile<0>(lds, g, e);
        }
    }
}

__device__ __forceinline__ void phase_final(const Params& p, int vb, int G) {
    const int lane = threadIdx.x & 63, w = threadIdx.x >> 6;
    const float* x1f = (const float*)(p.ws + WS_X1F); const bf16_t* ybuf = (const bf16_t*)(p.ws + WS_Y);
    for (int row = vb * 8 + w; row < S; row += G * 8) {
        f32x4 v[4]; float s = 0.f;
#pragma unroll
        for (int j = 0; j < 4; ++j) v[j] = *((const f32x4*)(x1f + (size_t)row * D) + lane + 64 * j) * ALPHA;
#pragma unroll
        for (int k = 0; k < 9; ++k) {
            const u32x2* yr = (const u32x2*)(ybuf + (size_t)(row * 9 + k) * D) + lane;
#pragma unroll
            for (int j = 0; j < 4; ++j) { const u32x2 q = yr[64 * j]; v[j][0] += bf_lo(q[0]); v[j][1] += bf_hi(q[0]); v[j][2] += bf_lo(q[1]); v[j][3] += bf_hi(q[1]); }
        }
#pragma unroll
        for (int j = 0; j < 4; ++j) s += (v[j][0] + v[j][1]) + (v[j][2] + v[j][3]);
        const float mean = wave_sum(s) * (1.0f / D); float s2 = 0.f;
#pragma unroll
        for (int j = 0; j < 4; ++j) { v[j] = v[j] - mean; s2 += (v[j][0] * v[j][0] + v[j][1] * v[j][1]) + (v[j][2] * v[j][2] + v[j][3] * v[j][3]); }
        const float rstd = rsqrtf(wave_sum(s2) * (1.0f / D) + LN_EPS);
#pragma unroll
        for (int j = 0; j < 4; ++j) {
            const f32x4 gg = *((const f32x4*)p.ln2g + lane + 64 * j), bb = *((const f32x4*)p.ln2b + lane + 64 * j);
            *((f32x4*)(p.out + (size_t)row * D) + lane + 64 * j) = v[j] * rstd * gg + bb;
        }
    }
}

__global__ void __launch_bounds__(NTHREADS) mega(Params p) {
    extern __shared__ __attribute__((aligned(16))) char lds[];
    const int G = gridDim.x, bx = blockIdx.x;
    const int vb = (G % 8 == 0) ? (bx % 8) * (G / 8) + bx / 8 : bx;
    if (threadIdx.x < 4) ((volatile LAS unsigned*)((LAS char*)lds + LDS_BARST))[threadIdx.x] = 0u;
    __syncthreads();
    XcdBarrier bar; bar.bar = (unsigned*)(p.ws + WS_CTL) + CW_BAR; bar.x = 0; bar.st = nullptr;
    if (p.ph_hi - p.ph_lo > 1) bar = xcd_barrier_post((unsigned*)(p.ws + WS_CTL) + CW_BAR, (volatile LAS unsigned*)((LAS char*)lds + LDS_BARST));
#define SEAM(k) do { if (p.ph_lo <= (k) && (k) + 1 < p.ph_hi) { xcd_barrier(bar); } } while (0)
#define IN(k) (p.ph_lo <= (k) && (k) < p.ph_hi)
    if (IN(0)) { phase_rope(p, vb, G); if (MK_REPEAT == 0) { __syncthreads(); phase_rope(p, vb, G); } } SEAM(0);
    if (IN(1)) { phase_proj(p, lds, vb, G); if (MK_REPEAT == 1) { __syncthreads(); phase_proj(p, lds, vb, G); } } SEAM(1);
    if (IN(2)) { phase_attn(p, lds, vb, G); if (MK_REPEAT == 2) { __syncthreads(); phase_attn(p, lds, vb, G); } } SEAM(2);
    if (IN(3)) { phase_wout(p, lds, vb, G); if (MK_REPEAT == 3) { __syncthreads(); phase_wout(p, lds, vb, G); } } SEAM(3);
    if (IN(4)) { phase_router(p, lds, vb, G); if (MK_REPEAT == 4) { __syncthreads(); phase_router(p, lds, vb, G, 1); } if (MK_REPEAT == 7) { for (int i = 0; i < 10; ++i) xcd_barrier(bar); } } SEAM(4);
    if (IN(5)) { phase_experts(p, lds, vb, G); if (MK_REPEAT == 5) { __syncthreads(); phase_experts(p, lds, vb, G); } } SEAM(5);
    if (IN(6)) { phase_final(p, vb, G); if (MK_REPEAT == 6) { __syncthreads(); phase_final(p, vb, G); } }
#undef SEAM
#undef IN
}

extern "C" void kernel_launch(void* const* d_in, const int* in_sizes, int n_in, void* d_out, int out_size, void* d_ws, size_t ws_size, hipStream_t stream) {
    static int grid = 0;
    if (grid == 0) {
        if (n_in != 22 || in_sizes[0] != S * D || out_size != S * D || ws_size < WS_END) {
            fprintf(stderr, "kernel_launch: unexpected shapes: n_in %d in0 %d out %d ws %zu (need %zu)\n", n_in, n_in > 0 ? in_sizes[0] : -1, out_size, ws_size, (size_t)WS_END); grid = -1; return; }
        int dev = 0, cus = 0, per_cu = 0;
        hipGetDevice(&dev); hipDeviceGetAttribute(&cus, hipDeviceAttributeMultiprocessorCount, dev);
        if (hipFuncSetAttribute((const void*)mega, hipFuncAttributeMaxDynamicSharedMemorySize, LDS_BYTES) != hipSuccess) { fprintf(stderr, "kernel_launch: hipFuncSetAttribute failed\n"); grid = -1; return; }
        hipOccupancyMaxActiveBlocksPerMultiprocessor(&per_cu, (const void*)mega, NTHREADS, LDS_BYTES);
        if (per_cu < 1) { fprintf(stderr, "kernel_launch: occupancy query says %d blocks per CU\n", per_cu); per_cu = 1; }
        grid = cus * 1;
        (void)hipGetLastError();
    }
    if (grid < 0) return;
    hipMemsetAsync((char*)d_ws + WS_CTL, 0, CTL_BYTES, stream);
    Params p{};
    const float** f = (const float**)&p;
    for (int i = 0; i < 22; ++i) f[i] = (const float*)d_in[i];
    p.out = (float*)d_out; p.ws = (unsigned char*)d_ws;
#if MK_ONE_LAUNCH
    p.ph_lo = 0; p.ph_hi = 7;
    void* args[] = {&p};
    hipError_t e = hipLaunchCooperativeKernel((const void*)mega, dim3(grid), dim3(NTHREADS), args, LDS_BYTES, stream);
    if (e != hipSuccess) fprintf(stderr, "kernel_launch: cooperative launch failed: %s (grid %d)\n", hipGetErrorString(e), grid);
#else
    for (int ph = 0; ph < 7; ++ph) {
        p.ph_lo = ph; p.ph_hi = ph + 1;
        hipLaunchKernelGGL(mega, dim3(grid), dim3(NTHREADS), LDS_BYTES, stream, p);
    }
#endif
}
```

```cpp
#include <hip/hip_runtime.h>
#include <hip/hip_cooperative_groups.h>
#include <cstdio>
#include <cstdint>
namespace cg = cooperative_groups;

#ifndef MK_REPEAT
#define MK_REPEAT -1
#endif
#ifndef MK_ONE_LAUNCH
#define MK_ONE_LAUNCH 1
#endif

constexpr int S = 16384, D = 1024, INW = 2304, NE = 256, FF = 256;
constexpr int NTHREADS = 512;
constexpr int CAP = 16384;
constexpr float ALPHA = 1.189207115002721f;
constexpr float LN_EPS = 1e-5f;
constexpr float QSCALE = 0.125f * 1.4426950408889634f;
constexpr float LOG2E = 1.4426950408889634f;
constexpr int C_AQ = 0, C_AK = 512, C_AV = 640, C_BQ = 768, C_BK = 1280, C_BV = 1792;

constexpr size_t MiB = 1ull << 20;
constexpr size_t WS_CTL = 0;
constexpr size_t CTL_BYTES = 64 * 1024;
constexpr size_t WS_ROPE = 1 * MiB;
constexpr size_t WS_WIN = 8 * MiB;
constexpr size_t WS_WOUT = 13 * MiB;
constexpr size_t WS_WR = 15 * MiB;
constexpr size_t WS_WSGU = 16 * MiB;
constexpr size_t WS_WSD = 17 * MiB;
constexpr size_t WS_EGU = 20 * MiB;
constexpr size_t WS_ED = 276 * MiB;
constexpr size_t WS_X1F = 404 * MiB;
constexpr size_t WS_X1B = 468 * MiB;
constexpr size_t WS_LIST = 500 * MiB;
constexpr size_t WS_GATE = 516 * MiB;
constexpr size_t WS_ACT = 518 * MiB;
constexpr size_t WS_Y = 590 * MiB;
constexpr size_t WS_XB = 590 * MiB;
constexpr size_t WS_PROJ = 622 * MiB;
constexpr size_t WS_ATT = 694 * MiB;
constexpr size_t WS_PRELN = 726 * MiB;
constexpr size_t WS_END = 878 * MiB;

constexpr int LDS_BYTES = 147456;
constexpr int LDS_MISC = 131072;

typedef unsigned short bf16_t;
typedef short bf16x8 __attribute__((ext_vector_type(8)));
typedef short s16x4 __attribute__((ext_vector_type(4)));
typedef float f32x4 __attribute__((ext_vector_type(4)));
typedef float f32x16 __attribute__((ext_vector_type(16)));
typedef unsigned u32x4 __attribute__((ext_vector_type(4)));
typedef unsigned u32x2 __attribute__((ext_vector_type(2)));


#define LAS __attribute__((address_space(3)))
#define XB_TMO      128
#define XB_XCNT(j)  (256  + 64 * (j))
#define XB_XSUB(j)  (1280 + 64 * (j))
#define XB_XGEN(j)  (2304 + 64 * (j))
#define XB_TOP      3328
#define XB_TOPGEN   3392
#define XCD_BAR_WORDS 3456
#define XB_SPIN_CAP (1u << 18)
__device__ __forceinline__ unsigned xb_ld(unsigned* p)              { return __hip_atomic_load(p, __ATOMIC_RELAXED, __HIP_MEMORY_SCOPE_AGENT); }
__device__ __forceinline__ unsigned xb_add(unsigned* p, unsigned v) { return __hip_atomic_fetch_add(p, v, __ATOMIC_RELAXED, __HIP_MEMORY_SCOPE_AGENT); }
__device__ __forceinline__ unsigned xb_xcc_id() { return (unsigned)__builtin_amdgcn_s_getreg((3 << 11) | 20) & 0xFu; }
#define XB_SPIN(cond, bar) do { unsigned _sp = 0; while (cond) { __builtin_amdgcn_s_sleep(1); \
    if ((++_sp & 255u) == 0u) { if (xb_ld(&(bar)[XB_TMO])) break; if (_sp > XB_SPIN_CAP) { atomicAdd(&(bar)[XB_TMO], 1u); break; } } } } while (0)
struct XcdBarrier { unsigned* bar; unsigned x; volatile LAS unsigned* st; };
__device__ __forceinline__ XcdBarrier xcd_barrier_post(unsigned* bar, volatile LAS unsigned* st) {
    XcdBarrier b; b.bar = bar; b.x = xb_xcc_id(); b.st = st;
    if (threadIdx.x == 0) (void)xb_add(&bar[XB_XCNT(b.x)], 1u);
    return b;
}
__device__ __forceinline__ void xcd_barrier_complete(unsigned* bar, unsigned x, unsigned& nloc, unsigned& nx) {
    const unsigned G = gridDim.x * gridDim.y * gridDim.z;
    unsigned sum, cnt, mine, sp = 0u;
    for (;;) {
        sum = 0u; cnt = 0u; mine = 0u;
#pragma unroll
        for (unsigned j = 0; j < 16; ++j) { const unsigned c = xb_ld(&bar[XB_XCNT(j)]); sum += c; cnt += (c > 0u) ? 1u : 0u; mine = (j == x) ? c : mine; }
        if (sum == G) break;
        __builtin_amdgcn_s_sleep(1);
        if ((++sp & 255u) == 0u) { if (xb_ld(&bar[XB_TMO])) break; if (sp > XB_SPIN_CAP) { atomicAdd(&bar[XB_TMO], 1u); break; } }
    }
    nloc = mine > 0u ? mine : 1u; nx = cnt > 0u ? cnt : 1u;
}
__device__ __forceinline__ void xcd_barrier(const XcdBarrier& b) {
    asm volatile("s_waitcnt vmcnt(0)" ::: "memory");
    __syncthreads();
    if (threadIdx.x == 0) {
        unsigned* bar = b.bar;
        __builtin_amdgcn_s_waitcnt(0);
        unsigned nloc = b.st[0], nx = b.st[1];
        if (nloc == 0u) { xcd_barrier_complete(bar, b.x, nloc, nx); b.st[0] = nloc; b.st[1] = nx; }
        const unsigned old = xb_add(&bar[XB_XSUB(b.x)], 1u);
        const unsigned gen = old / nloc;
        if (old + 1u == (gen + 1u) * nloc) {
            __builtin_amdgcn_fence(__ATOMIC_RELEASE, "agent");
            asm volatile("s_waitcnt vmcnt(0)" ::: "memory");
            const unsigned og = xb_add(&bar[XB_TOP], 1u);
            const unsigned tg = og / nx;
            if (og + 1u == (tg + 1u) * nx) xb_add(&bar[XB_TOPGEN], 1u);
            else XB_SPIN(xb_ld(&bar[XB_TOPGEN]) == tg, bar);
            __builtin_amdgcn_fence(__ATOMIC_ACQUIRE, "agent");
            xb_add(&bar[XB_XGEN(b.x)], 1u);
            asm volatile("s_waitcnt vmcnt(0)" ::: "memory");
        } else {
            XB_SPIN(xb_ld(&bar[XB_XGEN(b.x)]) == gen, bar);
            __builtin_amdgcn_fence(__ATOMIC_ACQUIRE, "agent");
            asm volatile("s_waitcnt vmcnt(0)" ::: "memory");
        }
    }
    __syncthreads();
}
constexpr int CW_BAR = 4096;
constexpr int LDS_BARST = LDS_MISC + 8192;

struct Params {
    const float* x; const float* w_in; const float* b_in; const float* sinks;
    const float* lq1; const float* lk1; const float* lq2; const float* lk2; const float* subg;
    const float* w_out; const float* ln1g; const float* ln1b; const float* w_r; const float* r_bias;
    const float* w_g; const float* w_u; const float* w_d; const float* ws_g; const float* ws_u; const float* ws_d;
    const float* ln2g; const float* ln2b;
    float* out; unsigned char* ws;
    int ph_lo, ph_hi;
};

__device__ __forceinline__ unsigned cvt_pk(float lo, float hi) { unsigned r; asm volatile("v_cvt_pk_bf16_f32 %0, %1, %2" : "=v"(r) : "v"(lo), "v"(hi)); return r; }
__device__ __forceinline__ float bf_lo(unsigned u) { return __uint_as_float(u << 16); }
__device__ __forceinline__ float bf_hi(unsigned u) { return __uint_as_float(u & 0xffff0000u); }
__device__ __forceinline__ float wave_sum(float v) {
#pragma unroll
    for (int o = 1; o < 64; o <<= 1) v += __shfl_xor(v, o);
    return v;
}
__device__ __forceinline__ float half_max(float v) { auto rr = __builtin_amdgcn_permlane32_swap(__float_as_uint(v), __float_as_uint(v), false, false); return fmaxf(__uint_as_float(rr[0]), __uint_as_float(rr[1])); }
__device__ __forceinline__ float half_sum(float v) { auto rr = __builtin_amdgcn_permlane32_swap(__float_as_uint(v), __float_as_uint(v), false, false); return __uint_as_float(rr[0]) + __uint_as_float(rr[1]); }

__device__ __forceinline__ int swz(int r, int c) { const int f = (r & 7) ^ (((r >> 3) & 1) << 1) ^ ((r >> 4) & 1); return r * 128 + ((c ^ f) << 4); }

struct G2Args {
    const char* A; const char* B;
    unsigned offA[4], offB[4];
    int nk;
};
__device__ __forceinline__ unsigned g2_chunk_off(int lane, int w) { const int f = (lane >> 3) ^ ((w & 1) << 1) ^ ((w >> 1) & 1); return (unsigned)(((lane & 7) ^ f) << 4); }
template <int MT, class Epi>
__device__ __forceinline__ void gemm2(char* lds_, const G2Args& g, const Epi& epi) {
    constexpr int A_BYTES = 32 * MT * 128, B_BYTES = 256 * 128, STAGE = A_BYTES + B_BYTES, AR = MT / 2;
    LAS char* lds = (LAS char*)lds_;
    const int tid = threadIdx.x, lane = tid & 63, w = __builtin_amdgcn_readfirstlane(tid >> 6), wr = w >> 2, wc = w & 3, fr = lane & 15, fq = lane >> 4;
    f32x4 acc[MT][4];
#pragma unroll
    for (int i = 0; i < MT; ++i)
#pragma unroll
        for (int j = 0; j < 4; ++j) acc[i][j] = (f32x4){0.f, 0.f, 0.f, 0.f};
    const int ldsw = w * 1024;
#define G2_STAGE(kt, s) do { \
        _Pragma("unroll") for (int i = 0; i < AR; ++i) __builtin_amdgcn_global_load_lds((const unsigned*)(g.A + g.offA[i] + (size_t)(kt) * 128), (LAS unsigned*)(lds + (s) * STAGE + i * 8192 + ldsw), 16, 0, 0); \
        _Pragma("unroll") for (int i = 0; i < 4; ++i) __builtin_amdgcn_global_load_lds((const unsigned*)(g.B + g.offB[i] + (size_t)(kt) * 128), (LAS unsigned*)(lds + (s) * STAGE + A_BYTES + i * 8192 + ldsw), 16, 0, 0); } while (0)
    G2_STAGE(0, 0);
    __syncthreads();
    for (int kt = 0; kt < g.nk; ++kt) {
        const int s = kt & 1;
        if (kt + 1 < g.nk) { if (s) G2_STAGE(kt + 1, 0); else G2_STAGE(kt + 1, 1); }
        const char* la = lds_ + s * STAGE; const char* lb = la + A_BYTES;
#pragma unroll
        for (int ks = 0; ks < 2; ++ks) {
            bf16x8 bfr[4];
#pragma unroll
            for (int nt = 0; nt < 4; ++nt) bfr[nt] = *(const bf16x8*)(lb + swz(wc * 64 + nt * 16 + fr, ks * 4 + fq));
#pragma unroll
            for (int h = 0; h < MT / 4; ++h) {
                bf16x8 af[4];
#pragma unroll
                for (int m = 0; m < 4; ++m) af[m] = *(const bf16x8*)(la + swz(wr * 16 * MT + (h * 4 + m) * 16 + fr, ks * 4 + fq));
#pragma unroll
                for (int m = 0; m < 4; ++m)
#pragma unroll
                    for (int nt = 0; nt < 4; ++nt) acc[h * 4 + m][nt] = __builtin_amdgcn_mfma_f32_16x16x32_bf16(bfr[nt], af[m], acc[h * 4 + m][nt], 0, 0, 0);
            }
        }
        __syncthreads();
    }
#undef G2_STAGE
    epi(acc, wr, wc, fr, fq);
}
template <int MT>
__device__ __forceinline__ void g2_rows_A(G2Args& g, size_t row0, unsigned ld_bytes) {
    const int lane = threadIdx.x & 63, w = __builtin_amdgcn_readfirstlane(threadIdx.x >> 6); const unsigned co = g2_chunk_off(lane, w);
#pragma unroll
    for (int i = 0; i < MT / 2; ++i) g.offA[i] = (unsigned)((row0 + i * 64 + w * 8 + (lane >> 3)) * ld_bytes) + co;
}
__device__ __forceinline__ void g2_rows_B(G2Args& g, size_t row0, unsigned ld_bytes) {
    const int lane = threadIdx.x & 63, w = __builtin_amdgcn_readfirstlane(threadIdx.x >> 6); const unsigned co = g2_chunk_off(lane, w);
#pragma unroll
    for (int i = 0; i < 4; ++i) g.offB[i] = (unsigned)((row0 + i * 64 + w * 8 + (lane >> 3)) * ld_bytes) + co;
}


struct G3Args { const char* A; unsigned offA[4]; const float* b; int ldb; int nk; };
template <int MT, class Epi>
__device__ __forceinline__ void gemm3(char* lds_, const G3Args& g, const Epi& epi) {
    constexpr int A_BYTES = 32 * MT * 128, B_BYTES = 256 * 128, STAGE = A_BYTES + B_BYTES, AR = MT / 2;
    LAS char* lds = (LAS char*)lds_;
    const int tid = threadIdx.x, lane = tid & 63, w = __builtin_amdgcn_readfirstlane(tid >> 6), wr = w >> 2, wc = w & 3, fr = lane & 15, fq = lane >> 4;
    f32x4 acc[MT][4];
#pragma unroll
    for (int i = 0; i < MT; ++i)
#pragma unroll
        for (int j = 0; j < 4; ++j) acc[i][j] = (f32x4){0.f, 0.f, 0.f, 0.f};
    const int ldsw = w * 1024;
    int bw[4];
#pragma unroll
    for (int j = 0; j < 4; ++j) bw[j] = swz(4 * lane + j, w);
    f32x4 br[8]; const float* pb = g.b;
#define G3_STAGE_A(kt, s) do { \
        _Pragma("unroll") for (int i = 0; i < AR; ++i) __builtin_amdgcn_global_load_lds((const unsigned*)(g.A + g.offA[i] + (size_t)(kt) * 128), (LAS unsigned*)(lds + (s) * STAGE + i * 8192 + ldsw), 16, 0, 0); } while (0)
#define G3_LOAD_B() do { _Pragma("unroll") for (int i = 0; i < 8; ++i) br[i] = *(const f32x4*)(pb + (size_t)i * g.ldb); pb += (size_t)64 * g.ldb; } while (0)
#define G3_WRITE_B(s) do { _Pragma("unroll") for (int j = 0; j < 4; ++j) { \
            u32x4 v = {cvt_pk(br[0][j], br[1][j]), cvt_pk(br[2][j], br[3][j]), cvt_pk(br[4][j], br[5][j]), cvt_pk(br[6][j], br[7][j])}; \
            *(u32x4*)(lds_ + (s) * STAGE + A_BYTES + bw[j]) = v; } } while (0)
    G3_STAGE_A(0, 0); G3_LOAD_B(); G3_WRITE_B(0);
    __syncthreads();
    for (int kt = 0; kt < g.nk; ++kt) {
        const int s = kt & 1; const bool more = kt + 1 < g.nk;
        if (more) { if (s) G3_STAGE_A(kt + 1, 0); else G3_STAGE_A(kt + 1, 1); G3_LOAD_B(); }
        const char* la = lds_ + s * STAGE; const char* lb = la + A_BYTES;
#pragma unroll
        for (int ks = 0; ks < 2; ++ks) {
            bf16x8 bfr[4];
#pragma unroll
            for (int nt = 0; nt < 4; ++nt) bfr[nt] = *(const bf16x8*)(lb + swz(wc * 64 + nt * 16 + fr, ks * 4 + fq));
#pragma unroll
            for (int h = 0; h < MT / 4; ++h) {
                bf16x8 af[4];
#pragma unroll
                for (int m = 0; m < 4; ++m) af[m] = *(const bf16x8*)(la + swz(wr * 16 * MT + (h * 4 + m) * 16 + fr, ks * 4 + fq));
#pragma unroll
                for (int m = 0; m < 4; ++m)
#pragma unroll
                    for (int nt = 0; nt < 4; ++nt) acc[h * 4 + m][nt] = __builtin_amdgcn_mfma_f32_16x16x32_bf16(bfr[nt], af[m], acc[h * 4 + m][nt], 0, 0, 0);
            }
        }
        if (more) { if (s) G3_WRITE_B(0); else G3_WRITE_B(1); }
        __syncthreads();
    }
#undef G3_STAGE_A
#undef G3_LOAD_B
#undef G3_WRITE_B
    epi(acc, wr, wc, fr, fq);
}

__device__ __forceinline__ void cvt_item(const float* W, int K, int N, bf16_t* WT, int ldt, int kb, int nb, int lane) {
    const float* src = W + (size_t)(kb * 64) * N + nb * 256 + 4 * lane;
    bf16_t* dst = WT + (size_t)(nb * 256 + 4 * lane) * ldt + kb * 64;
#pragma unroll 2
    for (int kc = 0; kc < 8; ++kc) {
        f32x4 r[8];
#pragma unroll
        for (int i = 0; i < 8; ++i) r[i] = *(const f32x4*)(src + (size_t)(kc * 8 + i) * N);
#pragma unroll
        for (int j = 0; j < 4; ++j) {
            u32x4 v = {cvt_pk(r[0][j], r[1][j]), cvt_pk(r[2][j], r[3][j]), cvt_pk(r[4][j], r[5][j]), cvt_pk(r[6][j], r[7][j])};
            *(u32x4*)(dst + (size_t)j * ldt + kc * 8) = v;
        }
    }
}
__device__ __forceinline__ void phase_prep(const Params& p, int vb, int G) {
    const int tid = threadIdx.x, lane = tid & 63, w = tid >> 6;
    float* cs = (float*)(p.ws + WS_ROPE); float* sn = cs + (size_t)S * 32;
    for (int idx = vb * NTHREADS + tid; idx < S * 32; idx += G * NTHREADS) {
        const int pos = idx >> 5, i = idx & 31;
        const float pw = (float)pow(10000.0, (double)i / 32.0);
        const float inv = 1.0f / pw;
        const float angf = __fmul_rn((float)pos, inv);
        const double a = (double)angf;
        const double q = rint(a * 0.63661977236758134308);
        double r = fma(-q, 1.57079632679489655800, a); r = fma(-q, 6.12323399573676603587e-17, r);
        const double r2 = r * r;
        double sp = r * (1.0 + r2 * (-1.0 / 6 + r2 * (1.0 / 120 + r2 * (-1.0 / 5040 + r2 * (1.0 / 362880 + r2 * (-1.0 / 39916800))))));
        double cp = 1.0 + r2 * (-0.5 + r2 * (1.0 / 24 + r2 * (-1.0 / 720 + r2 * (1.0 / 40320 + r2 * (-1.0 / 3628800 + r2 * (1.0 / 479001600))))));
        const int qi = ((int)((long long)q)) & 3;
        double sv, cv;
        if (qi == 0) { sv = sp; cv = cp; } else if (qi == 1) { sv = cp; cv = -sp; } else if (qi == 2) { sv = -sp; cv = -cp; } else { sv = -cp; cv = sp; }
        cs[idx] = (float)cv; sn[idx] = (float)sv;
    }
    { const f32x4* xs = (const f32x4*)p.x; u32x4* xd = (u32x4*)(p.ws + WS_XB);
      for (size_t i = (size_t)vb * NTHREADS + tid; i < (size_t)S * D / 8; i += (size_t)G * NTHREADS) {
          const f32x4 a = xs[2 * i], b = xs[2 * i + 1];
          xd[i] = (u32x4){cvt_pk(a[0], a[1]), cvt_pk(a[2], a[3]), cvt_pk(b[0], b[1]), cvt_pk(b[2], b[3])}; } }
    const int gw = vb * 8 + w, NGW = G * 8;
    constexpr int I_IN = 16 * 9, I_OUT = 16 * 4, I_R = 16, I_SG = 16, I_SU = 16, I_SD = 4 * 4, I_SMALL = I_IN + I_OUT + I_R + I_SG + I_SU + I_SD;
    for (int it = gw; it < I_SMALL; it += NGW) {
        int r = it;
        if (r < I_IN) { cvt_item(p.w_in, D, INW, (bf16_t*)(p.ws + WS_WIN), D, r / 9, r % 9, lane); continue; } r -= I_IN;
        if (r < I_OUT) { cvt_item(p.w_out, D, D, (bf16_t*)(p.ws + WS_WOUT), D, r >> 2, r & 3, lane); continue; } r -= I_OUT;
        if (r < I_R) { cvt_item(p.w_r, D, NE, (bf16_t*)(p.ws + WS_WR), D, r, 0, lane); continue; } r -= I_R;
        if (r < I_SG) { cvt_item(p.ws_g, D, FF, (bf16_t*)(p.ws + WS_WSGU), D, r, 0, lane); continue; } r -= I_SG;
        if (r < I_SU) { cvt_item(p.ws_u, D, FF, (bf16_t*)(p.ws + WS_WSGU) + (size_t)256 * D, D, r, 0, lane); continue; } r -= I_SU;
        cvt_item(p.ws_d, FF, D, (bf16_t*)(p.ws + WS_WSD), FF, r >> 2, r & 3, lane);
    }
}

template <int MT> struct EpiProj {
    const float* bias; const float* cs; const float* sn; bf16_t* out; int row0, col0;
    __device__ __forceinline__ void operator()(f32x4 (&acc)[MT][4], int wr, int wc, int fr, int fq) const {
        const int hb = col0 + wc * 64;
        const bool is_q = (hb < C_AK) || (hb >= C_BQ && hb < C_BK);
        const bool is_rope = is_q || (hb >= C_AK && hb < C_AV) || (hb >= C_BK && hb < C_BV);
        const float sc = is_q ? QSCALE : 1.0f;
#pragma unroll
        for (int mt = 0; mt < MT; ++mt) {
            const int row = row0 + wr * 16 * MT + mt * 16 + fr;
            f32x4 v[4];
#pragma unroll
            for (int nt = 0; nt < 4; ++nt) v[nt] = acc[mt][nt] + *(const f32x4*)(bias + hb + nt * 16 + 4 * fq);
            if (is_rope) {
#pragma unroll
                for (int nt = 0; nt < 2; ++nt) {
                    const f32x4 c = *(const f32x4*)(cs + (size_t)row * 32 + nt * 16 + 4 * fq), s = *(const f32x4*)(sn + (size_t)row * 32 + nt * 16 + 4 * fq);
                    const f32x4 t1 = v[nt], t2 = v[nt + 2];
                    v[nt] = t1 * c - t2 * s; v[nt + 2] = t2 * c + t1 * s;
                }
            }
#pragma unroll
            for (int nt = 0; nt < 4; ++nt) {
                const f32x4 o = v[nt] * sc;
                u32x2 pk = {cvt_pk(o[0], o[1]), cvt_pk(o[2], o[3])};
                *(u32x2*)(out + (size_t)row * INW + hb + nt * 16 + 4 * fq) = pk;
            }
        }
    }
};
__device__ __forceinline__ void phase_proj(const Params& p, char* lds, int vb, int G) {
    const float* cs = (const float*)(p.ws + WS_ROPE); const float* sn = cs + (size_t)S * 32;
    constexpr int NBIG = 512, NUNITS = NBIG + 2 * 64;
    for (int u = vb; u < NUNITS; u += G) {
        G2Args g; g.A = (const char*)(p.ws + WS_XB); g.B = (const char*)(p.ws + WS_WIN); g.nk = D / 64;
        if (u < NBIG) {
            const int tm = u / 9, tn = u % 9;
            g2_rows_A<8>(g, (size_t)tm * 256, D * 2); g2_rows_B(g, (size_t)tn * 256, D * 2);
            EpiProj<8> e{p.b_in, cs, sn, (bf16_t*)(p.ws + WS_PROJ), tm * 256, tn * 256};
            gemm2<8>(lds, g, e);
        } else {
            const int t = NBIG + ((u - NBIG) >> 1), half = (u - NBIG) & 1, tm = t / 9, tn = t % 9;
            g2_rows_A<4>(g, (size_t)tm * 256 + half * 128, D * 2); g2_rows_B(g, (size_t)tn * 256, D * 2);
            EpiProj<4> e{p.b_in, cs, sn, (bf16_t*)(p.ws + WS_PROJ), tm * 256 + half * 128, tn * 256};
            gemm2<4>(lds, g, e);
        }
    }
}

template <int OFF> __device__ __forceinline__ s16x4 tr_read(int vb) { s16x4 r; asm volatile("ds_read_b64_tr_b16 %0, %1 offset:%2" : "=&v"(r) : "v"(vb), "i"(OFF) : "memory"); return r; }
__device__ __forceinline__ int v_off(int k, int c, int ndb) { return ((k >> 3) * ndb + (c >> 5)) * 512 + ((k & 7) * 32 + (c & 31)) * 2; }

constexpr int AT_STAGE = 32768;
template <int NDB, int KB, int T> struct PvPart {
    static __device__ __forceinline__ void run(f32x16& o, int vbase, const bf16x8& pa, const bf16x8& pb) {
        constexpr int o0 = (KB * 4 * NDB + T) * 512, st = NDB * 512;
        const s16x4 l0 = tr_read<o0 + 0 * st>(vbase), h0 = tr_read<o0 + 1 * st>(vbase), l1 = tr_read<o0 + 2 * st>(vbase), h1 = tr_read<o0 + 3 * st>(vbase);
        asm volatile("s_waitcnt lgkmcnt(0)" ::: "memory"); __builtin_amdgcn_sched_barrier(0);
#define PKV(L, H) (bf16x8){L[0], L[1], L[2], L[3], H[0], H[1], H[2], H[3]}
        o = __builtin_amdgcn_mfma_f32_32x32x16_bf16(PKV(l0, h0), pa, o, 0, 0, 0);
        o = __builtin_amdgcn_mfma_f32_32x32x16_bf16(PKV(l1, h1), pb, o, 0, 0, 0);
#undef PKV
    }
};
template <int NDB, int KB>
__device__ __forceinline__ void pv_half(f32x16 (&o)[NDB], f32x16& ol, int vbase, const bf16x8& pa, const bf16x8& pb) {
    const bf16x8 ones = {16256, 16256, 16256, 16256, 16256, 16256, 16256, 16256};
    ol = __builtin_amdgcn_mfma_f32_32x32x16_bf16(ones, pa, ol, 0, 0, 0);
    ol = __builtin_amdgcn_mfma_f32_32x32x16_bf16(ones, pb, ol, 0, 0, 0);
    PvPart<NDB, KB, 0>::run(o[0], vbase, pa, pb); PvPart<NDB, KB, 1>::run(o[1], vbase, pa, pb);
    if constexpr (NDB == 4) { PvPart<NDB, KB, 2>::run(o[2], vbase, pa, pb); PvPart<NDB, KB, 3>::run(o[3], vbase, pa, pb); }
}
constexpr float ATT_THR = 10.0f;
template <int NDB>
__device__ __forceinline__ void attn_scores(char* lds, int kof, const bf16x8 (&qf)[4], f32x16& s0, f32x16& s1, f32x16 (&o)[NDB], f32x16& ol, f32x16& nm, bool first, int r32, int hi) {
    s0 = nm; s1 = nm;
#pragma unroll
    for (int ds = 0; ds < 4; ++ds) {
        const bf16x8 k0 = *(const bf16x8*)(lds + kof + swz(r32, ds * 2 + hi)), k1 = *(const bf16x8*)(lds + kof + swz(32 + r32, ds * 2 + hi));
        s0 = __builtin_amdgcn_mfma_f32_32x32x16_bf16(k0, qf[ds], s0, 0, 0, 0);
        s1 = __builtin_amdgcn_mfma_f32_32x32x16_bf16(k1, qf[ds], s1, 0, 0, 0);
    }
    float mx = fmaxf(s0[0], s1[0]);
#pragma unroll
    for (int r = 1; r < 16; ++r) mx = fmaxf(fmaxf(mx, s0[r]), s1[r]);
    mx = half_max(mx);
    if (first || __any(mx > ATT_THR)) {
        const float delta = first ? mx : fmaxf(mx, 0.f), alpha = first ? 0.f : __builtin_amdgcn_exp2f(-delta);
#pragma unroll
        for (int r = 0; r < 16; ++r) { s0[r] -= delta; s1[r] -= delta; nm[r] -= delta; ol[r] *= alpha; }
#pragma unroll
        for (int t = 0; t < NDB; ++t)
#pragma unroll
            for (int r = 0; r < 16; ++r) o[t][r] *= alpha;
    }
}
__device__ __forceinline__ void exp_pack(const f32x16& s, bf16x8& pa, bf16x8& pb) {
    float e[16];
#pragma unroll
    for (int r = 0; r < 16; ++r) e[r] = __builtin_amdgcn_exp2f(s[r]);
    u32x4 a = {cvt_pk(e[0], e[1]), cvt_pk(e[2], e[3]), cvt_pk(e[4], e[5]), cvt_pk(e[6], e[7])};
    u32x4 b = {cvt_pk(e[8], e[9]), cvt_pk(e[10], e[11]), cvt_pk(e[12], e[13]), cvt_pk(e[14], e[15])};
    pa = *(bf16x8*)&a; pb = *(bf16x8*)&b;
}

__device__ __forceinline__ void attn_diff_unit(const Params& p, char* lds, int h, int qb, float lam) {
    const int tid = threadIdx.x, lane = tid & 63, w = __builtin_amdgcn_readfirstlane(tid >> 6), r32 = lane & 31, hi = lane >> 5, mp = w >> 2, wq = w & 3;
    const bf16_t* proj = (const bf16_t*)(p.ws + WS_PROJ);
    const int NT = 2 * qb + 2, myNT = (wq < 2) ? NT - 1 : NT;
    bf16x8 qf[4];
    { const bf16_t* qp = proj + (size_t)(qb * 128 + wq * 32 + r32) * INW + C_BQ + h * 128 + mp * 64 + hi * 8;
#pragma unroll
      for (int ds = 0; ds < 4; ++ds) qf[ds] = *(const bf16x8*)(qp + ds * 16); }
    asm volatile("" : "+v"(qf[0]), "+v"(qf[1]), "+v"(qf[2]), "+v"(qf[3]));
    f32x16 o[4] = {}; f32x16 ol = {}, nm = {};
    const bf16_t* gk0 = proj + (size_t)(tid >> 3) * INW + C_BK + h * 128 + (tid & 7) * 8;
    const bf16_t* gv0 = proj + (size_t)(tid >> 4) * INW + C_BV + h * 128 + (tid & 15) * 8;
    const int wk = swz(tid >> 3, tid & 7), wv0 = v_off(tid >> 4, (tid & 15) * 8, 4), wv1 = v_off(32 + (tid >> 4), (tid & 15) * 8, 4);
    const int vlane = ((lane & 3) << 3) | (((lane >> 2) & 3) << 6) | (((lane >> 4) & 1) << 5) | (((lane >> 5) & 1) << 8);
    u32x4 st0, st1, st2, st3;
#define D_LOAD(t) do { const size_t ko = (size_t)(t) * 64 * INW; st0 = *(const u32x4*)(gk0 + ko); st1 = *(const u32x4*)(gk0 + ko + 64); st2 = *(const u32x4*)(gv0 + ko); st3 = *(const u32x4*)(gv0 + ko + (size_t)32 * INW); } while (0)
#define D_WRITE(t) do { char* kb_ = lds + ((t) & 1) * 16384; char* vb_ = lds + 32768 + ((t) % 3) * 16384; *(u32x4*)(kb_ + wk) = st0; *(u32x4*)(kb_ + 8192 + wk) = st1; *(u32x4*)(vb_ + wv0) = st2; *(u32x4*)(vb_ + wv1) = st3; } while (0)
#define D_VB(t) ((int)(uintptr_t)(lds + 32768 + ((t) % 3) * 16384) + vlane)
    bf16x8 p0, p1, p2, p3; f32x16 s0, s1;
    D_LOAD(0); D_WRITE(0); D_LOAD(1); __syncthreads();
    for (int t = 0; t < NT; ++t) {

        if (mp == 1 && t >= 1 && t - 1 < myNT) { const int vb_ = D_VB(t - 1); pv_half<4, 0>(o, ol, vb_, p0, p1); pv_half<4, 1>(o, ol, vb_, p2, p3); }
        if (t < myNT) {
            attn_scores<4>(lds, (t & 1) * 16384 + mp * 8192, qf, s0, s1, o, ol, nm, t == 0, r32, hi);
            exp_pack(s0, p0, p1);
            if (mp == 0) { const int vb_ = D_VB(t); pv_half<4, 0>(o, ol, vb_, p0, p1); exp_pack(s1, p2, p3); pv_half<4, 1>(o, ol, vb_, p2, p3); }
            else exp_pack(s1, p2, p3);
        }
        if (t + 1 < NT) { D_WRITE(t + 1); if (t + 2 < NT) D_LOAD(t + 2); }
        __syncthreads();
    }
    if (mp == 1 && NT - 1 < myNT) { const int vb_ = D_VB(NT - 1); pv_half<4, 0>(o, ol, vb_, p0, p1); pv_half<4, 1>(o, ol, vb_, p2, p3); }
    __syncthreads();
#undef D_LOAD
#undef D_WRITE
#undef D_VB
    float* xb = (float*)lds;
    const float il = 1.0f / ol[0];
    if (mp == 1) {
        const float f = il * lam;
#pragma unroll
        for (int t = 0; t < 4; ++t)
#pragma unroll
            for (int r = 0; r < 16; ++r) xb[(wq * 64 + t * 16 + r) * 64 + lane] = o[t][r] * f;
    }
    __syncthreads();
    if (mp == 0) {
        float ss = 0.f;
#pragma unroll
        for (int t = 0; t < 4; ++t)
#pragma unroll
            for (int r = 0; r < 16; ++r) { const float v = o[t][r] * il - xb[(wq * 64 + t * 16 + r) * 64 + lane]; o[t][r] = v; ss += v * v; }
        ss = half_sum(ss);
        const float rs = rsqrtf(ss * (1.0f / 128.0f) + LN_EPS) * 0.8f;
        bf16_t* op = (bf16_t*)(p.ws + WS_ATT) + (size_t)(qb * 128 + wq * 32 + r32) * D + 512 + h * 128;
#pragma unroll
        for (int t = 0; t < 4; ++t)
#pragma unroll
            for (int rr = 0; rr < 4; ++rr) {
                const int dv0 = 32 * t + 8 * rr + 4 * hi;
                const f32x4 gg = *(const f32x4*)(p.subg + dv0);
                u32x2 pk = {cvt_pk(o[t][4 * rr] * rs * gg[0], o[t][4 * rr + 1] * rs * gg[1]), cvt_pk(o[t][4 * rr + 2] * rs * gg[2], o[t][4 * rr + 3] * rs * gg[3])};
                *(u32x2*)(op + dv0) = pk;
            }
    }
    __syncthreads();
}
__device__ __forceinline__ void attn_swa_unit(const Params& p, char* lds, int kvh, int n) {
    const int tid = threadIdx.x, lane = tid & 63, w = __builtin_amdgcn_readfirstlane(tid >> 6), r32 = lane & 31, hi = lane >> 5, g = w >> 1, hq = kvh * 4 + g;
    const bf16_t* proj = (const bf16_t*)(p.ws + WS_PROJ);
    const int c0 = (n >= 2) ? n - 2 : 0, NT = n - c0 + 1;
    const int tok = n * 64 + (w & 1) * 32 + r32;
    bf16x8 qf[4];
    { const bf16_t* qp = proj + (size_t)tok * INW + C_AQ + hq * 64 + hi * 8;
#pragma unroll
      for (int ds = 0; ds < 4; ++ds) qf[ds] = *(const bf16x8*)(qp + ds * 16); }
    f32x16 o[2] = {}; f32x16 ol, nm;
    { float ms = -p.sinks[hq] * LOG2E; asm volatile("" : "+v"(qf[0]), "+v"(qf[1]), "+v"(qf[2]), "+v"(qf[3]), "+v"(ms));
#pragma unroll
      for (int r = 0; r < 16; ++r) { nm[r] = ms; ol[r] = 1.0f; } }
    const bf16_t* gk = proj + (size_t)(c0 * 64 + (tid >> 3)) * INW + C_AK + kvh * 64 + (tid & 7) * 8;
    const bf16_t* gv = proj + (size_t)(c0 * 64 + (tid >> 3)) * INW + C_AV + kvh * 64 + (tid & 7) * 8;
    const int wk = swz(tid >> 3, tid & 7), wv = v_off(tid >> 3, (tid & 7) * 8, 2);
    const int vlane = ((lane & 3) << 3) | (((lane >> 2) & 3) << 6) | (((lane >> 4) & 1) << 5) | (((lane >> 5) & 1) << 8);
    u32x4 st0, st1;
#define W_LOAD(t) do { const size_t ko = (size_t)(t) * 64 * INW; st0 = *(const u32x4*)(gk + ko); st1 = *(const u32x4*)(gv + ko); } while (0)
#define W_WRITE(b) do { char* sb = lds + (b) * AT_STAGE; *(u32x4*)(sb + wk) = st0; *(u32x4*)(sb + 8192 + wv) = st1; } while (0)
    W_LOAD(0); W_WRITE(0); __syncthreads();
    for (int t = 0; t < NT; ++t) {
        const int b = t & 1;
        if (t + 1 < NT) W_LOAD(t + 1);
        { f32x16 s0, s1; bf16x8 p0, p1, p2, p3; const int vb_ = (int)(uintptr_t)(lds + b * AT_STAGE + 8192) + vlane;
          attn_scores<2>(lds, b * AT_STAGE, qf, s0, s1, o, ol, nm, false, r32, hi);
          exp_pack(s0, p0, p1); pv_half<2, 0>(o, ol, vb_, p0, p1); exp_pack(s1, p2, p3); pv_half<2, 1>(o, ol, vb_, p2, p3); }
        if (t + 1 < NT) W_WRITE(b ^ 1);
        __syncthreads();
    }
#undef W_LOAD
#undef W_WRITE
    const float il = 1.0f / ol[0];
    bf16_t* op = (bf16_t*)(p.ws + WS_ATT) + (size_t)tok * D + hq * 64;
#pragma unroll
    for (int t = 0; t < 2; ++t)
#pragma unroll
        for (int rr = 0; rr < 4; ++rr) {
            const int dv0 = 32 * t + 8 * rr + 4 * hi;
            u32x2 pk = {cvt_pk(o[t][4 * rr] * il, o[t][4 * rr + 1] * il), cvt_pk(o[t][4 * rr + 2] * il, o[t][4 * rr + 3] * il)};
            *(u32x2*)(op + dv0) = pk;
        }
}
__device__ __forceinline__ void phase_attn(const Params& p, char* lds, int vb, int G) {
    const int lane = threadIdx.x & 63;
    const float d1 = wave_sum(p.lq1[lane] * p.lk1[lane]), d2 = wave_sum(p.lq2[lane] * p.lk2[lane]);
    const float lam = expf(d1) - expf(d2) + 0.2f;
    for (int u = vb; u < 1024; u += G) {
        if (u < 256) attn_diff_unit(p, lds, u >> 6, 127 - (u & 63), lam);
        else if (u < 512) attn_diff_unit(p, lds, (u - 256) >> 6, (u - 256) & 63, lam);
        else attn_swa_unit(p, lds, (u - 512) >> 8, (u - 512) & 255);
    }
}

struct EpiPreLn {
    const float* x; float* out; int row0, col0;
    __device__ __forceinline__ void operator()(f32x4 (&acc)[8][4], int wr, int wc, int fr, int fq) const {
#pragma unroll
        for (int mt = 0; mt < 8; ++mt) {
            const size_t ro = (size_t)(row0 + wr * 128 + mt * 16 + fr) * D + col0 + wc * 64 + 4 * fq;
#pragma unroll
            for (int nt = 0; nt < 4; ++nt) { const f32x4 xv = *(const f32x4*)(x + ro + nt * 16); *(f32x4*)(out + ro + nt * 16) = xv * ALPHA + acc[mt][nt]; }
        }
    }
};
__device__ __forceinline__ void phase_wout(const Params& p, char* lds, int vb, int G) {
    for (int u = vb; u < (S / 256) * 4; u += G) {
        const int tm = u >> 2, tn = u & 3;
        G2Args g; g.A = (const char*)(p.ws + WS_ATT); g.B = (const char*)(p.ws + WS_WOUT); g.nk = D / 64;
        g2_rows_A<8>(g, (size_t)tm * 256, D * 2); g2_rows_B(g, (size_t)tn * 256, D * 2);
        EpiPreLn e{p.x, (float*)(p.ws + WS_PRELN), tm * 256, tn * 256};
        gemm2<8>(lds, g, e);
    }
}

struct EpiLogits {
    float* L;
    __device__ __forceinline__ void operator()(f32x4 (&acc)[4][4], int wr, int wc, int fr, int fq) const {
#pragma unroll
        for (int mt = 0; mt < 4; ++mt)
#pragma unroll
            for (int nt = 0; nt < 4; ++nt) *(f32x4*)(L + (wr * 64 + mt * 16 + fr) * 256 + wc * 64 + nt * 16 + 4 * fq) = acc[mt][nt];
    }
};
__device__ __forceinline__ void phase_router(const Params& p, char* lds, int vb, int G) {
    const int tid = threadIdx.x, lane = tid & 63, w = tid >> 6;
    const float* preln = (const float*)(p.ws + WS_PRELN);
    float* x1f = (float*)(p.ws + WS_X1F); bf16_t* x1b = (bf16_t*)(p.ws + WS_X1B);
    unsigned* cnt = (unsigned*)(p.ws + WS_CTL); int* list = (int*)(p.ws + WS_LIST); float* gates = (float*)(p.ws + WS_GATE);
    for (int u = vb; u < S / 128; u += G) {
        for (int i = 0; i < 16; ++i) {
            const int row = u * 128 + w * 16 + i;
            const f32x4* xr = (const f32x4*)(preln + (size_t)row * D) + lane;
            f32x4 v[4]; float s = 0.f;
#pragma unroll
            for (int j = 0; j < 4; ++j) { v[j] = xr[64 * j]; s += (v[j][0] + v[j][1]) + (v[j][2] + v[j][3]); }
            const float mean = wave_sum(s) * (1.0f / D); float s2 = 0.f;
#pragma unroll
            for (int j = 0; j < 4; ++j) { v[j] = v[j] - mean; s2 += (v[j][0] * v[j][0] + v[j][1] * v[j][1]) + (v[j][2] * v[j][2] + v[j][3] * v[j][3]); }
            const float rstd = rsqrtf(wave_sum(s2) * (1.0f / D) + LN_EPS);
#pragma unroll
            for (int j = 0; j < 4; ++j) {
                const f32x4 gg = *((const f32x4*)p.ln1g + lane + 64 * j), bb = *((const f32x4*)p.ln1b + lane + 64 * j);
                const f32x4 y = v[j] * rstd * gg + bb;
                *((f32x4*)(x1f + (size_t)row * D) + lane + 64 * j) = y;
                u32x2 pk = {cvt_pk(y[0], y[1]), cvt_pk(y[2], y[3])};
                *((u32x2*)(x1b + (size_t)row * D) + lane + 64 * j) = pk;
            }
        }
        asm volatile("s_waitcnt vmcnt(0)" ::: "memory");
        __syncthreads();
        { G2Args g; g.A = (const char*)x1b; g.B = (const char*)(p.ws + WS_WR); g.nk = D / 64;
          g2_rows_A<4>(g, (size_t)u * 128, D * 2); g2_rows_B(g, 0, D * 2);
          EpiLogits e{(float*)lds};
          gemm2<4>(lds, g, e); }
        __syncthreads();
        const f32x4 rb = *((const f32x4*)p.r_bias + lane);
        const float NEG = -__builtin_inff();
        for (int i = 0; i < 16; ++i) {
            const int tl = w * 16 + i, t = u * 128 + tl;
            const f32x4 lg = *((const f32x4*)((const float*)lds + tl * 256) + lane);
            float sc[4], cand[4];
#pragma unroll
            for (int j = 0; j < 4; ++j) { sc[j] = 1.0f / (1.0f + expf(-lg[j])); cand[j] = sc[j] + rb[j]; }
            float a1, a2;
            { const float m01 = fmaxf(cand[0], cand[1]), n01 = fminf(cand[0], cand[1]), m23 = fmaxf(cand[2], cand[3]), n23 = fminf(cand[2], cand[3]);
              a1 = fmaxf(m01, m23); a2 = fmaxf(fminf(m01, m23), fmaxf(n01, n23)); }
#pragma unroll
            for (int off = 1; off < 8; off <<= 1) { const float b1 = __shfl_xor(a1, off), b2 = __shfl_xor(a2, off); const float n1 = fmaxf(a1, b1), n2 = fmaxf(fminf(a1, b1), fmaxf(a2, b2)); a1 = n1; a2 = n2; }
            const float gs = a1 + a2; const int mygrp = lane >> 3; int rank = 0;
#pragma unroll
            for (int g2 = 0; g2 < 8; ++g2) { const float v = __shfl(gs, g2 * 8); rank += (v > gs || (v == gs && g2 < mygrp)) ? 1 : 0; }
            if (rank >= 4) {
#pragma unroll
                for (int j = 0; j < 4; ++j) cand[j] = NEG;
            }
            int my_e = 0; float my_s = 0.f, gsum = 0.f;
#pragma unroll
            for (int k = 0; k < 8; ++k) {
                float bv = cand[0]; int bi = 0;
#pragma unroll
                for (int j = 1; j < 4; ++j) if (cand[j] > bv) { bv = cand[j]; bi = j; }
                int idx = 4 * lane + bi;
#pragma unroll
                for (int off = 32; off >= 1; off >>= 1) { const float ov = __shfl_xor(bv, off); const int oi = __shfl_xor(idx, off); if (ov > bv || (ov == bv && oi < idx)) { bv = ov; idx = oi; } }
                const int owner = idx >> 2, sub = idx & 3;
                float scv = sc[0];
#pragma unroll
                for (int j = 1; j < 4; ++j) scv = (sub == j) ? sc[j] : scv;
                if (lane == owner) {
#pragma unroll
                    for (int j = 0; j < 4; ++j) if (sub == j) cand[j] = NEG;
                }
                const float gsc = __shfl(scv, owner);
                if (lane == k) { my_e = idx; my_s = gsc; }
                gsum += gsc;
            }
            if (lane < 8) {
                const float gate = my_s / gsum * 2.5f;
                const unsigned pos = atomicAdd(cnt + my_e, 1u);
                list[(size_t)my_e * CAP + pos] = t * 8 + lane;
                gates[t * 8 + lane] = gate;
            }
        }
        __syncthreads();
    }
}

#ifndef MOE_MT
#define MOE_MT 8
#endif
constexpr int MOE_BM = 32 * MOE_MT;
struct EpiAct {
    bf16_t* act; const int* slots; int ncol0;
    __device__ __forceinline__ void operator()(f32x4 (&acc)[MOE_MT][4], int wr, int wc, int fr, int fq) const {
#pragma unroll
        for (int mt = 0; mt < MOE_MT; ++mt) {
            const int ar = slots[wr * 16 * MOE_MT + mt * 16 + fr];
            if (ar >= 0) {
#pragma unroll
                for (int nt = 0; nt < 2; ++nt) {
                    const f32x4 gv = acc[mt][nt], uv = acc[mt][nt + 2]; float a[4];
#pragma unroll
                    for (int j = 0; j < 4; ++j) a[j] = gv[j] / (1.0f + __expf(-gv[j])) * uv[j];
                    u32x2 pk = {cvt_pk(a[0], a[1]), cvt_pk(a[2], a[3])};
                    *(u32x2*)(act + (size_t)ar * FF + ncol0 + wc * 32 + nt * 16 + 4 * fq) = pk;
                }
            }
        }
    }
};
struct EpiY {
    bf16_t* y; const int* yrows; const float* gl; int col0;
    __device__ __forceinline__ void operator()(f32x4 (&acc)[MOE_MT][4], int wr, int wc, int fr, int fq) const {
#pragma unroll
        for (int mt = 0; mt < MOE_MT; ++mt) {
            const int r = wr * 16 * MOE_MT + mt * 16 + fr, yr = yrows[r];
            if (yr >= 0) {
                const float gt = gl[r];
#pragma unroll
                for (int nt = 0; nt < 4; ++nt) {
                    const f32x4 v = acc[mt][nt] * gt;
                    u32x2 pk = {cvt_pk(v[0], v[1]), cvt_pk(v[2], v[3])};
                    *(u32x2*)(y + (size_t)yr * D + col0 + wc * 64 + nt * 16 + 4 * fq) = pk;
                }
            }
        }
    }
};
__device__ __forceinline__ void phase_experts(const Params& p, char* lds, int vb, int G) {
    const int tid = threadIdx.x, lane = tid & 63, w = __builtin_amdgcn_readfirstlane(tid >> 6);
    const unsigned* cnt = (const unsigned*)(p.ws + WS_CTL); const int* list = (const int*)(p.ws + WS_LIST); const float* gates = (const float*)(p.ws + WS_GATE);
    bf16_t* act = (bf16_t*)(p.ws + WS_ACT); bf16_t* ybuf = (bf16_t*)(p.ws + WS_Y);
    int* nts = (int*)(lds + LDS_MISC); int* pre = nts + 256;
    int* s_arow = pre + 260; int* s_yrow = s_arow + MOE_BM; int* s_tok = s_yrow + MOE_BM; float* s_gate = (float*)(s_tok + MOE_BM);
    if (tid < 256) nts[tid] = (int)((__hip_atomic_load(cnt + tid, __ATOMIC_RELAXED, __HIP_MEMORY_SCOPE_AGENT) + (MOE_BM - 1)) / MOE_BM);
    __syncthreads();
    if (tid < 257) { int s = 0; for (int e = 0; e < tid; ++e) s += nts[e]; pre[tid] = s; }
    __syncthreads();
    const int NR = pre[256], NU = NR + S / MOE_BM;
    const unsigned co = g2_chunk_off(lane, w);
    for (int u = vb; u < NU; u += G) {
        __syncthreads();
        const float *wg, *wu, *wd;
        if (u < NR) {
            int lo = 0, hi = 255;
            while (lo < hi) { const int mid = (lo + hi + 1) >> 1; if (pre[mid] <= u) lo = mid; else hi = mid - 1; }
            const int e = lo, tile = u - pre[e], n = (int)__hip_atomic_load(cnt + e, __ATOMIC_RELAXED, __HIP_MEMORY_SCOPE_AGENT);
            if (tid < MOE_BM) {
                const int idx = tile * MOE_BM + tid;
                if (idx < n) { const int slot = list[(size_t)e * CAP + idx]; s_arow[tid] = slot; s_yrow[tid] = slot + (slot >> 3); s_tok[tid] = slot >> 3; s_gate[tid] = gates[slot]; }
                else { s_arow[tid] = -1; s_yrow[tid] = -1; s_tok[tid] = 0; s_gate[tid] = 0.f; }
            }
            wg = p.w_g + (size_t)e * D * FF; wu = p.w_u + (size_t)e * D * FF; wd = p.w_d + (size_t)e * FF * D;
        } else {
            const int tile = u - NR;
            if (tid < MOE_BM) { const int tk = tile * MOE_BM + tid; s_arow[tid] = S * 8 + tk; s_yrow[tid] = tk * 9 + 8; s_tok[tid] = tk; s_gate[tid] = 1.0f; }
            wg = p.ws_g; wu = p.ws_u; wd = p.ws_d;
        }
        __syncthreads();
        for (int np = 0; np < 2; ++np) {
            G3Args g; g.A = (const char*)(p.ws + WS_X1B); g.nk = D / 64; g.ldb = FF;
#pragma unroll
            for (int i = 0; i < MOE_MT / 2; ++i) g.offA[i] = (unsigned)s_tok[i * 64 + w * 8 + (lane >> 3)] * (unsigned)(D * 2) + co;
            { const int n0 = 4 * lane, bwc = n0 >> 6, sub = n0 & 63;
              const float* bsrc = (sub < 32) ? (wg + np * 128 + bwc * 32 + sub) : (wu + np * 128 + bwc * 32 + (sub - 32));
              g.b = bsrc + (size_t)(w * 8) * FF; }
            EpiAct e{act, s_arow, np * 128};
            gemm3<MOE_MT>(lds, g, e);
        }
        asm volatile("s_waitcnt vmcnt(0)" ::: "memory");
        __syncthreads();
        for (int np = 0; np < 4; ++np) {
            G3Args g; g.A = (const char*)act; g.nk = FF / 64; g.ldb = D;
#pragma unroll
            for (int i = 0; i < MOE_MT / 2; ++i) { const int ar = s_arow[i * 64 + w * 8 + (lane >> 3)]; g.offA[i] = (unsigned)(ar < 0 ? 0 : ar) * (unsigned)(FF * 2) + co; }
            g.b = wd + (size_t)(w * 8) * D + np * 256 + 4 * lane;
            EpiY e{ybuf, s_yrow, s_gate, np * 256};
            gemm3<MOE_MT>(lds, g, e);
        }
    }
}

__device__ __forceinline__ void phase_final(const Params& p, int vb, int G) {
    const int lane = threadIdx.x & 63, w = threadIdx.x >> 6;
    const float* x1f = (const float*)(p.ws + WS_X1F); const bf16_t* ybuf = (const bf16_t*)(p.ws + WS_Y);
    for (int row = vb * 8 + w; row < S; row += G * 8) {
        f32x4 v[4]; float s = 0.f;
#pragma unroll
        for (int j = 0; j < 4; ++j) v[j] = *((const f32x4*)(x1f + (size_t)row * D) + lane + 64 * j) * ALPHA;
#pragma unroll
        for (int k = 0; k < 9; ++k) {
            const u32x2* yr = (const u32x2*)(ybuf + (size_t)(row * 9 + k) * D) + lane;
#pragma unroll
            for (int j = 0; j < 4; ++j) { const u32x2 q = yr[64 * j]; v[j][0] += bf_lo(q[0]); v[j][1] += bf_hi(q[0]); v[j][2] += bf_lo(q[1]); v[j][3] += bf_hi(q[1]); }
        }
#pragma unroll
        for (int j = 0; j < 4; ++j) s += (v[j][0] + v[j][1]) + (v[j][2] + v[j][3]);
        const float mean = wave_sum(s) * (1.0f / D); float s2 = 0.f;
#pragma unroll
        for (int j = 0; j < 4; ++j) { v[j] = v[j] - mean; s2 += (v[j][0] * v[j][0] + v[j][1] * v[j][1]) + (v[j][2] * v[j][2] + v[j][3] * v[j][3]); }
        const float rstd = rsqrtf(wave_sum(s2) * (1.0f / D) + LN_EPS);
#pragma unroll
        for (int j = 0; j < 4; ++j) {
            const f32x4 gg = *((const f32x4*)p.ln2g + lane + 64 * j), bb = *((const f32x4*)p.ln2b + lane + 64 * j);
            *((f32x4*)(p.out + (size_t)row * D) + lane + 64 * j) = v[j] * rstd * gg + bb;
        }
    }
}

__global__ void __launch_bounds__(NTHREADS) mega(Params p) {
    extern __shared__ __attribute__((aligned(16))) char lds[];
    const int G = gridDim.x, bx = blockIdx.x;
    const int vb = (G % 8 == 0) ? (bx % 8) * (G / 8) + bx / 8 : bx;
    if (threadIdx.x < 4) ((volatile LAS unsigned*)((LAS char*)lds + LDS_BARST))[threadIdx.x] = 0u;
    __syncthreads();
    XcdBarrier bar; bar.bar = (unsigned*)(p.ws + WS_CTL) + CW_BAR; bar.x = 0; bar.st = nullptr;
    if (p.ph_hi - p.ph_lo > 1) bar = xcd_barrier_post((unsigned*)(p.ws + WS_CTL) + CW_BAR, (volatile LAS unsigned*)((LAS char*)lds + LDS_BARST));
#define SEAM(k) do { if (p.ph_lo <= (k) && (k) + 1 < p.ph_hi) { xcd_barrier(bar); } } while (0)
#define IN(k) (p.ph_lo <= (k) && (k) < p.ph_hi)
#define RUN(k, call) do { if (IN(k)) { call; if (MK_REPEAT == (k)) { __syncthreads(); call; } } } while (0)
    RUN(0, phase_prep(p, vb, G)); SEAM(0);
    RUN(1, phase_proj(p, lds, vb, G)); SEAM(1);
    RUN(2, phase_attn(p, lds, vb, G)); SEAM(2);
    RUN(3, phase_wout(p, lds, vb, G)); SEAM(3);
    if (IN(4)) { phase_router(p, lds, vb, G); } SEAM(4);
    RUN(5, phase_experts(p, lds, vb, G)); SEAM(5);
    RUN(6, phase_final(p, vb, G));
#undef SEAM
#undef IN
#undef RUN
}

extern "C" void kernel_launch(void* const* d_in, const int* in_sizes, int n_in, void* d_out, int out_size, void* d_ws, size_t ws_size, hipStream_t stream) {
    static int grid = 0;
    if (grid == 0) {
        if (n_in != 22 || in_sizes[0] != S * D || out_size != S * D || ws_size < WS_END) {
            fprintf(stderr, "kernel_launch: unexpected shapes: n_in %d in0 %d out %d ws %zu (need %zu)\n", n_in, n_in > 0 ? in_sizes[0] : -1, out_size, ws_size, (size_t)WS_END); grid = -1; return; }
        int dev = 0, cus = 0, per_cu = 0;
        (void)hipGetDevice(&dev); (void)hipDeviceGetAttribute(&cus, hipDeviceAttributeMultiprocessorCount, dev);
        if (hipFuncSetAttribute((const void*)mega, hipFuncAttributeMaxDynamicSharedMemorySize, LDS_BYTES) != hipSuccess) { fprintf(stderr, "kernel_launch: hipFuncSetAttribute failed\n"); grid = -1; return; }
        (void)hipOccupancyMaxActiveBlocksPerMultiprocessor(&per_cu, (const void*)mega, NTHREADS, LDS_BYTES);
        if (per_cu < 1) { fprintf(stderr, "kernel_launch: occupancy query says %d blocks per CU\n", per_cu); per_cu = 1; }
        grid = cus * 1;
        (void)hipGetLastError();
    }
    if (grid < 0) return;
    (void)hipMemsetAsync((char*)d_ws + WS_CTL, 0, CTL_BYTES, stream);
    Params p{};
    const float** f = (const float**)&p;
    for (int i = 0; i < 22; ++i) f[i] = (const float*)d_in[i];
    p.out = (float*)d_out; p.ws = (unsigned char*)d_ws;
#if MK_ONE_LAUNCH
    p.ph_lo = 0; p.ph_hi = 7;
    void* args[] = {&p};
    hipError_t e = hipLaunchCooperativeKernel((const void*)mega, dim3(grid), dim3(NTHREADS), args, LDS_BYTES, stream);
    if (e != hipSuccess) fprintf(stderr, "kernel_launch: cooperative launch failed: %s (grid %d)\n", hipGetErrorString(e), grid);
#else
    for (int ph = 0; ph < 7; ++ph) {
        p.ph_lo = ph; p.ph_hi = ph + 1;
        hipLaunchKernelGGL(mega, dim3(grid), dim3(NTHREADS), LDS_BYTES, stream, p);
    }
#endif
}
```

```cpp
#include <hip/hip_runtime.h>
#include <hip/hip_cooperative_groups.h>
#include <cstdio>
#include <cstdint>
namespace cg = cooperative_groups;

#ifndef MK_REPEAT
#define MK_REPEAT -1
#endif
#ifndef MK_ONE_LAUNCH
#define MK_ONE_LAUNCH 1
#endif

constexpr int S = 16384, D = 1024, INW = 2304, NE = 256, FF = 256;
constexpr int NTHREADS = 512;
constexpr int CAP = 16384;
constexpr float ALPHA = 1.189207115002721f;
constexpr float LN_EPS = 1e-5f;
constexpr float QSCALE = 0.125f * 1.4426950408889634f;
constexpr float LOG2E = 1.4426950408889634f;
constexpr int C_AQ = 0, C_AK = 512, C_AV = 640, C_BQ = 768, C_BK = 1280, C_BV = 1792;

constexpr size_t MiB = 1ull << 20;
constexpr size_t WS_CTL = 0;
constexpr size_t CTL_BYTES = 64 * 1024;
constexpr size_t WS_ROPE = 1 * MiB;
constexpr size_t WS_WIN = 8 * MiB;
constexpr size_t WS_WOUT = 13 * MiB;
constexpr size_t WS_WR = 15 * MiB;
constexpr size_t WS_WSGU = 16 * MiB;
constexpr size_t WS_WSD = 17 * MiB;
constexpr size_t WS_EGU = 20 * MiB;
constexpr size_t WS_ED = 276 * MiB;
constexpr size_t WS_X1F = 404 * MiB;
constexpr size_t WS_X1B = 468 * MiB;
constexpr size_t WS_LIST = 500 * MiB;
constexpr size_t WS_GATE = 516 * MiB;
constexpr size_t WS_ACT = 518 * MiB;
constexpr size_t WS_Y = 590 * MiB;
constexpr size_t WS_XB = 590 * MiB;
constexpr size_t WS_PROJ = 622 * MiB;
constexpr size_t WS_ATT = 694 * MiB;
constexpr size_t WS_PRELN = 726 * MiB;
constexpr size_t WS_END = 878 * MiB;

constexpr int LDS_BYTES = 147456;
constexpr int LDS_MISC = 131072;

typedef unsigned short bf16_t;
typedef short bf16x8 __attribute__((ext_vector_type(8)));
typedef short s16x4 __attribute__((ext_vector_type(4)));
typedef float f32x4 __attribute__((ext_vector_type(4)));
typedef float f32x16 __attribute__((ext_vector_type(16)));
typedef unsigned u32x4 __attribute__((ext_vector_type(4)));
typedef unsigned u32x2 __attribute__((ext_vector_type(2)));
typedef float f32x2 __attribute__((ext_vector_type(2)));


#define LAS __attribute__((address_space(3)))
#define XB_TMO      128
#define XB_XCNT(j)  (256  + 64 * (j))
#define XB_XSUB(j)  (1280 + 64 * (j))
#define XB_XGEN(j)  (2304 + 64 * (j))
#define XB_TOP      3328
#define XB_TOPGEN   3392
#define XCD_BAR_WORDS 3456
#define XB_SPIN_CAP (1u << 18)
__device__ __forceinline__ unsigned xb_ld(unsigned* p)              { return __hip_atomic_load(p, __ATOMIC_RELAXED, __HIP_MEMORY_SCOPE_AGENT); }
__device__ __forceinline__ unsigned xb_add(unsigned* p, unsigned v) { return __hip_atomic_fetch_add(p, v, __ATOMIC_RELAXED, __HIP_MEMORY_SCOPE_AGENT); }
__device__ __forceinline__ unsigned xb_xcc_id() { return (unsigned)__builtin_amdgcn_s_getreg((3 << 11) | 20) & 0xFu; }
#define XB_SPIN(cond, bar) do { unsigned _sp = 0; while (cond) { __builtin_amdgcn_s_sleep(1); \
    if ((++_sp & 255u) == 0u) { if (xb_ld(&(bar)[XB_TMO])) break; if (_sp > XB_SPIN_CAP) { atomicAdd(&(bar)[XB_TMO], 1u); break; } } } } while (0)
struct XcdBarrier { unsigned* bar; unsigned x; volatile LAS unsigned* st; };
__device__ __forceinline__ XcdBarrier xcd_barrier_post(unsigned* bar, volatile LAS unsigned* st) {
    XcdBarrier b; b.bar = bar; b.x = xb_xcc_id(); b.st = st;
    if (threadIdx.x == 0) (void)xb_add(&bar[XB_XCNT(b.x)], 1u);
    return b;
}
__device__ __forceinline__ void xcd_barrier_complete(unsigned* bar, unsigned x, unsigned& nloc, unsigned& nx) {
    const unsigned G = gridDim.x * gridDim.y * gridDim.z;
    unsigned sum, cnt, mine, sp = 0u;
    for (;;) {
        sum = 0u; cnt = 0u; mine = 0u;
#pragma unroll
        for (unsigned j = 0; j < 16; ++j) { const unsigned c = xb_ld(&bar[XB_XCNT(j)]); sum += c; cnt += (c > 0u) ? 1u : 0u; mine = (j == x) ? c : mine; }
        if (sum == G) break;
        __builtin_amdgcn_s_sleep(1);
        if ((++sp & 255u) == 0u) { if (xb_ld(&bar[XB_TMO])) break; if (sp > XB_SPIN_CAP) { atomicAdd(&bar[XB_TMO], 1u); break; } }
    }
    nloc = mine > 0u ? mine : 1u; nx = cnt > 0u ? cnt : 1u;
}
__device__ __forceinline__ void xcd_barrier(const XcdBarrier& b) {
    asm volatile("s_waitcnt vmcnt(0)" ::: "memory");
    __syncthreads();
    if (threadIdx.x == 0) {
        unsigned* bar = b.bar;
        __builtin_amdgcn_s_waitcnt(0);
        unsigned nloc = b.st[0], nx = b.st[1];
        if (nloc == 0u) { xcd_barrier_complete(bar, b.x, nloc, nx); b.st[0] = nloc; b.st[1] = nx; }
        const unsigned old = xb_add(&bar[XB_XSUB(b.x)], 1u);
        const unsigned gen = old / nloc;
        if (old + 1u == (gen + 1u) * nloc) {
            __builtin_amdgcn_fence(__ATOMIC_RELEASE, "agent");
            asm volatile("s_waitcnt vmcnt(0)" ::: "memory");
            const unsigned og = xb_add(&bar[XB_TOP], 1u);
            const unsigned tg = og / nx;
            if (og + 1u == (tg + 1u) * nx) xb_add(&bar[XB_TOPGEN], 1u);
            else XB_SPIN(xb_ld(&bar[XB_TOPGEN]) == tg, bar);
            __builtin_amdgcn_fence(__ATOMIC_ACQUIRE, "agent");
            xb_add(&bar[XB_XGEN(b.x)], 1u);
            asm volatile("s_waitcnt vmcnt(0)" ::: "memory");
        } else {
            XB_SPIN(xb_ld(&bar[XB_XGEN(b.x)]) == gen, bar);
            __builtin_amdgcn_fence(__ATOMIC_ACQUIRE, "agent");
            asm volatile("s_waitcnt vmcnt(0)" ::: "memory");
        }
    }
    __syncthreads();
}
constexpr int CW_BAR = 4096;
constexpr int LDS_BARST = LDS_MISC + 8192;

struct Params {
    const float* x; const float* w_in; const float* b_in; const float* sinks;
    const float* lq1; const float* lk1; const float* lq2; const float* lk2; const float* subg;
    const float* w_out; const float* ln1g; const float* ln1b; const float* w_r; const float* r_bias;
    const float* w_g; const float* w_u; const float* w_d; const float* ws_g; const float* ws_u; const float* ws_d;
    const float* ln2g; const float* ln2b;
    float* out; unsigned char* ws;
    int ph_lo, ph_hi;
};

__device__ __forceinline__ unsigned cvt_pk(float lo, float hi) { unsigned r; asm volatile("v_cvt_pk_bf16_f32 %0, %1, %2" : "=v"(r) : "v"(lo), "v"(hi)); return r; }
constexpr float W8_SCALE = 256.0f, W8_INV = 1.0f / 256.0f;
__device__ __forceinline__ unsigned pack_fp8x4(f32x4 v) {
    v = v * W8_SCALE;
#pragma unroll
    for (int i = 0; i < 4; ++i) v[i] = fminf(fmaxf(v[i], -448.0f), 448.0f);
    int w = 0; w = __builtin_amdgcn_cvt_pk_fp8_f32(v[0], v[1], w, false); w = __builtin_amdgcn_cvt_pk_fp8_f32(v[2], v[3], w, true); return (unsigned)w;
}
__device__ __forceinline__ float bf_lo(unsigned u) { return __uint_as_float(u << 16); }
__device__ __forceinline__ float bf_hi(unsigned u) { return __uint_as_float(u & 0xffff0000u); }
__device__ __forceinline__ float wave_sum(float v) {
#pragma unroll
    for (int o = 1; o < 64; o <<= 1) v += __shfl_xor(v, o);
    return v;
}
__device__ __forceinline__ float half_max(float v) { auto rr = __builtin_amdgcn_permlane32_swap(__float_as_uint(v), __float_as_uint(v), false, false); return fmaxf(__uint_as_float(rr[0]), __uint_as_float(rr[1])); }
__device__ __forceinline__ float half_sum(float v) { auto rr = __builtin_amdgcn_permlane32_swap(__float_as_uint(v), __float_as_uint(v), false, false); return __uint_as_float(rr[0]) + __uint_as_float(rr[1]); }

__device__ __forceinline__ int swz(int r, int c) { const int f = (r & 7) ^ (((r >> 3) & 1) << 1) ^ ((r >> 4) & 1); return r * 128 + ((c ^ f) << 4); }

struct G2Args {
    const char* A; const char* B;
    unsigned offA[4], offB[4];
    int nk;
    unsigned akstep;
};
__device__ __forceinline__ unsigned g2_chunk_off(int lane, int w) { const int f = (lane >> 3) ^ ((w & 1) << 1) ^ ((w >> 1) & 1); return (unsigned)(((lane & 7) ^ f) << 4); }
template <int MT, class Epi>
__device__ __forceinline__ void gemm2(char* lds_, const G2Args& g, const Epi& epi) {
    constexpr int A_BYTES = 32 * MT * 128, B_BYTES = 256 * 128, STAGE = A_BYTES + B_BYTES, AR = MT / 2;
    LAS char* lds = (LAS char*)lds_;
    const int tid = threadIdx.x, lane = tid & 63, w = __builtin_amdgcn_readfirstlane(tid >> 6), wr = w >> 2, wc = w & 3, fr = lane & 15, fq = lane >> 4;
    f32x4 acc[MT][4];
#pragma unroll
    for (int i = 0; i < MT; ++i)
#pragma unroll
        for (int j = 0; j < 4; ++j) acc[i][j] = (f32x4){0.f, 0.f, 0.f, 0.f};
    const int ldsw = w * 1024;
#define G2_STAGE(kt, s) do { \
        _Pragma("unroll") for (int i = 0; i < AR; ++i) __builtin_amdgcn_global_load_lds((const unsigned*)(g.A + g.offA[i] + (size_t)(kt) * g.akstep), (LAS unsigned*)(lds + (s) * STAGE + i * 8192 + ldsw), 16, 0, 0); \
        _Pragma("unroll") for (int i = 0; i < 4; ++i) __builtin_amdgcn_global_load_lds((const unsigned*)(g.B + g.offB[i] + (size_t)(kt) * 128), (LAS unsigned*)(lds + (s) * STAGE + A_BYTES + i * 8192 + ldsw), 16, 0, 0); } while (0)
    G2_STAGE(0, 0);
    __syncthreads();
    for (int kt = 0; kt < g.nk; ++kt) {
        const int s = kt & 1;
        if (kt + 1 < g.nk) { if (s) G2_STAGE(kt + 1, 0); else G2_STAGE(kt + 1, 1); }
        const char* la = lds_ + s * STAGE; const char* lb = la + A_BYTES;
        {
            constexpr int NG = 2 * (MT / 4);
            bf16x8 bfr[4], af[2][4];
#pragma unroll
            for (int nt = 0; nt < 4; ++nt) bfr[nt] = *(const bf16x8*)(lb + swz(wc * 64 + nt * 16 + fr, fq));
#pragma unroll
            for (int m = 0; m < 4; ++m) af[0][m] = *(const bf16x8*)(la + swz(wr * 16 * MT + m * 16 + fr, fq));
#pragma unroll
            for (int gi = 0; gi < NG; ++gi) {
                const int ks = gi / (MT / 4), h = gi % (MT / 4);
                if (gi > 0 && h == 0) {
#pragma unroll
                    for (int nt = 0; nt < 4; ++nt) bfr[nt] = *(const bf16x8*)(lb + swz(wc * 64 + nt * 16 + fr, ks * 4 + fq));
                }
                if (gi + 1 < NG) {
                    const int ks2 = (gi + 1) / (MT / 4), h2 = (gi + 1) % (MT / 4);
#pragma unroll
                    for (int m = 0; m < 4; ++m) af[(gi + 1) & 1][m] = *(const bf16x8*)(la + swz(wr * 16 * MT + (h2 * 4 + m) * 16 + fr, ks2 * 4 + fq));
                }
                __builtin_amdgcn_sched_barrier(0);
#pragma unroll
                for (int m = 0; m < 4; ++m)
#pragma unroll
                    for (int nt = 0; nt < 4; ++nt) acc[h * 4 + m][nt] = __builtin_amdgcn_mfma_f32_16x16x32_bf16(bfr[nt], af[gi & 1][m], acc[h * 4 + m][nt], 0, 0, 0);
                __builtin_amdgcn_sched_barrier(0);
            }
        }
        __syncthreads();
    }
#undef G2_STAGE
    epi(acc, wr, wc, fr, fq);
}
template <int MT>
__device__ __forceinline__ void g2_rows_A(G2Args& g, size_t row0, unsigned ld_bytes) {
    const int lane = threadIdx.x & 63, w = __builtin_amdgcn_readfirstlane(threadIdx.x >> 6); const unsigned co = g2_chunk_off(lane, w);
#pragma unroll
    for (int i = 0; i < MT / 2; ++i) g.offA[i] = (unsigned)((row0 + i * 64 + w * 8 + (lane >> 3)) * ld_bytes) + co;
}
__device__ __forceinline__ void g2_rows_B(G2Args& g, size_t row0, unsigned ld_bytes) {
    const int lane = threadIdx.x & 63, w = __builtin_amdgcn_readfirstlane(threadIdx.x >> 6); const unsigned co = g2_chunk_off(lane, w);
#pragma unroll
    for (int i = 0; i < 4; ++i) g.offB[i] = (unsigned)((row0 + i * 64 + w * 8 + (lane >> 3)) * ld_bytes) + co;
}


struct G3Args { const char* A; unsigned offA[4]; const float* b; int ldb; int nk; };
template <int MT, class Epi>
__device__ __forceinline__ void gemm3(char* lds_, const G3Args& g, const Epi& epi) {
    constexpr int A_BYTES = 32 * MT * 128, B_BYTES = 256 * 128, STAGE = A_BYTES + B_BYTES, AR = MT / 2;
    LAS char* lds = (LAS char*)lds_;
    const int tid = threadIdx.x, lane = tid & 63, w = __builtin_amdgcn_readfirstlane(tid >> 6), wr = w >> 2, wc = w & 3, fr = lane & 15, fq = lane >> 4;
    f32x4 acc[MT][4];
#pragma unroll
    for (int i = 0; i < MT; ++i)
#pragma unroll
        for (int j = 0; j < 4; ++j) acc[i][j] = (f32x4){0.f, 0.f, 0.f, 0.f};
    const int ldsw = w * 1024;
    int bw[4];
#pragma unroll
    for (int j = 0; j < 4; ++j) bw[j] = swz(4 * lane + j, w);
    f32x4 br[8]; const float* pb = g.b;
#define G3_STAGE_A(kt, s) do { \
        _Pragma("unroll") for (int i = 0; i < AR; ++i) __builtin_amdgcn_global_load_lds((const unsigned*)(g.A + g.offA[i] + (size_t)(kt) * 128), (LAS unsigned*)(lds + (s) * STAGE + i * 8192 + ldsw), 16, 0, 0); } while (0)
#define G3_LOAD_B() do { _Pragma("unroll") for (int i = 0; i < 8; ++i) br[i] = *(const f32x4*)(pb + (size_t)i * g.ldb); pb += (size_t)64 * g.ldb; } while (0)
#define G3_WRITE_B(s) do { _Pragma("unroll") for (int j = 0; j < 4; ++j) { \
            u32x4 v = {cvt_pk(br[0][j], br[1][j]), cvt_pk(br[2][j], br[3][j]), cvt_pk(br[4][j], br[5][j]), cvt_pk(br[6][j], br[7][j])}; \
            *(u32x4*)(lds_ + (s) * STAGE + A_BYTES + bw[j]) = v; } } while (0)
    G3_STAGE_A(0, 0); G3_LOAD_B(); G3_WRITE_B(0);
    __syncthreads();
    for (int kt = 0; kt < g.nk; ++kt) {
        const int s = kt & 1; const bool more = kt + 1 < g.nk;
        if (more) { if (s) G3_STAGE_A(kt + 1, 0); else G3_STAGE_A(kt + 1, 1); G3_LOAD_B(); }
        __builtin_amdgcn_sched_barrier(0);
        const char* la = lds_ + s * STAGE; const char* lb = la + A_BYTES;
#pragma unroll
        for (int ks = 0; ks < 2; ++ks) {
            bf16x8 bfr[4];
#pragma unroll
            for (int nt = 0; nt < 4; ++nt) bfr[nt] = *(const bf16x8*)(lb + swz(wc * 64 + nt * 16 + fr, ks * 4 + fq));
#pragma unroll
            for (int h = 0; h < MT / 4; ++h) {
                bf16x8 af[4];
#pragma unroll
                for (int m = 0; m < 4; ++m) af[m] = *(const bf16x8*)(la + swz(wr * 16 * MT + (h * 4 + m) * 16 + fr, ks * 4 + fq));
#pragma unroll
                for (int m = 0; m < 4; ++m)
#pragma unroll
                    for (int nt = 0; nt < 4; ++nt) acc[h * 4 + m][nt] = __builtin_amdgcn_mfma_f32_16x16x32_bf16(bfr[nt], af[m], acc[h * 4 + m][nt], 0, 0, 0);
            }
        }
        if (more) { if (s) G3_WRITE_B(0); else G3_WRITE_B(1); }
        __syncthreads();
    }
#undef G3_STAGE_A
#undef G3_LOAD_B
#undef G3_WRITE_B
    epi(acc, wr, wc, fr, fq);
}


struct G3bArgs { const char* A; unsigned offA[4]; const unsigned char* b; int ldb; int nk; unsigned akstep; };
template <int MT, class Epi>
__device__ __forceinline__ void gemm3b(char* lds_, const G3bArgs& g, const Epi& epi) {
    constexpr int A_BYTES = 32 * MT * 128, B_BYTES = 256 * 128, STAGE = A_BYTES + B_BYTES, AR = MT / 2;
    LAS char* lds = (LAS char*)lds_;
    const int tid = threadIdx.x, lane = tid & 63, w = __builtin_amdgcn_readfirstlane(tid >> 6), wr = w >> 2, wc = w & 3, fr = lane & 15, fq = lane >> 4;
    f32x4 acc[MT][4];
#pragma unroll
    for (int i = 0; i < MT; ++i)
#pragma unroll
        for (int j = 0; j < 4; ++j) acc[i][j] = (f32x4){0.f, 0.f, 0.f, 0.f};
    const int ldsw = w * 1024;
    int bw[4];
#pragma unroll
    for (int j = 0; j < 4; ++j) bw[j] = swz(4 * lane + j, w);
    unsigned br[8]; const unsigned char* pb = g.b;
#define G3_STAGE_A(kt, s) do { \
        _Pragma("unroll") for (int i = 0; i < AR; ++i) __builtin_amdgcn_global_load_lds((const unsigned*)(g.A + g.offA[i] + (size_t)(kt) * g.akstep), (LAS unsigned*)(lds + (s) * STAGE + i * 8192 + ldsw), 16, 0, 0); } while (0)
#define G3_LOAD_B() do { _Pragma("unroll") for (int i = 0; i < 8; ++i) br[i] = *(const unsigned*)(pb + (size_t)i * g.ldb); pb += (size_t)64 * g.ldb; } while (0)
#define G3_WRITE_B(s) do { _Pragma("unroll") for (int hh = 0; hh < 2; ++hh) { f32x2 f[8]; \
            _Pragma("unroll") for (int i = 0; i < 8; ++i) f[i] = hh ? __builtin_amdgcn_cvt_pk_f32_fp8((int)br[i], true) : __builtin_amdgcn_cvt_pk_f32_fp8((int)br[i], false); \
            _Pragma("unroll") for (int jj = 0; jj < 2; ++jj) { \
                u32x4 v = {cvt_pk(f[0][jj], f[1][jj]), cvt_pk(f[2][jj], f[3][jj]), cvt_pk(f[4][jj], f[5][jj]), cvt_pk(f[6][jj], f[7][jj])}; \
                *(u32x4*)(lds_ + (s) * STAGE + A_BYTES + bw[hh * 2 + jj]) = v; } } } while (0)
    G3_STAGE_A(0, 0); G3_LOAD_B(); G3_WRITE_B(0);
    __syncthreads();
    for (int kt = 0; kt < g.nk; ++kt) {
        const int s = kt & 1; const bool more = kt + 1 < g.nk;
        if (more) { if (s) G3_STAGE_A(kt + 1, 0); else G3_STAGE_A(kt + 1, 1); G3_LOAD_B(); }
        __builtin_amdgcn_sched_barrier(0);
        const char* la = lds_ + s * STAGE; const char* lb = la + A_BYTES;
#pragma unroll
        for (int ks = 0; ks < 2; ++ks) {
            bf16x8 bfr[4];
#pragma unroll
            for (int nt = 0; nt < 4; ++nt) bfr[nt] = *(const bf16x8*)(lb + swz(wc * 64 + nt * 16 + fr, ks * 4 + fq));
#pragma unroll
            for (int h = 0; h < MT / 4; ++h) {
                bf16x8 af[4];
#pragma unroll
                for (int m = 0; m < 4; ++m) af[m] = *(const bf16x8*)(la + swz(wr * 16 * MT + (h * 4 + m) * 16 + fr, ks * 4 + fq));
                __builtin_amdgcn_sched_barrier(0);
#pragma unroll
                for (int m = 0; m < 4; ++m)
#pragma unroll
                    for (int nt = 0; nt < 4; ++nt) acc[h * 4 + m][nt] = __builtin_amdgcn_mfma_f32_16x16x32_bf16(bfr[nt], af[m], acc[h * 4 + m][nt], 0, 0, 0);
                __builtin_amdgcn_sched_barrier(0);
            }
        }
        if (more) { if (s) G3_WRITE_B(0); else G3_WRITE_B(1); }
        __syncthreads();
    }
#undef G3_STAGE_A
#undef G3_LOAD_B
#undef G3_WRITE_B
    epi(acc, wr, wc, fr, fq);
}

__device__ __forceinline__ void cvt_item(const float* W, int K, int N, bf16_t* WT, int ldt, int kb, int nb, int lane) {
    const float* src = W + (size_t)(kb * 64) * N + nb * 256 + 4 * lane;
    bf16_t* dst = WT + (size_t)(nb * 256 + 4 * lane) * ldt + kb * 64;
#pragma unroll 2
    for (int kc = 0; kc < 8; ++kc) {
        f32x4 r[8];
#pragma unroll
        for (int i = 0; i < 8; ++i) r[i] = *(const f32x4*)(src + (size_t)(kc * 8 + i) * N);
#pragma unroll
        for (int j = 0; j < 4; ++j) {
            u32x4 v = {cvt_pk(r[0][j], r[1][j]), cvt_pk(r[2][j], r[3][j]), cvt_pk(r[4][j], r[5][j]), cvt_pk(r[6][j], r[7][j])};
            *(u32x4*)(dst + (size_t)j * ldt + kc * 8) = v;
        }
    }
}
__device__ __forceinline__ void phase_prep(const Params& p, int vb, int G) {
    const int tid = threadIdx.x, lane = tid & 63, w = tid >> 6;
    float* cs = (float*)(p.ws + WS_ROPE); float* sn = cs + (size_t)S * 32;
    for (int idx = vb * NTHREADS + tid; idx < S * 32; idx += G * NTHREADS) {
        const int pos = idx >> 5, i = idx & 31;
        const float pw = (float)pow(10000.0, (double)i / 32.0);
        const float inv = 1.0f / pw;
        const float angf = __fmul_rn((float)pos, inv);
        const double a = (double)angf;
        const double q = rint(a * 0.63661977236758134308);
        double r = fma(-q, 1.57079632679489655800, a); r = fma(-q, 6.12323399573676603587e-17, r);
        const double r2 = r * r;
        double sp = r * (1.0 + r2 * (-1.0 / 6 + r2 * (1.0 / 120 + r2 * (-1.0 / 5040 + r2 * (1.0 / 362880 + r2 * (-1.0 / 39916800))))));
        double cp = 1.0 + r2 * (-0.5 + r2 * (1.0 / 24 + r2 * (-1.0 / 720 + r2 * (1.0 / 40320 + r2 * (-1.0 / 3628800 + r2 * (1.0 / 479001600))))));
        const int qi = ((int)((long long)q)) & 3;
        double sv, cv;
        if (qi == 0) { sv = sp; cv = cp; } else if (qi == 1) { sv = cp; cv = -sp; } else if (qi == 2) { sv = -sp; cv = -cp; } else { sv = -cp; cv = sp; }
        cs[idx] = (float)cv; sn[idx] = (float)sv;
    }
    { const f32x4* xs = (const f32x4*)p.x; u32x4* xd = (u32x4*)(p.ws + WS_XB);
      for (size_t i = (size_t)vb * NTHREADS + tid; i < (size_t)S * D / 8; i += (size_t)G * NTHREADS) {
          const f32x4 a = xs[2 * i], b = xs[2 * i + 1];
          xd[i] = (u32x4){cvt_pk(a[0], a[1]), cvt_pk(a[2], a[3]), cvt_pk(b[0], b[1]), cvt_pk(b[2], b[3])}; } }
    const int gw = vb * 8 + w, NGW = G * 8;
    constexpr int I_IN = 16 * 9, I_OUT = 16 * 4, I_R = 16, I_SG = 16, I_SU = 16, I_SD = 4 * 4, I_SMALL = I_IN + I_OUT + I_R;
    for (int it = gw; it < I_SMALL; it += NGW) {
        int r = it;
        if (r < I_IN) { cvt_item(p.w_in, D, INW, (bf16_t*)(p.ws + WS_WIN), D, r / 9, r % 9, lane); continue; } r -= I_IN;
        if (r < I_OUT) { cvt_item(p.w_out, D, D, (bf16_t*)(p.ws + WS_WOUT), D, r >> 2, r & 3, lane); continue; } r -= I_OUT;
        cvt_item(p.w_r, D, NE, (bf16_t*)(p.ws + WS_WR), D, r, 0, lane);
    }
    for (int i = vb * NTHREADS + tid; i < 3 * 262144 / 8; i += G * NTHREADS) {
        const int seg = i / 32768, o = (i % 32768) * 8;
        const float* sp = (seg == 0 ? p.ws_g : (seg == 1 ? p.ws_u : p.ws_d)) + o;
        unsigned char* dp = (seg < 2 ? (unsigned char*)(p.ws + WS_WSGU) + (size_t)seg * 262144 : (unsigned char*)(p.ws + WS_WSD)) + o;
        *(u32x2*)dp = (u32x2){pack_fp8x4(*(const f32x4*)sp), pack_fp8x4(*(const f32x4*)(sp + 4))};
    }
}

template <int MT> struct EpiProj {
    const float* bias; const float* cs; const float* sn; bf16_t* out; int row0, col0;
    __device__ __forceinline__ void operator()(f32x4 (&acc)[MT][4], int wr, int wc, int fr, int fq) const {
        const int hb = col0 + wc * 64;
        const bool is_q = (hb < C_AK) || (hb >= C_BQ && hb < C_BK);
        const bool is_rope = is_q || (hb >= C_AK && hb < C_AV) || (hb >= C_BK && hb < C_BV);
        const float sc = is_q ? QSCALE : 1.0f;
#pragma unroll
        for (int mt = 0; mt < MT; ++mt) {
            const int row = row0 + wr * 16 * MT + mt * 16 + fr;
            f32x4 v[4];
#pragma unroll
            for (int nt = 0; nt < 4; ++nt) v[nt] = acc[mt][nt] + *(const f32x4*)(bias + hb + nt * 16 + 4 * fq);
            if (is_rope) {
#pragma unroll
                for (int nt = 0; nt < 2; ++nt) {
                    const f32x4 c = *(const f32x4*)(cs + (size_t)row * 32 + nt * 16 + 4 * fq), s = *(const f32x4*)(sn + (size_t)row * 32 + nt * 16 + 4 * fq);
                    const f32x4 t1 = v[nt], t2 = v[nt + 2];
                    v[nt] = t1 * c - t2 * s; v[nt + 2] = t2 * c + t1 * s;
                }
            }
#pragma unroll
            for (int nt = 0; nt < 4; ++nt) {
                const f32x4 o = v[nt] * sc;
                u32x2 pk = {cvt_pk(o[0], o[1]), cvt_pk(o[2], o[3])};
                *(u32x2*)(out + (size_t)row * INW + hb + nt * 16 + 4 * fq) = pk;
            }
        }
    }
};
__device__ __forceinline__ void phase_proj(const Params& p, char* lds, int vb, int G) {
    const float* cs = (const float*)(p.ws + WS_ROPE); const float* sn = cs + (size_t)S * 32;
    constexpr int NBIG = 512, NUNITS = NBIG + 2 * 64;
    for (int u = vb; u < NUNITS; u += G) {
        G2Args g; g.A = (const char*)(p.ws + WS_XB); g.B = (const char*)(p.ws + WS_WIN); g.nk = D / 64; g.akstep = 128;
        if (u < NBIG) {
            const int tm = u / 9, tn = u % 9;
            g2_rows_A<8>(g, (size_t)tm * 256, D * 2); g2_rows_B(g, (size_t)tn * 256, D * 2);
            EpiProj<8> e{p.b_in, cs, sn, (bf16_t*)(p.ws + WS_PROJ), tm * 256, tn * 256};
            gemm2<8>(lds, g, e);
        } else {
            const int t = NBIG + ((u - NBIG) >> 1), half = (u - NBIG) & 1, tm = t / 9, tn = t % 9;
            g2_rows_A<4>(g, (size_t)tm * 256 + half * 128, D * 2); g2_rows_B(g, (size_t)tn * 256, D * 2);
            EpiProj<4> e{p.b_in, cs, sn, (bf16_t*)(p.ws + WS_PROJ), tm * 256 + half * 128, tn * 256};
            gemm2<4>(lds, g, e);
        }
    }
}

template <int OFF> __device__ __forceinline__ s16x4 tr_read(int vb) { s16x4 r; asm volatile("ds_read_b64_tr_b16 %0, %1 offset:%2" : "=&v"(r) : "v"(vb), "i"(OFF) : "memory"); return r; }
__device__ __forceinline__ int v_off(int k, int c, int ndb) { return ((k >> 3) * ndb + (c >> 5)) * 512 + ((k & 7) * 32 + (c & 31)) * 2; }

constexpr int AT_STAGE = 32768;
template <int NDB, int KB, int T> struct PvPart {
    static __device__ __forceinline__ void run(f32x16& o, int vbase, const bf16x8& pa, const bf16x8& pb) {
        constexpr int o0 = (KB * 4 * NDB + T) * 512, st = NDB * 512;
        const s16x4 l0 = tr_read<o0 + 0 * st>(vbase), h0 = tr_read<o0 + 1 * st>(vbase), l1 = tr_read<o0 + 2 * st>(vbase), h1 = tr_read<o0 + 3 * st>(vbase);
        asm volatile("s_waitcnt lgkmcnt(0)" ::: "memory"); __builtin_amdgcn_sched_barrier(0);
#define PKV(L, H) (bf16x8){L[0], L[1], L[2], L[3], H[0], H[1], H[2], H[3]}
        o = __builtin_amdgcn_mfma_f32_32x32x16_bf16(PKV(l0, h0), pa, o, 0, 0, 0);
        o = __builtin_amdgcn_mfma_f32_32x32x16_bf16(PKV(l1, h1), pb, o, 0, 0, 0);
#undef PKV
    }
};
template <int NDB, int KB>
__device__ __forceinline__ void pv_half(f32x16 (&o)[NDB], f32x16& ol, int vbase, const bf16x8& pa, const bf16x8& pb) {
    const bf16x8 ones = {16256, 16256, 16256, 16256, 16256, 16256, 16256, 16256};
    ol = __builtin_amdgcn_mfma_f32_32x32x16_bf16(ones, pa, ol, 0, 0, 0);
    ol = __builtin_amdgcn_mfma_f32_32x32x16_bf16(ones, pb, ol, 0, 0, 0);
    PvPart<NDB, KB, 0>::run(o[0], vbase, pa, pb); PvPart<NDB, KB, 1>::run(o[1], vbase, pa, pb);
    if constexpr (NDB == 4) { PvPart<NDB, KB, 2>::run(o[2], vbase, pa, pb); PvPart<NDB, KB, 3>::run(o[3], vbase, pa, pb); }
}
constexpr float ATT_THR = 10.0f;
template <int NDB>
__device__ __forceinline__ void attn_scores(char* lds, int kof, const bf16x8 (&qf)[4], f32x16& s0, f32x16& s1, f32x16 (&o)[NDB], f32x16& ol, f32x16& nm, bool first, int r32, int hi) {
    s0 = nm; s1 = nm;
#pragma unroll
    for (int ds = 0; ds < 4; ++ds) {
        const bf16x8 k0 = *(const bf16x8*)(lds + kof + swz(r32, ds * 2 + hi)), k1 = *(const bf16x8*)(lds + kof + swz(32 + r32, ds * 2 + hi));
        s0 = __builtin_amdgcn_mfma_f32_32x32x16_bf16(k0, qf[ds], s0, 0, 0, 0);
        s1 = __builtin_amdgcn_mfma_f32_32x32x16_bf16(k1, qf[ds], s1, 0, 0, 0);
    }
    float mx = fmaxf(s0[0], s1[0]);
#pragma unroll
    for (int r = 1; r < 16; ++r) mx = fmaxf(fmaxf(mx, s0[r]), s1[r]);
    mx = half_max(mx);
    if (first || __any(mx > ATT_THR)) {
        const float delta = first ? mx : fmaxf(mx, 0.f), alpha = first ? 0.f : __builtin_amdgcn_exp2f(-delta);
#pragma unroll
        for (int r = 0; r < 16; ++r) { s0[r] -= delta; s1[r] -= delta; nm[r] -= delta; ol[r] *= alpha; }
#pragma unroll
        for (int t = 0; t < NDB; ++t)
#pragma unroll
            for (int r = 0; r < 16; ++r) o[t][r] *= alpha;
    }
}
__device__ __forceinline__ void exp_pack(const f32x16& s, bf16x8& pa, bf16x8& pb) {
    float e[16];
#pragma unroll
    for (int r = 0; r < 16; ++r) e[r] = __builtin_amdgcn_exp2f(s[r]);
    u32x4 a = {cvt_pk(e[0], e[1]), cvt_pk(e[2], e[3]), cvt_pk(e[4], e[5]), cvt_pk(e[6], e[7])};
    u32x4 b = {cvt_pk(e[8], e[9]), cvt_pk(e[10], e[11]), cvt_pk(e[12], e[13]), cvt_pk(e[14], e[15])};
    pa = *(bf16x8*)&a; pb = *(bf16x8*)&b;
}

struct CvState { int c; int have; f32x4 a, b, a2, b2; };
constexpr int CV_CHUNKS = 192;
__device__ __forceinline__ const float* cv_src(const Params& p, int e, int c) { const int seg = c >> 6; const float* base = seg == 0 ? p.w_g : (seg == 1 ? p.w_u : p.w_d); return base + (size_t)e * 262144 + (size_t)(c & 63) * 4096 + threadIdx.x * 8; }
__device__ __forceinline__ unsigned char* cv_dst(const Params& p, int e, int c) { const int seg = c >> 6; unsigned char* base = seg < 2 ? (unsigned char*)(p.ws + WS_EGU) + (size_t)e * 524288 + (size_t)seg * 262144 : (unsigned char*)(p.ws + WS_ED) + (size_t)e * 262144; return base + (size_t)(c & 63) * 4096 + threadIdx.x * 8; }
__device__ __forceinline__ void cv_step(const Params& p, int e, CvState& cv) {
    if (cv.have) {
        *(u32x2*)cv_dst(p, e, cv.c - 2) = (u32x2){pack_fp8x4(cv.a), pack_fp8x4(cv.b)};
        *(u32x2*)cv_dst(p, e, cv.c - 1) = (u32x2){pack_fp8x4(cv.a2), pack_fp8x4(cv.b2)};
        cv.have = 0; }
    if (cv.c < CV_CHUNKS) { const float* sp = cv_src(p, e, cv.c); cv.a = *(const f32x4*)sp; cv.b = *(const f32x4*)(sp + 4);
        const float* sp2 = cv_src(p, e, cv.c + 1); cv.a2 = *(const f32x4*)sp2; cv.b2 = *(const f32x4*)(sp2 + 4); cv.have = 1; cv.c += 2; }
}
__device__ __forceinline__ void attn_diff_unit(const Params& p, char* lds_, int h, int qb, float lam, int cve, CvState& cv) {
    LAS char* lds = (LAS char*)lds_;
    const int tid = threadIdx.x, lane = tid & 63, w = __builtin_amdgcn_readfirstlane(tid >> 6), r32 = lane & 31, hi = lane >> 5, mp = w >> 2, wq = w & 3;
    const bf16_t* proj = (const bf16_t*)(p.ws + WS_PROJ);
    const int NT = 2 * qb + 2, NP = NT / 2, myNT = (wq < 2) ? NT - 1 : NT;
    bf16x8 qf[4];
    { const bf16_t* qp = proj + (size_t)(qb * 128 + wq * 32 + r32) * INW + C_BQ + h * 128 + mp * 64 + hi * 8;
#pragma unroll
      for (int ds = 0; ds < 4; ++ds) qf[ds] = *(const bf16x8*)(qp + ds * 16); }
    asm volatile("" : "+v"(qf[0]), "+v"(qf[1]), "+v"(qf[2]), "+v"(qf[3]));
    f32x16 o[4] = {}; f32x16 ol = {}, nm = {};
    const char* gk = (const char*)(proj + (size_t)(w * 8 + (lane >> 3)) * INW + C_BK + h * 128) + g2_chunk_off(lane, w);
    const char* gv = (const char*)(proj + (size_t)(w * 8 + ((lane & 31) >> 2)) * INW + C_BV + h * 128 + (lane >> 5) * 32 + (lane & 3) * 8);
    const int vlane = ((lane & 3) << 3) | (((lane >> 2) & 3) << 6) | (((lane >> 4) & 1) << 5) | (((lane >> 5) & 1) << 8);
    constexpr size_t TSTEP = (size_t)64 * INW * 2;
#define A_STAGE(pr, sg) do { const char* k0_ = gk + (size_t)(pr) * 2 * TSTEP; const char* v0_ = gv + (size_t)(pr) * 2 * TSTEP; \
        _Pragma("unroll") for (int j = 0; j < 2; ++j) { \
            __builtin_amdgcn_global_load_lds((const unsigned*)(k0_ + j * TSTEP), (LAS unsigned*)(lds + (sg) * 65536 + (0 * 2 + j) * 8192 + w * 1024), 16, 0, 0); \
            __builtin_amdgcn_global_load_lds((const unsigned*)(k0_ + j * TSTEP + 128), (LAS unsigned*)(lds + (sg) * 65536 + (1 * 2 + j) * 8192 + w * 1024), 16, 0, 0); \
            __builtin_amdgcn_global_load_lds((const unsigned*)(v0_ + j * TSTEP), (LAS unsigned*)(lds + (sg) * 65536 + 32768 + j * 16384 + (2 * w) * 1024), 16, 0, 0); \
            __builtin_amdgcn_global_load_lds((const unsigned*)(v0_ + j * TSTEP + 128), (LAS unsigned*)(lds + (sg) * 65536 + 32768 + j * 16384 + (2 * w + 1) * 1024), 16, 0, 0); } } while (0)
    A_STAGE(0, 0);
    __syncthreads();
    bool first = true;
    for (int it = 0; it < NP; ++it) {
        const int sg = it & 1;
        cv_step(p, cve, cv);
        if (it + 1 < NP) { if (sg) A_STAGE(it + 1, 0); else A_STAGE(it + 1, 1); }
#pragma unroll
        for (int jj = 0; jj < 2; ++jj) {
            const int j = jj, t = 2 * it + j;
            if (t < myNT) {
                bf16x8 p0, p1, p2, p3; f32x16 s0, s1;
                const int vb_ = (int)(uintptr_t)(lds_ + sg * 65536 + 32768 + j * 16384) + vlane;
                attn_scores<4>(lds_, sg * 65536 + (mp * 2 + j) * 8192, qf, s0, s1, o, ol, nm, first, r32, hi);
                first = false;
                exp_pack(s0, p0, p1); pv_half<4, 0>(o, ol, vb_, p0, p1); exp_pack(s1, p2, p3); pv_half<4, 1>(o, ol, vb_, p2, p3);
            }
        }
        __syncthreads();
    }
#undef A_STAGE
    float* xb = (float*)lds_;
    const float il = 1.0f / ol[0];
    if (mp == 1) {
        const float f = il * lam;
#pragma unroll
        for (int t = 0; t < 4; ++t)
#pragma unroll
            for (int r = 0; r < 16; ++r) xb[(wq * 64 + t * 16 + r) * 64 + lane] = o[t][r] * f;
    }
    __syncthreads();
    if (mp == 0) {
        float ss = 0.f;
#pragma unroll
        for (int t = 0; t < 4; ++t)
#pragma unroll
            for (int r = 0; r < 16; ++r) { const float v = o[t][r] * il - xb[(wq * 64 + t * 16 + r) * 64 + lane]; o[t][r] = v; ss += v * v; }
        ss = half_sum(ss);
        const float rs = rsqrtf(ss * (1.0f / 128.0f) + LN_EPS) * 0.8f;
        bf16_t* op = (bf16_t*)(p.ws + WS_ATT) + (size_t)(qb * 128 + wq * 32 + r32) * D + 512 + h * 128;
#pragma unroll
        for (int t = 0; t < 4; ++t)
#pragma unroll
            for (int rr = 0; rr < 4; ++rr) {
                const int dv0 = 32 * t + 8 * rr + 4 * hi;
                const f32x4 gg = *(const f32x4*)(p.subg + dv0);
                u32x2 pk = {cvt_pk(o[t][4 * rr] * rs * gg[0], o[t][4 * rr + 1] * rs * gg[1]), cvt_pk(o[t][4 * rr + 2] * rs * gg[2], o[t][4 * rr + 3] * rs * gg[3])};
                *(u32x2*)(op + dv0) = pk;
            }
    }
    __syncthreads();
}
__device__ __forceinline__ void attn_swa_unit(const Params& p, char* lds, int kvh, int n) {
    const int tid = threadIdx.x, lane = tid & 63, w = __builtin_amdgcn_readfirstlane(tid >> 6), r32 = lane & 31, hi = lane >> 5, g = w >> 1, hq = kvh * 4 + g;
    const bf16_t* proj = (const bf16_t*)(p.ws + WS_PROJ);
    const int c0 = (n >= 2) ? n - 2 : 0, NT = n - c0 + 1;
    const int tok = n * 64 + (w & 1) * 32 + r32;
    bf16x8 qf[4];
    { const bf16_t* qp = proj + (size_t)tok * INW + C_AQ + hq * 64 + hi * 8;
#pragma unroll
      for (int ds = 0; ds < 4; ++ds) qf[ds] = *(const bf16x8*)(qp + ds * 16); }
    f32x16 o[2] = {}; f32x16 ol, nm;
    { float ms = -p.sinks[hq] * LOG2E; asm volatile("" : "+v"(qf[0]), "+v"(qf[1]), "+v"(qf[2]), "+v"(qf[3]), "+v"(ms));
#pragma unroll
      for (int r = 0; r < 16; ++r) { nm[r] = ms; ol[r] = 1.0f; } }
    const bf16_t* gk = proj + (size_t)(c0 * 64 + (tid >> 3)) * INW + C_AK + kvh * 64 + (tid & 7) * 8;
    const bf16_t* gv = proj + (size_t)(c0 * 64 + (tid >> 3)) * INW + C_AV + kvh * 64 + (tid & 7) * 8;
    const int wk = swz(tid >> 3, tid & 7), wv = v_off(tid >> 3, (tid & 7) * 8, 2);
    const int vlane = ((lane & 3) << 3) | (((lane >> 2) & 3) << 6) | (((lane >> 4) & 1) << 5) | (((lane >> 5) & 1) << 8);
    u32x4 st0, st1;
#define W_LOAD(t) do { const size_t ko = (size_t)(t) * 64 * INW; st0 = *(const u32x4*)(gk + ko); st1 = *(const u32x4*)(gv + ko); } while (0)
#define W_WRITE(b) do { char* sb = lds + (b) * AT_STAGE; *(u32x4*)(sb + wk) = st0; *(u32x4*)(sb + 8192 + wv) = st1; } while (0)
    W_LOAD(0); W_WRITE(0); __syncthreads();
    for (int t = 0; t < NT; ++t) {
        const int b = t & 1;
        if (t + 1 < NT) W_LOAD(t + 1);
        { f32x16 s0, s1; bf16x8 p0, p1, p2, p3; const int vb_ = (int)(uintptr_t)(lds + b * AT_STAGE + 8192) + vlane;
          attn_scores<2>(lds, b * AT_STAGE, qf, s0, s1, o, ol, nm, false, r32, hi);
          exp_pack(s0, p0, p1); pv_half<2, 0>(o, ol, vb_, p0, p1); exp_pack(s1, p2, p3); pv_half<2, 1>(o, ol, vb_, p2, p3); }
        if (t + 1 < NT) W_WRITE(b ^ 1);
        __syncthreads();
    }
#undef W_LOAD
#undef W_WRITE
    const float il = 1.0f / ol[0];
    bf16_t* op = (bf16_t*)(p.ws + WS_ATT) + (size_t)tok * D + hq * 64;
#pragma unroll
    for (int t = 0; t < 2; ++t)
#pragma unroll
        for (int rr = 0; rr < 4; ++rr) {
            const int dv0 = 32 * t + 8 * rr + 4 * hi;
            u32x2 pk = {cvt_pk(o[t][4 * rr] * il, o[t][4 * rr + 1] * il), cvt_pk(o[t][4 * rr + 2] * il, o[t][4 * rr + 3] * il)};
            *(u32x2*)(op + dv0) = pk;
        }
}
__device__ __forceinline__ void phase_attn(const Params& p, char* lds, int vb, int G) {
    const int lane = threadIdx.x & 63;
    const float d1 = wave_sum(p.lq1[lane] * p.lk1[lane]), d2 = wave_sum(p.lq2[lane] * p.lk2[lane]);
    const float lam = expf(d1) - expf(d2) + 0.2f;
    CvState cv; cv.c = 0; cv.have = 0; cv.a = (f32x4){0.f, 0.f, 0.f, 0.f}; cv.b = cv.a; cv.a2 = cv.a; cv.b2 = cv.a;
    for (int u = vb; u < 1024; u += G) {
        if (u < 256) attn_diff_unit(p, lds, u >> 6, 127 - (u & 63), lam, vb, cv);
        else if (u < 512) attn_diff_unit(p, lds, (u - 256) >> 6, (u - 256) & 63, lam, vb, cv);
        else attn_swa_unit(p, lds, (u - 512) >> 8, (u - 512) & 255);
    }
    for (int e = vb; e < NE; e += G) {
        if (e != vb) { cv.c = 0; cv.have = 0; }
        while (cv.c < CV_CHUNKS || cv.have) cv_step(p, e, cv);
    }
}

struct EpiPreLn {
    const float* x; float* out; int row0, col0;
    __device__ __forceinline__ void operator()(f32x4 (&acc)[8][4], int wr, int wc, int fr, int fq) const {
#pragma unroll
        for (int mt = 0; mt < 8; ++mt) {
            const size_t ro = (size_t)(row0 + wr * 128 + mt * 16 + fr) * D + col0 + wc * 64 + 4 * fq;
#pragma unroll
            for (int nt = 0; nt < 4; ++nt) { const f32x4 xv = *(const f32x4*)(x + ro + nt * 16); *(f32x4*)(out + ro + nt * 16) = xv * ALPHA + acc[mt][nt]; }
        }
    }
};
__device__ __forceinline__ void phase_wout(const Params& p, char* lds, int vb, int G) {
    for (int u = vb; u < (S / 256) * 4; u += G) {
        const int tm = u >> 2, tn = u & 3;
        G2Args g; g.A = (const char*)(p.ws + WS_ATT); g.B = (const char*)(p.ws + WS_WOUT); g.nk = D / 64; g.akstep = 128;
        g2_rows_A<8>(g, (size_t)tm * 256, D * 2); g2_rows_B(g, (size_t)tn * 256, D * 2);
        EpiPreLn e{p.x, (float*)(p.ws + WS_PRELN), tm * 256, tn * 256};
        gemm2<8>(lds, g, e);
    }
}

struct EpiLogits {
    float* L;
    __device__ __forceinline__ void operator()(f32x4 (&acc)[4][4], int wr, int wc, int fr, int fq) const {
#pragma unroll
        for (int mt = 0; mt < 4; ++mt)
#pragma unroll
            for (int nt = 0; nt < 4; ++nt) *(f32x4*)(L + (wr * 64 + mt * 16 + fr) * 256 + wc * 64 + nt * 16 + 4 * fq) = acc[mt][nt];
    }
};
__device__ __forceinline__ void phase_router(const Params& p, char* lds, int vb, int G) {
    const int tid = threadIdx.x, lane = tid & 63, w = tid >> 6;
    const float* preln = (const float*)(p.ws + WS_PRELN);
    float* x1f = (float*)(p.ws + WS_X1F); bf16_t* x1b = (bf16_t*)(p.ws + WS_X1B);
    unsigned* cnt = (unsigned*)(p.ws + WS_CTL); int* list = (int*)(p.ws + WS_LIST); float* gates = (float*)(p.ws + WS_GATE);
    for (int u = vb; u < S / 64; u += G) {
        for (int i = 0; i < 8; ++i) {
            const int row = u * 64 + w * 8 + i;
            const f32x4* xr = (const f32x4*)(preln + (size_t)row * D) + lane;
            f32x4 v[4]; float s = 0.f;
#pragma unroll
            for (int j = 0; j < 4; ++j) { v[j] = xr[64 * j]; s += (v[j][0] + v[j][1]) + (v[j][2] + v[j][3]); }
            const float mean = wave_sum(s) * (1.0f / D); float s2 = 0.f;
#pragma unroll
            for (int j = 0; j < 4; ++j) { v[j] = v[j] - mean; s2 += (v[j][0] * v[j][0] + v[j][1] * v[j][1]) + (v[j][2] * v[j][2] + v[j][3] * v[j][3]); }
            const float rstd = rsqrtf(wave_sum(s2) * (1.0f / D) + LN_EPS);
#pragma unroll
            for (int j = 0; j < 4; ++j) {
                const f32x4 gg = *((const f32x4*)p.ln1g + lane + 64 * j), bb = *((const f32x4*)p.ln1b + lane + 64 * j);
                const f32x4 y = v[j] * rstd * gg + bb;
                *((f32x4*)(x1f + (size_t)row * D) + lane + 64 * j) = y;
                u32x2 pk = {cvt_pk(y[0], y[1]), cvt_pk(y[2], y[3])};
                *(u32x2*)(x1b + ((size_t)((lane >> 4) + 4 * j) * S + row) * 64 + ((4 * lane) & 63)) = pk;
            }
        }
        asm volatile("s_waitcnt vmcnt(0)" ::: "memory");
        __syncthreads();
        { G2Args g; g.A = (const char*)x1b; g.B = (const char*)(p.ws + WS_WR); g.nk = D / 64; g.akstep = S * 128;
          g2_rows_A<4>(g, (size_t)u * 64, 128); g.offA[1] = g.offA[0]; g2_rows_B(g, 0, D * 2);
          EpiLogits e{(float*)lds};
          gemm2<4>(lds, g, e); }
        __syncthreads();
        const f32x4 rb = *((const f32x4*)p.r_bias + lane);
        const float NEG = -__builtin_inff();
        for (int i0 = 0; i0 < 8; i0 += 4) {
            float sc[4][4], cand[4][4]; int my_e[4]; float my_s[4], gsum[4];
#pragma unroll
            for (int q = 0; q < 4; ++q) {
                const int tl = w * 8 + i0 + q;
                const f32x4 lg = *((const f32x4*)((const float*)lds + tl * 256) + lane);
#pragma unroll
                for (int j = 0; j < 4; ++j) { sc[q][j] = 1.0f / (1.0f + __expf(-lg[j])); cand[q][j] = sc[q][j] + rb[j]; }
                my_e[q] = 0; my_s[q] = 0.f; gsum[q] = 0.f;
            }
            float a1[4], a2[4];
#pragma unroll
            for (int q = 0; q < 4; ++q) { const float m01 = fmaxf(cand[q][0], cand[q][1]), n01 = fminf(cand[q][0], cand[q][1]), m23 = fmaxf(cand[q][2], cand[q][3]), n23 = fminf(cand[q][2], cand[q][3]);
              a1[q] = fmaxf(m01, m23); a2[q] = fmaxf(fminf(m01, m23), fmaxf(n01, n23)); }
#pragma unroll
            for (int off = 1; off < 8; off <<= 1) {
#pragma unroll
                for (int q = 0; q < 4; ++q) { const float b1 = __shfl_xor(a1[q], off), b2 = __shfl_xor(a2[q], off); const float n1 = fmaxf(a1[q], b1), n2 = fmaxf(fminf(a1[q], b1), fmaxf(a2[q], b2)); a1[q] = n1; a2[q] = n2; }
            }
            const int mygrp = lane >> 3;
#pragma unroll
            for (int q = 0; q < 4; ++q) {
                const float gs = a1[q] + a2[q]; int rank = 0;
#pragma unroll
                for (int g2 = 0; g2 < 8; ++g2) { const float v = __shfl(gs, g2 * 8); rank += (v > gs || (v == gs && g2 < mygrp)) ? 1 : 0; }
                if (rank >= 4) {
#pragma unroll
                    for (int j = 0; j < 4; ++j) cand[q][j] = NEG;
                }
            }
#pragma unroll
            for (int k = 0; k < 8; ++k) {
                float bv[4]; int idx[4];
#pragma unroll
                for (int q = 0; q < 4; ++q) { bv[q] = cand[q][0]; int bi = 0;
#pragma unroll
                    for (int j = 1; j < 4; ++j) if (cand[q][j] > bv[q]) { bv[q] = cand[q][j]; bi = j; }
                    idx[q] = 4 * lane + bi; }
#pragma unroll
                for (int off = 32; off >= 1; off >>= 1) {
#pragma unroll
                    for (int q = 0; q < 4; ++q) { const float ov = __shfl_xor(bv[q], off); const int oi = __shfl_xor(idx[q], off); if (ov > bv[q] || (ov == bv[q] && oi < idx[q])) { bv[q] = ov; idx[q] = oi; } }
                }
#pragma unroll
                for (int q = 0; q < 4; ++q) {
                    const int owner = idx[q] >> 2, sub = idx[q] & 3;
                    float scv = sc[q][0];
#pragma unroll
                    for (int j = 1; j < 4; ++j) scv = (sub == j) ? sc[q][j] : scv;
                    if (lane == owner) {
#pragma unroll
                        for (int j = 0; j < 4; ++j) if (sub == j) cand[q][j] = NEG;
                    }
                    const float gsc = __shfl(scv, owner);
                    if (lane == k) { my_e[q] = idx[q]; my_s[q] = gsc; }
                    gsum[q] += gsc;
                }
            }
            if (lane < 8) {
#pragma unroll
                for (int q = 0; q < 4; ++q) {
                    const int t = u * 64 + w * 8 + i0 + q;
                    const float gate = my_s[q] / gsum[q] * 2.5f;
                    const unsigned pos = atomicAdd(cnt + my_e[q], 1u);
                    list[(size_t)my_e[q] * CAP + pos] = t * 8 + lane;
                    gates[t * 8 + lane] = gate;
                }
            }
        }
        __syncthreads();
    }
}

#ifndef MOE_MT
#define MOE_MT 8
#endif
constexpr int MOE_BM = 32 * MOE_MT;
struct EpiAct {
    bf16_t* act; const int* slots; int ncol0;
    __device__ __forceinline__ void operator()(f32x4 (&acc)[MOE_MT][4], int wr, int wc, int fr, int fq) const {
#pragma unroll
        for (int mt = 0; mt < MOE_MT; ++mt) {
            const int ar = slots[wr * 16 * MOE_MT + mt * 16 + fr];
            if (ar >= 0) {
#pragma unroll
                for (int nt = 0; nt < 2; ++nt) {
                    const f32x4 gv = acc[mt][nt], uv = acc[mt][nt + 2]; float a[4];
#pragma unroll
                    for (int j = 0; j < 4; ++j) { const float gq = gv[j] * W8_INV; a[j] = gq / (1.0f + __expf(-gq)) * (uv[j] * W8_INV); }
                    u32x2 pk = {cvt_pk(a[0], a[1]), cvt_pk(a[2], a[3])};
                    *(u32x2*)(act + (size_t)ar * FF + ncol0 + wc * 32 + nt * 16 + 4 * fq) = pk;
                }
            }
        }
    }
};
struct EpiY {
    bf16_t* y; const int* yrows; const float* gl; int col0;
    __device__ __forceinline__ void operator()(f32x4 (&acc)[MOE_MT][4], int wr, int wc, int fr, int fq) const {
#pragma unroll
        for (int mt = 0; mt < MOE_MT; ++mt) {
            const int r = wr * 16 * MOE_MT + mt * 16 + fr, yr = yrows[r];
            if (yr >= 0) {
                const float gt = gl[r] * W8_INV;
#pragma unroll
                for (int nt = 0; nt < 4; ++nt) {
                    const f32x4 v = acc[mt][nt] * gt;
                    u32x2 pk = {cvt_pk(v[0], v[1]), cvt_pk(v[2], v[3])};
                    *(u32x2*)(y + (size_t)yr * D + col0 + wc * 64 + nt * 16 + 4 * fq) = pk;
                }
            }
        }
    }
};
__device__ __forceinline__ void phase_experts(const Params& p, char* lds, int vb, int G) {
    const int tid0 = threadIdx.x, w = __builtin_amdgcn_readfirstlane(tid0 >> 6);
    const unsigned* cnt = (const unsigned*)(p.ws + WS_CTL); const int* list = (const int*)(p.ws + WS_LIST); const float* gates = (const float*)(p.ws + WS_GATE);
    bf16_t* act = (bf16_t*)(p.ws + WS_ACT); bf16_t* ybuf = (bf16_t*)(p.ws + WS_Y);
    int* nts = (int*)(lds + LDS_MISC); int* pre = nts + 256;
    int* s_arow = pre + 260; int* s_yrow = s_arow + MOE_BM; int* s_tok = s_yrow + MOE_BM; float* s_gate = (float*)(s_tok + MOE_BM);
    if (tid0 < 256) nts[tid0] = (int)((__hip_atomic_load(cnt + tid0, __ATOMIC_RELAXED, __HIP_MEMORY_SCOPE_AGENT) + (MOE_BM - 1)) / MOE_BM);
    __syncthreads();
    if (tid0 < 257) { int s = 0; for (int e = 0; e < tid0; ++e) s += nts[e]; pre[tid0] = s; }
    __syncthreads();
    const int NR = __builtin_amdgcn_readfirstlane(pre[256]), NU = NR + S / MOE_BM;
    for (int u = vb; u < NU; u += G) {
        __syncthreads();
        int tid = threadIdx.x; asm volatile("" : "+v"(tid));
        const int lane = tid & 63; const unsigned co = g2_chunk_off(lane, w);
        const unsigned char *bg, *bu, *bd;
        if (u < NR) {
            int lo = 0, hi = 255;
            while (lo < hi) { const int mid = (lo + hi + 1) >> 1; if (pre[mid] <= u) lo = mid; else hi = mid - 1; }
            const int e = lo, tile = u - pre[e], n = (int)__hip_atomic_load(cnt + e, __ATOMIC_RELAXED, __HIP_MEMORY_SCOPE_AGENT);
            if (tid < MOE_BM) {
                const int idx = tile * MOE_BM + tid;
                if (idx < n) { const int slot = list[(size_t)e * CAP + idx]; s_arow[tid] = slot; s_yrow[tid] = slot + (slot >> 3); s_tok[tid] = slot >> 3; s_gate[tid] = gates[slot]; }
                else { s_arow[tid] = -1; s_yrow[tid] = -1; s_tok[tid] = 0; s_gate[tid] = 0.f; }
            }
            bg = (const unsigned char*)(p.ws + WS_EGU) + (size_t)e * 524288; bu = bg + 262144; bd = (const unsigned char*)(p.ws + WS_ED) + (size_t)e * 262144;
        } else {
            const int tile = u - NR;
            if (tid < MOE_BM) { const int tk = tile * MOE_BM + tid; s_arow[tid] = S * 8 + tk; s_yrow[tid] = tk * 9 + 8; s_tok[tid] = tk; s_gate[tid] = 1.0f; }
            bg = (const unsigned char*)(p.ws + WS_WSGU); bu = bg + 262144; bd = (const unsigned char*)(p.ws + WS_WSD);
        }
        __syncthreads();
        for (int np = 0; np < 2; ++np) {
            G3bArgs g; g.A = (const char*)(p.ws + WS_X1B); g.nk = D / 64; g.ldb = FF; g.akstep = S * 128;
#pragma unroll
            for (int i = 0; i < MOE_MT / 2; ++i) g.offA[i] = (unsigned)s_tok[i * 64 + w * 8 + (lane >> 3)] * 128u + co;
            { const int n0 = 4 * lane, bwc = n0 >> 6, sub = n0 & 63;
              g.b = ((sub < 32) ? bg : bu) + np * 128 + bwc * 32 + (sub & 31) + (size_t)(w * 8) * FF; }
            EpiAct e{act, s_arow, np * 128};
            gemm3b<MOE_MT>(lds, g, e);
        }
        asm volatile("s_waitcnt vmcnt(0)" ::: "memory");
        __syncthreads();
        for (int np = 0; np < 4; ++np) {
            G3bArgs g; g.A = (const char*)act; g.nk = FF / 64; g.ldb = D; g.akstep = 128;
#pragma unroll
            for (int i = 0; i < MOE_MT / 2; ++i) { const int ar = s_arow[i * 64 + w * 8 + (lane >> 3)]; g.offA[i] = (unsigned)(ar < 0 ? 0 : ar) * (unsigned)(FF * 2) + co; }
            g.b = bd + (size_t)(w * 8) * D + np * 256 + 4 * lane;
            EpiY e{ybuf, s_yrow, s_gate, np * 256};
            gemm3b<MOE_MT>(lds, g, e);
        }
    }
}

__device__ __forceinline__ void phase_final(const Params& p, int vb, int G) {
    const int lane = threadIdx.x & 63, w = threadIdx.x >> 6;
    const float* x1f = (const float*)(p.ws + WS_X1F); const bf16_t* ybuf = (const bf16_t*)(p.ws + WS_Y);
    for (int row = vb * 8 + w; row < S; row += G * 8) {
        f32x4 v[4]; float s = 0.f;
#pragma unroll
        for (int j = 0; j < 4; ++j) v[j] = *((const f32x4*)(x1f + (size_t)row * D) + lane + 64 * j) * ALPHA;
#pragma unroll
        for (int k = 0; k < 9; ++k) {
            const u32x2* yr = (const u32x2*)(ybuf + (size_t)(row * 9 + k) * D) + lane;
#pragma unroll
            for (int j = 0; j < 4; ++j) { const u32x2 q = yr[64 * j]; v[j][0] += bf_lo(q[0]); v[j][1] += bf_hi(q[0]); v[j][2] += bf_lo(q[1]); v[j][3] += bf_hi(q[1]); }
        }
#pragma unroll
        for (int j = 0; j < 4; ++j) s += (v[j][0] + v[j][1]) + (v[j][2] + v[j][3]);
        const float mean = wave_sum(s) * (1.0f / D); float s2 = 0.f;
#pragma unroll
        for (int j = 0; j < 4; ++j) { v[j] = v[j] - mean; s2 += (v[j][0] * v[j][0] + v[j][1] * v[j][1]) + (v[j][2] * v[j][2] + v[j][3] * v[j][3]); }
        const float rstd = rsqrtf(wave_sum(s2) * (1.0f / D) + LN_EPS);
#pragma unroll
        for (int j = 0; j < 4; ++j) {
            const f32x4 gg = *((const f32x4*)p.ln2g + lane + 64 * j), bb = *((const f32x4*)p.ln2b + lane + 64 * j);
            *((f32x4*)(p.out + (size_t)row * D) + lane + 64 * j) = v[j] * rstd * gg + bb;
        }
    }
}

__global__ void __launch_bounds__(NTHREADS) mega(Params p) {
    extern __shared__ __attribute__((aligned(16))) char lds[];
    const int G = gridDim.x, bx = blockIdx.x;
    const int vb = (G % 8 == 0) ? (bx % 8) * (G / 8) + bx / 8 : bx;
    if (threadIdx.x < 4) ((volatile LAS unsigned*)((LAS char*)lds + LDS_BARST))[threadIdx.x] = 0u;
    __syncthreads();
    XcdBarrier bar; bar.bar = (unsigned*)(p.ws + WS_CTL) + CW_BAR; bar.x = 0; bar.st = nullptr;
    if (p.ph_hi - p.ph_lo > 1) bar = xcd_barrier_post((unsigned*)(p.ws + WS_CTL) + CW_BAR, (volatile LAS unsigned*)((LAS char*)lds + LDS_BARST));
#define SEAM(k) do { if (p.ph_lo <= (k) && (k) + 1 < p.ph_hi) { xcd_barrier(bar); } } while (0)
#define IN(k) (p.ph_lo <= (k) && (k) < p.ph_hi)
#define RUN(k, call) do { if (IN(k)) { call; if (MK_REPEAT == (k)) { __syncthreads(); call; } } } while (0)
    RUN(0, phase_prep(p, vb, G)); SEAM(0);
    RUN(1, phase_proj(p, lds, vb, G)); SEAM(1);
    RUN(2, phase_attn(p, lds, vb, G)); SEAM(2);
    RUN(3, phase_wout(p, lds, vb, G)); SEAM(3);
    if (IN(4)) { phase_router(p, lds, vb, G); } SEAM(4);
    RUN(5, phase_experts(p, lds, vb, G)); SEAM(5);
    RUN(6, phase_final(p, vb, G));
#undef SEAM
#undef IN
#undef RUN
}

extern "C" void kernel_launch(void* const* d_in, const int* in_sizes, int n_in, void* d_out, int out_size, void* d_ws, size_t ws_size, hipStream_t stream) {
    static int grid = 0;
    if (grid == 0) {
        if (n_in != 22 || in_sizes[0] != S * D || out_size != S * D || ws_size < WS_END) {
            fprintf(stderr, "kernel_launch: unexpected shapes: n_in %d in0 %d out %d ws %zu (need %zu)\n", n_in, n_in > 0 ? in_sizes[0] : -1, out_size, ws_size, (size_t)WS_END); grid = -1; return; }
        int dev = 0, cus = 0, per_cu = 0;
        (void)hipGetDevice(&dev); (void)hipDeviceGetAttribute(&cus, hipDeviceAttributeMultiprocessorCount, dev);
        if (hipFuncSetAttribute((const void*)mega, hipFuncAttributeMaxDynamicSharedMemorySize, LDS_BYTES) != hipSuccess) { fprintf(stderr, "kernel_launch: hipFuncSetAttribute failed\n"); grid = -1; return; }
        (void)hipOccupancyMaxActiveBlocksPerMultiprocessor(&per_cu, (const void*)mega, NTHREADS, LDS_BYTES);
        if (per_cu < 1) { fprintf(stderr, "kernel_launch: occupancy query says %d blocks per CU\n", per_cu); per_cu = 1; }
        grid = cus * 1;
        (void)hipGetLastError();
    }
    if (grid < 0) return;
    (void)hipMemsetAsync((char*)d_ws + WS_CTL, 0, CTL_BYTES, stream);
    Params p{};
    const float** f = (const float**)&p;
    for (int i = 0; i < 22; ++i) f[i] = (const float*)d_in[i];
    p.out = (float*)d_out; p.ws = (unsigned char*)d_ws;
#if MK_ONE_LAUNCH
    p.ph_lo = 0; p.ph_hi = 7;
    void* args[] = {&p};
    hipError_t e = hipLaunchCooperativeKernel((const void*)mega, dim3(grid), dim3(NTHREADS), args, LDS_BYTES, stream);
    if (e != hipSuccess) fprintf(stderr, "kernel_launch: cooperative launch failed: %s (grid %d)\n", hipGetErrorString(e), grid);
#else
    for (int ph = 0; ph < 7; ++ph) {
        p.ph_lo = ph; p.ph_hi = ph + 1;
        hipLaunchKernelGGL(mega, dim3(grid), dim3(NTHREADS), LDS_BYTES, stream, p);
    }
#endif
}
```

```cpp
#include <hip/hip_runtime.h>
#include <hip/hip_cooperative_groups.h>
#include <cstdio>
#include <cstdint>
namespace cg = cooperative_groups;

#ifndef MK_REPEAT
#define MK_REPEAT -1
#endif
#ifndef MK_ONE_LAUNCH
#define MK_ONE_LAUNCH 1
#endif

constexpr int S = 16384, D = 1024, INW = 2304, NE = 256, FF = 256;
constexpr int NTHREADS = 512;
constexpr int CAP = 16384;
constexpr float ALPHA = 1.189207115002721f;
constexpr float LN_EPS = 1e-5f;
constexpr float QSCALE = 0.125f * 1.4426950408889634f;
constexpr float LOG2E = 1.4426950408889634f;
constexpr int C_AQ = 0, C_AK = 512, C_AV = 640, C_BQ = 768, C_BK = 1280, C_BV = 1792;

constexpr size_t MiB = 1ull << 20;
constexpr size_t WS_CTL = 0;
constexpr size_t CTL_BYTES = 128 * 1024;
constexpr int CNT_STRIDE = 64;
constexpr size_t WS_ROPE = 1 * MiB;
constexpr size_t WS_WIN = 8 * MiB;
constexpr size_t WS_WOUT = 13 * MiB;
constexpr size_t WS_WR = 15 * MiB;
constexpr size_t WS_WSGU = 16 * MiB;
constexpr size_t WS_WSD = 17 * MiB;
constexpr size_t WS_EGU = 20 * MiB;
constexpr size_t WS_ED = 276 * MiB;
constexpr size_t WS_X1F = 404 * MiB;
constexpr size_t WS_X1B = 468 * MiB;
constexpr size_t WS_LIST = 500 * MiB;
constexpr size_t WS_GATE = 516 * MiB;
constexpr size_t WS_ACT = 518 * MiB;
constexpr size_t WS_Y = 590 * MiB;
constexpr size_t WS_XB = 590 * MiB;
constexpr size_t WS_PROJ = 622 * MiB;
constexpr size_t WS_ATT = 694 * MiB;
constexpr size_t WS_PRELN = 726 * MiB;
constexpr size_t WS_END = 878 * MiB;

constexpr int LDS_BYTES = 147456;
constexpr int LDS_MISC = 131072;

typedef unsigned short bf16_t;
typedef short bf16x8 __attribute__((ext_vector_type(8)));
typedef short s16x4 __attribute__((ext_vector_type(4)));
typedef float f32x4 __attribute__((ext_vector_type(4)));
typedef float f32x16 __attribute__((ext_vector_type(16)));
typedef unsigned u32x4 __attribute__((ext_vector_type(4)));
typedef unsigned u32x2 __attribute__((ext_vector_type(2)));
typedef float f32x2 __attribute__((ext_vector_type(2)));


#define LAS __attribute__((address_space(3)))
#define XB_TMO      128
#define XB_XCNT(j)  (256  + 64 * (j))
#define XB_XSUB(j)  (1280 + 64 * (j))
#define XB_XGEN(j)  (2304 + 64 * (j))
#define XB_TOP      3328
#define XB_TOPGEN   3392
#define XCD_BAR_WORDS 3456
#define XB_SPIN_CAP (1u << 18)
__device__ __forceinline__ unsigned xb_ld(unsigned* p)              { return __hip_atomic_load(p, __ATOMIC_RELAXED, __HIP_MEMORY_SCOPE_AGENT); }
__device__ __forceinline__ unsigned xb_add(unsigned* p, unsigned v) { return __hip_atomic_fetch_add(p, v, __ATOMIC_RELAXED, __HIP_MEMORY_SCOPE_AGENT); }
__device__ __forceinline__ unsigned xb_xcc_id() { return (unsigned)__builtin_amdgcn_s_getreg((3 << 11) | 20) & 0xFu; }
#define XB_SPIN(cond, bar) do { unsigned _sp = 0; while (cond) { __builtin_amdgcn_s_sleep(1); \
    if ((++_sp & 255u) == 0u) { if (xb_ld(&(bar)[XB_TMO])) break; if (_sp > XB_SPIN_CAP) { atomicAdd(&(bar)[XB_TMO], 1u); break; } } } } while (0)
struct XcdBarrier { unsigned* bar; unsigned x; volatile LAS unsigned* st; };
__device__ __forceinline__ XcdBarrier xcd_barrier_post(unsigned* bar, volatile LAS unsigned* st) {
    XcdBarrier b; b.bar = bar; b.x = xb_xcc_id(); b.st = st;
    if (threadIdx.x == 0) (void)xb_add(&bar[XB_XCNT(b.x)], 1u);
    return b;
}
__device__ __forceinline__ void xcd_barrier_complete(unsigned* bar, unsigned x, unsigned& nloc, unsigned& nx) {
    const unsigned G = gridDim.x * gridDim.y * gridDim.z;
    unsigned sum, cnt, mine, sp = 0u;
    for (;;) {
        sum = 0u; cnt = 0u; mine = 0u;
#pragma unroll
        for (unsigned j = 0; j < 16; ++j) { const unsigned c = xb_ld(&bar[XB_XCNT(j)]); sum += c; cnt += (c > 0u) ? 1u : 0u; mine = (j == x) ? c : mine; }
        if (sum == G) break;
        __builtin_amdgcn_s_sleep(1);
        if ((++sp & 255u) == 0u) { if (xb_ld(&bar[XB_TMO])) break; if (sp > XB_SPIN_CAP) { atomicAdd(&bar[XB_TMO], 1u); break; } }
    }
    nloc = mine > 0u ? mine : 1u; nx = cnt > 0u ? cnt : 1u;
}
__device__ __forceinline__ void xcd_barrier(const XcdBarrier& b) {
    asm volatile("s_waitcnt vmcnt(0)" ::: "memory");
    __syncthreads();
    if (threadIdx.x == 0) {
        unsigned* bar = b.bar;
        __builtin_amdgcn_s_waitcnt(0);
        unsigned nloc = b.st[0], nx = b.st[1];
        if (nloc == 0u) { xcd_barrier_complete(bar, b.x, nloc, nx); b.st[0] = nloc; b.st[1] = nx; }
        const unsigned old = xb_add(&bar[XB_XSUB(b.x)], 1u);
        const unsigned gen = old / nloc;
        if (old + 1u == (gen + 1u) * nloc) {
            __builtin_amdgcn_fence(__ATOMIC_RELEASE, "agent");
            asm volatile("s_waitcnt vmcnt(0)" ::: "memory");
            const unsigned og = xb_add(&bar[XB_TOP], 1u);
            const unsigned tg = og / nx;
            if (og + 1u == (tg + 1u) * nx) xb_add(&bar[XB_TOPGEN], 1u);
            else XB_SPIN(xb_ld(&bar[XB_TOPGEN]) == tg, bar);
            __builtin_amdgcn_fence(__ATOMIC_ACQUIRE, "agent");
            xb_add(&bar[XB_XGEN(b.x)], 1u);
            asm volatile("s_waitcnt vmcnt(0)" ::: "memory");
        } else {
            XB_SPIN(xb_ld(&bar[XB_XGEN(b.x)]) == gen, bar);
            __builtin_amdgcn_fence(__ATOMIC_ACQUIRE, "agent");
            asm volatile("s_waitcnt vmcnt(0)" ::: "memory");
        }
    }
    __syncthreads();
}
constexpr int CW_BAR = 4096;
constexpr int LDS_BARST = LDS_MISC + 8192;

struct Params {
    const float* x; const float* w_in; const float* b_in; const float* sinks;
    const float* lq1; const float* lk1; const float* lq2; const float* lk2; const float* subg;
    const float* w_out; const float* ln1g; const float* ln1b; const float* w_r; const float* r_bias;
    const float* w_g; const float* w_u; const float* w_d; const float* ws_g; const float* ws_u; const float* ws_d;
    const float* ln2g; const float* ln2b;
    float* out; unsigned char* ws;
    int ph_lo, ph_hi;
};

__device__ __forceinline__ unsigned cvt_pk(float lo, float hi) { unsigned r; asm volatile("v_cvt_pk_bf16_f32 %0, %1, %2" : "=v"(r) : "v"(lo), "v"(hi)); return r; }
constexpr float W8_SCALE = 256.0f, W8_INV = 1.0f / 256.0f;
__device__ __forceinline__ unsigned pack_fp8x4(f32x4 v) {
    v = v * W8_SCALE;
#pragma unroll
    for (int i = 0; i < 4; ++i) v[i] = fminf(fmaxf(v[i], -448.0f), 448.0f);
    int w = 0; w = __builtin_amdgcn_cvt_pk_fp8_f32(v[0], v[1], w, false); w = __builtin_amdgcn_cvt_pk_fp8_f32(v[2], v[3], w, true); return (unsigned)w;
}
__device__ __forceinline__ float bf_lo(unsigned u) { return __uint_as_float(u << 16); }
__device__ __forceinline__ float bf_hi(unsigned u) { return __uint_as_float(u & 0xffff0000u); }
__device__ __forceinline__ float wave_sum(float v) {
#pragma unroll
    for (int o = 1; o < 64; o <<= 1) v += __shfl_xor(v, o);
    return v;
}
__device__ __forceinline__ float half_max(float v) { auto rr = __builtin_amdgcn_permlane32_swap(__float_as_uint(v), __float_as_uint(v), false, false); return fmaxf(__uint_as_float(rr[0]), __uint_as_float(rr[1])); }
__device__ __forceinline__ float half_sum(float v) { auto rr = __builtin_amdgcn_permlane32_swap(__float_as_uint(v), __float_as_uint(v), false, false); return __uint_as_float(rr[0]) + __uint_as_float(rr[1]); }

__device__ __forceinline__ int swz(int r, int c) { const int f = (r & 7) ^ (((r >> 3) & 1) << 1) ^ ((r >> 4) & 1); return r * 128 + ((c ^ f) << 4); }

struct G2Args {
    const char* A; const char* B;
    unsigned offA[4], offB[4];
    int nk;
    unsigned akstep;
};
__device__ __forceinline__ unsigned g2_chunk_off(int lane, int w) { const int f = (lane >> 3) ^ ((w & 1) << 1) ^ ((w >> 1) & 1); return (unsigned)(((lane & 7) ^ f) << 4); }
template <int MT, class Epi>
__device__ __forceinline__ void gemm2(char* lds_, const G2Args& g, const Epi& epi) {
    constexpr int A_BYTES = 32 * MT * 128, B_BYTES = 256 * 128, STAGE = A_BYTES + B_BYTES, AR = MT / 2;
    LAS char* lds = (LAS char*)lds_;
    const int tid = threadIdx.x, lane = tid & 63, w = __builtin_amdgcn_readfirstlane(tid >> 6), wr = w >> 2, wc = w & 3, fr = lane & 15, fq = lane >> 4;
    f32x4 acc[MT][4];
#pragma unroll
    for (int i = 0; i < MT; ++i)
#pragma unroll
        for (int j = 0; j < 4; ++j) acc[i][j] = (f32x4){0.f, 0.f, 0.f, 0.f};
    const int ldsw = w * 1024;
#define G2_STAGE(kt, s) do { \
        _Pragma("unroll") for (int i = 0; i < AR; ++i) __builtin_amdgcn_global_load_lds((const unsigned*)(g.A + g.offA[i] + (size_t)(kt) * g.akstep), (LAS unsigned*)(lds + (s) * STAGE + i * 8192 + ldsw), 16, 0, 0); \
        _Pragma("unroll") for (int i = 0; i < 4; ++i) __builtin_amdgcn_global_load_lds((const unsigned*)(g.B + g.offB[i] + (size_t)(kt) * 128), (LAS unsigned*)(lds + (s) * STAGE + A_BYTES + i * 8192 + ldsw), 16, 0, 0); } while (0)
    G2_STAGE(0, 0);
    __syncthreads();
    for (int kt = 0; kt < g.nk; ++kt) {
        const int s = kt & 1;
        if (kt + 1 < g.nk) { if (s) G2_STAGE(kt + 1, 0); else G2_STAGE(kt + 1, 1); }
        const char* la = lds_ + s * STAGE; const char* lb = la + A_BYTES;
        {
            constexpr int NG = 2 * (MT / 4);
            bf16x8 bfr[4], af[2][4];
#pragma unroll
            for (int nt = 0; nt < 4; ++nt) bfr[nt] = *(const bf16x8*)(lb + swz(wc * 64 + nt * 16 + fr, fq));
#pragma unroll
            for (int m = 0; m < 4; ++m) af[0][m] = *(const bf16x8*)(la + swz(wr * 16 * MT + m * 16 + fr, fq));
#pragma unroll
            for (int gi = 0; gi < NG; ++gi) {
                const int ks = gi / (MT / 4), h = gi % (MT / 4);
                if (gi > 0 && h == 0) {
#pragma unroll
                    for (int nt = 0; nt < 4; ++nt) bfr[nt] = *(const bf16x8*)(lb + swz(wc * 64 + nt * 16 + fr, ks * 4 + fq));
                }
                if (gi + 1 < NG) {
                    const int ks2 = (gi + 1) / (MT / 4), h2 = (gi + 1) % (MT / 4);
#pragma unroll
                    for (int m = 0; m < 4; ++m) af[(gi + 1) & 1][m] = *(const bf16x8*)(la + swz(wr * 16 * MT + (h2 * 4 + m) * 16 + fr, ks2 * 4 + fq));
                }
                __builtin_amdgcn_sched_barrier(0);
#pragma unroll
                for (int m = 0; m < 4; ++m)
#pragma unroll
                    for (int nt = 0; nt < 4; ++nt) acc[h * 4 + m][nt] = __builtin_amdgcn_mfma_f32_16x16x32_bf16(bfr[nt], af[gi & 1][m], acc[h * 4 + m][nt], 0, 0, 0);
                __builtin_amdgcn_sched_barrier(0);
            }
        }
        __syncthreads();
    }
#undef G2_STAGE
    epi(acc, wr, wc, fr, fq);
}
template <int MT>
__device__ __forceinline__ void g2_rows_A(G2Args& g, size_t row0, unsigned ld_bytes) {
    const int lane = threadIdx.x & 63, w = __builtin_amdgcn_readfirstlane(threadIdx.x >> 6); const unsigned co = g2_chunk_off(lane, w);
#pragma unroll
    for (int i = 0; i < MT / 2; ++i) g.offA[i] = (unsigned)((row0 + i * 64 + w * 8 + (lane >> 3)) * ld_bytes) + co;
}
__device__ __forceinline__ void g2_rows_B(G2Args& g, size_t row0, unsigned ld_bytes) {
    const int lane = threadIdx.x & 63, w = __builtin_amdgcn_readfirstlane(threadIdx.x >> 6); const unsigned co = g2_chunk_off(lane, w);
#pragma unroll
    for (int i = 0; i < 4; ++i) g.offB[i] = (unsigned)((row0 + i * 64 + w * 8 + (lane >> 3)) * ld_bytes) + co;
}


struct G3Args { const char* A; unsigned offA[4]; const float* b; int ldb; int nk; };
template <int MT, class Epi>
__device__ __forceinline__ void gemm3(char* lds_, const G3Args& g, const Epi& epi) {
    constexpr int A_BYTES = 32 * MT * 128, B_BYTES = 256 * 128, STAGE = A_BYTES + B_BYTES, AR = MT / 2;
    LAS char* lds = (LAS char*)lds_;
    const int tid = threadIdx.x, lane = tid & 63, w = __builtin_amdgcn_readfirstlane(tid >> 6), wr = w >> 2, wc = w & 3, fr = lane & 15, fq = lane >> 4;
    f32x4 acc[MT][4];
#pragma unroll
    for (int i = 0; i < MT; ++i)
#pragma unroll
        for (int j = 0; j < 4; ++j) acc[i][j] = (f32x4){0.f, 0.f, 0.f, 0.f};
    const int ldsw = w * 1024;
    int bw[4];
#pragma unroll
    for (int j = 0; j < 4; ++j) bw[j] = swz(4 * lane + j, w);
    f32x4 br[8]; const float* pb = g.b;
#define G3_STAGE_A(kt, s) do { \
        _Pragma("unroll") for (int i = 0; i < AR; ++i) __builtin_amdgcn_global_load_lds((const unsigned*)(g.A + g.offA[i] + (size_t)(kt) * 128), (LAS unsigned*)(lds + (s) * STAGE + i * 8192 + ldsw), 16, 0, 0); } while (0)
#define G3_LOAD_B() do { _Pragma("unroll") for (int i = 0; i < 8; ++i) br[i] = *(const f32x4*)(pb + (size_t)i * g.ldb); pb += (size_t)64 * g.ldb; } while (0)
#define G3_WRITE_B(s) do { _Pragma("unroll") for (int j = 0; j < 4; ++j) { \
            u32x4 v = {cvt_pk(br[0][j], br[1][j]), cvt_pk(br[2][j], br[3][j]), cvt_pk(br[4][j], br[5][j]), cvt_pk(br[6][j], br[7][j])}; \
            *(u32x4*)(lds_ + (s) * STAGE + A_BYTES + bw[j]) = v; } } while (0)
    G3_STAGE_A(0, 0); G3_LOAD_B(); G3_WRITE_B(0);
    __syncthreads();
    for (int kt = 0; kt < g.nk; ++kt) {
        const int s = kt & 1; const bool more = kt + 1 < g.nk;
        if (more) { if (s) G3_STAGE_A(kt + 1, 0); else G3_STAGE_A(kt + 1, 1); G3_LOAD_B(); }
        __builtin_amdgcn_sched_barrier(0);
        const char* la = lds_ + s * STAGE; const char* lb = la + A_BYTES;
#pragma unroll
        for (int ks = 0; ks < 2; ++ks) {
            bf16x8 bfr[4];
#pragma unroll
            for (int nt = 0; nt < 4; ++nt) bfr[nt] = *(const bf16x8*)(lb + swz(wc * 64 + nt * 16 + fr, ks * 4 + fq));
#pragma unroll
            for (int h = 0; h < MT / 4; ++h) {
                bf16x8 af[4];
#pragma unroll
                for (int m = 0; m < 4; ++m) af[m] = *(const bf16x8*)(la + swz(wr * 16 * MT + (h * 4 + m) * 16 + fr, ks * 4 + fq));
#pragma unroll
                for (int m = 0; m < 4; ++m)
#pragma unroll
                    for (int nt = 0; nt < 4; ++nt) acc[h * 4 + m][nt] = __builtin_amdgcn_mfma_f32_16x16x32_bf16(bfr[nt], af[m], acc[h * 4 + m][nt], 0, 0, 0);
            }
        }
        if (more) { if (s) G3_WRITE_B(0); else G3_WRITE_B(1); }
        __syncthreads();
    }
#undef G3_STAGE_A
#undef G3_LOAD_B
#undef G3_WRITE_B
    epi(acc, wr, wc, fr, fq);
}


struct G3bArgs { const char* A; unsigned offA[4]; const unsigned char* b; int ldb; int nk; unsigned akstep; };
template <int MT, class Epi>
__device__ __forceinline__ void gemm3b(char* lds_, const G3bArgs& g, const Epi& epi) {
    constexpr int A_BYTES = 32 * MT * 128, B_BYTES = 256 * 128, STAGE = A_BYTES + B_BYTES, AR = MT / 2;
    LAS char* lds = (LAS char*)lds_;
    const int tid = threadIdx.x, lane = tid & 63, w = __builtin_amdgcn_readfirstlane(tid >> 6), wr = w >> 2, wc = w & 3, fr = lane & 15, fq = lane >> 4;
    f32x4 acc[MT][4];
#pragma unroll
    for (int i = 0; i < MT; ++i)
#pragma unroll
        for (int j = 0; j < 4; ++j) acc[i][j] = (f32x4){0.f, 0.f, 0.f, 0.f};
    const int ldsw = w * 1024;
    int bw[4];
#pragma unroll
    for (int j = 0; j < 4; ++j) bw[j] = swz(4 * lane + j, w);
    unsigned br[8]; const unsigned char* pb = g.b;
#define G3_STAGE_A(kt, s) do { \
        _Pragma("unroll") for (int i = 0; i < AR; ++i) __builtin_amdgcn_global_load_lds((const unsigned*)(g.A + g.offA[i] + (size_t)(kt) * g.akstep), (LAS unsigned*)(lds + (s) * STAGE + i * 8192 + ldsw), 16, 0, 0); } while (0)
#define G3_LOAD_B() do { _Pragma("unroll") for (int i = 0; i < 8; ++i) br[i] = *(const unsigned*)(pb + (size_t)i * g.ldb); pb += (size_t)64 * g.ldb; } while (0)
#define G3_WRITE_B(s) do { _Pragma("unroll") for (int hh = 0; hh < 2; ++hh) { f32x2 f[8]; \
            _Pragma("unroll") for (int i = 0; i < 8; ++i) f[i] = hh ? __builtin_amdgcn_cvt_pk_f32_fp8((int)br[i], true) : __builtin_amdgcn_cvt_pk_f32_fp8((int)br[i], false); \
            _Pragma("unroll") for (int jj = 0; jj < 2; ++jj) { \
                u32x4 v = {cvt_pk(f[0][jj], f[1][jj]), cvt_pk(f[2][jj], f[3][jj]), cvt_pk(f[4][jj], f[5][jj]), cvt_pk(f[6][jj], f[7][jj])}; \
                *(u32x4*)(lds_ + (s) * STAGE + A_BYTES + bw[hh * 2 + jj]) = v; } } } while (0)
    G3_STAGE_A(0, 0); G3_LOAD_B(); G3_WRITE_B(0);
    __syncthreads();
    for (int kt = 0; kt < g.nk; ++kt) {
        const int s = kt & 1; const bool more = kt + 1 < g.nk;
        if (more) { if (s) G3_STAGE_A(kt + 1, 0); else G3_STAGE_A(kt + 1, 1); G3_LOAD_B(); }
        __builtin_amdgcn_sched_barrier(0);
        const char* la = lds_ + s * STAGE; const char* lb = la + A_BYTES;
#pragma unroll
        for (int ks = 0; ks < 2; ++ks) {
            bf16x8 bfr[4];
#pragma unroll
            for (int nt = 0; nt < 4; ++nt) bfr[nt] = *(const bf16x8*)(lb + swz(wc * 64 + nt * 16 + fr, ks * 4 + fq));
#pragma unroll
            for (int h = 0; h < MT / 4; ++h) {
                bf16x8 af[4];
#pragma unroll
                for (int m = 0; m < 4; ++m) af[m] = *(const bf16x8*)(la + swz(wr * 16 * MT + (h * 4 + m) * 16 + fr, ks * 4 + fq));
                __builtin_amdgcn_sched_barrier(0);
#pragma unroll
                for (int m = 0; m < 4; ++m)
#pragma unroll
                    for (int nt = 0; nt < 4; ++nt) acc[h * 4 + m][nt] = __builtin_amdgcn_mfma_f32_16x16x32_bf16(bfr[nt], af[m], acc[h * 4 + m][nt], 0, 0, 0);
                __builtin_amdgcn_sched_barrier(0);
            }
        }
        if (more) { if (s) G3_WRITE_B(0); else G3_WRITE_B(1); }
        __syncthreads();
    }
#undef G3_STAGE_A
#undef G3_LOAD_B
#undef G3_WRITE_B
    epi(acc, wr, wc, fr, fq);
}

__device__ __forceinline__ void cvt_item(const float* W, int K, int N, bf16_t* WT, int ldt, int kb, int nb, int lane) {
    const float* src = W + (size_t)(kb * 64) * N + nb * 256 + 4 * lane;
    bf16_t* dst = WT + (size_t)(nb * 256 + 4 * lane) * ldt + kb * 64;
#pragma unroll 2
    for (int kc = 0; kc < 8; ++kc) {
        f32x4 r[8];
#pragma unroll
        for (int i = 0; i < 8; ++i) r[i] = *(const f32x4*)(src + (size_t)(kc * 8 + i) * N);
#pragma unroll
        for (int j = 0; j < 4; ++j) {
            u32x4 v = {cvt_pk(r[0][j], r[1][j]), cvt_pk(r[2][j], r[3][j]), cvt_pk(r[4][j], r[5][j]), cvt_pk(r[6][j], r[7][j])};
            *(u32x4*)(dst + (size_t)j * ldt + kc * 8) = v;
        }
    }
}
__device__ __forceinline__ void phase_prep(const Params& p, int vb, int G) {
    const int tid = threadIdx.x, lane = tid & 63, w = tid >> 6;
    float* cs = (float*)(p.ws + WS_ROPE); float* sn = cs + (size_t)S * 32;
    for (int idx = vb * NTHREADS + tid; idx < S * 32; idx += G * NTHREADS) {
        const int pos = idx >> 5, i = idx & 31;
        const float pw = (float)pow(10000.0, (double)i / 32.0);
        const float inv = 1.0f / pw;
        const float angf = __fmul_rn((float)pos, inv);
        const double a = (double)angf;
        const double q = rint(a * 0.63661977236758134308);
        double r = fma(-q, 1.57079632679489655800, a); r = fma(-q, 6.12323399573676603587e-17, r);
        const double r2 = r * r;
        double sp = r * (1.0 + r2 * (-1.0 / 6 + r2 * (1.0 / 120 + r2 * (-1.0 / 5040 + r2 * (1.0 / 362880 + r2 * (-1.0 / 39916800))))));
        double cp = 1.0 + r2 * (-0.5 + r2 * (1.0 / 24 + r2 * (-1.0 / 720 + r2 * (1.0 / 40320 + r2 * (-1.0 / 3628800 + r2 * (1.0 / 479001600))))));
        const int qi = ((int)((long long)q)) & 3;
        double sv, cv;
        if (qi == 0) { sv = sp; cv = cp; } else if (qi == 1) { sv = cp; cv = -sp; } else if (qi == 2) { sv = -sp; cv = -cp; } else { sv = -cp; cv = sp; }
        cs[idx] = (float)cv; sn[idx] = (float)sv;
    }
    { const f32x4* xs = (const f32x4*)p.x; u32x4* xd = (u32x4*)(p.ws + WS_XB);
      for (size_t i = (size_t)vb * NTHREADS + tid; i < (size_t)S * D / 8; i += (size_t)G * NTHREADS) {
          const f32x4 a = xs[2 * i], b = xs[2 * i + 1];
          xd[i] = (u32x4){cvt_pk(a[0], a[1]), cvt_pk(a[2], a[3]), cvt_pk(b[0], b[1]), cvt_pk(b[2], b[3])}; } }
    const int gw = vb * 8 + w, NGW = G * 8;
    constexpr int I_IN = 16 * 9, I_OUT = 16 * 4, I_R = 16, I_SG = 16, I_SU = 16, I_SD = 4 * 4, I_SMALL = I_IN + I_OUT + I_R;
    for (int it = gw; it < I_SMALL; it += NGW) {
        int r = it;
        if (r < I_IN) { cvt_item(p.w_in, D, INW, (bf16_t*)(p.ws + WS_WIN), D, r / 9, r % 9, lane); continue; } r -= I_IN;
        if (r < I_OUT) { cvt_item(p.w_out, D, D, (bf16_t*)(p.ws + WS_WOUT), D, r >> 2, r & 3, lane); continue; } r -= I_OUT;
        cvt_item(p.w_r, D, NE, (bf16_t*)(p.ws + WS_WR), D, r, 0, lane);
    }
    for (int i = vb * NTHREADS + tid; i < 3 * 262144 / 8; i += G * NTHREADS) {
        const int seg = i / 32768, o = (i % 32768) * 8;
        const float* sp = (seg == 0 ? p.ws_g : (seg == 1 ? p.ws_u : p.ws_d)) + o;
        unsigned char* dp = (seg < 2 ? (unsigned char*)(p.ws + WS_WSGU) + (size_t)seg * 262144 : (unsigned char*)(p.ws + WS_WSD)) + o;
        *(u32x2*)dp = (u32x2){pack_fp8x4(*(const f32x4*)sp), pack_fp8x4(*(const f32x4*)(sp + 4))};
    }
}

template <int MT> struct EpiProj {
    const float* bias; const float* cs; const float* sn; bf16_t* out; int row0, col0;
    __device__ __forceinline__ void operator()(f32x4 (&acc)[MT][4], int wr, int wc, int fr, int fq) const {
        const int hb = col0 + wc * 64;
        const bool is_q = (hb < C_AK) || (hb >= C_BQ && hb < C_BK);
        const bool is_rope = is_q || (hb >= C_AK && hb < C_AV) || (hb >= C_BK && hb < C_BV);
        const float sc = is_q ? QSCALE : 1.0f;
#pragma unroll
        for (int mt = 0; mt < MT; ++mt) {
            const int row = row0 + wr * 16 * MT + mt * 16 + fr;
            f32x4 v[4];
#pragma unroll
            for (int nt = 0; nt < 4; ++nt) v[nt] = acc[mt][nt] + *(const f32x4*)(bias + hb + nt * 16 + 4 * fq);
            if (is_rope) {
#pragma unroll
                for (int nt = 0; nt < 2; ++nt) {
                    const f32x4 c = *(const f32x4*)(cs + (size_t)row * 32 + nt * 16 + 4 * fq), s = *(const f32x4*)(sn + (size_t)row * 32 + nt * 16 + 4 * fq);
                    const f32x4 t1 = v[nt], t2 = v[nt + 2];
                    v[nt] = t1 * c - t2 * s; v[nt + 2] = t2 * c + t1 * s;
                }
            }
#pragma unroll
            for (int nt = 0; nt < 4; ++nt) {
                const f32x4 o = v[nt] * sc;
                u32x2 pk = {cvt_pk(o[0], o[1]), cvt_pk(o[2], o[3])};
                *(u32x2*)(out + (size_t)row * INW + hb + nt * 16 + 4 * fq) = pk;
            }
        }
    }
};
__device__ __forceinline__ void phase_proj(const Params& p, char* lds, int vb, int G) {
    const float* cs = (const float*)(p.ws + WS_ROPE); const float* sn = cs + (size_t)S * 32;
    constexpr int NBIG = 512, NUNITS = NBIG + 2 * 64;
    for (int u = vb; u < NUNITS; u += G) {
        G2Args g; g.A = (const char*)(p.ws + WS_XB); g.B = (const char*)(p.ws + WS_WIN); g.nk = D / 64; g.akstep = 128;
        if (u < NBIG) {
            const int tm = u / 9, tn = u % 9;
            g2_rows_A<8>(g, (size_t)tm * 256, D * 2); g2_rows_B(g, (size_t)tn * 256, D * 2);
            EpiProj<8> e{p.b_in, cs, sn, (bf16_t*)(p.ws + WS_PROJ), tm * 256, tn * 256};
            gemm2<8>(lds, g, e);
        } else {
            const int t = NBIG + ((u - NBIG) >> 1), half = (u - NBIG) & 1, tm = t / 9, tn = t % 9;
            g2_rows_A<4>(g, (size_t)tm * 256 + half * 128, D * 2); g2_rows_B(g, (size_t)tn * 256, D * 2);
            EpiProj<4> e{p.b_in, cs, sn, (bf16_t*)(p.ws + WS_PROJ), tm * 256 + half * 128, tn * 256};
            gemm2<4>(lds, g, e);
        }
    }
}

template <int OFF> __device__ __forceinline__ s16x4 tr_read(int vb) { s16x4 r; asm volatile("ds_read_b64_tr_b16 %0, %1 offset:%2" : "=&v"(r) : "v"(vb), "i"(OFF) : "memory"); return r; }
__device__ __forceinline__ int v_off(int k, int c, int ndb) { return ((k >> 3) * ndb + (c >> 5)) * 512 + ((k & 7) * 32 + (c & 31)) * 2; }

constexpr int AT_STAGE = 32768;
template <int NDB, int KB, int T> struct PvPart {
    static __device__ __forceinline__ void run(f32x16& o, int vbase, const bf16x8& pa, const bf16x8& pb) {
        constexpr int o0 = (KB * 4 * NDB + T) * 512, st = NDB * 512;
        const s16x4 l0 = tr_read<o0 + 0 * st>(vbase), h0 = tr_read<o0 + 1 * st>(vbase), l1 = tr_read<o0 + 2 * st>(vbase), h1 = tr_read<o0 + 3 * st>(vbase);
        asm volatile("s_waitcnt lgkmcnt(0)" ::: "memory"); __builtin_amdgcn_sched_barrier(0);
#define PKV(L, H) (bf16x8){L[0], L[1], L[2], L[3], H[0], H[1], H[2], H[3]}
        o = __builtin_amdgcn_mfma_f32_32x32x16_bf16(PKV(l0, h0), pa, o, 0, 0, 0);
        o = __builtin_amdgcn_mfma_f32_32x32x16_bf16(PKV(l1, h1), pb, o, 0, 0, 0);
#undef PKV
    }
};
template <int NDB, int KB>
__device__ __forceinline__ void pv_half(f32x16 (&o)[NDB], f32x16& ol, int vbase, const bf16x8& pa, const bf16x8& pb) {
    const bf16x8 ones = {16256, 16256, 16256, 16256, 16256, 16256, 16256, 16256};
    ol = __builtin_amdgcn_mfma_f32_32x32x16_bf16(ones, pa, ol, 0, 0, 0);
    ol = __builtin_amdgcn_mfma_f32_32x32x16_bf16(ones, pb, ol, 0, 0, 0);
    PvPart<NDB, KB, 0>::run(o[0], vbase, pa, pb); PvPart<NDB, KB, 1>::run(o[1], vbase, pa, pb);
    if constexpr (NDB == 4) { PvPart<NDB, KB, 2>::run(o[2], vbase, pa, pb); PvPart<NDB, KB, 3>::run(o[3], vbase, pa, pb); }
}
constexpr float ATT_THR = 10.0f;
template <int NDB>
__device__ __forceinline__ void attn_scores(char* lds, int kof, const bf16x8 (&qf)[4], f32x16& s0, f32x16& s1, f32x16 (&o)[NDB], f32x16& ol, f32x16& nm, bool first, int r32, int hi) {
    s0 = nm; s1 = nm;
#pragma unroll
    for (int ds = 0; ds < 4; ++ds) {
        const bf16x8 k0 = *(const bf16x8*)(lds + kof + swz(r32, ds * 2 + hi)), k1 = *(const bf16x8*)(lds + kof + swz(32 + r32, ds * 2 + hi));
        s0 = __builtin_amdgcn_mfma_f32_32x32x16_bf16(k0, qf[ds], s0, 0, 0, 0);
        s1 = __builtin_amdgcn_mfma_f32_32x32x16_bf16(k1, qf[ds], s1, 0, 0, 0);
    }
    float mx = fmaxf(s0[0], s1[0]);
#pragma unroll
    for (int r = 1; r < 16; ++r) mx = fmaxf(fmaxf(mx, s0[r]), s1[r]);
    mx = half_max(mx);
    if (first || __any(mx > ATT_THR)) {
        const float delta = first ? mx : fmaxf(mx, 0.f), alpha = first ? 0.f : __builtin_amdgcn_exp2f(-delta);
#pragma unroll
        for (int r = 0; r < 16; ++r) { s0[r] -= delta; s1[r] -= delta; nm[r] -= delta; ol[r] *= alpha; }
#pragma unroll
        for (int t = 0; t < NDB; ++t)
#pragma unroll
            for (int r = 0; r < 16; ++r) o[t][r] *= alpha;
    }
}
__device__ __forceinline__ void exp_pack(const f32x16& s, bf16x8& pa, bf16x8& pb) {
    float e[16];
#pragma unroll
    for (int r = 0; r < 16; ++r) e[r] = __builtin_amdgcn_exp2f(s[r]);
    u32x4 a = {cvt_pk(e[0], e[1]), cvt_pk(e[2], e[3]), cvt_pk(e[4], e[5]), cvt_pk(e[6], e[7])};
    u32x4 b = {cvt_pk(e[8], e[9]), cvt_pk(e[10], e[11]), cvt_pk(e[12], e[13]), cvt_pk(e[14], e[15])};
    pa = *(bf16x8*)&a; pb = *(bf16x8*)&b;
}

struct CvState { int c; int have; f32x4 a, b, a2, b2; };
constexpr int CV_CHUNKS = 192;
__device__ __forceinline__ const float* cv_src(const Params& p, int e, int c) { const int seg = c >> 6; const float* base = seg == 0 ? p.w_g : (seg == 1 ? p.w_u : p.w_d); return base + (size_t)e * 262144 + (size_t)(c & 63) * 4096 + threadIdx.x * 8; }
__device__ __forceinline__ unsigned char* cv_dst(const Params& p, int e, int c) { const int seg = c >> 6; unsigned char* base = seg < 2 ? (unsigned char*)(p.ws + WS_EGU) + (size_t)e * 524288 + (size_t)seg * 262144 : (unsigned char*)(p.ws + WS_ED) + (size_t)e * 262144; return base + (size_t)(c & 63) * 4096 + threadIdx.x * 8; }
__device__ __forceinline__ void cv_step(const Params& p, int e, CvState& cv) {
    if (cv.have) {
        *(u32x2*)cv_dst(p, e, cv.c - 2) = (u32x2){pack_fp8x4(cv.a), pack_fp8x4(cv.b)};
        *(u32x2*)cv_dst(p, e, cv.c - 1) = (u32x2){pack_fp8x4(cv.a2), pack_fp8x4(cv.b2)};
        cv.have = 0; }
    if (cv.c < CV_CHUNKS) { const float* sp = cv_src(p, e, cv.c); cv.a = *(const f32x4*)sp; cv.b = *(const f32x4*)(sp + 4);
        const float* sp2 = cv_src(p, e, cv.c + 1); cv.a2 = *(const f32x4*)sp2; cv.b2 = *(const f32x4*)(sp2 + 4); cv.have = 1; cv.c += 2; }
}
__device__ __forceinline__ void attn_diff_unit(const Params& p, char* lds_, int h, int qb, float lam, int cve, CvState& cv) {
    LAS char* lds = (LAS char*)lds_;
    const int tid = threadIdx.x, lane = tid & 63, w = __builtin_amdgcn_readfirstlane(tid >> 6), r32 = lane & 31, hi = lane >> 5, mp = w >> 2, wq = w & 3;
    const bf16_t* proj = (const bf16_t*)(p.ws + WS_PROJ);
    const int NT = 2 * qb + 2, NP = NT / 2, myNT = (wq < 2) ? NT - 1 : NT;
    bf16x8 qf[4];
    { const bf16_t* qp = proj + (size_t)(qb * 128 + wq * 32 + r32) * INW + C_BQ + h * 128 + mp * 64 + hi * 8;
#pragma unroll
      for (int ds = 0; ds < 4; ++ds) qf[ds] = *(const bf16x8*)(qp + ds * 16); }
    asm volatile("" : "+v"(qf[0]), "+v"(qf[1]), "+v"(qf[2]), "+v"(qf[3]));
    f32x16 o[4] = {}; f32x16 ol = {}, nm = {};
    const char* gk = (const char*)(proj + (size_t)(w * 8 + (lane >> 3)) * INW + C_BK + h * 128) + g2_chunk_off(lane, w);
    const char* gv = (const char*)(proj + (size_t)(w * 8 + ((lane & 31) >> 2)) * INW + C_BV + h * 128 + (lane >> 5) * 32 + (lane & 3) * 8);
    const int vlane = ((lane & 3) << 3) | (((lane >> 2) & 3) << 6) | (((lane >> 4) & 1) << 5) | (((lane >> 5) & 1) << 8);
    constexpr size_t TSTEP = (size_t)64 * INW * 2;
#define A_STAGE(pr, sg) do { const char* k0_ = gk + (size_t)(pr) * 2 * TSTEP; const char* v0_ = gv + (size_t)(pr) * 2 * TSTEP; \
        _Pragma("unroll") for (int j = 0; j < 2; ++j) { \
            __builtin_amdgcn_global_load_lds((const unsigned*)(k0_ + j * TSTEP), (LAS unsigned*)(lds + (sg) * 65536 + (0 * 2 + j) * 8192 + w * 1024), 16, 0, 0); \
            __builtin_amdgcn_global_load_lds((const unsigned*)(k0_ + j * TSTEP + 128), (LAS unsigned*)(lds + (sg) * 65536 + (1 * 2 + j) * 8192 + w * 1024), 16, 0, 0); \
            __builtin_amdgcn_global_load_lds((const unsigned*)(v0_ + j * TSTEP), (LAS unsigned*)(lds + (sg) * 65536 + 32768 + j * 16384 + (2 * w) * 1024), 16, 0, 0); \
            __builtin_amdgcn_global_load_lds((const unsigned*)(v0_ + j * TSTEP + 128), (LAS unsigned*)(lds + (sg) * 65536 + 32768 + j * 16384 + (2 * w + 1) * 1024), 16, 0, 0); } } while (0)
    A_STAGE(0, 0);
    __syncthreads();
    bool first = true;
    for (int it = 0; it < NP; ++it) {
        const int sg = it & 1;
        cv_step(p, cve, cv);
        if (it + 1 < NP) { if (sg) A_STAGE(it + 1, 0); else A_STAGE(it + 1, 1); }
#pragma unroll
        for (int jj = 0; jj < 2; ++jj) {
            const int j = jj, t = 2 * it + j;
            if (t < myNT) {
                bf16x8 p0, p1, p2, p3; f32x16 s0, s1;
                const int vb_ = (int)(uintptr_t)(lds_ + sg * 65536 + 32768 + j * 16384) + vlane;
                attn_scores<4>(lds_, sg * 65536 + (mp * 2 + j) * 8192, qf, s0, s1, o, ol, nm, first, r32, hi);
                first = false;
                exp_pack(s0, p0, p1); pv_half<4, 0>(o, ol, vb_, p0, p1); exp_pack(s1, p2, p3); pv_half<4, 1>(o, ol, vb_, p2, p3);
            }
        }
        __syncthreads();
    }
#undef A_STAGE
    float* xb = (float*)lds_;
    const float il = 1.0f / ol[0];
    if (mp == 1) {
        const float f = il * lam;
#pragma unroll
        for (int t = 0; t < 4; ++t)
#pragma unroll
            for (int r = 0; r < 16; ++r) xb[(wq * 64 + t * 16 + r) * 64 + lane] = o[t][r] * f;
    }
    __syncthreads();
    if (mp == 0) {
        float ss = 0.f;
#pragma unroll
        for (int t = 0; t < 4; ++t)
#pragma unroll
            for (int r = 0; r < 16; ++r) { const float v = o[t][r] * il - xb[(wq * 64 + t * 16 + r) * 64 + lane]; o[t][r] = v; ss += v * v; }
        ss = half_sum(ss);
        const float rs = rsqrtf(ss * (1.0f / 128.0f) + LN_EPS) * 0.8f;
        bf16_t* op = (bf16_t*)(p.ws + WS_ATT) + (size_t)(qb * 128 + wq * 32 + r32) * D + 512 + h * 128;
#pragma unroll
        for (int t = 0; t < 4; ++t)
#pragma unroll
            for (int rr = 0; rr < 4; ++rr) {
                const int dv0 = 32 * t + 8 * rr + 4 * hi;
                const f32x4 gg = *(const f32x4*)(p.subg + dv0);
                u32x2 pk = {cvt_pk(o[t][4 * rr] * rs * gg[0], o[t][4 * rr + 1] * rs * gg[1]), cvt_pk(o[t][4 * rr + 2] * rs * gg[2], o[t][4 * rr + 3] * rs * gg[3])};
                *(u32x2*)(op + dv0) = pk;
            }
    }
    __syncthreads();
}
__device__ __forceinline__ void attn_swa_unit(const Params& p, char* lds, int kvh, int n) {
    const int tid = threadIdx.x, lane = tid & 63, w = __builtin_amdgcn_readfirstlane(tid >> 6), r32 = lane & 31, hi = lane >> 5, g = w >> 1, hq = kvh * 4 + g;
    const bf16_t* proj = (const bf16_t*)(p.ws + WS_PROJ);
    const int c0 = (n >= 2) ? n - 2 : 0, NT = n - c0 + 1;
    const int tok = n * 64 + (w & 1) * 32 + r32;
    bf16x8 qf[4];
    { const bf16_t* qp = proj + (size_t)tok * INW + C_AQ + hq * 64 + hi * 8;
#pragma unroll
      for (int ds = 0; ds < 4; ++ds) qf[ds] = *(const bf16x8*)(qp + ds * 16); }
    f32x16 o[2] = {}; f32x16 ol, nm;
    { float ms = -p.sinks[hq] * LOG2E; asm volatile("" : "+v"(qf[0]), "+v"(qf[1]), "+v"(qf[2]), "+v"(qf[3]), "+v"(ms));
#pragma unroll
      for (int r = 0; r < 16; ++r) { nm[r] = ms; ol[r] = 1.0f; } }
    const bf16_t* gk = proj + (size_t)(c0 * 64 + (tid >> 3)) * INW + C_AK + kvh * 64 + (tid & 7) * 8;
    const bf16_t* gv = proj + (size_t)(c0 * 64 + (tid >> 3)) * INW + C_AV + kvh * 64 + (tid & 7) * 8;
    const int wk = swz(tid >> 3, tid & 7), wv = v_off(tid >> 3, (tid & 7) * 8, 2);
    const int vlane = ((lane & 3) << 3) | (((lane >> 2) & 3) << 6) | (((lane >> 4) & 1) << 5) | (((lane >> 5) & 1) << 8);
    u32x4 st0, st1;
#define W_LOAD(t) do { const size_t ko = (size_t)(t) * 64 * INW; st0 = *(const u32x4*)(gk + ko); st1 = *(const u32x4*)(gv + ko); } while (0)
#define W_WRITE(b) do { char* sb = lds + (b) * AT_STAGE; *(u32x4*)(sb + wk) = st0; *(u32x4*)(sb + 8192 + wv) = st1; } while (0)
    W_LOAD(0); W_WRITE(0); __syncthreads();
    for (int t = 0; t < NT; ++t) {
        const int b = t & 1;
        if (t + 1 < NT) W_LOAD(t + 1);
        { f32x16 s0, s1; bf16x8 p0, p1, p2, p3; const int vb_ = (int)(uintptr_t)(lds + b * AT_STAGE + 8192) + vlane;
          attn_scores<2>(lds, b * AT_STAGE, qf, s0, s1, o, ol, nm, false, r32, hi);
          exp_pack(s0, p0, p1); pv_half<2, 0>(o, ol, vb_, p0, p1); exp_pack(s1, p2, p3); pv_half<2, 1>(o, ol, vb_, p2, p3); }
        if (t + 1 < NT) W_WRITE(b ^ 1);
        __syncthreads();
    }
#undef W_LOAD
#undef W_WRITE
    const float il = 1.0f / ol[0];
    bf16_t* op = (bf16_t*)(p.ws + WS_ATT) + (size_t)tok * D + hq * 64;
#pragma unroll
    for (int t = 0; t < 2; ++t)
#pragma unroll
        for (int rr = 0; rr < 4; ++rr) {
            const int dv0 = 32 * t + 8 * rr + 4 * hi;
            u32x2 pk = {cvt_pk(o[t][4 * rr] * il, o[t][4 * rr + 1] * il), cvt_pk(o[t][4 * rr + 2] * il, o[t][4 * rr + 3] * il)};
            *(u32x2*)(op + dv0) = pk;
        }
}
__device__ __forceinline__ void phase_attn(const Params& p, char* lds, int vb, int G) {
    const int lane = threadIdx.x & 63;
    const float d1 = wave_sum(p.lq1[lane] * p.lk1[lane]), d2 = wave_sum(p.lq2[lane] * p.lk2[lane]);
    const float lam = expf(d1) - expf(d2) + 0.2f;
    CvState cv; cv.c = 0; cv.have = 0; cv.a = (f32x4){0.f, 0.f, 0.f, 0.f}; cv.b = cv.a; cv.a2 = cv.a; cv.b2 = cv.a;
    for (int u = vb; u < 1024; u += G) {
        if (u < 256) attn_diff_unit(p, lds, u >> 6, 127 - (u & 63), lam, vb, cv);
        else if (u < 512) attn_diff_unit(p, lds, (u - 256) >> 6, (u - 256) & 63, lam, vb, cv);
        else attn_swa_unit(p, lds, (u - 512) >> 8, (u - 512) & 255);
    }
    for (int e = vb; e < NE; e += G) {
        if (e != vb) { cv.c = 0; cv.have = 0; }
        while (cv.c < CV_CHUNKS || cv.have) cv_step(p, e, cv);
    }
}

struct EpiPreLn {
    const float* x; float* out; int row0, col0;
    __device__ __forceinline__ void operator()(f32x4 (&acc)[8][4], int wr, int wc, int fr, int fq) const {
#pragma unroll
        for (int mt = 0; mt < 8; ++mt) {
            const size_t ro = (size_t)(row0 + wr * 128 + mt * 16 + fr) * D + col0 + wc * 64 + 4 * fq;
#pragma unroll
            for (int nt = 0; nt < 4; ++nt) { const f32x4 xv = *(const f32x4*)(x + ro + nt * 16); *(f32x4*)(out + ro + nt * 16) = xv * ALPHA + acc[mt][nt]; }
        }
    }
};
__device__ __forceinline__ void phase_wout(const Params& p, char* lds, int vb, int G) {
    for (int u = vb; u < (S / 256) * 4; u += G) {
        const int tm = u >> 2, tn = u & 3;
        G2Args g; g.A = (const char*)(p.ws + WS_ATT); g.B = (const char*)(p.ws + WS_WOUT); g.nk = D / 64; g.akstep = 128;
        g2_rows_A<8>(g, (size_t)tm * 256, D * 2); g2_rows_B(g, (size_t)tn * 256, D * 2);
        EpiPreLn e{p.x, (float*)(p.ws + WS_PRELN), tm * 256, tn * 256};
        gemm2<8>(lds, g, e);
    }
}

struct EpiLogits {
    float* L;
    __device__ __forceinline__ void operator()(f32x4 (&acc)[4][4], int wr, int wc, int fr, int fq) const {
#pragma unroll
        for (int mt = 0; mt < 4; ++mt)
#pragma unroll
            for (int nt = 0; nt < 4; ++nt) *(f32x4*)(L + (wr * 64 + mt * 16 + fr) * 256 + wc * 64 + nt * 16 + 4 * fq) = acc[mt][nt];
    }
};
__device__ __forceinline__ void phase_router(const Params& p, char* lds, int vb, int G) {
    const int tid = threadIdx.x, lane = tid & 63, w = tid >> 6;
    const float* preln = (const float*)(p.ws + WS_PRELN);
    float* x1f = (float*)(p.ws + WS_X1F); bf16_t* x1b = (bf16_t*)(p.ws + WS_X1B);
    unsigned* cnt = (unsigned*)(p.ws + WS_CTL + 65536); int* list = (int*)(p.ws + WS_LIST); float* gates = (float*)(p.ws + WS_GATE);
    for (int u = vb; u < S / 64; u += G) {
        for (int i = 0; i < 8; ++i) {
            const int row = u * 64 + w * 8 + i;
            const f32x4* xr = (const f32x4*)(preln + (size_t)row * D) + lane;
            f32x4 v[4]; float s = 0.f;
#pragma unroll
            for (int j = 0; j < 4; ++j) { v[j] = xr[64 * j]; s += (v[j][0] + v[j][1]) + (v[j][2] + v[j][3]); }
            const float mean = wave_sum(s) * (1.0f / D); float s2 = 0.f;
#pragma unroll
            for (int j = 0; j < 4; ++j) { v[j] = v[j] - mean; s2 += (v[j][0] * v[j][0] + v[j][1] * v[j][1]) + (v[j][2] * v[j][2] + v[j][3] * v[j][3]); }
            const float rstd = rsqrtf(wave_sum(s2) * (1.0f / D) + LN_EPS);
#pragma unroll
            for (int j = 0; j < 4; ++j) {
                const f32x4 gg = *((const f32x4*)p.ln1g + lane + 64 * j), bb = *((const f32x4*)p.ln1b + lane + 64 * j);
                const f32x4 y = v[j] * rstd * gg + bb;
                *((f32x4*)(x1f + (size_t)row * D) + lane + 64 * j) = y;
                u32x2 pk = {cvt_pk(y[0], y[1]), cvt_pk(y[2], y[3])};
                *(u32x2*)(x1b + ((size_t)((lane >> 4) + 4 * j) * S + row) * 64 + ((4 * lane) & 63)) = pk;
            }
        }
        asm volatile("s_waitcnt vmcnt(0)" ::: "memory");
        __syncthreads();
        { G2Args g; g.A = (const char*)x1b; g.B = (const char*)(p.ws + WS_WR); g.nk = D / 64; g.akstep = S * 128;
          g2_rows_A<4>(g, (size_t)u * 64, 128); g.offA[1] = g.offA[0]; g2_rows_B(g, 0, D * 2);
          EpiLogits e{(float*)lds};
          gemm2<4>(lds, g, e); }
        __syncthreads();
        const f32x4 rb = *((const f32x4*)p.r_bias + lane);
        const float NEG = -__builtin_inff();
        for (int i0 = 0; i0 < 8; i0 += 4) {
            float sc[4][4], cand[4][4]; int my_e[4]; float my_s[4], gsum[4];
#pragma unroll
            for (int q = 0; q < 4; ++q) {
                const int tl = w * 8 + i0 + q;
                const f32x4 lg = *((const f32x4*)((const float*)lds + tl * 256) + lane);
#pragma unroll
                for (int j = 0; j < 4; ++j) { sc[q][j] = 1.0f / (1.0f + __expf(-lg[j])); cand[q][j] = sc[q][j] + rb[j]; }
                my_e[q] = 0; my_s[q] = 0.f; gsum[q] = 0.f;
            }
            float a1[4], a2[4];
#pragma unroll
            for (int q = 0; q < 4; ++q) { const float m01 = fmaxf(cand[q][0], cand[q][1]), n01 = fminf(cand[q][0], cand[q][1]), m23 = fmaxf(cand[q][2], cand[q][3]), n23 = fminf(cand[q][2], cand[q][3]);
              a1[q] = fmaxf(m01, m23); a2[q] = fmaxf(fminf(m01, m23), fmaxf(n01, n23)); }
#pragma unroll
            for (int off = 1; off < 8; off <<= 1) {
#pragma unroll
                for (int q = 0; q < 4; ++q) { const float b1 = __shfl_xor(a1[q], off), b2 = __shfl_xor(a2[q], off); const float n1 = fmaxf(a1[q], b1), n2 = fmaxf(fminf(a1[q], b1), fmaxf(a2[q], b2)); a1[q] = n1; a2[q] = n2; }
            }
            const int mygrp = lane >> 3;
#pragma unroll
            for (int q = 0; q < 4; ++q) {
                const float gs = a1[q] + a2[q]; int rank = 0;
#pragma unroll
                for (int g2 = 0; g2 < 8; ++g2) { const float v = __shfl(gs, g2 * 8); rank += (v > gs || (v == gs && g2 < mygrp)) ? 1 : 0; }
                if (rank >= 4) {
#pragma unroll
                    for (int j = 0; j < 4; ++j) cand[q][j] = NEG;
                }
            }
#pragma unroll
            for (int k = 0; k < 8; ++k) {
                float bv[4]; int idx[4];
#pragma unroll
                for (int q = 0; q < 4; ++q) { bv[q] = cand[q][0]; int bi = 0;
#pragma unroll
                    for (int j = 1; j < 4; ++j) if (cand[q][j] > bv[q]) { bv[q] = cand[q][j]; bi = j; }
                    idx[q] = 4 * lane + bi; }
#pragma unroll
                for (int off = 32; off >= 1; off >>= 1) {
#pragma unroll
                    for (int q = 0; q < 4; ++q) { const float ov = __shfl_xor(bv[q], off); const int oi = __shfl_xor(idx[q], off); if (ov > bv[q] || (ov == bv[q] && oi < idx[q])) { bv[q] = ov; idx[q] = oi; } }
                }
#pragma unroll
                for (int q = 0; q < 4; ++q) {
                    const int owner = idx[q] >> 2, sub = idx[q] & 3;
                    float scv = sc[q][0];
#pragma unroll
                    for (int j = 1; j < 4; ++j) scv = (sub == j) ? sc[q][j] : scv;
                    if (lane == owner) {
#pragma unroll
                        for (int j = 0; j < 4; ++j) if (sub == j) cand[q][j] = NEG;
                    }
                    const float gsc = __shfl(scv, owner);
                    if (lane == k) { my_e[q] = idx[q]; my_s[q] = gsc; }
                    gsum[q] += gsc;
                }
            }
            if (lane < 8) {
#pragma unroll
                for (int q = 0; q < 4; ++q) {
                    const int t = u * 64 + w * 8 + i0 + q;
                    const float gate = my_s[q] / gsum[q] * 2.5f;
                    const unsigned pos = atomicAdd(cnt + my_e[q] * CNT_STRIDE, 1u);
                    list[(size_t)my_e[q] * CAP + pos] = t * 8 + lane;
                    gates[t * 8 + lane] = gate;
                }
            }
        }
        __syncthreads();
    }
}

#ifndef MOE_MT
#define MOE_MT 8
#endif
constexpr int MOE_BM = 32 * MOE_MT;
struct EpiAct {
    bf16_t* act; const int* slots; int ncol0;
    __device__ __forceinline__ void operator()(f32x4 (&acc)[MOE_MT][4], int wr, int wc, int fr, int fq) const {
#pragma unroll
        for (int mt = 0; mt < MOE_MT; ++mt) {
            const int ar = slots[wr * 16 * MOE_MT + mt * 16 + fr];
            if (ar >= 0) {
#pragma unroll
                for (int nt = 0; nt < 2; ++nt) {
                    const f32x4 gv = acc[mt][nt], uv = acc[mt][nt + 2]; float a[4];
#pragma unroll
                    for (int j = 0; j < 4; ++j) { const float gq = gv[j] * W8_INV; a[j] = gq / (1.0f + __expf(-gq)) * (uv[j] * W8_INV); }
                    u32x2 pk = {cvt_pk(a[0], a[1]), cvt_pk(a[2], a[3])};
                    *(u32x2*)(act + (size_t)ar * FF + ncol0 + wc * 32 + nt * 16 + 4 * fq) = pk;
                }
            }
        }
    }
};
struct EpiY {
    bf16_t* y; const int* yrows; const float* gl; int col0;
    __device__ __forceinline__ void operator()(f32x4 (&acc)[MOE_MT][4], int wr, int wc, int fr, int fq) const {
#pragma unroll
        for (int mt = 0; mt < MOE_MT; ++mt) {
            const int r = wr * 16 * MOE_MT + mt * 16 + fr, yr = yrows[r];
            if (yr >= 0) {
                const float gt = gl[r] * W8_INV;
#pragma unroll
                for (int nt = 0; nt < 4; ++nt) {
                    const f32x4 v = acc[mt][nt] * gt;
                    u32x2 pk = {cvt_pk(v[0], v[1]), cvt_pk(v[2], v[3])};
                    *(u32x2*)(y + (size_t)yr * D + col0 + wc * 64 + nt * 16 + 4 * fq) = pk;
                }
            }
        }
    }
};
__device__ __forceinline__ void phase_experts(const Params& p, char* lds, int vb, int G) {
    const int tid0 = threadIdx.x, w = __builtin_amdgcn_readfirstlane(tid0 >> 6);
    const unsigned* cnt = (const unsigned*)(p.ws + WS_CTL + 65536); const int* list = (const int*)(p.ws + WS_LIST); const float* gates = (const float*)(p.ws + WS_GATE);
    bf16_t* act = (bf16_t*)(p.ws + WS_ACT); bf16_t* ybuf = (bf16_t*)(p.ws + WS_Y);
    int* nts = (int*)(lds + LDS_MISC); int* pre = nts + 256;
    int* s_arow = pre + 260; int* s_yrow = s_arow + MOE_BM; int* s_tok = s_yrow + MOE_BM; float* s_gate = (float*)(s_tok + MOE_BM);
    if (tid0 < 256) nts[tid0] = (int)((__hip_atomic_load(cnt + tid0 * CNT_STRIDE, __ATOMIC_RELAXED, __HIP_MEMORY_SCOPE_AGENT) + (MOE_BM - 1)) / MOE_BM);
    __syncthreads();
    if (tid0 < 257) { int s = 0; for (int e = 0; e < tid0; ++e) s += nts[e]; pre[tid0] = s; }
    __syncthreads();
    const int NR = __builtin_amdgcn_readfirstlane(pre[256]), NU = NR + S / MOE_BM;
    for (int u = vb; u < NU; u += G) {
        __syncthreads();
        int tid = threadIdx.x; asm volatile("" : "+v"(tid));
        const int lane = tid & 63; const unsigned co = g2_chunk_off(lane, w);
        const unsigned char *bg, *bu, *bd;
        if (u < NR) {
            int lo = 0, hi = 255;
            while (lo < hi) { const int mid = (lo + hi + 1) >> 1; if (pre[mid] <= u) lo = mid; else hi = mid - 1; }
            const int e = lo, tile = u - pre[e], n = (int)__hip_atomic_load(cnt + e * CNT_STRIDE, __ATOMIC_RELAXED, __HIP_MEMORY_SCOPE_AGENT);
            if (tid < MOE_BM) {
                const int idx = tile * MOE_BM + tid;
                if (idx < n) { const int slot = list[(size_t)e * CAP + idx]; s_arow[tid] = slot; s_yrow[tid] = slot + (slot >> 3); s_tok[tid] = slot >> 3; s_gate[tid] = gates[slot]; }
                else { s_arow[tid] = -1; s_yrow[tid] = -1; s_tok[tid] = 0; s_gate[tid] = 0.f; }
            }
            bg = (const unsigned char*)(p.ws + WS_EGU) + (size_t)e * 524288; bu = bg + 262144; bd = (const unsigned char*)(p.ws + WS_ED) + (size_t)e * 262144;
        } else {
            const int tile = u - NR;
            if (tid < MOE_BM) { const int tk = tile * MOE_BM + tid; s_arow[tid] = S * 8 + tk; s_yrow[tid] = tk * 9 + 8; s_tok[tid] = tk; s_gate[tid] = 1.0f; }
            bg = (const unsigned char*)(p.ws + WS_WSGU); bu = bg + 262144; bd = (const unsigned char*)(p.ws + WS_WSD);
        }
        __syncthreads();
        for (int np = 0; np < 2; ++np) {
            G3bArgs g; g.A = (const char*)(p.ws + WS_X1B); g.nk = D / 64; g.ldb = FF; g.akstep = S * 128;
#pragma unroll
            for (int i = 0; i < MOE_MT / 2; ++i) g.offA[i] = (unsigned)s_tok[i * 64 + w * 8 + (lane >> 3)] * 128u + co;
            { const int n0 = 4 * lane, bwc = n0 >> 6, sub = n0 & 63;
              g.b = ((sub < 32) ? bg : bu) + np * 128 + bwc * 32 + (sub & 31) + (size_t)(w * 8) * FF; }
            EpiAct e{act, s_arow, np * 128};
            gemm3b<MOE_MT>(lds, g, e);
        }
        asm volatile("s_waitcnt vmcnt(0)" ::: "memory");
        __syncthreads();
        for (int np = 0; np < 4; ++np) {
            G3bArgs g; g.A = (const char*)act; g.nk = FF / 64; g.ldb = D; g.akstep = 128;
#pragma unroll
            for (int i = 0; i < MOE_MT / 2; ++i) { const int ar = s_arow[i * 64 + w * 8 + (lane >> 3)]; g.offA[i] = (unsigned)(ar < 0 ? 0 : ar) * (unsigned)(FF * 2) + co; }
            g.b = bd + (size_t)(w * 8) * D + np * 256 + 4 * lane;
            EpiY e{ybuf, s_yrow, s_gate, np * 256};
            gemm3b<MOE_MT>(lds, g, e);
        }
    }
}

__device__ __forceinline__ void phase_final(const Params& p, int vb, int G) {
    const int lane = threadIdx.x & 63, w = threadIdx.x >> 6;
    const float* x1f = (const float*)(p.ws + WS_X1F); const bf16_t* ybuf = (const bf16_t*)(p.ws + WS_Y);
    for (int row = vb * 8 + w; row < S; row += G * 8) {
        f32x4 v[4]; float s = 0.f;
#pragma unroll
        for (int j = 0; j < 4; ++j) v[j] = *((const f32x4*)(x1f + (size_t)row * D) + lane + 64 * j) * ALPHA;
#pragma unroll
        for (int k = 0; k < 9; ++k) {
            const u32x2* yr = (const u32x2*)(ybuf + (size_t)(row * 9 + k) * D) + lane;
#pragma unroll
            for (int j = 0; j < 4; ++j) { const u32x2 q = yr[64 * j]; v[j][0] += bf_lo(q[0]); v[j][1] += bf_hi(q[0]); v[j][2] += bf_lo(q[1]); v[j][3] += bf_hi(q[1]); }
        }
#pragma unroll
        for (int j = 0; j < 4; ++j) s += (v[j][0] + v[j][1]) + (v[j][2] + v[j][3]);
        const float mean = wave_sum(s) * (1.0f / D); float s2 = 0.f;
#pragma unroll
        for (int j = 0; j < 4; ++j) { v[j] = v[j] - mean; s2 += (v[j][0] * v[j][0] + v[j][1] * v[j][1]) + (v[j][2] * v[j][2] + v[j][3] * v[j][3]); }
        const float rstd = rsqrtf(wave_sum(s2) * (1.0f / D) + LN_EPS);
#pragma unroll
        for (int j = 0; j < 4; ++j) {
            const f32x4 gg = *((const f32x4*)p.ln2g + lane + 64 * j), bb = *((const f32x4*)p.ln2b + lane + 64 * j);
            *((f32x4*)(p.out + (size_t)row * D) + lane + 64 * j) = v[j] * rstd * gg + bb;
        }
    }
}

__global__ void __launch_bounds__(NTHREADS) mega(Params p) {
    extern __shared__ __attribute__((aligned(16))) char lds[];
    const int G = gridDim.x, bx = blockIdx.x;
    const int vb = (G % 8 == 0) ? (bx % 8) * (G / 8) + bx / 8 : bx;
    if (threadIdx.x < 4) ((volatile LAS unsigned*)((LAS char*)lds + LDS_BARST))[threadIdx.x] = 0u;
    __syncthreads();
    XcdBarrier bar; bar.bar = (unsigned*)(p.ws + WS_CTL) + CW_BAR; bar.x = 0; bar.st = nullptr;
    if (p.ph_hi - p.ph_lo > 1) bar = xcd_barrier_post((unsigned*)(p.ws + WS_CTL) + CW_BAR, (volatile LAS unsigned*)((LAS char*)lds + LDS_BARST));
#define SEAM(k) do { if (p.ph_lo <= (k) && (k) + 1 < p.ph_hi) { xcd_barrier(bar); } } while (0)
#define IN(k) (p.ph_lo <= (k) && (k) < p.ph_hi)
#define RUN(k, call) do { if (IN(k)) { call; if (MK_REPEAT == (k)) { __syncthreads(); call; } } } while (0)
    RUN(0, phase_prep(p, vb, G)); SEAM(0);
    RUN(1, phase_proj(p, lds, vb, G)); SEAM(1);
    RUN(2, phase_attn(p, lds, vb, G)); SEAM(2);
    RUN(3, phase_wout(p, lds, vb, G)); SEAM(3);
    if (IN(4)) { phase_router(p, lds, vb, G); } SEAM(4);
    RUN(5, phase_experts(p, lds, vb, G)); SEAM(5);
    RUN(6, phase_final(p, vb, G));
#undef SEAM
#undef IN
#undef RUN
}

extern "C" void kernel_launch(void* const* d_in, const int* in_sizes, int n_in, void* d_out, int out_size, void* d_ws, size_t ws_size, hipStream_t stream) {
    static int grid = 0;
    if (grid == 0) {
        if (n_in != 22 || in_sizes[0] != S * D || out_size != S * D || ws_size < WS_END) {
            fprintf(stderr, "kernel_launch: unexpected shapes: n_in %d in0 %d out %d ws %zu (need %zu)\n", n_in, n_in > 0 ? in_sizes[0] : -1, out_size, ws_size, (size_t)WS_END); grid = -1; return; }
        int dev = 0, cus = 0, per_cu = 0;
        (void)hipGetDevice(&dev); (void)hipDeviceGetAttribute(&cus, hipDeviceAttributeMultiprocessorCount, dev);
        if (hipFuncSetAttribute((const void*)mega, hipFuncAttributeMaxDynamicSharedMemorySize, LDS_BYTES) != hipSuccess) { fprintf(stderr, "kernel_launch: hipFuncSetAttribute failed\n"); grid = -1; return; }
        (void)hipOccupancyMaxActiveBlocksPerMultiprocessor(&per_cu, (const void*)mega, NTHREADS, LDS_BYTES);
        if (per_cu < 1) { fprintf(stderr, "kernel_launch: occupancy query says %d blocks per CU\n", per_cu); per_cu = 1; }
        grid = cus * 1;
        (void)hipGetLastError();
    }
    if (grid < 0) return;
    (void)hipMemsetAsync((char*)d_ws + WS_CTL, 0, CTL_BYTES, stream);
    Params p{};
    const float** f = (const float**)&p;
    for (int i = 0; i < 22; ++i) f[i] = (const float*)d_in[i];
    p.out = (float*)d_out; p.ws = (unsigned char*)d_ws;
#if MK_ONE_LAUNCH
    p.ph_lo = 0; p.ph_hi = 7;
    void* args[] = {&p};
    hipError_t e = hipLaunchCooperativeKernel((const void*)mega, dim3(grid), dim3(NTHREADS), args, LDS_BYTES, stream);
    if (e != hipSuccess) fprintf(stderr, "kernel_launch: cooperative launch failed: %s (grid %d)\n", hipGetErrorString(e), grid);
#else
    for (int ph = 0; ph < 7; ++ph) {
        p.ph_lo = ph; p.ph_hi = ph + 1;
        hipLaunchKernelGGL(mega, dim3(grid), dim3(NTHREADS), LDS_BYTES, stream, p);
    }
#endif
}
```

```cpp
#include <hip/hip_runtime.h>
#include <hip/hip_cooperative_groups.h>
#include <cstdio>
#include <cstdint>
namespace cg = cooperative_groups;

#ifndef MK_REPEAT
#define MK_REPEAT -1
#endif
#ifndef MK_ONE_LAUNCH
#define MK_ONE_LAUNCH 1
#endif

constexpr int S = 16384, D = 1024, INW = 2304, NE = 256, FF = 256;
constexpr int NTHREADS = 512;
constexpr int CAP = 16384;
constexpr float ALPHA = 1.189207115002721f;
constexpr float LN_EPS = 1e-5f;
constexpr float QSCALE = 0.125f * 1.4426950408889634f;
constexpr float LOG2E = 1.4426950408889634f;
constexpr int C_AQ = 0, C_AK = 512, C_AV = 640, C_BQ = 768, C_BK = 1280, C_BV = 1792;

constexpr size_t MiB = 1ull << 20;
constexpr size_t WS_CTL = 0;
constexpr size_t CTL_BYTES = 128 * 1024;
constexpr int CNT_STRIDE = 64;
constexpr size_t WS_ROPE = 1 * MiB;
constexpr size_t WS_WIN = 8 * MiB;
constexpr size_t WS_WOUT = 13 * MiB;
constexpr size_t WS_WR = 15 * MiB;
constexpr size_t WS_WSGU = 16 * MiB;
constexpr size_t WS_WSD = 17 * MiB;
constexpr size_t WS_EGU = 20 * MiB;
constexpr size_t WS_ED = 276 * MiB;
constexpr size_t WS_X1F = 404 * MiB;
constexpr size_t WS_X1B = 468 * MiB;
constexpr size_t WS_LIST = 500 * MiB;
constexpr size_t WS_GATE = 516 * MiB;
constexpr size_t WS_ACT = 518 * MiB;
constexpr size_t WS_Y = 590 * MiB;
constexpr size_t WS_XB = 590 * MiB;
constexpr size_t WS_PROJ = 622 * MiB;
constexpr size_t WS_ATT = 694 * MiB;
constexpr size_t WS_PRELN = 726 * MiB;
constexpr size_t WS_END = 878 * MiB;

constexpr int LDS_BYTES = 147456;
constexpr int LDS_MISC = 131072;

typedef unsigned short bf16_t;
typedef short bf16x8 __attribute__((ext_vector_type(8)));
typedef short s16x4 __attribute__((ext_vector_type(4)));
typedef float f32x4 __attribute__((ext_vector_type(4)));
typedef float f32x16 __attribute__((ext_vector_type(16)));
typedef unsigned u32x4 __attribute__((ext_vector_type(4)));
typedef unsigned u32x2 __attribute__((ext_vector_type(2)));
typedef float f32x2 __attribute__((ext_vector_type(2)));


#define LAS __attribute__((address_space(3)))
#define XB_TMO      128
#define XB_XCNT(j)  (256  + 64 * (j))
#define XB_XSUB(j)  (1280 + 64 * (j))
#define XB_XGEN(j)  (2304 + 64 * (j))
#define XB_TOP      3328
#define XB_TOPGEN   3392
#define XCD_BAR_WORDS 3456
#define XB_SPIN_CAP (1u << 18)
__device__ __forceinline__ unsigned xb_ld(unsigned* p)              { return __hip_atomic_load(p, __ATOMIC_RELAXED, __HIP_MEMORY_SCOPE_AGENT); }
__device__ __forceinline__ unsigned xb_add(unsigned* p, unsigned v) { return __hip_atomic_fetch_add(p, v, __ATOMIC_RELAXED, __HIP_MEMORY_SCOPE_AGENT); }
__device__ __forceinline__ unsigned xb_xcc_id() { return (unsigned)__builtin_amdgcn_s_getreg((3 << 11) | 20) & 0xFu; }
#define XB_SPIN(cond, bar) do { unsigned _sp = 0; while (cond) { __builtin_amdgcn_s_sleep(1); \
    if ((++_sp & 255u) == 0u) { if (xb_ld(&(bar)[XB_TMO])) break; if (_sp > XB_SPIN_CAP) { atomicAdd(&(bar)[XB_TMO], 1u); break; } } } } while (0)
struct XcdBarrier { unsigned* bar; unsigned x; volatile LAS unsigned* st; };
__device__ __forceinline__ XcdBarrier xcd_barrier_post(unsigned* bar, volatile LAS unsigned* st) {
    XcdBarrier b; b.bar = bar; b.x = xb_xcc_id(); b.st = st;
    if (threadIdx.x == 0) (void)xb_add(&bar[XB_XCNT(b.x)], 1u);
    return b;
}
__device__ __forceinline__ void xcd_barrier_complete(unsigned* bar, unsigned x, unsigned& nloc, unsigned& nx) {
    const unsigned G = gridDim.x * gridDim.y * gridDim.z;
    unsigned sum, cnt, mine, sp = 0u;
    for (;;) {
        sum = 0u; cnt = 0u; mine = 0u;
#pragma unroll
        for (unsigned j = 0; j < 16; ++j) { const unsigned c = xb_ld(&bar[XB_XCNT(j)]); sum += c; cnt += (c > 0u) ? 1u : 0u; mine = (j == x) ? c : mine; }
        if (sum == G) break;
        __builtin_amdgcn_s_sleep(1);
        if ((++sp & 255u) == 0u) { if (xb_ld(&bar[XB_TMO])) break; if (sp > XB_SPIN_CAP) { atomicAdd(&bar[XB_TMO], 1u); break; } }
    }
    nloc = mine > 0u ? mine : 1u; nx = cnt > 0u ? cnt : 1u;
}
__device__ __forceinline__ void xcd_barrier(const XcdBarrier& b) {
    asm volatile("s_waitcnt vmcnt(0)" ::: "memory");
    __syncthreads();
    if (threadIdx.x == 0) {
        unsigned* bar = b.bar;
        __builtin_amdgcn_s_waitcnt(0);
        unsigned nloc = b.st[0], nx = b.st[1];
        if (nloc == 0u) { xcd_barrier_complete(bar, b.x, nloc, nx); b.st[0] = nloc; b.st[1] = nx; }
        const unsigned old = xb_add(&bar[XB_XSUB(b.x)], 1u);
        const unsigned gen = old / nloc;
        if (old + 1u == (gen + 1u) * nloc) {
            __builtin_amdgcn_fence(__ATOMIC_RELEASE, "agent");
            asm volatile("s_waitcnt vmcnt(0)" ::: "memory");
            const unsigned og = xb_add(&bar[XB_TOP], 1u);
            const unsigned tg = og / nx;
            if (og + 1u == (tg + 1u) * nx) xb_add(&bar[XB_TOPGEN], 1u);
            else XB_SPIN(xb_ld(&bar[XB_TOPGEN]) == tg, bar);
            __builtin_amdgcn_fence(__ATOMIC_ACQUIRE, "agent");
            xb_add(&bar[XB_XGEN(b.x)], 1u);
            asm volatile("s_waitcnt vmcnt(0)" ::: "memory");
        } else {
            XB_SPIN(xb_ld(&bar[XB_XGEN(b.x)]) == gen, bar);
            __builtin_amdgcn_fence(__ATOMIC_ACQUIRE, "agent");
            asm volatile("s_waitcnt vmcnt(0)" ::: "memory");
        }
    }
    __syncthreads();
}
constexpr int CW_BAR = 4096;
constexpr int LDS_BARST = LDS_MISC + 8192;

struct Params {
    const float* x; const float* w_in; const float* b_in; const float* sinks;
    const float* lq1; const float* lk1; const float* lq2; const float* lk2; const float* subg;
    const float* w_out; const float* ln1g; const float* ln1b; const float* w_r; const float* r_bias;
    const float* w_g; const float* w_u; const float* w_d; const float* ws_g; const float* ws_u; const float* ws_d;
    const float* ln2g; const float* ln2b;
    float* out; unsigned char* ws;
    int ph_lo, ph_hi;
};

__device__ __forceinline__ unsigned cvt_pk(float lo, float hi) { unsigned r; asm volatile("v_cvt_pk_bf16_f32 %0, %1, %2" : "=v"(r) : "v"(lo), "v"(hi)); return r; }
constexpr float W8_SCALE = 256.0f, W8_INV = 1.0f;    constexpr float W8_UNUSED = 1.0f / 256.0f;
__device__ __forceinline__ unsigned pack_fp8x4(f32x4 v) {
    v = v * W8_SCALE;
#pragma unroll
    for (int i = 0; i < 4; ++i) v[i] = fminf(fmaxf(v[i], -448.0f), 448.0f);
    int w = 0; w = __builtin_amdgcn_cvt_pk_fp8_f32(v[0], v[1], w, false); w = __builtin_amdgcn_cvt_pk_fp8_f32(v[2], v[3], w, true); return (unsigned)w;
}
__device__ __forceinline__ float bf_lo(unsigned u) { return __uint_as_float(u << 16); }
__device__ __forceinline__ float bf_hi(unsigned u) { return __uint_as_float(u & 0xffff0000u); }
__device__ __forceinline__ float wave_sum(float v) {
#pragma unroll
    for (int o = 1; o < 64; o <<= 1) v += __shfl_xor(v, o);
    return v;
}
__device__ __forceinline__ float half_max(float v) { auto rr = __builtin_amdgcn_permlane32_swap(__float_as_uint(v), __float_as_uint(v), false, false); return fmaxf(__uint_as_float(rr[0]), __uint_as_float(rr[1])); }
__device__ __forceinline__ float half_sum(float v) { auto rr = __builtin_amdgcn_permlane32_swap(__float_as_uint(v), __float_as_uint(v), false, false); return __uint_as_float(rr[0]) + __uint_as_float(rr[1]); }

__device__ __forceinline__ int swz(int r, int c) { const int f = (r & 7) ^ (((r >> 3) & 1) << 1) ^ ((r >> 4) & 1); return r * 128 + ((c ^ f) << 4); }

struct G2Args {
    const char* A; const char* B;
    unsigned offA[4], offB[4];
    int nk;
    unsigned akstep;
};
__device__ __forceinline__ unsigned g2_chunk_off(int lane, int w) { const int f = (lane >> 3) ^ ((w & 1) << 1) ^ ((w >> 1) & 1); return (unsigned)(((lane & 7) ^ f) << 4); }
template <int MT, class Epi>
__device__ __forceinline__ void gemm2(char* lds_, const G2Args& g, const Epi& epi) {
    constexpr int A_BYTES = 32 * MT * 128, B_BYTES = 256 * 128, STAGE = A_BYTES + B_BYTES, AR = MT / 2;
    LAS char* lds = (LAS char*)lds_;
    const int tid = threadIdx.x, lane = tid & 63, w = __builtin_amdgcn_readfirstlane(tid >> 6), wr = w >> 2, wc = w & 3, fr = lane & 15, fq = lane >> 4;
    f32x4 acc[MT][4];
#pragma unroll
    for (int i = 0; i < MT; ++i)
#pragma unroll
        for (int j = 0; j < 4; ++j) acc[i][j] = (f32x4){0.f, 0.f, 0.f, 0.f};
    const int ldsw = w * 1024;
#define G2_STAGE(kt, s) do { \
        _Pragma("unroll") for (int i = 0; i < AR; ++i) __builtin_amdgcn_global_load_lds((const unsigned*)(g.A + g.offA[i] + (size_t)(kt) * g.akstep), (LAS unsigned*)(lds + (s) * STAGE + i * 8192 + ldsw), 16, 0, 0); \
        _Pragma("unroll") for (int i = 0; i < 4; ++i) __builtin_amdgcn_global_load_lds((const unsigned*)(g.B + g.offB[i] + (size_t)(kt) * 128), (LAS unsigned*)(lds + (s) * STAGE + A_BYTES + i * 8192 + ldsw), 16, 0, 0); } while (0)
    G2_STAGE(0, 0);
    __syncthreads();
    for (int kt = 0; kt < g.nk; ++kt) {
        const int s = kt & 1;
        if (kt + 1 < g.nk) { if (s) G2_STAGE(kt + 1, 0); else G2_STAGE(kt + 1, 1); }
        const char* la = lds_ + s * STAGE; const char* lb = la + A_BYTES;
        {
            constexpr int NG = 2 * (MT / 4);
            bf16x8 bfr[4], af[2][4];
#pragma unroll
            for (int nt = 0; nt < 4; ++nt) bfr[nt] = *(const bf16x8*)(lb + swz(wc * 64 + nt * 16 + fr, fq));
#pragma unroll
            for (int m = 0; m < 4; ++m) af[0][m] = *(const bf16x8*)(la + swz(wr * 16 * MT + m * 16 + fr, fq));
#pragma unroll
            for (int gi = 0; gi < NG; ++gi) {
                const int ks = gi / (MT / 4), h = gi % (MT / 4);
                if (gi > 0 && h == 0) {
#pragma unroll
                    for (int nt = 0; nt < 4; ++nt) bfr[nt] = *(const bf16x8*)(lb + swz(wc * 64 + nt * 16 + fr, ks * 4 + fq));
                }
                if (gi + 1 < NG) {
                    const int ks2 = (gi + 1) / (MT / 4), h2 = (gi + 1) % (MT / 4);
#pragma unroll
                    for (int m = 0; m < 4; ++m) af[(gi + 1) & 1][m] = *(const bf16x8*)(la + swz(wr * 16 * MT + (h2 * 4 + m) * 16 + fr, ks2 * 4 + fq));
                }
                __builtin_amdgcn_sched_barrier(0);
#pragma unroll
                for (int m = 0; m < 4; ++m)
#pragma unroll
                    for (int nt = 0; nt < 4; ++nt) acc[h * 4 + m][nt] = __builtin_amdgcn_mfma_f32_16x16x32_bf16(bfr[nt], af[gi & 1][m], acc[h * 4 + m][nt], 0, 0, 0);
                __builtin_amdgcn_sched_barrier(0);
            }
        }
        __syncthreads();
    }
#undef G2_STAGE
    epi(acc, wr, wc, fr, fq);
}
template <int MT>
__device__ __forceinline__ void g2_rows_A(G2Args& g, size_t row0, unsigned ld_bytes) {
    const int lane = threadIdx.x & 63, w = __builtin_amdgcn_readfirstlane(threadIdx.x >> 6); const unsigned co = g2_chunk_off(lane, w);
#pragma unroll
    for (int i = 0; i < MT / 2; ++i) g.offA[i] = (unsigned)((row0 + i * 64 + w * 8 + (lane >> 3)) * ld_bytes) + co;
}
__device__ __forceinline__ void g2_rows_B(G2Args& g, size_t row0, unsigned ld_bytes) {
    const int lane = threadIdx.x & 63, w = __builtin_amdgcn_readfirstlane(threadIdx.x >> 6); const unsigned co = g2_chunk_off(lane, w);
#pragma unroll
    for (int i = 0; i < 4; ++i) g.offB[i] = (unsigned)((row0 + i * 64 + w * 8 + (lane >> 3)) * ld_bytes) + co;
}


struct G3Args { const char* A; unsigned offA[4]; const float* b; int ldb; int nk; };
template <int MT, class Epi>
__device__ __forceinline__ void gemm3(char* lds_, const G3Args& g, const Epi& epi) {
    constexpr int A_BYTES = 32 * MT * 128, B_BYTES = 256 * 128, STAGE = A_BYTES + B_BYTES, AR = MT / 2;
    LAS char* lds = (LAS char*)lds_;
    const int tid = threadIdx.x, lane = tid & 63, w = __builtin_amdgcn_readfirstlane(tid >> 6), wr = w >> 2, wc = w & 3, fr = lane & 15, fq = lane >> 4;
    f32x4 acc[MT][4];
#pragma unroll
    for (int i = 0; i < MT; ++i)
#pragma unroll
        for (int j = 0; j < 4; ++j) acc[i][j] = (f32x4){0.f, 0.f, 0.f, 0.f};
    const int ldsw = w * 1024;
    int bw[4];
#pragma unroll
    for (int j = 0; j < 4; ++j) bw[j] = swz(4 * lane + j, w);
    f32x4 br[8]; const float* pb = g.b;
#define G3_STAGE_A(kt, s) do { \
        _Pragma("unroll") for (int i = 0; i < AR; ++i) __builtin_amdgcn_global_load_lds((const unsigned*)(g.A + g.offA[i] + (size_t)(kt) * 128), (LAS unsigned*)(lds + (s) * STAGE + i * 8192 + ldsw), 16, 0, 0); } while (0)
#define G3_LOAD_B() do { _Pragma("unroll") for (int i = 0; i < 8; ++i) br[i] = *(const f32x4*)(pb + (size_t)i * g.ldb); pb += (size_t)64 * g.ldb; } while (0)
#define G3_WRITE_B(s) do { _Pragma("unroll") for (int j = 0; j < 4; ++j) { \
            u32x4 v = {cvt_pk(br[0][j], br[1][j]), cvt_pk(br[2][j], br[3][j]), cvt_pk(br[4][j], br[5][j]), cvt_pk(br[6][j], br[7][j])}; \
            *(u32x4*)(lds_ + (s) * STAGE + A_BYTES + bw[j]) = v; } } while (0)
    G3_STAGE_A(0, 0); G3_LOAD_B(); G3_WRITE_B(0);
    __syncthreads();
    for (int kt = 0; kt < g.nk; ++kt) {
        const int s = kt & 1; const bool more = kt + 1 < g.nk;
        if (more) { if (s) G3_STAGE_A(kt + 1, 0); else G3_STAGE_A(kt + 1, 1); G3_LOAD_B(); }
        __builtin_amdgcn_sched_barrier(0);
        const char* la = lds_ + s * STAGE; const char* lb = la + A_BYTES;
#pragma unroll
        for (int ks = 0; ks < 2; ++ks) {
            bf16x8 bfr[4];
#pragma unroll
            for (int nt = 0; nt < 4; ++nt) bfr[nt] = *(const bf16x8*)(lb + swz(wc * 64 + nt * 16 + fr, ks * 4 + fq));
#pragma unroll
            for (int h = 0; h < MT / 4; ++h) {
                bf16x8 af[4];
#pragma unroll
                for (int m = 0; m < 4; ++m) af[m] = *(const bf16x8*)(la + swz(wr * 16 * MT + (h * 4 + m) * 16 + fr, ks * 4 + fq));
#pragma unroll
                for (int m = 0; m < 4; ++m)
#pragma unroll
                    for (int nt = 0; nt < 4; ++nt) acc[h * 4 + m][nt] = __builtin_amdgcn_mfma_f32_16x16x32_bf16(bfr[nt], af[m], acc[h * 4 + m][nt], 0, 0, 0);
            }
        }
        if (more) { if (s) G3_WRITE_B(0); else G3_WRITE_B(1); }
        __syncthreads();
    }
#undef G3_STAGE_A
#undef G3_LOAD_B
#undef G3_WRITE_B
    epi(acc, wr, wc, fr, fq);
}


struct G3bArgs { const char* A; unsigned offA[4]; const unsigned char* b; int ldb; int nk; unsigned akstep; };
template <int MT, int LDB, class Epi>
__device__ __forceinline__ void gemm3b(char* lds_, const G3bArgs& g, int npass, int bpstep, const Epi& epi) {
    constexpr int A_BYTES = 32 * MT * 128, B_BYTES = 256 * 128, STAGE = A_BYTES + B_BYTES, AR = MT / 2;
    LAS char* lds = (LAS char*)lds_;
    const int tid = threadIdx.x, lane = tid & 63, w = __builtin_amdgcn_readfirstlane(tid >> 6), wr = w >> 2, wc = w & 3, fr = lane & 15, fq = lane >> 4;
    f32x4 acc[MT][4];
#pragma unroll
    for (int i = 0; i < MT; ++i)
#pragma unroll
        for (int j = 0; j < 4; ++j) acc[i][j] = (f32x4){0.f, 0.f, 0.f, 0.f};
    const int ldsw = w * 1024;
    int bw[4];
#pragma unroll
    for (int j = 0; j < 4; ++j) bw[j] = swz(4 * lane + j, w);
    unsigned br[8];
    const int nk = g.nk, nsteps = nk * npass;
#define G3_STAGE_A(kt, s) do { \
        _Pragma("unroll") for (int i = 0; i < AR; ++i) __builtin_amdgcn_global_load_lds((const unsigned*)(g.A + g.offA[i] + (size_t)(kt) * g.akstep), (LAS unsigned*)(lds + (s) * STAGE + i * 8192 + ldsw), 16, 0, 0); } while (0)
#define G3_LOAD_B(ps, kt) do { const unsigned char* pb_ = g.b + (size_t)(ps) * bpstep + (size_t)(kt) * 64 * LDB; _Pragma("unroll") for (int i = 0; i < 8; ++i) br[i] = *(const unsigned*)(pb_ + i * LDB); } while (0)
#define G3_WRITE_B(s) do { _Pragma("unroll") for (int hh = 0; hh < 2; ++hh) { f32x2 f[8]; \
            _Pragma("unroll") for (int i = 0; i < 8; ++i) f[i] = hh ? __builtin_amdgcn_cvt_pk_f32_fp8((int)br[i], true) : __builtin_amdgcn_cvt_pk_f32_fp8((int)br[i], false); \
            _Pragma("unroll") for (int jj = 0; jj < 2; ++jj) { \
                u32x4 v = {cvt_pk(f[0][jj], f[1][jj]), cvt_pk(f[2][jj], f[3][jj]), cvt_pk(f[4][jj], f[5][jj]), cvt_pk(f[6][jj], f[7][jj])}; \
                *(u32x4*)(lds_ + (s) * STAGE + A_BYTES + bw[hh * 2 + jj]) = v; } } } while (0)
    G3_STAGE_A(0, 0); G3_LOAD_B(0, 0); G3_WRITE_B(0);
    __syncthreads();
    int ps = 0, kt = 0;
    for (int st = 0; st < nsteps; ++st) {
        const int s = st & 1; const bool more = st + 1 < nsteps;
        int ps2 = ps, kt2 = kt + 1; if (kt2 == nk) { kt2 = 0; ++ps2; }
        if (more) { if (s) G3_STAGE_A(kt2, 0); else G3_STAGE_A(kt2, 1); G3_LOAD_B(ps2, kt2); }
        __builtin_amdgcn_sched_barrier(0);
        const char* la = lds_ + s * STAGE; const char* lb = la + A_BYTES;
#pragma unroll
        for (int ks = 0; ks < 2; ++ks) {
            bf16x8 bfr[4];
#pragma unroll
            for (int nt = 0; nt < 4; ++nt) bfr[nt] = *(const bf16x8*)(lb + swz(wc * 64 + nt * 16 + fr, ks * 4 + fq));
#pragma unroll
            for (int h = 0; h < MT / 4; ++h) {
                bf16x8 af[4];
#pragma unroll
                for (int m = 0; m < 4; ++m) af[m] = *(const bf16x8*)(la + swz(wr * 16 * MT + (h * 4 + m) * 16 + fr, ks * 4 + fq));
                __builtin_amdgcn_sched_barrier(0);
#pragma unroll
                for (int m = 0; m < 4; ++m)
#pragma unroll
                    for (int nt = 0; nt < 4; ++nt) acc[h * 4 + m][nt] = __builtin_amdgcn_mfma_f32_16x16x32_bf16(bfr[nt], af[m], acc[h * 4 + m][nt], 0, 0, 0);
                __builtin_amdgcn_sched_barrier(0);
            }
        }
        if (kt == nk - 1) {
            epi(acc, ps, wr, wc, fr, fq);
#pragma unroll
            for (int i = 0; i < MT; ++i)
#pragma unroll
                for (int j = 0; j < 4; ++j) acc[i][j] = (f32x4){0.f, 0.f, 0.f, 0.f};
        }
        if (more) { if (s) G3_WRITE_B(0); else G3_WRITE_B(1); }
        __syncthreads();
        ps = ps2; kt = kt2;
    }
#undef G3_STAGE_A
#undef G3_LOAD_B
#undef G3_WRITE_B
}

struct G3fArgs { const char* A; unsigned offA[4]; const float* b; int nk; unsigned akstep; };
template <int MT, int LDB, class Epi>
__device__ __forceinline__ void gemm3f(char* lds_, const G3fArgs& g, int npass, int bpstep, const Epi& epi) {
    constexpr int A_BYTES = 32 * MT * 128, B_BYTES = 256 * 128, STAGE = A_BYTES + B_BYTES, AR = MT / 2;
    LAS char* lds = (LAS char*)lds_;
    const int tid = threadIdx.x, lane = tid & 63, w = __builtin_amdgcn_readfirstlane(tid >> 6), wr = w >> 2, wc = w & 3, fr = lane & 15, fq = lane >> 4;
    f32x4 acc[MT][4];
#pragma unroll
    for (int i = 0; i < MT; ++i)
#pragma unroll
        for (int j = 0; j < 4; ++j) acc[i][j] = (f32x4){0.f, 0.f, 0.f, 0.f};
    const int ldsw = w * 1024;
    int bw[4];
#pragma unroll
    for (int j = 0; j < 4; ++j) bw[j] = swz(4 * lane + j, w);
    f32x4 br[8];
    const int nk = g.nk, nsteps = nk * npass;
#define G3_STAGE_A(kt, s) do { \
        _Pragma("unroll") for (int i = 0; i < AR; ++i) __builtin_amdgcn_global_load_lds((const unsigned*)(g.A + g.offA[i] + (size_t)(kt) * g.akstep), (LAS unsigned*)(lds + (s) * STAGE + i * 8192 + ldsw), 16, 0, 0); } while (0)
#define G3_LOAD_B(ps, kt) do { const float* pb_ = g.b + (size_t)(ps) * bpstep + (size_t)(kt) * 64 * LDB; _Pragma("unroll") for (int i = 0; i < 8; ++i) br[i] = *(const f32x4*)(pb_ + i * LDB); } while (0)
#define G3_WRITE_B(s) do { _Pragma("unroll") for (int j = 0; j < 4; ++j) { \
            u32x4 v = {cvt_pk(br[0][j], br[1][j]), cvt_pk(br[2][j], br[3][j]), cvt_pk(br[4][j], br[5][j]), cvt_pk(br[6][j], br[7][j])}; \
            *(u32x4*)(lds_ + (s) * STAGE + A_BYTES + bw[j]) = v; } } while (0)
    G3_STAGE_A(0, 0); G3_LOAD_B(0, 0); G3_WRITE_B(0);
    __syncthreads();
    int ps = 0, kt = 0;
    for (int st = 0; st < nsteps; ++st) {
        const int s = st & 1; const bool more = st + 1 < nsteps;
        int ps2 = ps, kt2 = kt + 1; if (kt2 == nk) { kt2 = 0; ++ps2; }
        if (more) { if (s) G3_STAGE_A(kt2, 0); else G3_STAGE_A(kt2, 1); G3_LOAD_B(ps2, kt2); }
        __builtin_amdgcn_sched_barrier(0);
        const char* la = lds_ + s * STAGE; const char* lb = la + A_BYTES;
#pragma unroll
        for (int ks = 0; ks < 2; ++ks) {
            bf16x8 bfr[4];
#pragma unroll
            for (int nt = 0; nt < 4; ++nt) bfr[nt] = *(const bf16x8*)(lb + swz(wc * 64 + nt * 16 + fr, ks * 4 + fq));
#pragma unroll
            for (int h = 0; h < MT / 2; ++h) {
                bf16x8 af[2];
#pragma unroll
                for (int m = 0; m < 2; ++m) af[m] = *(const bf16x8*)(la + swz(wr * 16 * MT + (h * 2 + m) * 16 + fr, ks * 4 + fq));
                __builtin_amdgcn_sched_barrier(0);
#pragma unroll
                for (int m = 0; m < 2; ++m)
#pragma unroll
                    for (int nt = 0; nt < 4; ++nt) acc[h * 2 + m][nt] = __builtin_amdgcn_mfma_f32_16x16x32_bf16(bfr[nt], af[m], acc[h * 2 + m][nt], 0, 0, 0);
                __builtin_amdgcn_sched_barrier(0);
            }
        }
        if (kt == nk - 1) {
            epi(acc, ps, wr, wc, fr, fq);
#pragma unroll
            for (int i = 0; i < MT; ++i)
#pragma unroll
                for (int j = 0; j < 4; ++j) acc[i][j] = (f32x4){0.f, 0.f, 0.f, 0.f};
        }
        if (more) { if (s) G3_WRITE_B(0); else G3_WRITE_B(1); }
        __syncthreads();
        ps = ps2; kt = kt2;
    }
#undef G3_STAGE_A
#undef G3_LOAD_B
#undef G3_WRITE_B
}

__device__ __forceinline__ void cvt_item(const float* W, int K, int N, bf16_t* WT, int ldt, int kb, int nb, int lane) {
    const float* src = W + (size_t)(kb * 64) * N + nb * 256 + 4 * lane;
    bf16_t* dst = WT + (size_t)(nb * 256 + 4 * lane) * ldt + kb * 64;
#pragma unroll 2
    for (int kc = 0; kc < 8; ++kc) {
        f32x4 r[8];
#pragma unroll
        for (int i = 0; i < 8; ++i) r[i] = *(const f32x4*)(src + (size_t)(kc * 8 + i) * N);
#pragma unroll
        for (int j = 0; j < 4; ++j) {
            u32x4 v = {cvt_pk(r[0][j], r[1][j]), cvt_pk(r[2][j], r[3][j]), cvt_pk(r[4][j], r[5][j]), cvt_pk(r[6][j], r[7][j])};
            *(u32x4*)(dst + (size_t)j * ldt + kc * 8) = v;
        }
    }
}
__device__ __forceinline__ void phase_prep(const Params& p, int vb, int G) {
    const int tid = threadIdx.x, lane = tid & 63, w = tid >> 6;
    float* cs = (float*)(p.ws + WS_ROPE); float* sn = cs + (size_t)S * 32;
    for (int idx = vb * NTHREADS + tid; idx < S * 32; idx += G * NTHREADS) {
        const int pos = idx >> 5, i = idx & 31;
        const float pw = (float)pow(10000.0, (double)i / 32.0);
        const float inv = 1.0f / pw;
        const float angf = __fmul_rn((float)pos, inv);
        const double a = (double)angf;
        const double q = rint(a * 0.63661977236758134308);
        double r = fma(-q, 1.57079632679489655800, a); r = fma(-q, 6.12323399573676603587e-17, r);
        const double r2 = r * r;
        double sp = r * (1.0 + r2 * (-1.0 / 6 + r2 * (1.0 / 120 + r2 * (-1.0 / 5040 + r2 * (1.0 / 362880 + r2 * (-1.0 / 39916800))))));
        double cp = 1.0 + r2 * (-0.5 + r2 * (1.0 / 24 + r2 * (-1.0 / 720 + r2 * (1.0 / 40320 + r2 * (-1.0 / 3628800 + r2 * (1.0 / 479001600))))));
        const int qi = ((int)((long long)q)) & 3;
        double sv, cv;
        if (qi == 0) { sv = sp; cv = cp; } else if (qi == 1) { sv = cp; cv = -sp; } else if (qi == 2) { sv = -sp; cv = -cp; } else { sv = -cp; cv = sp; }
        cs[idx] = (float)cv; sn[idx] = (float)sv;
    }
    { const f32x4* xs = (const f32x4*)p.x; u32x4* xd = (u32x4*)(p.ws + WS_XB);
      for (size_t i = (size_t)vb * NTHREADS + tid; i < (size_t)S * D / 8; i += (size_t)G * NTHREADS) {
          const f32x4 a = xs[2 * i], b = xs[2 * i + 1];
          xd[i] = (u32x4){cvt_pk(a[0], a[1]), cvt_pk(a[2], a[3]), cvt_pk(b[0], b[1]), cvt_pk(b[2], b[3])}; } }
    const int gw = vb * 8 + w, NGW = G * 8;
    constexpr int I_IN = 16 * 9, I_OUT = 16 * 4, I_R = 16, I_SG = 16, I_SU = 16, I_SD = 4 * 4, I_SMALL = I_IN + I_OUT + I_R;
    for (int it = gw; it < I_SMALL; it += NGW) {
        int r = it;
        if (r < I_IN) { cvt_item(p.w_in, D, INW, (bf16_t*)(p.ws + WS_WIN), D, r / 9, r % 9, lane); continue; } r -= I_IN;
        if (r < I_OUT) { cvt_item(p.w_out, D, D, (bf16_t*)(p.ws + WS_WOUT), D, r >> 2, r & 3, lane); continue; } r -= I_OUT;
        cvt_item(p.w_r, D, NE, (bf16_t*)(p.ws + WS_WR), D, r, 0, lane);
    }
}

template <int MT> struct EpiProj {
    const float* bias; const float* cs; const float* sn; bf16_t* out; int row0, col0;
    __device__ __forceinline__ void operator()(f32x4 (&acc)[MT][4], int wr, int wc, int fr, int fq) const {
        const int hb = col0 + wc * 64;
        const bool is_q = (hb < C_AK) || (hb >= C_BQ && hb < C_BK);
        const bool is_rope = is_q || (hb >= C_AK && hb < C_AV) || (hb >= C_BK && hb < C_BV);
        const float sc = is_q ? QSCALE : 1.0f;
#pragma unroll
        for (int mt = 0; mt < MT; ++mt) {
            const int row = row0 + wr * 16 * MT + mt * 16 + fr;
            f32x4 v[4];
#pragma unroll
            for (int nt = 0; nt < 4; ++nt) v[nt] = acc[mt][nt] + *(const f32x4*)(bias + hb + nt * 16 + 4 * fq);
            if (is_rope) {
#pragma unroll
                for (int nt = 0; nt < 2; ++nt) {
                    const f32x4 c = *(const f32x4*)(cs + (size_t)row * 32 + nt * 16 + 4 * fq), s = *(const f32x4*)(sn + (size_t)row * 32 + nt * 16 + 4 * fq);
                    const f32x4 t1 = v[nt], t2 = v[nt + 2];
                    v[nt] = t1 * c - t2 * s; v[nt + 2] = t2 * c + t1 * s;
                }
            }
#pragma unroll
            for (int nt = 0; nt < 4; ++nt) {
                const f32x4 o = v[nt] * sc;
                u32x2 pk = {cvt_pk(o[0], o[1]), cvt_pk(o[2], o[3])};
                *(u32x2*)(out + (size_t)row * INW + hb + nt * 16 + 4 * fq) = pk;
            }
        }
    }
};
__device__ __forceinline__ void phase_proj(const Params& p, char* lds, int vb, int G) {
    const float* cs = (const float*)(p.ws + WS_ROPE); const float* sn = cs + (size_t)S * 32;
    constexpr int NBIG = 512, NUNITS = NBIG + 2 * 64;
    for (int u = vb; u < NUNITS; u += G) {
        G2Args g; g.A = (const char*)(p.ws + WS_XB); g.B = (const char*)(p.ws + WS_WIN); g.nk = D / 64; g.akstep = 128;
        if (u < NBIG) {
            const int tm = u / 9, tn = u % 9;
            g2_rows_A<8>(g, (size_t)tm * 256, D * 2); g2_rows_B(g, (size_t)tn * 256, D * 2);
            EpiProj<8> e{p.b_in, cs, sn, (bf16_t*)(p.ws + WS_PROJ), tm * 256, tn * 256};
            gemm2<8>(lds, g, e);
        } else {
            const int t = NBIG + ((u - NBIG) >> 1), half = (u - NBIG) & 1, tm = t / 9, tn = t % 9;
            g2_rows_A<4>(g, (size_t)tm * 256 + half * 128, D * 2); g2_rows_B(g, (size_t)tn * 256, D * 2);
            EpiProj<4> e{p.b_in, cs, sn, (bf16_t*)(p.ws + WS_PROJ), tm * 256 + half * 128, tn * 256};
            gemm2<4>(lds, g, e);
        }
    }
}

template <int OFF> __device__ __forceinline__ s16x4 tr_read(int vb) { s16x4 r; asm volatile("ds_read_b64_tr_b16 %0, %1 offset:%2" : "=&v"(r) : "v"(vb), "i"(OFF) : "memory"); return r; }
__device__ __forceinline__ int v_off(int k, int c, int ndb) { return ((k >> 3) * ndb + (c >> 5)) * 512 + ((k & 7) * 32 + (c & 31)) * 2; }

constexpr int AT_STAGE = 32768;
template <int NDB, int KB, int T> struct PvPart {
    static __device__ __forceinline__ void run(f32x16& o, int vbase, const bf16x8& pa, const bf16x8& pb) {
        constexpr int o0 = (KB * 4 * NDB + T) * 512, st = NDB * 512;
        const s16x4 l0 = tr_read<o0 + 0 * st>(vbase), h0 = tr_read<o0 + 1 * st>(vbase), l1 = tr_read<o0 + 2 * st>(vbase), h1 = tr_read<o0 + 3 * st>(vbase);
        asm volatile("s_waitcnt lgkmcnt(0)" ::: "memory"); __builtin_amdgcn_sched_barrier(0);
#define PKV(L, H) (bf16x8){L[0], L[1], L[2], L[3], H[0], H[1], H[2], H[3]}
        o = __builtin_amdgcn_mfma_f32_32x32x16_bf16(PKV(l0, h0), pa, o, 0, 0, 0);
        o = __builtin_amdgcn_mfma_f32_32x32x16_bf16(PKV(l1, h1), pb, o, 0, 0, 0);
#undef PKV
    }
};
template <int NDB, int KB>
__device__ __forceinline__ void pv_half(f32x16 (&o)[NDB], f32x16& ol, int vbase, const bf16x8& pa, const bf16x8& pb) {
    const bf16x8 ones = {16256, 16256, 16256, 16256, 16256, 16256, 16256, 16256};
    ol = __builtin_amdgcn_mfma_f32_32x32x16_bf16(ones, pa, ol, 0, 0, 0);
    ol = __builtin_amdgcn_mfma_f32_32x32x16_bf16(ones, pb, ol, 0, 0, 0);
    PvPart<NDB, KB, 0>::run(o[0], vbase, pa, pb); PvPart<NDB, KB, 1>::run(o[1], vbase, pa, pb);
    if constexpr (NDB == 4) { PvPart<NDB, KB, 2>::run(o[2], vbase, pa, pb); PvPart<NDB, KB, 3>::run(o[3], vbase, pa, pb); }
}
constexpr float ATT_THR = 10.0f;
template <int NDB>
__device__ __forceinline__ void attn_scores(char* lds, int kof, const bf16x8 (&qf)[4], f32x16& s0, f32x16& s1, f32x16 (&o)[NDB], f32x16& ol, f32x16& nm, bool first, int r32, int hi) {
    s0 = nm; s1 = nm;
#pragma unroll
    for (int ds = 0; ds < 4; ++ds) {
        const bf16x8 k0 = *(const bf16x8*)(lds + kof + swz(r32, ds * 2 + hi)), k1 = *(const bf16x8*)(lds + kof + swz(32 + r32, ds * 2 + hi));
        s0 = __builtin_amdgcn_mfma_f32_32x32x16_bf16(k0, qf[ds], s0, 0, 0, 0);
        s1 = __builtin_amdgcn_mfma_f32_32x32x16_bf16(k1, qf[ds], s1, 0, 0, 0);
    }
    float mx = fmaxf(s0[0], s1[0]);
#pragma unroll
    for (int r = 1; r < 16; ++r) mx = fmaxf(fmaxf(mx, s0[r]), s1[r]);
    mx = half_max(mx);
    if (first || __any(mx > ATT_THR)) {
        const float delta = first ? mx : fmaxf(mx, 0.f), alpha = first ? 0.f : __builtin_amdgcn_exp2f(-delta);
#pragma unroll
        for (int r = 0; r < 16; ++r) { s0[r] -= delta; s1[r] -= delta; nm[r] -= delta; ol[r] *= alpha; }
#pragma unroll
        for (int t = 0; t < NDB; ++t)
#pragma unroll
            for (int r = 0; r < 16; ++r) o[t][r] *= alpha;
    }
}
__device__ __forceinline__ void exp_pack(const f32x16& s, bf16x8& pa, bf16x8& pb) {
    float e[16];
#pragma unroll
    for (int r = 0; r < 16; ++r) e[r] = __builtin_amdgcn_exp2f(s[r]);
    u32x4 a = {cvt_pk(e[0], e[1]), cvt_pk(e[2], e[3]), cvt_pk(e[4], e[5]), cvt_pk(e[6], e[7])};
    u32x4 b = {cvt_pk(e[8], e[9]), cvt_pk(e[10], e[11]), cvt_pk(e[12], e[13]), cvt_pk(e[14], e[15])};
    pa = *(bf16x8*)&a; pb = *(bf16x8*)&b;
}

struct CvState { int c; int have; f32x4 a, b, a2, b2; };
constexpr int CV_CHUNKS = 192;
__device__ __forceinline__ const float* cv_src(const Params& p, int e, int c) { const int seg = c >> 6; const float* base = seg == 0 ? p.w_g : (seg == 1 ? p.w_u : p.w_d); return base + (size_t)e * 262144 + (size_t)(c & 63) * 4096 + threadIdx.x * 8; }
__device__ __forceinline__ unsigned char* cv_dst(const Params& p, int e, int c) { const int seg = c >> 6; unsigned char* base = seg < 2 ? (unsigned char*)(p.ws + WS_EGU) + (size_t)e * 524288 + (size_t)seg * 262144 : (unsigned char*)(p.ws + WS_ED) + (size_t)e * 262144; return base + (size_t)(c & 63) * 4096 + threadIdx.x * 8; }
__device__ __forceinline__ void cv_step(const Params& p, int e, CvState& cv) {
    if (cv.have) {
        *(u32x2*)cv_dst(p, e, cv.c - 2) = (u32x2){pack_fp8x4(cv.a), pack_fp8x4(cv.b)};
        *(u32x2*)cv_dst(p, e, cv.c - 1) = (u32x2){pack_fp8x4(cv.a2), pack_fp8x4(cv.b2)};
        cv.have = 0; }
    if (cv.c < CV_CHUNKS) { const float* sp = cv_src(p, e, cv.c); cv.a = *(const f32x4*)sp; cv.b = *(const f32x4*)(sp + 4);
        const float* sp2 = cv_src(p, e, cv.c + 1); cv.a2 = *(const f32x4*)sp2; cv.b2 = *(const f32x4*)(sp2 + 4); cv.have = 1; cv.c += 2; }
}
__device__ __forceinline__ void attn_diff_unit(const Params& p, char* lds_, int h, int qb, float lam, int cve, CvState& cv) {
    LAS char* lds = (LAS char*)lds_;
    const int tid = threadIdx.x, lane = tid & 63, w = __builtin_amdgcn_readfirstlane(tid >> 6), r32 = lane & 31, hi = lane >> 5, mp = w >> 2, wq = w & 3;
    const bf16_t* proj = (const bf16_t*)(p.ws + WS_PROJ);
    const int NT = 2 * qb + 2, NP = NT / 2, myNT = (wq < 2) ? NT - 1 : NT;
    bf16x8 qf[4];
    { const bf16_t* qp = proj + (size_t)(qb * 128 + wq * 32 + r32) * INW + C_BQ + h * 128 + mp * 64 + hi * 8;
#pragma unroll
      for (int ds = 0; ds < 4; ++ds) qf[ds] = *(const bf16x8*)(qp + ds * 16); }
    asm volatile("" : "+v"(qf[0]), "+v"(qf[1]), "+v"(qf[2]), "+v"(qf[3]));
    f32x16 o[4] = {}; f32x16 ol = {}, nm = {};
    const char* gk = (const char*)(proj + (size_t)(w * 8 + (lane >> 3)) * INW + C_BK + h * 128) + g2_chunk_off(lane, w);
    const char* gv = (const char*)(proj + (size_t)(w * 8 + ((lane & 31) >> 2)) * INW + C_BV + h * 128 + (lane >> 5) * 32 + (lane & 3) * 8);
    const int vlane = ((lane & 3) << 3) | (((lane >> 2) & 3) << 6) | (((lane >> 4) & 1) << 5) | (((lane >> 5) & 1) << 8);
    constexpr size_t TSTEP = (size_t)64 * INW * 2;
#define A_STAGE(pr, sg) do { const char* k0_ = gk + (size_t)(pr) * 2 * TSTEP; const char* v0_ = gv + (size_t)(pr) * 2 * TSTEP; \
        _Pragma("unroll") for (int j = 0; j < 2; ++j) { \
            __builtin_amdgcn_global_load_lds((const unsigned*)(k0_ + j * TSTEP), (LAS unsigned*)(lds + (sg) * 65536 + (0 * 2 + j) * 8192 + w * 1024), 16, 0, 0); \
            __builtin_amdgcn_global_load_lds((const unsigned*)(k0_ + j * TSTEP + 128), (LAS unsigned*)(lds + (sg) * 65536 + (1 * 2 + j) * 8192 + w * 1024), 16, 0, 0); \
            __builtin_amdgcn_global_load_lds((const unsigned*)(v0_ + j * TSTEP), (LAS unsigned*)(lds + (sg) * 65536 + 32768 + j * 16384 + (2 * w) * 1024), 16, 0, 0); \
            __builtin_amdgcn_global_load_lds((const unsigned*)(v0_ + j * TSTEP + 128), (LAS unsigned*)(lds + (sg) * 65536 + 32768 + j * 16384 + (2 * w + 1) * 1024), 16, 0, 0); } } while (0)
    A_STAGE(0, 0);
    __syncthreads();
    bool first = true;
    for (int it = 0; it < NP; ++it) {
        const int sg = it & 1;
        if (it + 1 < NP) { if (sg) A_STAGE(it + 1, 0); else A_STAGE(it + 1, 1); }
#pragma unroll
        for (int jj = 0; jj < 2; ++jj) {
            const int j = jj, t = 2 * it + j;
            if (t < myNT) {
                bf16x8 p0, p1, p2, p3; f32x16 s0, s1;
                const int vb_ = (int)(uintptr_t)(lds_ + sg * 65536 + 32768 + j * 16384) + vlane;
                attn_scores<4>(lds_, sg * 65536 + (mp * 2 + j) * 8192, qf, s0, s1, o, ol, nm, first, r32, hi);
                first = false;
                exp_pack(s0, p0, p1); pv_half<4, 0>(o, ol, vb_, p0, p1); exp_pack(s1, p2, p3); pv_half<4, 1>(o, ol, vb_, p2, p3);
            }
        }
        __syncthreads();
    }
#undef A_STAGE
    float* xb = (float*)lds_;
    const float il = 1.0f / ol[0];
    if (mp == 1) {
        const float f = il * lam;
#pragma unroll
        for (int t = 0; t < 4; ++t)
#pragma unroll
            for (int r = 0; r < 16; ++r) xb[(wq * 64 + t * 16 + r) * 64 + lane] = o[t][r] * f;
    }
    __syncthreads();
    if (mp == 0) {
        float ss = 0.f;
#pragma unroll
        for (int t = 0; t < 4; ++t)
#pragma unroll
            for (int r = 0; r < 16; ++r) { const float v = o[t][r] * il - xb[(wq * 64 + t * 16 + r) * 64 + lane]; o[t][r] = v; ss += v * v; }
        ss = half_sum(ss);
        const float rs = rsqrtf(ss * (1.0f / 128.0f) + LN_EPS) * 0.8f;
        bf16_t* op = (bf16_t*)(p.ws + WS_ATT) + (size_t)(qb * 128 + wq * 32 + r32) * D + 512 + h * 128;
#pragma unroll
        for (int t = 0; t < 4; ++t)
#pragma unroll
            for (int rr = 0; rr < 4; ++rr) {
                const int dv0 = 32 * t + 8 * rr + 4 * hi;
                const f32x4 gg = *(const f32x4*)(p.subg + dv0);
                u32x2 pk = {cvt_pk(o[t][4 * rr] * rs * gg[0], o[t][4 * rr + 1] * rs * gg[1]), cvt_pk(o[t][4 * rr + 2] * rs * gg[2], o[t][4 * rr + 3] * rs * gg[3])};
                *(u32x2*)(op + dv0) = pk;
            }
    }
    __syncthreads();
}
__device__ __forceinline__ void attn_swa_unit(const Params& p, char* lds, int kvh, int n) {
    const int tid = threadIdx.x, lane = tid & 63, w = __builtin_amdgcn_readfirstlane(tid >> 6), r32 = lane & 31, hi = lane >> 5, g = w >> 1, hq = kvh * 4 + g;
    const bf16_t* proj = (const bf16_t*)(p.ws + WS_PROJ);
    const int c0 = (n >= 2) ? n - 2 : 0, NT = n - c0 + 1;
    const int tok = n * 64 + (w & 1) * 32 + r32;
    bf16x8 qf[4];
    { const bf16_t* qp = proj + (size_t)tok * INW + C_AQ + hq * 64 + hi * 8;
#pragma unroll
      for (int ds = 0; ds < 4; ++ds) qf[ds] = *(const bf16x8*)(qp + ds * 16); }
    f32x16 o[2] = {}; f32x16 ol, nm;
    { float ms = -p.sinks[hq] * LOG2E; asm volatile("" : "+v"(qf[0]), "+v"(qf[1]), "+v"(qf[2]), "+v"(qf[3]), "+v"(ms));
#pragma unroll
      for (int r = 0; r < 16; ++r) { nm[r] = ms; ol[r] = 1.0f; } }
    const bf16_t* gk = proj + (size_t)(c0 * 64 + (tid >> 3)) * INW + C_AK + kvh * 64 + (tid & 7) * 8;
    const bf16_t* gv = proj + (size_t)(c0 * 64 + (tid >> 3)) * INW + C_AV + kvh * 64 + (tid & 7) * 8;
    const int wk = swz(tid >> 3, tid & 7), wv = v_off(tid >> 3, (tid & 7) * 8, 2);
    const int vlane = ((lane & 3) << 3) | (((lane >> 2) & 3) << 6) | (((lane >> 4) & 1) << 5) | (((lane >> 5) & 1) << 8);
    u32x4 st0, st1;
#define W_LOAD(t) do { const size_t ko = (size_t)(t) * 64 * INW; st0 = *(const u32x4*)(gk + ko); st1 = *(const u32x4*)(gv + ko); } while (0)
#define W_WRITE(b) do { char* sb = lds + (b) * AT_STAGE; *(u32x4*)(sb + wk) = st0; *(u32x4*)(sb + 8192 + wv) = st1; } while (0)
    W_LOAD(0); W_WRITE(0); __syncthreads();
    for (int t = 0; t < NT; ++t) {
        const int b = t & 1;
        if (t + 1 < NT) W_LOAD(t + 1);
        { f32x16 s0, s1; bf16x8 p0, p1, p2, p3; const int vb_ = (int)(uintptr_t)(lds + b * AT_STAGE + 8192) + vlane;
          attn_scores<2>(lds, b * AT_STAGE, qf, s0, s1, o, ol, nm, false, r32, hi);
          exp_pack(s0, p0, p1); pv_half<2, 0>(o, ol, vb_, p0, p1); exp_pack(s1, p2, p3); pv_half<2, 1>(o, ol, vb_, p2, p3); }
        if (t + 1 < NT) W_WRITE(b ^ 1);
        __syncthreads();
    }
#undef W_LOAD
#undef W_WRITE
    const float il = 1.0f / ol[0];
    bf16_t* op = (bf16_t*)(p.ws + WS_ATT) + (size_t)tok * D + hq * 64;
#pragma unroll
    for (int t = 0; t < 2; ++t)
#pragma unroll
        for (int rr = 0; rr < 4; ++rr) {
            const int dv0 = 32 * t + 8 * rr + 4 * hi;
            u32x2 pk = {cvt_pk(o[t][4 * rr] * il, o[t][4 * rr + 1] * il), cvt_pk(o[t][4 * rr + 2] * il, o[t][4 * rr + 3] * il)};
            *(u32x2*)(op + dv0) = pk;
        }
}
__device__ __forceinline__ void phase_attn(const Params& p, char* lds, int vb, int G) {
    const int lane = threadIdx.x & 63;
    const float d1 = wave_sum(p.lq1[lane] * p.lk1[lane]), d2 = wave_sum(p.lq2[lane] * p.lk2[lane]);
    const float lam = expf(d1) - expf(d2) + 0.2f;
    CvState cv; cv.c = 0; cv.have = 0; cv.a = (f32x4){0.f, 0.f, 0.f, 0.f}; cv.b = cv.a; cv.a2 = cv.a; cv.b2 = cv.a;
    for (int u = vb; u < 1024; u += G) {
        if (u < 256) attn_diff_unit(p, lds, u >> 6, 127 - (u & 63), lam, vb, cv);
        else if (u < 512) attn_diff_unit(p, lds, (u - 256) >> 6, (u - 256) & 63, lam, vb, cv);
        else attn_swa_unit(p, lds, (u - 512) >> 8, (u - 512) & 255);
    }
}

struct EpiPreLn {
    const float* x; float* out; int row0, col0;
    __device__ __forceinline__ void operator()(f32x4 (&acc)[8][4], int wr, int wc, int fr, int fq) const {
#pragma unroll
        for (int mt = 0; mt < 8; ++mt) {
            const size_t ro = (size_t)(row0 + wr * 128 + mt * 16 + fr) * D + col0 + wc * 64 + 4 * fq;
#pragma unroll
            for (int nt = 0; nt < 4; ++nt) { const f32x4 xv = *(const f32x4*)(x + ro + nt * 16); *(f32x4*)(out + ro + nt * 16) = xv * ALPHA + acc[mt][nt]; }
        }
    }
};
__device__ __forceinline__ void phase_wout(const Params& p, char* lds, int vb, int G) {
    for (int u = vb; u < (S / 256) * 4; u += G) {
        const int tm = u >> 2, tn = u & 3;
        G2Args g; g.A = (const char*)(p.ws + WS_ATT); g.B = (const char*)(p.ws + WS_WOUT); g.nk = D / 64; g.akstep = 128;
        g2_rows_A<8>(g, (size_t)tm * 256, D * 2); g2_rows_B(g, (size_t)tn * 256, D * 2);
        EpiPreLn e{p.x, (float*)(p.ws + WS_PRELN), tm * 256, tn * 256};
        gemm2<8>(lds, g, e);
    }
}

struct EpiLogits {
    float* L;
    __device__ __forceinline__ void operator()(f32x4 (&acc)[4][4], int wr, int wc, int fr, int fq) const {
#pragma unroll
        for (int mt = 0; mt < 4; ++mt)
#pragma unroll
            for (int nt = 0; nt < 4; ++nt) *(f32x4*)(L + (wr * 64 + mt * 16 + fr) * 256 + wc * 64 + nt * 16 + 4 * fq) = acc[mt][nt];
    }
};
__device__ __forceinline__ void phase_router(const Params& p, char* lds, int vb, int G) {
    const int tid = threadIdx.x, lane = tid & 63, w = tid >> 6;
    const float* preln = (const float*)(p.ws + WS_PRELN);
    float* x1f = (float*)(p.ws + WS_X1F); bf16_t* x1b = (bf16_t*)(p.ws + WS_X1B);
    unsigned* cnt = (unsigned*)(p.ws + WS_CTL + 65536); int* list = (int*)(p.ws + WS_LIST); float* gates = (float*)(p.ws + WS_GATE);
    for (int u = vb; u < S / 64; u += G) {
        {
            f32x4 v[8][4]; float sm[8], sq[8];
#pragma unroll
            for (int i = 0; i < 8; ++i) { const f32x4* xr = (const f32x4*)(preln + (size_t)(u * 64 + w * 8 + i) * D) + lane;
#pragma unroll
                for (int j = 0; j < 4; ++j) v[i][j] = xr[64 * j]; }
#pragma unroll
            for (int i = 0; i < 8; ++i) { float s = 0.f;
#pragma unroll
                for (int j = 0; j < 4; ++j) s += (v[i][j][0] + v[i][j][1]) + (v[i][j][2] + v[i][j][3]);
                sm[i] = s; }
#pragma unroll
            for (int o = 1; o < 64; o <<= 1) {
#pragma unroll
                for (int i = 0; i < 8; ++i) sm[i] += __shfl_xor(sm[i], o); }
#pragma unroll
            for (int i = 0; i < 8; ++i) { const float mean = sm[i] * (1.0f / D); float s2 = 0.f;
#pragma unroll
                for (int j = 0; j < 4; ++j) { v[i][j] = v[i][j] - mean; s2 += (v[i][j][0] * v[i][j][0] + v[i][j][1] * v[i][j][1]) + (v[i][j][2] * v[i][j][2] + v[i][j][3] * v[i][j][3]); }
                sq[i] = s2; }
#pragma unroll
            for (int o = 1; o < 64; o <<= 1) {
#pragma unroll
                for (int i = 0; i < 8; ++i) sq[i] += __shfl_xor(sq[i], o); }
#pragma unroll
            for (int j = 0; j < 4; ++j) {
                const f32x4 gg = *((const f32x4*)p.ln1g + lane + 64 * j), bb = *((const f32x4*)p.ln1b + lane + 64 * j);
#pragma unroll
                for (int i = 0; i < 8; ++i) {
                    const int row = u * 64 + w * 8 + i;
                    const float rstd = rsqrtf(sq[i] * (1.0f / D) + LN_EPS);
                    const f32x4 y = v[i][j] * rstd * gg + bb;
                    *((f32x4*)(x1f + (size_t)row * D) + lane + 64 * j) = y;
                    u32x2 pk = {cvt_pk(y[0], y[1]), cvt_pk(y[2], y[3])};
                    *(u32x2*)(x1b + ((size_t)((lane >> 4) + 4 * j) * S + row) * 64 + ((4 * lane) & 63)) = pk;
                }
            }
        }
        asm volatile("s_waitcnt vmcnt(0)" ::: "memory");
        __syncthreads();
        { G2Args g; g.A = (const char*)x1b; g.B = (const char*)(p.ws + WS_WR); g.nk = D / 64; g.akstep = S * 128;
          g2_rows_A<4>(g, (size_t)u * 64, 128); g.offA[1] = g.offA[0]; g2_rows_B(g, 0, D * 2);
          EpiLogits e{(float*)lds};
          gemm2<4>(lds, g, e); }
        __syncthreads();
        const f32x4 rb = *((const f32x4*)p.r_bias + lane);
        const float NEG = -__builtin_inff();
        for (int i0 = 0; i0 < 8; i0 += 4) {
            float sc[4][4], cand[4][4]; int my_e[4]; float my_s[4], gsum[4];
#pragma unroll
            for (int q = 0; q < 4; ++q) {
                const int tl = w * 8 + i0 + q;
                const f32x4 lg = *((const f32x4*)((const float*)lds + tl * 256) + lane);
#pragma unroll
                for (int j = 0; j < 4; ++j) { sc[q][j] = 1.0f / (1.0f + __expf(-lg[j])); cand[q][j] = sc[q][j] + rb[j]; }
                my_e[q] = 0; my_s[q] = 0.f; gsum[q] = 0.f;
            }
            float a1[4], a2[4];
#pragma unroll
            for (int q = 0; q < 4; ++q) { const float m01 = fmaxf(cand[q][0], cand[q][1]), n01 = fminf(cand[q][0], cand[q][1]), m23 = fmaxf(cand[q][2], cand[q][3]), n23 = fminf(cand[q][2], cand[q][3]);
              a1[q] = fmaxf(m01, m23); a2[q] = fmaxf(fminf(m01, m23), fmaxf(n01, n23)); }
#pragma unroll
            for (int off = 1; off < 8; off <<= 1) {
#pragma unroll
                for (int q = 0; q < 4; ++q) { const float b1 = __shfl_xor(a1[q], off), b2 = __shfl_xor(a2[q], off); const float n1 = fmaxf(a1[q], b1), n2 = fmaxf(fminf(a1[q], b1), fmaxf(a2[q], b2)); a1[q] = n1; a2[q] = n2; }
            }
            const int mygrp = lane >> 3;
#pragma unroll
            for (int q = 0; q < 4; ++q) {
                const float gs = a1[q] + a2[q]; int rank = 0;
#pragma unroll
                for (int g2 = 0; g2 < 8; ++g2) { const float v = __shfl(gs, g2 * 8); rank += (v > gs || (v == gs && g2 < mygrp)) ? 1 : 0; }
                if (rank >= 4) {
#pragma unroll
                    for (int j = 0; j < 4; ++j) cand[q][j] = NEG;
                }
            }
#pragma unroll
            for (int k = 0; k < 8; ++k) {
                float bv[4]; int idx[4];
#pragma unroll
                for (int q = 0; q < 4; ++q) { bv[q] = cand[q][0]; int bi = 0;
#pragma unroll
                    for (int j = 1; j < 4; ++j) if (cand[q][j] > bv[q]) { bv[q] = cand[q][j]; bi = j; }
                    idx[q] = 4 * lane + bi; }
#pragma unroll
                for (int off = 32; off >= 1; off >>= 1) {
#pragma unroll
                    for (int q = 0; q < 4; ++q) { const float ov = __shfl_xor(bv[q], off); const int oi = __shfl_xor(idx[q], off); if (ov > bv[q] || (ov == bv[q] && oi < idx[q])) { bv[q] = ov; idx[q] = oi; } }
                }
#pragma unroll
                for (int q = 0; q < 4; ++q) {
                    const int owner = idx[q] >> 2, sub = idx[q] & 3;
                    float scv = sc[q][0];
#pragma unroll
                    for (int j = 1; j < 4; ++j) scv = (sub == j) ? sc[q][j] : scv;
                    if (lane == owner) {
#pragma unroll
                        for (int j = 0; j < 4; ++j) if (sub == j) cand[q][j] = NEG;
                    }
                    const float gsc = __shfl(scv, owner);
                    if (lane == k) { my_e[q] = idx[q]; my_s[q] = gsc; }
                    gsum[q] += gsc;
                }
            }
            if (lane < 8) {
#pragma unroll
                for (int q = 0; q < 4; ++q) {
                    const int t = u * 64 + w * 8 + i0 + q;
                    const float gate = my_s[q] / gsum[q] * 2.5f;
                    const unsigned pos = atomicAdd(cnt + my_e[q] * CNT_STRIDE, 1u);
                    list[(size_t)my_e[q] * CAP + pos] = t * 8 + lane;
                    gates[t * 8 + lane] = gate;
                }
            }
        }
        __syncthreads();
    }
}

#ifndef MOE_MT
#define MOE_MT 8
#endif
constexpr int MOE_BM = 32 * MOE_MT;
struct EpiAct {
    bf16_t* act; const int* slots;
    __device__ __forceinline__ void operator()(f32x4 (&acc)[MOE_MT][4], int pass, int wr, int wc, int fr, int fq) const {
        const int ncol0 = pass * 128;
#pragma unroll
        for (int mt = 0; mt < MOE_MT; ++mt) {
            const int ar = slots[wr * 16 * MOE_MT + mt * 16 + fr];
            if (ar >= 0) {
                float a[8];
#pragma unroll
                for (int nt = 0; nt < 2; ++nt)
#pragma unroll
                    for (int j = 0; j < 4; ++j) { const float gq = acc[mt][nt][j] * W8_INV; a[nt * 4 + j] = gq / (1.0f + __expf(-gq)) * (acc[mt][nt + 2][j] * W8_INV); }
                u32x4 pk = {cvt_pk(a[0], a[1]), cvt_pk(a[2], a[3]), cvt_pk(a[4], a[5]), cvt_pk(a[6], a[7])};
                *(u32x4*)(act + (size_t)ar * FF + ncol0 + wc * 32 + 8 * fq) = pk;
            }
        }
    }
};
struct EpiY {
    bf16_t* y; const int* yrows; const float* gl;
    __device__ __forceinline__ void operator()(f32x4 (&acc)[MOE_MT][4], int pass, int wr, int wc, int fr, int fq) const {
        const int col0 = pass * 256;
#pragma unroll
        for (int mt = 0; mt < MOE_MT; ++mt) {
            const int r = wr * 16 * MOE_MT + mt * 16 + fr, yr = yrows[r];
            if (yr >= 0) {
                const float gt = gl[r] * W8_INV;
#pragma unroll
                for (int a = 0; a < 2; ++a) {
                    const f32x4 v0 = acc[mt][2 * a] * gt, v1 = acc[mt][2 * a + 1] * gt;
                    u32x4 pk = {cvt_pk(v0[0], v0[1]), cvt_pk(v0[2], v0[3]), cvt_pk(v1[0], v1[1]), cvt_pk(v1[2], v1[3])};
                    *(u32x4*)(y + (size_t)yr * D + col0 + wc * 64 + a * 32 + 8 * fq) = pk;
                }
            }
        }
    }
};
__device__ __forceinline__ void phase_experts(const Params& p, char* lds, int vb, int G) {
    const int tid0 = threadIdx.x, w = __builtin_amdgcn_readfirstlane(tid0 >> 6);
    const unsigned* cnt = (const unsigned*)(p.ws + WS_CTL + 65536); const int* list = (const int*)(p.ws + WS_LIST); const float* gates = (const float*)(p.ws + WS_GATE);
    bf16_t* act = (bf16_t*)(p.ws + WS_ACT); bf16_t* ybuf = (bf16_t*)(p.ws + WS_Y);
    int* nts = (int*)(lds + LDS_MISC); int* pre = nts + 256;
    int* s_arow = pre + 260; int* s_yrow = s_arow + MOE_BM; int* s_tok = s_yrow + MOE_BM; float* s_gate = (float*)(s_tok + MOE_BM);
    if (tid0 < 256) nts[tid0] = (int)((__hip_atomic_load(cnt + tid0 * CNT_STRIDE, __ATOMIC_RELAXED, __HIP_MEMORY_SCOPE_AGENT) + (MOE_BM - 1)) / MOE_BM);
    __syncthreads();
    if (tid0 < 257) { int s = 0; for (int e = 0; e < tid0; ++e) s += nts[e]; pre[tid0] = s; }
    __syncthreads();
    const int NR = __builtin_amdgcn_readfirstlane(pre[256]), NU = NR + S / MOE_BM;
    for (int u = vb; u < NU; u += G) {
        __syncthreads();
        int tid = threadIdx.x; asm volatile("" : "+v"(tid));
        const int lane = tid & 63; const unsigned co = g2_chunk_off(lane, w);
        const float *bg, *bu, *bd;
        if (u < NR) {
            int lo = 0, hi = 255;
            while (lo < hi) { const int mid = (lo + hi + 1) >> 1; if (pre[mid] <= u) lo = mid; else hi = mid - 1; }
            const int e = lo, tile = u - pre[e], n = (int)__hip_atomic_load(cnt + e * CNT_STRIDE, __ATOMIC_RELAXED, __HIP_MEMORY_SCOPE_AGENT);
            if (tid < MOE_BM) {
                const int idx = tile * MOE_BM + tid;
                if (idx < n) { const int slot = list[(size_t)e * CAP + idx]; s_arow[tid] = slot; s_yrow[tid] = slot + (slot >> 3); s_tok[tid] = slot >> 3; s_gate[tid] = gates[slot]; }
                else { s_arow[tid] = -1; s_yrow[tid] = -1; s_tok[tid] = 0; s_gate[tid] = 0.f; }
            }
            bg = p.w_g + (size_t)e * D * FF; bu = p.w_u + (size_t)e * D * FF; bd = p.w_d + (size_t)e * FF * D;
        } else {
            const int tile = u - NR;
            if (tid < MOE_BM) { const int tk = tile * MOE_BM + tid; s_arow[tid] = S * 8 + tk; s_yrow[tid] = tk * 9 + 8; s_tok[tid] = tk; s_gate[tid] = 1.0f; }
            bg = p.ws_g; bu = p.ws_u; bd = p.ws_d;
        }
        __syncthreads();
        { G3fArgs g; g.A = (const char*)(p.ws + WS_X1B); g.nk = D / 64; g.akstep = S * 128;
#pragma unroll
          for (int i = 0; i < MOE_MT / 2; ++i) g.offA[i] = (unsigned)s_tok[i * 64 + w * 8 + (lane >> 3)] * 128u + co;
          { const int bwc = lane >> 4, nt = (lane >> 2) & 3, bfq = lane & 3;
            g.b = ((nt < 2) ? bg : bu) + bwc * 32 + 8 * bfq + 4 * (nt & 1) + (size_t)(w * 8) * FF; }
          EpiAct e{act, s_arow};
          gemm3f<MOE_MT, FF>(lds, g, 2, 128, e); }
        asm volatile("s_waitcnt vmcnt(0)" ::: "memory");
        __syncthreads();
        { G3fArgs g; g.A = (const char*)act; g.nk = FF / 64; g.akstep = 128;
#pragma unroll
          for (int i = 0; i < MOE_MT / 2; ++i) { const int ar = s_arow[i * 64 + w * 8 + (lane >> 3)]; g.offA[i] = (unsigned)(ar < 0 ? 0 : ar) * (unsigned)(FF * 2) + co; }
          g.b = bd + (size_t)(w * 8) * D + (lane >> 4) * 64 + (((lane >> 2) & 3) >> 1) * 32 + 8 * (lane & 3) + 4 * ((lane >> 2) & 1);
          EpiY e{ybuf, s_yrow, s_gate};
          gemm3f<MOE_MT, D>(lds, g, 4, 256, e); }
    }
}

__device__ __forceinline__ void phase_final(const Params& p, int vb, int G) {
    const int lane = threadIdx.x & 63, w = threadIdx.x >> 6;
    const float* x1f = (const float*)(p.ws + WS_X1F); const bf16_t* ybuf = (const bf16_t*)(p.ws + WS_Y);
    for (int row = vb * 8 + w; row < S; row += G * 8) {
        f32x4 v[4]; float s = 0.f;
#pragma unroll
        for (int j = 0; j < 4; ++j) v[j] = *((const f32x4*)(x1f + (size_t)row * D) + lane + 64 * j) * ALPHA;
#pragma unroll
        for (int k = 0; k < 9; ++k) {
            const u32x2* yr = (const u32x2*)(ybuf + (size_t)(row * 9 + k) * D) + lane;
#pragma unroll
            for (int j = 0; j < 4; ++j) { const u32x2 q = yr[64 * j]; v[j][0] += bf_lo(q[0]); v[j][1] += bf_hi(q[0]); v[j][2] += bf_lo(q[1]); v[j][3] += bf_hi(q[1]); }
        }
#pragma unroll
        for (int j = 0; j < 4; ++j) s += (v[j][0] + v[j][1]) + (v[j][2] + v[j][3]);
        const float mean = wave_sum(s) * (1.0f / D); float s2 = 0.f;
#pragma unroll
        for (int j = 0; j < 4; ++j) { v[j] = v[j] - mean; s2 += (v[j][0] * v[j][0] + v[j][1] * v[j][1]) + (v[j][2] * v[j][2] + v[j][3] * v[j][3]); }
        const float rstd = rsqrtf(wave_sum(s2) * (1.0f / D) + LN_EPS);
#pragma unroll
        for (int j = 0; j < 4; ++j) {
            const f32x4 gg = *((const f32x4*)p.ln2g + lane + 64 * j), bb = *((const f32x4*)p.ln2b + lane + 64 * j);
            *((f32x4*)(p.out + (size_t)row * D) + lane + 64 * j) = v[j] * rstd * gg + bb;
        }
    }
}

__global__ void __launch_bounds__(NTHREADS) mega(Params p) {
    extern __shared__ __attribute__((aligned(16))) char lds[];
    const int G = gridDim.x, bx = blockIdx.x;
    const int vb = (G % 8 == 0) ? (bx % 8) * (G / 8) + bx / 8 : bx;
    if (threadIdx.x < 4) ((volatile LAS unsigned*)((LAS char*)lds + LDS_BARST))[threadIdx.x] = 0u;
    __syncthreads();
    XcdBarrier bar; bar.bar = (unsigned*)(p.ws + WS_CTL) + CW_BAR; bar.x = 0; bar.st = nullptr;
    if (p.ph_hi - p.ph_lo > 1) bar = xcd_barrier_post((unsigned*)(p.ws + WS_CTL) + CW_BAR, (volatile LAS unsigned*)((LAS char*)lds + LDS_BARST));
#define SEAM(k) do { if (p.ph_lo <= (k) && (k) + 1 < p.ph_hi) { xcd_barrier(bar); } } while (0)
#define IN(k) (p.ph_lo <= (k) && (k) < p.ph_hi)
#define RUN(k, call) do { if (IN(k)) { call; if (MK_REPEAT == (k)) { __syncthreads(); call; } } } while (0)
    RUN(0, phase_prep(p, vb, G)); SEAM(0);
    RUN(1, phase_proj(p, lds, vb, G)); SEAM(1);
    RUN(2, phase_attn(p, lds, vb, G)); SEAM(2);
    RUN(3, phase_wout(p, lds, vb, G)); SEAM(3);
    if (IN(4)) { phase_router(p, lds, vb, G); } SEAM(4);
    RUN(5, phase_experts(p, lds, vb, G)); SEAM(5);
    RUN(6, phase_final(p, vb, G));
#undef SEAM
#undef IN
#undef RUN
}

extern "C" void kernel_launch(void* const* d_in, const int* in_sizes, int n_in, void* d_out, int out_size, void* d_ws, size_t ws_size, hipStream_t stream) {
    static int grid = 0;
    if (grid == 0) {
        if (n_in != 22 || in_sizes[0] != S * D || out_size != S * D || ws_size < WS_END) {
            fprintf(stderr, "kernel_launch: unexpected shapes: n_in %d in0 %d out %d ws %zu (need %zu)\n", n_in, n_in > 0 ? in_sizes[0] : -1, out_size, ws_size, (size_t)WS_END); grid = -1; return; }
        int dev = 0, cus = 0, per_cu = 0;
        (void)hipGetDevice(&dev); (void)hipDeviceGetAttribute(&cus, hipDeviceAttributeMultiprocessorCount, dev);
        if (hipFuncSetAttribute((const void*)mega, hipFuncAttributeMaxDynamicSharedMemorySize, LDS_BYTES) != hipSuccess) { fprintf(stderr, "kernel_launch: hipFuncSetAttribute failed\n"); grid = -1; return; }
        (void)hipOccupancyMaxActiveBlocksPerMultiprocessor(&per_cu, (const void*)mega, NTHREADS, LDS_BYTES);
        if (per_cu < 1) { fprintf(stderr, "kernel_launch: occupancy query says %d blocks per CU\n", per_cu); per_cu = 1; }
        grid = cus * 1;
        (void)hipGetLastError();
    }
    if (grid < 0) return;
    (void)hipMemsetAsync((char*)d_ws + WS_CTL, 0, CTL_BYTES, stream);
    Params p{};
    const float** f = (const float**)&p;
    for (int i = 0; i < 22; ++i) f[i] = (const float*)d_in[i];
    p.out = (float*)d_out; p.ws = (unsigned char*)d_ws;
#if MK_ONE_LAUNCH
    p.ph_lo = 0; p.ph_hi = 7;
    void* args[] = {&p};
    hipError_t e = hipLaunchCooperativeKernel((const void*)mega, dim3(grid), dim3(NTHREADS), args, LDS_BYTES, stream);
    if (e != hipSuccess) fprintf(stderr, "kernel_launch: cooperative launch failed: %s (grid %d)\n", hipGetErrorString(e), grid);
#else
    for (int ph = 0; ph < 7; ++ph) {
        p.ph_lo = ph; p.ph_hi = ph + 1;
        hipLaunchKernelGGL(mega, dim3(grid), dim3(NTHREADS), LDS_BYTES, stream, p);
    }
#endif
}
```

```cpp
#include <hip/hip_runtime.h>
#include <hip/hip_cooperative_groups.h>
#include <cstdio>
#include <cstdint>
namespace cg = cooperative_groups;

#ifndef MK_REPEAT
#define MK_REPEAT -1
#endif
#ifndef MK_ONE_LAUNCH
#define MK_ONE_LAUNCH 1
#endif

constexpr int S = 16384, D = 1024, INW = 2304, NE = 256, FF = 256;
constexpr int NTHREADS = 512;
constexpr int CAP = 16384;
constexpr float ALPHA = 1.189207115002721f;
constexpr float LN_EPS = 1e-5f;
constexpr float QSCALE = 0.125f * 1.4426950408889634f;
constexpr float LOG2E = 1.4426950408889634f;
constexpr int C_AQ = 0, C_AK = 512, C_AV = 640, C_BQ = 768, C_BK = 1280, C_BV = 1792;

constexpr size_t MiB = 1ull << 20;
constexpr size_t WS_CTL = 0;
constexpr size_t CTL_BYTES = 128 * 1024;
constexpr int CNT_STRIDE = 64;
constexpr size_t WS_ROPE = 1 * MiB;
constexpr size_t WS_WIN = 8 * MiB;
constexpr size_t WS_WOUT = 13 * MiB;
constexpr size_t WS_WR = 15 * MiB;
constexpr size_t WS_WSGU = 16 * MiB;
constexpr size_t WS_WSD = 17 * MiB;
constexpr size_t WS_EGU = 20 * MiB;
constexpr size_t WS_ED = 276 * MiB;
constexpr size_t WS_X1F = 404 * MiB;
constexpr size_t WS_X1B = 468 * MiB;
constexpr size_t WS_LIST = 500 * MiB;
constexpr size_t WS_GATE = 516 * MiB;
constexpr size_t WS_ACT = 518 * MiB;
constexpr size_t WS_Y = 590 * MiB;
constexpr size_t WS_XB = 590 * MiB;
constexpr size_t WS_PROJ = 622 * MiB;
constexpr size_t WS_ATT = 694 * MiB;
constexpr size_t WS_PRELN = 726 * MiB;
constexpr size_t WS_END = 878 * MiB;

constexpr int LDS_BYTES = 147456;
constexpr int LDS_MISC = 131072;

typedef unsigned short bf16_t;
typedef short bf16x8 __attribute__((ext_vector_type(8)));
typedef short s16x4 __attribute__((ext_vector_type(4)));
typedef float f32x4 __attribute__((ext_vector_type(4)));
typedef float f32x16 __attribute__((ext_vector_type(16)));
typedef unsigned u32x4 __attribute__((ext_vector_type(4)));
typedef unsigned u32x2 __attribute__((ext_vector_type(2)));
typedef float f32x2 __attribute__((ext_vector_type(2)));


#define LAS __attribute__((address_space(3)))
#define XB_TMO      128
#define XB_XCNT(j)  (256  + 64 * (j))
#define XB_XSUB(j)  (1280 + 64 * (j))
#define XB_XGEN(j)  (2304 + 64 * (j))
#define XB_TOP      3328
#define XB_TOPGEN   3392
#define XCD_BAR_WORDS 3456
#define XB_SPIN_CAP (1u << 18)
__device__ __forceinline__ unsigned xb_ld(unsigned* p)              { return __hip_atomic_load(p, __ATOMIC_RELAXED, __HIP_MEMORY_SCOPE_AGENT); }
__device__ __forceinline__ unsigned xb_add(unsigned* p, unsigned v) { return __hip_atomic_fetch_add(p, v, __ATOMIC_RELAXED, __HIP_MEMORY_SCOPE_AGENT); }
__device__ __forceinline__ unsigned xb_xcc_id() { return (unsigned)__builtin_amdgcn_s_getreg((3 << 11) | 20) & 0xFu; }
#define XB_SPIN(cond, bar) do { unsigned _sp = 0; while (cond) { __builtin_amdgcn_s_sleep(1); \
    if ((++_sp & 255u) == 0u) { if (xb_ld(&(bar)[XB_TMO])) break; if (_sp > XB_SPIN_CAP) { atomicAdd(&(bar)[XB_TMO], 1u); break; } } } } while (0)
struct XcdBarrier { unsigned* bar; unsigned x; volatile LAS unsigned* st; };
__device__ __forceinline__ XcdBarrier xcd_barrier_post(unsigned* bar, volatile LAS unsigned* st) {
    XcdBarrier b; b.bar = bar; b.x = xb_xcc_id(); b.st = st;
    if (threadIdx.x == 0) (void)xb_add(&bar[XB_XCNT(b.x)], 1u);
    return b;
}
__device__ __forceinline__ void xcd_barrier_complete(unsigned* bar, unsigned x, unsigned& nloc, unsigned& nx) {
    const unsigned G = gridDim.x * gridDim.y * gridDim.z;
    unsigned sum, cnt, mine, sp = 0u;
    for (;;) {
        sum = 0u; cnt = 0u; mine = 0u;
#pragma unroll
        for (unsigned j = 0; j < 16; ++j) { const unsigned c = xb_ld(&bar[XB_XCNT(j)]); sum += c; cnt += (c > 0u) ? 1u : 0u; mine = (j == x) ? c : mine; }
        if (sum == G) break;
        __builtin_amdgcn_s_sleep(1);
        if ((++sp & 255u) == 0u) { if (xb_ld(&bar[XB_TMO])) break; if (sp > XB_SPIN_CAP) { atomicAdd(&bar[XB_TMO], 1u); break; } }
    }
    nloc = mine > 0u ? mine : 1u; nx = cnt > 0u ? cnt : 1u;
}
__device__ __forceinline__ void xcd_barrier(const XcdBarrier& b) {
    asm volatile("s_waitcnt vmcnt(0)" ::: "memory");
    __syncthreads();
    if (threadIdx.x == 0) {
        unsigned* bar = b.bar;
        __builtin_amdgcn_s_waitcnt(0);
        unsigned nloc = b.st[0], nx = b.st[1];
        if (nloc == 0u) { xcd_barrier_complete(bar, b.x, nloc, nx); b.st[0] = nloc; b.st[1] = nx; }
        const unsigned old = xb_add(&bar[XB_XSUB(b.x)], 1u);
        const unsigned gen = old / nloc;
        if (old + 1u == (gen + 1u) * nloc) {
            __builtin_amdgcn_fence(__ATOMIC_RELEASE, "agent");
            asm volatile("s_waitcnt vmcnt(0)" ::: "memory");
            const unsigned og = xb_add(&bar[XB_TOP], 1u);
            const unsigned tg = og / nx;
            if (og + 1u == (tg + 1u) * nx) xb_add(&bar[XB_TOPGEN], 1u);
            else XB_SPIN(xb_ld(&bar[XB_TOPGEN]) == tg, bar);
            __builtin_amdgcn_fence(__ATOMIC_ACQUIRE, "agent");
            xb_add(&bar[XB_XGEN(b.x)], 1u);
            asm volatile("s_waitcnt vmcnt(0)" ::: "memory");
        } else {
            XB_SPIN(xb_ld(&bar[XB_XGEN(b.x)]) == gen, bar);
            __builtin_amdgcn_fence(__ATOMIC_ACQUIRE, "agent");
            asm volatile("s_waitcnt vmcnt(0)" ::: "memory");
        }
    }
    __syncthreads();
}
constexpr int CW_BAR = 4096;
constexpr int LDS_BARST = LDS_MISC + 8192;

struct Params {
    const float* x; const float* w_in; const float* b_in; const float* sinks;
    const float* lq1; const float* lk1; const float* lq2; const float* lk2; const float* subg;
    const float* w_out; const float* ln1g; const float* ln1b; const float* w_r; const float* r_bias;
    const float* w_g; const float* w_u; const float* w_d; const float* ws_g; const float* ws_u; const float* ws_d;
    const float* ln2g; const float* ln2b;
    float* out; unsigned char* ws;
    int ph_lo, ph_hi;
};

__device__ __forceinline__ unsigned cvt_pk(float lo, float hi) { unsigned r; asm volatile("v_cvt_pk_bf16_f32 %0, %1, %2" : "=v"(r) : "v"(lo), "v"(hi)); return r; }
__device__ __forceinline__ float bf_lo(unsigned u) { return __uint_as_float(u << 16); }
__device__ __forceinline__ float bf_hi(unsigned u) { return __uint_as_float(u & 0xffff0000u); }
__device__ __forceinline__ float wave_sum(float v) {
#pragma unroll
    for (int o = 1; o < 64; o <<= 1) v += __shfl_xor(v, o);
    return v;
}
__device__ __forceinline__ float half_max(float v) { auto rr = __builtin_amdgcn_permlane32_swap(__float_as_uint(v), __float_as_uint(v), false, false); return fmaxf(__uint_as_float(rr[0]), __uint_as_float(rr[1])); }
__device__ __forceinline__ float half_sum(float v) { auto rr = __builtin_amdgcn_permlane32_swap(__float_as_uint(v), __float_as_uint(v), false, false); return __uint_as_float(rr[0]) + __uint_as_float(rr[1]); }

__device__ __forceinline__ int swz(int r, int c) { const int f = (r & 7) ^ (((r >> 3) & 1) << 1) ^ ((r >> 4) & 1); return r * 128 + ((c ^ f) << 4); }

struct G2Args {
    const char* A; const char* B;
    unsigned offA[4], offB[4];
    int nk;
    unsigned akstep;
};
__device__ __forceinline__ unsigned g2_chunk_off(int lane, int w) { const int f = (lane >> 3) ^ ((w & 1) << 1) ^ ((w >> 1) & 1); return (unsigned)(((lane & 7) ^ f) << 4); }
template <int MT, class Epi>
__device__ __forceinline__ void gemm2(char* lds_, const G2Args& g, const Epi& epi) {
    constexpr int A_BYTES = 32 * MT * 128, B_BYTES = 256 * 128, STAGE = A_BYTES + B_BYTES, AR = MT / 2;
    LAS char* lds = (LAS char*)lds_;
    const int tid = threadIdx.x, lane = tid & 63, w = __builtin_amdgcn_readfirstlane(tid >> 6), wr = w >> 2, wc = w & 3, fr = lane & 15, fq = lane >> 4;
    f32x4 acc[MT][4];
#pragma unroll
    for (int i = 0; i < MT; ++i)
#pragma unroll
        for (int j = 0; j < 4; ++j) acc[i][j] = (f32x4){0.f, 0.f, 0.f, 0.f};
    const int ldsw = w * 1024;
#define G2_STAGE(kt, s) do { \
        _Pragma("unroll") for (int i = 0; i < AR; ++i) __builtin_amdgcn_global_load_lds((const unsigned*)(g.A + g.offA[i] + (size_t)(kt) * g.akstep), (LAS unsigned*)(lds + (s) * STAGE + i * 8192 + ldsw), 16, 0, 0); \
        _Pragma("unroll") for (int i = 0; i < 4; ++i) __builtin_amdgcn_global_load_lds((const unsigned*)(g.B + g.offB[i] + (size_t)(kt) * 128), (LAS unsigned*)(lds + (s) * STAGE + A_BYTES + i * 8192 + ldsw), 16, 0, 0); } while (0)
    G2_STAGE(0, 0);
    __syncthreads();
    for (int kt = 0; kt < g.nk; ++kt) {
        const int s = kt & 1;
        if (kt + 1 < g.nk) { if (s) G2_STAGE(kt + 1, 0); else G2_STAGE(kt + 1, 1); }
        const char* la = lds_ + s * STAGE; const char* lb = la + A_BYTES;
        {
            constexpr int NG = 2 * (MT / 4);
            bf16x8 bfr[4], af[2][4];
#pragma unroll
            for (int nt = 0; nt < 4; ++nt) bfr[nt] = *(const bf16x8*)(lb + swz(wc * 64 + nt * 16 + fr, fq));
#pragma unroll
            for (int m = 0; m < 4; ++m) af[0][m] = *(const bf16x8*)(la + swz(wr * 16 * MT + m * 16 + fr, fq));
#pragma unroll
            for (int gi = 0; gi < NG; ++gi) {
                const int ks = gi / (MT / 4), h = gi % (MT / 4);
                if (gi > 0 && h == 0) {
#pragma unroll
                    for (int nt = 0; nt < 4; ++nt) bfr[nt] = *(const bf16x8*)(lb + swz(wc * 64 + nt * 16 + fr, ks * 4 + fq));
                }
                if (gi + 1 < NG) {
                    const int ks2 = (gi + 1) / (MT / 4), h2 = (gi + 1) % (MT / 4);
#pragma unroll
                    for (int m = 0; m < 4; ++m) af[(gi + 1) & 1][m] = *(const bf16x8*)(la + swz(wr * 16 * MT + (h2 * 4 + m) * 16 + fr, ks2 * 4 + fq));
                }
                __builtin_amdgcn_sched_barrier(0);
#pragma unroll
                for (int m = 0; m < 4; ++m)
#pragma unroll
                    for (int nt = 0; nt < 4; ++nt) acc[h * 4 + m][nt] = __builtin_amdgcn_mfma_f32_16x16x32_bf16(bfr[nt], af[gi & 1][m], acc[h * 4 + m][nt], 0, 0, 0);
                __builtin_amdgcn_sched_barrier(0);
            }
        }
        __syncthreads();
    }
#undef G2_STAGE
    epi(acc, wr, wc, fr, fq);
}
template <int MT>
__device__ __forceinline__ void g2_rows_A(G2Args& g, size_t row0, unsigned ld_bytes) {
    const int lane = threadIdx.x & 63, w = __builtin_amdgcn_readfirstlane(threadIdx.x >> 6); const unsigned co = g2_chunk_off(lane, w);
#pragma unroll
    for (int i = 0; i < MT / 2; ++i) g.offA[i] = (unsigned)((row0 + i * 64 + w * 8 + (lane >> 3)) * ld_bytes) + co;
}
__device__ __forceinline__ void g2_rows_B(G2Args& g, size_t row0, unsigned ld_bytes) {
    const int lane = threadIdx.x & 63, w = __builtin_amdgcn_readfirstlane(threadIdx.x >> 6); const unsigned co = g2_chunk_off(lane, w);
#pragma unroll
    for (int i = 0; i < 4; ++i) g.offB[i] = (unsigned)((row0 + i * 64 + w * 8 + (lane >> 3)) * ld_bytes) + co;
}


struct G3fArgs { const char* A; unsigned offA[4]; const float* b; int nk; unsigned akstep; };
template <int MT, int LDB, class Epi>
__device__ __forceinline__ void gemm3f(char* lds_, const G3fArgs& g, int npass, int bpstep, const Epi& epi) {
    constexpr int A_BYTES = 32 * MT * 128, B_BYTES = 256 * 128, STAGE = A_BYTES + B_BYTES, AR = MT / 2;
    LAS char* lds = (LAS char*)lds_;
    const int tid = threadIdx.x, lane = tid & 63, w = __builtin_amdgcn_readfirstlane(tid >> 6), wr = w >> 2, wc = w & 3, fr = lane & 15, fq = lane >> 4;
    f32x4 acc[MT][4];
#pragma unroll
    for (int i = 0; i < MT; ++i)
#pragma unroll
        for (int j = 0; j < 4; ++j) acc[i][j] = (f32x4){0.f, 0.f, 0.f, 0.f};
    const int ldsw = w * 1024;
    int bw[4];
#pragma unroll
    for (int j = 0; j < 4; ++j) bw[j] = swz(4 * lane + j, w);
    f32x4 br[8];
    const int nk = g.nk, nsteps = nk * npass;
#define G3_STAGE_A(kt, s) do { \
        _Pragma("unroll") for (int i = 0; i < AR; ++i) __builtin_amdgcn_global_load_lds((const unsigned*)(g.A + g.offA[i] + (size_t)(kt) * g.akstep), (LAS unsigned*)(lds + (s) * STAGE + i * 8192 + ldsw), 16, 0, 0); } while (0)
#define G3_LOAD_B(ps, kt) do { const float* pb_ = g.b + (size_t)(ps) * bpstep + (size_t)(kt) * 64 * LDB; _Pragma("unroll") for (int i = 0; i < 8; ++i) br[i] = *(const f32x4*)(pb_ + i * LDB); } while (0)
#define G3_WRITE_B(s) do { _Pragma("unroll") for (int j = 0; j < 4; ++j) { \
            u32x4 v = {cvt_pk(br[0][j], br[1][j]), cvt_pk(br[2][j], br[3][j]), cvt_pk(br[4][j], br[5][j]), cvt_pk(br[6][j], br[7][j])}; \
            *(u32x4*)(lds_ + (s) * STAGE + A_BYTES + bw[j]) = v; } } while (0)
    G3_STAGE_A(0, 0); G3_LOAD_B(0, 0); G3_WRITE_B(0);
    __syncthreads();
    int ps = 0, kt = 0;
    for (int st = 0; st < nsteps; ++st) {
        const int s = st & 1; const bool more = st + 1 < nsteps;
        int ps2 = ps, kt2 = kt + 1; if (kt2 == nk) { kt2 = 0; ++ps2; }
        if (more) { if (s) G3_STAGE_A(kt2, 0); else G3_STAGE_A(kt2, 1); G3_LOAD_B(ps2, kt2); }
        __builtin_amdgcn_sched_barrier(0);
        const char* la = lds_ + s * STAGE; const char* lb = la + A_BYTES;
#pragma unroll
        for (int ks = 0; ks < 2; ++ks) {
            bf16x8 bfr[4];
#pragma unroll
            for (int nt = 0; nt < 4; ++nt) bfr[nt] = *(const bf16x8*)(lb + swz(wc * 64 + nt * 16 + fr, ks * 4 + fq));
#pragma unroll
            for (int h = 0; h < MT / 2; ++h) {
                bf16x8 af[2];
#pragma unroll
                for (int m = 0; m < 2; ++m) af[m] = *(const bf16x8*)(la + swz(wr * 16 * MT + (h * 2 + m) * 16 + fr, ks * 4 + fq));
                __builtin_amdgcn_sched_barrier(0);
#pragma unroll
                for (int m = 0; m < 2; ++m)
#pragma unroll
                    for (int nt = 0; nt < 4; ++nt) acc[h * 2 + m][nt] = __builtin_amdgcn_mfma_f32_16x16x32_bf16(bfr[nt], af[m], acc[h * 2 + m][nt], 0, 0, 0);
                __builtin_amdgcn_sched_barrier(0);
            }
        }
        if (kt == nk - 1) {
            epi(acc, ps, wr, wc, fr, fq);
#pragma unroll
            for (int i = 0; i < MT; ++i)
#pragma unroll
                for (int j = 0; j < 4; ++j) acc[i][j] = (f32x4){0.f, 0.f, 0.f, 0.f};
        }
        if (more) { if (s) G3_WRITE_B(0); else G3_WRITE_B(1); }
        __syncthreads();
        ps = ps2; kt = kt2;
    }
#undef G3_STAGE_A
#undef G3_LOAD_B
#undef G3_WRITE_B
}

__device__ __forceinline__ void cvt_item(const float* W, int K, int N, bf16_t* WT, int ldt, int kb, int nb, int lane) {
    const float* src = W + (size_t)(kb * 64) * N + nb * 256 + 4 * lane;
    bf16_t* dst = WT + (size_t)(nb * 256 + 4 * lane) * ldt + kb * 64;
#pragma unroll 2
    for (int kc = 0; kc < 8; ++kc) {
        f32x4 r[8];
#pragma unroll
        for (int i = 0; i < 8; ++i) r[i] = *(const f32x4*)(src + (size_t)(kc * 8 + i) * N);
#pragma unroll
        for (int j = 0; j < 4; ++j) {
            u32x4 v = {cvt_pk(r[0][j], r[1][j]), cvt_pk(r[2][j], r[3][j]), cvt_pk(r[4][j], r[5][j]), cvt_pk(r[6][j], r[7][j])};
            *(u32x4*)(dst + (size_t)j * ldt + kc * 8) = v;
        }
    }
}
__device__ __forceinline__ void phase_prep(const Params& p, int vb, int G) {
    const int tid = threadIdx.x, lane = tid & 63, w = tid >> 6;
    float* cs = (float*)(p.ws + WS_ROPE); float* sn = cs + (size_t)S * 32;
    for (int idx = vb * NTHREADS + tid; idx < S * 32; idx += G * NTHREADS) {
        const int pos = idx >> 5, i = idx & 31;
        const float pw = (float)pow(10000.0, (double)i / 32.0);
        const float inv = 1.0f / pw;
        const float angf = __fmul_rn((float)pos, inv);
        const double a = (double)angf;
        const double q = rint(a * 0.63661977236758134308);
        double r = fma(-q, 1.57079632679489655800, a); r = fma(-q, 6.12323399573676603587e-17, r);
        const double r2 = r * r;
        double sp = r * (1.0 + r2 * (-1.0 / 6 + r2 * (1.0 / 120 + r2 * (-1.0 / 5040 + r2 * (1.0 / 362880 + r2 * (-1.0 / 39916800))))));
        double cp = 1.0 + r2 * (-0.5 + r2 * (1.0 / 24 + r2 * (-1.0 / 720 + r2 * (1.0 / 40320 + r2 * (-1.0 / 3628800 + r2 * (1.0 / 479001600))))));
        const int qi = ((int)((long long)q)) & 3;
        double sv, cv;
        if (qi == 0) { sv = sp; cv = cp; } else if (qi == 1) { sv = cp; cv = -sp; } else if (qi == 2) { sv = -sp; cv = -cp; } else { sv = -cp; cv = sp; }
        cs[idx] = (float)cv; sn[idx] = (float)sv;
    }
    { const f32x4* xs = (const f32x4*)p.x; u32x4* xd = (u32x4*)(p.ws + WS_XB);
      for (size_t i = (size_t)vb * NTHREADS + tid; i < (size_t)S * D / 8; i += (size_t)G * NTHREADS) {
          const f32x4 a = xs[2 * i], b = xs[2 * i + 1];
          xd[i] = (u32x4){cvt_pk(a[0], a[1]), cvt_pk(a[2], a[3]), cvt_pk(b[0], b[1]), cvt_pk(b[2], b[3])}; } }
    const int gw = vb * 8 + w, NGW = G * 8;
    constexpr int I_IN = 16 * 9, I_OUT = 16 * 4, I_R = 16, I_SG = 16, I_SU = 16, I_SD = 4 * 4, I_SMALL = I_IN + I_OUT + I_R;
    for (int it = gw; it < I_SMALL; it += NGW) {
        int r = it;
        if (r < I_IN) { cvt_item(p.w_in, D, INW, (bf16_t*)(p.ws + WS_WIN), D, r / 9, r % 9, lane); continue; } r -= I_IN;
        if (r < I_OUT) { cvt_item(p.w_out, D, D, (bf16_t*)(p.ws + WS_WOUT), D, r >> 2, r & 3, lane); continue; } r -= I_OUT;
        cvt_item(p.w_r, D, NE, (bf16_t*)(p.ws + WS_WR), D, r, 0, lane);
    }
}

template <int MT> struct EpiProj {
    const float* bias; const float* cs; const float* sn; bf16_t* out; int row0, col0;
    __device__ __forceinline__ void operator()(f32x4 (&acc)[MT][4], int wr, int wc, int fr, int fq) const {
        const int hb = col0 + wc * 64;
        const bool is_q = (hb < C_AK) || (hb >= C_BQ && hb < C_BK);
        const bool is_rope = is_q || (hb >= C_AK && hb < C_AV) || (hb >= C_BK && hb < C_BV);
        const float sc = is_q ? QSCALE : 1.0f;
#pragma unroll
        for (int mt = 0; mt < MT; ++mt) {
            const int row = row0 + wr * 16 * MT + mt * 16 + fr;
            f32x4 v[4];
#pragma unroll
            for (int nt = 0; nt < 4; ++nt) v[nt] = acc[mt][nt] + *(const f32x4*)(bias + hb + nt * 16 + 4 * fq);
            if (is_rope) {
#pragma unroll
                for (int nt = 0; nt < 2; ++nt) {
                    const f32x4 c = *(const f32x4*)(cs + (size_t)row * 32 + nt * 16 + 4 * fq), s = *(const f32x4*)(sn + (size_t)row * 32 + nt * 16 + 4 * fq);
                    const f32x4 t1 = v[nt], t2 = v[nt + 2];
                    v[nt] = t1 * c - t2 * s; v[nt + 2] = t2 * c + t1 * s;
                }
            }
#pragma unroll
            for (int nt = 0; nt < 4; ++nt) {
                const f32x4 o = v[nt] * sc;
                u32x2 pk = {cvt_pk(o[0], o[1]), cvt_pk(o[2], o[3])};
                *(u32x2*)(out + (size_t)row * INW + hb + nt * 16 + 4 * fq) = pk;
            }
        }
    }
};
__device__ __forceinline__ void phase_proj(const Params& p, char* lds, int vb, int G) {
    const float* cs = (const float*)(p.ws + WS_ROPE); const float* sn = cs + (size_t)S * 32;
    constexpr int NBIG = 512, NUNITS = NBIG + 2 * 64;
    for (int u = vb; u < NUNITS; u += G) {
        G2Args g; g.A = (const char*)(p.ws + WS_XB); g.B = (const char*)(p.ws + WS_WIN); g.nk = D / 64; g.akstep = 128;
        if (u < NBIG) {
            const int tm = u / 9, tn = u % 9;
            g2_rows_A<8>(g, (size_t)tm * 256, D * 2); g2_rows_B(g, (size_t)tn * 256, D * 2);
            EpiProj<8> e{p.b_in, cs, sn, (bf16_t*)(p.ws + WS_PROJ), tm * 256, tn * 256};
            gemm2<8>(lds, g, e);
        } else {
            const int t = NBIG + ((u - NBIG) >> 1), half = (u - NBIG) & 1, tm = t / 9, tn = t % 9;
            g2_rows_A<4>(g, (size_t)tm * 256 + half * 128, D * 2); g2_rows_B(g, (size_t)tn * 256, D * 2);
            EpiProj<4> e{p.b_in, cs, sn, (bf16_t*)(p.ws + WS_PROJ), tm * 256 + half * 128, tn * 256};
            gemm2<4>(lds, g, e);
        }
    }
}

template <int OFF> __device__ __forceinline__ s16x4 tr_read(int vb) { s16x4 r; asm volatile("ds_read_b64_tr_b16 %0, %1 offset:%2" : "=&v"(r) : "v"(vb), "i"(OFF) : "memory"); return r; }
__device__ __forceinline__ int v_off(int k, int c, int ndb) { return ((k >> 3) * ndb + (c >> 5)) * 512 + ((k & 7) * 32 + (c & 31)) * 2; }

constexpr int AT_STAGE = 32768;
template <int NDB, int KB, int T> struct PvPart {
    static __device__ __forceinline__ void run(f32x16& o, int vbase, const bf16x8& pa, const bf16x8& pb) {
        constexpr int o0 = (KB * 4 * NDB + T) * 512, st = NDB * 512;
        const s16x4 l0 = tr_read<o0 + 0 * st>(vbase), h0 = tr_read<o0 + 1 * st>(vbase), l1 = tr_read<o0 + 2 * st>(vbase), h1 = tr_read<o0 + 3 * st>(vbase);
        asm volatile("s_waitcnt lgkmcnt(0)" ::: "memory"); __builtin_amdgcn_sched_barrier(0);
#define PKV(L, H) (bf16x8){L[0], L[1], L[2], L[3], H[0], H[1], H[2], H[3]}
        o = __builtin_amdgcn_mfma_f32_32x32x16_bf16(PKV(l0, h0), pa, o, 0, 0, 0);
        o = __builtin_amdgcn_mfma_f32_32x32x16_bf16(PKV(l1, h1), pb, o, 0, 0, 0);
#undef PKV
    }
};
template <int NDB, int KB>
__device__ __forceinline__ void pv_half(f32x16 (&o)[NDB], f32x16& ol, int vbase, const bf16x8& pa, const bf16x8& pb) {
    const bf16x8 ones = {16256, 16256, 16256, 16256, 16256, 16256, 16256, 16256};
    ol = __builtin_amdgcn_mfma_f32_32x32x16_bf16(ones, pa, ol, 0, 0, 0);
    ol = __builtin_amdgcn_mfma_f32_32x32x16_bf16(ones, pb, ol, 0, 0, 0);
    PvPart<NDB, KB, 0>::run(o[0], vbase, pa, pb); PvPart<NDB, KB, 1>::run(o[1], vbase, pa, pb);
    if constexpr (NDB == 4) { PvPart<NDB, KB, 2>::run(o[2], vbase, pa, pb); PvPart<NDB, KB, 3>::run(o[3], vbase, pa, pb); }
}
constexpr float ATT_THR = 10.0f;
template <int NDB>
__device__ __forceinline__ void attn_scores(char* lds, int kof, const bf16x8 (&qf)[4], f32x16& s0, f32x16& s1, f32x16 (&o)[NDB], f32x16& ol, f32x16& nm, bool first, int r32, int hi) {
    s0 = nm; s1 = nm;
#pragma unroll
    for (int ds = 0; ds < 4; ++ds) {
        const bf16x8 k0 = *(const bf16x8*)(lds + kof + swz(r32, ds * 2 + hi)), k1 = *(const bf16x8*)(lds + kof + swz(32 + r32, ds * 2 + hi));
        s0 = __builtin_amdgcn_mfma_f32_32x32x16_bf16(k0, qf[ds], s0, 0, 0, 0);
        s1 = __builtin_amdgcn_mfma_f32_32x32x16_bf16(k1, qf[ds], s1, 0, 0, 0);
    }
    float mx = fmaxf(s0[0], s1[0]);
#pragma unroll
    for (int r = 1; r < 16; ++r) mx = fmaxf(fmaxf(mx, s0[r]), s1[r]);
    mx = half_max(mx);
    if (first || __any(mx > ATT_THR)) {
        const float delta = first ? mx : fmaxf(mx, 0.f), alpha = first ? 0.f : __builtin_amdgcn_exp2f(-delta);
#pragma unroll
        for (int r = 0; r < 16; ++r) { s0[r] -= delta; s1[r] -= delta; nm[r] -= delta; ol[r] *= alpha; }
#pragma unroll
        for (int t = 0; t < NDB; ++t)
#pragma unroll
            for (int r = 0; r < 16; ++r) o[t][r] *= alpha;
    }
}
__device__ __forceinline__ void exp_pack(const f32x16& s, bf16x8& pa, bf16x8& pb) {
    float e[16];
#pragma unroll
    for (int r = 0; r < 16; ++r) e[r] = __builtin_amdgcn_exp2f(s[r]);
    u32x4 a = {cvt_pk(e[0], e[1]), cvt_pk(e[2], e[3]), cvt_pk(e[4], e[5]), cvt_pk(e[6], e[7])};
    u32x4 b = {cvt_pk(e[8], e[9]), cvt_pk(e[10], e[11]), cvt_pk(e[12], e[13]), cvt_pk(e[14], e[15])};
    pa = *(bf16x8*)&a; pb = *(bf16x8*)&b;
}

__device__ __forceinline__ void attn_diff_unit(const Params& p, char* lds_, int h, int qb, float lam) {
    LAS char* lds = (LAS char*)lds_;
    const int tid = threadIdx.x, lane = tid & 63, w = __builtin_amdgcn_readfirstlane(tid >> 6), r32 = lane & 31, hi = lane >> 5, mp = w >> 2, wq = w & 3;
    const bf16_t* proj = (const bf16_t*)(p.ws + WS_PROJ);
    const int NT = 2 * qb + 2, NP = NT / 2, myNT = (wq < 2) ? NT - 1 : NT;
    bf16x8 qf[4];
    { const bf16_t* qp = proj + (size_t)(qb * 128 + wq * 32 + r32) * INW + C_BQ + h * 128 + mp * 64 + hi * 8;
#pragma unroll
      for (int ds = 0; ds < 4; ++ds) qf[ds] = *(const bf16x8*)(qp + ds * 16); }
    asm volatile("" : "+v"(qf[0]), "+v"(qf[1]), "+v"(qf[2]), "+v"(qf[3]));
    f32x16 o[4] = {}; f32x16 ol = {}, nm = {};
    const char* gk = (const char*)(proj + (size_t)(w * 8 + (lane >> 3)) * INW + C_BK + h * 128) + g2_chunk_off(lane, w);
    const char* gv = (const char*)(proj + (size_t)(w * 8 + ((lane & 31) >> 2)) * INW + C_BV + h * 128 + (lane >> 5) * 32 + (lane & 3) * 8);
    const int vlane = ((lane & 3) << 3) | (((lane >> 2) & 3) << 6) | (((lane >> 4) & 1) << 5) | (((lane >> 5) & 1) << 8);
    constexpr size_t TSTEP = (size_t)64 * INW * 2;
#define A_STAGE(pr, sg) do { const char* k0_ = gk + (size_t)(pr) * 2 * TSTEP; const char* v0_ = gv + (size_t)(pr) * 2 * TSTEP; \
        _Pragma("unroll") for (int j = 0; j < 2; ++j) { \
            __builtin_amdgcn_global_load_lds((const unsigned*)(k0_ + j * TSTEP), (LAS unsigned*)(lds + (sg) * 65536 + (0 * 2 + j) * 8192 + w * 1024), 16, 0, 0); \
            __builtin_amdgcn_global_load_lds((const unsigned*)(k0_ + j * TSTEP + 128), (LAS unsigned*)(lds + (sg) * 65536 + (1 * 2 + j) * 8192 + w * 1024), 16, 0, 0); \
            __builtin_amdgcn_global_load_lds((const unsigned*)(v0_ + j * TSTEP), (LAS unsigned*)(lds + (sg) * 65536 + 32768 + j * 16384 + (2 * w) * 1024), 16, 0, 0); \
            __builtin_amdgcn_global_load_lds((const unsigned*)(v0_ + j * TSTEP + 128), (LAS unsigned*)(lds + (sg) * 65536 + 32768 + j * 16384 + (2 * w + 1) * 1024), 16, 0, 0); } } while (0)
    A_STAGE(0, 0);
    __syncthreads();
    bool first = true;
    for (int it = 0; it < NP; ++it) {
        const int sg = it & 1;
        if (it + 1 < NP) { if (sg) A_STAGE(it + 1, 0); else A_STAGE(it + 1, 1); }
#pragma unroll
        for (int jj = 0; jj < 2; ++jj) {
            const int j = jj, t = 2 * it + j;
            if (t < myNT) {
                bf16x8 p0, p1, p2, p3; f32x16 s0, s1;
                const int vb_ = (int)(uintptr_t)(lds_ + sg * 65536 + 32768 + j * 16384) + vlane;
                attn_scores<4>(lds_, sg * 65536 + (mp * 2 + j) * 8192, qf, s0, s1, o, ol, nm, first, r32, hi);
                first = false;
                exp_pack(s0, p0, p1); pv_half<4, 0>(o, ol, vb_, p0, p1); exp_pack(s1, p2, p3); pv_half<4, 1>(o, ol, vb_, p2, p3);
            }
        }
        __syncthreads();
    }
#undef A_STAGE
    float* xb = (float*)lds_;
    const float il = 1.0f / ol[0];
    if (mp == 1) {
        const float f = il * lam;
#pragma unroll
        for (int t = 0; t < 4; ++t)
#pragma unroll
            for (int r = 0; r < 16; ++r) xb[(wq * 64 + t * 16 + r) * 64 + lane] = o[t][r] * f;
    }
    __syncthreads();
    if (mp == 0) {
        float ss = 0.f;
#pragma unroll
        for (int t = 0; t < 4; ++t)
#pragma unroll
            for (int r = 0; r < 16; ++r) { const float v = o[t][r] * il - xb[(wq * 64 + t * 16 + r) * 64 + lane]; o[t][r] = v; ss += v * v; }
        ss = half_sum(ss);
        const float rs = rsqrtf(ss * (1.0f / 128.0f) + LN_EPS) * 0.8f;
        bf16_t* op = (bf16_t*)(p.ws + WS_ATT) + (size_t)(qb * 128 + wq * 32 + r32) * D + 512 + h * 128;
#pragma unroll
        for (int t = 0; t < 4; ++t)
#pragma unroll
            for (int rr = 0; rr < 4; ++rr) {
                const int dv0 = 32 * t + 8 * rr + 4 * hi;
                const f32x4 gg = *(const f32x4*)(p.subg + dv0);
                u32x2 pk = {cvt_pk(o[t][4 * rr] * rs * gg[0], o[t][4 * rr + 1] * rs * gg[1]), cvt_pk(o[t][4 * rr + 2] * rs * gg[2], o[t][4 * rr + 3] * rs * gg[3])};
                *(u32x2*)(op + dv0) = pk;
            }
    }
    __syncthreads();
}
__device__ __forceinline__ void attn_swa_unit(const Params& p, char* lds, int kvh, int n) {
    const int tid = threadIdx.x, lane = tid & 63, w = __builtin_amdgcn_readfirstlane(tid >> 6), r32 = lane & 31, hi = lane >> 5, g = w >> 1, hq = kvh * 4 + g;
    const bf16_t* proj = (const bf16_t*)(p.ws + WS_PROJ);
    const int c0 = (n >= 2) ? n - 2 : 0, NT = n - c0 + 1;
    const int tok = n * 64 + (w & 1) * 32 + r32;
    bf16x8 qf[4];
    { const bf16_t* qp = proj + (size_t)tok * INW + C_AQ + hq * 64 + hi * 8;
#pragma unroll
      for (int ds = 0; ds < 4; ++ds) qf[ds] = *(const bf16x8*)(qp + ds * 16); }
    f32x16 o[2] = {}; f32x16 ol, nm;
    { float ms = -p.sinks[hq] * LOG2E; asm volatile("" : "+v"(qf[0]), "+v"(qf[1]), "+v"(qf[2]), "+v"(qf[3]), "+v"(ms));
#pragma unroll
      for (int r = 0; r < 16; ++r) { nm[r] = ms; ol[r] = 1.0f; } }
    const bf16_t* gk = proj + (size_t)(c0 * 64 + (tid >> 3)) * INW + C_AK + kvh * 64 + (tid & 7) * 8;
    const bf16_t* gv = proj + (size_t)(c0 * 64 + (tid >> 3)) * INW + C_AV + kvh * 64 + (tid & 7) * 8;
    const int wk = swz(tid >> 3, tid & 7), wv = v_off(tid >> 3, (tid & 7) * 8, 2);
    const int vlane = ((lane & 3) << 3) | (((lane >> 2) & 3) << 6) | (((lane >> 4) & 1) << 5) | (((lane >> 5) & 1) << 8);
    u32x4 st0, st1;
#define W_LOAD(t) do { const size_t ko = (size_t)(t) * 64 * INW; st0 = *(const u32x4*)(gk + ko); st1 = *(const u32x4*)(gv + ko); } while (0)
#define W_WRITE(b) do { char* sb = lds + (b) * AT_STAGE; *(u32x4*)(sb + wk) = st0; *(u32x4*)(sb + 8192 + wv) = st1; } while (0)
    W_LOAD(0); W_WRITE(0); __syncthreads();
    for (int t = 0; t < NT; ++t) {
        const int b = t & 1;
        if (t + 1 < NT) W_LOAD(t + 1);
        { f32x16 s0, s1; bf16x8 p0, p1, p2, p3; const int vb_ = (int)(uintptr_t)(lds + b * AT_STAGE + 8192) + vlane;
          attn_scores<2>(lds, b * AT_STAGE, qf, s0, s1, o, ol, nm, false, r32, hi);
          exp_pack(s0, p0, p1); pv_half<2, 0>(o, ol, vb_, p0, p1); exp_pack(s1, p2, p3); pv_half<2, 1>(o, ol, vb_, p2, p3); }
        if (t + 1 < NT) W_WRITE(b ^ 1);
        __syncthreads();
    }
#undef W_LOAD
#undef W_WRITE
    const float il = 1.0f / ol[0];
    bf16_t* op = (bf16_t*)(p.ws + WS_ATT) + (size_t)tok * D + hq * 64;
#pragma unroll
    for (int t = 0; t < 2; ++t)
#pragma unroll
        for (int rr = 0; rr < 4; ++rr) {
            const int dv0 = 32 * t + 8 * rr + 4 * hi;
            u32x2 pk = {cvt_pk(o[t][4 * rr] * il, o[t][4 * rr + 1] * il), cvt_pk(o[t][4 * rr + 2] * il, o[t][4 * rr + 3] * il)};
            *(u32x2*)(op + dv0) = pk;
        }
}
__device__ __forceinline__ void phase_attn(const Params& p, char* lds, int vb, int G) {
    const int lane = threadIdx.x & 63;
    const float d1 = wave_sum(p.lq1[lane] * p.lk1[lane]), d2 = wave_sum(p.lq2[lane] * p.lk2[lane]);
    const float lam = expf(d1) - expf(d2) + 0.2f;
    for (int u = vb; u < 1024; u += G) {
        if (u < 256) attn_diff_unit(p, lds, u >> 6, 127 - (u & 63), lam);
        else if (u < 512) attn_diff_unit(p, lds, (u - 256) >> 6, (u - 256) & 63, lam);
        else attn_swa_unit(p, lds, (u - 512) >> 8, (u - 512) & 255);
    }
}

struct EpiPreLn {
    const float* x; float* out; int row0, col0;
    __device__ __forceinline__ void operator()(f32x4 (&acc)[8][4], int wr, int wc, int fr, int fq) const {
#pragma unroll
        for (int mt = 0; mt < 8; ++mt) {
            const size_t ro = (size_t)(row0 + wr * 128 + mt * 16 + fr) * D + col0 + wc * 64 + 4 * fq;
#pragma unroll
            for (int nt = 0; nt < 4; ++nt) { const f32x4 xv = *(const f32x4*)(x + ro + nt * 16); *(f32x4*)(out + ro + nt * 16) = xv * ALPHA + acc[mt][nt]; }
        }
    }
};
__device__ __forceinline__ void phase_wout(const Params& p, char* lds, int vb, int G) {
    for (int u = vb; u < (S / 256) * 4; u += G) {
        const int tm = u >> 2, tn = u & 3;
        G2Args g; g.A = (const char*)(p.ws + WS_ATT); g.B = (const char*)(p.ws + WS_WOUT); g.nk = D / 64; g.akstep = 128;
        g2_rows_A<8>(g, (size_t)tm * 256, D * 2); g2_rows_B(g, (size_t)tn * 256, D * 2);
        EpiPreLn e{p.x, (float*)(p.ws + WS_PRELN), tm * 256, tn * 256};
        gemm2<8>(lds, g, e);
    }
}

struct EpiLogits {
    float* L;
    __device__ __forceinline__ void operator()(f32x4 (&acc)[4][4], int wr, int wc, int fr, int fq) const {
#pragma unroll
        for (int mt = 0; mt < 4; ++mt)
#pragma unroll
            for (int nt = 0; nt < 4; ++nt) *(f32x4*)(L + (wr * 64 + mt * 16 + fr) * 256 + wc * 64 + nt * 16 + 4 * fq) = acc[mt][nt];
    }
};
__device__ __forceinline__ void phase_router(const Params& p, char* lds, int vb, int G) {
    const int tid = threadIdx.x, lane = tid & 63, w = tid >> 6;
    const float* preln = (const float*)(p.ws + WS_PRELN);
    bf16_t* x1b = (bf16_t*)(p.ws + WS_X1B);
    unsigned* cnt = (unsigned*)(p.ws + WS_CTL + 65536); int* list = (int*)(p.ws + WS_LIST); float* gates = (float*)(p.ws + WS_GATE);
    for (int u = vb; u < S / 64; u += G) {
        {
            f32x4 v[8][4]; float sm[8], sq[8];
#pragma unroll
            for (int i = 0; i < 8; ++i) { const f32x4* xr = (const f32x4*)(preln + (size_t)(u * 64 + w * 8 + i) * D) + lane;
#pragma unroll
                for (int j = 0; j < 4; ++j) v[i][j] = xr[64 * j]; }
#pragma unroll
            for (int i = 0; i < 8; ++i) { float s = 0.f;
#pragma unroll
                for (int j = 0; j < 4; ++j) s += (v[i][j][0] + v[i][j][1]) + (v[i][j][2] + v[i][j][3]);
                sm[i] = s; }
#pragma unroll
            for (int o = 1; o < 64; o <<= 1) {
#pragma unroll
                for (int i = 0; i < 8; ++i) sm[i] += __shfl_xor(sm[i], o); }
#pragma unroll
            for (int i = 0; i < 8; ++i) { const float mean = sm[i] * (1.0f / D); float s2 = 0.f;
#pragma unroll
                for (int j = 0; j < 4; ++j) { v[i][j] = v[i][j] - mean; s2 += (v[i][j][0] * v[i][j][0] + v[i][j][1] * v[i][j][1]) + (v[i][j][2] * v[i][j][2] + v[i][j][3] * v[i][j][3]); }
                sq[i] = s2; }
#pragma unroll
            for (int o = 1; o < 64; o <<= 1) {
#pragma unroll
                for (int i = 0; i < 8; ++i) sq[i] += __shfl_xor(sq[i], o); }
#pragma unroll
            for (int j = 0; j < 4; ++j) {
                const f32x4 gg = *((const f32x4*)p.ln1g + lane + 64 * j), bb = *((const f32x4*)p.ln1b + lane + 64 * j);
#pragma unroll
                for (int i = 0; i < 8; ++i) {
                    const int row = u * 64 + w * 8 + i;
                    const float rstd = rsqrtf(sq[i] * (1.0f / D) + LN_EPS);
                    const f32x4 y = v[i][j] * rstd * gg + bb;
                    u32x2 pk = {cvt_pk(y[0], y[1]), cvt_pk(y[2], y[3])};
                    *(u32x2*)(x1b + ((size_t)((lane >> 4) + 4 * j) * S + row) * 64 + ((4 * lane) & 63)) = pk;
                }
            }
        }
        asm volatile("s_waitcnt vmcnt(0)" ::: "memory");
        __syncthreads();
        { G2Args g; g.A = (const char*)x1b; g.B = (const char*)(p.ws + WS_WR); g.nk = D / 64; g.akstep = S * 128;
          g2_rows_A<4>(g, (size_t)u * 64, 128); g.offA[1] = g.offA[0]; g2_rows_B(g, 0, D * 2);
          EpiLogits e{(float*)lds};
          gemm2<4>(lds, g, e); }
        __syncthreads();
        const f32x4 rb = *((const f32x4*)p.r_bias + lane);
        const float NEG = -__builtin_inff();
        for (int i0 = 0; i0 < 8; i0 += 4) {
            float sc[4][4], cand[4][4]; int my_e[4]; float my_s[4], gsum[4];
#pragma unroll
            for (int q = 0; q < 4; ++q) {
                const int tl = w * 8 + i0 + q;
                const f32x4 lg = *((const f32x4*)((const float*)lds + tl * 256) + lane);
#pragma unroll
                for (int j = 0; j < 4; ++j) { sc[q][j] = 1.0f / (1.0f + __expf(-lg[j])); cand[q][j] = sc[q][j] + rb[j]; }
                my_e[q] = 0; my_s[q] = 0.f; gsum[q] = 0.f;
            }
            float a1[4], a2[4];
#pragma unroll
            for (int q = 0; q < 4; ++q) { const float m01 = fmaxf(cand[q][0], cand[q][1]), n01 = fminf(cand[q][0], cand[q][1]), m23 = fmaxf(cand[q][2], cand[q][3]), n23 = fminf(cand[q][2], cand[q][3]);
              a1[q] = fmaxf(m01, m23); a2[q] = fmaxf(fminf(m01, m23), fmaxf(n01, n23)); }
#pragma unroll
            for (int off = 1; off < 8; off <<= 1) {
#pragma unroll
                for (int q = 0; q < 4; ++q) { const float b1 = __shfl_xor(a1[q], off), b2 = __shfl_xor(a2[q], off); const float n1 = fmaxf(a1[q], b1), n2 = fmaxf(fminf(a1[q], b1), fmaxf(a2[q], b2)); a1[q] = n1; a2[q] = n2; }
            }
            const int mygrp = lane >> 3;
#pragma unroll
            for (int q = 0; q < 4; ++q) {
                const float gs = a1[q] + a2[q]; int rank = 0;
#pragma unroll
                for (int g2 = 0; g2 < 8; ++g2) { const float v = __shfl(gs, g2 * 8); rank += (v > gs || (v == gs && g2 < mygrp)) ? 1 : 0; }
                if (rank >= 4) {
#pragma unroll
                    for (int j = 0; j < 4; ++j) cand[q][j] = NEG;
                }
            }
#pragma unroll
            for (int k = 0; k < 8; ++k) {
                float bv[4]; int idx[4];
#pragma unroll
                for (int q = 0; q < 4; ++q) { bv[q] = cand[q][0]; int bi = 0;
#pragma unroll
                    for (int j = 1; j < 4; ++j) if (cand[q][j] > bv[q]) { bv[q] = cand[q][j]; bi = j; }
                    idx[q] = 4 * lane + bi; }
#pragma unroll
                for (int off = 32; off >= 1; off >>= 1) {
#pragma unroll
                    for (int q = 0; q < 4; ++q) { const float ov = __shfl_xor(bv[q], off); const int oi = __shfl_xor(idx[q], off); if (ov > bv[q] || (ov == bv[q] && oi < idx[q])) { bv[q] = ov; idx[q] = oi; } }
                }
#pragma unroll
                for (int q = 0; q < 4; ++q) {
                    const int owner = idx[q] >> 2, sub = idx[q] & 3;
                    float scv = sc[q][0];
#pragma unroll
                    for (int j = 1; j < 4; ++j) scv = (sub == j) ? sc[q][j] : scv;
                    if (lane == owner) {
#pragma unroll
                        for (int j = 0; j < 4; ++j) if (sub == j) cand[q][j] = NEG;
                    }
                    const float gsc = __shfl(scv, owner);
                    if (lane == k) { my_e[q] = idx[q]; my_s[q] = gsc; }
                    gsum[q] += gsc;
                }
            }
            if (lane < 8) {
#pragma unroll
                for (int q = 0; q < 4; ++q) {
                    const int t = u * 64 + w * 8 + i0 + q;
                    const float gate = my_s[q] / gsum[q] * 2.5f;
                    const unsigned pos = atomicAdd(cnt + my_e[q] * CNT_STRIDE, 1u);
                    list[(size_t)my_e[q] * CAP + pos] = t * 8 + lane;
                    gates[t * 8 + lane] = gate;
                }
            }
        }
        __syncthreads();
    }
}

#ifndef MOE_MT
#define MOE_MT 8
#endif
constexpr int MOE_BM = 32 * MOE_MT;
struct EpiAct {
    bf16_t* act; const int* slots;
    __device__ __forceinline__ void operator()(f32x4 (&acc)[MOE_MT][4], int pass, int wr, int wc, int fr, int fq) const {
        const int ncol0 = pass * 128;
#pragma unroll
        for (int mt = 0; mt < MOE_MT; ++mt) {
            const int ar = slots[wr * 16 * MOE_MT + mt * 16 + fr];
            if (ar >= 0) {
                float a[8];
#pragma unroll
                for (int nt = 0; nt < 2; ++nt)
#pragma unroll
                    for (int j = 0; j < 4; ++j) { const float gq = acc[mt][nt][j]; a[nt * 4 + j] = gq / (1.0f + __expf(-gq)) * (acc[mt][nt + 2][j]); }
                u32x4 pk = {cvt_pk(a[0], a[1]), cvt_pk(a[2], a[3]), cvt_pk(a[4], a[5]), cvt_pk(a[6], a[7])};
                *(u32x4*)(act + (size_t)ar * FF + ncol0 + wc * 32 + 8 * fq) = pk;
            }
        }
    }
};
struct EpiY {
    bf16_t* y; const int* yrows; const float* gl;
    __device__ __forceinline__ void operator()(f32x4 (&acc)[MOE_MT][4], int pass, int wr, int wc, int fr, int fq) const {
        const int col0 = pass * 256;
#pragma unroll
        for (int mt = 0; mt < MOE_MT; ++mt) {
            const int r = wr * 16 * MOE_MT + mt * 16 + fr, yr = yrows[r];
            if (yr >= 0) {
                const float gt = gl[r];
#pragma unroll
                for (int a = 0; a < 2; ++a) {
                    const f32x4 v0 = acc[mt][2 * a] * gt, v1 = acc[mt][2 * a + 1] * gt;
                    u32x4 pk = {cvt_pk(v0[0], v0[1]), cvt_pk(v0[2], v0[3]), cvt_pk(v1[0], v1[1]), cvt_pk(v1[2], v1[3])};
                    *(u32x4*)(y + (size_t)yr * D + col0 + wc * 64 + a * 32 + 8 * fq) = pk;
                }
            }
        }
    }
};
__device__ __forceinline__ void phase_experts(const Params& p, char* lds, int vb, int G) {
    const int tid0 = threadIdx.x, w = __builtin_amdgcn_readfirstlane(tid0 >> 6);
    const unsigned* cnt = (const unsigned*)(p.ws + WS_CTL + 65536); const int* list = (const int*)(p.ws + WS_LIST); const float* gates = (const float*)(p.ws + WS_GATE);
    bf16_t* act = (bf16_t*)(p.ws + WS_ACT); bf16_t* ybuf = (bf16_t*)(p.ws + WS_Y);
    int* nts = (int*)(lds + LDS_MISC); int* pre = nts + 256;
    int* s_arow = pre + 260; int* s_yrow = s_arow + MOE_BM; int* s_tok = s_yrow + MOE_BM; float* s_gate = (float*)(s_tok + MOE_BM);
    if (tid0 < 256) nts[tid0] = (int)((__hip_atomic_load(cnt + tid0 * CNT_STRIDE, __ATOMIC_RELAXED, __HIP_MEMORY_SCOPE_AGENT) + (MOE_BM - 1)) / MOE_BM);
    __syncthreads();
    if (tid0 < 257) { int s = 0; for (int e = 0; e < tid0; ++e) s += nts[e]; pre[tid0] = s; }
    __syncthreads();
    const int NR = __builtin_amdgcn_readfirstlane(pre[256]), NU = NR + S / MOE_BM;
    for (int u = vb; u < NU; u += G) {
        __syncthreads();
        int tid = threadIdx.x; asm volatile("" : "+v"(tid));
        const int lane = tid & 63; const unsigned co = g2_chunk_off(lane, w);
        const float *bg, *bu, *bd;
        if (u < NR) {
            int lo = 0, hi = 255;
            while (lo < hi) { const int mid = (lo + hi + 1) >> 1; if (pre[mid] <= u) lo = mid; else hi = mid - 1; }
            const int e = lo, tile = u - pre[e], n = (int)__hip_atomic_load(cnt + e * CNT_STRIDE, __ATOMIC_RELAXED, __HIP_MEMORY_SCOPE_AGENT);
            if (tid < MOE_BM) {
                const int idx = tile * MOE_BM + tid;
                if (idx < n) { const int slot = list[(size_t)e * CAP + idx]; s_arow[tid] = slot; s_yrow[tid] = slot + (slot >> 3); s_tok[tid] = slot >> 3; s_gate[tid] = gates[slot]; }
                else { s_arow[tid] = -1; s_yrow[tid] = -1; s_tok[tid] = 0; s_gate[tid] = 0.f; }
            }
            bg = p.w_g + (size_t)e * D * FF; bu = p.w_u + (size_t)e * D * FF; bd = p.w_d + (size_t)e * FF * D;
        } else {
            const int tile = u - NR;
            if (tid < MOE_BM) { const int tk = tile * MOE_BM + tid; s_arow[tid] = S * 8 + tk; s_yrow[tid] = tk * 9 + 8; s_tok[tid] = tk; s_gate[tid] = 1.0f; }
            bg = p.ws_g; bu = p.ws_u; bd = p.ws_d;
        }
        __syncthreads();
        { G3fArgs g; g.A = (const char*)(p.ws + WS_X1B); g.nk = D / 64; g.akstep = S * 128;
#pragma unroll
          for (int i = 0; i < MOE_MT / 2; ++i) g.offA[i] = (unsigned)s_tok[i * 64 + w * 8 + (lane >> 3)] * 128u + co;
          { const int bwc = lane >> 4, nt = (lane >> 2) & 3, bfq = lane & 3;
            g.b = ((nt < 2) ? bg : bu) + bwc * 32 + 8 * bfq + 4 * (nt & 1) + (size_t)(w * 8) * FF; }
          EpiAct e{act, s_arow};
          gemm3f<MOE_MT, FF>(lds, g, 2, 128, e); }
        asm volatile("s_waitcnt vmcnt(0)" ::: "memory");
        __syncthreads();
        { G3fArgs g; g.A = (const char*)act; g.nk = FF / 64; g.akstep = 128;
#pragma unroll
          for (int i = 0; i < MOE_MT / 2; ++i) { const int ar = s_arow[i * 64 + w * 8 + (lane >> 3)]; g.offA[i] = (unsigned)(ar < 0 ? 0 : ar) * (unsigned)(FF * 2) + co; }
          g.b = bd + (size_t)(w * 8) * D + (lane >> 4) * 64 + (((lane >> 2) & 3) >> 1) * 32 + 8 * (lane & 3) + 4 * ((lane >> 2) & 1);
          EpiY e{ybuf, s_yrow, s_gate};
          gemm3f<MOE_MT, D>(lds, g, 4, 256, e); }
    }
}

__device__ __forceinline__ void phase_final(const Params& p, int vb, int G) {
    const int lane = threadIdx.x & 63, w = threadIdx.x >> 6;
    const bf16_t* x1b = (const bf16_t*)(p.ws + WS_X1B); const bf16_t* ybuf = (const bf16_t*)(p.ws + WS_Y);
    constexpr int NR = 4;
    for (int row0 = (vb * 8 + w) * NR; row0 < S; row0 += G * 8 * NR) {
        f32x4 v[NR][4]; float sm[NR], sq[NR];
#pragma unroll
        for (int i = 0; i < NR; ++i) {
            const int row = row0 + i;
#pragma unroll
            for (int j = 0; j < 4; ++j) { const u32x2 q = *(const u32x2*)(x1b + ((size_t)((lane >> 4) + 4 * j) * S + row) * 64 + ((4 * lane) & 63));
                v[i][j] = (f32x4){bf_lo(q[0]), bf_hi(q[0]), bf_lo(q[1]), bf_hi(q[1])} * ALPHA; }
#pragma unroll
            for (int k = 0; k < 9; ++k) {
                const u32x2* yr = (const u32x2*)(ybuf + (size_t)(row * 9 + k) * D) + lane;
#pragma unroll
                for (int j = 0; j < 4; ++j) { const u32x2 q = yr[64 * j]; v[i][j][0] += bf_lo(q[0]); v[i][j][1] += bf_hi(q[0]); v[i][j][2] += bf_lo(q[1]); v[i][j][3] += bf_hi(q[1]); }
            }
        }
#pragma unroll
        for (int i = 0; i < NR; ++i) { float s = 0.f;
#pragma unroll
            for (int j = 0; j < 4; ++j) s += (v[i][j][0] + v[i][j][1]) + (v[i][j][2] + v[i][j][3]);
            sm[i] = s; }
#pragma unroll
        for (int o = 1; o < 64; o <<= 1) {
#pragma unroll
            for (int i = 0; i < NR; ++i) sm[i] += __shfl_xor(sm[i], o); }
#pragma unroll
        for (int i = 0; i < NR; ++i) { const float mean = sm[i] * (1.0f / D); float s2 = 0.f;
#pragma unroll
            for (int j = 0; j < 4; ++j) { v[i][j] = v[i][j] - mean; s2 += (v[i][j][0] * v[i][j][0] + v[i][j][1] * v[i][j][1]) + (v[i][j][2] * v[i][j][2] + v[i][j][3] * v[i][j][3]); }
            sq[i] = s2; }
#pragma unroll
        for (int o = 1; o < 64; o <<= 1) {
#pragma unroll
            for (int i = 0; i < NR; ++i) sq[i] += __shfl_xor(sq[i], o); }
#pragma unroll
        for (int j = 0; j < 4; ++j) {
            const f32x4 gg = *((const f32x4*)p.ln2g + lane + 64 * j), bb = *((const f32x4*)p.ln2b + lane + 64 * j);
#pragma unroll
            for (int i = 0; i < NR; ++i) { const float rstd = rsqrtf(sq[i] * (1.0f / D) + LN_EPS);
                *((f32x4*)(p.out + (size_t)(row0 + i) * D) + lane + 64 * j) = v[i][j] * rstd * gg + bb; }
        }
    }
}

__global__ void __launch_bounds__(NTHREADS) mega(Params p) {
    extern __shared__ __attribute__((aligned(16))) char lds[];
    const int G = gridDim.x, bx = blockIdx.x;
    const int vb = (G % 8 == 0) ? (bx % 8) * (G / 8) + bx / 8 : bx;
    if (threadIdx.x < 4) ((volatile LAS unsigned*)((LAS char*)lds + LDS_BARST))[threadIdx.x] = 0u;
    __syncthreads();
    XcdBarrier bar; bar.bar = (unsigned*)(p.ws + WS_CTL) + CW_BAR; bar.x = 0; bar.st = nullptr;
    if (p.ph_hi - p.ph_lo > 1) bar = xcd_barrier_post((unsigned*)(p.ws + WS_CTL) + CW_BAR, (volatile LAS unsigned*)((LAS char*)lds + LDS_BARST));
#define SEAM(k) do { if (p.ph_lo <= (k) && (k) + 1 < p.ph_hi) { xcd_barrier(bar); } } while (0)
#define IN(k) (p.ph_lo <= (k) && (k) < p.ph_hi)
#define RUN(k, call) do { if (IN(k)) { call; if (MK_REPEAT == (k)) { __syncthreads(); call; } } } while (0)
    RUN(0, phase_prep(p, vb, G)); SEAM(0);
    RUN(1, phase_proj(p, lds, vb, G)); SEAM(1);
    RUN(2, phase_attn(p, lds, vb, G)); SEAM(2);
    RUN(3, phase_wout(p, lds, vb, G)); SEAM(3);
    if (IN(4)) { phase_router(p, lds, vb, G); } SEAM(4);
    RUN(5, phase_experts(p, lds, vb, G)); SEAM(5);
    RUN(6, phase_final(p, vb, G));
#undef SEAM
#undef IN
#undef RUN
}

extern "C" void kernel_launch(void* const* d_in, const int* in_sizes, int n_in, void* d_out, int out_size, void* d_ws, size_t ws_size, hipStream_t stream) {
    static int grid = 0;
    if (grid == 0) {
        if (n_in != 22 || in_sizes[0] != S * D || out_size != S * D || ws_size < WS_END) {
            fprintf(stderr, "kernel_launch: unexpected shapes: n_in %d in0 %d out %d ws %zu (need %zu)\n", n_in, n_in > 0 ? in_sizes[0] : -1, out_size, ws_size, (size_t)WS_END); grid = -1; return; }
        int dev = 0, cus = 0, per_cu = 0;
        (void)hipGetDevice(&dev); (void)hipDeviceGetAttribute(&cus, hipDeviceAttributeMultiprocessorCount, dev);
        if (hipFuncSetAttribute((const void*)mega, hipFuncAttributeMaxDynamicSharedMemorySize, LDS_BYTES) != hipSuccess) { fprintf(stderr, "kernel_launch: hipFuncSetAttribute failed\n"); grid = -1; return; }
        (void)hipOccupancyMaxActiveBlocksPerMultiprocessor(&per_cu, (const void*)mega, NTHREADS, LDS_BYTES);
        if (per_cu < 1) { fprintf(stderr, "kernel_launch: occupancy query says %d blocks per CU\n", per_cu); per_cu = 1; }
        grid = cus * 1;
        (void)hipGetLastError();
    }
    if (grid < 0) return;
    (void)hipMemsetAsync((char*)d_ws + WS_CTL, 0, CTL_BYTES, stream);
    Params p{};
    const float** f = (const float**)&p;
    for (int i = 0; i < 22; ++i) f[i] = (const float*)d_in[i];
    p.out = (float*)d_out; p.ws = (unsigned char*)d_ws;
#if MK_ONE_LAUNCH
    p.ph_lo = 0; p.ph_hi = 7;
    void* args[] = {&p};
    hipError_t e = hipLaunchCooperativeKernel((const void*)mega, dim3(grid), dim3(NTHREADS), args, LDS_BYTES, stream);
    if (e != hipSuccess) fprintf(stderr, "kernel_launch: cooperative launch failed: %s (grid %d)\n", hipGetErrorString(e), grid);
#else
    for (int ph = 0; ph < 7; ++ph) {
        p.ph_lo = ph; p.ph_hi = ph + 1;
        hipLaunchKernelGGL(mega, dim3(grid), dim3(NTHREADS), LDS_BYTES, stream, p);
    }
#endif
}
```

```cpp
#include <hip/hip_runtime.h>
#include <hip/hip_cooperative_groups.h>
#include <cstdio>
#include <cstdint>
namespace cg = cooperative_groups;

#ifndef MK_REPEAT
#define MK_REPEAT -1
#endif
#ifndef MK_ONE_LAUNCH
#define MK_ONE_LAUNCH 1
#endif

constexpr int S = 16384, D = 1024, INW = 2304, NE = 256, FF = 256;
constexpr int NTHREADS = 512;
constexpr int CAP = 16384;
constexpr float ALPHA = 1.189207115002721f;
constexpr float LN_EPS = 1e-5f;
constexpr float QSCALE = 0.125f * 1.4426950408889634f;
constexpr float LOG2E = 1.4426950408889634f;
constexpr int C_AQ = 0, C_AK = 512, C_AV = 640, C_BQ = 768, C_BK = 1280, C_BV = 1792;

constexpr size_t MiB = 1ull << 20;
constexpr size_t WS_CTL = 0;
constexpr size_t CTL_BYTES = 128 * 1024;
constexpr int CNT_STRIDE = 64;
constexpr size_t WS_ROPE = 1 * MiB;
constexpr size_t WS_WIN = 8 * MiB;
constexpr size_t WS_WOUT = 13 * MiB;
constexpr size_t WS_WR = 15 * MiB;
constexpr size_t WS_WSGU = 16 * MiB;
constexpr size_t WS_WSD = 17 * MiB;
constexpr size_t WS_EGU = 20 * MiB;
constexpr size_t WS_ED = 276 * MiB;
constexpr size_t WS_X1F = 404 * MiB;
constexpr size_t WS_X1B = 468 * MiB;
constexpr size_t WS_LIST = 500 * MiB;
constexpr size_t WS_GATE = 516 * MiB;
constexpr size_t WS_ACT = 518 * MiB;
constexpr size_t WS_Y = 590 * MiB;
constexpr size_t WS_XB = 590 * MiB;
constexpr size_t WS_PROJ = 622 * MiB;
constexpr size_t WS_ATT = 694 * MiB;
constexpr size_t WS_PRELN = 726 * MiB;
constexpr size_t WS_END = 878 * MiB;

constexpr int LDS_BYTES = 147456;
constexpr int LDS_MISC = 131072;

typedef unsigned short bf16_t;
typedef short bf16x8 __attribute__((ext_vector_type(8)));
typedef short s16x4 __attribute__((ext_vector_type(4)));
typedef float f32x4 __attribute__((ext_vector_type(4)));
typedef float f32x16 __attribute__((ext_vector_type(16)));
typedef unsigned u32x4 __attribute__((ext_vector_type(4)));
typedef unsigned u32x2 __attribute__((ext_vector_type(2)));
typedef float f32x2 __attribute__((ext_vector_type(2)));


#define LAS __attribute__((address_space(3)))
#define XB_TMO      128
#define XB_XCNT(j)  (256  + 64 * (j))
#define XB_XSUB(j)  (1280 + 64 * (j))
#define XB_XGEN(j)  (2304 + 64 * (j))
#define XB_TOP      3328
#define XB_TOPGEN   3392
#define XCD_BAR_WORDS 3456
#define XB_SPIN_CAP (1u << 18)
__device__ __forceinline__ unsigned xb_ld(unsigned* p)              { return __hip_atomic_load(p, __ATOMIC_RELAXED, __HIP_MEMORY_SCOPE_AGENT); }
__device__ __forceinline__ unsigned xb_add(unsigned* p, unsigned v) { return __hip_atomic_fetch_add(p, v, __ATOMIC_RELAXED, __HIP_MEMORY_SCOPE_AGENT); }
__device__ __forceinline__ unsigned xb_xcc_id() { return (unsigned)__builtin_amdgcn_s_getreg((3 << 11) | 20) & 0xFu; }
#define XB_SPIN(cond, bar) do { unsigned _sp = 0; while (cond) { __builtin_amdgcn_s_sleep(1); \
    if ((++_sp & 255u) == 0u) { if (xb_ld(&(bar)[XB_TMO])) break; if (_sp > XB_SPIN_CAP) { atomicAdd(&(bar)[XB_TMO], 1u); break; } } } } while (0)
struct XcdBarrier { unsigned* bar; unsigned x; volatile LAS unsigned* st; };
__device__ __forceinline__ XcdBarrier xcd_barrier_post(unsigned* bar, volatile LAS unsigned* st) {
    XcdBarrier b; b.bar = bar; b.x = xb_xcc_id(); b.st = st;
    if (threadIdx.x == 0) (void)xb_add(&bar[XB_XCNT(b.x)], 1u);
    return b;
}
__device__ __forceinline__ void xcd_barrier_complete(unsigned* bar, unsigned x, unsigned& nloc, unsigned& nx) {
    const unsigned G = gridDim.x * gridDim.y * gridDim.z;
    unsigned sum, cnt, mine, sp = 0u;
    for (;;) {
        sum = 0u; cnt = 0u; mine = 0u;
#pragma unroll
        for (unsigned j = 0; j < 16; ++j) { const unsigned c = xb_ld(&bar[XB_XCNT(j)]); sum += c; cnt += (c > 0u) ? 1u : 0u; mine = (j == x) ? c : mine; }
        if (sum == G) break;
        __builtin_amdgcn_s_sleep(1);
        if ((++sp & 255u) == 0u) { if (xb_ld(&bar[XB_TMO])) break; if (sp > XB_SPIN_CAP) { atomicAdd(&bar[XB_TMO], 1u); break; } }
    }
    nloc = mine > 0u ? mine : 1u; nx = cnt > 0u ? cnt : 1u;
}
__device__ __forceinline__ void xcd_barrier(const XcdBarrier& b) {
    asm volatile("s_waitcnt vmcnt(0)" ::: "memory");
    __syncthreads();
    if (threadIdx.x == 0) {
        unsigned* bar = b.bar;
        __builtin_amdgcn_s_waitcnt(0);
        unsigned nloc = b.st[0], nx = b.st[1];
        if (nloc == 0u) { xcd_barrier_complete(bar, b.x, nloc, nx); b.st[0] = nloc; b.st[1] = nx; }
        const unsigned old = xb_add(&bar[XB_XSUB(b.x)], 1u);
        const unsigned gen = old / nloc;
        if (old + 1u == (gen + 1u) * nloc) {
            __builtin_amdgcn_fence(__ATOMIC_RELEASE, "agent");
            asm volatile("s_waitcnt vmcnt(0)" ::: "memory");
            const unsigned og = xb_add(&bar[XB_TOP], 1u);
            const unsigned tg = og / nx;
            if (og + 1u == (tg + 1u) * nx) xb_add(&bar[XB_TOPGEN], 1u);
            else XB_SPIN(xb_ld(&bar[XB_TOPGEN]) == tg, bar);
            __builtin_amdgcn_fence(__ATOMIC_ACQUIRE, "agent");
            xb_add(&bar[XB_XGEN(b.x)], 1u);
            asm volatile("s_waitcnt vmcnt(0)" ::: "memory");
        } else {
            XB_SPIN(xb_ld(&bar[XB_XGEN(b.x)]) == gen, bar);
            __builtin_amdgcn_fence(__ATOMIC_ACQUIRE, "agent");
            asm volatile("s_waitcnt vmcnt(0)" ::: "memory");
        }
    }
    __syncthreads();
}
constexpr int CW_BAR = 4096;
constexpr int LDS_BARST = LDS_MISC + 8192;

struct Params {
    const float* x; const float* w_in; const float* b_in; const float* sinks;
    const float* lq1; const float* lk1; const float* lq2; const float* lk2; const float* subg;
    const float* w_out; const float* ln1g; const float* ln1b; const float* w_r; const float* r_bias;
    const float* w_g; const float* w_u; const float* w_d; const float* ws_g; const float* ws_u; const float* ws_d;
    const float* ln2g; const float* ln2b;
    float* out; unsigned char* ws;
    int ph_lo, ph_hi;
};

__device__ __forceinline__ unsigned cvt_pk(float lo, float hi) { unsigned r; asm volatile("v_cvt_pk_bf16_f32 %0, %1, %2" : "=v"(r) : "v"(lo), "v"(hi)); return r; }
__device__ __forceinline__ float bf_lo(unsigned u) { return __uint_as_float(u << 16); }
__device__ __forceinline__ float bf_hi(unsigned u) { return __uint_as_float(u & 0xffff0000u); }
__device__ __forceinline__ float wave_sum(float v) {
#pragma unroll
    for (int o = 1; o < 64; o <<= 1) v += __shfl_xor(v, o);
    return v;
}
__device__ __forceinline__ float half_max(float v) { auto rr = __builtin_amdgcn_permlane32_swap(__float_as_uint(v), __float_as_uint(v), false, false); return fmaxf(__uint_as_float(rr[0]), __uint_as_float(rr[1])); }
__device__ __forceinline__ float half_sum(float v) { auto rr = __builtin_amdgcn_permlane32_swap(__float_as_uint(v), __float_as_uint(v), false, false); return __uint_as_float(rr[0]) + __uint_as_float(rr[1]); }

__device__ __forceinline__ int swz(int r, int c) { const int f = (r & 7) ^ (((r >> 3) & 1) << 1) ^ ((r >> 4) & 1); return r * 128 + ((c ^ f) << 4); }

struct G2Args {
    const char* A; const char* B;
    unsigned offA[4], offB[4];
    int nk;
    unsigned akstep;
};
__device__ __forceinline__ unsigned g2_chunk_off(int lane, int w) { const int f = (lane >> 3) ^ ((w & 1) << 1) ^ ((w >> 1) & 1); return (unsigned)(((lane & 7) ^ f) << 4); }
template <int MT, class Epi>
__device__ __forceinline__ void gemm2(char* lds_, const G2Args& g, const Epi& epi) {
    constexpr int A_BYTES = 32 * MT * 128, B_BYTES = 256 * 128, STAGE = A_BYTES + B_BYTES, AR = MT / 2;
    LAS char* lds = (LAS char*)lds_;
    const int tid = threadIdx.x, lane = tid & 63, w = __builtin_amdgcn_readfirstlane(tid >> 6), wr = w >> 2, wc = w & 3, fr = lane & 15, fq = lane >> 4;
    f32x4 acc[MT][4];
#pragma unroll
    for (int i = 0; i < MT; ++i)
#pragma unroll
        for (int j = 0; j < 4; ++j) acc[i][j] = (f32x4){0.f, 0.f, 0.f, 0.f};
    const int ldsw = w * 1024;
#define G2_STAGE(kt, s) do { \
        _Pragma("unroll") for (int i = 0; i < AR; ++i) __builtin_amdgcn_global_load_lds((const unsigned*)(g.A + g.offA[i] + (size_t)(kt) * g.akstep), (LAS unsigned*)(lds + (s) * STAGE + i * 8192 + ldsw), 16, 0, 0); \
        _Pragma("unroll") for (int i = 0; i < 4; ++i) __builtin_amdgcn_global_load_lds((const unsigned*)(g.B + g.offB[i] + (size_t)(kt) * 128), (LAS unsigned*)(lds + (s) * STAGE + A_BYTES + i * 8192 + ldsw), 16, 0, 0); } while (0)
    G2_STAGE(0, 0);
    __syncthreads();
    for (int kt = 0; kt < g.nk; ++kt) {
        const int s = kt & 1;
        if (kt + 1 < g.nk) { if (s) G2_STAGE(kt + 1, 0); else G2_STAGE(kt + 1, 1); }
        const char* la = lds_ + s * STAGE; const char* lb = la + A_BYTES;
        {
            constexpr int NG = 2 * (MT / 4);
            bf16x8 bfr[4], af[2][4];
#pragma unroll
            for (int nt = 0; nt < 4; ++nt) bfr[nt] = *(const bf16x8*)(lb + swz(wc * 64 + nt * 16 + fr, fq));
#pragma unroll
            for (int m = 0; m < 4; ++m) af[0][m] = *(const bf16x8*)(la + swz(wr * 16 * MT + m * 16 + fr, fq));
#pragma unroll
            for (int gi = 0; gi < NG; ++gi) {
                const int ks = gi / (MT / 4), h = gi % (MT / 4);
                if (gi > 0 && h == 0) {
#pragma unroll
                    for (int nt = 0; nt < 4; ++nt) bfr[nt] = *(const bf16x8*)(lb + swz(wc * 64 + nt * 16 + fr, ks * 4 + fq));
                }
                if (gi + 1 < NG) {
                    const int ks2 = (gi + 1) / (MT / 4), h2 = (gi + 1) % (MT / 4);
#pragma unroll
                    for (int m = 0; m < 4; ++m) af[(gi + 1) & 1][m] = *(const bf16x8*)(la + swz(wr * 16 * MT + (h2 * 4 + m) * 16 + fr, ks2 * 4 + fq));
                }
                __builtin_amdgcn_sched_barrier(0);
#pragma unroll
                for (int m = 0; m < 4; ++m)
#pragma unroll
                    for (int nt = 0; nt < 4; ++nt) acc[h * 4 + m][nt] = __builtin_amdgcn_mfma_f32_16x16x32_bf16(bfr[nt], af[gi & 1][m], acc[h * 4 + m][nt], 0, 0, 0);
                __builtin_amdgcn_sched_barrier(0);
            }
        }
        __syncthreads();
    }
#undef G2_STAGE
    epi(acc, wr, wc, fr, fq);
}
template <int MT>
__device__ __forceinline__ void g2_rows_A(G2Args& g, size_t row0, unsigned ld_bytes) {
    const int lane = threadIdx.x & 63, w = __builtin_amdgcn_readfirstlane(threadIdx.x >> 6); const unsigned co = g2_chunk_off(lane, w);
#pragma unroll
    for (int i = 0; i < MT / 2; ++i) g.offA[i] = (unsigned)((row0 + i * 64 + w * 8 + (lane >> 3)) * ld_bytes) + co;
}
__device__ __forceinline__ void g2_rows_B(G2Args& g, size_t row0, unsigned ld_bytes) {
    const int lane = threadIdx.x & 63, w = __builtin_amdgcn_readfirstlane(threadIdx.x >> 6); const unsigned co = g2_chunk_off(lane, w);
#pragma unroll
    for (int i = 0; i < 4; ++i) g.offB[i] = (unsigned)((row0 + i * 64 + w * 8 + (lane >> 3)) * ld_bytes) + co;
}


struct G3fArgs { const char* A; unsigned offA[4]; const float* b; int nk; unsigned akstep; };
template <int MT, int LDB, class Epi>
__device__ __forceinline__ void gemm3f(char* lds_, const G3fArgs& g, int npass, int bpstep, const Epi& epi) {
    constexpr int A_BYTES = 32 * MT * 128, B_BYTES = 256 * 128, STAGE = A_BYTES + B_BYTES, AR = MT / 2;
    LAS char* lds = (LAS char*)lds_;
    const int tid = threadIdx.x, lane = tid & 63, w = __builtin_amdgcn_readfirstlane(tid >> 6), wr = w >> 2, wc = w & 3, fr = lane & 15, fq = lane >> 4;
    f32x4 acc[MT][4];
#pragma unroll
    for (int i = 0; i < MT; ++i)
#pragma unroll
        for (int j = 0; j < 4; ++j) acc[i][j] = (f32x4){0.f, 0.f, 0.f, 0.f};
    const int ldsw = w * 1024;
    int bw[4];
#pragma unroll
    for (int j = 0; j < 4; ++j) bw[j] = swz(4 * lane + j, w);
    f32x4 br[8];
    const int nk = g.nk, nsteps = nk * npass;
#define G3_STAGE_A(kt, s) do { \
        _Pragma("unroll") for (int i = 0; i < AR; ++i) __builtin_amdgcn_global_load_lds((const unsigned*)(g.A + g.offA[i] + (size_t)(kt) * g.akstep), (LAS unsigned*)(lds + (s) * STAGE + i * 8192 + ldsw), 16, 0, 0); } while (0)
#define G3_LOAD_B(ps, kt) do { const float* pb_ = g.b + (size_t)(ps) * bpstep + (size_t)(kt) * 64 * LDB; _Pragma("unroll") for (int i = 0; i < 8; ++i) br[i] = *(const f32x4*)(pb_ + i * LDB); } while (0)
#define G3_WRITE_B(s) do { _Pragma("unroll") for (int j = 0; j < 4; ++j) { \
            u32x4 v = {cvt_pk(br[0][j], br[1][j]), cvt_pk(br[2][j], br[3][j]), cvt_pk(br[4][j], br[5][j]), cvt_pk(br[6][j], br[7][j])}; \
            *(u32x4*)(lds_ + (s) * STAGE + A_BYTES + bw[j]) = v; } } while (0)
    G3_STAGE_A(0, 0); G3_LOAD_B(0, 0); G3_WRITE_B(0);
    __syncthreads();
    int ps = 0, kt = 0;
    for (int st = 0; st < nsteps; ++st) {
        const int s = st & 1; const bool more = st + 1 < nsteps;
        int ps2 = ps, kt2 = kt + 1; if (kt2 == nk) { kt2 = 0; ++ps2; }
        if (more) { if (s) G3_STAGE_A(kt2, 0); else G3_STAGE_A(kt2, 1); G3_LOAD_B(ps2, kt2); }
        __builtin_amdgcn_sched_barrier(0);
        const char* la = lds_ + s * STAGE; const char* lb = la + A_BYTES;
#pragma unroll
        for (int ks = 0; ks < 2; ++ks) {
            bf16x8 bfr[4];
#pragma unroll
            for (int nt = 0; nt < 4; ++nt) bfr[nt] = *(const bf16x8*)(lb + swz(wc * 64 + nt * 16 + fr, ks * 4 + fq));
#pragma unroll
            for (int h = 0; h < MT / 2; ++h) {
                bf16x8 af[2];
#pragma unroll
                for (int m = 0; m < 2; ++m) af[m] = *(const bf16x8*)(la + swz(wr * 16 * MT + (h * 2 + m) * 16 + fr, ks * 4 + fq));
                __builtin_amdgcn_sched_barrier(0);
#pragma unroll
                for (int m = 0; m < 2; ++m)
#pragma unroll
                    for (int nt = 0; nt < 4; ++nt) acc[h * 2 + m][nt] = __builtin_amdgcn_mfma_f32_16x16x32_bf16(bfr[nt], af[m], acc[h * 2 + m][nt], 0, 0, 0);
                __builtin_amdgcn_sched_barrier(0);
            }
        }
        if (kt == nk - 1) {
            epi(acc, ps, wr, wc, fr, fq);
#pragma unroll
            for (int i = 0; i < MT; ++i)
#pragma unroll
                for (int j = 0; j < 4; ++j) acc[i][j] = (f32x4){0.f, 0.f, 0.f, 0.f};
        }
        if (more) { if (s) G3_WRITE_B(0); else G3_WRITE_B(1); }
        __syncthreads();
        ps = ps2; kt = kt2;
    }
#undef G3_STAGE_A
#undef G3_LOAD_B
#undef G3_WRITE_B
}

__device__ __forceinline__ void cvt_item(const float* W, int K, int N, bf16_t* WT, int ldt, int kb, int nb, int kc, int lane) {
    const float* src = W + (size_t)(kb * 64 + kc * 8) * N + nb * 256 + 4 * lane;
    bf16_t* dst = WT + (size_t)(nb * 256 + 4 * lane) * ldt + kb * 64 + kc * 8;
    f32x4 r[8];
#pragma unroll
    for (int i = 0; i < 8; ++i) r[i] = *(const f32x4*)(src + (size_t)i * N);
#pragma unroll
    for (int j = 0; j < 4; ++j) {
        u32x4 v = {cvt_pk(r[0][j], r[1][j]), cvt_pk(r[2][j], r[3][j]), cvt_pk(r[4][j], r[5][j]), cvt_pk(r[6][j], r[7][j])};
        *(u32x4*)(dst + (size_t)j * ldt) = v;
    }
}
__device__ __forceinline__ void phase_prep(const Params& p, int vb, int G) {
    const int tid = threadIdx.x, lane = tid & 63, w = tid >> 6;
    float* cs = (float*)(p.ws + WS_ROPE); float* sn = cs + (size_t)S * 32;
    for (int idx = vb * NTHREADS + tid; idx < S * 32; idx += G * NTHREADS) {
        const int pos = idx >> 5, i = idx & 31;
        const float pw = (float)pow(10000.0, (double)i / 32.0);
        const float inv = 1.0f / pw;
        const float angf = __fmul_rn((float)pos, inv);
        const double a = (double)angf;
        const double q = rint(a * 0.63661977236758134308);
        double r = fma(-q, 1.57079632679489655800, a); r = fma(-q, 6.12323399573676603587e-17, r);
        const double r2 = r * r;
        double sp = r * (1.0 + r2 * (-1.0 / 6 + r2 * (1.0 / 120 + r2 * (-1.0 / 5040 + r2 * (1.0 / 362880 + r2 * (-1.0 / 39916800))))));
        double cp = 1.0 + r2 * (-0.5 + r2 * (1.0 / 24 + r2 * (-1.0 / 720 + r2 * (1.0 / 40320 + r2 * (-1.0 / 3628800 + r2 * (1.0 / 479001600))))));
        const int qi = ((int)((long long)q)) & 3;
        double sv, cv;
        if (qi == 0) { sv = sp; cv = cp; } else if (qi == 1) { sv = cp; cv = -sp; } else if (qi == 2) { sv = -sp; cv = -cp; } else { sv = -cp; cv = sp; }
        cs[idx] = (float)cv; sn[idx] = (float)sv;
    }
    { const f32x4* xs = (const f32x4*)p.x; u32x4* xd = (u32x4*)(p.ws + WS_XB);
      for (size_t i = (size_t)vb * NTHREADS + tid; i < (size_t)S * D / 8; i += (size_t)G * NTHREADS) {
          const f32x4 a = xs[2 * i], b = xs[2 * i + 1];
          xd[i] = (u32x4){cvt_pk(a[0], a[1]), cvt_pk(a[2], a[3]), cvt_pk(b[0], b[1]), cvt_pk(b[2], b[3])}; } }
    const int gw = vb * 8 + w, NGW = G * 8;
    constexpr int I_IN = 16 * 9, I_OUT = 16 * 4, I_R = 16, I_SG = 16, I_SU = 16, I_SD = 4 * 4, I_SMALL = I_IN + I_OUT + I_R;
    for (int it8 = gw; it8 < I_SMALL * 8; it8 += NGW) {
        int r = it8 >> 3; const int kc = it8 & 7;
        if (r < I_IN) { cvt_item(p.w_in, D, INW, (bf16_t*)(p.ws + WS_WIN), D, r / 9, r % 9, kc, lane); continue; } r -= I_IN;
        if (r < I_OUT) { cvt_item(p.w_out, D, D, (bf16_t*)(p.ws + WS_WOUT), D, r >> 2, r & 3, kc, lane); continue; } r -= I_OUT;
        cvt_item(p.w_r, D, NE, (bf16_t*)(p.ws + WS_WR), D, r, 0, kc, lane);
    }
}

template <int MT> struct EpiProj {
    const float* bias; const float* cs; const float* sn; bf16_t* out; int row0, col0;
    __device__ __forceinline__ void operator()(f32x4 (&acc)[MT][4], int wr, int wc, int fr, int fq) const {
        const int hb = col0 + wc * 64;
        const bool is_q = (hb < C_AK) || (hb >= C_BQ && hb < C_BK);
        const bool is_rope = is_q || (hb >= C_AK && hb < C_AV) || (hb >= C_BK && hb < C_BV);
        const float sc = is_q ? QSCALE : 1.0f;
#pragma unroll
        for (int mt = 0; mt < MT; ++mt) {
            const int row = row0 + wr * 16 * MT + mt * 16 + fr;
            f32x4 v[4];
#pragma unroll
            for (int nt = 0; nt < 4; ++nt) v[nt] = acc[mt][nt] + *(const f32x4*)(bias + hb + nt * 16 + 4 * fq);
            if (is_rope) {
#pragma unroll
                for (int nt = 0; nt < 2; ++nt) {
                    const f32x4 c = *(const f32x4*)(cs + (size_t)row * 32 + nt * 16 + 4 * fq), s = *(const f32x4*)(sn + (size_t)row * 32 + nt * 16 + 4 * fq);
                    const f32x4 t1 = v[nt], t2 = v[nt + 2];
                    v[nt] = t1 * c - t2 * s; v[nt + 2] = t2 * c + t1 * s;
                }
            }
#pragma unroll
            for (int nt = 0; nt < 4; ++nt) {
                const f32x4 o = v[nt] * sc;
                u32x2 pk = {cvt_pk(o[0], o[1]), cvt_pk(o[2], o[3])};
                *(u32x2*)(out + (size_t)row * INW + hb + nt * 16 + 4 * fq) = pk;
            }
        }
    }
};
__device__ __forceinline__ void phase_proj(const Params& p, char* lds, int vb, int G) {
    const float* cs = (const float*)(p.ws + WS_ROPE); const float* sn = cs + (size_t)S * 32;
    constexpr int NBIG = 512, NUNITS = NBIG + 2 * 64;
    for (int u = vb; u < NUNITS; u += G) {
        G2Args g; g.A = (const char*)(p.ws + WS_XB); g.B = (const char*)(p.ws + WS_WIN); g.nk = D / 64; g.akstep = 128;
        if (u < NBIG) {
            const int tm = u / 9, tn = u % 9;
            g2_rows_A<8>(g, (size_t)tm * 256, D * 2); g2_rows_B(g, (size_t)tn * 256, D * 2);
            EpiProj<8> e{p.b_in, cs, sn, (bf16_t*)(p.ws + WS_PROJ), tm * 256, tn * 256};
            gemm2<8>(lds, g, e);
        } else {
            const int t = NBIG + ((u - NBIG) >> 1), half = (u - NBIG) & 1, tm = t / 9, tn = t % 9;
            g2_rows_A<4>(g, (size_t)tm * 256 + half * 128, D * 2); g2_rows_B(g, (size_t)tn * 256, D * 2);
            EpiProj<4> e{p.b_in, cs, sn, (bf16_t*)(p.ws + WS_PROJ), tm * 256 + half * 128, tn * 256};
            gemm2<4>(lds, g, e);
        }
    }
}

template <int OFF> __device__ __forceinline__ s16x4 tr_read(int vb) { s16x4 r; asm volatile("ds_read_b64_tr_b16 %0, %1 offset:%2" : "=&v"(r) : "v"(vb), "i"(OFF) : "memory"); return r; }
__device__ __forceinline__ int v_off(int k, int c, int ndb) { return ((k >> 3) * ndb + (c >> 5)) * 512 + ((k & 7) * 32 + (c & 31)) * 2; }

constexpr int AT_STAGE = 32768;
template <int NDB, int KB, int T> struct PvPart {
    static __device__ __forceinline__ void run(f32x16& o, int vbase, const bf16x8& pa, const bf16x8& pb) {
        constexpr int o0 = (KB * 4 * NDB + T) * 512, st = NDB * 512;
        const s16x4 l0 = tr_read<o0 + 0 * st>(vbase), h0 = tr_read<o0 + 1 * st>(vbase), l1 = tr_read<o0 + 2 * st>(vbase), h1 = tr_read<o0 + 3 * st>(vbase);
        asm volatile("s_waitcnt lgkmcnt(0)" ::: "memory"); __builtin_amdgcn_sched_barrier(0);
#define PKV(L, H) (bf16x8){L[0], L[1], L[2], L[3], H[0], H[1], H[2], H[3]}
        o = __builtin_amdgcn_mfma_f32_32x32x16_bf16(PKV(l0, h0), pa, o, 0, 0, 0);
        o = __builtin_amdgcn_mfma_f32_32x32x16_bf16(PKV(l1, h1), pb, o, 0, 0, 0);
#undef PKV
    }
};
template <int NDB, int KB>
__device__ __forceinline__ void pv_half(f32x16 (&o)[NDB], f32x16& ol, int vbase, const bf16x8& pa, const bf16x8& pb) {
    const bf16x8 ones = {16256, 16256, 16256, 16256, 16256, 16256, 16256, 16256};
    ol = __builtin_amdgcn_mfma_f32_32x32x16_bf16(ones, pa, ol, 0, 0, 0);
    ol = __builtin_amdgcn_mfma_f32_32x32x16_bf16(ones, pb, ol, 0, 0, 0);
    PvPart<NDB, KB, 0>::run(o[0], vbase, pa, pb); PvPart<NDB, KB, 1>::run(o[1], vbase, pa, pb);
    if constexpr (NDB == 4) { PvPart<NDB, KB, 2>::run(o[2], vbase, pa, pb); PvPart<NDB, KB, 3>::run(o[3], vbase, pa, pb); }
}
constexpr float ATT_THR = 10.0f;
template <int NDB>
__device__ __forceinline__ void attn_scores(char* lds, int kof, const bf16x8 (&qf)[4], f32x16& s0, f32x16& s1, f32x16 (&o)[NDB], f32x16& ol, f32x16& nm, bool first, int r32, int hi) {
    s0 = nm; s1 = nm;
#pragma unroll
    for (int ds = 0; ds < 4; ++ds) {
        const bf16x8 k0 = *(const bf16x8*)(lds + kof + swz(r32, ds * 2 + hi)), k1 = *(const bf16x8*)(lds + kof + swz(32 + r32, ds * 2 + hi));
        s0 = __builtin_amdgcn_mfma_f32_32x32x16_bf16(k0, qf[ds], s0, 0, 0, 0);
        s1 = __builtin_amdgcn_mfma_f32_32x32x16_bf16(k1, qf[ds], s1, 0, 0, 0);
    }
    float mx = fmaxf(s0[0], s1[0]);
#pragma unroll
    for (int r = 1; r < 16; ++r) mx = fmaxf(fmaxf(mx, s0[r]), s1[r]);
    mx = half_max(mx);
    if (first || __any(mx > ATT_THR)) {
        const float delta = first ? mx : fmaxf(mx, 0.f), alpha = first ? 0.f : __builtin_amdgcn_exp2f(-delta);
#pragma unroll
        for (int r = 0; r < 16; ++r) { s0[r] -= delta; s1[r] -= delta; nm[r] -= delta; ol[r] *= alpha; }
#pragma unroll
        for (int t = 0; t < NDB; ++t)
#pragma unroll
            for (int r = 0; r < 16; ++r) o[t][r] *= alpha;
    }
}
__device__ __forceinline__ void exp_pack(const f32x16& s, bf16x8& pa, bf16x8& pb) {
    float e[16];
#pragma unroll
    for (int r = 0; r < 16; ++r) e[r] = __builtin_amdgcn_exp2f(s[r]);
    u32x4 a = {cvt_pk(e[0], e[1]), cvt_pk(e[2], e[3]), cvt_pk(e[4], e[5]), cvt_pk(e[6], e[7])};
    u32x4 b = {cvt_pk(e[8], e[9]), cvt_pk(e[10], e[11]), cvt_pk(e[12], e[13]), cvt_pk(e[14], e[15])};
    pa = *(bf16x8*)&a; pb = *(bf16x8*)&b;
}

__device__ __forceinline__ void attn_diff_unit(const Params& p, char* lds_, int h, int qb, float lam) {
    LAS char* lds = (LAS char*)lds_;
    const int tid = threadIdx.x, lane = tid & 63, w = __builtin_amdgcn_readfirstlane(tid >> 6), r32 = lane & 31, hi = lane >> 5, mp = w >> 2, wq = w & 3;
    const bf16_t* proj = (const bf16_t*)(p.ws + WS_PROJ);
    const int NT = 2 * qb + 2, NP = NT / 2, myNT = (wq < 2) ? NT - 1 : NT;
    bf16x8 qf[4];
    { const bf16_t* qp = proj + (size_t)(qb * 128 + wq * 32 + r32) * INW + C_BQ + h * 128 + mp * 64 + hi * 8;
#pragma unroll
      for (int ds = 0; ds < 4; ++ds) qf[ds] = *(const bf16x8*)(qp + ds * 16); }
    asm volatile("" : "+v"(qf[0]), "+v"(qf[1]), "+v"(qf[2]), "+v"(qf[3]));
    f32x16 o[4] = {}; f32x16 ol = {}, nm = {};
    const char* gk = (const char*)(proj + (size_t)(w * 8 + (lane >> 3)) * INW + C_BK + h * 128) + g2_chunk_off(lane, w);
    const char* gv = (const char*)(proj + (size_t)(w * 8 + ((lane & 31) >> 2)) * INW + C_BV + h * 128 + (lane >> 5) * 32 + (lane & 3) * 8);
    const int vlane = ((lane & 3) << 3) | (((lane >> 2) & 3) << 6) | (((lane >> 4) & 1) << 5) | (((lane >> 5) & 1) << 8);
    constexpr size_t TSTEP = (size_t)64 * INW * 2;
#define A_STAGE(pr, sg) do { const char* k0_ = gk + (size_t)(pr) * 2 * TSTEP; const char* v0_ = gv + (size_t)(pr) * 2 * TSTEP; \
        _Pragma("unroll") for (int j = 0; j < 2; ++j) { \
            __builtin_amdgcn_global_load_lds((const unsigned*)(k0_ + j * TSTEP), (LAS unsigned*)(lds + (sg) * 65536 + (0 * 2 + j) * 8192 + w * 1024), 16, 0, 0); \
            __builtin_amdgcn_global_load_lds((const unsigned*)(k0_ + j * TSTEP + 128), (LAS unsigned*)(lds + (sg) * 65536 + (1 * 2 + j) * 8192 + w * 1024), 16, 0, 0); \
            __builtin_amdgcn_global_load_lds((const unsigned*)(v0_ + j * TSTEP), (LAS unsigned*)(lds + (sg) * 65536 + 32768 + j * 16384 + (2 * w) * 1024), 16, 0, 0); \
            __builtin_amdgcn_global_load_lds((const unsigned*)(v0_ + j * TSTEP + 128), (LAS unsigned*)(lds + (sg) * 65536 + 32768 + j * 16384 + (2 * w + 1) * 1024), 16, 0, 0); } } while (0)
    A_STAGE(0, 0);
    __syncthreads();
    bool first = true;
    for (int it = 0; it < NP; ++it) {
        const int sg = it & 1;
        if (it + 1 < NP) { if (sg) A_STAGE(it + 1, 0); else A_STAGE(it + 1, 1); }
#pragma unroll
        for (int jj = 0; jj < 2; ++jj) {
            const int j = jj, t = 2 * it + j;
            if (t < myNT) {
                bf16x8 p0, p1, p2, p3; f32x16 s0, s1;
                const int vb_ = (int)(uintptr_t)(lds_ + sg * 65536 + 32768 + j * 16384) + vlane;
                attn_scores<4>(lds_, sg * 65536 + (mp * 2 + j) * 8192, qf, s0, s1, o, ol, nm, first, r32, hi);
                first = false;
                exp_pack(s0, p0, p1); pv_half<4, 0>(o, ol, vb_, p0, p1); exp_pack(s1, p2, p3); pv_half<4, 1>(o, ol, vb_, p2, p3);
            }
        }
        __syncthreads();
    }
#undef A_STAGE
    float* xb = (float*)lds_;
    const float il = 1.0f / ol[0];
    if (mp == 1) {
        const float f = il * lam;
#pragma unroll
        for (int t = 0; t < 4; ++t)
#pragma unroll
            for (int r = 0; r < 16; ++r) xb[(wq * 64 + t * 16 + r) * 64 + lane] = o[t][r] * f;
    }
    __syncthreads();
    if (mp == 0) {
        float ss = 0.f;
#pragma unroll
        for (int t = 0; t < 4; ++t)
#pragma unroll
            for (int r = 0; r < 16; ++r) { const float v = o[t][r] * il - xb[(wq * 64 + t * 16 + r) * 64 + lane]; o[t][r] = v; ss += v * v; }
        ss = half_sum(ss);
        const float rs = rsqrtf(ss * (1.0f / 128.0f) + LN_EPS) * 0.8f;
        bf16_t* op = (bf16_t*)(p.ws + WS_ATT) + (size_t)(qb * 128 + wq * 32 + r32) * D + 512 + h * 128;
#pragma unroll
        for (int t = 0; t < 4; ++t)
#pragma unroll
            for (int rr = 0; rr < 4; ++rr) {
                const int dv0 = 32 * t + 8 * rr + 4 * hi;
                const f32x4 gg = *(const f32x4*)(p.subg + dv0);
                u32x2 pk = {cvt_pk(o[t][4 * rr] * rs * gg[0], o[t][4 * rr + 1] * rs * gg[1]), cvt_pk(o[t][4 * rr + 2] * rs * gg[2], o[t][4 * rr + 3] * rs * gg[3])};
                *(u32x2*)(op + dv0) = pk;
            }
    }
    __syncthreads();
}
__device__ __forceinline__ void attn_swa_unit(const Params& p, char* lds, int kvh, int n) {
    const int tid = threadIdx.x, lane = tid & 63, w = __builtin_amdgcn_readfirstlane(tid >> 6), r32 = lane & 31, hi = lane >> 5, g = w >> 1, hq = kvh * 4 + g;
    const bf16_t* proj = (const bf16_t*)(p.ws + WS_PROJ);
    const int c0 = (n >= 2) ? n - 2 : 0, NT = n - c0 + 1;
    const int tok = n * 64 + (w & 1) * 32 + r32;
    bf16x8 qf[4];
    { const bf16_t* qp = proj + (size_t)tok * INW + C_AQ + hq * 64 + hi * 8;
#pragma unroll
      for (int ds = 0; ds < 4; ++ds) qf[ds] = *(const bf16x8*)(qp + ds * 16); }
    f32x16 o[2] = {}; f32x16 ol, nm;
    { float ms = -p.sinks[hq] * LOG2E; asm volatile("" : "+v"(qf[0]), "+v"(qf[1]), "+v"(qf[2]), "+v"(qf[3]), "+v"(ms));
#pragma unroll
      for (int r = 0; r < 16; ++r) { nm[r] = ms; ol[r] = 1.0f; } }
    const bf16_t* gk = proj + (size_t)(c0 * 64 + (tid >> 3)) * INW + C_AK + kvh * 64 + (tid & 7) * 8;
    const bf16_t* gv = proj + (size_t)(c0 * 64 + (tid >> 3)) * INW + C_AV + kvh * 64 + (tid & 7) * 8;
    const int wk = swz(tid >> 3, tid & 7), wv = v_off(tid >> 3, (tid & 7) * 8, 2);
    const int vlane = ((lane & 3) << 3) | (((lane >> 2) & 3) << 6) | (((lane >> 4) & 1) << 5) | (((lane >> 5) & 1) << 8);
    u32x4 st0, st1;
#define W_LOAD(t) do { const size_t ko = (size_t)(t) * 64 * INW; st0 = *(const u32x4*)(gk + ko); st1 = *(const u32x4*)(gv + ko); } while (0)
#define W_WRITE(b) do { char* sb = lds + (b) * AT_STAGE; *(u32x4*)(sb + wk) = st0; *(u32x4*)(sb + 8192 + wv) = st1; } while (0)
    W_LOAD(0); W_WRITE(0); __syncthreads();
    for (int t = 0; t < NT; ++t) {
        const int b = t & 1;
        if (t + 1 < NT) W_LOAD(t + 1);
        { f32x16 s0, s1; bf16x8 p0, p1, p2, p3; const int vb_ = (int)(uintptr_t)(lds + b * AT_STAGE + 8192) + vlane;
          attn_scores<2>(lds, b * AT_STAGE, qf, s0, s1, o, ol, nm, false, r32, hi);
          exp_pack(s0, p0, p1); pv_half<2, 0>(o, ol, vb_, p0, p1); exp_pack(s1, p2, p3); pv_half<2, 1>(o, ol, vb_, p2, p3); }
        if (t + 1 < NT) W_WRITE(b ^ 1);
        __syncthreads();
    }
#undef W_LOAD
#undef W_WRITE
    const float il = 1.0f / ol[0];
    bf16_t* op = (bf16_t*)(p.ws + WS_ATT) + (size_t)tok * D + hq * 64;
#pragma unroll
    for (int t = 0; t < 2; ++t)
#pragma unroll
        for (int rr = 0; rr < 4; ++rr) {
            const int dv0 = 32 * t + 8 * rr + 4 * hi;
            u32x2 pk = {cvt_pk(o[t][4 * rr] * il, o[t][4 * rr + 1] * il), cvt_pk(o[t][4 * rr + 2] * il, o[t][4 * rr + 3] * il)};
            *(u32x2*)(op + dv0) = pk;
        }
}
__device__ __forceinline__ void phase_attn(const Params& p, char* lds, int vb, int G) {
    const int lane = threadIdx.x & 63;
    const float d1 = wave_sum(p.lq1[lane] * p.lk1[lane]), d2 = wave_sum(p.lq2[lane] * p.lk2[lane]);
    const float lam = expf(d1) - expf(d2) + 0.2f;
    for (int u = vb; u < 1024; u += G) {
        if (u < 256) attn_diff_unit(p, lds, u >> 6, 127 - (u & 63), lam);
        else if (u < 512) attn_diff_unit(p, lds, (u - 256) >> 6, (u - 256) & 63, lam);
        else attn_swa_unit(p, lds, (u - 512) >> 8, (u - 512) & 255);
    }
}

struct EpiPreLn {
    const float* x; float* out; int row0, col0;
    __device__ __forceinline__ void operator()(f32x4 (&acc)[8][4], int wr, int wc, int fr, int fq) const {
#pragma unroll
        for (int mt = 0; mt < 8; ++mt) {
            const size_t ro = (size_t)(row0 + wr * 128 + mt * 16 + fr) * D + col0 + wc * 64 + 4 * fq;
#pragma unroll
            for (int nt = 0; nt < 4; ++nt) { const f32x4 xv = *(const f32x4*)(x + ro + nt * 16); *(f32x4*)(out + ro + nt * 16) = xv * ALPHA + acc[mt][nt]; }
        }
    }
};
__device__ __forceinline__ void phase_wout(const Params& p, char* lds, int vb, int G) {
    for (int u = vb; u < (S / 256) * 4; u += G) {
        const int tm = u >> 2, tn = u & 3;
        G2Args g; g.A = (const char*)(p.ws + WS_ATT); g.B = (const char*)(p.ws + WS_WOUT); g.nk = D / 64; g.akstep = 128;
        g2_rows_A<8>(g, (size_t)tm * 256, D * 2); g2_rows_B(g, (size_t)tn * 256, D * 2);
        EpiPreLn e{p.x, (float*)(p.ws + WS_PRELN), tm * 256, tn * 256};
        gemm2<8>(lds, g, e);
    }
}

struct EpiLogits {
    float* L;
    __device__ __forceinline__ void operator()(f32x4 (&acc)[4][4], int wr, int wc, int fr, int fq) const {
#pragma unroll
        for (int mt = 0; mt < 4; ++mt)
#pragma unroll
            for (int nt = 0; nt < 4; ++nt) *(f32x4*)(L + (wr * 64 + mt * 16 + fr) * 256 + wc * 64 + nt * 16 + 4 * fq) = acc[mt][nt];
    }
};
__device__ __forceinline__ void phase_router(const Params& p, char* lds, int vb, int G) {
    const int tid = threadIdx.x, lane = tid & 63, w = tid >> 6;
    const float* preln = (const float*)(p.ws + WS_PRELN);
    bf16_t* x1b = (bf16_t*)(p.ws + WS_X1B);
    unsigned* cnt = (unsigned*)(p.ws + WS_CTL + 65536); int* list = (int*)(p.ws + WS_LIST); float* gates = (float*)(p.ws + WS_GATE);
    for (int u = vb; u < S / 64; u += G) {
        {
            f32x4 v[8][4]; float sm[8], sq[8];
#pragma unroll
            for (int i = 0; i < 8; ++i) { const f32x4* xr = (const f32x4*)(preln + (size_t)(u * 64 + w * 8 + i) * D) + lane;
#pragma unroll
                for (int j = 0; j < 4; ++j) v[i][j] = xr[64 * j]; }
#pragma unroll
            for (int i = 0; i < 8; ++i) { float s = 0.f;
#pragma unroll
                for (int j = 0; j < 4; ++j) s += (v[i][j][0] + v[i][j][1]) + (v[i][j][2] + v[i][j][3]);
                sm[i] = s; }
#pragma unroll
            for (int o = 1; o < 64; o <<= 1) {
#pragma unroll
                for (int i = 0; i < 8; ++i) sm[i] += __shfl_xor(sm[i], o); }
#pragma unroll
            for (int i = 0; i < 8; ++i) { const float mean = sm[i] * (1.0f / D); float s2 = 0.f;
#pragma unroll
                for (int j = 0; j < 4; ++j) { v[i][j] = v[i][j] - mean; s2 += (v[i][j][0] * v[i][j][0] + v[i][j][1] * v[i][j][1]) + (v[i][j][2] * v[i][j][2] + v[i][j][3] * v[i][j][3]); }
                sq[i] = s2; }
#pragma unroll
            for (int o = 1; o < 64; o <<= 1) {
#pragma unroll
                for (int i = 0; i < 8; ++i) sq[i] += __shfl_xor(sq[i], o); }
#pragma unroll
            for (int j = 0; j < 4; ++j) {
                const f32x4 gg = *((const f32x4*)p.ln1g + lane + 64 * j), bb = *((const f32x4*)p.ln1b + lane + 64 * j);
#pragma unroll
                for (int i = 0; i < 8; ++i) {
                    const int row = u * 64 + w * 8 + i;
                    const float rstd = rsqrtf(sq[i] * (1.0f / D) + LN_EPS);
                    const f32x4 y = v[i][j] * rstd * gg + bb;
                    u32x2 pk = {cvt_pk(y[0], y[1]), cvt_pk(y[2], y[3])};
                    *(u32x2*)(x1b + ((size_t)((lane >> 4) + 4 * j) * S + row) * 64 + ((4 * lane) & 63)) = pk;
                }
            }
        }
        asm volatile("s_waitcnt vmcnt(0)" ::: "memory");
        __syncthreads();
        { G2Args g; g.A = (const char*)x1b; g.B = (const char*)(p.ws + WS_WR); g.nk = D / 64; g.akstep = S * 128;
          g2_rows_A<4>(g, (size_t)u * 64, 128); g.offA[1] = g.offA[0]; g2_rows_B(g, 0, D * 2);
          EpiLogits e{(float*)lds};
          gemm2<4>(lds, g, e); }
        __syncthreads();
        const f32x4 rb = *((const f32x4*)p.r_bias + lane);
        const float NEG = -__builtin_inff();
        for (int i0 = 0; i0 < 8; i0 += 4) {
            float sc[4][4], cand[4][4]; int my_e[4]; float my_s[4], gsum[4];
#pragma unroll
            for (int q = 0; q < 4; ++q) {
                const int tl = w * 8 + i0 + q;
                const f32x4 lg = *((const f32x4*)((const float*)lds + tl * 256) + lane);
#pragma unroll
                for (int j = 0; j < 4; ++j) { sc[q][j] = 1.0f / (1.0f + __expf(-lg[j])); cand[q][j] = sc[q][j] + rb[j]; }
                my_e[q] = 0; my_s[q] = 0.f; gsum[q] = 0.f;
            }
            float a1[4], a2[4];
#pragma unroll
            for (int q = 0; q < 4; ++q) { const float m01 = fmaxf(cand[q][0], cand[q][1]), n01 = fminf(cand[q][0], cand[q][1]), m23 = fmaxf(cand[q][2], cand[q][3]), n23 = fminf(cand[q][2], cand[q][3]);
              a1[q] = fmaxf(m01, m23); a2[q] = fmaxf(fminf(m01, m23), fmaxf(n01, n23)); }
#pragma unroll
            for (int off = 1; off < 8; off <<= 1) {
#pragma unroll
                for (int q = 0; q < 4; ++q) { const float b1 = __shfl_xor(a1[q], off), b2 = __shfl_xor(a2[q], off); const float n1 = fmaxf(a1[q], b1), n2 = fmaxf(fminf(a1[q], b1), fmaxf(a2[q], b2)); a1[q] = n1; a2[q] = n2; }
            }
            const int mygrp = lane >> 3;
#pragma unroll
            for (int q = 0; q < 4; ++q) {
                const float gs = a1[q] + a2[q]; int rank = 0;
#pragma unroll
                for (int g2 = 0; g2 < 8; ++g2) { const float v = __shfl(gs, g2 * 8); rank += (v > gs || (v == gs && g2 < mygrp)) ? 1 : 0; }
                if (rank >= 4) {
#pragma unroll
                    for (int j = 0; j < 4; ++j) cand[q][j] = NEG;
                }
            }
#pragma unroll
            for (int k = 0; k < 8; ++k) {
                float bv[4]; int idx[4];
#pragma unroll
                for (int q = 0; q < 4; ++q) { bv[q] = cand[q][0]; int bi = 0;
#pragma unroll
                    for (int j = 1; j < 4; ++j) if (cand[q][j] > bv[q]) { bv[q] = cand[q][j]; bi = j; }
                    idx[q] = 4 * lane + bi; }
#pragma unroll
                for (int off = 32; off >= 1; off >>= 1) {
#pragma unroll
                    for (int q = 0; q < 4; ++q) { const float ov = __shfl_xor(bv[q], off); const int oi = __shfl_xor(idx[q], off); if (ov > bv[q] || (ov == bv[q] && oi < idx[q])) { bv[q] = ov; idx[q] = oi; } }
                }
#pragma unroll
                for (int q = 0; q < 4; ++q) {
                    const int owner = idx[q] >> 2, sub = idx[q] & 3;
                    float scv = sc[q][0];
#pragma unroll
                    for (int j = 1; j < 4; ++j) scv = (sub == j) ? sc[q][j] : scv;
                    if (lane == owner) {
#pragma unroll
                        for (int j = 0; j < 4; ++j) if (sub == j) cand[q][j] = NEG;
                    }
                    const float gsc = __shfl(scv, owner);
                    if (lane == k) { my_e[q] = idx[q]; my_s[q] = gsc; }
                    gsum[q] += gsc;
                }
            }
            if (lane < 8) {
#pragma unroll
                for (int q = 0; q < 4; ++q) {
                    const int t = u * 64 + w * 8 + i0 + q;
                    const float gate = my_s[q] / gsum[q] * 2.5f;
                    const unsigned pos = atomicAdd(cnt + my_e[q] * CNT_STRIDE, 1u);
                    list[(size_t)my_e[q] * CAP + pos] = t * 8 + lane;
                    gates[t * 8 + lane] = gate;
                }
            }
        }
        __syncthreads();
    }
}

#ifndef MOE_MT
#define MOE_MT 8
#endif
constexpr int MOE_BM = 32 * MOE_MT;
struct EpiAct {
    bf16_t* act; const int* slots;
    __device__ __forceinline__ void operator()(f32x4 (&acc)[MOE_MT][4], int pass, int wr, int wc, int fr, int fq) const {
        const int ncol0 = pass * 128;
#pragma unroll
        for (int mt = 0; mt < MOE_MT; ++mt) {
            const int ar = slots[wr * 16 * MOE_MT + mt * 16 + fr];
            if (ar >= 0) {
                float a[8];
#pragma unroll
                for (int nt = 0; nt < 2; ++nt)
#pragma unroll
                    for (int j = 0; j < 4; ++j) { const float gq = acc[mt][nt][j]; a[nt * 4 + j] = gq / (1.0f + __expf(-gq)) * (acc[mt][nt + 2][j]); }
                u32x4 pk = {cvt_pk(a[0], a[1]), cvt_pk(a[2], a[3]), cvt_pk(a[4], a[5]), cvt_pk(a[6], a[7])};
                *(u32x4*)(act + (size_t)ar * FF + ncol0 + wc * 32 + 8 * fq) = pk;
            }
        }
    }
};
struct EpiY {
    bf16_t* y; const int* yrows; const float* gl;
    __device__ __forceinline__ void operator()(f32x4 (&acc)[MOE_MT][4], int pass, int wr, int wc, int fr, int fq) const {
        const int col0 = pass * 256;
#pragma unroll
        for (int mt = 0; mt < MOE_MT; ++mt) {
            const int r = wr * 16 * MOE_MT + mt * 16 + fr, yr = yrows[r];
            if (yr >= 0) {
                const float gt = gl[r];
#pragma unroll
                for (int a = 0; a < 2; ++a) {
                    const f32x4 v0 = acc[mt][2 * a] * gt, v1 = acc[mt][2 * a + 1] * gt;
                    u32x4 pk = {cvt_pk(v0[0], v0[1]), cvt_pk(v0[2], v0[3]), cvt_pk(v1[0], v1[1]), cvt_pk(v1[2], v1[3])};
                    *(u32x4*)(y + (size_t)yr * D + col0 + wc * 64 + a * 32 + 8 * fq) = pk;
                }
            }
        }
    }
};
__device__ __forceinline__ void phase_experts(const Params& p, char* lds, int vb, int G) {
    const int tid0 = threadIdx.x, w = __builtin_amdgcn_readfirstlane(tid0 >> 6);
    const unsigned* cnt = (const unsigned*)(p.ws + WS_CTL + 65536); const int* list = (const int*)(p.ws + WS_LIST); const float* gates = (const float*)(p.ws + WS_GATE);
    bf16_t* act = (bf16_t*)(p.ws + WS_ACT); bf16_t* ybuf = (bf16_t*)(p.ws + WS_Y);
    int* nts = (int*)(lds + LDS_MISC); int* pre = nts + 256;
    int* s_arow = pre + 260; int* s_yrow = s_arow + MOE_BM; int* s_tok = s_yrow + MOE_BM; float* s_gate = (float*)(s_tok + MOE_BM);
    if (tid0 < 256) nts[tid0] = (int)((__hip_atomic_load(cnt + tid0 * CNT_STRIDE, __ATOMIC_RELAXED, __HIP_MEMORY_SCOPE_AGENT) + (MOE_BM - 1)) / MOE_BM);
    __syncthreads();
    if (tid0 < 257) { int s = 0; for (int e = 0; e < tid0; ++e) s += nts[e]; pre[tid0] = s; }
    __syncthreads();
    const int NR = __builtin_amdgcn_readfirstlane(pre[256]), NU = NR + S / MOE_BM;
    for (int u = vb; u < NU; u += G) {
        __syncthreads();
        int tid = threadIdx.x; asm volatile("" : "+v"(tid));
        const int lane = tid & 63; const unsigned co = g2_chunk_off(lane, w);
        const float *bg, *bu, *bd;
        if (u < NR) {
            int lo = 0, hi = 255;
            while (lo < hi) { const int mid = (lo + hi + 1) >> 1; if (pre[mid] <= u) lo = mid; else hi = mid - 1; }
            const int e = lo, tile = u - pre[e], n = (int)__hip_atomic_load(cnt + e * CNT_STRIDE, __ATOMIC_RELAXED, __HIP_MEMORY_SCOPE_AGENT);
            if (tid < MOE_BM) {
                const int idx = tile * MOE_BM + tid;
                if (idx < n) { const int slot = list[(size_t)e * CAP + idx]; s_arow[tid] = slot; s_yrow[tid] = slot + (slot >> 3); s_tok[tid] = slot >> 3; s_gate[tid] = gates[slot]; }
                else { s_arow[tid] = -1; s_yrow[tid] = -1; s_tok[tid] = 0; s_gate[tid] = 0.f; }
            }
            bg = p.w_g + (size_t)e * D * FF; bu = p.w_u + (size_t)e * D * FF; bd = p.w_d + (size_t)e * FF * D;
        } else {
            const int tile = u - NR;
            if (tid < MOE_BM) { const int tk = tile * MOE_BM + tid; s_arow[tid] = S * 8 + tk; s_yrow[tid] = tk * 9 + 8; s_tok[tid] = tk; s_gate[tid] = 1.0f; }
            bg = p.ws_g; bu = p.ws_u; bd = p.ws_d;
        }
        __syncthreads();
        { G3fArgs g; g.A = (const char*)(p.ws + WS_X1B); g.nk = D / 64; g.akstep = S * 128;
#pragma unroll
          for (int i = 0; i < MOE_MT / 2; ++i) g.offA[i] = (unsigned)s_tok[i * 64 + w * 8 + (lane >> 3)] * 128u + co;
          { const int bwc = lane >> 4, nt = (lane >> 2) & 3, bfq = lane & 3;
            g.b = ((nt < 2) ? bg : bu) + bwc * 32 + 8 * bfq + 4 * (nt & 1) + (size_t)(w * 8) * FF; }
          EpiAct e{act, s_arow};
          gemm3f<MOE_MT, FF>(lds, g, 2, 128, e); }
        asm volatile("s_waitcnt vmcnt(0)" ::: "memory");
        __syncthreads();
        { G3fArgs g; g.A = (const char*)act; g.nk = FF / 64; g.akstep = 128;
#pragma unroll
          for (int i = 0; i < MOE_MT / 2; ++i) { const int ar = s_arow[i * 64 + w * 8 + (lane >> 3)]; g.offA[i] = (unsigned)(ar < 0 ? 0 : ar) * (unsigned)(FF * 2) + co; }
          g.b = bd + (size_t)(w * 8) * D + (lane >> 4) * 64 + (((lane >> 2) & 3) >> 1) * 32 + 8 * (lane & 3) + 4 * ((lane >> 2) & 1);
          EpiY e{ybuf, s_yrow, s_gate};
          gemm3f<MOE_MT, D>(lds, g, 4, 256, e); }
    }
}

__device__ __forceinline__ void phase_final(const Params& p, int vb, int G) {
    const int lane = threadIdx.x & 63, w = threadIdx.x >> 6;
    const bf16_t* x1b = (const bf16_t*)(p.ws + WS_X1B); const bf16_t* ybuf = (const bf16_t*)(p.ws + WS_Y);
    constexpr int NR = 2;
    for (int row0 = (vb * 8 + w) * NR; row0 < S; row0 += G * 8 * NR) {
        float v[NR][2][8]; float sm[NR], sq[NR];
#pragma unroll
        for (int i = 0; i < NR; ++i) {
            const int row = row0 + i;
#pragma unroll
            for (int j = 0; j < 2; ++j) { const u32x4 q = *(const u32x4*)(x1b + ((size_t)((lane >> 3) + 8 * j) * S + row) * 64 + ((8 * lane) & 63));
#pragma unroll
                for (int e = 0; e < 4; ++e) { v[i][j][2 * e] = bf_lo(q[e]) * ALPHA; v[i][j][2 * e + 1] = bf_hi(q[e]) * ALPHA; } }
#pragma unroll
            for (int k = 0; k < 9; ++k) {
                const u32x4* yr = (const u32x4*)(ybuf + (size_t)(row * 9 + k) * D) + lane;
#pragma unroll
                for (int j = 0; j < 2; ++j) { const u32x4 q = yr[64 * j];
#pragma unroll
                    for (int e = 0; e < 4; ++e) { v[i][j][2 * e] += bf_lo(q[e]); v[i][j][2 * e + 1] += bf_hi(q[e]); } }
            }
        }
#pragma unroll
        for (int i = 0; i < NR; ++i) { float s = 0.f;
#pragma unroll
            for (int j = 0; j < 2; ++j)
#pragma unroll
                for (int e = 0; e < 8; ++e) s += v[i][j][e];
            sm[i] = s; }
#pragma unroll
        for (int o = 1; o < 64; o <<= 1) {
#pragma unroll
            for (int i = 0; i < NR; ++i) sm[i] += __shfl_xor(sm[i], o); }
#pragma unroll
        for (int i = 0; i < NR; ++i) { const float mean = sm[i] * (1.0f / D); float s2 = 0.f;
#pragma unroll
            for (int j = 0; j < 2; ++j)
#pragma unroll
                for (int e = 0; e < 8; ++e) { v[i][j][e] -= mean; s2 += v[i][j][e] * v[i][j][e]; }
            sq[i] = s2; }
#pragma unroll
        for (int o = 1; o < 64; o <<= 1) {
#pragma unroll
            for (int i = 0; i < NR; ++i) sq[i] += __shfl_xor(sq[i], o); }
#pragma unroll
        for (int j = 0; j < 2; ++j) {
            const f32x4 g0 = *((const f32x4*)p.ln2g + 2 * lane + 128 * j), g1 = *((const f32x4*)p.ln2g + 2 * lane + 128 * j + 1);
            const f32x4 b0 = *((const f32x4*)p.ln2b + 2 * lane + 128 * j), b1 = *((const f32x4*)p.ln2b + 2 * lane + 128 * j + 1);
#pragma unroll
            for (int i = 0; i < NR; ++i) { const float rstd = rsqrtf(sq[i] * (1.0f / D) + LN_EPS);
                f32x4* op = (f32x4*)(p.out + (size_t)(row0 + i) * D) + 2 * lane + 128 * j;
                op[0] = (f32x4){v[i][j][0], v[i][j][1], v[i][j][2], v[i][j][3]} * rstd * g0 + b0;
                op[1] = (f32x4){v[i][j][4], v[i][j][5], v[i][j][6], v[i][j][7]} * rstd * g1 + b1; }
        }
    }
}

__global__ void __launch_bounds__(NTHREADS) mega(Params p) {
    extern __shared__ __attribute__((aligned(16))) char lds[];
    const int G = gridDim.x, bx = blockIdx.x;
    const int vb = (G % 8 == 0) ? (bx % 8) * (G / 8) + bx / 8 : bx;
    if (threadIdx.x < 4) ((volatile LAS unsigned*)((LAS char*)lds + LDS_BARST))[threadIdx.x] = 0u;
    __syncthreads();
    XcdBarrier bar; bar.bar = (unsigned*)(p.ws + WS_CTL) + CW_BAR; bar.x = 0; bar.st = nullptr;
    if (p.ph_hi - p.ph_lo > 1) bar = xcd_barrier_post((unsigned*)(p.ws + WS_CTL) + CW_BAR, (volatile LAS unsigned*)((LAS char*)lds + LDS_BARST));
#define SEAM(k) do { if (p.ph_lo <= (k) && (k) + 1 < p.ph_hi) { xcd_barrier(bar); } } while (0)
#define IN(k) (p.ph_lo <= (k) && (k) < p.ph_hi)
#define RUN(k, call) do { if (IN(k)) { call; if (MK_REPEAT == (k)) { __syncthreads(); call; } } } while (0)
    RUN(0, phase_prep(p, vb, G)); SEAM(0);
    RUN(1, phase_proj(p, lds, vb, G)); SEAM(1);
    RUN(2, phase_attn(p, lds, vb, G)); SEAM(2);
    RUN(3, phase_wout(p, lds, vb, G)); SEAM(3);
    if (IN(4)) { phase_router(p, lds, vb, G); } SEAM(4);
    RUN(5, phase_experts(p, lds, vb, G)); SEAM(5);
    RUN(6, phase_final(p, vb, G));
#undef SEAM
#undef IN
#undef RUN
}

extern "C" void kernel_launch(void* const* d_in, const int* in_sizes, int n_in, void* d_out, int out_size, void* d_ws, size_t ws_size, hipStream_t stream) {
    static int grid = 0;
    if (grid == 0) {
        if (n_in != 22 || in_sizes[0] != S * D || out_size != S * D || ws_size < WS_END) {
            fprintf(stderr, "kernel_launch: unexpected shapes: n_in %d in0 %d out %d ws %zu (need %zu)\n", n_in, n_in > 0 ? in_sizes[0] : -1, out_size, ws_size, (size_t)WS_END); grid = -1; return; }
        int dev = 0, cus = 0, per_cu = 0;
        (void)hipGetDevice(&dev); (void)hipDeviceGetAttribute(&cus, hipDeviceAttributeMultiprocessorCount, dev);
        if (hipFuncSetAttribute((const void*)mega, hipFuncAttributeMaxDynamicSharedMemorySize, LDS_BYTES) != hipSuccess) { fprintf(stderr, "kernel_launch: hipFuncSetAttribute failed\n"); grid = -1; return; }
        (void)hipOccupancyMaxActiveBlocksPerMultiprocessor(&per_cu, (const void*)mega, NTHREADS, LDS_BYTES);
        if (per_cu < 1) { fprintf(stderr, "kernel_launch: occupancy query says %d blocks per CU\n", per_cu); per_cu = 1; }
        grid = cus * 1;
        (void)hipGetLastError();
    }
    if (grid < 0) return;
    (void)hipMemsetAsync((char*)d_ws + WS_CTL, 0, CTL_BYTES, stream);
    Params p{};
    const float** f = (const float**)&p;
    for (int i = 0; i < 22; ++i) f[i] = (const float*)d_in[i];
    p.out = (float*)d_out; p.ws = (unsigned char*)d_ws;
#if MK_ONE_LAUNCH
    p.ph_lo = 0; p.ph_hi = 7;
    void* args[] = {&p};
    hipError_t e = hipLaunchCooperativeKernel((const void*)mega, dim3(grid), dim3(NTHREADS), args, LDS_BYTES, stream);
    if (e != hipSuccess) fprintf(stderr, "kernel_launch: cooperative launch failed: %s (grid %d)\n", hipGetErrorString(e), grid);
#else
    for (int ph = 0; ph < 7; ++ph) {
        p.ph_lo = ph; p.ph_hi = ph + 1;
        hipLaunchKernelGGL(mega, dim3(grid), dim3(NTHREADS), LDS_BYTES, stream, p);
    }
#endif
}
```

```cpp
#include <hip/hip_runtime.h>
#include <hip/hip_cooperative_groups.h>
#include <cstdio>
#include <cstdint>
namespace cg = cooperative_groups;

#ifndef MK_REPEAT
#define MK_REPEAT -1
#endif
#ifndef MK_ONE_LAUNCH
#define MK_ONE_LAUNCH 1
#endif

constexpr int S = 16384, D = 1024, INW = 2304, NE = 256, FF = 256;
constexpr int NTHREADS = 512;
constexpr int CAP = 16384;
constexpr float ALPHA = 1.189207115002721f;
constexpr float LN_EPS = 1e-5f;
constexpr float QSCALE = 0.125f * 1.4426950408889634f;
constexpr float LOG2E = 1.4426950408889634f;
constexpr int C_AQ = 0, C_AK = 512, C_AV = 640, C_BQ = 768, C_BK = 1280, C_BV = 1792;

constexpr size_t MiB = 1ull << 20;
constexpr size_t WS_CTL = 0;
constexpr size_t CTL_BYTES = 128 * 1024;
constexpr int CNT_STRIDE = 64;
constexpr size_t WS_ROPE = 1 * MiB;
constexpr size_t WS_WIN = 8 * MiB;
constexpr size_t WS_WOUT = 13 * MiB;
constexpr size_t WS_WR = 15 * MiB;
constexpr size_t WS_WSGU = 16 * MiB;
constexpr size_t WS_WSD = 17 * MiB;
constexpr size_t WS_EGU = 20 * MiB;
constexpr size_t WS_ED = 276 * MiB;
constexpr size_t WS_X1F = 404 * MiB;
constexpr size_t WS_X1B = 468 * MiB;
constexpr size_t WS_LIST = 500 * MiB;
constexpr size_t WS_GATE = 516 * MiB;
constexpr size_t WS_ACT = 518 * MiB;
constexpr size_t WS_Y = 590 * MiB;
constexpr size_t WS_XB = 590 * MiB;
constexpr size_t WS_PROJ = 622 * MiB;
constexpr size_t WS_ATT = 694 * MiB;
constexpr size_t WS_PRELN = 726 * MiB;
constexpr size_t WS_END = 878 * MiB;

constexpr int LDS_BYTES = 147456;
constexpr int LDS_MISC = 131072;

typedef unsigned short bf16_t;
typedef short bf16x8 __attribute__((ext_vector_type(8)));
typedef short s16x4 __attribute__((ext_vector_type(4)));
typedef float f32x4 __attribute__((ext_vector_type(4)));
typedef float f32x16 __attribute__((ext_vector_type(16)));
typedef unsigned u32x4 __attribute__((ext_vector_type(4)));
typedef unsigned u32x2 __attribute__((ext_vector_type(2)));
typedef float f32x2 __attribute__((ext_vector_type(2)));


#define LAS __attribute__((address_space(3)))
#define XB_TMO      128
#define XB_XCNT(j)  (256  + 64 * (j))
#define XB_XSUB(j)  (1280 + 64 * (j))
#define XB_XGEN(j)  (2304 + 64 * (j))
#define XB_TOP      3328
#define XB_TOPGEN   3392
#define XCD_BAR_WORDS 3456
#define XB_SPIN_CAP (1u << 18)
__device__ __forceinline__ unsigned xb_ld(unsigned* p)              { return __hip_atomic_load(p, __ATOMIC_RELAXED, __HIP_MEMORY_SCOPE_AGENT); }
__device__ __forceinline__ unsigned xb_add(unsigned* p, unsigned v) { return __hip_atomic_fetch_add(p, v, __ATOMIC_RELAXED, __HIP_MEMORY_SCOPE_AGENT); }
__device__ __forceinline__ unsigned xb_xcc_id() { return (unsigned)__builtin_amdgcn_s_getreg((3 << 11) | 20) & 0xFu; }
#define XB_SPIN(cond, bar) do { unsigned _sp = 0; while (cond) { __builtin_amdgcn_s_sleep(1); \
    if ((++_sp & 255u) == 0u) { if (xb_ld(&(bar)[XB_TMO])) break; if (_sp > XB_SPIN_CAP) { atomicAdd(&(bar)[XB_TMO], 1u); break; } } } } while (0)
struct XcdBarrier { unsigned* bar; unsigned x; volatile LAS unsigned* st; };
__device__ __forceinline__ XcdBarrier xcd_barrier_post(unsigned* bar, volatile LAS unsigned* st) {
    XcdBarrier b; b.bar = bar; b.x = xb_xcc_id(); b.st = st;
    if (threadIdx.x == 0) (void)xb_add(&bar[XB_XCNT(b.x)], 1u);
    return b;
}
__device__ __forceinline__ void xcd_barrier_complete(unsigned* bar, unsigned x, unsigned& nloc, unsigned& nx) {
    const unsigned G = gridDim.x * gridDim.y * gridDim.z;
    unsigned sum, cnt, mine, sp = 0u;
    for (;;) {
        sum = 0u; cnt = 0u; mine = 0u;
#pragma unroll
        for (unsigned j = 0; j < 16; ++j) { const unsigned c = xb_ld(&bar[XB_XCNT(j)]); sum += c; cnt += (c > 0u) ? 1u : 0u; mine = (j == x) ? c : mine; }
        if (sum == G) break;
        __builtin_amdgcn_s_sleep(1);
        if ((++sp & 255u) == 0u) { if (xb_ld(&bar[XB_TMO])) break; if (sp > XB_SPIN_CAP) { atomicAdd(&bar[XB_TMO], 1u); break; } }
    }
    nloc = mine > 0u ? mine : 1u; nx = cnt > 0u ? cnt : 1u;
}
__device__ __forceinline__ void xcd_barrier(const XcdBarrier& b) {
    asm volatile("s_waitcnt vmcnt(0)" ::: "memory");
    __syncthreads();
    if (threadIdx.x == 0) {
        unsigned* bar = b.bar;
        __builtin_amdgcn_s_waitcnt(0);
        unsigned nloc = b.st[0], nx = b.st[1];
        if (nloc == 0u) { xcd_barrier_complete(bar, b.x, nloc, nx); b.st[0] = nloc; b.st[1] = nx; }
        const unsigned old = xb_add(&bar[XB_XSUB(b.x)], 1u);
        const unsigned gen = old / nloc;
        if (old + 1u == (gen + 1u) * nloc) {
            __builtin_amdgcn_fence(__ATOMIC_RELEASE, "agent");
            asm volatile("s_waitcnt vmcnt(0)" ::: "memory");
            const unsigned og = xb_add(&bar[XB_TOP], 1u);
            const unsigned tg = og / nx;
            if (og + 1u == (tg + 1u) * nx) xb_add(&bar[XB_TOPGEN], 1u);
            else XB_SPIN(xb_ld(&bar[XB_TOPGEN]) == tg, bar);
            __builtin_amdgcn_fence(__ATOMIC_ACQUIRE, "agent");
            xb_add(&bar[XB_XGEN(b.x)], 1u);
            asm volatile("s_waitcnt vmcnt(0)" ::: "memory");
        } else {
            XB_SPIN(xb_ld(&bar[XB_XGEN(b.x)]) == gen, bar);
            __builtin_amdgcn_fence(__ATOMIC_ACQUIRE, "agent");
            asm volatile("s_waitcnt vmcnt(0)" ::: "memory");
        }
    }
    __syncthreads();
}
constexpr int CW_BAR = 4096;
constexpr int LDS_BARST = LDS_MISC + 8192;

struct Params {
    const float* x; const float* w_in; const float* b_in; const float* sinks;
    const float* lq1; const float* lk1; const float* lq2; const float* lk2; const float* subg;
    const float* w_out; const float* ln1g; const float* ln1b; const float* w_r; const float* r_bias;
    const float* w_g; const float* w_u; const float* w_d; const float* ws_g; const float* ws_u; const float* ws_d;
    const float* ln2g; const float* ln2b;
    float* out; unsigned char* ws;
    int ph_lo, ph_hi;
};

__device__ __forceinline__ unsigned cvt_pk(float lo, float hi) { unsigned r; asm volatile("v_cvt_pk_bf16_f32 %0, %1, %2" : "=v"(r) : "v"(lo), "v"(hi)); return r; }
__device__ __forceinline__ float bf_lo(unsigned u) { return __uint_as_float(u << 16); }
__device__ __forceinline__ float bf_hi(unsigned u) { return __uint_as_float(u & 0xffff0000u); }
__device__ __forceinline__ float wave_sum(float v) {
#pragma unroll
    for (int o = 1; o < 64; o <<= 1) v += __shfl_xor(v, o);
    return v;
}
__device__ __forceinline__ float half_max(float v) { auto rr = __builtin_amdgcn_permlane32_swap(__float_as_uint(v), __float_as_uint(v), false, false); return fmaxf(__uint_as_float(rr[0]), __uint_as_float(rr[1])); }
__device__ __forceinline__ float half_sum(float v) { auto rr = __builtin_amdgcn_permlane32_swap(__float_as_uint(v), __float_as_uint(v), false, false); return __uint_as_float(rr[0]) + __uint_as_float(rr[1]); }

__device__ __forceinline__ int swz(int r, int c) { const int f = (r & 7) ^ (((r >> 3) & 1) << 1) ^ ((r >> 4) & 1); return r * 128 + ((c ^ f) << 4); }

struct G2Args {
    const char* A; const char* B;
    unsigned offA[4], offB[4];
    int nk;
    unsigned akstep;
};
__device__ __forceinline__ unsigned g2_chunk_off(int lane, int w) { const int f = (lane >> 3) ^ ((w & 1) << 1) ^ ((w >> 1) & 1); return (unsigned)(((lane & 7) ^ f) << 4); }
template <int MT, int NT, class Epi>
__device__ __forceinline__ void gemm2n(char* lds_, const G2Args& g, const Epi& epi) {
    constexpr int A_BYTES = 32 * MT * 128, B_BYTES = 64 * NT * 128, STAGE = A_BYTES + B_BYTES, AR = MT / 2, BRR = NT;
    LAS char* lds = (LAS char*)lds_;
    const int tid = threadIdx.x, lane = tid & 63, w = __builtin_amdgcn_readfirstlane(tid >> 6), wr = w >> 2, wc = w & 3, fr = lane & 15, fq = lane >> 4;
    f32x4 acc[MT][NT];
#pragma unroll
    for (int i = 0; i < MT; ++i)
#pragma unroll
        for (int j = 0; j < NT; ++j) acc[i][j] = (f32x4){0.f, 0.f, 0.f, 0.f};
    const int ldsw = w * 1024;
#define G2_STAGE(kt, s) do { \
        _Pragma("unroll") for (int i = 0; i < AR; ++i) __builtin_amdgcn_global_load_lds((const unsigned*)(g.A + g.offA[i] + (size_t)(kt) * g.akstep), (LAS unsigned*)(lds + (s) * STAGE + i * 8192 + ldsw), 16, 0, 0); \
        _Pragma("unroll") for (int i = 0; i < BRR; ++i) __builtin_amdgcn_global_load_lds((const unsigned*)(g.B + g.offB[i] + (size_t)(kt) * 128), (LAS unsigned*)(lds + (s) * STAGE + A_BYTES + i * 8192 + ldsw), 16, 0, 0); } while (0)
    G2_STAGE(0, 0);
    __syncthreads();
    for (int kt = 0; kt < g.nk; ++kt) {
        const int s = kt & 1;
        if (kt + 1 < g.nk) { if (s) G2_STAGE(kt + 1, 0); else G2_STAGE(kt + 1, 1); }
        const char* la = lds_ + s * STAGE; const char* lb = la + A_BYTES;
        {
            constexpr int NG = 2 * (MT / 4);
            bf16x8 bfr[NT], af[2][4];
#pragma unroll
            for (int nt = 0; nt < NT; ++nt) bfr[nt] = *(const bf16x8*)(lb + swz(wc * 16 * NT + nt * 16 + fr, fq));
#pragma unroll
            for (int m = 0; m < 4; ++m) af[0][m] = *(const bf16x8*)(la + swz(wr * 16 * MT + m * 16 + fr, fq));
#pragma unroll
            for (int gi = 0; gi < NG; ++gi) {
                const int ks = gi / (MT / 4), h = gi % (MT / 4);
                if (gi > 0 && h == 0) {
#pragma unroll
                    for (int nt = 0; nt < NT; ++nt) bfr[nt] = *(const bf16x8*)(lb + swz(wc * 16 * NT + nt * 16 + fr, ks * 4 + fq));
                }
                if (gi + 1 < NG) {
                    const int ks2 = (gi + 1) / (MT / 4), h2 = (gi + 1) % (MT / 4);
#pragma unroll
                    for (int m = 0; m < 4; ++m) af[(gi + 1) & 1][m] = *(const bf16x8*)(la + swz(wr * 16 * MT + (h2 * 4 + m) * 16 + fr, ks2 * 4 + fq));
                }
                __builtin_amdgcn_sched_barrier(0);
#pragma unroll
                for (int m = 0; m < 4; ++m)
#pragma unroll
                    for (int nt = 0; nt < NT; ++nt) acc[h * 4 + m][nt] = __builtin_amdgcn_mfma_f32_16x16x32_bf16(bfr[nt], af[gi & 1][m], acc[h * 4 + m][nt], 0, 0, 0);
                __builtin_amdgcn_sched_barrier(0);
            }
        }
        __syncthreads();
    }
#undef G2_STAGE
    epi(acc, wr, wc, fr, fq);
}
template <int MT, class Epi>
__device__ __forceinline__ void gemm2(char* lds_, const G2Args& g, const Epi& epi) { gemm2n<MT, 4>(lds_, g, epi); }
template <int MT>
__device__ __forceinline__ void g2_rows_A(G2Args& g, size_t row0, unsigned ld_bytes) {
    const int lane = threadIdx.x & 63, w = __builtin_amdgcn_readfirstlane(threadIdx.x >> 6); const unsigned co = g2_chunk_off(lane, w);
#pragma unroll
    for (int i = 0; i < MT / 2; ++i) g.offA[i] = (unsigned)((row0 + i * 64 + w * 8 + (lane >> 3)) * ld_bytes) + co;
}
__device__ __forceinline__ void g2_rows_B(G2Args& g, size_t row0, unsigned ld_bytes) {
    const int lane = threadIdx.x & 63, w = __builtin_amdgcn_readfirstlane(threadIdx.x >> 6); const unsigned co = g2_chunk_off(lane, w);
#pragma unroll
    for (int i = 0; i < 4; ++i) g.offB[i] = (unsigned)((row0 + i * 64 + w * 8 + (lane >> 3)) * ld_bytes) + co;
}


struct G3fArgs { const char* A; unsigned offA[4]; const float* b; int nk; unsigned akstep; };
template <int MT, int LDB, class Epi>
__device__ __forceinline__ void gemm3f(char* lds_, const G3fArgs& g, int npass, int bpstep, const Epi& epi) {
    constexpr int A_BYTES = 32 * MT * 128, B_BYTES = 256 * 128, STAGE = A_BYTES + B_BYTES, AR = MT / 2;
    LAS char* lds = (LAS char*)lds_;
    const int tid = threadIdx.x, lane = tid & 63, w = __builtin_amdgcn_readfirstlane(tid >> 6), wr = w >> 2, wc = w & 3, fr = lane & 15, fq = lane >> 4;
    f32x4 acc[MT][4];
#pragma unroll
    for (int i = 0; i < MT; ++i)
#pragma unroll
        for (int j = 0; j < 4; ++j) acc[i][j] = (f32x4){0.f, 0.f, 0.f, 0.f};
    const int ldsw = w * 1024;
    int bw[4];
#pragma unroll
    for (int j = 0; j < 4; ++j) bw[j] = swz(4 * lane + j, w);
    f32x4 br[8];
    const int nk = g.nk, nsteps = nk * npass;
#define G3_STAGE_A(kt, s) do { \
        _Pragma("unroll") for (int i = 0; i < AR; ++i) __builtin_amdgcn_global_load_lds((const unsigned*)(g.A + g.offA[i] + (size_t)(kt) * g.akstep), (LAS unsigned*)(lds + (s) * STAGE + i * 8192 + ldsw), 16, 0, 0); } while (0)
#define G3_LOAD_B(ps, kt) do { const float* pb_ = g.b + (size_t)(ps) * bpstep + (size_t)(kt) * 64 * LDB; _Pragma("unroll") for (int i = 0; i < 8; ++i) br[i] = *(const f32x4*)(pb_ + i * LDB); } while (0)
#define G3_WRITE_B(s) do { _Pragma("unroll") for (int j = 0; j < 4; ++j) { \
            u32x4 v = {cvt_pk(br[0][j], br[1][j]), cvt_pk(br[2][j], br[3][j]), cvt_pk(br[4][j], br[5][j]), cvt_pk(br[6][j], br[7][j])}; \
            *(u32x4*)(lds_ + (s) * STAGE + A_BYTES + bw[j]) = v; } } while (0)
    G3_STAGE_A(0, 0); G3_LOAD_B(0, 0); G3_WRITE_B(0);
    __syncthreads();
    int ps = 0, kt = 0;
    for (int st = 0; st < nsteps; ++st) {
        const int s = st & 1; const bool more = st + 1 < nsteps;
        int ps2 = ps, kt2 = kt + 1; if (kt2 == nk) { kt2 = 0; ++ps2; }
        if (more) { if (s) G3_STAGE_A(kt2, 0); else G3_STAGE_A(kt2, 1); G3_LOAD_B(ps2, kt2); }
        __builtin_amdgcn_sched_barrier(0);
        const char* la = lds_ + s * STAGE; const char* lb = la + A_BYTES;
#pragma unroll
        for (int ks = 0; ks < 2; ++ks) {
            bf16x8 bfr[4];
#pragma unroll
            for (int nt = 0; nt < 4; ++nt) bfr[nt] = *(const bf16x8*)(lb + swz(wc * 64 + nt * 16 + fr, ks * 4 + fq));
#pragma unroll
            for (int h = 0; h < MT / 2; ++h) {
                bf16x8 af[2];
#pragma unroll
                for (int m = 0; m < 2; ++m) af[m] = *(const bf16x8*)(la + swz(wr * 16 * MT + (h * 2 + m) * 16 + fr, ks * 4 + fq));
                __builtin_amdgcn_sched_barrier(0);
#pragma unroll
                for (int m = 0; m < 2; ++m)
#pragma unroll
                    for (int nt = 0; nt < 4; ++nt) acc[h * 2 + m][nt] = __builtin_amdgcn_mfma_f32_16x16x32_bf16(bfr[nt], af[m], acc[h * 2 + m][nt], 0, 0, 0);
                __builtin_amdgcn_sched_barrier(0);
            }
        }
        if (kt == nk - 1) {
            epi(acc, ps, wr, wc, fr, fq);
#pragma unroll
            for (int i = 0; i < MT; ++i)
#pragma unroll
                for (int j = 0; j < 4; ++j) acc[i][j] = (f32x4){0.f, 0.f, 0.f, 0.f};
        }
        if (more) { if (s) G3_WRITE_B(0); else G3_WRITE_B(1); }
        __syncthreads();
        ps = ps2; kt = kt2;
    }
#undef G3_STAGE_A
#undef G3_LOAD_B
#undef G3_WRITE_B
}

__device__ __forceinline__ void cvt_item(const float* W, int K, int N, bf16_t* WT, int ldt, int kb, int nb, int kc, int lane) {
    const float* src = W + (size_t)(kb * 64 + kc * 8) * N + nb * 256 + 4 * lane;
    bf16_t* dst = WT + (size_t)(nb * 256 + 4 * lane) * ldt + kb * 64 + kc * 8;
    f32x4 r[8];
#pragma unroll
    for (int i = 0; i < 8; ++i) r[i] = *(const f32x4*)(src + (size_t)i * N);
#pragma unroll
    for (int j = 0; j < 4; ++j) {
        u32x4 v = {cvt_pk(r[0][j], r[1][j]), cvt_pk(r[2][j], r[3][j]), cvt_pk(r[4][j], r[5][j]), cvt_pk(r[6][j], r[7][j])};
        *(u32x4*)(dst + (size_t)j * ldt) = v;
    }
}
__device__ __forceinline__ void phase_prep(const Params& p, int vb, int G) {
    const int tid = threadIdx.x, lane = tid & 63, w = tid >> 6;
    float* cs = (float*)(p.ws + WS_ROPE); float* sn = cs + (size_t)S * 32;
    for (int idx = vb * NTHREADS + tid; idx < S * 32; idx += G * NTHREADS) {
        const int pos = idx >> 5, i = idx & 31;
        const float pw = (float)pow(10000.0, (double)i / 32.0);
        const float inv = 1.0f / pw;
        const float angf = __fmul_rn((float)pos, inv);
        const double a = (double)angf;
        const double q = rint(a * 0.63661977236758134308);
        double r = fma(-q, 1.57079632679489655800, a); r = fma(-q, 6.12323399573676603587e-17, r);
        const double r2 = r * r;
        double sp = r * (1.0 + r2 * (-1.0 / 6 + r2 * (1.0 / 120 + r2 * (-1.0 / 5040 + r2 * (1.0 / 362880 + r2 * (-1.0 / 39916800))))));
        double cp = 1.0 + r2 * (-0.5 + r2 * (1.0 / 24 + r2 * (-1.0 / 720 + r2 * (1.0 / 40320 + r2 * (-1.0 / 3628800 + r2 * (1.0 / 479001600))))));
        const int qi = ((int)((long long)q)) & 3;
        double sv, cv;
        if (qi == 0) { sv = sp; cv = cp; } else if (qi == 1) { sv = cp; cv = -sp; } else if (qi == 2) { sv = -sp; cv = -cp; } else { sv = -cp; cv = sp; }
        cs[idx] = (float)cv; sn[idx] = (float)sv;
    }
    { const f32x4* xs = (const f32x4*)p.x; u32x4* xd = (u32x4*)(p.ws + WS_XB);
      for (size_t i = (size_t)vb * NTHREADS + tid; i < (size_t)S * D / 8; i += (size_t)G * NTHREADS) {
          const f32x4 a = xs[2 * i], b = xs[2 * i + 1];
          xd[i] = (u32x4){cvt_pk(a[0], a[1]), cvt_pk(a[2], a[3]), cvt_pk(b[0], b[1]), cvt_pk(b[2], b[3])}; } }
    const int gw = vb * 8 + w, NGW = G * 8;
    constexpr int I_IN = 16 * 9, I_OUT = 16 * 4, I_R = 16, I_SG = 16, I_SU = 16, I_SD = 4 * 4, I_SMALL = I_IN + I_OUT + I_R;
    for (int it8 = gw; it8 < I_SMALL * 8; it8 += NGW) {
        int r = it8 >> 3; const int kc = it8 & 7;
        if (r < I_IN) { cvt_item(p.w_in, D, INW, (bf16_t*)(p.ws + WS_WIN), D, r / 9, r % 9, kc, lane); continue; } r -= I_IN;
        if (r < I_OUT) { cvt_item(p.w_out, D, D, (bf16_t*)(p.ws + WS_WOUT), D, r >> 2, r & 3, kc, lane); continue; } r -= I_OUT;
        cvt_item(p.w_r, D, NE, (bf16_t*)(p.ws + WS_WR), D, r, 0, kc, lane);
    }
}

template <int MT> struct EpiProj {
    const float* bias; const float* cs; const float* sn; bf16_t* out; int row0, col0;
    __device__ __forceinline__ void operator()(f32x4 (&acc)[MT][4], int wr, int wc, int fr, int fq) const {
        const int hb = col0 + wc * 64;
        const bool is_q = (hb < C_AK) || (hb >= C_BQ && hb < C_BK);
        const bool is_rope = is_q || (hb >= C_AK && hb < C_AV) || (hb >= C_BK && hb < C_BV);
        const float sc = is_q ? QSCALE : 1.0f;
#pragma unroll
        for (int mt = 0; mt < MT; ++mt) {
            const int row = row0 + wr * 16 * MT + mt * 16 + fr;
            f32x4 v[4];
#pragma unroll
            for (int nt = 0; nt < 4; ++nt) v[nt] = acc[mt][nt] + *(const f32x4*)(bias + hb + nt * 16 + 4 * fq);
            if (is_rope) {
#pragma unroll
                for (int nt = 0; nt < 2; ++nt) {
                    const f32x4 c = *(const f32x4*)(cs + (size_t)row * 32 + nt * 16 + 4 * fq), s = *(const f32x4*)(sn + (size_t)row * 32 + nt * 16 + 4 * fq);
                    const f32x4 t1 = v[nt], t2 = v[nt + 2];
                    v[nt] = t1 * c - t2 * s; v[nt + 2] = t2 * c + t1 * s;
                }
            }
#pragma unroll
            for (int nt = 0; nt < 4; ++nt) {
                const f32x4 o = v[nt] * sc;
                u32x2 pk = {cvt_pk(o[0], o[1]), cvt_pk(o[2], o[3])};
                *(u32x2*)(out + (size_t)row * INW + hb + nt * 16 + 4 * fq) = pk;
            }
        }
    }
};
struct EpiProjQ {
    const float* bias; const float* cs; const float* sn; bf16_t* out; int row0, col0;
    __device__ __forceinline__ void operator()(f32x4 (&acc)[4][2], int wr, int wc, int fr, int fq) const {
        const int hb = col0 + (wc >> 1) * 64, i0 = (wc & 1) * 16 + 4 * fq;
        const bool is_q = (hb < C_AK) || (hb >= C_BQ && hb < C_BK);
        const bool is_rope = is_q || (hb >= C_AK && hb < C_AV) || (hb >= C_BK && hb < C_BV);
        const float sc = is_q ? QSCALE : 1.0f;
#pragma unroll
        for (int mt = 0; mt < 4; ++mt) {
            const int row = row0 + wr * 64 + mt * 16 + fr;
            f32x4 v0 = acc[mt][0] + *(const f32x4*)(bias + hb + i0), v1 = acc[mt][1] + *(const f32x4*)(bias + hb + 32 + i0);
            if (is_rope) {
                const f32x4 c = *(const f32x4*)(cs + (size_t)row * 32 + i0), s = *(const f32x4*)(sn + (size_t)row * 32 + i0);
                const f32x4 t1 = v0, t2 = v1; v0 = t1 * c - t2 * s; v1 = t2 * c + t1 * s;
            }
            v0 = v0 * sc; v1 = v1 * sc;
            *(u32x2*)(out + (size_t)row * INW + hb + i0) = (u32x2){cvt_pk(v0[0], v0[1]), cvt_pk(v0[2], v0[3])};
            *(u32x2*)(out + (size_t)row * INW + hb + 32 + i0) = (u32x2){cvt_pk(v1[0], v1[1]), cvt_pk(v1[2], v1[3])};
        }
    }
};
__device__ __forceinline__ void phase_proj(const Params& p, char* lds, int vb, int G) {
    const float* cs = (const float*)(p.ws + WS_ROPE); const float* sn = cs + (size_t)S * 32;
    constexpr int NBIG = 512, NUNITS = NBIG + 4 * 64;
    for (int u = vb; u < NUNITS; u += G) {
        G2Args g; g.A = (const char*)(p.ws + WS_XB); g.B = (const char*)(p.ws + WS_WIN); g.nk = D / 64; g.akstep = 128;
        if (u < NBIG) {
            const int tm = u / 9, tn = u % 9;
            g2_rows_A<8>(g, (size_t)tm * 256, D * 2); g2_rows_B(g, (size_t)tn * 256, D * 2);
            EpiProj<8> e{p.b_in, cs, sn, (bf16_t*)(p.ws + WS_PROJ), tm * 256, tn * 256};
            gemm2<8>(lds, g, e);
        } else {
            const int q = u - NBIG, t = NBIG + (q >> 2), hm = (q >> 1) & 1, hn = q & 1, tm = t / 9, tn = t % 9;
            g2_rows_A<4>(g, (size_t)tm * 256 + hm * 128, D * 2);
            { const int lane = threadIdx.x & 63, w = __builtin_amdgcn_readfirstlane(threadIdx.x >> 6); const unsigned co = g2_chunk_off(lane, w);
#pragma unroll
              for (int i = 0; i < 2; ++i) { const int n = i * 64 + w * 8 + (lane >> 3), wcn = n >> 5, sub = n & 31;
                  const int col = tn * 256 + hn * 128 + (wcn >> 1) * 64 + (wcn & 1) * 16 + (sub & 15) + (sub >> 4) * 32;
                  g.offB[i] = (unsigned)col * (unsigned)(D * 2) + co; } }
            EpiProjQ e{p.b_in, cs, sn, (bf16_t*)(p.ws + WS_PROJ), tm * 256 + hm * 128, tn * 256 + hn * 128};
            gemm2n<4, 2>(lds, g, e);
        }
    }
}

template <int OFF> __device__ __forceinline__ s16x4 tr_read(int vb) { s16x4 r; asm volatile("ds_read_b64_tr_b16 %0, %1 offset:%2" : "=&v"(r) : "v"(vb), "i"(OFF) : "memory"); return r; }
__device__ __forceinline__ int v_off(int k, int c, int ndb) { return ((k >> 3) * ndb + (c >> 5)) * 512 + ((k & 7) * 32 + (c & 31)) * 2; }

constexpr int AT_STAGE = 32768;
template <int NDB, int KB, int T> struct PvPart {
    static __device__ __forceinline__ void run(f32x16& o, int vbase, const bf16x8& pa, const bf16x8& pb) {
        constexpr int o0 = (KB * 4 * NDB + T) * 512, st = NDB * 512;
        const s16x4 l0 = tr_read<o0 + 0 * st>(vbase), h0 = tr_read<o0 + 1 * st>(vbase), l1 = tr_read<o0 + 2 * st>(vbase), h1 = tr_read<o0 + 3 * st>(vbase);
        asm volatile("s_waitcnt lgkmcnt(0)" ::: "memory"); __builtin_amdgcn_sched_barrier(0);
#define PKV(L, H) (bf16x8){L[0], L[1], L[2], L[3], H[0], H[1], H[2], H[3]}
        o = __builtin_amdgcn_mfma_f32_32x32x16_bf16(PKV(l0, h0), pa, o, 0, 0, 0);
        o = __builtin_amdgcn_mfma_f32_32x32x16_bf16(PKV(l1, h1), pb, o, 0, 0, 0);
#undef PKV
    }
};
template <int NDB, int KB>
__device__ __forceinline__ void pv_half(f32x16 (&o)[NDB], f32x16& ol, int vbase, const bf16x8& pa, const bf16x8& pb) {
    const bf16x8 ones = {16256, 16256, 16256, 16256, 16256, 16256, 16256, 16256};
    ol = __builtin_amdgcn_mfma_f32_32x32x16_bf16(ones, pa, ol, 0, 0, 0);
    ol = __builtin_amdgcn_mfma_f32_32x32x16_bf16(ones, pb, ol, 0, 0, 0);
    PvPart<NDB, KB, 0>::run(o[0], vbase, pa, pb); PvPart<NDB, KB, 1>::run(o[1], vbase, pa, pb);
    if constexpr (NDB == 4) { PvPart<NDB, KB, 2>::run(o[2], vbase, pa, pb); PvPart<NDB, KB, 3>::run(o[3], vbase, pa, pb); }
}
constexpr float ATT_THR = 10.0f;
template <int NDB>
__device__ __forceinline__ void attn_scores(char* lds, int kof, const bf16x8 (&qf)[4], f32x16& s0, f32x16& s1, f32x16 (&o)[NDB], f32x16& ol, f32x16& nm, bool first, int r32, int hi) {
    s0 = nm; s1 = nm;
#pragma unroll
    for (int ds = 0; ds < 4; ++ds) {
        const bf16x8 k0 = *(const bf16x8*)(lds + kof + swz(r32, ds * 2 + hi)), k1 = *(const bf16x8*)(lds + kof + swz(32 + r32, ds * 2 + hi));
        s0 = __builtin_amdgcn_mfma_f32_32x32x16_bf16(k0, qf[ds], s0, 0, 0, 0);
        s1 = __builtin_amdgcn_mfma_f32_32x32x16_bf16(k1, qf[ds], s1, 0, 0, 0);
    }
    float mx = fmaxf(s0[0], s1[0]);
#pragma unroll
    for (int r = 1; r < 16; ++r) mx = fmaxf(fmaxf(mx, s0[r]), s1[r]);
    mx = half_max(mx);
    if (first || __any(mx > ATT_THR)) {
        const float delta = first ? mx : fmaxf(mx, 0.f), alpha = first ? 0.f : __builtin_amdgcn_exp2f(-delta);
#pragma unroll
        for (int r = 0; r < 16; ++r) { s0[r] -= delta; s1[r] -= delta; nm[r] -= delta; ol[r] *= alpha; }
#pragma unroll
        for (int t = 0; t < NDB; ++t)
#pragma unroll
            for (int r = 0; r < 16; ++r) o[t][r] *= alpha;
    }
}
__device__ __forceinline__ void exp_pack(const f32x16& s, bf16x8& pa, bf16x8& pb) {
    float e[16];
#pragma unroll
    for (int r = 0; r < 16; ++r) e[r] = __builtin_amdgcn_exp2f(s[r]);
    u32x4 a = {cvt_pk(e[0], e[1]), cvt_pk(e[2], e[3]), cvt_pk(e[4], e[5]), cvt_pk(e[6], e[7])};
    u32x4 b = {cvt_pk(e[8], e[9]), cvt_pk(e[10], e[11]), cvt_pk(e[12], e[13]), cvt_pk(e[14], e[15])};
    pa = *(bf16x8*)&a; pb = *(bf16x8*)&b;
}

__device__ __forceinline__ void attn_diff_unit(const Params& p, char* lds_, int h, int qb, float lam) {
    LAS char* lds = (LAS char*)lds_;
    const int tid = threadIdx.x, lane = tid & 63, w = __builtin_amdgcn_readfirstlane(tid >> 6), r32 = lane & 31, hi = lane >> 5, mp = w >> 2, wq = w & 3;
    const bf16_t* proj = (const bf16_t*)(p.ws + WS_PROJ);
    const int NT = 2 * qb + 2, NP = NT / 2, myNT = (wq < 2) ? NT - 1 : NT;
    bf16x8 qf[4];
    { const bf16_t* qp = proj + (size_t)(qb * 128 + wq * 32 + r32) * INW + C_BQ + h * 128 + mp * 64 + hi * 8;
#pragma unroll
      for (int ds = 0; ds < 4; ++ds) qf[ds] = *(const bf16x8*)(qp + ds * 16); }
    asm volatile("" : "+v"(qf[0]), "+v"(qf[1]), "+v"(qf[2]), "+v"(qf[3]));
    f32x16 o[4] = {}; f32x16 ol = {}, nm = {};
    const char* gk = (const char*)(proj + (size_t)(w * 8 + (lane >> 3)) * INW + C_BK + h * 128) + g2_chunk_off(lane, w);
    const char* gv = (const char*)(proj + (size_t)(w * 8 + ((lane & 31) >> 2)) * INW + C_BV + h * 128 + (lane >> 5) * 32 + (lane & 3) * 8);
    const int vlane = ((lane & 3) << 3) | (((lane >> 2) & 3) << 6) | (((lane >> 4) & 1) << 5) | (((lane >> 5) & 1) << 8);
    constexpr size_t TSTEP = (size_t)64 * INW * 2;
#define A_STAGE(pr, sg) do { const char* k0_ = gk + (size_t)(pr) * 2 * TSTEP; const char* v0_ = gv + (size_t)(pr) * 2 * TSTEP; \
        _Pragma("unroll") for (int j = 0; j < 2; ++j) { \
            __builtin_amdgcn_global_load_lds((const unsigned*)(k0_ + j * TSTEP), (LAS unsigned*)(lds + (sg) * 65536 + (0 * 2 + j) * 8192 + w * 1024), 16, 0, 0); \
            __builtin_amdgcn_global_load_lds((const unsigned*)(k0_ + j * TSTEP + 128), (LAS unsigned*)(lds + (sg) * 65536 + (1 * 2 + j) * 8192 + w * 1024), 16, 0, 0); \
            __builtin_amdgcn_global_load_lds((const unsigned*)(v0_ + j * TSTEP), (LAS unsigned*)(lds + (sg) * 65536 + 32768 + j * 16384 + (2 * w) * 1024), 16, 0, 0); \
            __builtin_amdgcn_global_load_lds((const unsigned*)(v0_ + j * TSTEP + 128), (LAS unsigned*)(lds + (sg) * 65536 + 32768 + j * 16384 + (2 * w + 1) * 1024), 16, 0, 0); } } while (0)
    A_STAGE(0, 0);
    __syncthreads();
    bool first = true;
    for (int it = 0; it < NP; ++it) {
        const int sg = it & 1;
        if (it + 1 < NP) { if (sg) A_STAGE(it + 1, 0); else A_STAGE(it + 1, 1); }
#pragma unroll
        for (int jj = 0; jj < 2; ++jj) {
            const int j = jj, t = 2 * it + j;
            if (t < myNT) {
                bf16x8 p0, p1, p2, p3; f32x16 s0, s1;
                const int vb_ = (int)(uintptr_t)(lds_ + sg * 65536 + 32768 + j * 16384) + vlane;
                attn_scores<4>(lds_, sg * 65536 + (mp * 2 + j) * 8192, qf, s0, s1, o, ol, nm, first, r32, hi);
                first = false;
                exp_pack(s0, p0, p1); pv_half<4, 0>(o, ol, vb_, p0, p1); exp_pack(s1, p2, p3); pv_half<4, 1>(o, ol, vb_, p2, p3);
            }
        }
        __syncthreads();
    }
#undef A_STAGE
    float* xb = (float*)lds_;
    const float il = 1.0f / ol[0];
    if (mp == 1) {
        const float f = il * lam;
#pragma unroll
        for (int t = 0; t < 4; ++t)
#pragma unroll
            for (int r = 0; r < 16; ++r) xb[(wq * 64 + t * 16 + r) * 64 + lane] = o[t][r] * f;
    }
    __syncthreads();
    if (mp == 0) {
        float ss = 0.f;
#pragma unroll
        for (int t = 0; t < 4; ++t)
#pragma unroll
            for (int r = 0; r < 16; ++r) { const float v = o[t][r] * il - xb[(wq * 64 + t * 16 + r) * 64 + lane]; o[t][r] = v; ss += v * v; }
        ss = half_sum(ss);
        const float rs = rsqrtf(ss * (1.0f / 128.0f) + LN_EPS) * 0.8f;
        bf16_t* op = (bf16_t*)(p.ws + WS_ATT) + (size_t)(qb * 128 + wq * 32 + r32) * D + 512 + h * 128;
#pragma unroll
        for (int t = 0; t < 4; ++t)
#pragma unroll
            for (int rr = 0; rr < 4; ++rr) {
                const int dv0 = 32 * t + 8 * rr + 4 * hi;
                const f32x4 gg = *(const f32x4*)(p.subg + dv0);
                u32x2 pk = {cvt_pk(o[t][4 * rr] * rs * gg[0], o[t][4 * rr + 1] * rs * gg[1]), cvt_pk(o[t][4 * rr + 2] * rs * gg[2], o[t][4 * rr + 3] * rs * gg[3])};
                *(u32x2*)(op + dv0) = pk;
            }
    }
    __syncthreads();
}
__device__ __forceinline__ void attn_swa_unit(const Params& p, char* lds, int kvh, int n) {
    const int tid = threadIdx.x, lane = tid & 63, w = __builtin_amdgcn_readfirstlane(tid >> 6), r32 = lane & 31, hi = lane >> 5, g = w >> 1, hq = kvh * 4 + g;
    const bf16_t* proj = (const bf16_t*)(p.ws + WS_PROJ);
    const int c0 = (n >= 2) ? n - 2 : 0, NT = n - c0 + 1;
    const int tok = n * 64 + (w & 1) * 32 + r32;
    bf16x8 qf[4];
    { const bf16_t* qp = proj + (size_t)tok * INW + C_AQ + hq * 64 + hi * 8;
#pragma unroll
      for (int ds = 0; ds < 4; ++ds) qf[ds] = *(const bf16x8*)(qp + ds * 16); }
    f32x16 o[2] = {}; f32x16 ol, nm;
    { float ms = -p.sinks[hq] * LOG2E; asm volatile("" : "+v"(qf[0]), "+v"(qf[1]), "+v"(qf[2]), "+v"(qf[3]), "+v"(ms));
#pragma unroll
      for (int r = 0; r < 16; ++r) { nm[r] = ms; ol[r] = 1.0f; } }
    const bf16_t* gk = proj + (size_t)(c0 * 64 + (tid >> 3)) * INW + C_AK + kvh * 64 + (tid & 7) * 8;
    const bf16_t* gv = proj + (size_t)(c0 * 64 + (tid >> 3)) * INW + C_AV + kvh * 64 + (tid & 7) * 8;
    const int wk = swz(tid >> 3, tid & 7), wv = v_off(tid >> 3, (tid & 7) * 8, 2);
    const int vlane = ((lane & 3) << 3) | (((lane >> 2) & 3) << 6) | (((lane >> 4) & 1) << 5) | (((lane >> 5) & 1) << 8);
    u32x4 st0, st1;
#define W_LOAD(t) do { const size_t ko = (size_t)(t) * 64 * INW; st0 = *(const u32x4*)(gk + ko); st1 = *(const u32x4*)(gv + ko); } while (0)
#define W_WRITE(b) do { char* sb = lds + (b) * AT_STAGE; *(u32x4*)(sb + wk) = st0; *(u32x4*)(sb + 8192 + wv) = st1; } while (0)
    W_LOAD(0); W_WRITE(0); __syncthreads();
    for (int t = 0; t < NT; ++t) {
        const int b = t & 1;
        if (t + 1 < NT) W_LOAD(t + 1);
        { f32x16 s0, s1; bf16x8 p0, p1, p2, p3; const int vb_ = (int)(uintptr_t)(lds + b * AT_STAGE + 8192) + vlane;
          attn_scores<2>(lds, b * AT_STAGE, qf, s0, s1, o, ol, nm, false, r32, hi);
          exp_pack(s0, p0, p1); pv_half<2, 0>(o, ol, vb_, p0, p1); exp_pack(s1, p2, p3); pv_half<2, 1>(o, ol, vb_, p2, p3); }
        if (t + 1 < NT) W_WRITE(b ^ 1);
        __syncthreads();
    }
#undef W_LOAD
#undef W_WRITE
    const float il = 1.0f / ol[0];
    bf16_t* op = (bf16_t*)(p.ws + WS_ATT) + (size_t)tok * D + hq * 64;
#pragma unroll
    for (int t = 0; t < 2; ++t)
#pragma unroll
        for (int rr = 0; rr < 4; ++rr) {
            const int dv0 = 32 * t + 8 * rr + 4 * hi;
            u32x2 pk = {cvt_pk(o[t][4 * rr] * il, o[t][4 * rr + 1] * il), cvt_pk(o[t][4 * rr + 2] * il, o[t][4 * rr + 3] * il)};
            *(u32x2*)(op + dv0) = pk;
        }
}
__device__ __forceinline__ void phase_attn(const Params& p, char* lds, int vb, int G) {
    const int lane = threadIdx.x & 63;
    const float d1 = wave_sum(p.lq1[lane] * p.lk1[lane]), d2 = wave_sum(p.lq2[lane] * p.lk2[lane]);
    const float lam = expf(d1) - expf(d2) + 0.2f;
    for (int u = vb; u < 1024; u += G) {
        if (u < 256) attn_diff_unit(p, lds, u >> 6, 127 - (u & 63), lam);
        else if (u < 512) attn_diff_unit(p, lds, (u - 256) >> 6, (u - 256) & 63, lam);
        else attn_swa_unit(p, lds, (u - 512) >> 8, (u - 512) & 255);
    }
}

struct EpiPreLn {
    const float* x; float* out; int row0, col0;
    __device__ __forceinline__ void operator()(f32x4 (&acc)[8][4], int wr, int wc, int fr, int fq) const {
#pragma unroll
        for (int mt = 0; mt < 8; ++mt) {
            const size_t ro = (size_t)(row0 + wr * 128 + mt * 16 + fr) * D + col0 + wc * 64 + 4 * fq;
#pragma unroll
            for (int nt = 0; nt < 4; ++nt) { const f32x4 xv = *(const f32x4*)(x + ro + nt * 16); *(f32x4*)(out + ro + nt * 16) = xv * ALPHA + acc[mt][nt]; }
        }
    }
};
__device__ __forceinline__ void phase_wout(const Params& p, char* lds, int vb, int G) {
    for (int u = vb; u < (S / 256) * 4; u += G) {
        const int tm = u >> 2, tn = u & 3;
        G2Args g; g.A = (const char*)(p.ws + WS_ATT); g.B = (const char*)(p.ws + WS_WOUT); g.nk = D / 64; g.akstep = 128;
        g2_rows_A<8>(g, (size_t)tm * 256, D * 2); g2_rows_B(g, (size_t)tn * 256, D * 2);
        EpiPreLn e{p.x, (float*)(p.ws + WS_PRELN), tm * 256, tn * 256};
        gemm2<8>(lds, g, e);
    }
}

struct EpiLogits {
    float* L;
    __device__ __forceinline__ void operator()(f32x4 (&acc)[4][4], int wr, int wc, int fr, int fq) const {
#pragma unroll
        for (int mt = 0; mt < 4; ++mt)
#pragma unroll
            for (int nt = 0; nt < 4; ++nt) *(f32x4*)(L + (wr * 64 + mt * 16 + fr) * 256 + wc * 64 + nt * 16 + 4 * fq) = acc[mt][nt];
    }
};
__device__ __forceinline__ void phase_router(const Params& p, char* lds, int vb, int G) {
    const int tid = threadIdx.x, lane = tid & 63, w = tid >> 6;
    const float* preln = (const float*)(p.ws + WS_PRELN);
    bf16_t* x1b = (bf16_t*)(p.ws + WS_X1B);
    unsigned* cnt = (unsigned*)(p.ws + WS_CTL + 65536); int* list = (int*)(p.ws + WS_LIST); float* gates = (float*)(p.ws + WS_GATE);
    for (int u = vb; u < S / 64; u += G) {
        {
            f32x4 v[8][4]; float sm[8], sq[8];
#pragma unroll
            for (int i = 0; i < 8; ++i) { const f32x4* xr = (const f32x4*)(preln + (size_t)(u * 64 + w * 8 + i) * D) + lane;
#pragma unroll
                for (int j = 0; j < 4; ++j) v[i][j] = xr[64 * j]; }
#pragma unroll
            for (int i = 0; i < 8; ++i) { float s = 0.f;
#pragma unroll
                for (int j = 0; j < 4; ++j) s += (v[i][j][0] + v[i][j][1]) + (v[i][j][2] + v[i][j][3]);
                sm[i] = s; }
#pragma unroll
            for (int o = 1; o < 64; o <<= 1) {
#pragma unroll
                for (int i = 0; i < 8; ++i) sm[i] += __shfl_xor(sm[i], o); }
#pragma unroll
            for (int i = 0; i < 8; ++i) { const float mean = sm[i] * (1.0f / D); float s2 = 0.f;
#pragma unroll
                for (int j = 0; j < 4; ++j) { v[i][j] = v[i][j] - mean; s2 += (v[i][j][0] * v[i][j][0] + v[i][j][1] * v[i][j][1]) + (v[i][j][2] * v[i][j][2] + v[i][j][3] * v[i][j][3]); }
                sq[i] = s2; }
#pragma unroll
            for (int o = 1; o < 64; o <<= 1) {
#pragma unroll
                for (int i = 0; i < 8; ++i) sq[i] += __shfl_xor(sq[i], o); }
#pragma unroll
            for (int j = 0; j < 4; ++j) {
                const f32x4 gg = *((const f32x4*)p.ln1g + lane + 64 * j), bb = *((const f32x4*)p.ln1b + lane + 64 * j);
#pragma unroll
                for (int i = 0; i < 8; ++i) {
                    const int row = u * 64 + w * 8 + i;
                    const float rstd = rsqrtf(sq[i] * (1.0f / D) + LN_EPS);
                    const f32x4 y = v[i][j] * rstd * gg + bb;
                    u32x2 pk = {cvt_pk(y[0], y[1]), cvt_pk(y[2], y[3])};
                    *(u32x2*)(x1b + ((size_t)((lane >> 4) + 4 * j) * S + row) * 64 + ((4 * lane) & 63)) = pk;
                }
            }
        }
        asm volatile("s_waitcnt vmcnt(0)" ::: "memory");
        __syncthreads();
        { G2Args g; g.A = (const char*)x1b; g.B = (const char*)(p.ws + WS_WR); g.nk = D / 64; g.akstep = S * 128;
          g2_rows_A<4>(g, (size_t)u * 64, 128); g.offA[1] = g.offA[0]; g2_rows_B(g, 0, D * 2);
          EpiLogits e{(float*)lds};
          gemm2<4>(lds, g, e); }
        __syncthreads();
        const f32x4 rb = *((const f32x4*)p.r_bias + lane);
        const float NEG = -__builtin_inff();
        for (int i0 = 0; i0 < 8; i0 += 4) {
            float sc[4][4], cand[4][4]; int my_e[4]; float my_s[4], gsum[4];
#pragma unroll
            for (int q = 0; q < 4; ++q) {
                const int tl = w * 8 + i0 + q;
                const f32x4 lg = *((const f32x4*)((const float*)lds + tl * 256) + lane);
#pragma unroll
                for (int j = 0; j < 4; ++j) { sc[q][j] = 1.0f / (1.0f + __expf(-lg[j])); cand[q][j] = sc[q][j] + rb[j]; }
                my_e[q] = 0; my_s[q] = 0.f; gsum[q] = 0.f;
            }
            float a1[4], a2[4];
#pragma unroll
            for (int q = 0; q < 4; ++q) { const float m01 = fmaxf(cand[q][0], cand[q][1]), n01 = fminf(cand[q][0], cand[q][1]), m23 = fmaxf(cand[q][2], cand[q][3]), n23 = fminf(cand[q][2], cand[q][3]);
              a1[q] = fmaxf(m01, m23); a2[q] = fmaxf(fminf(m01, m23), fmaxf(n01, n23)); }
#pragma unroll
            for (int off = 1; off < 8; off <<= 1) {
#pragma unroll
                for (int q = 0; q < 4; ++q) { const float b1 = __shfl_xor(a1[q], off), b2 = __shfl_xor(a2[q], off); const float n1 = fmaxf(a1[q], b1), n2 = fmaxf(fminf(a1[q], b1), fmaxf(a2[q], b2)); a1[q] = n1; a2[q] = n2; }
            }
            const int mygrp = lane >> 3;
#pragma unroll
            for (int q = 0; q < 4; ++q) {
                const float gs = a1[q] + a2[q]; int rank = 0;
#pragma unroll
                for (int g2 = 0; g2 < 8; ++g2) { const float v = __shfl(gs, g2 * 8); rank += (v > gs || (v == gs && g2 < mygrp)) ? 1 : 0; }
                if (rank >= 4) {
#pragma unroll
                    for (int j = 0; j < 4; ++j) cand[q][j] = NEG;
                }
            }
#pragma unroll
            for (int k = 0; k < 8; ++k) {
                float bv[4]; int idx[4];
#pragma unroll
                for (int q = 0; q < 4; ++q) { bv[q] = cand[q][0]; int bi = 0;
#pragma unroll
                    for (int j = 1; j < 4; ++j) if (cand[q][j] > bv[q]) { bv[q] = cand[q][j]; bi = j; }
                    idx[q] = 4 * lane + bi; }
#pragma unroll
                for (int off = 32; off >= 1; off >>= 1) {
#pragma unroll
                    for (int q = 0; q < 4; ++q) { const float ov = __shfl_xor(bv[q], off); const int oi = __shfl_xor(idx[q], off); if (ov > bv[q] || (ov == bv[q] && oi < idx[q])) { bv[q] = ov; idx[q] = oi; } }
                }
#pragma unroll
                for (int q = 0; q < 4; ++q) {
                    const int owner = idx[q] >> 2, sub = idx[q] & 3;
                    float scv = sc[q][0];
#pragma unroll
                    for (int j = 1; j < 4; ++j) scv = (sub == j) ? sc[q][j] : scv;
                    if (lane == owner) {
#pragma unroll
                        for (int j = 0; j < 4; ++j) if (sub == j) cand[q][j] = NEG;
                    }
                    const float gsc = __shfl(scv, owner);
                    if (lane == k) { my_e[q] = idx[q]; my_s[q] = gsc; }
                    gsum[q] += gsc;
                }
            }
            if (lane < 8) {
#pragma unroll
                for (int q = 0; q < 4; ++q) {
                    const int t = u * 64 + w * 8 + i0 + q;
                    const float gate = my_s[q] / gsum[q] * 2.5f;
                    const unsigned pos = atomicAdd(cnt + my_e[q] * CNT_STRIDE, 1u);
                    list[(size_t)my_e[q] * CAP + pos] = t * 8 + lane;
                    gates[t * 8 + lane] = gate;
                }
            }
        }
        __syncthreads();
    }
}

#ifndef MOE_MT
#define MOE_MT 8
#endif
constexpr int MOE_BM = 32 * MOE_MT;
struct EpiAct {
    bf16_t* act; const int* slots;
    __device__ __forceinline__ void operator()(f32x4 (&acc)[MOE_MT][4], int pass, int wr, int wc, int fr, int fq) const {
        const int ncol0 = pass * 128;
#pragma unroll
        for (int mt = 0; mt < MOE_MT; ++mt) {
            const int ar = slots[wr * 16 * MOE_MT + mt * 16 + fr];
            if (ar >= 0) {
                float a[8];
#pragma unroll
                for (int nt = 0; nt < 2; ++nt)
#pragma unroll
                    for (int j = 0; j < 4; ++j) { const float gq = acc[mt][nt][j]; a[nt * 4 + j] = gq / (1.0f + __expf(-gq)) * (acc[mt][nt + 2][j]); }
                u32x4 pk = {cvt_pk(a[0], a[1]), cvt_pk(a[2], a[3]), cvt_pk(a[4], a[5]), cvt_pk(a[6], a[7])};
                *(u32x4*)(act + (size_t)ar * FF + ncol0 + wc * 32 + 8 * fq) = pk;
            }
        }
    }
};
struct EpiY {
    bf16_t* y; const int* yrows; const float* gl;
    __device__ __forceinline__ void operator()(f32x4 (&acc)[MOE_MT][4], int pass, int wr, int wc, int fr, int fq) const {
        const int col0 = pass * 256;
#pragma unroll
        for (int mt = 0; mt < MOE_MT; ++mt) {
            const int r = wr * 16 * MOE_MT + mt * 16 + fr, yr = yrows[r];
            if (yr >= 0) {
                const float gt = gl[r];
#pragma unroll
                for (int a = 0; a < 2; ++a) {
                    const f32x4 v0 = acc[mt][2 * a] * gt, v1 = acc[mt][2 * a + 1] * gt;
                    u32x4 pk = {cvt_pk(v0[0], v0[1]), cvt_pk(v0[2], v0[3]), cvt_pk(v1[0], v1[1]), cvt_pk(v1[2], v1[3])};
                    *(u32x4*)(y + (size_t)yr * D + col0 + wc * 64 + a * 32 + 8 * fq) = pk;
                }
            }
        }
    }
};
__device__ __forceinline__ void phase_experts(const Params& p, char* lds, int vb, int G) {
    const int tid0 = threadIdx.x, w = __builtin_amdgcn_readfirstlane(tid0 >> 6);
    const unsigned* cnt = (const unsigned*)(p.ws + WS_CTL + 65536); const int* list = (const int*)(p.ws + WS_LIST); const float* gates = (const float*)(p.ws + WS_GATE);
    bf16_t* act = (bf16_t*)(p.ws + WS_ACT); bf16_t* ybuf = (bf16_t*)(p.ws + WS_Y);
    int* nts = (int*)(lds + LDS_MISC); int* pre = nts + 256;
    int* s_arow = pre + 260; int* s_yrow = s_arow + MOE_BM; int* s_tok = s_yrow + MOE_BM; float* s_gate = (float*)(s_tok + MOE_BM);
    if (tid0 < 256) nts[tid0] = (int)((__hip_atomic_load(cnt + tid0 * CNT_STRIDE, __ATOMIC_RELAXED, __HIP_MEMORY_SCOPE_AGENT) + (MOE_BM - 1)) / MOE_BM);
    __syncthreads();
    if (tid0 < 257) { int s = 0; for (int e = 0; e < tid0; ++e) s += nts[e]; pre[tid0] = s; }
    __syncthreads();
    const int NR = __builtin_amdgcn_readfirstlane(pre[256]), NU = NR + S / MOE_BM;
    for (int u = vb; u < NU; u += G) {
        __syncthreads();
        int tid = threadIdx.x; asm volatile("" : "+v"(tid));
        const int lane = tid & 63; const unsigned co = g2_chunk_off(lane, w);
        const float *bg, *bu, *bd;
        if (u < NR) {
            int lo = 0, hi = 255;
            while (lo < hi) { const int mid = (lo + hi + 1) >> 1; if (pre[mid] <= u) lo = mid; else hi = mid - 1; }
            const int e = lo, tile = u - pre[e], n = (int)__hip_atomic_load(cnt + e * CNT_STRIDE, __ATOMIC_RELAXED, __HIP_MEMORY_SCOPE_AGENT);
            if (tid < MOE_BM) {
                const int idx = tile * MOE_BM + tid;
                if (idx < n) { const int slot = list[(size_t)e * CAP + idx]; s_arow[tid] = slot; s_yrow[tid] = slot + (slot >> 3); s_tok[tid] = slot >> 3; s_gate[tid] = gates[slot]; }
                else { s_arow[tid] = -1; s_yrow[tid] = -1; s_tok[tid] = 0; s_gate[tid] = 0.f; }
            }
            bg = p.w_g + (size_t)e * D * FF; bu = p.w_u + (size_t)e * D * FF; bd = p.w_d + (size_t)e * FF * D;
        } else {
            const int tile = u - NR;
            if (tid < MOE_BM) { const int tk = tile * MOE_BM + tid; s_arow[tid] = S * 8 + tk; s_yrow[tid] = tk * 9 + 8; s_tok[tid] = tk; s_gate[tid] = 1.0f; }
            bg = p.ws_g; bu = p.ws_u; bd = p.ws_d;
        }
        __syncthreads();
        { G3fArgs g; g.A = (const char*)(p.ws + WS_X1B); g.nk = D / 64; g.akstep = S * 128;
#pragma unroll
          for (int i = 0; i < MOE_MT / 2; ++i) g.offA[i] = (unsigned)s_tok[i * 64 + w * 8 + (lane >> 3)] * 128u + co;
          { const int bwc = lane >> 4, nt = (lane >> 2) & 3, bfq = lane & 3;
            g.b = ((nt < 2) ? bg : bu) + bwc * 32 + 8 * bfq + 4 * (nt & 1) + (size_t)(w * 8) * FF; }
          EpiAct e{act, s_arow};
          gemm3f<MOE_MT, FF>(lds, g, 2, 128, e); }
        asm volatile("s_waitcnt vmcnt(0)" ::: "memory");
        __syncthreads();
        { G3fArgs g; g.A = (const char*)act; g.nk = FF / 64; g.akstep = 128;
#pragma unroll
          for (int i = 0; i < MOE_MT / 2; ++i) { const int ar = s_arow[i * 64 + w * 8 + (lane >> 3)]; g.offA[i] = (unsigned)(ar < 0 ? 0 : ar) * (unsigned)(FF * 2) + co; }
          g.b = bd + (size_t)(w * 8) * D + (lane >> 4) * 64 + (((lane >> 2) & 3) >> 1) * 32 + 8 * (lane & 3) + 4 * ((lane >> 2) & 1);
          EpiY e{ybuf, s_yrow, s_gate};
          gemm3f<MOE_MT, D>(lds, g, 4, 256, e); }
    }
}

__device__ __forceinline__ void phase_final(const Params& p, int vb, int G) {
    const int lane = threadIdx.x & 63, w = threadIdx.x >> 6;
    const bf16_t* x1b = (const bf16_t*)(p.ws + WS_X1B); const bf16_t* ybuf = (const bf16_t*)(p.ws + WS_Y);
    constexpr int NR = 2;
    for (int row0 = (vb * 8 + w) * NR; row0 < S; row0 += G * 8 * NR) {
        float v[NR][2][8]; float sm[NR], sq[NR];
#pragma unroll
        for (int i = 0; i < NR; ++i) {
            const int row = row0 + i;
#pragma unroll
            for (int j = 0; j < 2; ++j) { const u32x4 q = *(const u32x4*)(x1b + ((size_t)((lane >> 3) + 8 * j) * S + row) * 64 + ((8 * lane) & 63));
#pragma unroll
                for (int e = 0; e < 4; ++e) { v[i][j][2 * e] = bf_lo(q[e]) * ALPHA; v[i][j][2 * e + 1] = bf_hi(q[e]) * ALPHA; } }
#pragma unroll
            for (int k = 0; k < 9; ++k) {
                const u32x4* yr = (const u32x4*)(ybuf + (size_t)(row * 9 + k) * D) + lane;
#pragma unroll
                for (int j = 0; j < 2; ++j) { const u32x4 q = yr[64 * j];
#pragma unroll
                    for (int e = 0; e < 4; ++e) { v[i][j][2 * e] += bf_lo(q[e]); v[i][j][2 * e + 1] += bf_hi(q[e]); } }
            }
        }
#pragma unroll
        for (int i = 0; i < NR; ++i) { float s = 0.f;
#pragma unroll
            for (int j = 0; j < 2; ++j)
#pragma unroll
                for (int e = 0; e < 8; ++e) s += v[i][j][e];
            sm[i] = s; }
#pragma unroll
        for (int o = 1; o < 64; o <<= 1) {
#pragma unroll
            for (int i = 0; i < NR; ++i) sm[i] += __shfl_xor(sm[i], o); }
#pragma unroll
        for (int i = 0; i < NR; ++i) { const float mean = sm[i] * (1.0f / D); float s2 = 0.f;
#pragma unroll
            for (int j = 0; j < 2; ++j)
#pragma unroll
                for (int e = 0; e < 8; ++e) { v[i][j][e] -= mean; s2 += v[i][j][e] * v[i][j][e]; }
            sq[i] = s2; }
#pragma unroll
        for (int o = 1; o < 64; o <<= 1) {
#pragma unroll
            for (int i = 0; i < NR; ++i) sq[i] += __shfl_xor(sq[i], o); }
#pragma unroll
        for (int j = 0; j < 2; ++j) {
            const f32x4 g0 = *((const f32x4*)p.ln2g + 2 * lane + 128 * j), g1 = *((const f32x4*)p.ln2g + 2 * lane + 128 * j + 1);
            const f32x4 b0 = *((const f32x4*)p.ln2b + 2 * lane + 128 * j), b1 = *((const f32x4*)p.ln2b + 2 * lane + 128 * j + 1);
#pragma unroll
            for (int i = 0; i < NR; ++i) { const float rstd = rsqrtf(sq[i] * (1.0f / D) + LN_EPS);
                f32x4* op = (f32x4*)(p.out + (size_t)(row0 + i) * D) + 2 * lane + 128 * j;
                op[0] = (f32x4){v[i][j][0], v[i][j][1], v[i][j][2], v[i][j][3]} * rstd * g0 + b0;
                op[1] = (f32x4){v[i][j][4], v[i][j][5], v[i][j][6], v[i][j][7]} * rstd * g1 + b1; }
        }
    }
}

__global__ void __launch_bounds__(NTHREADS) mega(Params p) {
    extern __shared__ __attribute__((aligned(16))) char lds[];
    const int G = gridDim.x, bx = blockIdx.x;
    const int vb = (G % 8 == 0) ? (bx % 8) * (G / 8) + bx / 8 : bx;
    if (threadIdx.x < 4) ((volatile LAS unsigned*)((LAS char*)lds + LDS_BARST))[threadIdx.x] = 0u;
    __syncthreads();
    XcdBarrier bar; bar.bar = (unsigned*)(p.ws + WS_CTL) + CW_BAR; bar.x = 0; bar.st = nullptr;
    if (p.ph_hi - p.ph_lo > 1) bar = xcd_barrier_post((unsigned*)(p.ws + WS_CTL) + CW_BAR, (volatile LAS unsigned*)((LAS char*)lds + LDS_BARST));
#define SEAM(k) do { if (p.ph_lo <= (k) && (k) + 1 < p.ph_hi) { xcd_barrier(bar); } } while (0)
#define IN(k) (p.ph_lo <= (k) && (k) < p.ph_hi)
#define RUN(k, call) do { if (IN(k)) { call; if (MK_REPEAT == (k)) { __syncthreads(); call; } } } while (0)
    RUN(0, phase_prep(p, vb, G)); SEAM(0);
    RUN(1, phase_proj(p, lds, vb, G)); SEAM(1);
    RUN(2, phase_attn(p, lds, vb, G)); SEAM(2);
    RUN(3, phase_wout(p, lds, vb, G)); SEAM(3);
    if (IN(4)) { phase_router(p, lds, vb, G); } SEAM(4);
    RUN(5, phase_experts(p, lds, vb, G)); SEAM(5);
    RUN(6, phase_final(p, vb, G));
#undef SEAM
#undef IN
#undef RUN
}

extern "C" void kernel_launch(void* const* d_in, const int* in_sizes, int n_in, void* d_out, int out_size, void* d_ws, size_t ws_size, hipStream_t stream) {
    static int grid = 0;
    if (grid == 0) {
        if (n_in != 22 || in_sizes[0] != S * D || out_size != S * D || ws_size < WS_END) {
            fprintf(stderr, "kernel_launch: unexpected shapes: n_in %d in0 %d out %d ws %zu (need %zu)\n", n_in, n_in > 0 ? in_sizes[0] : -1, out_size, ws_size, (size_t)WS_END); grid = -1; return; }
        int dev = 0, cus = 0, per_cu = 0;
        (void)hipGetDevice(&dev); (void)hipDeviceGetAttribute(&cus, hipDeviceAttributeMultiprocessorCount, dev);
        if (hipFuncSetAttribute((const void*)mega, hipFuncAttributeMaxDynamicSharedMemorySize, LDS_BYTES) != hipSuccess) { fprintf(stderr, "kernel_launch: hipFuncSetAttribute failed\n"); grid = -1; return; }
        (void)hipOccupancyMaxActiveBlocksPerMultiprocessor(&per_cu, (const void*)mega, NTHREADS, LDS_BYTES);
        if (per_cu < 1) { fprintf(stderr, "kernel_launch: occupancy query says %d blocks per CU\n", per_cu); per_cu = 1; }
        grid = cus * 1;
        (void)hipGetLastError();
    }
    if (grid < 0) return;
    (void)hipMemsetAsync((char*)d_ws + WS_CTL, 0, CTL_BYTES, stream);
    Params p{};
    const float** f = (const float**)&p;
    for (int i = 0; i < 22; ++i) f[i] = (const float*)d_in[i];
    p.out = (float*)d_out; p.ws = (unsigned char*)d_ws;
#if MK_ONE_LAUNCH
    p.ph_lo = 0; p.ph_hi = 7;
    void* args[] = {&p};
    hipError_t e = hipLaunchCooperativeKernel((const void*)mega, dim3(grid), dim3(NTHREADS), args, LDS_BYTES, stream);
    if (e != hipSuccess) fprintf(stderr, "kernel_launch: cooperative launch failed: %s (grid %d)\n", hipGetErrorString(e), grid);
#else
    for (int ph = 0; ph < 7; ++ph) {
        p.ph_lo = ph; p.ph_hi = ph + 1;
        hipLaunchKernelGGL(mega, dim3(grid), dim3(NTHREADS), LDS_BYTES, stream, p);
    }
#endif
}
```

```cpp
#include <hip/hip_runtime.h>
#include <hip/hip_cooperative_groups.h>
#include <cstdio>
#include <cstdint>
namespace cg = cooperative_groups;

#ifndef MK_REPEAT
#define MK_REPEAT -1
#endif
#ifndef MK_ONE_LAUNCH
#define MK_ONE_LAUNCH 1
#endif

constexpr int S = 16384, D = 1024, INW = 2304, NE = 256, FF = 256;
constexpr int NTHREADS = 512;
constexpr int CAP = 16384;
constexpr float ALPHA = 1.189207115002721f;
constexpr float LN_EPS = 1e-5f;
constexpr float QSCALE = 0.125f * 1.4426950408889634f;
constexpr float LOG2E = 1.4426950408889634f;
constexpr int C_AQ = 0, C_AK = 512, C_AV = 640, C_BQ = 768, C_BK = 1280, C_BV = 1792;

constexpr size_t MiB = 1ull << 20;
constexpr size_t WS_CTL = 0;
constexpr size_t CTL_BYTES = 128 * 1024;
constexpr int CNT_STRIDE = 64;
constexpr size_t WS_ROPE = 1 * MiB;
constexpr size_t WS_WIN = 8 * MiB;
constexpr size_t WS_WOUT = 13 * MiB;
constexpr size_t WS_WR = 15 * MiB;
constexpr size_t WS_WSGU = 16 * MiB;
constexpr size_t WS_WSD = 17 * MiB;
constexpr size_t WS_EGU = 20 * MiB;
constexpr size_t WS_ED = 276 * MiB;
constexpr size_t WS_X1F = 404 * MiB;
constexpr size_t WS_X1B = 468 * MiB;
constexpr size_t WS_LIST = 500 * MiB;
constexpr size_t WS_GATE = 516 * MiB;
constexpr size_t WS_ACT = 518 * MiB;
constexpr size_t WS_Y = 590 * MiB;
constexpr size_t WS_XB = 590 * MiB;
constexpr size_t WS_PROJ = 622 * MiB;
constexpr size_t WS_ATT = 694 * MiB;
constexpr size_t WS_PRELN = 726 * MiB;
constexpr size_t WS_END = 878 * MiB;

constexpr int LDS_BYTES = 147456;
constexpr int LDS_MISC = 131072;

typedef unsigned short bf16_t;
typedef short bf16x8 __attribute__((ext_vector_type(8)));
typedef short s16x4 __attribute__((ext_vector_type(4)));
typedef float f32x4 __attribute__((ext_vector_type(4)));
typedef float f32x16 __attribute__((ext_vector_type(16)));
typedef unsigned u32x4 __attribute__((ext_vector_type(4)));
typedef unsigned u32x2 __attribute__((ext_vector_type(2)));
typedef float f32x2 __attribute__((ext_vector_type(2)));


#define LAS __attribute__((address_space(3)))
#define XB_TMO      128
#define XB_XCNT(j)  (256  + 64 * (j))
#define XB_XSUB(j)  (1280 + 64 * (j))
#define XB_XGEN(j)  (2304 + 64 * (j))
#define XB_TOP      3328
#define XB_TOPGEN   3392
#define XCD_BAR_WORDS 3456
#define XB_SPIN_CAP (1u << 18)
__device__ __forceinline__ unsigned xb_ld(unsigned* p)              { return __hip_atomic_load(p, __ATOMIC_RELAXED, __HIP_MEMORY_SCOPE_AGENT); }
__device__ __forceinline__ unsigned xb_add(unsigned* p, unsigned v) { return __hip_atomic_fetch_add(p, v, __ATOMIC_RELAXED, __HIP_MEMORY_SCOPE_AGENT); }
__device__ __forceinline__ unsigned xb_xcc_id() { return (unsigned)__builtin_amdgcn_s_getreg((3 << 11) | 20) & 0xFu; }
#define XB_SPIN(cond, bar) do { unsigned _sp = 0; while (cond) { __builtin_amdgcn_s_sleep(1); \
    if ((++_sp & 255u) == 0u) { if (xb_ld(&(bar)[XB_TMO])) break; if (_sp > XB_SPIN_CAP) { atomicAdd(&(bar)[XB_TMO], 1u); break; } } } } while (0)
struct XcdBarrier { unsigned* bar; unsigned x; volatile LAS unsigned* st; };
__device__ __forceinline__ XcdBarrier xcd_barrier_post(unsigned* bar, volatile LAS unsigned* st) {
    XcdBarrier b; b.bar = bar; b.x = xb_xcc_id(); b.st = st;
    if (threadIdx.x == 0) (void)xb_add(&bar[XB_XCNT(b.x)], 1u);
    return b;
}
__device__ __forceinline__ void xcd_barrier_complete(unsigned* bar, unsigned x, unsigned& nloc, unsigned& nx) {
    const unsigned G = gridDim.x * gridDim.y * gridDim.z;
    unsigned sum, cnt, mine, sp = 0u;
    for (;;) {
        sum = 0u; cnt = 0u; mine = 0u;
#pragma unroll
        for (unsigned j = 0; j < 16; ++j) { const unsigned c = xb_ld(&bar[XB_XCNT(j)]); sum += c; cnt += (c > 0u) ? 1u : 0u; mine = (j == x) ? c : mine; }
        if (sum == G) break;
        __builtin_amdgcn_s_sleep(1);
        if ((++sp & 255u) == 0u) { if (xb_ld(&bar[XB_TMO])) break; if (sp > XB_SPIN_CAP) { atomicAdd(&bar[XB_TMO], 1u); break; } }
    }
    nloc = mine > 0u ? mine : 1u; nx = cnt > 0u ? cnt : 1u;
}
__device__ __forceinline__ void xcd_barrier(const XcdBarrier& b) {
    asm volatile("s_waitcnt vmcnt(0)" ::: "memory");
    __syncthreads();
    if (threadIdx.x == 0) {
        unsigned* bar = b.bar;
        __builtin_amdgcn_s_waitcnt(0);
        unsigned nloc = b.st[0], nx = b.st[1];
        if (nloc == 0u) { xcd_barrier_complete(bar, b.x, nloc, nx); b.st[0] = nloc; b.st[1] = nx; }
        const unsigned old = xb_add(&bar[XB_XSUB(b.x)], 1u);
        const unsigned gen = old / nloc;
        if (old + 1u == (gen + 1u) * nloc) {
            __builtin_amdgcn_fence(__ATOMIC_RELEASE, "agent");
            asm volatile("s_waitcnt vmcnt(0)" ::: "memory");
            const unsigned og = xb_add(&bar[XB_TOP], 1u);
            const unsigned tg = og / nx;
            if (og + 1u == (tg + 1u) * nx) xb_add(&bar[XB_TOPGEN], 1u);
            else XB_SPIN(xb_ld(&bar[XB_TOPGEN]) == tg, bar);
            __builtin_amdgcn_fence(__ATOMIC_ACQUIRE, "agent");
            xb_add(&bar[XB_XGEN(b.x)], 1u);
            asm volatile("s_waitcnt vmcnt(0)" ::: "memory");
        } else {
            XB_SPIN(xb_ld(&bar[XB_XGEN(b.x)]) == gen, bar);
            __builtin_amdgcn_fence(__ATOMIC_ACQUIRE, "agent");
            asm volatile("s_waitcnt vmcnt(0)" ::: "memory");
        }
    }
    __syncthreads();
}
constexpr int CW_BAR = 4096;
constexpr int LDS_BARST = LDS_MISC + 8192;

struct Params {
    const float* x; const float* w_in; const float* b_in; const float* sinks;
    const float* lq1; const float* lk1; const float* lq2; const float* lk2; const float* subg;
    const float* w_out; const float* ln1g; const float* ln1b; const float* w_r; const float* r_bias;
    const float* w_g; const float* w_u; const float* w_d; const float* ws_g; const float* ws_u; const float* ws_d;
    const float* ln2g; const float* ln2b;
    float* out; unsigned char* ws;
    int ph_lo, ph_hi;
};

__device__ __forceinline__ unsigned cvt_pk(float lo, float hi) { unsigned r; asm volatile("v_cvt_pk_bf16_f32 %0, %1, %2" : "=v"(r) : "v"(lo), "v"(hi)); return r; }
__device__ __forceinline__ float bf_lo(unsigned u) { return __uint_as_float(u << 16); }
__device__ __forceinline__ float bf_hi(unsigned u) { return __uint_as_float(u & 0xffff0000u); }
__device__ __forceinline__ float wave_sum(float v) {
#pragma unroll
    for (int o = 1; o < 64; o <<= 1) v += __shfl_xor(v, o);
    return v;
}
__device__ __forceinline__ float half_max(float v) { auto rr = __builtin_amdgcn_permlane32_swap(__float_as_uint(v), __float_as_uint(v), false, false); return fmaxf(__uint_as_float(rr[0]), __uint_as_float(rr[1])); }
__device__ __forceinline__ float half_sum(float v) { auto rr = __builtin_amdgcn_permlane32_swap(__float_as_uint(v), __float_as_uint(v), false, false); return __uint_as_float(rr[0]) + __uint_as_float(rr[1]); }

__device__ __forceinline__ int swz(int r, int c) { const int f = (r & 7) ^ (((r >> 3) & 1) << 1) ^ ((r >> 4) & 1); return r * 128 + ((c ^ f) << 4); }

struct G2Args {
    const char* A; const char* B;
    unsigned offA[4], offB[4];
    int nk;
    unsigned akstep;
};
__device__ __forceinline__ unsigned g2_chunk_off(int lane, int w) { const int f = (lane >> 3) ^ ((w & 1) << 1) ^ ((w >> 1) & 1); return (unsigned)(((lane & 7) ^ f) << 4); }
template <int MT, int NT, class Epi>
__device__ __forceinline__ void gemm2n(char* lds_, const G2Args& g, const Epi& epi) {
    constexpr int A_BYTES = 32 * MT * 128, B_BYTES = 64 * NT * 128, STAGE = A_BYTES + B_BYTES, AR = MT / 2, BRR = NT;
    LAS char* lds = (LAS char*)lds_;
    const int tid = threadIdx.x, lane = tid & 63, w = __builtin_amdgcn_readfirstlane(tid >> 6), wr = w >> 2, wc = w & 3, fr = lane & 15, fq = lane >> 4;
    f32x4 acc[MT][NT];
#pragma unroll
    for (int i = 0; i < MT; ++i)
#pragma unroll
        for (int j = 0; j < NT; ++j) acc[i][j] = (f32x4){0.f, 0.f, 0.f, 0.f};
    const int ldsw = w * 1024;
#define G2_STAGE(kt, s) do { \
        _Pragma("unroll") for (int i = 0; i < AR; ++i) __builtin_amdgcn_global_load_lds((const unsigned*)(g.A + g.offA[i] + (size_t)(kt) * g.akstep), (LAS unsigned*)(lds + (s) * STAGE + i * 8192 + ldsw), 16, 0, 0); \
        _Pragma("unroll") for (int i = 0; i < BRR; ++i) __builtin_amdgcn_global_load_lds((const unsigned*)(g.B + g.offB[i] + (size_t)(kt) * 128), (LAS unsigned*)(lds + (s) * STAGE + A_BYTES + i * 8192 + ldsw), 16, 0, 0); } while (0)
    G2_STAGE(0, 0);
    __syncthreads();
    for (int kt = 0; kt < g.nk; ++kt) {
        const int s = kt & 1;
        if (kt + 1 < g.nk) { if (s) G2_STAGE(kt + 1, 0); else G2_STAGE(kt + 1, 1); }
        const char* la = lds_ + s * STAGE; const char* lb = la + A_BYTES;
        {
            constexpr int NG = 2 * (MT / 4);
            bf16x8 bfr[NT], af[2][4];
#pragma unroll
            for (int nt = 0; nt < NT; ++nt) bfr[nt] = *(const bf16x8*)(lb + swz(wc * 16 * NT + nt * 16 + fr, fq));
#pragma unroll
            for (int m = 0; m < 4; ++m) af[0][m] = *(const bf16x8*)(la + swz(wr * 16 * MT + m * 16 + fr, fq));
#pragma unroll
            for (int gi = 0; gi < NG; ++gi) {
                const int ks = gi / (MT / 4), h = gi % (MT / 4);
                if (gi > 0 && h == 0) {
#pragma unroll
                    for (int nt = 0; nt < NT; ++nt) bfr[nt] = *(const bf16x8*)(lb + swz(wc * 16 * NT + nt * 16 + fr, ks * 4 + fq));
                }
                if (gi + 1 < NG) {
                    const int ks2 = (gi + 1) / (MT / 4), h2 = (gi + 1) % (MT / 4);
#pragma unroll
                    for (int m = 0; m < 4; ++m) af[(gi + 1) & 1][m] = *(const bf16x8*)(la + swz(wr * 16 * MT + (h2 * 4 + m) * 16 + fr, ks2 * 4 + fq));
                }
                __builtin_amdgcn_sched_barrier(0);
#pragma unroll
                for (int m = 0; m < 4; ++m)
#pragma unroll
                    for (int nt = 0; nt < NT; ++nt) acc[h * 4 + m][nt] = __builtin_amdgcn_mfma_f32_16x16x32_bf16(bfr[nt], af[gi & 1][m], acc[h * 4 + m][nt], 0, 0, 0);
                __builtin_amdgcn_sched_barrier(0);
            }
        }
        __syncthreads();
    }
#undef G2_STAGE
    epi(acc, wr, wc, fr, fq);
}
template <int MT, class Epi>
__device__ __forceinline__ void gemm2(char* lds_, const G2Args& g, const Epi& epi) { gemm2n<MT, 4>(lds_, g, epi); }
template <int MT>
__device__ __forceinline__ void g2_rows_A(G2Args& g, size_t row0, unsigned ld_bytes) {
    const int lane = threadIdx.x & 63, w = __builtin_amdgcn_readfirstlane(threadIdx.x >> 6); const unsigned co = g2_chunk_off(lane, w);
#pragma unroll
    for (int i = 0; i < MT / 2; ++i) g.offA[i] = (unsigned)((row0 + i * 64 + w * 8 + (lane >> 3)) * ld_bytes) + co;
}
__device__ __forceinline__ void g2_rows_B(G2Args& g, size_t row0, unsigned ld_bytes) {
    const int lane = threadIdx.x & 63, w = __builtin_amdgcn_readfirstlane(threadIdx.x >> 6); const unsigned co = g2_chunk_off(lane, w);
#pragma unroll
    for (int i = 0; i < 4; ++i) g.offB[i] = (unsigned)((row0 + i * 64 + w * 8 + (lane >> 3)) * ld_bytes) + co;
}


struct G3fArgs { const char* A; unsigned offA[4]; const float* b; int nk; unsigned akstep; };
template <int MT, int LDB, class Epi>
__device__ __forceinline__ void gemm3f(char* lds_, const G3fArgs& g, int npass, int bpstep, const Epi& epi) {
    constexpr int A_BYTES = 32 * MT * 128, B_BYTES = 256 * 128, STAGE = A_BYTES + B_BYTES, AR = MT / 2;
    LAS char* lds = (LAS char*)lds_;
    const int tid = threadIdx.x, lane = tid & 63, w = __builtin_amdgcn_readfirstlane(tid >> 6), wr = w >> 2, wc = w & 3, fr = lane & 15, fq = lane >> 4;
    f32x4 acc[MT][4];
#pragma unroll
    for (int i = 0; i < MT; ++i)
#pragma unroll
        for (int j = 0; j < 4; ++j) acc[i][j] = (f32x4){0.f, 0.f, 0.f, 0.f};
    const int ldsw = w * 1024;
    int bw[4];
#pragma unroll
    for (int j = 0; j < 4; ++j) bw[j] = swz(4 * lane + j, w);
    f32x4 br[8];
    const int nk = g.nk, nsteps = nk * npass;
#define G3_STAGE_A(kt, s) do { \
        _Pragma("unroll") for (int i = 0; i < AR; ++i) __builtin_amdgcn_global_load_lds((const unsigned*)(g.A + g.offA[i] + (size_t)(kt) * g.akstep), (LAS unsigned*)(lds + (s) * STAGE + i * 8192 + ldsw), 16, 0, 0); } while (0)
#define G3_LOAD_B(ps, kt) do { const float* pb_ = g.b + (size_t)(ps) * bpstep + (size_t)(kt) * 64 * LDB; _Pragma("unroll") for (int i = 0; i < 8; ++i) br[i] = *(const f32x4*)(pb_ + i * LDB); } while (0)
#define G3_WRITE_B(s) do { _Pragma("unroll") for (int j = 0; j < 4; ++j) { \
            u32x4 v = {cvt_pk(br[0][j], br[1][j]), cvt_pk(br[2][j], br[3][j]), cvt_pk(br[4][j], br[5][j]), cvt_pk(br[6][j], br[7][j])}; \
            *(u32x4*)(lds_ + (s) * STAGE + A_BYTES + bw[j]) = v; } } while (0)
    G3_STAGE_A(0, 0); G3_LOAD_B(0, 0); G3_WRITE_B(0);
    __syncthreads();
    int ps = 0, kt = 0;
    for (int st = 0; st < nsteps; ++st) {
        const int s = st & 1; const bool more = st + 1 < nsteps;
        int ps2 = ps, kt2 = kt + 1; if (kt2 == nk) { kt2 = 0; ++ps2; }
        if (more) { if (s) G3_STAGE_A(kt2, 0); else G3_STAGE_A(kt2, 1); G3_LOAD_B(ps2, kt2); }
        __builtin_amdgcn_sched_barrier(0);
        const char* la = lds_ + s * STAGE; const char* lb = la + A_BYTES;
#pragma unroll
        for (int ks = 0; ks < 2; ++ks) {
            bf16x8 bfr[4];
#pragma unroll
            for (int nt = 0; nt < 4; ++nt) bfr[nt] = *(const bf16x8*)(lb + swz(wc * 64 + nt * 16 + fr, ks * 4 + fq));
#pragma unroll
            for (int h = 0; h < MT / 2; ++h) {
                bf16x8 af[2];
#pragma unroll
                for (int m = 0; m < 2; ++m) af[m] = *(const bf16x8*)(la + swz(wr * 16 * MT + (h * 2 + m) * 16 + fr, ks * 4 + fq));
                __builtin_amdgcn_sched_barrier(0);
#pragma unroll
                for (int m = 0; m < 2; ++m)
#pragma unroll
                    for (int nt = 0; nt < 4; ++nt) acc[h * 2 + m][nt] = __builtin_amdgcn_mfma_f32_16x16x32_bf16(bfr[nt], af[m], acc[h * 2 + m][nt], 0, 0, 0);
                __builtin_amdgcn_sched_barrier(0);
            }
        }
        if (kt == nk - 1) {
            epi(acc, ps, wr, wc, fr, fq);
#pragma unroll
            for (int i = 0; i < MT; ++i)
#pragma unroll
                for (int j = 0; j < 4; ++j) acc[i][j] = (f32x4){0.f, 0.f, 0.f, 0.f};
        }
        if (more) { if (s) G3_WRITE_B(0); else G3_WRITE_B(1); }
        __syncthreads();
        ps = ps2; kt = kt2;
    }
#undef G3_STAGE_A
#undef G3_LOAD_B
#undef G3_WRITE_B
}

__device__ __forceinline__ void cvt_item(const float* W, int K, int N, bf16_t* WT, int ldt, int kb, int nb, int kc, int lane) {
    const float* src = W + (size_t)(kb * 64 + kc * 8) * N + nb * 256 + 4 * lane;
    bf16_t* dst = WT + (size_t)(nb * 256 + 4 * lane) * ldt + kb * 64 + kc * 8;
    f32x4 r[8];
#pragma unroll
    for (int i = 0; i < 8; ++i) r[i] = *(const f32x4*)(src + (size_t)i * N);
#pragma unroll
    for (int j = 0; j < 4; ++j) {
        u32x4 v = {cvt_pk(r[0][j], r[1][j]), cvt_pk(r[2][j], r[3][j]), cvt_pk(r[4][j], r[5][j]), cvt_pk(r[6][j], r[7][j])};
        *(u32x4*)(dst + (size_t)j * ldt) = v;
    }
}
__device__ __forceinline__ void phase_prep(const Params& p, int vb, int G) {
    const int tid = threadIdx.x, lane = tid & 63, w = tid >> 6;
    float* cs = (float*)(p.ws + WS_ROPE); float* sn = cs + (size_t)S * 32;
    for (int idx = vb * NTHREADS + tid; idx < S * 32; idx += G * NTHREADS) {
        const int pos = idx >> 5, i = idx & 31;
        const float pw = (float)pow(10000.0, (double)i / 32.0);
        const float inv = 1.0f / pw;
        const float angf = __fmul_rn((float)pos, inv);
        const double a = (double)angf;
        const double q = rint(a * 0.63661977236758134308);
        double r = fma(-q, 1.57079632679489655800, a); r = fma(-q, 6.12323399573676603587e-17, r);
        const double r2 = r * r;
        double sp = r * (1.0 + r2 * (-1.0 / 6 + r2 * (1.0 / 120 + r2 * (-1.0 / 5040 + r2 * (1.0 / 362880 + r2 * (-1.0 / 39916800))))));
        double cp = 1.0 + r2 * (-0.5 + r2 * (1.0 / 24 + r2 * (-1.0 / 720 + r2 * (1.0 / 40320 + r2 * (-1.0 / 3628800 + r2 * (1.0 / 479001600))))));
        const int qi = ((int)((long long)q)) & 3;
        double sv, cv;
        if (qi == 0) { sv = sp; cv = cp; } else if (qi == 1) { sv = cp; cv = -sp; } else if (qi == 2) { sv = -sp; cv = -cp; } else { sv = -cp; cv = sp; }
        cs[idx] = (float)cv; sn[idx] = (float)sv;
    }
    { const f32x4* xs = (const f32x4*)p.x; u32x4* xd = (u32x4*)(p.ws + WS_XB);
      for (size_t i = (size_t)vb * NTHREADS + tid; i < (size_t)S * D / 8; i += (size_t)G * NTHREADS) {
          const f32x4 a = xs[2 * i], b = xs[2 * i + 1];
          xd[i] = (u32x4){cvt_pk(a[0], a[1]), cvt_pk(a[2], a[3]), cvt_pk(b[0], b[1]), cvt_pk(b[2], b[3])}; } }
    const int gw = vb * 8 + w, NGW = G * 8;
    constexpr int I_IN = 16 * 9, I_OUT = 16 * 4, I_R = 16, I_SG = 16, I_SU = 16, I_SD = 4 * 4, I_SMALL = I_IN + I_OUT + I_R;
    for (int it8 = gw; it8 < I_SMALL * 8; it8 += NGW) {
        int r = it8 >> 3; const int kc = it8 & 7;
        if (r < I_IN) { cvt_item(p.w_in, D, INW, (bf16_t*)(p.ws + WS_WIN), D, r / 9, r % 9, kc, lane); continue; } r -= I_IN;
        if (r < I_OUT) { cvt_item(p.w_out, D, D, (bf16_t*)(p.ws + WS_WOUT), D, r >> 2, r & 3, kc, lane); continue; } r -= I_OUT;
        cvt_item(p.w_r, D, NE, (bf16_t*)(p.ws + WS_WR), D, r, 0, kc, lane);
    }
}

template <int MT> struct EpiProj {
    const float* bias; const float* cs; const float* sn; bf16_t* out; int row0, col0; char* lds;
    __device__ __forceinline__ void operator()(f32x4 (&acc)[MT][4], int wr, int wc, int fr, int fq) const {
        const int hb = col0 + wc * 64;
        const bool is_q = (hb < C_AK) || (hb >= C_BQ && hb < C_BK);
        const bool is_rope = is_q || (hb >= C_AK && hb < C_AV) || (hb >= C_BK && hb < C_BV);
        const float sc = is_q ? QSCALE : 1.0f;
        const int tid = threadIdx.x, w = __builtin_amdgcn_readfirstlane(tid >> 6), lane = tid & 63;
        constexpr int TB = 32 * MT * 128;
        LAS char* l3 = (LAS char*)lds;
#pragma unroll
        for (int i = 0; i < TB / 8192; ++i) {
            __builtin_amdgcn_global_load_lds((const unsigned*)((const char*)(cs + (size_t)row0 * 32) + i * 8192 + w * 1024 + lane * 16), (LAS unsigned*)(l3 + i * 8192 + w * 1024), 16, 0, 0);
            __builtin_amdgcn_global_load_lds((const unsigned*)((const char*)(sn + (size_t)row0 * 32) + i * 8192 + w * 1024 + lane * 16), (LAS unsigned*)(l3 + TB + i * 8192 + w * 1024), 16, 0, 0);
        }
        f32x4 bv[4];
#pragma unroll
        for (int nt = 0; nt < 4; ++nt) bv[nt] = *(const f32x4*)(bias + hb + nt * 16 + 4 * fq);
        __syncthreads();
        const float* lcs = (const float*)lds; const float* lsn = (const float*)(lds + TB);
#pragma unroll
        for (int mt = 0; mt < MT; ++mt) {
            const int rl = wr * 16 * MT + mt * 16 + fr, row = row0 + rl;
            f32x4 v[4];
#pragma unroll
            for (int nt = 0; nt < 4; ++nt) v[nt] = acc[mt][nt] + bv[nt];
            if (is_rope) {
#pragma unroll
                for (int nt = 0; nt < 2; ++nt) {
                    const f32x4 c = *(const f32x4*)(lcs + rl * 32 + nt * 16 + 4 * fq), s = *(const f32x4*)(lsn + rl * 32 + nt * 16 + 4 * fq);
                    const f32x4 t1 = v[nt], t2 = v[nt + 2];
                    v[nt] = t1 * c - t2 * s; v[nt + 2] = t2 * c + t1 * s;
                }
            }
#pragma unroll
            for (int nt = 0; nt < 4; ++nt) {
                const f32x4 o = v[nt] * sc;
                u32x2 pk = {cvt_pk(o[0], o[1]), cvt_pk(o[2], o[3])};
                *(u32x2*)(out + (size_t)row * INW + hb + nt * 16 + 4 * fq) = pk;
            }
        }
        __syncthreads();
    }
};
struct EpiProjQ {
    const float* bias; const float* cs; const float* sn; bf16_t* out; int row0, col0;
    __device__ __forceinline__ void operator()(f32x4 (&acc)[4][2], int wr, int wc, int fr, int fq) const {
        const int hb = col0 + (wc >> 1) * 64, i0 = (wc & 1) * 16 + 4 * fq;
        const bool is_q = (hb < C_AK) || (hb >= C_BQ && hb < C_BK);
        const bool is_rope = is_q || (hb >= C_AK && hb < C_AV) || (hb >= C_BK && hb < C_BV);
        const float sc = is_q ? QSCALE : 1.0f;
#pragma unroll
        for (int mt = 0; mt < 4; ++mt) {
            const int row = row0 + wr * 64 + mt * 16 + fr;
            f32x4 v0 = acc[mt][0] + *(const f32x4*)(bias + hb + i0), v1 = acc[mt][1] + *(const f32x4*)(bias + hb + 32 + i0);
            if (is_rope) {
                const f32x4 c = *(const f32x4*)(cs + (size_t)row * 32 + i0), s = *(const f32x4*)(sn + (size_t)row * 32 + i0);
                const f32x4 t1 = v0, t2 = v1; v0 = t1 * c - t2 * s; v1 = t2 * c + t1 * s;
            }
            v0 = v0 * sc; v1 = v1 * sc;
            *(u32x2*)(out + (size_t)row * INW + hb + i0) = (u32x2){cvt_pk(v0[0], v0[1]), cvt_pk(v0[2], v0[3])};
            *(u32x2*)(out + (size_t)row * INW + hb + 32 + i0) = (u32x2){cvt_pk(v1[0], v1[1]), cvt_pk(v1[2], v1[3])};
        }
    }
};
__device__ __forceinline__ void phase_proj(const Params& p, char* lds, int vb, int G) {
    const float* cs = (const float*)(p.ws + WS_ROPE); const float* sn = cs + (size_t)S * 32;
    constexpr int NBIG = 512, NUNITS = NBIG + 4 * 64;
    for (int u = vb; u < NUNITS; u += G) {
        G2Args g; g.A = (const char*)(p.ws + WS_XB); g.B = (const char*)(p.ws + WS_WIN); g.nk = D / 64; g.akstep = 128;
        if (u < NBIG) {
            const int tm = u / 9, tn = u % 9;
            g2_rows_A<8>(g, (size_t)tm * 256, D * 2); g2_rows_B(g, (size_t)tn * 256, D * 2);
            EpiProj<8> e{p.b_in, cs, sn, (bf16_t*)(p.ws + WS_PROJ), tm * 256, tn * 256, lds};
            gemm2<8>(lds, g, e);
        } else {
            const int q = u - NBIG, t = NBIG + (q >> 2), hm = (q >> 1) & 1, hn = q & 1, tm = t / 9, tn = t % 9;
            g2_rows_A<4>(g, (size_t)tm * 256 + hm * 128, D * 2);
            { const int lane = threadIdx.x & 63, w = __builtin_amdgcn_readfirstlane(threadIdx.x >> 6); const unsigned co = g2_chunk_off(lane, w);
#pragma unroll
              for (int i = 0; i < 2; ++i) { const int n = i * 64 + w * 8 + (lane >> 3), wcn = n >> 5, sub = n & 31;
                  const int col = tn * 256 + hn * 128 + (wcn >> 1) * 64 + (wcn & 1) * 16 + (sub & 15) + (sub >> 4) * 32;
                  g.offB[i] = (unsigned)col * (unsigned)(D * 2) + co; } }
            EpiProjQ e{p.b_in, cs, sn, (bf16_t*)(p.ws + WS_PROJ), tm * 256 + hm * 128, tn * 256 + hn * 128};
            gemm2n<4, 2>(lds, g, e);
        }
    }
}

template <int OFF> __device__ __forceinline__ s16x4 tr_read(int vb) { s16x4 r; asm volatile("ds_read_b64_tr_b16 %0, %1 offset:%2" : "=&v"(r) : "v"(vb), "i"(OFF) : "memory"); return r; }
__device__ __forceinline__ int v_off(int k, int c, int ndb) { return ((k >> 3) * ndb + (c >> 5)) * 512 + ((k & 7) * 32 + (c & 31)) * 2; }

constexpr int AT_STAGE = 32768;
template <int NDB, int KB, int T> struct PvPart {
    static __device__ __forceinline__ void run(f32x16& o, int vbase, const bf16x8& pa, const bf16x8& pb) {
        constexpr int o0 = (KB * 4 * NDB + T) * 512, st = NDB * 512;
        const s16x4 l0 = tr_read<o0 + 0 * st>(vbase), h0 = tr_read<o0 + 1 * st>(vbase), l1 = tr_read<o0 + 2 * st>(vbase), h1 = tr_read<o0 + 3 * st>(vbase);
        asm volatile("s_waitcnt lgkmcnt(0)" ::: "memory"); __builtin_amdgcn_sched_barrier(0);
#define PKV(L, H) (bf16x8){L[0], L[1], L[2], L[3], H[0], H[1], H[2], H[3]}
        o = __builtin_amdgcn_mfma_f32_32x32x16_bf16(PKV(l0, h0), pa, o, 0, 0, 0);
        o = __builtin_amdgcn_mfma_f32_32x32x16_bf16(PKV(l1, h1), pb, o, 0, 0, 0);
#undef PKV
    }
};
template <int NDB, int KB>
__device__ __forceinline__ void pv_half(f32x16 (&o)[NDB], f32x16& ol, int vbase, const bf16x8& pa, const bf16x8& pb) {
    const bf16x8 ones = {16256, 16256, 16256, 16256, 16256, 16256, 16256, 16256};
    ol = __builtin_amdgcn_mfma_f32_32x32x16_bf16(ones, pa, ol, 0, 0, 0);
    ol = __builtin_amdgcn_mfma_f32_32x32x16_bf16(ones, pb, ol, 0, 0, 0);
    PvPart<NDB, KB, 0>::run(o[0], vbase, pa, pb); PvPart<NDB, KB, 1>::run(o[1], vbase, pa, pb);
    if constexpr (NDB == 4) { PvPart<NDB, KB, 2>::run(o[2], vbase, pa, pb); PvPart<NDB, KB, 3>::run(o[3], vbase, pa, pb); }
}
constexpr float ATT_THR = 10.0f;
template <int NDB>
__device__ __forceinline__ void attn_scores(char* lds, int kof, const bf16x8 (&qf)[4], f32x16& s0, f32x16& s1, f32x16 (&o)[NDB], f32x16& ol, f32x16& nm, bool first, int r32, int hi) {
    s0 = nm; s1 = nm;
#pragma unroll
    for (int ds = 0; ds < 4; ++ds) {
        const bf16x8 k0 = *(const bf16x8*)(lds + kof + swz(r32, ds * 2 + hi)), k1 = *(const bf16x8*)(lds + kof + swz(32 + r32, ds * 2 + hi));
        s0 = __builtin_amdgcn_mfma_f32_32x32x16_bf16(k0, qf[ds], s0, 0, 0, 0);
        s1 = __builtin_amdgcn_mfma_f32_32x32x16_bf16(k1, qf[ds], s1, 0, 0, 0);
    }
    float mx = fmaxf(s0[0], s1[0]);
#pragma unroll
    for (int r = 1; r < 16; ++r) mx = fmaxf(fmaxf(mx, s0[r]), s1[r]);
    mx = half_max(mx);
    if (first || __any(mx > ATT_THR)) {
        const float delta = first ? mx : fmaxf(mx, 0.f), alpha = first ? 0.f : __builtin_amdgcn_exp2f(-delta);
#pragma unroll
        for (int r = 0; r < 16; ++r) { s0[r] -= delta; s1[r] -= delta; nm[r] -= delta; ol[r] *= alpha; }
#pragma unroll
        for (int t = 0; t < NDB; ++t)
#pragma unroll
            for (int r = 0; r < 16; ++r) o[t][r] *= alpha;
    }
}
__device__ __forceinline__ void exp_pack(const f32x16& s, bf16x8& pa, bf16x8& pb) {
    float e[16];
#pragma unroll
    for (int r = 0; r < 16; ++r) e[r] = __builtin_amdgcn_exp2f(s[r]);
    u32x4 a = {cvt_pk(e[0], e[1]), cvt_pk(e[2], e[3]), cvt_pk(e[4], e[5]), cvt_pk(e[6], e[7])};
    u32x4 b = {cvt_pk(e[8], e[9]), cvt_pk(e[10], e[11]), cvt_pk(e[12], e[13]), cvt_pk(e[14], e[15])};
    pa = *(bf16x8*)&a; pb = *(bf16x8*)&b;
}

__device__ __forceinline__ void attn_diff_unit(const Params& p, char* lds_, int h, int qb, float lam) {
    LAS char* lds = (LAS char*)lds_;
    const int tid = threadIdx.x, lane = tid & 63, w = __builtin_amdgcn_readfirstlane(tid >> 6), r32 = lane & 31, hi = lane >> 5, mp = w >> 2, wq = w & 3;
    const bf16_t* proj = (const bf16_t*)(p.ws + WS_PROJ);
    const int NT = 2 * qb + 2, NP = NT / 2, myNT = (wq < 2) ? NT - 1 : NT;
    bf16x8 qf[4];
    { const bf16_t* qp = proj + (size_t)(qb * 128 + wq * 32 + r32) * INW + C_BQ + h * 128 + mp * 64 + hi * 8;
#pragma unroll
      for (int ds = 0; ds < 4; ++ds) qf[ds] = *(const bf16x8*)(qp + ds * 16); }
    asm volatile("" : "+v"(qf[0]), "+v"(qf[1]), "+v"(qf[2]), "+v"(qf[3]));
    f32x16 o[4] = {}; f32x16 ol = {}, nm = {};
    const char* gk = (const char*)(proj + (size_t)(w * 8 + (lane >> 3)) * INW + C_BK + h * 128) + g2_chunk_off(lane, w);
    const char* gv = (const char*)(proj + (size_t)(w * 8 + ((lane & 31) >> 2)) * INW + C_BV + h * 128 + (lane >> 5) * 32 + (lane & 3) * 8);
    const int vlane = ((lane & 3) << 3) | (((lane >> 2) & 3) << 6) | (((lane >> 4) & 1) << 5) | (((lane >> 5) & 1) << 8);
    constexpr size_t TSTEP = (size_t)64 * INW * 2;
#define A_STAGE(pr, sg) do { const char* k0_ = gk + (size_t)(pr) * 2 * TSTEP; const char* v0_ = gv + (size_t)(pr) * 2 * TSTEP; \
        _Pragma("unroll") for (int j = 0; j < 2; ++j) { \
            __builtin_amdgcn_global_load_lds((const unsigned*)(k0_ + j * TSTEP), (LAS unsigned*)(lds + (sg) * 65536 + (0 * 2 + j) * 8192 + w * 1024), 16, 0, 0); \
            __builtin_amdgcn_global_load_lds((const unsigned*)(k0_ + j * TSTEP + 128), (LAS unsigned*)(lds + (sg) * 65536 + (1 * 2 + j) * 8192 + w * 1024), 16, 0, 0); \
            __builtin_amdgcn_global_load_lds((const unsigned*)(v0_ + j * TSTEP), (LAS unsigned*)(lds + (sg) * 65536 + 32768 + j * 16384 + (2 * w) * 1024), 16, 0, 0); \
            __builtin_amdgcn_global_load_lds((const unsigned*)(v0_ + j * TSTEP + 128), (LAS unsigned*)(lds + (sg) * 65536 + 32768 + j * 16384 + (2 * w + 1) * 1024), 16, 0, 0); } } while (0)
    A_STAGE(0, 0);
    __syncthreads();
    bool first = true;
    for (int it = 0; it < NP; ++it) {
        const int sg = it & 1;
        if (it + 1 < NP) { if (sg) A_STAGE(it + 1, 0); else A_STAGE(it + 1, 1); }
#pragma unroll
        for (int jj = 0; jj < 2; ++jj) {
            const int j = jj, t = 2 * it + j;
            if (t < myNT) {
                bf16x8 p0, p1, p2, p3; f32x16 s0, s1;
                const int vb_ = (int)(uintptr_t)(lds_ + sg * 65536 + 32768 + j * 16384) + vlane;
                attn_scores<4>(lds_, sg * 65536 + (mp * 2 + j) * 8192, qf, s0, s1, o, ol, nm, first, r32, hi);
                first = false;
                exp_pack(s0, p0, p1); pv_half<4, 0>(o, ol, vb_, p0, p1); exp_pack(s1, p2, p3); pv_half<4, 1>(o, ol, vb_, p2, p3);
            }
        }
        __syncthreads();
    }
#undef A_STAGE
    float* xb = (float*)lds_;
    const float il = 1.0f / ol[0];
    if (mp == 1) {
        const float f = il * lam;
#pragma unroll
        for (int t = 0; t < 4; ++t)
#pragma unroll
            for (int r = 0; r < 16; ++r) xb[(wq * 64 + t * 16 + r) * 64 + lane] = o[t][r] * f;
    }
    __syncthreads();
    if (mp == 0) {
        float ss = 0.f;
#pragma unroll
        for (int t = 0; t < 4; ++t)
#pragma unroll
            for (int r = 0; r < 16; ++r) { const float v = o[t][r] * il - xb[(wq * 64 + t * 16 + r) * 64 + lane]; o[t][r] = v; ss += v * v; }
        ss = half_sum(ss);
        const float rs = rsqrtf(ss * (1.0f / 128.0f) + LN_EPS) * 0.8f;
        bf16_t* op = (bf16_t*)(p.ws + WS_ATT) + (size_t)(qb * 128 + wq * 32 + r32) * D + 512 + h * 128;
#pragma unroll
        for (int t = 0; t < 4; ++t)
#pragma unroll
            for (int rr = 0; rr < 4; ++rr) {
                const int dv0 = 32 * t + 8 * rr + 4 * hi;
                const f32x4 gg = *(const f32x4*)(p.subg + dv0);
                u32x2 pk = {cvt_pk(o[t][4 * rr] * rs * gg[0], o[t][4 * rr + 1] * rs * gg[1]), cvt_pk(o[t][4 * rr + 2] * rs * gg[2], o[t][4 * rr + 3] * rs * gg[3])};
                *(u32x2*)(op + dv0) = pk;
            }
    }
    __syncthreads();
}
__device__ __forceinline__ void attn_swa_unit(const Params& p, char* lds, int kvh, int n) {
    const int tid = threadIdx.x, lane = tid & 63, w = __builtin_amdgcn_readfirstlane(tid >> 6), r32 = lane & 31, hi = lane >> 5, g = w >> 1, hq = kvh * 4 + g;
    const bf16_t* proj = (const bf16_t*)(p.ws + WS_PROJ);
    const int c0 = (n >= 2) ? n - 2 : 0, NT = n - c0 + 1;
    const int tok = n * 64 + (w & 1) * 32 + r32;
    bf16x8 qf[4];
    { const bf16_t* qp = proj + (size_t)tok * INW + C_AQ + hq * 64 + hi * 8;
#pragma unroll
      for (int ds = 0; ds < 4; ++ds) qf[ds] = *(const bf16x8*)(qp + ds * 16); }
    f32x16 o[2] = {}; f32x16 ol, nm;
    { float ms = -p.sinks[hq] * LOG2E; asm volatile("" : "+v"(qf[0]), "+v"(qf[1]), "+v"(qf[2]), "+v"(qf[3]), "+v"(ms));
#pragma unroll
      for (int r = 0; r < 16; ++r) { nm[r] = ms; ol[r] = 1.0f; } }
    const bf16_t* gk = proj + (size_t)(c0 * 64 + (tid >> 3)) * INW + C_AK + kvh * 64 + (tid & 7) * 8;
    const bf16_t* gv = proj + (size_t)(c0 * 64 + (tid >> 3)) * INW + C_AV + kvh * 64 + (tid & 7) * 8;
    const int wk = swz(tid >> 3, tid & 7), wv = v_off(tid >> 3, (tid & 7) * 8, 2);
    const int vlane = ((lane & 3) << 3) | (((lane >> 2) & 3) << 6) | (((lane >> 4) & 1) << 5) | (((lane >> 5) & 1) << 8);
    u32x4 st0, st1;
#define W_LOAD(t) do { const size_t ko = (size_t)(t) * 64 * INW; st0 = *(const u32x4*)(gk + ko); st1 = *(const u32x4*)(gv + ko); } while (0)
#define W_WRITE(b) do { char* sb = lds + (b) * AT_STAGE; *(u32x4*)(sb + wk) = st0; *(u32x4*)(sb + 8192 + wv) = st1; } while (0)
    W_LOAD(0); W_WRITE(0); __syncthreads();
    for (int t = 0; t < NT; ++t) {
        const int b = t & 1;
        if (t + 1 < NT) W_LOAD(t + 1);
        { f32x16 s0, s1; bf16x8 p0, p1, p2, p3; const int vb_ = (int)(uintptr_t)(lds + b * AT_STAGE + 8192) + vlane;
          attn_scores<2>(lds, b * AT_STAGE, qf, s0, s1, o, ol, nm, false, r32, hi);
          exp_pack(s0, p0, p1); pv_half<2, 0>(o, ol, vb_, p0, p1); exp_pack(s1, p2, p3); pv_half<2, 1>(o, ol, vb_, p2, p3); }
        if (t + 1 < NT) W_WRITE(b ^ 1);
        __syncthreads();
    }
#undef W_LOAD
#undef W_WRITE
    const float il = 1.0f / ol[0];
    bf16_t* op = (bf16_t*)(p.ws + WS_ATT) + (size_t)tok * D + hq * 64;
#pragma unroll
    for (int t = 0; t < 2; ++t)
#pragma unroll
        for (int rr = 0; rr < 4; ++rr) {
            const int dv0 = 32 * t + 8 * rr + 4 * hi;
            u32x2 pk = {cvt_pk(o[t][4 * rr] * il, o[t][4 * rr + 1] * il), cvt_pk(o[t][4 * rr + 2] * il, o[t][4 * rr + 3] * il)};
            *(u32x2*)(op + dv0) = pk;
        }
}
__device__ __forceinline__ void phase_attn(const Params& p, char* lds, int vb, int G) {
    const int lane = threadIdx.x & 63;
    const float d1 = wave_sum(p.lq1[lane] * p.lk1[lane]), d2 = wave_sum(p.lq2[lane] * p.lk2[lane]);
    const float lam = expf(d1) - expf(d2) + 0.2f;
    for (int u = vb; u < 1024; u += G) {
        if (u < 256) attn_diff_unit(p, lds, u >> 6, 127 - (u & 63), lam);
        else if (u < 512) attn_diff_unit(p, lds, (u - 256) >> 6, (u - 256) & 63, lam);
        else attn_swa_unit(p, lds, (u - 512) >> 8, (u - 512) & 255);
    }
}

struct EpiPreLn {
    const float* x; float* out; int row0, col0;
    __device__ __forceinline__ void operator()(f32x4 (&acc)[8][4], int wr, int wc, int fr, int fq) const {
        f32x4 xa[4], xb_[4];
        const size_t rbase = (size_t)(row0 + wr * 128 + fr) * D + col0 + wc * 64 + 4 * fq;
#pragma unroll
        for (int nt = 0; nt < 4; ++nt) xa[nt] = *(const f32x4*)(x + rbase + nt * 16);
#pragma unroll
        for (int mt = 0; mt < 8; ++mt) {
            const size_t ro = rbase + (size_t)mt * 16 * D;
            if (mt + 1 < 8) {
#pragma unroll
                for (int nt = 0; nt < 4; ++nt) { if (mt & 1) xa[nt] = *(const f32x4*)(x + ro + (size_t)16 * D + nt * 16); else xb_[nt] = *(const f32x4*)(x + ro + (size_t)16 * D + nt * 16); }
            }
#pragma unroll
            for (int nt = 0; nt < 4; ++nt) { const f32x4 xv = (mt & 1) ? xb_[nt] : xa[nt]; *(f32x4*)(out + ro + nt * 16) = xv * ALPHA + acc[mt][nt]; }
        }
    }
};
__device__ __forceinline__ void phase_wout(const Params& p, char* lds, int vb, int G) {
    for (int u = vb; u < (S / 256) * 4; u += G) {
        const int tm = u >> 2, tn = u & 3;
        G2Args g; g.A = (const char*)(p.ws + WS_ATT); g.B = (const char*)(p.ws + WS_WOUT); g.nk = D / 64; g.akstep = 128;
        g2_rows_A<8>(g, (size_t)tm * 256, D * 2); g2_rows_B(g, (size_t)tn * 256, D * 2);
        EpiPreLn e{p.x, (float*)(p.ws + WS_PRELN), tm * 256, tn * 256};
        gemm2<8>(lds, g, e);
    }
}

struct EpiLogits {
    float* L;
    __device__ __forceinline__ void operator()(f32x4 (&acc)[4][4], int wr, int wc, int fr, int fq) const {
#pragma unroll
        for (int mt = 0; mt < 4; ++mt)
#pragma unroll
            for (int nt = 0; nt < 4; ++nt) *(f32x4*)(L + (wr * 64 + mt * 16 + fr) * 256 + wc * 64 + nt * 16 + 4 * fq) = acc[mt][nt];
    }
};
__device__ __forceinline__ void phase_router(const Params& p, char* lds, int vb, int G) {
    const int tid = threadIdx.x, lane = tid & 63, w = tid >> 6;
    const float* preln = (const float*)(p.ws + WS_PRELN);
    bf16_t* x1b = (bf16_t*)(p.ws + WS_X1B);
    unsigned* cnt = (unsigned*)(p.ws + WS_CTL + 65536); int* list = (int*)(p.ws + WS_LIST); float* gates = (float*)(p.ws + WS_GATE);
    for (int u = vb; u < S / 64; u += G) {
        {
            f32x4 v[8][4]; float sm[8], sq[8];
#pragma unroll
            for (int i = 0; i < 8; ++i) { const f32x4* xr = (const f32x4*)(preln + (size_t)(u * 64 + w * 8 + i) * D) + lane;
#pragma unroll
                for (int j = 0; j < 4; ++j) v[i][j] = xr[64 * j]; }
#pragma unroll
            for (int i = 0; i < 8; ++i) { float s = 0.f;
#pragma unroll
                for (int j = 0; j < 4; ++j) s += (v[i][j][0] + v[i][j][1]) + (v[i][j][2] + v[i][j][3]);
                sm[i] = s; }
#pragma unroll
            for (int o = 1; o < 64; o <<= 1) {
#pragma unroll
                for (int i = 0; i < 8; ++i) sm[i] += __shfl_xor(sm[i], o); }
#pragma unroll
            for (int i = 0; i < 8; ++i) { const float mean = sm[i] * (1.0f / D); float s2 = 0.f;
#pragma unroll
                for (int j = 0; j < 4; ++j) { v[i][j] = v[i][j] - mean; s2 += (v[i][j][0] * v[i][j][0] + v[i][j][1] * v[i][j][1]) + (v[i][j][2] * v[i][j][2] + v[i][j][3] * v[i][j][3]); }
                sq[i] = s2; }
#pragma unroll
            for (int o = 1; o < 64; o <<= 1) {
#pragma unroll
                for (int i = 0; i < 8; ++i) sq[i] += __shfl_xor(sq[i], o); }
#pragma unroll
            for (int j = 0; j < 4; ++j) {
                const f32x4 gg = *((const f32x4*)p.ln1g + lane + 64 * j), bb = *((const f32x4*)p.ln1b + lane + 64 * j);
#pragma unroll
                for (int i = 0; i < 8; ++i) {
                    const int row = u * 64 + w * 8 + i;
                    const float rstd = rsqrtf(sq[i] * (1.0f / D) + LN_EPS);
                    const f32x4 y = v[i][j] * rstd * gg + bb;
                    u32x2 pk = {cvt_pk(y[0], y[1]), cvt_pk(y[2], y[3])};
                    *(u32x2*)(x1b + ((size_t)((lane >> 4) + 4 * j) * S + row) * 64 + ((4 * lane) & 63)) = pk;
                }
            }
        }
        asm volatile("s_waitcnt vmcnt(0)" ::: "memory");
        __syncthreads();
        { G2Args g; g.A = (const char*)x1b; g.B = (const char*)(p.ws + WS_WR); g.nk = D / 64; g.akstep = S * 128;
          g2_rows_A<4>(g, (size_t)u * 64, 128); g.offA[1] = g.offA[0]; g2_rows_B(g, 0, D * 2);
          EpiLogits e{(float*)lds};
          gemm2<4>(lds, g, e); }
        __syncthreads();
        const f32x4 rb = *((const f32x4*)p.r_bias + lane);
        const float NEG = -__builtin_inff();
        for (int i0 = 0; i0 < 8; i0 += 4) {
            float sc[4][4], cand[4][4]; int my_e[4]; float my_s[4], gsum[4];
#pragma unroll
            for (int q = 0; q < 4; ++q) {
                const int tl = w * 8 + i0 + q;
                const f32x4 lg = *((const f32x4*)((const float*)lds + tl * 256) + lane);
#pragma unroll
                for (int j = 0; j < 4; ++j) { sc[q][j] = 1.0f / (1.0f + __expf(-lg[j])); cand[q][j] = sc[q][j] + rb[j]; }
                my_e[q] = 0; my_s[q] = 0.f; gsum[q] = 0.f;
            }
            float a1[4], a2[4];
#pragma unroll
            for (int q = 0; q < 4; ++q) { const float m01 = fmaxf(cand[q][0], cand[q][1]), n01 = fminf(cand[q][0], cand[q][1]), m23 = fmaxf(cand[q][2], cand[q][3]), n23 = fminf(cand[q][2], cand[q][3]);
              a1[q] = fmaxf(m01, m23); a2[q] = fmaxf(fminf(m01, m23), fmaxf(n01, n23)); }
#pragma unroll
            for (int off = 1; off < 8; off <<= 1) {
#pragma unroll
                for (int q = 0; q < 4; ++q) { const float b1 = __shfl_xor(a1[q], off), b2 = __shfl_xor(a2[q], off); const float n1 = fmaxf(a1[q], b1), n2 = fmaxf(fminf(a1[q], b1), fmaxf(a2[q], b2)); a1[q] = n1; a2[q] = n2; }
            }
            const int mygrp = lane >> 3;
#pragma unroll
            for (int q = 0; q < 4; ++q) {
                const float gs = a1[q] + a2[q]; int rank = 0;
#pragma unroll
                for (int g2 = 0; g2 < 8; ++g2) { const float v = __shfl(gs, g2 * 8); rank += (v > gs || (v == gs && g2 < mygrp)) ? 1 : 0; }
                if (rank >= 4) {
#pragma unroll
                    for (int j = 0; j < 4; ++j) cand[q][j] = NEG;
                }
            }
#pragma unroll
            for (int k = 0; k < 8; ++k) {
                float bv[4]; int idx[4];
#pragma unroll
                for (int q = 0; q < 4; ++q) { bv[q] = cand[q][0]; int bi = 0;
#pragma unroll
                    for (int j = 1; j < 4; ++j) if (cand[q][j] > bv[q]) { bv[q] = cand[q][j]; bi = j; }
                    idx[q] = 4 * lane + bi; }
#pragma unroll
                for (int off = 32; off >= 1; off >>= 1) {
#pragma unroll
                    for (int q = 0; q < 4; ++q) { const float ov = __shfl_xor(bv[q], off); const int oi = __shfl_xor(idx[q], off); if (ov > bv[q] || (ov == bv[q] && oi < idx[q])) { bv[q] = ov; idx[q] = oi; } }
                }
#pragma unroll
                for (int q = 0; q < 4; ++q) {
                    const int owner = idx[q] >> 2, sub = idx[q] & 3;
                    float scv = sc[q][0];
#pragma unroll
                    for (int j = 1; j < 4; ++j) scv = (sub == j) ? sc[q][j] : scv;
                    if (lane == owner) {
#pragma unroll
                        for (int j = 0; j < 4; ++j) if (sub == j) cand[q][j] = NEG;
                    }
                    const float gsc = __shfl(scv, owner);
                    if (lane == k) { my_e[q] = idx[q]; my_s[q] = gsc; }
                    gsum[q] += gsc;
                }
            }
            if (lane < 8) {
#pragma unroll
                for (int q = 0; q < 4; ++q) {
                    const int t = u * 64 + w * 8 + i0 + q;
                    const float gate = my_s[q] / gsum[q] * 2.5f;
                    const unsigned pos = atomicAdd(cnt + my_e[q] * CNT_STRIDE, 1u);
                    list[(size_t)my_e[q] * CAP + pos] = t * 8 + lane;
                    gates[t * 8 + lane] = gate;
                }
            }
        }
        __syncthreads();
    }
}

#ifndef MOE_MT
#define MOE_MT 8
#endif
constexpr int MOE_BM = 32 * MOE_MT;
struct EpiAct {
    bf16_t* act; const int* slots;
    __device__ __forceinline__ void operator()(f32x4 (&acc)[MOE_MT][4], int pass, int wr, int wc, int fr, int fq) const {
        const int ncol0 = pass * 128;
#pragma unroll
        for (int mt = 0; mt < MOE_MT; ++mt) {
            const int ar = slots[wr * 16 * MOE_MT + mt * 16 + fr];
            if (ar >= 0) {
                float a[8];
#pragma unroll
                for (int nt = 0; nt < 2; ++nt)
#pragma unroll
                    for (int j = 0; j < 4; ++j) { const float gq = acc[mt][nt][j]; a[nt * 4 + j] = gq / (1.0f + __expf(-gq)) * (acc[mt][nt + 2][j]); }
                u32x4 pk = {cvt_pk(a[0], a[1]), cvt_pk(a[2], a[3]), cvt_pk(a[4], a[5]), cvt_pk(a[6], a[7])};
                *(u32x4*)(act + (size_t)ar * FF + ncol0 + wc * 32 + 8 * fq) = pk;
            }
        }
    }
};
struct EpiY {
    bf16_t* y; const int* yrows; const float* gl;
    __device__ __forceinline__ void operator()(f32x4 (&acc)[MOE_MT][4], int pass, int wr, int wc, int fr, int fq) const {
        const int col0 = pass * 256;
#pragma unroll
        for (int mt = 0; mt < MOE_MT; ++mt) {
            const int r = wr * 16 * MOE_MT + mt * 16 + fr, yr = yrows[r];
            if (yr >= 0) {
                const float gt = gl[r];
#pragma unroll
                for (int a = 0; a < 2; ++a) {
                    const f32x4 v0 = acc[mt][2 * a] * gt, v1 = acc[mt][2 * a + 1] * gt;
                    u32x4 pk = {cvt_pk(v0[0], v0[1]), cvt_pk(v0[2], v0[3]), cvt_pk(v1[0], v1[1]), cvt_pk(v1[2], v1[3])};
                    *(u32x4*)(y + (size_t)yr * D + col0 + wc * 64 + a * 32 + 8 * fq) = pk;
                }
            }
        }
    }
};
__device__ __forceinline__ void phase_experts(const Params& p, char* lds, int vb, int G) {
    const int tid0 = threadIdx.x, w = __builtin_amdgcn_readfirstlane(tid0 >> 6);
    const unsigned* cnt = (const unsigned*)(p.ws + WS_CTL + 65536); const int* list = (const int*)(p.ws + WS_LIST); const float* gates = (const float*)(p.ws + WS_GATE);
    bf16_t* act = (bf16_t*)(p.ws + WS_ACT); bf16_t* ybuf = (bf16_t*)(p.ws + WS_Y);
    int* nts = (int*)(lds + LDS_MISC); int* pre = nts + 256;
    int* s_arow = pre + 260; int* s_yrow = s_arow + MOE_BM; int* s_tok = s_yrow + MOE_BM; float* s_gate = (float*)(s_tok + MOE_BM);
    if (tid0 < 256) nts[tid0] = (int)((__hip_atomic_load(cnt + tid0 * CNT_STRIDE, __ATOMIC_RELAXED, __HIP_MEMORY_SCOPE_AGENT) + (MOE_BM - 1)) / MOE_BM);
    __syncthreads();
    if (tid0 < 257) { int s = 0; for (int e = 0; e < tid0; ++e) s += nts[e]; pre[tid0] = s; }
    __syncthreads();
    const int NR = __builtin_amdgcn_readfirstlane(pre[256]), NU = NR + S / MOE_BM;
    for (int u = vb; u < NU; u += G) {
        __syncthreads();
        int tid = threadIdx.x; asm volatile("" : "+v"(tid));
        const int lane = tid & 63; const unsigned co = g2_chunk_off(lane, w);
        const float *bg, *bu, *bd;
        if (u < NR) {
            int lo = 0, hi = 255;
            while (lo < hi) { const int mid = (lo + hi + 1) >> 1; if (pre[mid] <= u) lo = mid; else hi = mid - 1; }
            const int e = lo, tile = u - pre[e], n = (int)__hip_atomic_load(cnt + e * CNT_STRIDE, __ATOMIC_RELAXED, __HIP_MEMORY_SCOPE_AGENT);
            if (tid < MOE_BM) {
                const int idx = tile * MOE_BM + tid;
                if (idx < n) { const int slot = list[(size_t)e * CAP + idx]; s_arow[tid] = slot; s_yrow[tid] = slot + (slot >> 3); s_tok[tid] = slot >> 3; s_gate[tid] = gates[slot]; }
                else { s_arow[tid] = -1; s_yrow[tid] = -1; s_tok[tid] = 0; s_gate[tid] = 0.f; }
            }
            bg = p.w_g + (size_t)e * D * FF; bu = p.w_u + (size_t)e * D * FF; bd = p.w_d + (size_t)e * FF * D;
        } else {
            const int tile = u - NR;
            if (tid < MOE_BM) { const int tk = tile * MOE_BM + tid; s_arow[tid] = S * 8 + tk; s_yrow[tid] = tk * 9 + 8; s_tok[tid] = tk; s_gate[tid] = 1.0f; }
            bg = p.ws_g; bu = p.ws_u; bd = p.ws_d;
        }
        __syncthreads();
        { G3fArgs g; g.A = (const char*)(p.ws + WS_X1B); g.nk = D / 64; g.akstep = S * 128;
#pragma unroll
          for (int i = 0; i < MOE_MT / 2; ++i) g.offA[i] = (unsigned)s_tok[i * 64 + w * 8 + (lane >> 3)] * 128u + co;
          { const int bwc = lane >> 4, nt = (lane >> 2) & 3, bfq = lane & 3;
            g.b = ((nt < 2) ? bg : bu) + bwc * 32 + 8 * bfq + 4 * (nt & 1) + (size_t)(w * 8) * FF; }
          EpiAct e{act, s_arow};
          gemm3f<MOE_MT, FF>(lds, g, 2, 128, e); }
        asm volatile("s_waitcnt vmcnt(0)" ::: "memory");
        __syncthreads();
        { G3fArgs g; g.A = (const char*)act; g.nk = FF / 64; g.akstep = 128;
#pragma unroll
          for (int i = 0; i < MOE_MT / 2; ++i) { const int ar = s_arow[i * 64 + w * 8 + (lane >> 3)]; g.offA[i] = (unsigned)(ar < 0 ? 0 : ar) * (unsigned)(FF * 2) + co; }
          g.b = bd + (size_t)(w * 8) * D + (lane >> 4) * 64 + (((lane >> 2) & 3) >> 1) * 32 + 8 * (lane & 3) + 4 * ((lane >> 2) & 1);
          EpiY e{ybuf, s_yrow, s_gate};
          gemm3f<MOE_MT, D>(lds, g, 4, 256, e); }
    }
}

__device__ __forceinline__ void phase_final(const Params& p, int vb, int G) {
    const int lane = threadIdx.x & 63, w = threadIdx.x >> 6;
    const bf16_t* x1b = (const bf16_t*)(p.ws + WS_X1B); const bf16_t* ybuf = (const bf16_t*)(p.ws + WS_Y);
    constexpr int NR = 2;
    for (int row0 = (vb * 8 + w) * NR; row0 < S; row0 += G * 8 * NR) {
        float v[NR][2][8]; float sm[NR], sq[NR];
#pragma unroll
        for (int i = 0; i < NR; ++i) {
            const int row = row0 + i;
#pragma unroll
            for (int j = 0; j < 2; ++j) { const u32x4 q = *(const u32x4*)(x1b + ((size_t)((lane >> 3) + 8 * j) * S + row) * 64 + ((8 * lane) & 63));
#pragma unroll
                for (int e = 0; e < 4; ++e) { v[i][j][2 * e] = bf_lo(q[e]) * ALPHA; v[i][j][2 * e + 1] = bf_hi(q[e]) * ALPHA; } }
#pragma unroll
            for (int k = 0; k < 9; ++k) {
                const u32x4* yr = (const u32x4*)(ybuf + (size_t)(row * 9 + k) * D) + lane;
#pragma unroll
                for (int j = 0; j < 2; ++j) { const u32x4 q = yr[64 * j];
#pragma unroll
                    for (int e = 0; e < 4; ++e) { v[i][j][2 * e] += bf_lo(q[e]); v[i][j][2 * e + 1] += bf_hi(q[e]); } }
            }
        }
#pragma unroll
        for (int i = 0; i < NR; ++i) { float s = 0.f;
#pragma unroll
            for (int j = 0; j < 2; ++j)
#pragma unroll
                for (int e = 0; e < 8; ++e) s += v[i][j][e];
            sm[i] = s; }
#pragma unroll
        for (int o = 1; o < 64; o <<= 1) {
#pragma unroll
            for (int i = 0; i < NR; ++i) sm[i] += __shfl_xor(sm[i], o); }
#pragma unroll
        for (int i = 0; i < NR; ++i) { const float mean = sm[i] * (1.0f / D); float s2 = 0.f;
#pragma unroll
            for (int j = 0; j < 2; ++j)
#pragma unroll
                for (int e = 0; e < 8; ++e) { v[i][j][e] -= mean; s2 += v[i][j][e] * v[i][j][e]; }
            sq[i] = s2; }
#pragma unroll
        for (int o = 1; o < 64; o <<= 1) {
#pragma unroll
            for (int i = 0; i < NR; ++i) sq[i] += __shfl_xor(sq[i], o); }
#pragma unroll
        for (int j = 0; j < 2; ++j) {
            const f32x4 g0 = *((const f32x4*)p.ln2g + 2 * lane + 128 * j), g1 = *((const f32x4*)p.ln2g + 2 * lane + 128 * j + 1);
            const f32x4 b0 = *((const f32x4*)p.ln2b + 2 * lane + 128 * j), b1 = *((const f32x4*)p.ln2b + 2 * lane + 128 * j + 1);
#pragma unroll
            for (int i = 0; i < NR; ++i) { const float rstd = rsqrtf(sq[i] * (1.0f / D) + LN_EPS);
                f32x4* op = (f32x4*)(p.out + (size_t)(row0 + i) * D) + 2 * lane + 128 * j;
                op[0] = (f32x4){v[i][j][0], v[i][j][1], v[i][j][2], v[i][j][3]} * rstd * g0 + b0;
                op[1] = (f32x4){v[i][j][4], v[i][j][5], v[i][j][6], v[i][j][7]} * rstd * g1 + b1; }
        }
    }
}

__global__ void __launch_bounds__(NTHREADS) mega(Params p) {
    extern __shared__ __attribute__((aligned(16))) char lds[];
    const int G = gridDim.x, bx = blockIdx.x;
    const int vb = (G % 8 == 0) ? (bx % 8) * (G / 8) + bx / 8 : bx;
    if (threadIdx.x < 4) ((volatile LAS unsigned*)((LAS char*)lds + LDS_BARST))[threadIdx.x] = 0u;
    __syncthreads();
    XcdBarrier bar; bar.bar = (unsigned*)(p.ws + WS_CTL) + CW_BAR; bar.x = 0; bar.st = nullptr;
    if (p.ph_hi - p.ph_lo > 1) bar = xcd_barrier_post((unsigned*)(p.ws + WS_CTL) + CW_BAR, (volatile LAS unsigned*)((LAS char*)lds + LDS_BARST));
#define SEAM(k) do { if (p.ph_lo <= (k) && (k) + 1 < p.ph_hi) { xcd_barrier(bar); } } while (0)
#define IN(k) (p.ph_lo <= (k) && (k) < p.ph_hi)
#define RUN(k, call) do { if (IN(k)) { call; if (MK_REPEAT == (k)) { __syncthreads(); call; } } } while (0)
    RUN(0, phase_prep(p, vb, G)); SEAM(0);
    RUN(1, phase_proj(p, lds, vb, G)); SEAM(1);
    RUN(2, phase_attn(p, lds, vb, G)); SEAM(2);
    RUN(3, phase_wout(p, lds, vb, G)); SEAM(3);
    if (IN(4)) { phase_router(p, lds, vb, G); } SEAM(4);
    RUN(5, phase_experts(p, lds, vb, G)); SEAM(5);
    RUN(6, phase_final(p, vb, G));
#undef SEAM
#undef IN
#undef RUN
}

extern "C" void kernel_launch(void* const* d_in, const int* in_sizes, int n_in, void* d_out, int out_size, void* d_ws, size_t ws_size, hipStream_t stream) {
    static int grid = 0;
    if (grid == 0) {
        if (n_in != 22 || in_sizes[0] != S * D || out_size != S * D || ws_size < WS_END) {
            fprintf(stderr, "kernel_launch: unexpected shapes: n_in %d in0 %d out %d ws %zu (need %zu)\n", n_in, n_in > 0 ? in_sizes[0] : -1, out_size, ws_size, (size_t)WS_END); grid = -1; return; }
        int dev = 0, cus = 0, per_cu = 0;
        (void)hipGetDevice(&dev); (void)hipDeviceGetAttribute(&cus, hipDeviceAttributeMultiprocessorCount, dev);
        if (hipFuncSetAttribute((const void*)mega, hipFuncAttributeMaxDynamicSharedMemorySize, LDS_BYTES) != hipSuccess) { fprintf(stderr, "kernel_launch: hipFuncSetAttribute failed\n"); grid = -1; return; }
        (void)hipOccupancyMaxActiveBlocksPerMultiprocessor(&per_cu, (const void*)mega, NTHREADS, LDS_BYTES);
        if (per_cu < 1) { fprintf(stderr, "kernel_launch: occupancy query says %d blocks per CU\n", per_cu); per_cu = 1; }
        grid = cus * 1;
        (void)hipGetLastError();
    }
    if (grid < 0) return;
    (void)hipMemsetAsync((char*)d_ws + WS_CTL, 0, CTL_BYTES, stream);
    Params p{};
    const float** f = (const float**)&p;
    for (int i = 0; i < 22; ++i) f[i] = (const float*)d_in[i];
    p.out = (float*)d_out; p.ws = (unsigned char*)d_ws;
#if MK_ONE_LAUNCH
    p.ph_lo = 0; p.ph_hi = 7;
    void* args[] = {&p};
    hipError_t e = hipLaunchCooperativeKernel((const void*)mega, dim3(grid), dim3(NTHREADS), args, LDS_BYTES, stream);
    if (e != hipSuccess) fprintf(stderr, "kernel_launch: cooperative launch failed: %s (grid %d)\n", hipGetErrorString(e), grid);
#else
    for (int ph = 0; ph < 7; ++ph) {
        p.ph_lo = ph; p.ph_hi = ph + 1;
        hipLaunchKernelGGL(mega, dim3(grid), dim3(NTHREADS), LDS_BYTES, stream, p);
    }
#endif
}
```

```cpp
#include <hip/hip_runtime.h>
#include <hip/hip_cooperative_groups.h>
#include <cstdio>
#include <cstdint>
namespace cg = cooperative_groups;

#ifndef MK_REPEAT
#define MK_REPEAT -1
#endif
#ifndef MK_ONE_LAUNCH
#define MK_ONE_LAUNCH 1
#endif

constexpr int S = 16384, D = 1024, INW = 2304, NE = 256, FF = 256;
constexpr int NTHREADS = 512;
constexpr int CAP = 16384;
constexpr float ALPHA = 1.189207115002721f;
constexpr float LN_EPS = 1e-5f;
constexpr float QSCALE = 0.125f * 1.4426950408889634f;
constexpr float LOG2E = 1.4426950408889634f;
constexpr int C_AQ = 0, C_AK = 512, C_AV = 640, C_BQ = 768, C_BK = 1280, C_BV = 1792;

constexpr size_t MiB = 1ull << 20;
constexpr size_t WS_CTL = 0;
constexpr size_t CTL_BYTES = 128 * 1024;
constexpr int CNT_STRIDE = 64;
constexpr size_t WS_ROPE = 1 * MiB;
constexpr size_t WS_WIN = 8 * MiB;
constexpr size_t WS_WOUT = 13 * MiB;
constexpr size_t WS_WR = 15 * MiB;
constexpr size_t WS_WSGU = 16 * MiB;
constexpr size_t WS_WSD = 17 * MiB;
constexpr size_t WS_EGU = 20 * MiB;
constexpr size_t WS_ED = 276 * MiB;
constexpr size_t WS_X1F = 404 * MiB;
constexpr size_t WS_X1B = 468 * MiB;
constexpr size_t WS_LIST = 500 * MiB;
constexpr size_t WS_GATE = 516 * MiB;
constexpr size_t WS_ACT = 518 * MiB;
constexpr size_t WS_Y = 590 * MiB;
constexpr size_t WS_XB = 590 * MiB;
constexpr size_t WS_PROJ = 622 * MiB;
constexpr size_t WS_ATT = 694 * MiB;
constexpr size_t WS_PRELN = 726 * MiB;
constexpr size_t WS_END = 878 * MiB;

constexpr int LDS_BYTES = 147456;
constexpr int LDS_MISC = 131072;

typedef unsigned short bf16_t;
typedef short bf16x8 __attribute__((ext_vector_type(8)));
typedef short s16x4 __attribute__((ext_vector_type(4)));
typedef float f32x4 __attribute__((ext_vector_type(4)));
typedef float f32x16 __attribute__((ext_vector_type(16)));
typedef unsigned u32x4 __attribute__((ext_vector_type(4)));
typedef unsigned u32x2 __attribute__((ext_vector_type(2)));
typedef float f32x2 __attribute__((ext_vector_type(2)));


#define LAS __attribute__((address_space(3)))
#define XB_TMO      128
#define XB_XCNT(j)  (256  + 64 * (j))
#define XB_XSUB(j)  (1280 + 64 * (j))
#define XB_XGEN(j)  (2304 + 64 * (j))
#define XB_TOP      3328
#define XB_TOPGEN   3392
#define XCD_BAR_WORDS 3456
#define XB_SPIN_CAP (1u << 18)
__device__ __forceinline__ unsigned xb_ld(unsigned* p)              { return __hip_atomic_load(p, __ATOMIC_RELAXED, __HIP_MEMORY_SCOPE_AGENT); }
__device__ __forceinline__ unsigned xb_add(unsigned* p, unsigned v) { return __hip_atomic_fetch_add(p, v, __ATOMIC_RELAXED, __HIP_MEMORY_SCOPE_AGENT); }
__device__ __forceinline__ unsigned xb_xcc_id() { return (unsigned)__builtin_amdgcn_s_getreg((3 << 11) | 20) & 0xFu; }
#define XB_SPIN(cond, bar) do { unsigned _sp = 0; while (cond) { __builtin_amdgcn_s_sleep(1); \
    if ((++_sp & 255u) == 0u) { if (xb_ld(&(bar)[XB_TMO])) break; if (_sp > XB_SPIN_CAP) { atomicAdd(&(bar)[XB_TMO], 1u); break; } } } } while (0)
struct XcdBarrier { unsigned* bar; unsigned x; volatile LAS unsigned* st; };
__device__ __forceinline__ XcdBarrier xcd_barrier_post(unsigned* bar, volatile LAS unsigned* st) {
    XcdBarrier b; b.bar = bar; b.x = xb_xcc_id(); b.st = st;
    if (threadIdx.x == 0) (void)xb_add(&bar[XB_XCNT(b.x)], 1u);
    return b;
}
__device__ __forceinline__ void xcd_barrier_complete(unsigned* bar, unsigned x, unsigned& nloc, unsigned& nx) {
    const unsigned G = gridDim.x * gridDim.y * gridDim.z;
    unsigned sum, cnt, mine, sp = 0u;
    for (;;) {
        sum = 0u; cnt = 0u; mine = 0u;
#pragma unroll
        for (unsigned j = 0; j < 16; ++j) { const unsigned c = xb_ld(&bar[XB_XCNT(j)]); sum += c; cnt += (c > 0u) ? 1u : 0u; mine = (j == x) ? c : mine; }
        if (sum == G) break;
        __builtin_amdgcn_s_sleep(1);
        if ((++sp & 255u) == 0u) { if (xb_ld(&bar[XB_TMO])) break; if (sp > XB_SPIN_CAP) { atomicAdd(&bar[XB_TMO], 1u); break; } }
    }
    nloc = mine > 0u ? mine : 1u; nx = cnt > 0u ? cnt : 1u;
}
__device__ __forceinline__ void xcd_barrier(const XcdBarrier& b) {
    asm volatile("s_waitcnt vmcnt(0)" ::: "memory");
    __syncthreads();
    if (threadIdx.x == 0) {
        unsigned* bar = b.bar;
        __builtin_amdgcn_s_waitcnt(0);
        unsigned nloc = b.st[0], nx = b.st[1];
        if (nloc == 0u) { xcd_barrier_complete(bar, b.x, nloc, nx); b.st[0] = nloc; b.st[1] = nx; }
        const unsigned old = xb_add(&bar[XB_XSUB(b.x)], 1u);
        const unsigned gen = old / nloc;
        if (old + 1u == (gen + 1u) * nloc) {
            __builtin_amdgcn_fence(__ATOMIC_RELEASE, "agent");
            asm volatile("s_waitcnt vmcnt(0)" ::: "memory");
            const unsigned og = xb_add(&bar[XB_TOP], 1u);
            const unsigned tg = og / nx;
            if (og + 1u == (tg + 1u) * nx) xb_add(&bar[XB_TOPGEN], 1u);
            else XB_SPIN(xb_ld(&bar[XB_TOPGEN]) == tg, bar);
            __builtin_amdgcn_fence(__ATOMIC_ACQUIRE, "agent");
            xb_add(&bar[XB_XGEN(b.x)], 1u);
            asm volatile("s_waitcnt vmcnt(0)" ::: "memory");
        } else {
            XB_SPIN(xb_ld(&bar[XB_XGEN(b.x)]) == gen, bar);
            __builtin_amdgcn_fence(__ATOMIC_ACQUIRE, "agent");
            asm volatile("s_waitcnt vmcnt(0)" ::: "memory");
        }
    }
    __syncthreads();
}
constexpr int CW_BAR = 4096;
constexpr int LDS_BARST = LDS_MISC + 8192;

struct Params {
    const float* x; const float* w_in; const float* b_in; const float* sinks;
    const float* lq1; const float* lk1; const float* lq2; const float* lk2; const float* subg;
    const float* w_out; const float* ln1g; const float* ln1b; const float* w_r; const float* r_bias;
    const float* w_g; const float* w_u; const float* w_d; const float* ws_g; const float* ws_u; const float* ws_d;
    const float* ln2g; const float* ln2b;
    float* out; unsigned char* ws;
    int ph_lo, ph_hi;
};

__device__ __forceinline__ unsigned cvt_pk(float lo, float hi) { unsigned r; asm volatile("v_cvt_pk_bf16_f32 %0, %1, %2" : "=v"(r) : "v"(lo), "v"(hi)); return r; }
__device__ __forceinline__ float bf_lo(unsigned u) { return __uint_as_float(u << 16); }
__device__ __forceinline__ float bf_hi(unsigned u) { return __uint_as_float(u & 0xffff0000u); }
__device__ __forceinline__ float wave_sum(float v) {
#pragma unroll
    for (int o = 1; o < 64; o <<= 1) v += __shfl_xor(v, o);
    return v;
}
__device__ __forceinline__ float half_max(float v) { auto rr = __builtin_amdgcn_permlane32_swap(__float_as_uint(v), __float_as_uint(v), false, false); return fmaxf(__uint_as_float(rr[0]), __uint_as_float(rr[1])); }
__device__ __forceinline__ float half_sum(float v) { auto rr = __builtin_amdgcn_permlane32_swap(__float_as_uint(v), __float_as_uint(v), false, false); return __uint_as_float(rr[0]) + __uint_as_float(rr[1]); }

__device__ __forceinline__ int swz(int r, int c) { const int f = (r & 7) ^ (((r >> 3) & 1) << 1) ^ ((r >> 4) & 1); return r * 128 + ((c ^ f) << 4); }

struct G2Args {
    const char* A; const char* B;
    unsigned offA[4], offB[4];
    int nk;
    unsigned akstep;
};
__device__ __forceinline__ unsigned g2_chunk_off(int lane, int w) { const int f = (lane >> 3) ^ ((w & 1) << 1) ^ ((w >> 1) & 1); return (unsigned)(((lane & 7) ^ f) << 4); }
template <int MT, int NT, class Epi>
__device__ __forceinline__ void gemm2n(char* lds_, const G2Args& g, const Epi& epi) {
    constexpr int A_BYTES = 32 * MT * 128, B_BYTES = 64 * NT * 128, STAGE = A_BYTES + B_BYTES, AR = MT / 2, BRR = NT;
    LAS char* lds = (LAS char*)lds_;
    const int tid = threadIdx.x, lane = tid & 63, w = __builtin_amdgcn_readfirstlane(tid >> 6), wr = w >> 2, wc = w & 3, fr = lane & 15, fq = lane >> 4;
    f32x4 acc[MT][NT];
#pragma unroll
    for (int i = 0; i < MT; ++i)
#pragma unroll
        for (int j = 0; j < NT; ++j) acc[i][j] = (f32x4){0.f, 0.f, 0.f, 0.f};
    const int ldsw = w * 1024;
#define G2_STAGE(kt, s) do { \
        _Pragma("unroll") for (int i = 0; i < AR; ++i) __builtin_amdgcn_global_load_lds((const unsigned*)(g.A + g.offA[i] + (size_t)(kt) * g.akstep), (LAS unsigned*)(lds + (s) * STAGE + i * 8192 + ldsw), 16, 0, 0); \
        _Pragma("unroll") for (int i = 0; i < BRR; ++i) __builtin_amdgcn_global_load_lds((const unsigned*)(g.B + g.offB[i] + (size_t)(kt) * 128), (LAS unsigned*)(lds + (s) * STAGE + A_BYTES + i * 8192 + ldsw), 16, 0, 0); } while (0)
    G2_STAGE(0, 0);
    __syncthreads();
    for (int kt = 0; kt < g.nk; ++kt) {
        const int s = kt & 1;
        if (kt + 1 < g.nk) { if (s) G2_STAGE(kt + 1, 0); else G2_STAGE(kt + 1, 1); }
        const char* la = lds_ + s * STAGE; const char* lb = la + A_BYTES;
        {
            constexpr int NG = 2 * (MT / 4);
            bf16x8 bfr[NT], af[2][4];
#pragma unroll
            for (int nt = 0; nt < NT; ++nt) bfr[nt] = *(const bf16x8*)(lb + swz(wc * 16 * NT + nt * 16 + fr, fq));
#pragma unroll
            for (int m = 0; m < 4; ++m) af[0][m] = *(const bf16x8*)(la + swz(wr * 16 * MT + m * 16 + fr, fq));
#pragma unroll
            for (int gi = 0; gi < NG; ++gi) {
                const int ks = gi / (MT / 4), h = gi % (MT / 4);
                if (gi > 0 && h == 0) {
#pragma unroll
                    for (int nt = 0; nt < NT; ++nt) bfr[nt] = *(const bf16x8*)(lb + swz(wc * 16 * NT + nt * 16 + fr, ks * 4 + fq));
                }
                if (gi + 1 < NG) {
                    const int ks2 = (gi + 1) / (MT / 4), h2 = (gi + 1) % (MT / 4);
#pragma unroll
                    for (int m = 0; m < 4; ++m) af[(gi + 1) & 1][m] = *(const bf16x8*)(la + swz(wr * 16 * MT + (h2 * 4 + m) * 16 + fr, ks2 * 4 + fq));
                }
                __builtin_amdgcn_sched_barrier(0);
#pragma unroll
                for (int m = 0; m < 4; ++m)
#pragma unroll
                    for (int nt = 0; nt < NT; ++nt) acc[h * 4 + m][nt] = __builtin_amdgcn_mfma_f32_16x16x32_bf16(bfr[nt], af[gi & 1][m], acc[h * 4 + m][nt], 0, 0, 0);
                __builtin_amdgcn_sched_barrier(0);
            }
        }
        __syncthreads();
    }
#undef G2_STAGE
    epi(acc, wr, wc, fr, fq);
}
template <int MT, class Epi>
__device__ __forceinline__ void gemm2(char* lds_, const G2Args& g, const Epi& epi) { gemm2n<MT, 4>(lds_, g, epi); }
template <int MT>
__device__ __forceinline__ void g2_rows_A(G2Args& g, size_t row0, unsigned ld_bytes) {
    const int lane = threadIdx.x & 63, w = __builtin_amdgcn_readfirstlane(threadIdx.x >> 6); const unsigned co = g2_chunk_off(lane, w);
#pragma unroll
    for (int i = 0; i < MT / 2; ++i) g.offA[i] = (unsigned)((row0 + i * 64 + w * 8 + (lane >> 3)) * ld_bytes) + co;
}
__device__ __forceinline__ void g2_rows_B(G2Args& g, size_t row0, unsigned ld_bytes) {
    const int lane = threadIdx.x & 63, w = __builtin_amdgcn_readfirstlane(threadIdx.x >> 6); const unsigned co = g2_chunk_off(lane, w);
#pragma unroll
    for (int i = 0; i < 4; ++i) g.offB[i] = (unsigned)((row0 + i * 64 + w * 8 + (lane >> 3)) * ld_bytes) + co;
}


struct G3fArgs { const char* A; unsigned offA[4]; const float* b; int nk; unsigned akstep; };
template <int MT, int LDB, class Epi>
__device__ __forceinline__ void gemm3f(char* lds_, const G3fArgs& g, int npass, int bpstep, const Epi& epi) {
    constexpr int A_BYTES = 32 * MT * 128, B_BYTES = 256 * 128, STAGE = A_BYTES + B_BYTES, AR = MT / 2;
    LAS char* lds = (LAS char*)lds_;
    const int tid = threadIdx.x, lane = tid & 63, w = __builtin_amdgcn_readfirstlane(tid >> 6), wr = w >> 2, wc = w & 3, fr = lane & 15, fq = lane >> 4;
    f32x4 acc[MT][4];
#pragma unroll
    for (int i = 0; i < MT; ++i)
#pragma unroll
        for (int j = 0; j < 4; ++j) acc[i][j] = (f32x4){0.f, 0.f, 0.f, 0.f};
    const int ldsw = w * 1024;
    int bw[4];
#pragma unroll
    for (int j = 0; j < 4; ++j) bw[j] = swz(4 * lane + j, w);
    f32x4 br[8];
    const int nk = g.nk, nsteps = nk * npass;
#define G3_STAGE_A(kt, s) do { \
        _Pragma("unroll") for (int i = 0; i < AR; ++i) __builtin_amdgcn_global_load_lds((const unsigned*)(g.A + g.offA[i] + (size_t)(kt) * g.akstep), (LAS unsigned*)(lds + (s) * STAGE + i * 8192 + ldsw), 16, 0, 0); } while (0)
#define G3_LOAD_B(ps, kt) do { const float* pb_ = g.b + (size_t)(ps) * bpstep + (size_t)(kt) * 64 * LDB; _Pragma("unroll") for (int i = 0; i < 8; ++i) br[i] = *(const f32x4*)(pb_ + i * LDB); } while (0)
#define G3_WRITE_B(s) do { _Pragma("unroll") for (int j = 0; j < 4; ++j) { \
            u32x4 v = {cvt_pk(br[0][j], br[1][j]), cvt_pk(br[2][j], br[3][j]), cvt_pk(br[4][j], br[5][j]), cvt_pk(br[6][j], br[7][j])}; \
            *(u32x4*)(lds_ + (s) * STAGE + A_BYTES + bw[j]) = v; } } while (0)
    G3_STAGE_A(0, 0); G3_LOAD_B(0, 0); G3_WRITE_B(0);
    __syncthreads();
    int ps = 0, kt = 0;
    for (int st = 0; st < nsteps; ++st) {
        const int s = st & 1; const bool more = st + 1 < nsteps;
        int ps2 = ps, kt2 = kt + 1; if (kt2 == nk) { kt2 = 0; ++ps2; }
        if (more) { if (s) G3_STAGE_A(kt2, 0); else G3_STAGE_A(kt2, 1); G3_LOAD_B(ps2, kt2); }
        __builtin_amdgcn_sched_barrier(0);
        const char* la = lds_ + s * STAGE; const char* lb = la + A_BYTES;
#pragma unroll
        for (int ks = 0; ks < 2; ++ks) {
            bf16x8 bfr[4];
#pragma unroll
            for (int nt = 0; nt < 4; ++nt) bfr[nt] = *(const bf16x8*)(lb + swz(wc * 64 + nt * 16 + fr, ks * 4 + fq));
#pragma unroll
            for (int h = 0; h < MT / 2; ++h) {
                bf16x8 af[2];
#pragma unroll
                for (int m = 0; m < 2; ++m) af[m] = *(const bf16x8*)(la + swz(wr * 16 * MT + (h * 2 + m) * 16 + fr, ks * 4 + fq));
                __builtin_amdgcn_sched_barrier(0);
#pragma unroll
                for (int m = 0; m < 2; ++m)
#pragma unroll
                    for (int nt = 0; nt < 4; ++nt) acc[h * 2 + m][nt] = __builtin_amdgcn_mfma_f32_16x16x32_bf16(bfr[nt], af[m], acc[h * 2 + m][nt], 0, 0, 0);
                __builtin_amdgcn_sched_barrier(0);
            }
        }
        if (kt == nk - 1) {
            epi(acc, ps, wr, wc, fr, fq);
#pragma unroll
            for (int i = 0; i < MT; ++i)
#pragma unroll
                for (int j = 0; j < 4; ++j) acc[i][j] = (f32x4){0.f, 0.f, 0.f, 0.f};
        }
        if (more) { if (s) G3_WRITE_B(0); else G3_WRITE_B(1); }
        __syncthreads();
        ps = ps2; kt = kt2;
    }
#undef G3_STAGE_A
#undef G3_LOAD_B
#undef G3_WRITE_B
}

__device__ __forceinline__ void cvt_item(const float* W, int K, int N, bf16_t* WT, int ldt, int kb, int nb, int kc, int lane) {
    const float* src = W + (size_t)(kb * 64 + kc * 8) * N + nb * 256 + 4 * lane;
    bf16_t* dst = WT + (size_t)(nb * 256 + 4 * lane) * ldt + kb * 64 + kc * 8;
    f32x4 r[8];
#pragma unroll
    for (int i = 0; i < 8; ++i) r[i] = *(const f32x4*)(src + (size_t)i * N);
#pragma unroll
    for (int j = 0; j < 4; ++j) {
        u32x4 v = {cvt_pk(r[0][j], r[1][j]), cvt_pk(r[2][j], r[3][j]), cvt_pk(r[4][j], r[5][j]), cvt_pk(r[6][j], r[7][j])};
        *(u32x4*)(dst + (size_t)j * ldt) = v;
    }
}
__device__ __forceinline__ void phase_prep(const Params& p, int vb, int G) {
    const int tid = threadIdx.x, lane = tid & 63, w = tid >> 6;
    float* cs = (float*)(p.ws + WS_ROPE); float* sn = cs + (size_t)S * 32;
    for (int idx = vb * NTHREADS + tid; idx < S * 32; idx += G * NTHREADS) {
        const int pos = idx >> 5, i = idx & 31;
        const float pw = (float)pow(10000.0, (double)i / 32.0);
        const float inv = 1.0f / pw;
        const float angf = __fmul_rn((float)pos, inv);
        const double a = (double)angf;
        const double q = rint(a * 0.63661977236758134308);
        double r = fma(-q, 1.57079632679489655800, a); r = fma(-q, 6.12323399573676603587e-17, r);
        const double r2 = r * r;
        double sp = r * (1.0 + r2 * (-1.0 / 6 + r2 * (1.0 / 120 + r2 * (-1.0 / 5040 + r2 * (1.0 / 362880 + r2 * (-1.0 / 39916800))))));
        double cp = 1.0 + r2 * (-0.5 + r2 * (1.0 / 24 + r2 * (-1.0 / 720 + r2 * (1.0 / 40320 + r2 * (-1.0 / 3628800 + r2 * (1.0 / 479001600))))));
        const int qi = ((int)((long long)q)) & 3;
        double sv, cv;
        if (qi == 0) { sv = sp; cv = cp; } else if (qi == 1) { sv = cp; cv = -sp; } else if (qi == 2) { sv = -sp; cv = -cp; } else { sv = -cp; cv = sp; }
        cs[idx] = (float)cv; sn[idx] = (float)sv;
    }
    { const f32x4* xs = (const f32x4*)p.x; u32x4* xd = (u32x4*)(p.ws + WS_XB);
      for (size_t i = (size_t)vb * NTHREADS + tid; i < (size_t)S * D / 8; i += (size_t)G * NTHREADS) {
          const f32x4 a = xs[2 * i], b = xs[2 * i + 1];
          xd[i] = (u32x4){cvt_pk(a[0], a[1]), cvt_pk(a[2], a[3]), cvt_pk(b[0], b[1]), cvt_pk(b[2], b[3])}; } }
    const int gw = vb * 8 + w, NGW = G * 8;
    constexpr int I_IN = 16 * 9, I_OUT = 16 * 4, I_R = 16, I_SG = 16, I_SU = 16, I_SD = 4 * 4, I_SMALL = I_IN + I_OUT + I_R;
    for (int it8 = gw; it8 < I_SMALL * 8; it8 += NGW) {
        int r = it8 >> 3; const int kc = it8 & 7;
        if (r < I_IN) { cvt_item(p.w_in, D, INW, (bf16_t*)(p.ws + WS_WIN), D, r / 9, r % 9, kc, lane); continue; } r -= I_IN;
        if (r < I_OUT) { cvt_item(p.w_out, D, D, (bf16_t*)(p.ws + WS_WOUT), D, r >> 2, r & 3, kc, lane); continue; } r -= I_OUT;
        cvt_item(p.w_r, D, NE, (bf16_t*)(p.ws + WS_WR), D, r, 0, kc, lane);
    }
}

template <int MT> struct EpiProj {
    const float* bias; const float* cs; const float* sn; bf16_t* out; int row0, col0; char* lds;
    __device__ __forceinline__ void operator()(f32x4 (&acc)[MT][4], int wr, int wc, int fr, int fq) const {
        const int hb = col0 + wc * 64;
        const bool is_q = (hb < C_AK) || (hb >= C_BQ && hb < C_BK);
        const bool is_rope = is_q || (hb >= C_AK && hb < C_AV) || (hb >= C_BK && hb < C_BV);
        const float sc = is_q ? QSCALE : 1.0f;
        const int tid = threadIdx.x, w = __builtin_amdgcn_readfirstlane(tid >> 6), lane = tid & 63;
        constexpr int TB = 32 * MT * 128;
        LAS char* l3 = (LAS char*)lds;
#pragma unroll
        for (int i = 0; i < TB / 8192; ++i) {
            __builtin_amdgcn_global_load_lds((const unsigned*)((const char*)(cs + (size_t)row0 * 32) + i * 8192 + w * 1024 + lane * 16), (LAS unsigned*)(l3 + i * 8192 + w * 1024), 16, 0, 0);
            __builtin_amdgcn_global_load_lds((const unsigned*)((const char*)(sn + (size_t)row0 * 32) + i * 8192 + w * 1024 + lane * 16), (LAS unsigned*)(l3 + TB + i * 8192 + w * 1024), 16, 0, 0);
        }
        f32x4 bv[4];
#pragma unroll
        for (int nt = 0; nt < 4; ++nt) bv[nt] = *(const f32x4*)(bias + hb + nt * 16 + 4 * fq);
        __syncthreads();
        const float* lcs = (const float*)lds; const float* lsn = (const float*)(lds + TB);
#pragma unroll
        for (int mt = 0; mt < MT; ++mt) {
            const int rl = wr * 16 * MT + mt * 16 + fr, row = row0 + rl;
            f32x4 v[4];
#pragma unroll
            for (int nt = 0; nt < 4; ++nt) v[nt] = acc[mt][nt] + bv[nt];
            if (is_rope) {
#pragma unroll
                for (int nt = 0; nt < 2; ++nt) {
                    const f32x4 c = *(const f32x4*)(lcs + rl * 32 + nt * 16 + 4 * fq), s = *(const f32x4*)(lsn + rl * 32 + nt * 16 + 4 * fq);
                    const f32x4 t1 = v[nt], t2 = v[nt + 2];
                    v[nt] = t1 * c - t2 * s; v[nt + 2] = t2 * c + t1 * s;
                }
            }
#pragma unroll
            for (int nt = 0; nt < 4; ++nt) {
                const f32x4 o = v[nt] * sc;
                u32x2 pk = {cvt_pk(o[0], o[1]), cvt_pk(o[2], o[3])};
                *(u32x2*)(out + (size_t)row * INW + hb + nt * 16 + 4 * fq) = pk;
            }
        }
        __syncthreads();
    }
};
struct EpiProjQ {
    const float* bias; const float* cs; const float* sn; bf16_t* out; int row0, col0;
    __device__ __forceinline__ void operator()(f32x4 (&acc)[4][2], int wr, int wc, int fr, int fq) const {
        const int hb = col0 + (wc >> 1) * 64, i0 = (wc & 1) * 16 + 4 * fq;
        const bool is_q = (hb < C_AK) || (hb >= C_BQ && hb < C_BK);
        const bool is_rope = is_q || (hb >= C_AK && hb < C_AV) || (hb >= C_BK && hb < C_BV);
        const float sc = is_q ? QSCALE : 1.0f;
#pragma unroll
        for (int mt = 0; mt < 4; ++mt) {
            const int row = row0 + wr * 64 + mt * 16 + fr;
            f32x4 v0 = acc[mt][0] + *(const f32x4*)(bias + hb + i0), v1 = acc[mt][1] + *(const f32x4*)(bias + hb + 32 + i0);
            if (is_rope) {
                const f32x4 c = *(const f32x4*)(cs + (size_t)row * 32 + i0), s = *(const f32x4*)(sn + (size_t)row * 32 + i0);
                const f32x4 t1 = v0, t2 = v1; v0 = t1 * c - t2 * s; v1 = t2 * c + t1 * s;
            }
            v0 = v0 * sc; v1 = v1 * sc;
            *(u32x2*)(out + (size_t)row * INW + hb + i0) = (u32x2){cvt_pk(v0[0], v0[1]), cvt_pk(v0[2], v0[3])};
            *(u32x2*)(out + (size_t)row * INW + hb + 32 + i0) = (u32x2){cvt_pk(v1[0], v1[1]), cvt_pk(v1[2], v1[3])};
        }
    }
};
__device__ __forceinline__ void phase_proj(const Params& p, char* lds, int vb, int G) {
    const float* cs = (const float*)(p.ws + WS_ROPE); const float* sn = cs + (size_t)S * 32;
    constexpr int NBIG = 512, NUNITS = NBIG + 4 * 64;
    for (int u = vb; u < NUNITS; u += G) {
        G2Args g; g.A = (const char*)(p.ws + WS_XB); g.B = (const char*)(p.ws + WS_WIN); g.nk = D / 64; g.akstep = 128;
        if (u < NBIG) {
            const int tm = u / 9, tn = u % 9;
            g2_rows_A<8>(g, (size_t)tm * 256, D * 2); g2_rows_B(g, (size_t)tn * 256, D * 2);
            EpiProj<8> e{p.b_in, cs, sn, (bf16_t*)(p.ws + WS_PROJ), tm * 256, tn * 256, lds};
            gemm2<8>(lds, g, e);
        } else {
            const int q = u - NBIG, t = NBIG + (q >> 2), hm = (q >> 1) & 1, hn = q & 1, tm = t / 9, tn = t % 9;
            g2_rows_A<4>(g, (size_t)tm * 256 + hm * 128, D * 2);
            { const int lane = threadIdx.x & 63, w = __builtin_amdgcn_readfirstlane(threadIdx.x >> 6); const unsigned co = g2_chunk_off(lane, w);
#pragma unroll
              for (int i = 0; i < 2; ++i) { const int n = i * 64 + w * 8 + (lane >> 3), wcn = n >> 5, sub = n & 31;
                  const int col = tn * 256 + hn * 128 + (wcn >> 1) * 64 + (wcn & 1) * 16 + (sub & 15) + (sub >> 4) * 32;
                  g.offB[i] = (unsigned)col * (unsigned)(D * 2) + co; } }
            EpiProjQ e{p.b_in, cs, sn, (bf16_t*)(p.ws + WS_PROJ), tm * 256 + hm * 128, tn * 256 + hn * 128};
            gemm2n<4, 2>(lds, g, e);
        }
    }
}

template <int OFF> __device__ __forceinline__ s16x4 tr_read(int vb) { s16x4 r; asm volatile("ds_read_b64_tr_b16 %0, %1 offset:%2" : "=&v"(r) : "v"(vb), "i"(OFF) : "memory"); return r; }
__device__ __forceinline__ int v_off(int k, int c, int ndb) { return ((k >> 3) * ndb + (c >> 5)) * 512 + ((k & 7) * 32 + (c & 31)) * 2; }

constexpr int AT_STAGE = 32768;
template <int NDB, int KB, int T> struct PvPart {
    static __device__ __forceinline__ void run(f32x16& o, int vbase, const bf16x8& pa, const bf16x8& pb) {
        constexpr int o0 = (KB * 4 * NDB + T) * 512, st = NDB * 512;
        const s16x4 l0 = tr_read<o0 + 0 * st>(vbase), h0 = tr_read<o0 + 1 * st>(vbase), l1 = tr_read<o0 + 2 * st>(vbase), h1 = tr_read<o0 + 3 * st>(vbase);
        asm volatile("s_waitcnt lgkmcnt(0)" ::: "memory"); __builtin_amdgcn_sched_barrier(0);
#define PKV(L, H) (bf16x8){L[0], L[1], L[2], L[3], H[0], H[1], H[2], H[3]}
        o = __builtin_amdgcn_mfma_f32_32x32x16_bf16(PKV(l0, h0), pa, o, 0, 0, 0);
        o = __builtin_amdgcn_mfma_f32_32x32x16_bf16(PKV(l1, h1), pb, o, 0, 0, 0);
#undef PKV
    }
};
template <int NDB, int KB>
__device__ __forceinline__ void pv_half(f32x16 (&o)[NDB], f32x16& ol, int vbase, const bf16x8& pa, const bf16x8& pb) {
    const bf16x8 ones = {16256, 16256, 16256, 16256, 16256, 16256, 16256, 16256};
    ol = __builtin_amdgcn_mfma_f32_32x32x16_bf16(ones, pa, ol, 0, 0, 0);
    ol = __builtin_amdgcn_mfma_f32_32x32x16_bf16(ones, pb, ol, 0, 0, 0);
    PvPart<NDB, KB, 0>::run(o[0], vbase, pa, pb); PvPart<NDB, KB, 1>::run(o[1], vbase, pa, pb);
    if constexpr (NDB == 4) { PvPart<NDB, KB, 2>::run(o[2], vbase, pa, pb); PvPart<NDB, KB, 3>::run(o[3], vbase, pa, pb); }
}
constexpr float ATT_THR = 10.0f;
template <int NDB>
__device__ __forceinline__ void attn_scores(char* lds, int kof, const bf16x8 (&qf)[4], f32x16& s0, f32x16& s1, f32x16 (&o)[NDB], f32x16& ol, f32x16& nm, bool first, int r32, int hi) {
    s0 = nm; s1 = nm;
#pragma unroll
    for (int ds = 0; ds < 4; ++ds) {
        const bf16x8 k0 = *(const bf16x8*)(lds + kof + swz(r32, ds * 2 + hi)), k1 = *(const bf16x8*)(lds + kof + swz(32 + r32, ds * 2 + hi));
        s0 = __builtin_amdgcn_mfma_f32_32x32x16_bf16(k0, qf[ds], s0, 0, 0, 0);
        s1 = __builtin_amdgcn_mfma_f32_32x32x16_bf16(k1, qf[ds], s1, 0, 0, 0);
    }
    float mx = fmaxf(s0[0], s1[0]);
#pragma unroll
    for (int r = 1; r < 16; ++r) mx = fmaxf(fmaxf(mx, s0[r]), s1[r]);
    mx = half_max(mx);
    if (first || __any(mx > ATT_THR)) {
        const float delta = first ? mx : fmaxf(mx, 0.f), alpha = first ? 0.f : __builtin_amdgcn_exp2f(-delta);
#pragma unroll
        for (int r = 0; r < 16; ++r) { s0[r] -= delta; s1[r] -= delta; nm[r] -= delta; ol[r] *= alpha; }
#pragma unroll
        for (int t = 0; t < NDB; ++t)
#pragma unroll
            for (int r = 0; r < 16; ++r) o[t][r] *= alpha;
    }
}
__device__ __forceinline__ void exp_pack(const f32x16& s, bf16x8& pa, bf16x8& pb) {
    float e[16];
#pragma unroll
    for (int r = 0; r < 16; ++r) e[r] = __builtin_amdgcn_exp2f(s[r]);
    u32x4 a = {cvt_pk(e[0], e[1]), cvt_pk(e[2], e[3]), cvt_pk(e[4], e[5]), cvt_pk(e[6], e[7])};
    u32x4 b = {cvt_pk(e[8], e[9]), cvt_pk(e[10], e[11]), cvt_pk(e[12], e[13]), cvt_pk(e[14], e[15])};
    pa = *(bf16x8*)&a; pb = *(bf16x8*)&b;
}

template <int OFF> __device__ __forceinline__ bf16x8 k_read(int a) { bf16x8 r; asm volatile("ds_read_b128 %0, %1 offset:%2" : "=&v"(r) : "v"(a), "i"(OFF) : "memory"); return r; }
struct VSet { s16x4 l0, h0, l1, h1; };
template <int KB, int T> __device__ __forceinline__ void v_issue(VSet& v, int vbase) {
    constexpr int o0 = (KB * 16 + T) * 512, st = 4 * 512;
    v.l0 = tr_read<o0>(vbase); v.h0 = tr_read<o0 + st>(vbase); v.l1 = tr_read<o0 + 2 * st>(vbase); v.h1 = tr_read<o0 + 3 * st>(vbase);
}
#define WAIT_K(n, a, b) asm volatile("s_waitcnt lgkmcnt(" #n ")" : "+v"(a), "+v"(b) :: "memory")
#define WAIT_V(n, v) asm volatile("s_waitcnt lgkmcnt(" #n ")" : "+v"(v.l0), "+v"(v.h0), "+v"(v.l1), "+v"(v.h1) :: "memory")
#define PKV(L, H) (bf16x8){L[0], L[1], L[2], L[3], H[0], H[1], H[2], H[3]}
#define MF32(a, b, c) __builtin_amdgcn_mfma_f32_32x32x16_bf16(a, b, c, 0, 0, 0)
#define SB __builtin_amdgcn_sched_barrier(0)
#define EXP4(src, i, wlo, whi) do { const float e0_ = __builtin_amdgcn_exp2f(src[4 * (i)]), e1_ = __builtin_amdgcn_exp2f(src[4 * (i) + 1]), e2_ = __builtin_amdgcn_exp2f(src[4 * (i) + 2]), e3_ = __builtin_amdgcn_exp2f(src[4 * (i) + 3]); \
        l2 += (f32x2){e0_, e1_}; l2 += (f32x2){e2_, e3_}; wlo = cvt_pk(e0_, e1_); whi = cvt_pk(e2_, e3_); } while (0)
#define MAX4(i) do { mx = fmaxf(fmaxf(mx, n0[4 * (i)]), n1[4 * (i)]); mx = fmaxf(fmaxf(mx, n0[4 * (i) + 1]), n1[4 * (i) + 1]); \
        mx = fmaxf(fmaxf(mx, n0[4 * (i) + 2]), n1[4 * (i) + 2]); mx = fmaxf(fmaxf(mx, n0[4 * (i) + 3]), n1[4 * (i) + 3]); } while (0)
__device__ __forceinline__ void diff_slot(f32x16& c0, f32x16& c1, f32x16& n0, f32x16& n1, f32x16 (&o)[4], f32x2& l2, f32x16& nm, const bf16x8 (&qf)[4],
                                          int ka0, int ka1, int ka2, int ka3, int vbase, bool has_next) {
    constexpr bool HASNEXT = true;
    bf16x8 kA, kB, kC, kD, kE, kF, kG, kH; VSet v0, v1, v2, v3, v4, v5, v6, v7; u32x4 w0, w1, w2, w3;
    SB;
    if constexpr (HASNEXT) { kA = k_read<0>(ka0); kB = k_read<4096>(ka0); kC = k_read<0>(ka1); kD = k_read<4096>(ka1); }
    EXP4(c0, 0, w0[0], w0[1]);
    if constexpr (HASNEXT) { WAIT_K(2, kA, kB); kE = k_read<0>(ka2); kF = k_read<4096>(ka2); n0 = MF32(kA, qf[0], nm); n1 = MF32(kB, qf[0], nm); }
    SB;
    EXP4(c0, 1, w0[2], w0[3]);
    if constexpr (HASNEXT) { WAIT_K(2, kC, kD); kG = k_read<0>(ka3); kH = k_read<4096>(ka3); n0 = MF32(kC, qf[1], n0); n1 = MF32(kD, qf[1], n1); }
    SB;
    EXP4(c0, 2, w1[0], w1[1]);
    if constexpr (HASNEXT) { WAIT_K(2, kE, kF); }
    v_issue<0, 0>(v0, vbase);
    if constexpr (HASNEXT) { n0 = MF32(kE, qf[2], n0); n1 = MF32(kF, qf[2], n1); }
    SB;
    EXP4(c0, 3, w1[2], w1[3]);
    if constexpr (HASNEXT) { WAIT_K(4, kG, kH); }
    v_issue<0, 1>(v1, vbase);
    if constexpr (HASNEXT) { n0 = MF32(kG, qf[3], n0); n1 = MF32(kH, qf[3], n1); }
    const bf16x8 p0 = *(bf16x8*)&w0, p1 = *(bf16x8*)&w1;
    SB;
    EXP4(c1, 0, w2[0], w2[1]);
    WAIT_V(4, v0); v_issue<0, 2>(v2, vbase);
    o[0] = MF32(PKV(v0.l0, v0.h0), p0, o[0]); o[0] = MF32(PKV(v0.l1, v0.h1), p1, o[0]);
    SB;
    EXP4(c1, 1, w2[2], w2[3]);
    WAIT_V(4, v1); v_issue<0, 3>(v3, vbase);
    o[1] = MF32(PKV(v1.l0, v1.h0), p0, o[1]); o[1] = MF32(PKV(v1.l1, v1.h1), p1, o[1]);
    SB;
    EXP4(c1, 2, w3[0], w3[1]);
    WAIT_V(4, v2); v_issue<1, 0>(v4, vbase);
    o[2] = MF32(PKV(v2.l0, v2.h0), p0, o[2]); o[2] = MF32(PKV(v2.l1, v2.h1), p1, o[2]);
    SB;
    EXP4(c1, 3, w3[2], w3[3]);
    WAIT_V(4, v3); v_issue<1, 1>(v5, vbase);
    o[3] = MF32(PKV(v3.l0, v3.h0), p0, o[3]); o[3] = MF32(PKV(v3.l1, v3.h1), p1, o[3]);
    const bf16x8 p2 = *(bf16x8*)&w2, p3 = *(bf16x8*)&w3;
    SB;
    float mx = -3.0e38f;
    if constexpr (HASNEXT) MAX4(0);
    WAIT_V(4, v4); v_issue<1, 2>(v6, vbase);
    o[0] = MF32(PKV(v4.l0, v4.h0), p2, o[0]); o[0] = MF32(PKV(v4.l1, v4.h1), p3, o[0]);
    SB;
    if constexpr (HASNEXT) MAX4(1);
    WAIT_V(4, v5); v_issue<1, 3>(v7, vbase);
    o[1] = MF32(PKV(v5.l0, v5.h0), p2, o[1]); o[1] = MF32(PKV(v5.l1, v5.h1), p3, o[1]);
    SB;
    if constexpr (HASNEXT) MAX4(2);
    WAIT_V(4, v6);
    o[2] = MF32(PKV(v6.l0, v6.h0), p2, o[2]); o[2] = MF32(PKV(v6.l1, v6.h1), p3, o[2]);
    SB;
    if constexpr (HASNEXT) MAX4(3);
    WAIT_V(0, v7);
    o[3] = MF32(PKV(v7.l0, v7.h0), p2, o[3]); o[3] = MF32(PKV(v7.l1, v7.h1), p3, o[3]);
    SB;
    if (has_next) {
        mx = half_max(mx);
        if (__any(mx > ATT_THR)) {
            const float delta = fmaxf(mx, 0.f), alpha = __builtin_amdgcn_exp2f(-delta);
#pragma unroll
            for (int r = 0; r < 16; ++r) { n0[r] -= delta; n1[r] -= delta; nm[r] -= delta; }
            l2 *= alpha;
#pragma unroll
            for (int t = 0; t < 4; ++t)
#pragma unroll
                for (int r = 0; r < 16; ++r) o[t][r] *= alpha;
        }
    }
}
__device__ __forceinline__ void attn_diff_unit(const Params& p, char* lds_, int h, int qb, float lam) {
    LAS char* lds = (LAS char*)lds_;
    const int tid = threadIdx.x, lane = tid & 63, w = __builtin_amdgcn_readfirstlane(tid >> 6), r32 = lane & 31, hi = lane >> 5, mp = w >> 2, wq = w & 3;
    const bf16_t* proj = (const bf16_t*)(p.ws + WS_PROJ);
    const int NT = 2 * qb + 2, NP = NT / 2, myNT = (wq < 2) ? NT - 1 : NT;
    bf16x8 qf[4];
    { const bf16_t* qp = proj + (size_t)(qb * 128 + wq * 32 + r32) * INW + C_BQ + h * 128 + mp * 64 + hi * 8;
#pragma unroll
      for (int ds = 0; ds < 4; ++ds) qf[ds] = *(const bf16x8*)(qp + ds * 16); }
    asm volatile("" : "+v"(qf[0]), "+v"(qf[1]), "+v"(qf[2]), "+v"(qf[3]));
    f32x16 o[4] = {}; f32x16 nm; f32x2 l2 = {0.f, 0.f};
    const char* gk = (const char*)(proj + (size_t)(w * 8 + (lane >> 3)) * INW + C_BK + h * 128) + g2_chunk_off(lane, w);
    const char* gv = (const char*)(proj + (size_t)(w * 8 + ((lane & 31) >> 2)) * INW + C_BV + h * 128 + (lane >> 5) * 32 + (lane & 3) * 8);
    const int vlane = ((lane & 3) << 3) | (((lane >> 2) & 3) << 6) | (((lane >> 4) & 1) << 5) | (((lane >> 5) & 1) << 8);
    const int ldsb = (int)(uintptr_t)lds_;
    const int kad0 = ldsb + mp * 8192 + swz(r32, 0 + hi), kad1 = ldsb + mp * 8192 + swz(r32, 2 + hi), kad2 = ldsb + mp * 8192 + swz(r32, 4 + hi), kad3 = ldsb + mp * 8192 + swz(r32, 6 + hi);
    constexpr size_t TSTEP = (size_t)64 * INW * 2;
#define DMA_K(t_) do { const int tt_ = (t_); const char* s_ = gk + (size_t)tt_ * TSTEP; LAS char* d_ = lds + (tt_ & 3) * 16384 + w * 1024; \
        __builtin_amdgcn_global_load_lds((const unsigned*)s_, (LAS unsigned*)d_, 16, 0, 0); \
        __builtin_amdgcn_global_load_lds((const unsigned*)(s_ + 128), (LAS unsigned*)(d_ + 8192), 16, 0, 0); } while (0)
#define DMA_V(t_) do { const int tt_ = (t_); const char* s_ = gv + (size_t)tt_ * TSTEP; LAS char* d_ = lds + 65536 + (tt_ & 3) * 16384 + (2 * w) * 1024; \
        __builtin_amdgcn_global_load_lds((const unsigned*)s_, (LAS unsigned*)d_, 16, 0, 0); \
        __builtin_amdgcn_global_load_lds((const unsigned*)(s_ + 128), (LAS unsigned*)(d_ + 1024), 16, 0, 0); } while (0)
    DMA_K(0); DMA_K(1); if (NT > 2) DMA_K(2); DMA_V(0); DMA_V(1);
    __syncthreads();
    f32x16 A0 = {}, A1 = {}, B0 = {}, B1 = {};
    {
#pragma unroll
        for (int ds = 0; ds < 4; ++ds) {
            const bf16x8 k0 = *(const bf16x8*)(lds_ + mp * 8192 + swz(r32, ds * 2 + hi)), k1 = *(const bf16x8*)(lds_ + mp * 8192 + swz(32 + r32, ds * 2 + hi));
            A0 = MF32(k0, qf[ds], A0); A1 = MF32(k1, qf[ds], A1);
        }
        float mx = fmaxf(A0[0], A1[0]);
#pragma unroll
        for (int r = 1; r < 16; ++r) mx = fmaxf(fmaxf(mx, A0[r]), A1[r]);
        mx = half_max(mx);
#pragma unroll
        for (int r = 0; r < 16; ++r) { A0[r] -= mx; A1[r] -= mx; nm[r] = -mx; }
    }
    __syncthreads();
    for (int it = 0; it < NP; ++it) {
        const int t = 2 * it;
        if (t + 2 < NT) { DMA_K(t + 3); DMA_V(t + 2); DMA_V(t + 3); }
        if (t + 4 < NT) DMA_K(t + 4);
        { const int ks = ((t + 1) & 3) * 16384, vb_ = ldsb + 65536 + (t & 3) * 16384 + vlane;
          diff_slot(A0, A1, B0, B1, o, l2, nm, qf, kad0 + ks, kad1 + ks, kad2 + ks, kad3 + ks, vb_, t + 1 < myNT); }
        if (t + 1 < myNT) {
            const int ks = ((t + 2) & 3) * 16384, vb_ = ldsb + 65536 + ((t + 1) & 3) * 16384 + vlane;
            diff_slot(B0, B1, A0, A1, o, l2, nm, qf, kad0 + ks, kad1 + ks, kad2 + ks, kad3 + ks, vb_, t + 2 < myNT);
        }
        __syncthreads();
    }
#undef DMA_K
#undef DMA_V
    float* xb = (float*)lds_;
    const float il = 1.0f / half_sum(l2[0] + l2[1]);
    if (mp == 1) {
        const float f = il * lam;
#pragma unroll
        for (int t = 0; t < 4; ++t)
#pragma unroll
            for (int r = 0; r < 16; ++r) xb[(wq * 64 + t * 16 + r) * 64 + lane] = o[t][r] * f;
    }
    __syncthreads();
    if (mp == 0) {
        float ss = 0.f;
#pragma unroll
        for (int t = 0; t < 4; ++t)
#pragma unroll
            for (int r = 0; r < 16; ++r) { const float v = o[t][r] * il - xb[(wq * 64 + t * 16 + r) * 64 + lane]; o[t][r] = v; ss += v * v; }
        ss = half_sum(ss);
        const float rs = rsqrtf(ss * (1.0f / 128.0f) + LN_EPS) * 0.8f;
        bf16_t* op = (bf16_t*)(p.ws + WS_ATT) + (size_t)(qb * 128 + wq * 32 + r32) * D + 512 + h * 128;
#pragma unroll
        for (int t = 0; t < 4; ++t)
#pragma unroll
            for (int rr = 0; rr < 4; ++rr) {
                const int dv0 = 32 * t + 8 * rr + 4 * hi;
                const f32x4 gg = *(const f32x4*)(p.subg + dv0);
                u32x2 pk = {cvt_pk(o[t][4 * rr] * rs * gg[0], o[t][4 * rr + 1] * rs * gg[1]), cvt_pk(o[t][4 * rr + 2] * rs * gg[2], o[t][4 * rr + 3] * rs * gg[3])};
                *(u32x2*)(op + dv0) = pk;
            }
    }
    __syncthreads();
}
#undef WAIT_K
#undef WAIT_V
#undef PKV
#undef MF32
#undef SB
#undef EXP4
#undef MAX4
__device__ __forceinline__ void attn_swa_unit(const Params& p, char* lds, int kvh, int n) {
    const int tid = threadIdx.x, lane = tid & 63, w = __builtin_amdgcn_readfirstlane(tid >> 6), r32 = lane & 31, hi = lane >> 5, g = w >> 1, hq = kvh * 4 + g;
    const bf16_t* proj = (const bf16_t*)(p.ws + WS_PROJ);
    const int c0 = (n >= 2) ? n - 2 : 0, NT = n - c0 + 1;
    const int tok = n * 64 + (w & 1) * 32 + r32;
    bf16x8 qf[4];
    { const bf16_t* qp = proj + (size_t)tok * INW + C_AQ + hq * 64 + hi * 8;
#pragma unroll
      for (int ds = 0; ds < 4; ++ds) qf[ds] = *(const bf16x8*)(qp + ds * 16); }
    f32x16 o[2] = {}; f32x16 ol, nm;
    { float ms = -p.sinks[hq] * LOG2E; asm volatile("" : "+v"(qf[0]), "+v"(qf[1]), "+v"(qf[2]), "+v"(qf[3]), "+v"(ms));
#pragma unroll
      for (int r = 0; r < 16; ++r) { nm[r] = ms; ol[r] = 1.0f; } }
    const bf16_t* gk = proj + (size_t)(c0 * 64 + (tid >> 3)) * INW + C_AK + kvh * 64 + (tid & 7) * 8;
    const bf16_t* gv = proj + (size_t)(c0 * 64 + (tid >> 3)) * INW + C_AV + kvh * 64 + (tid & 7) * 8;
    const int wk = swz(tid >> 3, tid & 7), wv = v_off(tid >> 3, (tid & 7) * 8, 2);
    const int vlane = ((lane & 3) << 3) | (((lane >> 2) & 3) << 6) | (((lane >> 4) & 1) << 5) | (((lane >> 5) & 1) << 8);
    u32x4 st0, st1;
#define W_LOAD(t) do { const size_t ko = (size_t)(t) * 64 * INW; st0 = *(const u32x4*)(gk + ko); st1 = *(const u32x4*)(gv + ko); } while (0)
#define W_WRITE(b) do { char* sb = lds + (b) * AT_STAGE; *(u32x4*)(sb + wk) = st0; *(u32x4*)(sb + 8192 + wv) = st1; } while (0)
    W_LOAD(0); W_WRITE(0); __syncthreads();
    for (int t = 0; t < NT; ++t) {
        const int b = t & 1;
        if (t + 1 < NT) W_LOAD(t + 1);
        { f32x16 s0, s1; bf16x8 p0, p1, p2, p3; const int vb_ = (int)(uintptr_t)(lds + b * AT_STAGE + 8192) + vlane;
          attn_scores<2>(lds, b * AT_STAGE, qf, s0, s1, o, ol, nm, false, r32, hi);
          exp_pack(s0, p0, p1); pv_half<2, 0>(o, ol, vb_, p0, p1); exp_pack(s1, p2, p3); pv_half<2, 1>(o, ol, vb_, p2, p3); }
        if (t + 1 < NT) W_WRITE(b ^ 1);
        __syncthreads();
    }
#undef W_LOAD
#undef W_WRITE
    const float il = 1.0f / ol[0];
    bf16_t* op = (bf16_t*)(p.ws + WS_ATT) + (size_t)tok * D + hq * 64;
#pragma unroll
    for (int t = 0; t < 2; ++t)
#pragma unroll
        for (int rr = 0; rr < 4; ++rr) {
            const int dv0 = 32 * t + 8 * rr + 4 * hi;
            u32x2 pk = {cvt_pk(o[t][4 * rr] * il, o[t][4 * rr + 1] * il), cvt_pk(o[t][4 * rr + 2] * il, o[t][4 * rr + 3] * il)};
            *(u32x2*)(op + dv0) = pk;
        }
}
__device__ __forceinline__ void phase_attn(const Params& p, char* lds, int vb, int G) {
    const int lane = threadIdx.x & 63;
    const float d1 = wave_sum(p.lq1[lane] * p.lk1[lane]), d2 = wave_sum(p.lq2[lane] * p.lk2[lane]);
    const float lam = expf(d1) - expf(d2) + 0.2f;
    for (int u = vb; u < 1024; u += G) {
        if (u < 256) attn_diff_unit(p, lds, u >> 6, 127 - (u & 63), lam);
        else if (u < 512) attn_diff_unit(p, lds, (u - 256) >> 6, (u - 256) & 63, lam);
        else attn_swa_unit(p, lds, (u - 512) >> 8, (u - 512) & 255);
    }
}

struct EpiPreLn {
    const float* x; float* out; int row0, col0;
    __device__ __forceinline__ void operator()(f32x4 (&acc)[8][4], int wr, int wc, int fr, int fq) const {
        f32x4 xa[4], xb_[4];
        const size_t rbase = (size_t)(row0 + wr * 128 + fr) * D + col0 + wc * 64 + 4 * fq;
#pragma unroll
        for (int nt = 0; nt < 4; ++nt) xa[nt] = *(const f32x4*)(x + rbase + nt * 16);
#pragma unroll
        for (int mt = 0; mt < 8; ++mt) {
            const size_t ro = rbase + (size_t)mt * 16 * D;
            if (mt + 1 < 8) {
#pragma unroll
                for (int nt = 0; nt < 4; ++nt) { if (mt & 1) xa[nt] = *(const f32x4*)(x + ro + (size_t)16 * D + nt * 16); else xb_[nt] = *(const f32x4*)(x + ro + (size_t)16 * D + nt * 16); }
            }
#pragma unroll
            for (int nt = 0; nt < 4; ++nt) { const f32x4 xv = (mt & 1) ? xb_[nt] : xa[nt]; *(f32x4*)(out + ro + nt * 16) = xv * ALPHA + acc[mt][nt]; }
        }
    }
};
__device__ __forceinline__ void phase_wout(const Params& p, char* lds, int vb, int G) {
    for (int u = vb; u < (S / 256) * 4; u += G) {
        const int tm = u >> 2, tn = u & 3;
        G2Args g; g.A = (const char*)(p.ws + WS_ATT); g.B = (const char*)(p.ws + WS_WOUT); g.nk = D / 64; g.akstep = 128;
        g2_rows_A<8>(g, (size_t)tm * 256, D * 2); g2_rows_B(g, (size_t)tn * 256, D * 2);
        EpiPreLn e{p.x, (float*)(p.ws + WS_PRELN), tm * 256, tn * 256};
        gemm2<8>(lds, g, e);
    }
}

struct EpiLogits {
    float* L;
    __device__ __forceinline__ void operator()(f32x4 (&acc)[4][4], int wr, int wc, int fr, int fq) const {
#pragma unroll
        for (int mt = 0; mt < 4; ++mt)
#pragma unroll
            for (int nt = 0; nt < 4; ++nt) *(f32x4*)(L + (wr * 64 + mt * 16 + fr) * 256 + wc * 64 + nt * 16 + 4 * fq) = acc[mt][nt];
    }
};
__device__ __forceinline__ void phase_router(const Params& p, char* lds, int vb, int G) {
    const int tid = threadIdx.x, lane = tid & 63, w = tid >> 6;
    const float* preln = (const float*)(p.ws + WS_PRELN);
    bf16_t* x1b = (bf16_t*)(p.ws + WS_X1B);
    unsigned* cnt = (unsigned*)(p.ws + WS_CTL + 65536); int* list = (int*)(p.ws + WS_LIST); float* gates = (float*)(p.ws + WS_GATE);
    for (int u = vb; u < S / 64; u += G) {
        {
            f32x4 v[8][4]; float sm[8], sq[8];
#pragma unroll
            for (int i = 0; i < 8; ++i) { const f32x4* xr = (const f32x4*)(preln + (size_t)(u * 64 + w * 8 + i) * D) + lane;
#pragma unroll
                for (int j = 0; j < 4; ++j) v[i][j] = xr[64 * j]; }
#pragma unroll
            for (int i = 0; i < 8; ++i) { float s = 0.f;
#pragma unroll
                for (int j = 0; j < 4; ++j) s += (v[i][j][0] + v[i][j][1]) + (v[i][j][2] + v[i][j][3]);
                sm[i] = s; }
#pragma unroll
            for (int o = 1; o < 64; o <<= 1) {
#pragma unroll
                for (int i = 0; i < 8; ++i) sm[i] += __shfl_xor(sm[i], o); }
#pragma unroll
            for (int i = 0; i < 8; ++i) { const float mean = sm[i] * (1.0f / D); float s2 = 0.f;
#pragma unroll
                for (int j = 0; j < 4; ++j) { v[i][j] = v[i][j] - mean; s2 += (v[i][j][0] * v[i][j][0] + v[i][j][1] * v[i][j][1]) + (v[i][j][2] * v[i][j][2] + v[i][j][3] * v[i][j][3]); }
                sq[i] = s2; }
#pragma unroll
            for (int o = 1; o < 64; o <<= 1) {
#pragma unroll
                for (int i = 0; i < 8; ++i) sq[i] += __shfl_xor(sq[i], o); }
#pragma unroll
            for (int j = 0; j < 4; ++j) {
                const f32x4 gg = *((const f32x4*)p.ln1g + lane + 64 * j), bb = *((const f32x4*)p.ln1b + lane + 64 * j);
#pragma unroll
                for (int i = 0; i < 8; ++i) {
                    const int row = u * 64 + w * 8 + i;
                    const float rstd = rsqrtf(sq[i] * (1.0f / D) + LN_EPS);
                    const f32x4 y = v[i][j] * rstd * gg + bb;
                    u32x2 pk = {cvt_pk(y[0], y[1]), cvt_pk(y[2], y[3])};
                    *(u32x2*)(x1b + ((size_t)((lane >> 4) + 4 * j) * S + row) * 64 + ((4 * lane) & 63)) = pk;
                }
            }
        }
        asm volatile("s_waitcnt vmcnt(0)" ::: "memory");
        __syncthreads();
        { G2Args g; g.A = (const char*)x1b; g.B = (const char*)(p.ws + WS_WR); g.nk = D / 64; g.akstep = S * 128;
          g2_rows_A<4>(g, (size_t)u * 64, 128); g.offA[1] = g.offA[0]; g2_rows_B(g, 0, D * 2);
          EpiLogits e{(float*)lds};
          gemm2<4>(lds, g, e); }
        __syncthreads();
        const f32x4 rb = *((const f32x4*)p.r_bias + lane);
        const float NEG = -__builtin_inff();
        for (int i0 = 0; i0 < 8; i0 += 4) {
            float sc[4][4], cand[4][4]; int my_e[4]; float my_s[4], gsum[4];
#pragma unroll
            for (int q = 0; q < 4; ++q) {
                const int tl = w * 8 + i0 + q;
                const f32x4 lg = *((const f32x4*)((const float*)lds + tl * 256) + lane);
#pragma unroll
                for (int j = 0; j < 4; ++j) { sc[q][j] = 1.0f / (1.0f + __expf(-lg[j])); cand[q][j] = sc[q][j] + rb[j]; }
                my_e[q] = 0; my_s[q] = 0.f; gsum[q] = 0.f;
            }
            float a1[4], a2[4];
#pragma unroll
            for (int q = 0; q < 4; ++q) { const float m01 = fmaxf(cand[q][0], cand[q][1]), n01 = fminf(cand[q][0], cand[q][1]), m23 = fmaxf(cand[q][2], cand[q][3]), n23 = fminf(cand[q][2], cand[q][3]);
              a1[q] = fmaxf(m01, m23); a2[q] = fmaxf(fminf(m01, m23), fmaxf(n01, n23)); }
#pragma unroll
            for (int off = 1; off < 8; off <<= 1) {
#pragma unroll
                for (int q = 0; q < 4; ++q) { const float b1 = __shfl_xor(a1[q], off), b2 = __shfl_xor(a2[q], off); const float n1 = fmaxf(a1[q], b1), n2 = fmaxf(fminf(a1[q], b1), fmaxf(a2[q], b2)); a1[q] = n1; a2[q] = n2; }
            }
            const int mygrp = lane >> 3;
#pragma unroll
            for (int q = 0; q < 4; ++q) {
                const float gs = a1[q] + a2[q]; int rank = 0;
#pragma unroll
                for (int g2 = 0; g2 < 8; ++g2) { const float v = __shfl(gs, g2 * 8); rank += (v > gs || (v == gs && g2 < mygrp)) ? 1 : 0; }
                if (rank >= 4) {
#pragma unroll
                    for (int j = 0; j < 4; ++j) cand[q][j] = NEG;
                }
            }
#pragma unroll
            for (int k = 0; k < 8; ++k) {
                float bv[4]; int idx[4];
#pragma unroll
                for (int q = 0; q < 4; ++q) { bv[q] = cand[q][0]; int bi = 0;
#pragma unroll
                    for (int j = 1; j < 4; ++j) if (cand[q][j] > bv[q]) { bv[q] = cand[q][j]; bi = j; }
                    idx[q] = 4 * lane + bi; }
#pragma unroll
                for (int off = 32; off >= 1; off >>= 1) {
#pragma unroll
                    for (int q = 0; q < 4; ++q) { const float ov = __shfl_xor(bv[q], off); const int oi = __shfl_xor(idx[q], off); if (ov > bv[q] || (ov == bv[q] && oi < idx[q])) { bv[q] = ov; idx[q] = oi; } }
                }
#pragma unroll
                for (int q = 0; q < 4; ++q) {
                    const int owner = idx[q] >> 2, sub = idx[q] & 3;
                    float scv = sc[q][0];
#pragma unroll
                    for (int j = 1; j < 4; ++j) scv = (sub == j) ? sc[q][j] : scv;
                    if (lane == owner) {
#pragma unroll
                        for (int j = 0; j < 4; ++j) if (sub == j) cand[q][j] = NEG;
                    }
                    const float gsc = __shfl(scv, owner);
                    if (lane == k) { my_e[q] = idx[q]; my_s[q] = gsc; }
                    gsum[q] += gsc;
                }
            }
            if (lane < 8) {
#pragma unroll
                for (int q = 0; q < 4; ++q) {
                    const int t = u * 64 + w * 8 + i0 + q;
                    const float gate = my_s[q] / gsum[q] * 2.5f;
                    const unsigned pos = atomicAdd(cnt + my_e[q] * CNT_STRIDE, 1u);
                    list[(size_t)my_e[q] * CAP + pos] = t * 8 + lane;
                    gates[t * 8 + lane] = gate;
                }
            }
        }
        __syncthreads();
    }
}

#ifndef MOE_MT
#define MOE_MT 8
#endif
constexpr int MOE_BM = 32 * MOE_MT;
struct EpiAct {
    bf16_t* act; const int* slots;
    __device__ __forceinline__ void operator()(f32x4 (&acc)[MOE_MT][4], int pass, int wr, int wc, int fr, int fq) const {
        const int ncol0 = pass * 128;
#pragma unroll
        for (int mt = 0; mt < MOE_MT; ++mt) {
            const int ar = slots[wr * 16 * MOE_MT + mt * 16 + fr];
            if (ar >= 0) {
                float a[8];
#pragma unroll
                for (int nt = 0; nt < 2; ++nt)
#pragma unroll
                    for (int j = 0; j < 4; ++j) { const float gq = acc[mt][nt][j]; a[nt * 4 + j] = gq / (1.0f + __expf(-gq)) * (acc[mt][nt + 2][j]); }
                u32x4 pk = {cvt_pk(a[0], a[1]), cvt_pk(a[2], a[3]), cvt_pk(a[4], a[5]), cvt_pk(a[6], a[7])};
                *(u32x4*)(act + (size_t)ar * FF + ncol0 + wc * 32 + 8 * fq) = pk;
            }
        }
    }
};
struct EpiY {
    bf16_t* y; const int* yrows; const float* gl;
    __device__ __forceinline__ void operator()(f32x4 (&acc)[MOE_MT][4], int pass, int wr, int wc, int fr, int fq) const {
        const int col0 = pass * 256;
#pragma unroll
        for (int mt = 0; mt < MOE_MT; ++mt) {
            const int r = wr * 16 * MOE_MT + mt * 16 + fr, yr = yrows[r];
            if (yr >= 0) {
                const float gt = gl[r];
#pragma unroll
                for (int a = 0; a < 2; ++a) {
                    const f32x4 v0 = acc[mt][2 * a] * gt, v1 = acc[mt][2 * a + 1] * gt;
                    u32x4 pk = {cvt_pk(v0[0], v0[1]), cvt_pk(v0[2], v0[3]), cvt_pk(v1[0], v1[1]), cvt_pk(v1[2], v1[3])};
                    *(u32x4*)(y + (size_t)yr * D + col0 + wc * 64 + a * 32 + 8 * fq) = pk;
                }
            }
        }
    }
};
__device__ __forceinline__ void phase_experts(const Params& p, char* lds, int vb, int G) {
    const int tid0 = threadIdx.x, w = __builtin_amdgcn_readfirstlane(tid0 >> 6);
    const unsigned* cnt = (const unsigned*)(p.ws + WS_CTL + 65536); const int* list = (const int*)(p.ws + WS_LIST); const float* gates = (const float*)(p.ws + WS_GATE);
    bf16_t* act = (bf16_t*)(p.ws + WS_ACT); bf16_t* ybuf = (bf16_t*)(p.ws + WS_Y);
    int* nts = (int*)(lds + LDS_MISC); int* pre = nts + 256;
    int* s_arow = pre + 260; int* s_yrow = s_arow + MOE_BM; int* s_tok = s_yrow + MOE_BM; float* s_gate = (float*)(s_tok + MOE_BM);
    if (tid0 < 256) nts[tid0] = (int)((__hip_atomic_load(cnt + tid0 * CNT_STRIDE, __ATOMIC_RELAXED, __HIP_MEMORY_SCOPE_AGENT) + (MOE_BM - 1)) / MOE_BM);
    __syncthreads();
    if (tid0 < 257) { int s = 0; for (int e = 0; e < tid0; ++e) s += nts[e]; pre[tid0] = s; }
    __syncthreads();
    const int NR = __builtin_amdgcn_readfirstlane(pre[256]), NU = NR + S / MOE_BM;
    for (int u = vb; u < NU; u += G) {
        __syncthreads();
        int tid = threadIdx.x; asm volatile("" : "+v"(tid));
        const int lane = tid & 63; const unsigned co = g2_chunk_off(lane, w);
        const float *bg, *bu, *bd;
        if (u < NR) {
            int lo = 0, hi = 255;
            while (lo < hi) { const int mid = (lo + hi + 1) >> 1; if (pre[mid] <= u) lo = mid; else hi = mid - 1; }
            const int e = lo, tile = u - pre[e], n = (int)__hip_atomic_load(cnt + e * CNT_STRIDE, __ATOMIC_RELAXED, __HIP_MEMORY_SCOPE_AGENT);
            if (tid < MOE_BM) {
                const int idx = tile * MOE_BM + tid;
                if (idx < n) { const int slot = list[(size_t)e * CAP + idx]; s_arow[tid] = slot; s_yrow[tid] = slot + (slot >> 3); s_tok[tid] = slot >> 3; s_gate[tid] = gates[slot]; }
                else { s_arow[tid] = -1; s_yrow[tid] = -1; s_tok[tid] = 0; s_gate[tid] = 0.f; }
            }
            bg = p.w_g + (size_t)e * D * FF; bu = p.w_u + (size_t)e * D * FF; bd = p.w_d + (size_t)e * FF * D;
        } else {
            const int tile = u - NR;
            if (tid < MOE_BM) { const int tk = tile * MOE_BM + tid; s_arow[tid] = S * 8 + tk; s_yrow[tid] = tk * 9 + 8; s_tok[tid] = tk; s_gate[tid] = 1.0f; }
            bg = p.ws_g; bu = p.ws_u; bd = p.ws_d;
        }
        __syncthreads();
        { G3fArgs g; g.A = (const char*)(p.ws + WS_X1B); g.nk = D / 64; g.akstep = S * 128;
#pragma unroll
          for (int i = 0; i < MOE_MT / 2; ++i) g.offA[i] = (unsigned)s_tok[i * 64 + w * 8 + (lane >> 3)] * 128u + co;
          { const int bwc = lane >> 4, nt = (lane >> 2) & 3, bfq = lane & 3;
            g.b = ((nt < 2) ? bg : bu) + bwc * 32 + 8 * bfq + 4 * (nt & 1) + (size_t)(w * 8) * FF; }
          EpiAct e{act, s_arow};
          gemm3f<MOE_MT, FF>(lds, g, 2, 128, e); }
        asm volatile("s_waitcnt vmcnt(0)" ::: "memory");
        __syncthreads();
        { G3fArgs g; g.A = (const char*)act; g.nk = FF / 64; g.akstep = 128;
#pragma unroll
          for (int i = 0; i < MOE_MT / 2; ++i) { const int ar = s_arow[i * 64 + w * 8 + (lane >> 3)]; g.offA[i] = (unsigned)(ar < 0 ? 0 : ar) * (unsigned)(FF * 2) + co; }
          g.b = bd + (size_t)(w * 8) * D + (lane >> 4) * 64 + (((lane >> 2) & 3) >> 1) * 32 + 8 * (lane & 3) + 4 * ((lane >> 2) & 1);
          EpiY e{ybuf, s_yrow, s_gate};
          gemm3f<MOE_MT, D>(lds, g, 4, 256, e); }
    }
}

__device__ __forceinline__ void phase_final(const Params& p, int vb, int G) {
    const int lane = threadIdx.x & 63, w = threadIdx.x >> 6;
    const bf16_t* x1b = (const bf16_t*)(p.ws + WS_X1B); const bf16_t* ybuf = (const bf16_t*)(p.ws + WS_Y);
    constexpr int NR = 2;
    for (int row0 = (vb * 8 + w) * NR; row0 < S; row0 += G * 8 * NR) {
        float v[NR][2][8]; float sm[NR], sq[NR];
#pragma unroll
        for (int i = 0; i < NR; ++i) {
            const int row = row0 + i;
#pragma unroll
            for (int j = 0; j < 2; ++j) { const u32x4 q = *(const u32x4*)(x1b + ((size_t)((lane >> 3) + 8 * j) * S + row) * 64 + ((8 * lane) & 63));
#pragma unroll
                for (int e = 0; e < 4; ++e) { v[i][j][2 * e] = bf_lo(q[e]) * ALPHA; v[i][j][2 * e + 1] = bf_hi(q[e]) * ALPHA; } }
#pragma unroll
            for (int k = 0; k < 9; ++k) {
                const u32x4* yr = (const u32x4*)(ybuf + (size_t)(row * 9 + k) * D) + lane;
#pragma unroll
                for (int j = 0; j < 2; ++j) { const u32x4 q = yr[64 * j];
#pragma unroll
                    for (int e = 0; e < 4; ++e) { v[i][j][2 * e] += bf_lo(q[e]); v[i][j][2 * e + 1] += bf_hi(q[e]); } }
            }
        }
#pragma unroll
        for (int i = 0; i < NR; ++i) { float s = 0.f;
#pragma unroll
            for (int j = 0; j < 2; ++j)
#pragma unroll
                for (int e = 0; e < 8; ++e) s += v[i][j][e];
            sm[i] = s; }
#pragma unroll
        for (int o = 1; o < 64; o <<= 1) {
#pragma unroll
            for (int i = 0; i < NR; ++i) sm[i] += __shfl_xor(sm[i], o); }
#pragma unroll
        for (int i = 0; i < NR; ++i) { const float mean = sm[i] * (1.0f / D); float s2 = 0.f;
#pragma unroll
            for (int j = 0; j < 2; ++j)
#pragma unroll
                for (int e = 0; e < 8; ++e) { v[i][j][e] -= mean; s2 += v[i][j][e] * v[i][j][e]; }
            sq[i] = s2; }
#pragma unroll
        for (int o = 1; o < 64; o <<= 1) {
#pragma unroll
            for (int i = 0; i < NR; ++i) sq[i] += __shfl_xor(sq[i], o); }
#pragma unroll
        for (int j = 0; j < 2; ++j) {
            const f32x4 g0 = *((const f32x4*)p.ln2g + 2 * lane + 128 * j), g1 = *((const f32x4*)p.ln2g + 2 * lane + 128 * j + 1);
            const f32x4 b0 = *((const f32x4*)p.ln2b + 2 * lane + 128 * j), b1 = *((const f32x4*)p.ln2b + 2 * lane + 128 * j + 1);
#pragma unroll
            for (int i = 0; i < NR; ++i) { const float rstd = rsqrtf(sq[i] * (1.0f / D) + LN_EPS);
                f32x4* op = (f32x4*)(p.out + (size_t)(row0 + i) * D) + 2 * lane + 128 * j;
                op[0] = (f32x4){v[i][j][0], v[i][j][1], v[i][j][2], v[i][j][3]} * rstd * g0 + b0;
                op[1] = (f32x4){v[i][j][4], v[i][j][5], v[i][j][6], v[i][j][7]} * rstd * g1 + b1; }
        }
    }
}

__global__ void __launch_bounds__(NTHREADS) mega(Params p) {
    extern __shared__ __attribute__((aligned(16))) char lds[];
    const int G = gridDim.x, bx = blockIdx.x;
    const int vb = (G % 8 == 0) ? (bx % 8) * (G / 8) + bx / 8 : bx;
    if (threadIdx.x < 4) ((volatile LAS unsigned*)((LAS char*)lds + LDS_BARST))[threadIdx.x] = 0u;
    __syncthreads();
    XcdBarrier bar; bar.bar = (unsigned*)(p.ws + WS_CTL) + CW_BAR; bar.x = 0; bar.st = nullptr;
    if (p.ph_hi - p.ph_lo > 1) bar = xcd_barrier_post((unsigned*)(p.ws + WS_CTL) + CW_BAR, (volatile LAS unsigned*)((LAS char*)lds + LDS_BARST));
#define SEAM(k) do { if (p.ph_lo <= (k) && (k) + 1 < p.ph_hi) { xcd_barrier(bar); } } while (0)
#define IN(k) (p.ph_lo <= (k) && (k) < p.ph_hi)
#define RUN(k, call) do { if (IN(k)) { call; if (MK_REPEAT == (k)) { __syncthreads(); call; } } } while (0)
    RUN(0, phase_prep(p, vb, G)); SEAM(0);
    RUN(1, phase_proj(p, lds, vb, G)); SEAM(1);
    RUN(2, phase_attn(p, lds, vb, G)); SEAM(2);
    RUN(3, phase_wout(p, lds, vb, G)); SEAM(3);
    if (IN(4)) { phase_router(p, lds, vb, G); } SEAM(4);
    RUN(5, phase_experts(p, lds, vb, G)); SEAM(5);
    RUN(6, phase_final(p, vb, G));
#undef SEAM
#undef IN
#undef RUN
}

extern "C" void kernel_launch(void* const* d_in, const int* in_sizes, int n_in, void* d_out, int out_size, void* d_ws, size_t ws_size, hipStream_t stream) {
    static int grid = 0;
    if (grid == 0) {
        if (n_in != 22 || in_sizes[0] != S * D || out_size != S * D || ws_size < WS_END) {
            fprintf(stderr, "kernel_launch: unexpected shapes: n_in %d in0 %d out %d ws %zu (need %zu)\n", n_in, n_in > 0 ? in_sizes[0] : -1, out_size, ws_size, (size_t)WS_END); grid = -1; return; }
        int dev = 0, cus = 0, per_cu = 0;
        (void)hipGetDevice(&dev); (void)hipDeviceGetAttribute(&cus, hipDeviceAttributeMultiprocessorCount, dev);
        if (hipFuncSetAttribute((const void*)mega, hipFuncAttributeMaxDynamicSharedMemorySize, LDS_BYTES) != hipSuccess) { fprintf(stderr, "kernel_launch: hipFuncSetAttribute failed\n"); grid = -1; return; }
        (void)hipOccupancyMaxActiveBlocksPerMultiprocessor(&per_cu, (const void*)mega, NTHREADS, LDS_BYTES);
        if (per_cu < 1) { fprintf(stderr, "kernel_launch: occupancy query says %d blocks per CU\n", per_cu); per_cu = 1; }
        grid = cus * 1;
        (void)hipGetLastError();
    }
    if (grid < 0) return;
    (void)hipMemsetAsync((char*)d_ws + WS_CTL, 0, CTL_BYTES, stream);
    Params p{};
    const float** f = (const float**)&p;
    for (int i = 0; i < 22; ++i) f[i] = (const float*)d_in[i];
    p.out = (float*)d_out; p.ws = (unsigned char*)d_ws;
#if MK_ONE_LAUNCH
    p.ph_lo = 0; p.ph_hi = 7;
    void* args[] = {&p};
    hipError_t e = hipLaunchCooperativeKernel((const void*)mega, dim3(grid), dim3(NTHREADS), args, LDS_BYTES, stream);
    if (e != hipSuccess) fprintf(stderr, "kernel_launch: cooperative launch failed: %s (grid %d)\n", hipGetErrorString(e), grid);
#else
    for (int ph = 0; ph < 7; ++ph) {
        p.ph_lo = ph; p.ph_hi = ph + 1;
        hipLaunchKernelGGL(mega, dim3(grid), dim3(NTHREADS), LDS_BYTES, stream, p);
    }
#endif
}
```

```cpp
#include <hip/hip_runtime.h>
#include <hip/hip_cooperative_groups.h>
#include <cstdio>
#include <cstdint>
namespace cg = cooperative_groups;

#ifndef MK_REPEAT
#define MK_REPEAT -1
#endif
#ifndef MK_ONE_LAUNCH
#define MK_ONE_LAUNCH 1
#endif

constexpr int S = 16384, D = 1024, INW = 2304, NE = 256, FF = 256;
constexpr int NTHREADS = 512;
constexpr int CAP = 16384;
constexpr float ALPHA = 1.189207115002721f;
constexpr float LN_EPS = 1e-5f;
constexpr float QSCALE = 0.125f * 1.4426950408889634f;
constexpr float LOG2E = 1.4426950408889634f;
constexpr int C_AQ = 0, C_AK = 512, C_AV = 640, C_BQ = 768, C_BK = 1280, C_BV = 1792;

constexpr size_t MiB = 1ull << 20;
constexpr size_t WS_CTL = 0;
constexpr size_t CTL_BYTES = 128 * 1024;
constexpr int CNT_STRIDE = 64;
constexpr size_t WS_ROPE = 1 * MiB;
constexpr size_t WS_WIN = 8 * MiB;
constexpr size_t WS_WOUT = 13 * MiB;
constexpr size_t WS_WR = 15 * MiB;
constexpr size_t WS_WSGU = 16 * MiB;
constexpr size_t WS_WSD = 17 * MiB;
constexpr size_t WS_EGU = 20 * MiB;
constexpr size_t WS_ED = 276 * MiB;
constexpr size_t WS_X1F = 404 * MiB;
constexpr size_t WS_X1B = 468 * MiB;
constexpr size_t WS_LIST = 500 * MiB;
constexpr size_t WS_GATE = 516 * MiB;
constexpr size_t WS_ACT = 518 * MiB;
constexpr size_t WS_Y = 590 * MiB;
constexpr size_t WS_XB = 590 * MiB;
constexpr size_t WS_PROJ = 622 * MiB;
constexpr size_t WS_ATT = 694 * MiB;
constexpr size_t WS_PRELN = 726 * MiB;
constexpr size_t WS_END = 878 * MiB;

constexpr int LDS_BYTES = 147456;
constexpr int LDS_MISC = 131072;

typedef unsigned short bf16_t;
typedef short bf16x8 __attribute__((ext_vector_type(8)));
typedef short s16x4 __attribute__((ext_vector_type(4)));
typedef float f32x4 __attribute__((ext_vector_type(4)));
typedef float f32x16 __attribute__((ext_vector_type(16)));
typedef unsigned u32x4 __attribute__((ext_vector_type(4)));
typedef unsigned u32x2 __attribute__((ext_vector_type(2)));
typedef float f32x2 __attribute__((ext_vector_type(2)));


#define LAS __attribute__((address_space(3)))
#define XB_TMO      128
#define XB_XCNT(j)  (256  + 64 * (j))
#define XB_XSUB(j)  (1280 + 64 * (j))
#define XB_XGEN(j)  (2304 + 64 * (j))
#define XB_TOP      3328
#define XB_TOPGEN   3392
#define XCD_BAR_WORDS 3456
#define XB_SPIN_CAP (1u << 18)
__device__ __forceinline__ unsigned xb_ld(unsigned* p)              { return __hip_atomic_load(p, __ATOMIC_RELAXED, __HIP_MEMORY_SCOPE_AGENT); }
__device__ __forceinline__ unsigned xb_add(unsigned* p, unsigned v) { return __hip_atomic_fetch_add(p, v, __ATOMIC_RELAXED, __HIP_MEMORY_SCOPE_AGENT); }
__device__ __forceinline__ unsigned xb_xcc_id() { return (unsigned)__builtin_amdgcn_s_getreg((3 << 11) | 20) & 0xFu; }
#define XB_SPIN(cond, bar) do { unsigned _sp = 0; while (cond) { __builtin_amdgcn_s_sleep(1); \
    if ((++_sp & 255u) == 0u) { if (xb_ld(&(bar)[XB_TMO])) break; if (_sp > XB_SPIN_CAP) { atomicAdd(&(bar)[XB_TMO], 1u); break; } } } } while (0)
struct XcdBarrier { unsigned* bar; unsigned x; volatile LAS unsigned* st; };
__device__ __forceinline__ XcdBarrier xcd_barrier_post(unsigned* bar, volatile LAS unsigned* st) {
    XcdBarrier b; b.bar = bar; b.x = xb_xcc_id(); b.st = st;
    if (threadIdx.x == 0) (void)xb_add(&bar[XB_XCNT(b.x)], 1u);
    return b;
}
__device__ __forceinline__ void xcd_barrier_complete(unsigned* bar, unsigned x, unsigned& nloc, unsigned& nx) {
    const unsigned G = gridDim.x * gridDim.y * gridDim.z;
    unsigned sum, cnt, mine, sp = 0u;
    for (;;) {
        sum = 0u; cnt = 0u; mine = 0u;
#pragma unroll
        for (unsigned j = 0; j < 16; ++j) { const unsigned c = xb_ld(&bar[XB_XCNT(j)]); sum += c; cnt += (c > 0u) ? 1u : 0u; mine = (j == x) ? c : mine; }
        if (sum == G) break;
        __builtin_amdgcn_s_sleep(1);
        if ((++sp & 255u) == 0u) { if (xb_ld(&bar[XB_TMO])) break; if (sp > XB_SPIN_CAP) { atomicAdd(&bar[XB_TMO], 1u); break; } }
    }
    nloc = mine > 0u ? mine : 1u; nx = cnt > 0u ? cnt : 1u;
}
__device__ __forceinline__ void xcd_barrier(const XcdBarrier& b) {
    asm volatile("s_waitcnt vmcnt(0)" ::: "memory");
    __syncthreads();
    if (threadIdx.x == 0) {
        unsigned* bar = b.bar;
        __builtin_amdgcn_s_waitcnt(0);
        unsigned nloc = b.st[0], nx = b.st[1];
        if (nloc == 0u) { xcd_barrier_complete(bar, b.x, nloc, nx); b.st[0] = nloc; b.st[1] = nx; }
        const unsigned old = xb_add(&bar[XB_XSUB(b.x)], 1u);
        const unsigned gen = old / nloc;
        if (old + 1u == (gen + 1u) * nloc) {
            __builtin_amdgcn_fence(__ATOMIC_RELEASE, "agent");
            asm volatile("s_waitcnt vmcnt(0)" ::: "memory");
            const unsigned og = xb_add(&bar[XB_TOP], 1u);
            const unsigned tg = og / nx;
            if (og + 1u == (tg + 1u) * nx) xb_add(&bar[XB_TOPGEN], 1u);
            else XB_SPIN(xb_ld(&bar[XB_TOPGEN]) == tg, bar);
            __builtin_amdgcn_fence(__ATOMIC_ACQUIRE, "agent");
            xb_add(&bar[XB_XGEN(b.x)], 1u);
            asm volatile("s_waitcnt vmcnt(0)" ::: "memory");
        } else {
            XB_SPIN(xb_ld(&bar[XB_XGEN(b.x)]) == gen, bar);
            __builtin_amdgcn_fence(__ATOMIC_ACQUIRE, "agent");
            asm volatile("s_waitcnt vmcnt(0)" ::: "memory");
        }
    }
    __syncthreads();
}
constexpr int CW_BAR = 4096;
constexpr int LDS_BARST = LDS_MISC + 8192;

struct Params {
    const float* x; const float* w_in; const float* b_in; const float* sinks;
    const float* lq1; const float* lk1; const float* lq2; const float* lk2; const float* subg;
    const float* w_out; const float* ln1g; const float* ln1b; const float* w_r; const float* r_bias;
    const float* w_g; const float* w_u; const float* w_d; const float* ws_g; const float* ws_u; const float* ws_d;
    const float* ln2g; const float* ln2b;
    float* out; unsigned char* ws;
    int ph_lo, ph_hi;
};

__device__ __forceinline__ unsigned cvt_pk(float lo, float hi) { unsigned r; asm volatile("v_cvt_pk_bf16_f32 %0, %1, %2" : "=v"(r) : "v"(lo), "v"(hi)); return r; }
__device__ __forceinline__ float bf_lo(unsigned u) { return __uint_as_float(u << 16); }
__device__ __forceinline__ float bf_hi(unsigned u) { return __uint_as_float(u & 0xffff0000u); }
__device__ __forceinline__ float wave_sum(float v) {
#pragma unroll
    for (int o = 1; o < 64; o <<= 1) v += __shfl_xor(v, o);
    return v;
}
__device__ __forceinline__ float half_max(float v) { auto rr = __builtin_amdgcn_permlane32_swap(__float_as_uint(v), __float_as_uint(v), false, false); return fmaxf(__uint_as_float(rr[0]), __uint_as_float(rr[1])); }
__device__ __forceinline__ float half_sum(float v) { auto rr = __builtin_amdgcn_permlane32_swap(__float_as_uint(v), __float_as_uint(v), false, false); return __uint_as_float(rr[0]) + __uint_as_float(rr[1]); }

__device__ __forceinline__ int swz(int r, int c) { const int f = (r & 7) ^ (((r >> 3) & 1) << 1) ^ ((r >> 4) & 1); return r * 128 + ((c ^ f) << 4); }

struct G2Args {
    const char* A; const char* B;
    unsigned offA[4], offB[4];
    int nk;
    unsigned akstep;
};
__device__ __forceinline__ unsigned g2_chunk_off(int lane, int w) { const int f = (lane >> 3) ^ ((w & 1) << 1) ^ ((w >> 1) & 1); return (unsigned)(((lane & 7) ^ f) << 4); }
template <int MT, int NT, class Epi>
__device__ __forceinline__ void gemm2n(char* lds_, const G2Args& g, const Epi& epi) {
    constexpr int A_BYTES = 32 * MT * 128, B_BYTES = 64 * NT * 128, STAGE = A_BYTES + B_BYTES, AR = MT / 2, BRR = NT;
    LAS char* lds = (LAS char*)lds_;
    const int tid = threadIdx.x, lane = tid & 63, w = __builtin_amdgcn_readfirstlane(tid >> 6), wr = w >> 2, wc = w & 3, fr = lane & 15, fq = lane >> 4;
    f32x4 acc[MT][NT];
#pragma unroll
    for (int i = 0; i < MT; ++i)
#pragma unroll
        for (int j = 0; j < NT; ++j) acc[i][j] = (f32x4){0.f, 0.f, 0.f, 0.f};
    const int ldsw = w * 1024;
#define G2_STAGE(kt, s) do { \
        _Pragma("unroll") for (int i = 0; i < AR; ++i) __builtin_amdgcn_global_load_lds((const unsigned*)(g.A + g.offA[i] + (size_t)(kt) * g.akstep), (LAS unsigned*)(lds + (s) * STAGE + i * 8192 + ldsw), 16, 0, 0); \
        _Pragma("unroll") for (int i = 0; i < BRR; ++i) __builtin_amdgcn_global_load_lds((const unsigned*)(g.B + g.offB[i] + (size_t)(kt) * 128), (LAS unsigned*)(lds + (s) * STAGE + A_BYTES + i * 8192 + ldsw), 16, 0, 0); } while (0)
    G2_STAGE(0, 0);
    __syncthreads();
    for (int kt = 0; kt < g.nk; ++kt) {
        const int s = kt & 1;
        if (kt + 1 < g.nk) { if (s) G2_STAGE(kt + 1, 0); else G2_STAGE(kt + 1, 1); }
        const char* la = lds_ + s * STAGE; const char* lb = la + A_BYTES;
        {
            constexpr int NG = 2 * (MT / 4);
            bf16x8 bfr[NT], af[2][4];
#pragma unroll
            for (int nt = 0; nt < NT; ++nt) bfr[nt] = *(const bf16x8*)(lb + swz(wc * 16 * NT + nt * 16 + fr, fq));
#pragma unroll
            for (int m = 0; m < 4; ++m) af[0][m] = *(const bf16x8*)(la + swz(wr * 16 * MT + m * 16 + fr, fq));
#pragma unroll
            for (int gi = 0; gi < NG; ++gi) {
                const int ks = gi / (MT / 4), h = gi % (MT / 4);
                if (gi > 0 && h == 0) {
#pragma unroll
                    for (int nt = 0; nt < NT; ++nt) bfr[nt] = *(const bf16x8*)(lb + swz(wc * 16 * NT + nt * 16 + fr, ks * 4 + fq));
                }
                if (gi + 1 < NG) {
                    const int ks2 = (gi + 1) / (MT / 4), h2 = (gi + 1) % (MT / 4);
#pragma unroll
                    for (int m = 0; m < 4; ++m) af[(gi + 1) & 1][m] = *(const bf16x8*)(la + swz(wr * 16 * MT + (h2 * 4 + m) * 16 + fr, ks2 * 4 + fq));
                }
                __builtin_amdgcn_sched_barrier(0);
#pragma unroll
                for (int m = 0; m < 4; ++m)
#pragma unroll
                    for (int nt = 0; nt < NT; ++nt) acc[h * 4 + m][nt] = __builtin_amdgcn_mfma_f32_16x16x32_bf16(bfr[nt], af[gi & 1][m], acc[h * 4 + m][nt], 0, 0, 0);
                __builtin_amdgcn_sched_barrier(0);
            }
        }
        __syncthreads();
    }
#undef G2_STAGE
    epi(acc, wr, wc, fr, fq);
}
template <int MT, class Epi>
__device__ __forceinline__ void gemm2(char* lds_, const G2Args& g, const Epi& epi) { gemm2n<MT, 4>(lds_, g, epi); }
template <int MT>
__device__ __forceinline__ void g2_rows_A(G2Args& g, size_t row0, unsigned ld_bytes) {
    const int lane = threadIdx.x & 63, w = __builtin_amdgcn_readfirstlane(threadIdx.x >> 6); const unsigned co = g2_chunk_off(lane, w);
#pragma unroll
    for (int i = 0; i < MT / 2; ++i) g.offA[i] = (unsigned)((row0 + i * 64 + w * 8 + (lane >> 3)) * ld_bytes) + co;
}
__device__ __forceinline__ void g2_rows_B(G2Args& g, size_t row0, unsigned ld_bytes) {
    const int lane = threadIdx.x & 63, w = __builtin_amdgcn_readfirstlane(threadIdx.x >> 6); const unsigned co = g2_chunk_off(lane, w);
#pragma unroll
    for (int i = 0; i < 4; ++i) g.offB[i] = (unsigned)((row0 + i * 64 + w * 8 + (lane >> 3)) * ld_bytes) + co;
}


struct G3fArgs { const char* A; unsigned offA[4]; const float* b; int nk; unsigned akstep; };
template <int MT, int LDB, class Epi>
__device__ __forceinline__ void gemm3f(char* lds_, const G3fArgs& g, int npass, int bpstep, const Epi& epi) {
    constexpr int A_BYTES = 32 * MT * 128, B_BYTES = 256 * 128, STAGE = A_BYTES + B_BYTES, AR = MT / 2;
    LAS char* lds = (LAS char*)lds_;
    const int tid = threadIdx.x, lane = tid & 63, w = __builtin_amdgcn_readfirstlane(tid >> 6), wr = w >> 2, wc = w & 3, fr = lane & 15, fq = lane >> 4;
    f32x4 acc[MT][4];
#pragma unroll
    for (int i = 0; i < MT; ++i)
#pragma unroll
        for (int j = 0; j < 4; ++j) acc[i][j] = (f32x4){0.f, 0.f, 0.f, 0.f};
    const int ldsw = w * 1024;
    int bw[4];
#pragma unroll
    for (int j = 0; j < 4; ++j) bw[j] = swz(4 * lane + j, w);
    f32x4 br[8];
    const int nk = g.nk, nsteps = nk * npass;
#define G3_STAGE_A(kt, s) do { \
        _Pragma("unroll") for (int i = 0; i < AR; ++i) __builtin_amdgcn_global_load_lds((const unsigned*)(g.A + g.offA[i] + (size_t)(kt) * g.akstep), (LAS unsigned*)(lds + (s) * STAGE + i * 8192 + ldsw), 16, 0, 0); } while (0)
#define G3_LOAD_B(ps, kt) do { const float* pb_ = g.b + (size_t)(ps) * bpstep + (size_t)(kt) * 64 * LDB; _Pragma("unroll") for (int i = 0; i < 8; ++i) br[i] = *(const f32x4*)(pb_ + i * LDB); } while (0)
#define G3_WRITE_B(s) do { _Pragma("unroll") for (int j = 0; j < 4; ++j) { \
            u32x4 v = {cvt_pk(br[0][j], br[1][j]), cvt_pk(br[2][j], br[3][j]), cvt_pk(br[4][j], br[5][j]), cvt_pk(br[6][j], br[7][j])}; \
            *(u32x4*)(lds_ + (s) * STAGE + A_BYTES + bw[j]) = v; } } while (0)
    G3_STAGE_A(0, 0); G3_LOAD_B(0, 0); G3_WRITE_B(0);
    __syncthreads();
    int ps = 0, kt = 0;
    for (int st = 0; st < nsteps; ++st) {
        const int s = st & 1; const bool more = st + 1 < nsteps;
        int ps2 = ps, kt2 = kt + 1; if (kt2 == nk) { kt2 = 0; ++ps2; }
        if (more) { if (s) G3_STAGE_A(kt2, 0); else G3_STAGE_A(kt2, 1); G3_LOAD_B(ps2, kt2); }
        __builtin_amdgcn_sched_barrier(0);
        const char* la = lds_ + s * STAGE; const char* lb = la + A_BYTES;
#pragma unroll
        for (int ks = 0; ks < 2; ++ks) {
            bf16x8 bfr[4];
#pragma unroll
            for (int nt = 0; nt < 4; ++nt) bfr[nt] = *(const bf16x8*)(lb + swz(wc * 64 + nt * 16 + fr, ks * 4 + fq));
#pragma unroll
            for (int h = 0; h < MT / 2; ++h) {
                bf16x8 af[2];
#pragma unroll
                for (int m = 0; m < 2; ++m) af[m] = *(const bf16x8*)(la + swz(wr * 16 * MT + (h * 2 + m) * 16 + fr, ks * 4 + fq));
                __builtin_amdgcn_sched_barrier(0);
#pragma unroll
                for (int m = 0; m < 2; ++m)
#pragma unroll
                    for (int nt = 0; nt < 4; ++nt) acc[h * 2 + m][nt] = __builtin_amdgcn_mfma_f32_16x16x32_bf16(bfr[nt], af[m], acc[h * 2 + m][nt], 0, 0, 0);
                __builtin_amdgcn_sched_barrier(0);
            }
        }
        if (kt == nk - 1) {
            epi(acc, ps, wr, wc, fr, fq);
#pragma unroll
            for (int i = 0; i < MT; ++i)
#pragma unroll
                for (int j = 0; j < 4; ++j) acc[i][j] = (f32x4){0.f, 0.f, 0.f, 0.f};
        }
        if (more) { if (s) G3_WRITE_B(0); else G3_WRITE_B(1); }
        __syncthreads();
        ps = ps2; kt = kt2;
    }
#undef G3_STAGE_A
#undef G3_LOAD_B
#undef G3_WRITE_B
}

__device__ __forceinline__ void cvt_item(const float* W, int K, int N, bf16_t* WT, int ldt, int kb, int nb, int kc, int lane) {
    const float* src = W + (size_t)(kb * 64 + kc * 8) * N + nb * 256 + 4 * lane;
    bf16_t* dst = WT + (size_t)(nb * 256 + 4 * lane) * ldt + kb * 64 + kc * 8;
    f32x4 r[8];
#pragma unroll
    for (int i = 0; i < 8; ++i) r[i] = *(const f32x4*)(src + (size_t)i * N);
#pragma unroll
    for (int j = 0; j < 4; ++j) {
        u32x4 v = {cvt_pk(r[0][j], r[1][j]), cvt_pk(r[2][j], r[3][j]), cvt_pk(r[4][j], r[5][j]), cvt_pk(r[6][j], r[7][j])};
        *(u32x4*)(dst + (size_t)j * ldt) = v;
    }
}
__device__ __forceinline__ void phase_prep(const Params& p, int vb, int G) {
    const int tid = threadIdx.x, lane = tid & 63, w = tid >> 6;
    float* cs = (float*)(p.ws + WS_ROPE); float* sn = cs + (size_t)S * 32;
    for (int idx = vb * NTHREADS + tid; idx < S * 32; idx += G * NTHREADS) {
        const int pos = idx >> 5, i = idx & 31;
        const float pw = (float)pow(10000.0, (double)i / 32.0);
        const float inv = 1.0f / pw;
        const float angf = __fmul_rn((float)pos, inv);
        const double a = (double)angf;
        const double q = rint(a * 0.63661977236758134308);
        double r = fma(-q, 1.57079632679489655800, a); r = fma(-q, 6.12323399573676603587e-17, r);
        const double r2 = r * r;
        double sp = r * (1.0 + r2 * (-1.0 / 6 + r2 * (1.0 / 120 + r2 * (-1.0 / 5040 + r2 * (1.0 / 362880 + r2 * (-1.0 / 39916800))))));
        double cp = 1.0 + r2 * (-0.5 + r2 * (1.0 / 24 + r2 * (-1.0 / 720 + r2 * (1.0 / 40320 + r2 * (-1.0 / 3628800 + r2 * (1.0 / 479001600))))));
        const int qi = ((int)((long long)q)) & 3;
        double sv, cv;
        if (qi == 0) { sv = sp; cv = cp; } else if (qi == 1) { sv = cp; cv = -sp; } else if (qi == 2) { sv = -sp; cv = -cp; } else { sv = -cp; cv = sp; }
        cs[idx] = (float)cv; sn[idx] = (float)sv;
    }
    { const f32x4* xs = (const f32x4*)p.x; u32x4* xd = (u32x4*)(p.ws + WS_XB);
      for (size_t i = (size_t)vb * NTHREADS + tid; i < (size_t)S * D / 8; i += (size_t)G * NTHREADS) {
          const f32x4 a = xs[2 * i], b = xs[2 * i + 1];
          xd[i] = (u32x4){cvt_pk(a[0], a[1]), cvt_pk(a[2], a[3]), cvt_pk(b[0], b[1]), cvt_pk(b[2], b[3])}; } }
    const int gw = vb * 8 + w, NGW = G * 8;
    constexpr int I_IN = 16 * 9, I_OUT = 16 * 4, I_R = 16, I_SG = 16, I_SU = 16, I_SD = 4 * 4, I_SMALL = I_IN + I_OUT + I_R;
    for (int it8 = gw; it8 < I_SMALL * 8; it8 += NGW) {
        int r = it8 >> 3; const int kc = it8 & 7;
        if (r < I_IN) { cvt_item(p.w_in, D, INW, (bf16_t*)(p.ws + WS_WIN), D, r / 9, r % 9, kc, lane); continue; } r -= I_IN;
        if (r < I_OUT) { cvt_item(p.w_out, D, D, (bf16_t*)(p.ws + WS_WOUT), D, r >> 2, r & 3, kc, lane); continue; } r -= I_OUT;
        cvt_item(p.w_r, D, NE, (bf16_t*)(p.ws + WS_WR), D, r, 0, kc, lane);
    }
}

template <int MT> struct EpiProj {
    const float* bias; const float* cs; const float* sn; bf16_t* out; int row0, col0; char* lds;
    __device__ __forceinline__ void operator()(f32x4 (&acc)[MT][4], int wr, int wc, int fr, int fq) const {
        const int hb = col0 + wc * 64;
        const bool is_q = (hb < C_AK) || (hb >= C_BQ && hb < C_BK);
        const bool is_rope = is_q || (hb >= C_AK && hb < C_AV) || (hb >= C_BK && hb < C_BV);
        const float sc = is_q ? QSCALE : 1.0f;
        const int tid = threadIdx.x, w = __builtin_amdgcn_readfirstlane(tid >> 6), lane = tid & 63;
        constexpr int TB = 32 * MT * 128;
        LAS char* l3 = (LAS char*)lds;
#pragma unroll
        for (int i = 0; i < TB / 8192; ++i) {
            __builtin_amdgcn_global_load_lds((const unsigned*)((const char*)(cs + (size_t)row0 * 32) + i * 8192 + w * 1024 + lane * 16), (LAS unsigned*)(l3 + i * 8192 + w * 1024), 16, 0, 0);
            __builtin_amdgcn_global_load_lds((const unsigned*)((const char*)(sn + (size_t)row0 * 32) + i * 8192 + w * 1024 + lane * 16), (LAS unsigned*)(l3 + TB + i * 8192 + w * 1024), 16, 0, 0);
        }
        f32x4 bv[4];
#pragma unroll
        for (int nt = 0; nt < 4; ++nt) bv[nt] = *(const f32x4*)(bias + hb + nt * 16 + 4 * fq);
        __syncthreads();
        const float* lcs = (const float*)lds; const float* lsn = (const float*)(lds + TB);
#pragma unroll
        for (int mt = 0; mt < MT; ++mt) {
            const int rl = wr * 16 * MT + mt * 16 + fr, row = row0 + rl;
            f32x4 v[4];
#pragma unroll
            for (int nt = 0; nt < 4; ++nt) v[nt] = acc[mt][nt] + bv[nt];
            if (is_rope) {
#pragma unroll
                for (int nt = 0; nt < 2; ++nt) {
                    const f32x4 c = *(const f32x4*)(lcs + rl * 32 + nt * 16 + 4 * fq), s = *(const f32x4*)(lsn + rl * 32 + nt * 16 + 4 * fq);
                    const f32x4 t1 = v[nt], t2 = v[nt + 2];
                    v[nt] = t1 * c - t2 * s; v[nt + 2] = t2 * c + t1 * s;
                }
            }
#pragma unroll
            for (int nt = 0; nt < 4; ++nt) {
                const f32x4 o = v[nt] * sc;
                u32x2 pk = {cvt_pk(o[0], o[1]), cvt_pk(o[2], o[3])};
                *(u32x2*)(out + (size_t)row * INW + hb + nt * 16 + 4 * fq) = pk;
            }
        }
        __syncthreads();
    }
};
struct EpiProjQ {
    const float* bias; const float* cs; const float* sn; bf16_t* out; int row0, col0;
    __device__ __forceinline__ void operator()(f32x4 (&acc)[4][2], int wr, int wc, int fr, int fq) const {
        const int hb = col0 + (wc >> 1) * 64, i0 = (wc & 1) * 16 + 4 * fq;
        const bool is_q = (hb < C_AK) || (hb >= C_BQ && hb < C_BK);
        const bool is_rope = is_q || (hb >= C_AK && hb < C_AV) || (hb >= C_BK && hb < C_BV);
        const float sc = is_q ? QSCALE : 1.0f;
#pragma unroll
        for (int mt = 0; mt < 4; ++mt) {
            const int row = row0 + wr * 64 + mt * 16 + fr;
            f32x4 v0 = acc[mt][0] + *(const f32x4*)(bias + hb + i0), v1 = acc[mt][1] + *(const f32x4*)(bias + hb + 32 + i0);
            if (is_rope) {
                const f32x4 c = *(const f32x4*)(cs + (size_t)row * 32 + i0), s = *(const f32x4*)(sn + (size_t)row * 32 + i0);
                const f32x4 t1 = v0, t2 = v1; v0 = t1 * c - t2 * s; v1 = t2 * c + t1 * s;
            }
            v0 = v0 * sc; v1 = v1 * sc;
            *(u32x2*)(out + (size_t)row * INW + hb + i0) = (u32x2){cvt_pk(v0[0], v0[1]), cvt_pk(v0[2], v0[3])};
            *(u32x2*)(out + (size_t)row * INW + hb + 32 + i0) = (u32x2){cvt_pk(v1[0], v1[1]), cvt_pk(v1[2], v1[3])};
        }
    }
};
__device__ __forceinline__ void phase_proj(const Params& p, char* lds, int vb, int G) {
    const float* cs = (const float*)(p.ws + WS_ROPE); const float* sn = cs + (size_t)S * 32;
    constexpr int NBIG = 512, NUNITS = NBIG + 4 * 64;
    for (int u = vb; u < NUNITS; u += G) {
        G2Args g; g.A = (const char*)(p.ws + WS_XB); g.B = (const char*)(p.ws + WS_WIN); g.nk = D / 64; g.akstep = 128;
        if (u < NBIG) {
            const int tm = u / 9, tn = u % 9;
            g2_rows_A<8>(g, (size_t)tm * 256, D * 2); g2_rows_B(g, (size_t)tn * 256, D * 2);
            EpiProj<8> e{p.b_in, cs, sn, (bf16_t*)(p.ws + WS_PROJ), tm * 256, tn * 256, lds};
            gemm2<8>(lds, g, e);
        } else {
            const int q = u - NBIG, t = NBIG + (q >> 2), hm = (q >> 1) & 1, hn = q & 1, tm = t / 9, tn = t % 9;
            g2_rows_A<4>(g, (size_t)tm * 256 + hm * 128, D * 2);
            { const int lane = threadIdx.x & 63, w = __builtin_amdgcn_readfirstlane(threadIdx.x >> 6); const unsigned co = g2_chunk_off(lane, w);
#pragma unroll
              for (int i = 0; i < 2; ++i) { const int n = i * 64 + w * 8 + (lane >> 3), wcn = n >> 5, sub = n & 31;
                  const int col = tn * 256 + hn * 128 + (wcn >> 1) * 64 + (wcn & 1) * 16 + (sub & 15) + (sub >> 4) * 32;
                  g.offB[i] = (unsigned)col * (unsigned)(D * 2) + co; } }
            EpiProjQ e{p.b_in, cs, sn, (bf16_t*)(p.ws + WS_PROJ), tm * 256 + hm * 128, tn * 256 + hn * 128};
            gemm2n<4, 2>(lds, g, e);
        }
    }
}

template <int OFF> __device__ __forceinline__ s16x4 tr_read(int vb) { s16x4 r; asm volatile("ds_read_b64_tr_b16 %0, %1 offset:%2" : "=&v"(r) : "v"(vb), "i"(OFF) : "memory"); return r; }
__device__ __forceinline__ int v_off(int k, int c, int ndb) { return ((k >> 3) * ndb + (c >> 5)) * 512 + ((k & 7) * 32 + (c & 31)) * 2; }

constexpr int AT_STAGE = 32768;
template <int NDB, int KB, int T> struct PvPart {
    static __device__ __forceinline__ void run(f32x16& o, int vbase, const bf16x8& pa, const bf16x8& pb) {
        constexpr int o0 = (KB * 4 * NDB + T) * 512, st = NDB * 512;
        const s16x4 l0 = tr_read<o0 + 0 * st>(vbase), h0 = tr_read<o0 + 1 * st>(vbase), l1 = tr_read<o0 + 2 * st>(vbase), h1 = tr_read<o0 + 3 * st>(vbase);
        asm volatile("s_waitcnt lgkmcnt(0)" ::: "memory"); __builtin_amdgcn_sched_barrier(0);
#define PKV(L, H) (bf16x8){L[0], L[1], L[2], L[3], H[0], H[1], H[2], H[3]}
        o = __builtin_amdgcn_mfma_f32_32x32x16_bf16(PKV(l0, h0), pa, o, 0, 0, 0);
        o = __builtin_amdgcn_mfma_f32_32x32x16_bf16(PKV(l1, h1), pb, o, 0, 0, 0);
#undef PKV
    }
};
template <int NDB, int KB>
__device__ __forceinline__ void pv_half(f32x16 (&o)[NDB], f32x16& ol, int vbase, const bf16x8& pa, const bf16x8& pb) {
    const bf16x8 ones = {16256, 16256, 16256, 16256, 16256, 16256, 16256, 16256};
    ol = __builtin_amdgcn_mfma_f32_32x32x16_bf16(ones, pa, ol, 0, 0, 0);
    ol = __builtin_amdgcn_mfma_f32_32x32x16_bf16(ones, pb, ol, 0, 0, 0);
    PvPart<NDB, KB, 0>::run(o[0], vbase, pa, pb); PvPart<NDB, KB, 1>::run(o[1], vbase, pa, pb);
    if constexpr (NDB == 4) { PvPart<NDB, KB, 2>::run(o[2], vbase, pa, pb); PvPart<NDB, KB, 3>::run(o[3], vbase, pa, pb); }
}
constexpr float ATT_THR = 10.0f;
template <int NDB>
__device__ __forceinline__ void attn_scores(char* lds, int kof, const bf16x8 (&qf)[4], f32x16& s0, f32x16& s1, f32x16 (&o)[NDB], f32x16& ol, f32x16& nm, bool first, int r32, int hi) {
    s0 = nm; s1 = nm;
#pragma unroll
    for (int ds = 0; ds < 4; ++ds) {
        const bf16x8 k0 = *(const bf16x8*)(lds + kof + swz(r32, ds * 2 + hi)), k1 = *(const bf16x8*)(lds + kof + swz(32 + r32, ds * 2 + hi));
        s0 = __builtin_amdgcn_mfma_f32_32x32x16_bf16(k0, qf[ds], s0, 0, 0, 0);
        s1 = __builtin_amdgcn_mfma_f32_32x32x16_bf16(k1, qf[ds], s1, 0, 0, 0);
    }
    float mx = fmaxf(s0[0], s1[0]);
#pragma unroll
    for (int r = 1; r < 16; ++r) mx = fmaxf(fmaxf(mx, s0[r]), s1[r]);
    mx = half_max(mx);
    if (first || __any(mx > ATT_THR)) {
        const float delta = first ? mx : fmaxf(mx, 0.f), alpha = first ? 0.f : __builtin_amdgcn_exp2f(-delta);
#pragma unroll
        for (int r = 0; r < 16; ++r) { s0[r] -= delta; s1[r] -= delta; nm[r] -= delta; ol[r] *= alpha; }
#pragma unroll
        for (int t = 0; t < NDB; ++t)
#pragma unroll
            for (int r = 0; r < 16; ++r) o[t][r] *= alpha;
    }
}
__device__ __forceinline__ void exp_pack(const f32x16& s, bf16x8& pa, bf16x8& pb) {
    float e[16];
#pragma unroll
    for (int r = 0; r < 16; ++r) e[r] = __builtin_amdgcn_exp2f(s[r]);
    u32x4 a = {cvt_pk(e[0], e[1]), cvt_pk(e[2], e[3]), cvt_pk(e[4], e[5]), cvt_pk(e[6], e[7])};
    u32x4 b = {cvt_pk(e[8], e[9]), cvt_pk(e[10], e[11]), cvt_pk(e[12], e[13]), cvt_pk(e[14], e[15])};
    pa = *(bf16x8*)&a; pb = *(bf16x8*)&b;
}

template <int OFF> __device__ __forceinline__ bf16x8 k_read(int a) { bf16x8 r; asm volatile("ds_read_b128 %0, %1 offset:%2" : "=&v"(r) : "v"(a), "i"(OFF) : "memory"); return r; }
struct VSet { s16x4 l0, h0, l1, h1; };
template <int KB, int T> __device__ __forceinline__ void v_issue(VSet& v, int vbase) {
    constexpr int o0 = (KB * 16 + T) * 512, st = 4 * 512;
    v.l0 = tr_read<o0>(vbase); v.h0 = tr_read<o0 + st>(vbase); v.l1 = tr_read<o0 + 2 * st>(vbase); v.h1 = tr_read<o0 + 3 * st>(vbase);
}
#define WAIT_K(n, a, b) asm volatile("s_waitcnt lgkmcnt(" #n ")" : "+v"(a), "+v"(b) :: "memory")
#define WAIT_V(n, v) asm volatile("s_waitcnt lgkmcnt(" #n ")" : "+v"(v.l0), "+v"(v.h0), "+v"(v.l1), "+v"(v.h1) :: "memory")
#define PKV(L, H) (bf16x8){L[0], L[1], L[2], L[3], H[0], H[1], H[2], H[3]}
#define MF32(a, b, c) __builtin_amdgcn_mfma_f32_32x32x16_bf16(a, b, c, 0, 0, 0)
#define SB __builtin_amdgcn_sched_barrier(0)
#define EXP4(src, i, wlo, whi) do { const float e0_ = __builtin_amdgcn_exp2f(src[4 * (i)]), e1_ = __builtin_amdgcn_exp2f(src[4 * (i) + 1]), e2_ = __builtin_amdgcn_exp2f(src[4 * (i) + 2]), e3_ = __builtin_amdgcn_exp2f(src[4 * (i) + 3]); \
        asm("v_add_f32 %0, %1, %0" : "+v"(l2[0]) : "v"(e0_)); asm("v_add_f32 %0, %1, %0" : "+v"(l2[1]) : "v"(e1_)); asm("v_add_f32 %0, %1, %0" : "+v"(l2[0]) : "v"(e2_)); asm("v_add_f32 %0, %1, %0" : "+v"(l2[1]) : "v"(e3_)); \
        wlo = cvt_pk(e0_, e1_); whi = cvt_pk(e2_, e3_); } while (0)
#define MAX4(i) do { mx = fmaxf(fmaxf(mx, n0[4 * (i)]), n1[4 * (i)]); mx = fmaxf(fmaxf(mx, n0[4 * (i) + 1]), n1[4 * (i) + 1]); \
        mx = fmaxf(fmaxf(mx, n0[4 * (i) + 2]), n1[4 * (i) + 2]); mx = fmaxf(fmaxf(mx, n0[4 * (i) + 3]), n1[4 * (i) + 3]); asm volatile("" : "+v"(mx)); } while (0)
struct DmaPlan { const char* base; unsigned gk, gv; size_t ok3, ok4, ov2, ov3; LAS char* dk3; LAS char* dk4; LAS char* dv2; LAS char* dv3; };
#define DMAP(src, dst) __builtin_amdgcn_global_load_lds((const unsigned*)(src), (LAS unsigned*)(dst), 16, 0, 0)
template <bool DMA>
__device__ __forceinline__ void diff_slot(f32x16& c0, f32x16& c1, f32x16& n0, f32x16& n1, f32x16 (&o)[4], f32x2& l2, f32x16& nm, const bf16x8 (&qf)[4],
                                          int ka0, int ka1, int ka2, int ka3, int vbase, bool has_next, const DmaPlan& dp) {
    constexpr bool HASNEXT = true;
    bf16x8 kA, kB, kC, kD, kE, kF, kG, kH; VSet v0, v1, v2, v3, v4, v5, v6, v7; u32x4 w0, w1, w2, w3;
    SB;
    if constexpr (HASNEXT) { kA = k_read<0>(ka0); kB = k_read<4096>(ka0); kC = k_read<0>(ka1); kD = k_read<4096>(ka1); }
    EXP4(c0, 0, w0[0], w0[1]);
    if constexpr (HASNEXT) { WAIT_K(2, kA, kB); kE = k_read<0>(ka2); kF = k_read<4096>(ka2); n0 = MF32(kA, qf[0], nm); n1 = MF32(kB, qf[0], nm); }
    if constexpr (DMA) DMAP(dp.base + dp.ok3 + dp.gk, dp.dk3);
    SB;
    EXP4(c0, 1, w0[2], w0[3]);
    if constexpr (HASNEXT) { WAIT_K(2, kC, kD); kG = k_read<0>(ka3); kH = k_read<4096>(ka3); n0 = MF32(kC, qf[1], n0); n1 = MF32(kD, qf[1], n1); }
    if constexpr (DMA) DMAP(dp.base + (dp.ok3 + 128) + dp.gk, dp.dk3 + 8192);
    SB;
    EXP4(c0, 2, w1[0], w1[1]);
    if constexpr (HASNEXT) { WAIT_K(2, kE, kF); }
    v_issue<0, 0>(v0, vbase);
    if constexpr (HASNEXT) { n0 = MF32(kE, qf[2], n0); n1 = MF32(kF, qf[2], n1); }
    if constexpr (DMA) DMAP(dp.base + dp.ov2 + dp.gv, dp.dv2);
    SB;
    EXP4(c0, 3, w1[2], w1[3]);
    if constexpr (HASNEXT) { WAIT_K(4, kG, kH); }
    v_issue<0, 1>(v1, vbase);
    if constexpr (HASNEXT) { n0 = MF32(kG, qf[3], n0); n1 = MF32(kH, qf[3], n1); }
    if constexpr (DMA) DMAP(dp.base + (dp.ov2 + 128) + dp.gv, dp.dv2 + 1024);
    const bf16x8 p0 = *(bf16x8*)&w0, p1 = *(bf16x8*)&w1;
    SB;
    EXP4(c1, 0, w2[0], w2[1]);
    WAIT_V(4, v0); v_issue<0, 2>(v2, vbase);
    o[0] = MF32(PKV(v0.l0, v0.h0), p0, o[0]); o[0] = MF32(PKV(v0.l1, v0.h1), p1, o[0]);
    if constexpr (DMA) DMAP(dp.base + dp.ov3 + dp.gv, dp.dv3);
    SB;
    EXP4(c1, 1, w2[2], w2[3]);
    WAIT_V(4, v1); v_issue<0, 3>(v3, vbase);
    o[1] = MF32(PKV(v1.l0, v1.h0), p0, o[1]); o[1] = MF32(PKV(v1.l1, v1.h1), p1, o[1]);
    if constexpr (DMA) DMAP(dp.base + (dp.ov3 + 128) + dp.gv, dp.dv3 + 1024);
    SB;
    EXP4(c1, 2, w3[0], w3[1]);
    WAIT_V(4, v2); v_issue<1, 0>(v4, vbase);
    o[2] = MF32(PKV(v2.l0, v2.h0), p0, o[2]); o[2] = MF32(PKV(v2.l1, v2.h1), p1, o[2]);
    if constexpr (DMA) DMAP(dp.base + dp.ok4 + dp.gk, dp.dk4);
    SB;
    EXP4(c1, 3, w3[2], w3[3]);
    WAIT_V(4, v3); v_issue<1, 1>(v5, vbase);
    o[3] = MF32(PKV(v3.l0, v3.h0), p0, o[3]); o[3] = MF32(PKV(v3.l1, v3.h1), p1, o[3]);
    if constexpr (DMA) DMAP(dp.base + (dp.ok4 + 128) + dp.gk, dp.dk4 + 8192);
    const bf16x8 p2 = *(bf16x8*)&w2, p3 = *(bf16x8*)&w3;
    SB;
    float mx = -3.0e38f;
    if constexpr (HASNEXT) MAX4(0);
    WAIT_V(4, v4); v_issue<1, 2>(v6, vbase);
    o[0] = MF32(PKV(v4.l0, v4.h0), p2, o[0]); o[0] = MF32(PKV(v4.l1, v4.h1), p3, o[0]);
    SB;
    if constexpr (HASNEXT) MAX4(1);
    WAIT_V(4, v5); v_issue<1, 3>(v7, vbase);
    o[1] = MF32(PKV(v5.l0, v5.h0), p2, o[1]); o[1] = MF32(PKV(v5.l1, v5.h1), p3, o[1]);
    SB;
    if constexpr (HASNEXT) MAX4(2);
    WAIT_V(4, v6);
    o[2] = MF32(PKV(v6.l0, v6.h0), p2, o[2]); o[2] = MF32(PKV(v6.l1, v6.h1), p3, o[2]);
    SB;
    if constexpr (HASNEXT) MAX4(3);
    WAIT_V(0, v7);
    o[3] = MF32(PKV(v7.l0, v7.h0), p2, o[3]); o[3] = MF32(PKV(v7.l1, v7.h1), p3, o[3]);
    SB;
    if (has_next) {
        mx = half_max(mx);
        if (__any(mx > ATT_THR)) {
            const float delta = fmaxf(mx, 0.f), alpha = __builtin_amdgcn_exp2f(-delta);
#pragma unroll
            for (int r = 0; r < 16; ++r) { n0[r] -= delta; n1[r] -= delta; nm[r] -= delta; }
            l2 *= alpha;
#pragma unroll
            for (int t = 0; t < 4; ++t)
#pragma unroll
                for (int r = 0; r < 16; ++r) o[t][r] *= alpha;
        }
    }
}
__device__ __forceinline__ void attn_diff_unit(const Params& p, char* lds_, int h, int qb, float lam) {
    LAS char* lds = (LAS char*)lds_;
    const int tid = threadIdx.x, lane = tid & 63, w = __builtin_amdgcn_readfirstlane(tid >> 6), r32 = lane & 31, hi = lane >> 5, mp = w >> 2, wq = w & 3;
    const bf16_t* proj = (const bf16_t*)(p.ws + WS_PROJ);
    const int NT = 2 * qb + 2, NP = NT / 2, myNT = (wq < 2) ? NT - 1 : NT;
    bf16x8 qf[4];
    { const bf16_t* qp = proj + (size_t)(qb * 128 + wq * 32 + r32) * INW + C_BQ + h * 128 + mp * 64 + hi * 8;
#pragma unroll
      for (int ds = 0; ds < 4; ++ds) qf[ds] = *(const bf16x8*)(qp + ds * 16); }
    asm volatile("" : "+v"(qf[0]), "+v"(qf[1]), "+v"(qf[2]), "+v"(qf[3]));
    f32x16 o[4] = {}; f32x16 nm; f32x2 l2 = {0.f, 0.f};
    const unsigned gko = (unsigned)((w * 8 + (lane >> 3)) * INW + C_BK + h * 128) * 2u + g2_chunk_off(lane, w);
    const unsigned gvo = (unsigned)((w * 8 + ((lane & 31) >> 2)) * INW + C_BV + h * 128 + (lane >> 5) * 32 + (lane & 3) * 8) * 2u;
    const char* gk = (const char*)proj + gko; const char* gv = (const char*)proj + gvo;
    const int vlane = ((lane & 3) << 3) | (((lane >> 2) & 3) << 6) | (((lane >> 4) & 1) << 5) | (((lane >> 5) & 1) << 8);
    const int ldsb = (int)(uintptr_t)lds_;
    const int kad0 = ldsb + mp * 8192 + swz(r32, 0 + hi), kad1 = ldsb + mp * 8192 + swz(r32, 2 + hi), kad2 = ldsb + mp * 8192 + swz(r32, 4 + hi), kad3 = ldsb + mp * 8192 + swz(r32, 6 + hi);
    constexpr size_t TSTEP = (size_t)64 * INW * 2;
#define DMA_K(t_) do { const int tt_ = (t_); const char* s_ = gk + (size_t)tt_ * TSTEP; LAS char* d_ = lds + (tt_ & 3) * 16384 + w * 1024; \
        __builtin_amdgcn_global_load_lds((const unsigned*)s_, (LAS unsigned*)d_, 16, 0, 0); \
        __builtin_amdgcn_global_load_lds((const unsigned*)(s_ + 128), (LAS unsigned*)(d_ + 8192), 16, 0, 0); } while (0)
#define DMA_V(t_) do { const int tt_ = (t_); const char* s_ = gv + (size_t)tt_ * TSTEP; LAS char* d_ = lds + 65536 + (tt_ & 3) * 16384 + (2 * w) * 1024; \
        __builtin_amdgcn_global_load_lds((const unsigned*)s_, (LAS unsigned*)d_, 16, 0, 0); \
        __builtin_amdgcn_global_load_lds((const unsigned*)(s_ + 128), (LAS unsigned*)(d_ + 1024), 16, 0, 0); } while (0)
    DMA_K(0); DMA_K(1); if (NT > 2) DMA_K(2); DMA_V(0); DMA_V(1);
    __syncthreads();
    f32x16 A0 = {}, A1 = {}, B0 = {}, B1 = {};
    {
#pragma unroll
        for (int ds = 0; ds < 4; ++ds) {
            const bf16x8 k0 = *(const bf16x8*)(lds_ + mp * 8192 + swz(r32, ds * 2 + hi)), k1 = *(const bf16x8*)(lds_ + mp * 8192 + swz(32 + r32, ds * 2 + hi));
            A0 = MF32(k0, qf[ds], A0); A1 = MF32(k1, qf[ds], A1);
        }
        float mx = fmaxf(A0[0], A1[0]);
#pragma unroll
        for (int r = 1; r < 16; ++r) mx = fmaxf(fmaxf(mx, A0[r]), A1[r]);
        mx = half_max(mx);
#pragma unroll
        for (int r = 0; r < 16; ++r) { A0[r] -= mx; A1[r] -= mx; nm[r] = -mx; }
    }
    __syncthreads();
    for (int it = 0; it < NP; ++it) {
        const int t = 2 * it;
        DmaPlan dp;
        dp.base = (const char*)proj; dp.gk = gko; dp.gv = gvo;
        dp.ok3 = (size_t)min(t + 3, NT - 1) * TSTEP; dp.dk3 = lds + ((t + 3) & 3) * 16384 + w * 1024;
        dp.ok4 = (size_t)min(t + 4, NT - 1) * TSTEP; dp.dk4 = lds + ((t + 4) & 3) * 16384 + w * 1024;
        dp.ov2 = (size_t)min(t + 2, NT - 1) * TSTEP; dp.dv2 = lds + 65536 + ((t + 2) & 3) * 16384 + (2 * w) * 1024;
        dp.ov3 = (size_t)min(t + 3, NT - 1) * TSTEP; dp.dv3 = lds + 65536 + ((t + 3) & 3) * 16384 + (2 * w) * 1024;
        { const int ks = ((t + 1) & 3) * 16384, vb_ = ldsb + 65536 + (t & 3) * 16384 + vlane;
          diff_slot<true>(A0, A1, B0, B1, o, l2, nm, qf, kad0 + ks, kad1 + ks, kad2 + ks, kad3 + ks, vb_, t + 1 < myNT, dp); }
        if (t + 1 < myNT) {
            const int ks = ((t + 2) & 3) * 16384, vb_ = ldsb + 65536 + ((t + 1) & 3) * 16384 + vlane;
            diff_slot<false>(B0, B1, A0, A1, o, l2, nm, qf, kad0 + ks, kad1 + ks, kad2 + ks, kad3 + ks, vb_, t + 2 < myNT, dp);
        }
        __syncthreads();
    }
#undef DMA_K
#undef DMA_V
    float* xb = (float*)lds_;
    const float il = 1.0f / half_sum(l2[0] + l2[1]);
    if (mp == 1) {
        const float f = il * *(const float*)(lds_ + LDS_MISC);
#pragma unroll
        for (int t = 0; t < 4; ++t)
#pragma unroll
            for (int r = 0; r < 16; ++r) xb[(wq * 64 + t * 16 + r) * 64 + lane] = o[t][r] * f;
    }
    __syncthreads();
    if (mp == 0) {
        float ss = 0.f;
#pragma unroll
        for (int t = 0; t < 4; ++t)
#pragma unroll
            for (int r = 0; r < 16; ++r) { const float v = o[t][r] * il - xb[(wq * 64 + t * 16 + r) * 64 + lane]; o[t][r] = v; ss += v * v; }
        ss = half_sum(ss);
        const float rs = rsqrtf(ss * (1.0f / 128.0f) + LN_EPS) * 0.8f;
        bf16_t* op = (bf16_t*)(p.ws + WS_ATT) + (size_t)(qb * 128 + wq * 32 + r32) * D + 512 + h * 128;
#pragma unroll
        for (int t = 0; t < 4; ++t)
#pragma unroll
            for (int rr = 0; rr < 4; ++rr) {
                const int dv0 = 32 * t + 8 * rr + 4 * hi;
                const f32x4 gg = *(const f32x4*)(p.subg + dv0);
                u32x2 pk = {cvt_pk(o[t][4 * rr] * rs * gg[0], o[t][4 * rr + 1] * rs * gg[1]), cvt_pk(o[t][4 * rr + 2] * rs * gg[2], o[t][4 * rr + 3] * rs * gg[3])};
                *(u32x2*)(op + dv0) = pk;
            }
    }
    __syncthreads();
}
#undef DMAP
#undef WAIT_K
#undef WAIT_V
#undef PKV
#undef MF32
#undef SB
#undef EXP4
#undef MAX4
__device__ __forceinline__ void attn_swa_unit(const Params& p, char* lds, int kvh, int n) {
    const int tid = threadIdx.x, lane = tid & 63, w = __builtin_amdgcn_readfirstlane(tid >> 6), r32 = lane & 31, hi = lane >> 5, g = w >> 1, hq = kvh * 4 + g;
    const bf16_t* proj = (const bf16_t*)(p.ws + WS_PROJ);
    const int c0 = (n >= 2) ? n - 2 : 0, NT = n - c0 + 1;
    const int tok = n * 64 + (w & 1) * 32 + r32;
    bf16x8 qf[4];
    { const bf16_t* qp = proj + (size_t)tok * INW + C_AQ + hq * 64 + hi * 8;
#pragma unroll
      for (int ds = 0; ds < 4; ++ds) qf[ds] = *(const bf16x8*)(qp + ds * 16); }
    f32x16 o[2] = {}; f32x16 ol, nm;
    { float ms = -p.sinks[hq] * LOG2E; asm volatile("" : "+v"(qf[0]), "+v"(qf[1]), "+v"(qf[2]), "+v"(qf[3]), "+v"(ms));
#pragma unroll
      for (int r = 0; r < 16; ++r) { nm[r] = ms; ol[r] = 1.0f; } }
    const bf16_t* gk = proj + (size_t)(c0 * 64 + (tid >> 3)) * INW + C_AK + kvh * 64 + (tid & 7) * 8;
    const bf16_t* gv = proj + (size_t)(c0 * 64 + (tid >> 3)) * INW + C_AV + kvh * 64 + (tid & 7) * 8;
    const int wk = swz(tid >> 3, tid & 7), wv = v_off(tid >> 3, (tid & 7) * 8, 2);
    const int vlane = ((lane & 3) << 3) | (((lane >> 2) & 3) << 6) | (((lane >> 4) & 1) << 5) | (((lane >> 5) & 1) << 8);
    u32x4 st0, st1;
#define W_LOAD(t) do { const size_t ko = (size_t)(t) * 64 * INW; st0 = *(const u32x4*)(gk + ko); st1 = *(const u32x4*)(gv + ko); } while (0)
#define W_WRITE(b) do { char* sb = lds + (b) * AT_STAGE; *(u32x4*)(sb + wk) = st0; *(u32x4*)(sb + 8192 + wv) = st1; } while (0)
    W_LOAD(0); W_WRITE(0); __syncthreads();
    for (int t = 0; t < NT; ++t) {
        const int b = t & 1;
        if (t + 1 < NT) W_LOAD(t + 1);
        { f32x16 s0, s1; bf16x8 p0, p1, p2, p3; const int vb_ = (int)(uintptr_t)(lds + b * AT_STAGE + 8192) + vlane;
          attn_scores<2>(lds, b * AT_STAGE, qf, s0, s1, o, ol, nm, false, r32, hi);
          exp_pack(s0, p0, p1); pv_half<2, 0>(o, ol, vb_, p0, p1); exp_pack(s1, p2, p3); pv_half<2, 1>(o, ol, vb_, p2, p3); }
        if (t + 1 < NT) W_WRITE(b ^ 1);
        __syncthreads();
    }
#undef W_LOAD
#undef W_WRITE
    const float il = 1.0f / ol[0];
    bf16_t* op = (bf16_t*)(p.ws + WS_ATT) + (size_t)tok * D + hq * 64;
#pragma unroll
    for (int t = 0; t < 2; ++t)
#pragma unroll
        for (int rr = 0; rr < 4; ++rr) {
            const int dv0 = 32 * t + 8 * rr + 4 * hi;
            u32x2 pk = {cvt_pk(o[t][4 * rr] * il, o[t][4 * rr + 1] * il), cvt_pk(o[t][4 * rr + 2] * il, o[t][4 * rr + 3] * il)};
            *(u32x2*)(op + dv0) = pk;
        }
}
__device__ __forceinline__ void phase_attn(const Params& p, char* lds, int vb, int G) {
    const int lane = threadIdx.x & 63;
    const float d1 = wave_sum(p.lq1[lane] * p.lk1[lane]), d2 = wave_sum(p.lq2[lane] * p.lk2[lane]);
    if (threadIdx.x == 0) *(float*)(lds + LDS_MISC) = expf(d1) - expf(d2) + 0.2f;
    __syncthreads();
    const float lam = 0.f;
    for (int u = vb; u < 1024; u += G) {
        if (u < 512) attn_diff_unit(p, lds, (u & 255) >> 6, (u < 256) ? 127 - (u & 63) : (u & 63), lam);
        else attn_swa_unit(p, lds, (u - 512) >> 8, (u - 512) & 255);
    }
}

struct EpiPreLn {
    const float* x; float* out; int row0, col0;
    __device__ __forceinline__ void operator()(f32x4 (&acc)[8][4], int wr, int wc, int fr, int fq) const {
        f32x4 xa[4], xb_[4];
        const size_t rbase = (size_t)(row0 + wr * 128 + fr) * D + col0 + wc * 64 + 4 * fq;
#pragma unroll
        for (int nt = 0; nt < 4; ++nt) xa[nt] = *(const f32x4*)(x + rbase + nt * 16);
#pragma unroll
        for (int mt = 0; mt < 8; ++mt) {
            const size_t ro = rbase + (size_t)mt * 16 * D;
            if (mt + 1 < 8) {
#pragma unroll
                for (int nt = 0; nt < 4; ++nt) { if (mt & 1) xa[nt] = *(const f32x4*)(x + ro + (size_t)16 * D + nt * 16); else xb_[nt] = *(const f32x4*)(x + ro + (size_t)16 * D + nt * 16); }
            }
#pragma unroll
            for (int nt = 0; nt < 4; ++nt) { const f32x4 xv = (mt & 1) ? xb_[nt] : xa[nt]; *(f32x4*)(out + ro + nt * 16) = xv * ALPHA + acc[mt][nt]; }
        }
    }
};
__device__ __forceinline__ void phase_wout(const Params& p, char* lds, int vb, int G) {
    for (int u = vb; u < (S / 256) * 4; u += G) {
        const int tm = u >> 2, tn = u & 3;
        G2Args g; g.A = (const char*)(p.ws + WS_ATT); g.B = (const char*)(p.ws + WS_WOUT); g.nk = D / 64; g.akstep = 128;
        g2_rows_A<8>(g, (size_t)tm * 256, D * 2); g2_rows_B(g, (size_t)tn * 256, D * 2);
        EpiPreLn e{p.x, (float*)(p.ws + WS_PRELN), tm * 256, tn * 256};
        gemm2<8>(lds, g, e);
    }
}

struct EpiLogits {
    float* L;
    __device__ __forceinline__ void operator()(f32x4 (&acc)[4][4], int wr, int wc, int fr, int fq) const {
#pragma unroll
        for (int mt = 0; mt < 4; ++mt)
#pragma unroll
            for (int nt = 0; nt < 4; ++nt) *(f32x4*)(L + (wr * 64 + mt * 16 + fr) * 256 + wc * 64 + nt * 16 + 4 * fq) = acc[mt][nt];
    }
};
__device__ __forceinline__ void phase_router(const Params& p, char* lds, int vb, int G) {
    const int tid = threadIdx.x, lane = tid & 63, w = tid >> 6;
    const float* preln = (const float*)(p.ws + WS_PRELN);
    bf16_t* x1b = (bf16_t*)(p.ws + WS_X1B);
    unsigned* cnt = (unsigned*)(p.ws + WS_CTL + 65536); int* list = (int*)(p.ws + WS_LIST); float* gates = (float*)(p.ws + WS_GATE);
    for (int u = vb; u < S / 64; u += G) {
        {
            f32x4 v[8][4]; float sm[8], sq[8];
#pragma unroll
            for (int i = 0; i < 8; ++i) { const f32x4* xr = (const f32x4*)(preln + (size_t)(u * 64 + w * 8 + i) * D) + lane;
#pragma unroll
                for (int j = 0; j < 4; ++j) v[i][j] = xr[64 * j]; }
#pragma unroll
            for (int i = 0; i < 8; ++i) { float s = 0.f;
#pragma unroll
                for (int j = 0; j < 4; ++j) s += (v[i][j][0] + v[i][j][1]) + (v[i][j][2] + v[i][j][3]);
                sm[i] = s; }
#pragma unroll
            for (int o = 1; o < 64; o <<= 1) {
#pragma unroll
                for (int i = 0; i < 8; ++i) sm[i] += __shfl_xor(sm[i], o); }
#pragma unroll
            for (int i = 0; i < 8; ++i) { const float mean = sm[i] * (1.0f / D); float s2 = 0.f;
#pragma unroll
                for (int j = 0; j < 4; ++j) { v[i][j] = v[i][j] - mean; s2 += (v[i][j][0] * v[i][j][0] + v[i][j][1] * v[i][j][1]) + (v[i][j][2] * v[i][j][2] + v[i][j][3] * v[i][j][3]); }
                sq[i] = s2; }
#pragma unroll
            for (int o = 1; o < 64; o <<= 1) {
#pragma unroll
                for (int i = 0; i < 8; ++i) sq[i] += __shfl_xor(sq[i], o); }
#pragma unroll
            for (int j = 0; j < 4; ++j) {
                const f32x4 gg = *((const f32x4*)p.ln1g + lane + 64 * j), bb = *((const f32x4*)p.ln1b + lane + 64 * j);
#pragma unroll
                for (int i = 0; i < 8; ++i) {
                    const int row = u * 64 + w * 8 + i;
                    const float rstd = rsqrtf(sq[i] * (1.0f / D) + LN_EPS);
                    const f32x4 y = v[i][j] * rstd * gg + bb;
                    u32x2 pk = {cvt_pk(y[0], y[1]), cvt_pk(y[2], y[3])};
                    *(u32x2*)(x1b + ((size_t)((lane >> 4) + 4 * j) * S + row) * 64 + ((4 * lane) & 63)) = pk;
                }
            }
        }
        asm volatile("s_waitcnt vmcnt(0)" ::: "memory");
        __syncthreads();
        { G2Args g; g.A = (const char*)x1b; g.B = (const char*)(p.ws + WS_WR); g.nk = D / 64; g.akstep = S * 128;
          g2_rows_A<4>(g, (size_t)u * 64, 128); g.offA[1] = g.offA[0]; g2_rows_B(g, 0, D * 2);
          EpiLogits e{(float*)lds};
          gemm2<4>(lds, g, e); }
        __syncthreads();
        const f32x4 rb = *((const f32x4*)p.r_bias + lane);
        const float NEG = -__builtin_inff();
        for (int i0 = 0; i0 < 8; i0 += 4) {
            float sc[4][4], cand[4][4]; int my_e[4]; float my_s[4], gsum[4];
#pragma unroll
            for (int q = 0; q < 4; ++q) {
                const int tl = w * 8 + i0 + q;
                const f32x4 lg = *((const f32x4*)((const float*)lds + tl * 256) + lane);
#pragma unroll
                for (int j = 0; j < 4; ++j) { sc[q][j] = 1.0f / (1.0f + __expf(-lg[j])); cand[q][j] = sc[q][j] + rb[j]; }
                my_e[q] = 0; my_s[q] = 0.f; gsum[q] = 0.f;
            }
            float a1[4], a2[4];
#pragma unroll
            for (int q = 0; q < 4; ++q) { const float m01 = fmaxf(cand[q][0], cand[q][1]), n01 = fminf(cand[q][0], cand[q][1]), m23 = fmaxf(cand[q][2], cand[q][3]), n23 = fminf(cand[q][2], cand[q][3]);
              a1[q] = fmaxf(m01, m23); a2[q] = fmaxf(fminf(m01, m23), fmaxf(n01, n23)); }
#pragma unroll
            for (int off = 1; off < 8; off <<= 1) {
#pragma unroll
                for (int q = 0; q < 4; ++q) { const float b1 = __shfl_xor(a1[q], off), b2 = __shfl_xor(a2[q], off); const float n1 = fmaxf(a1[q], b1), n2 = fmaxf(fminf(a1[q], b1), fmaxf(a2[q], b2)); a1[q] = n1; a2[q] = n2; }
            }
            const int mygrp = lane >> 3;
#pragma unroll
            for (int q = 0; q < 4; ++q) {
                const float gs = a1[q] + a2[q]; int rank = 0;
#pragma unroll
                for (int g2 = 0; g2 < 8; ++g2) { const float v = __shfl(gs, g2 * 8); rank += (v > gs || (v == gs && g2 < mygrp)) ? 1 : 0; }
                if (rank >= 4) {
#pragma unroll
                    for (int j = 0; j < 4; ++j) cand[q][j] = NEG;
                }
            }
#pragma unroll
            for (int k = 0; k < 8; ++k) {
                float bv[4]; int idx[4];
#pragma unroll
                for (int q = 0; q < 4; ++q) { bv[q] = cand[q][0]; int bi = 0;
#pragma unroll
                    for (int j = 1; j < 4; ++j) if (cand[q][j] > bv[q]) { bv[q] = cand[q][j]; bi = j; }
                    idx[q] = 4 * lane + bi; }
#pragma unroll
                for (int off = 32; off >= 1; off >>= 1) {
#pragma unroll
                    for (int q = 0; q < 4; ++q) { const float ov = __shfl_xor(bv[q], off); const int oi = __shfl_xor(idx[q], off); if (ov > bv[q] || (ov == bv[q] && oi < idx[q])) { bv[q] = ov; idx[q] = oi; } }
                }
#pragma unroll
                for (int q = 0; q < 4; ++q) {
                    const int owner = idx[q] >> 2, sub = idx[q] & 3;
                    float scv = sc[q][0];
#pragma unroll
                    for (int j = 1; j < 4; ++j) scv = (sub == j) ? sc[q][j] : scv;
                    if (lane == owner) {
#pragma unroll
                        for (int j = 0; j < 4; ++j) if (sub == j) cand[q][j] = NEG;
                    }
                    const float gsc = __shfl(scv, owner);
                    if (lane == k) { my_e[q] = idx[q]; my_s[q] = gsc; }
                    gsum[q] += gsc;
                }
            }
            if (lane < 8) {
#pragma unroll
                for (int q = 0; q < 4; ++q) {
                    const int t = u * 64 + w * 8 + i0 + q;
                    const float gate = my_s[q] / gsum[q] * 2.5f;
                    const unsigned pos = atomicAdd(cnt + my_e[q] * CNT_STRIDE, 1u);
                    list[(size_t)my_e[q] * CAP + pos] = t * 8 + lane;
                    gates[t * 8 + lane] = gate;
                }
            }
        }
        __syncthreads();
    }
}

#ifndef MOE_MT
#define MOE_MT 8
#endif
constexpr int MOE_BM = 32 * MOE_MT;
struct EpiAct {
    bf16_t* act; const int* slots;
    __device__ __forceinline__ void operator()(f32x4 (&acc)[MOE_MT][4], int pass, int wr, int wc, int fr, int fq) const {
        const int ncol0 = pass * 128;
#pragma unroll
        for (int mt = 0; mt < MOE_MT; ++mt) {
            const int ar = slots[wr * 16 * MOE_MT + mt * 16 + fr];
            if (ar >= 0) {
                float a[8];
#pragma unroll
                for (int nt = 0; nt < 2; ++nt)
#pragma unroll
                    for (int j = 0; j < 4; ++j) { const float gq = acc[mt][nt][j]; a[nt * 4 + j] = gq / (1.0f + __expf(-gq)) * (acc[mt][nt + 2][j]); }
                u32x4 pk = {cvt_pk(a[0], a[1]), cvt_pk(a[2], a[3]), cvt_pk(a[4], a[5]), cvt_pk(a[6], a[7])};
                *(u32x4*)(act + (size_t)ar * FF + ncol0 + wc * 32 + 8 * fq) = pk;
            }
        }
    }
};
struct EpiY {
    bf16_t* y; const int* yrows; const float* gl;
    __device__ __forceinline__ void operator()(f32x4 (&acc)[MOE_MT][4], int pass, int wr, int wc, int fr, int fq) const {
        const int col0 = pass * 256;
#pragma unroll
        for (int mt = 0; mt < MOE_MT; ++mt) {
            const int r = wr * 16 * MOE_MT + mt * 16 + fr, yr = yrows[r];
            if (yr >= 0) {
                const float gt = gl[r];
#pragma unroll
                for (int a = 0; a < 2; ++a) {
                    const f32x4 v0 = acc[mt][2 * a] * gt, v1 = acc[mt][2 * a + 1] * gt;
                    u32x4 pk = {cvt_pk(v0[0], v0[1]), cvt_pk(v0[2], v0[3]), cvt_pk(v1[0], v1[1]), cvt_pk(v1[2], v1[3])};
                    *(u32x4*)(y + (size_t)yr * D + col0 + wc * 64 + a * 32 + 8 * fq) = pk;
                }
            }
        }
    }
};
__device__ __forceinline__ void phase_experts(const Params& p, char* lds, int vb, int G) {
    const int tid0 = threadIdx.x, w = __builtin_amdgcn_readfirstlane(tid0 >> 6);
    const unsigned* cnt = (const unsigned*)(p.ws + WS_CTL + 65536); const int* list = (const int*)(p.ws + WS_LIST); const float* gates = (const float*)(p.ws + WS_GATE);
    bf16_t* act = (bf16_t*)(p.ws + WS_ACT); bf16_t* ybuf = (bf16_t*)(p.ws + WS_Y);
    int* nts = (int*)(lds + LDS_MISC); int* pre = nts + 256;
    int* s_arow = pre + 260; int* s_yrow = s_arow + MOE_BM; int* s_tok = s_yrow + MOE_BM; float* s_gate = (float*)(s_tok + MOE_BM);
    if (tid0 < 256) nts[tid0] = (int)((__hip_atomic_load(cnt + tid0 * CNT_STRIDE, __ATOMIC_RELAXED, __HIP_MEMORY_SCOPE_AGENT) + (MOE_BM - 1)) / MOE_BM);
    __syncthreads();
    if (tid0 < 257) { int s = 0; for (int e = 0; e < tid0; ++e) s += nts[e]; pre[tid0] = s; }
    __syncthreads();
    const int NR = __builtin_amdgcn_readfirstlane(pre[256]), NU = NR + S / MOE_BM;
    for (int u = vb; u < NU; u += G) {
        __syncthreads();
        int tid = threadIdx.x; asm volatile("" : "+v"(tid));
        const int lane = tid & 63; const unsigned co = g2_chunk_off(lane, w);
        const float *bg, *bu, *bd;
        if (u < NR) {
            int lo = 0, hi = 255;
            while (lo < hi) { const int mid = (lo + hi + 1) >> 1; if (pre[mid] <= u) lo = mid; else hi = mid - 1; }
            const int e = lo, tile = u - pre[e], n = (int)__hip_atomic_load(cnt + e * CNT_STRIDE, __ATOMIC_RELAXED, __HIP_MEMORY_SCOPE_AGENT);
            if (tid < MOE_BM) {
                const int idx = tile * MOE_BM + tid;
                if (idx < n) { const int slot = list[(size_t)e * CAP + idx]; s_arow[tid] = slot; s_yrow[tid] = slot + (slot >> 3); s_tok[tid] = slot >> 3; s_gate[tid] = gates[slot]; }
                else { s_arow[tid] = -1; s_yrow[tid] = -1; s_tok[tid] = 0; s_gate[tid] = 0.f; }
            }
            bg = p.w_g + (size_t)e * D * FF; bu = p.w_u + (size_t)e * D * FF; bd = p.w_d + (size_t)e * FF * D;
        } else {
            const int tile = u - NR;
            if (tid < MOE_BM) { const int tk = tile * MOE_BM + tid; s_arow[tid] = S * 8 + tk; s_yrow[tid] = tk * 9 + 8; s_tok[tid] = tk; s_gate[tid] = 1.0f; }
            bg = p.ws_g; bu = p.ws_u; bd = p.ws_d;
        }
        __syncthreads();
        { G3fArgs g; g.A = (const char*)(p.ws + WS_X1B); g.nk = D / 64; g.akstep = S * 128;
#pragma unroll
          for (int i = 0; i < MOE_MT / 2; ++i) g.offA[i] = (unsigned)s_tok[i * 64 + w * 8 + (lane >> 3)] * 128u + co;
          { const int bwc = lane >> 4, nt = (lane >> 2) & 3, bfq = lane & 3;
            g.b = ((nt < 2) ? bg : bu) + bwc * 32 + 8 * bfq + 4 * (nt & 1) + (size_t)(w * 8) * FF; }
          EpiAct e{act, s_arow};
          gemm3f<MOE_MT, FF>(lds, g, 2, 128, e); }
        asm volatile("s_waitcnt vmcnt(0)" ::: "memory");
        __syncthreads();
        { G3fArgs g; g.A = (const char*)act; g.nk = FF / 64; g.akstep = 128;
#pragma unroll
          for (int i = 0; i < MOE_MT / 2; ++i) { const int ar = s_arow[i * 64 + w * 8 + (lane >> 3)]; g.offA[i] = (unsigned)(ar < 0 ? 0 : ar) * (unsigned)(FF * 2) + co; }
          g.b = bd + (size_t)(w * 8) * D + (lane >> 4) * 64 + (((lane >> 2) & 3) >> 1) * 32 + 8 * (lane & 3) + 4 * ((lane >> 2) & 1);
          EpiY e{ybuf, s_yrow, s_gate};
          gemm3f<MOE_MT, D>(lds, g, 4, 256, e); }
    }
}

__device__ __forceinline__ void phase_final(const Params& p, int vb, int G) {
    const int lane = threadIdx.x & 63, w = threadIdx.x >> 6;
    const bf16_t* x1b = (const bf16_t*)(p.ws + WS_X1B); const bf16_t* ybuf = (const bf16_t*)(p.ws + WS_Y);
    constexpr int NR = 2;
    for (int row0 = (vb * 8 + w) * NR; row0 < S; row0 += G * 8 * NR) {
        float v[NR][2][8]; float sm[NR], sq[NR];
#pragma unroll
        for (int i = 0; i < NR; ++i) {
            const int row = row0 + i;
#pragma unroll
            for (int j = 0; j < 2; ++j) { const u32x4 q = *(const u32x4*)(x1b + ((size_t)((lane >> 3) + 8 * j) * S + row) * 64 + ((8 * lane) & 63));
#pragma unroll
                for (int e = 0; e < 4; ++e) { v[i][j][2 * e] = bf_lo(q[e]) * ALPHA; v[i][j][2 * e + 1] = bf_hi(q[e]) * ALPHA; } }
#pragma unroll
            for (int k = 0; k < 9; ++k) {
                const u32x4* yr = (const u32x4*)(ybuf + (size_t)(row * 9 + k) * D) + lane;
#pragma unroll
                for (int j = 0; j < 2; ++j) { const u32x4 q = yr[64 * j];
#pragma unroll
                    for (int e = 0; e < 4; ++e) { v[i][j][2 * e] += bf_lo(q[e]); v[i][j][2 * e + 1] += bf_hi(q[e]); } }
            }
        }
#pragma unroll
        for (int i = 0; i < NR; ++i) { float s = 0.f;
#pragma unroll
            for (int j = 0; j < 2; ++j)
#pragma unroll
                for (int e = 0; e < 8; ++e) s += v[i][j][e];
            sm[i] = s; }
#pragma unroll
        for (int o = 1; o < 64; o <<= 1) {
#pragma unroll
            for (int i = 0; i < NR; ++i) sm[i] += __shfl_xor(sm[i], o); }
#pragma unroll
        for (int i = 0; i < NR; ++i) { const float mean = sm[i] * (1.0f / D); float s2 = 0.f;
#pragma unroll
            for (int j = 0; j < 2; ++j)
#pragma unroll
                for (int e = 0; e < 8; ++e) { v[i][j][e] -= mean; s2 += v[i][j][e] * v[i][j][e]; }
            sq[i] = s2; }
#pragma unroll
        for (int o = 1; o < 64; o <<= 1) {
#pragma unroll
            for (int i = 0; i < NR; ++i) sq[i] += __shfl_xor(sq[i], o); }
#pragma unroll
        for (int j = 0; j < 2; ++j) {
            const f32x4 g0 = *((const f32x4*)p.ln2g + 2 * lane + 128 * j), g1 = *((const f32x4*)p.ln2g + 2 * lane + 128 * j + 1);
            const f32x4 b0 = *((const f32x4*)p.ln2b + 2 * lane + 128 * j), b1 = *((const f32x4*)p.ln2b + 2 * lane + 128 * j + 1);
#pragma unroll
            for (int i = 0; i < NR; ++i) { const float rstd = rsqrtf(sq[i] * (1.0f / D) + LN_EPS);
                f32x4* op = (f32x4*)(p.out + (size_t)(row0 + i) * D) + 2 * lane + 128 * j;
                op[0] = (f32x4){v[i][j][0], v[i][j][1], v[i][j][2], v[i][j][3]} * rstd * g0 + b0;
                op[1] = (f32x4){v[i][j][4], v[i][j][5], v[i][j][6], v[i][j][7]} * rstd * g1 + b1; }
        }
    }
}

__global__ void __launch_bounds__(NTHREADS) mega(Params p) {
    extern __shared__ __attribute__((aligned(16))) char lds[];
    const int G = gridDim.x, bx = blockIdx.x;
    const int vb = (G % 8 == 0) ? (bx % 8) * (G / 8) + bx / 8 : bx;
    if (threadIdx.x < 4) ((volatile LAS unsigned*)((LAS char*)lds + LDS_BARST))[threadIdx.x] = 0u;
    __syncthreads();
    XcdBarrier bar; bar.bar = (unsigned*)(p.ws + WS_CTL) + CW_BAR; bar.x = 0; bar.st = nullptr;
    if (p.ph_hi - p.ph_lo > 1) bar = xcd_barrier_post((unsigned*)(p.ws + WS_CTL) + CW_BAR, (volatile LAS unsigned*)((LAS char*)lds + LDS_BARST));
#define SEAM(k) do { if (p.ph_lo <= (k) && (k) + 1 < p.ph_hi) { xcd_barrier(bar); } } while (0)
#define IN(k) (p.ph_lo <= (k) && (k) < p.ph_hi)
#define RUN(k, call) do { if (IN(k)) { call; if (MK_REPEAT == (k)) { __syncthreads(); call; } } } while (0)
    RUN(0, phase_prep(p, vb, G)); SEAM(0);
    RUN(1, phase_proj(p, lds, vb, G)); SEAM(1);
    RUN(2, phase_attn(p, lds, vb, G)); SEAM(2);
    RUN(3, phase_wout(p, lds, vb, G)); SEAM(3);
    if (IN(4)) { phase_router(p, lds, vb, G); } SEAM(4);
    RUN(5, phase_experts(p, lds, vb, G)); SEAM(5);
    RUN(6, phase_final(p, vb, G));
#undef SEAM
#undef IN
#undef RUN
}

extern "C" void kernel_launch(void* const* d_in, const int* in_sizes, int n_in, void* d_out, int out_size, void* d_ws, size_t ws_size, hipStream_t stream) {
    static int grid = 0;
    if (grid == 0) {
        if (n_in != 22 || in_sizes[0] != S * D || out_size != S * D || ws_size < WS_END) {
            fprintf(stderr, "kernel_launch: unexpected shapes: n_in %d in0 %d out %d ws %zu (need %zu)\n", n_in, n_in > 0 ? in_sizes[0] : -1, out_size, ws_size, (size_t)WS_END); grid = -1; return; }
        int dev = 0, cus = 0, per_cu = 0;
        (void)hipGetDevice(&dev); (void)hipDeviceGetAttribute(&cus, hipDeviceAttributeMultiprocessorCount, dev);
        if (hipFuncSetAttribute((const void*)mega, hipFuncAttributeMaxDynamicSharedMemorySize, LDS_BYTES) != hipSuccess) { fprintf(stderr, "kernel_launch: hipFuncSetAttribute failed\n"); grid = -1; return; }
        (void)hipOccupancyMaxActiveBlocksPerMultiprocessor(&per_cu, (const void*)mega, NTHREADS, LDS_BYTES);
        if (per_cu < 1) { fprintf(stderr, "kernel_launch: occupancy query says %d blocks per CU\n", per_cu); per_cu = 1; }
        grid = cus * 1;
        (void)hipGetLastError();
    }
    if (grid < 0) return;
    (void)hipMemsetAsync((char*)d_ws + WS_CTL, 0, CTL_BYTES, stream);
    Params p{};
    const float** f = (const float**)&p;
    for (int i = 0; i < 22; ++i) f[i] = (const float*)d_in[i];
    p.out = (float*)d_out; p.ws = (unsigned char*)d_ws;
#if MK_ONE_LAUNCH
    p.ph_lo = 0; p.ph_hi = 7;
    void* args[] = {&p};
    hipError_t e = hipLaunchCooperativeKernel((const void*)mega, dim3(grid), dim3(NTHREADS), args, LDS_BYTES, stream);
    if (e != hipSuccess) fprintf(stderr, "kernel_launch: cooperative launch failed: %s (grid %d)\n", hipGetErrorString(e), grid);
#else
    for (int ph = 0; ph < 7; ++ph) {
        p.ph_lo = ph; p.ph_hi = ph + 1;
        hipLaunchKernelGGL(mega, dim3(grid), dim3(NTHREADS), LDS_BYTES, stream, p);
    }
#endif
}
```

```cpp
#include <hip/hip_runtime.h>
#include <hip/hip_cooperative_groups.h>
#include <cstdio>
#include <cstdint>
namespace cg = cooperative_groups;

#ifndef MK_REPEAT
#define MK_REPEAT -1
#endif
#ifndef MK_ONE_LAUNCH
#define MK_ONE_LAUNCH 1
#endif

constexpr int S = 16384, D = 1024, INW = 2304, NE = 256, FF = 256;
constexpr int NTHREADS = 512;
constexpr int CAP = 16384;
constexpr float ALPHA = 1.189207115002721f;
constexpr float LN_EPS = 1e-5f;
constexpr float QSCALE = 0.125f * 1.4426950408889634f;
constexpr float LOG2E = 1.4426950408889634f;
constexpr int C_AQ = 0, C_AK = 512, C_AV = 640, C_BQ = 768, C_BK = 1280, C_BV = 1792;

constexpr size_t MiB = 1ull << 20;
constexpr size_t WS_CTL = 0;
constexpr size_t CTL_BYTES = 128 * 1024;
constexpr int CNT_STRIDE = 64;
constexpr size_t WS_ROPE = 1 * MiB;
constexpr size_t WS_WIN = 8 * MiB;
constexpr size_t WS_WOUT = 13 * MiB;
constexpr size_t WS_WR = 15 * MiB;
constexpr size_t WS_WSGU = 16 * MiB;
constexpr size_t WS_WSD = 17 * MiB;
constexpr size_t WS_EGU = 20 * MiB;
constexpr size_t WS_ED = 276 * MiB;
constexpr size_t WS_X1F = 404 * MiB;
constexpr size_t WS_X1B = 468 * MiB;
constexpr size_t WS_LIST = 500 * MiB;
constexpr size_t WS_GATE = 516 * MiB;
constexpr size_t WS_ACT = 518 * MiB;
constexpr size_t WS_Y = 590 * MiB;
constexpr size_t WS_XB = 590 * MiB;
constexpr size_t WS_PROJ = 622 * MiB;
constexpr size_t WS_ATT = 694 * MiB;
constexpr size_t WS_PRELN = 726 * MiB;
constexpr size_t WS_END = 878 * MiB;

constexpr int LDS_BYTES = 147456;
constexpr int LDS_MISC = 131072;

typedef unsigned short bf16_t;
typedef short bf16x8 __attribute__((ext_vector_type(8)));
typedef short s16x4 __attribute__((ext_vector_type(4)));
typedef float f32x4 __attribute__((ext_vector_type(4)));
typedef float f32x16 __attribute__((ext_vector_type(16)));
typedef unsigned u32x4 __attribute__((ext_vector_type(4)));
typedef unsigned u32x2 __attribute__((ext_vector_type(2)));
typedef float f32x2 __attribute__((ext_vector_type(2)));


#define LAS __attribute__((address_space(3)))
#define XB_TMO      128
#define XB_XCNT(j)  (256  + 64 * (j))
#define XB_XSUB(j)  (1280 + 64 * (j))
#define XB_XGEN(j)  (2304 + 64 * (j))
#define XB_TOP      3328
#define XB_TOPGEN   3392
#define XCD_BAR_WORDS 3456
#define XB_SPIN_CAP (1u << 18)
__device__ __forceinline__ unsigned xb_ld(unsigned* p)              { return __hip_atomic_load(p, __ATOMIC_RELAXED, __HIP_MEMORY_SCOPE_AGENT); }
__device__ __forceinline__ unsigned xb_add(unsigned* p, unsigned v) { return __hip_atomic_fetch_add(p, v, __ATOMIC_RELAXED, __HIP_MEMORY_SCOPE_AGENT); }
__device__ __forceinline__ unsigned xb_xcc_id() { return (unsigned)__builtin_amdgcn_s_getreg((3 << 11) | 20) & 0xFu; }
#define XB_SPIN(cond, bar) do { unsigned _sp = 0; while (cond) { __builtin_amdgcn_s_sleep(1); \
    if ((++_sp & 255u) == 0u) { if (xb_ld(&(bar)[XB_TMO])) break; if (_sp > XB_SPIN_CAP) { atomicAdd(&(bar)[XB_TMO], 1u); break; } } } } while (0)
struct XcdBarrier { unsigned* bar; unsigned x; volatile LAS unsigned* st; };
__device__ __forceinline__ XcdBarrier xcd_barrier_post(unsigned* bar, volatile LAS unsigned* st) {
    XcdBarrier b; b.bar = bar; b.x = xb_xcc_id(); b.st = st;
    if (threadIdx.x == 0) (void)xb_add(&bar[XB_XCNT(b.x)], 1u);
    return b;
}
__device__ __forceinline__ void xcd_barrier_complete(unsigned* bar, unsigned x, unsigned& nloc, unsigned& nx) {
    const unsigned G = gridDim.x * gridDim.y * gridDim.z;
    unsigned sum, cnt, mine, sp = 0u;
    for (;;) {
        sum = 0u; cnt = 0u; mine = 0u;
#pragma unroll
        for (unsigned j = 0; j < 16; ++j) { const unsigned c = xb_ld(&bar[XB_XCNT(j)]); sum += c; cnt += (c > 0u) ? 1u : 0u; mine = (j == x) ? c : mine; }
        if (sum == G) break;
        __builtin_amdgcn_s_sleep(1);
        if ((++sp & 255u) == 0u) { if (xb_ld(&bar[XB_TMO])) break; if (sp > XB_SPIN_CAP) { atomicAdd(&bar[XB_TMO], 1u); break; } }
    }
    nloc = mine > 0u ? mine : 1u; nx = cnt > 0u ? cnt : 1u;
}
__device__ __forceinline__ void xcd_barrier(const XcdBarrier& b) {
    asm volatile("s_waitcnt vmcnt(0)" ::: "memory");
    __syncthreads();
    if (threadIdx.x == 0) {
        unsigned* bar = b.bar;
        __builtin_amdgcn_s_waitcnt(0);
        unsigned nloc = b.st[0], nx = b.st[1];
        if (nloc == 0u) { xcd_barrier_complete(bar, b.x, nloc, nx); b.st[0] = nloc; b.st[1] = nx; }
        const unsigned old = xb_add(&bar[XB_XSUB(b.x)], 1u);
        const unsigned gen = old / nloc;
        if (old + 1u == (gen + 1u) * nloc) {
            __builtin_amdgcn_fence(__ATOMIC_RELEASE, "agent");
            asm volatile("s_waitcnt vmcnt(0)" ::: "memory");
            const unsigned og = xb_add(&bar[XB_TOP], 1u);
            const unsigned tg = og / nx;
            if (og + 1u == (tg + 1u) * nx) xb_add(&bar[XB_TOPGEN], 1u);
            else XB_SPIN(xb_ld(&bar[XB_TOPGEN]) == tg, bar);
            __builtin_amdgcn_fence(__ATOMIC_ACQUIRE, "agent");
            xb_add(&bar[XB_XGEN(b.x)], 1u);
            asm volatile("s_waitcnt vmcnt(0)" ::: "memory");
        } else {
            XB_SPIN(xb_ld(&bar[XB_XGEN(b.x)]) == gen, bar);
            __builtin_amdgcn_fence(__ATOMIC_ACQUIRE, "agent");
            asm volatile("s_waitcnt vmcnt(0)" ::: "memory");
        }
    }
    __syncthreads();
}
constexpr int CW_BAR = 4096;
constexpr int LDS_BARST = LDS_MISC + 8192;

struct Params {
    const float* x; const float* w_in; const float* b_in; const float* sinks;
    const float* lq1; const float* lk1; const float* lq2; const float* lk2; const float* subg;
    const float* w_out; const float* ln1g; const float* ln1b; const float* w_r; const float* r_bias;
    const float* w_g; const float* w_u; const float* w_d; const float* ws_g; const float* ws_u; const float* ws_d;
    const float* ln2g; const float* ln2b;
    float* out; unsigned char* ws;
    int ph_lo, ph_hi;
};

__device__ __forceinline__ unsigned cvt_pk(float lo, float hi) { unsigned r; asm volatile("v_cvt_pk_bf16_f32 %0, %1, %2" : "=v"(r) : "v"(lo), "v"(hi)); return r; }
__device__ __forceinline__ float bf_lo(unsigned u) { return __uint_as_float(u << 16); }
__device__ __forceinline__ float bf_hi(unsigned u) { return __uint_as_float(u & 0xffff0000u); }
__device__ __forceinline__ float wave_sum(float v) {
#pragma unroll
    for (int o = 1; o < 64; o <<= 1) v += __shfl_xor(v, o);
    return v;
}
__device__ __forceinline__ float half_max(float v) { auto rr = __builtin_amdgcn_permlane32_swap(__float_as_uint(v), __float_as_uint(v), false, false); return fmaxf(__uint_as_float(rr[0]), __uint_as_float(rr[1])); }
__device__ __forceinline__ float half_sum(float v) { auto rr = __builtin_amdgcn_permlane32_swap(__float_as_uint(v), __float_as_uint(v), false, false); return __uint_as_float(rr[0]) + __uint_as_float(rr[1]); }

__device__ __forceinline__ int swz(int r, int c) { const int f = (r & 7) ^ (((r >> 3) & 1) << 1) ^ ((r >> 4) & 1); return r * 128 + ((c ^ f) << 4); }

struct G2Args {
    const char* A; const char* B;
    unsigned offA[4], offB[4];
    int nk;
    unsigned akstep;
};
__device__ __forceinline__ unsigned g2_chunk_off(int lane, int w) { const int f = (lane >> 3) ^ ((w & 1) << 1) ^ ((w >> 1) & 1); return (unsigned)(((lane & 7) ^ f) << 4); }
template <int MT, int NT, class Epi>
__device__ __forceinline__ void gemm2n(char* lds_, const G2Args& g, const Epi& epi) {
    constexpr int A_BYTES = 32 * MT * 128, B_BYTES = 64 * NT * 128, STAGE = A_BYTES + B_BYTES, AR = MT / 2, BRR = NT;
    LAS char* lds = (LAS char*)lds_;
    const int tid = threadIdx.x, lane = tid & 63, w = __builtin_amdgcn_readfirstlane(tid >> 6), wr = w >> 2, wc = w & 3, fr = lane & 15, fq = lane >> 4;
    f32x4 acc[MT][NT];
#pragma unroll
    for (int i = 0; i < MT; ++i)
#pragma unroll
        for (int j = 0; j < NT; ++j) acc[i][j] = (f32x4){0.f, 0.f, 0.f, 0.f};
    const int ldsw = w * 1024;
#define G2_STAGE(kt, s) do { \
        _Pragma("unroll") for (int i = 0; i < AR; ++i) __builtin_amdgcn_global_load_lds((const unsigned*)(g.A + g.offA[i] + (size_t)(kt) * g.akstep), (LAS unsigned*)(lds + (s) * STAGE + i * 8192 + ldsw), 16, 0, 0); \
        _Pragma("unroll") for (int i = 0; i < BRR; ++i) __builtin_amdgcn_global_load_lds((const unsigned*)(g.B + g.offB[i] + (size_t)(kt) * 128), (LAS unsigned*)(lds + (s) * STAGE + A_BYTES + i * 8192 + ldsw), 16, 0, 0); } while (0)
    G2_STAGE(0, 0);
    __syncthreads();
    for (int kt = 0; kt < g.nk; ++kt) {
        const int s = kt & 1;
        if (kt + 1 < g.nk) { if (s) G2_STAGE(kt + 1, 0); else G2_STAGE(kt + 1, 1); }
        const char* la = lds_ + s * STAGE; const char* lb = la + A_BYTES;
        {
            constexpr int NG = 2 * (MT / 4);
            bf16x8 bfr[NT], af[2][4];
#pragma unroll
            for (int nt = 0; nt < NT; ++nt) bfr[nt] = *(const bf16x8*)(lb + swz(wc * 16 * NT + nt * 16 + fr, fq));
#pragma unroll
            for (int m = 0; m < 4; ++m) af[0][m] = *(const bf16x8*)(la + swz(wr * 16 * MT + m * 16 + fr, fq));
#pragma unroll
            for (int gi = 0; gi < NG; ++gi) {
                const int ks = gi / (MT / 4), h = gi % (MT / 4);
                if (gi > 0 && h == 0) {
#pragma unroll
                    for (int nt = 0; nt < NT; ++nt) bfr[nt] = *(const bf16x8*)(lb + swz(wc * 16 * NT + nt * 16 + fr, ks * 4 + fq));
                }
                if (gi + 1 < NG) {
                    const int ks2 = (gi + 1) / (MT / 4), h2 = (gi + 1) % (MT / 4);
#pragma unroll
                    for (int m = 0; m < 4; ++m) af[(gi + 1) & 1][m] = *(const bf16x8*)(la + swz(wr * 16 * MT + (h2 * 4 + m) * 16 + fr, ks2 * 4 + fq));
                }
                __builtin_amdgcn_sched_barrier(0);
#pragma unroll
                for (int m = 0; m < 4; ++m)
#pragma unroll
                    for (int nt = 0; nt < NT; ++nt) acc[h * 4 + m][nt] = __builtin_amdgcn_mfma_f32_16x16x32_bf16(bfr[nt], af[gi & 1][m], acc[h * 4 + m][nt], 0, 0, 0);
                __builtin_amdgcn_sched_barrier(0);
            }
        }
        __syncthreads();
    }
#undef G2_STAGE
    epi(acc, wr, wc, fr, fq);
}
template <int MT, class Epi>
__device__ __forceinline__ void gemm2(char* lds_, const G2Args& g, const Epi& epi) { gemm2n<MT, 4>(lds_, g, epi); }
template <int MT>
__device__ __forceinline__ void g2_rows_A(G2Args& g, size_t row0, unsigned ld_bytes) {
    const int lane = threadIdx.x & 63, w = __builtin_amdgcn_readfirstlane(threadIdx.x >> 6); const unsigned co = g2_chunk_off(lane, w);
#pragma unroll
    for (int i = 0; i < MT / 2; ++i) g.offA[i] = (unsigned)((row0 + i * 64 + w * 8 + (lane >> 3)) * ld_bytes) + co;
}
__device__ __forceinline__ void g2_rows_B(G2Args& g, size_t row0, unsigned ld_bytes) {
    const int lane = threadIdx.x & 63, w = __builtin_amdgcn_readfirstlane(threadIdx.x >> 6); const unsigned co = g2_chunk_off(lane, w);
#pragma unroll
    for (int i = 0; i < 4; ++i) g.offB[i] = (unsigned)((row0 + i * 64 + w * 8 + (lane >> 3)) * ld_bytes) + co;
}


struct G3fArgs { const char* A; unsigned offA[4]; const float* b; int nk; unsigned akstep; };
template <int MT, int LDB, class Epi>
__device__ __forceinline__ void gemm3f(char* lds_, const G3fArgs& g, int npass, int bpstep, const Epi& epi) {
    constexpr int A_BYTES = 32 * MT * 128, B_BYTES = 256 * 128, STAGE = A_BYTES + B_BYTES, AR = MT / 2;
    LAS char* lds = (LAS char*)lds_;
    const int tid = threadIdx.x, lane = tid & 63, w = __builtin_amdgcn_readfirstlane(tid >> 6), wr = w >> 2, wc = w & 3, fr = lane & 15, fq = lane >> 4;
    f32x4 acc[MT][4];
#pragma unroll
    for (int i = 0; i < MT; ++i)
#pragma unroll
        for (int j = 0; j < 4; ++j) acc[i][j] = (f32x4){0.f, 0.f, 0.f, 0.f};
    const int ldsw = w * 1024;
    int bw[4];
#pragma unroll
    for (int j = 0; j < 4; ++j) bw[j] = swz(4 * lane + j, w);
    f32x4 br[8];
    const int nk = g.nk, nsteps = nk * npass;
#define G3_STAGE_A(kt, s) do { \
        _Pragma("unroll") for (int i = 0; i < AR; ++i) __builtin_amdgcn_global_load_lds((const unsigned*)(g.A + g.offA[i] + (size_t)(kt) * g.akstep), (LAS unsigned*)(lds + (s) * STAGE + i * 8192 + ldsw), 16, 0, 0); } while (0)
#define G3_LOAD_B(ps, kt) do { const float* pb_ = g.b + (size_t)(ps) * bpstep + (size_t)(kt) * 64 * LDB; _Pragma("unroll") for (int i = 0; i < 8; ++i) br[i] = *(const f32x4*)(pb_ + i * LDB); } while (0)
#define G3_WRITE_B(s) do { _Pragma("unroll") for (int j = 0; j < 4; ++j) { \
            u32x4 v = {cvt_pk(br[0][j], br[1][j]), cvt_pk(br[2][j], br[3][j]), cvt_pk(br[4][j], br[5][j]), cvt_pk(br[6][j], br[7][j])}; \
            *(u32x4*)(lds_ + (s) * STAGE + A_BYTES + bw[j]) = v; } } while (0)
    G3_STAGE_A(0, 0); G3_LOAD_B(0, 0); G3_WRITE_B(0);
    __syncthreads();
    int ps = 0, kt = 0;
    for (int st = 0; st < nsteps; ++st) {
        const int s = st & 1; const bool more = st + 1 < nsteps;
        int ps2 = ps, kt2 = kt + 1; if (kt2 == nk) { kt2 = 0; ++ps2; }
        if (more) { if (s) G3_STAGE_A(kt2, 0); else G3_STAGE_A(kt2, 1); G3_LOAD_B(ps2, kt2); }
        __builtin_amdgcn_sched_barrier(0);
        const char* la = lds_ + s * STAGE; const char* lb = la + A_BYTES;
#pragma unroll
        for (int ks = 0; ks < 2; ++ks) {
            bf16x8 bfr[4];
#pragma unroll
            for (int nt = 0; nt < 4; ++nt) bfr[nt] = *(const bf16x8*)(lb + swz(wc * 64 + nt * 16 + fr, ks * 4 + fq));
#pragma unroll
            for (int h = 0; h < MT / 2; ++h) {
                bf16x8 af[2];
#pragma unroll
                for (int m = 0; m < 2; ++m) af[m] = *(const bf16x8*)(la + swz(wr * 16 * MT + (h * 2 + m) * 16 + fr, ks * 4 + fq));
                __builtin_amdgcn_sched_barrier(0);
#pragma unroll
                for (int m = 0; m < 2; ++m)
#pragma unroll
                    for (int nt = 0; nt < 4; ++nt) acc[h * 2 + m][nt] = __builtin_amdgcn_mfma_f32_16x16x32_bf16(bfr[nt], af[m], acc[h * 2 + m][nt], 0, 0, 0);
                __builtin_amdgcn_sched_barrier(0);
            }
        }
        if (kt == nk - 1) {
            epi(acc, ps, wr, wc, fr, fq);
#pragma unroll
            for (int i = 0; i < MT; ++i)
#pragma unroll
                for (int j = 0; j < 4; ++j) acc[i][j] = (f32x4){0.f, 0.f, 0.f, 0.f};
        }
        if (more) { if (s) G3_WRITE_B(0); else G3_WRITE_B(1); }
        __syncthreads();
        ps = ps2; kt = kt2;
    }
#undef G3_STAGE_A
#undef G3_LOAD_B
#undef G3_WRITE_B
}

__device__ __forceinline__ void cvt_item(const float* W, int K, int N, bf16_t* WT, int ldt, int kb, int nb, int kc, int lane) {
    const float* src = W + (size_t)(kb * 64 + kc * 8) * N + nb * 256 + 4 * lane;
    bf16_t* dst = WT + (size_t)(nb * 256 + 4 * lane) * ldt + kb * 64 + kc * 8;
    f32x4 r[8];
#pragma unroll
    for (int i = 0; i < 8; ++i) r[i] = *(const f32x4*)(src + (size_t)i * N);
#pragma unroll
    for (int j = 0; j < 4; ++j) {
        u32x4 v = {cvt_pk(r[0][j], r[1][j]), cvt_pk(r[2][j], r[3][j]), cvt_pk(r[4][j], r[5][j]), cvt_pk(r[6][j], r[7][j])};
        *(u32x4*)(dst + (size_t)j * ldt) = v;
    }
}
__device__ __forceinline__ void phase_prep(const Params& p, int vb, int G) {
    const int tid = threadIdx.x, lane = tid & 63, w = tid >> 6;
    float* cs = (float*)(p.ws + WS_ROPE); float* sn = cs + (size_t)S * 32;
    for (int idx = vb * NTHREADS + tid; idx < S * 32; idx += G * NTHREADS) {
        const int pos = idx >> 5, i = idx & 31;
        const float pw = (float)pow(10000.0, (double)i / 32.0);
        const float inv = 1.0f / pw;
        const float angf = __fmul_rn((float)pos, inv);
        const double a = (double)angf;
        const double q = rint(a * 0.63661977236758134308);
        double r = fma(-q, 1.57079632679489655800, a); r = fma(-q, 6.12323399573676603587e-17, r);
        const double r2 = r * r;
        double sp = r * (1.0 + r2 * (-1.0 / 6 + r2 * (1.0 / 120 + r2 * (-1.0 / 5040 + r2 * (1.0 / 362880 + r2 * (-1.0 / 39916800))))));
        double cp = 1.0 + r2 * (-0.5 + r2 * (1.0 / 24 + r2 * (-1.0 / 720 + r2 * (1.0 / 40320 + r2 * (-1.0 / 3628800 + r2 * (1.0 / 479001600))))));
        const int qi = ((int)((long long)q)) & 3;
        double sv, cv;
        if (qi == 0) { sv = sp; cv = cp; } else if (qi == 1) { sv = cp; cv = -sp; } else if (qi == 2) { sv = -sp; cv = -cp; } else { sv = -cp; cv = sp; }
        cs[idx] = (float)cv; sn[idx] = (float)sv;
    }
    { const f32x4* xs = (const f32x4*)p.x; u32x4* xd = (u32x4*)(p.ws + WS_XB);
      for (size_t i = (size_t)vb * NTHREADS + tid; i < (size_t)S * D / 8; i += (size_t)G * NTHREADS) {
          const f32x4 a = xs[2 * i], b = xs[2 * i + 1];
          xd[i] = (u32x4){cvt_pk(a[0], a[1]), cvt_pk(a[2], a[3]), cvt_pk(b[0], b[1]), cvt_pk(b[2], b[3])}; } }
    const int gw = vb * 8 + w, NGW = G * 8;
    constexpr int I_IN = 16 * 9, I_OUT = 16 * 4, I_R = 16, I_SG = 16, I_SU = 16, I_SD = 4 * 4, I_SMALL = I_IN + I_OUT + I_R;
    for (int it8 = gw; it8 < I_SMALL * 8; it8 += NGW) {
        int r = it8 >> 3; const int kc = it8 & 7;
        if (r < I_IN) { cvt_item(p.w_in, D, INW, (bf16_t*)(p.ws + WS_WIN), D, r / 9, r % 9, kc, lane); continue; } r -= I_IN;
        if (r < I_OUT) { cvt_item(p.w_out, D, D, (bf16_t*)(p.ws + WS_WOUT), D, r >> 2, r & 3, kc, lane); continue; } r -= I_OUT;
        cvt_item(p.w_r, D, NE, (bf16_t*)(p.ws + WS_WR), D, r, 0, kc, lane);
    }
}

template <int MT> struct EpiProj {
    const float* bias; const float* cs; const float* sn; bf16_t* out; int row0, col0; char* lds;
    __device__ __forceinline__ void operator()(f32x4 (&acc)[MT][4], int wr, int wc, int fr, int fq) const {
        const int hb = col0 + wc * 64;
        const bool is_q = (hb < C_AK) || (hb >= C_BQ && hb < C_BK);
        const bool is_rope = is_q || (hb >= C_AK && hb < C_AV) || (hb >= C_BK && hb < C_BV);
        const float sc = is_q ? QSCALE : 1.0f;
        const int tid = threadIdx.x, w = __builtin_amdgcn_readfirstlane(tid >> 6), lane = tid & 63;
        constexpr int TB = 32 * MT * 128;
        LAS char* l3 = (LAS char*)lds;
#pragma unroll
        for (int i = 0; i < TB / 8192; ++i) {
            __builtin_amdgcn_global_load_lds((const unsigned*)((const char*)(cs + (size_t)row0 * 32) + i * 8192 + w * 1024 + lane * 16), (LAS unsigned*)(l3 + i * 8192 + w * 1024), 16, 0, 0);
            __builtin_amdgcn_global_load_lds((const unsigned*)((const char*)(sn + (size_t)row0 * 32) + i * 8192 + w * 1024 + lane * 16), (LAS unsigned*)(l3 + TB + i * 8192 + w * 1024), 16, 0, 0);
        }
        f32x4 bv[4];
#pragma unroll
        for (int nt = 0; nt < 4; ++nt) bv[nt] = *(const f32x4*)(bias + hb + (nt >> 1) * 32 + 8 * fq + 4 * (nt & 1));
        __syncthreads();
        const float* lcs = (const float*)lds; const float* lsn = (const float*)(lds + TB);
#pragma unroll
        for (int mt = 0; mt < MT; ++mt) {
            const int rl = wr * 16 * MT + mt * 16 + fr, row = row0 + rl;
            f32x4 v[4];
#pragma unroll
            for (int nt = 0; nt < 4; ++nt) v[nt] = acc[mt][nt] + bv[nt];
            if (is_rope) {
#pragma unroll
                for (int nt = 0; nt < 2; ++nt) {
                    const f32x4 c = *(const f32x4*)(lcs + rl * 32 + 8 * fq + 4 * nt), s = *(const f32x4*)(lsn + rl * 32 + 8 * fq + 4 * nt);
                    const f32x4 t1 = v[nt], t2 = v[nt + 2];
                    v[nt] = t1 * c - t2 * s; v[nt + 2] = t2 * c + t1 * s;
                }
            }
#pragma unroll
            for (int a = 0; a < 2; ++a) {
                const f32x4 o0 = v[2 * a] * sc, o1 = v[2 * a + 1] * sc;
                u32x4 pk = {cvt_pk(o0[0], o0[1]), cvt_pk(o0[2], o0[3]), cvt_pk(o1[0], o1[1]), cvt_pk(o1[2], o1[3])};
                *(u32x4*)(out + (size_t)row * INW + hb + a * 32 + 8 * fq) = pk;
            }
        }
        __syncthreads();
    }
};
struct EpiProjQ {
    const float* bias; const float* cs; const float* sn; bf16_t* out; int row0, col0;
    __device__ __forceinline__ void operator()(f32x4 (&acc)[4][2], int wr, int wc, int fr, int fq) const {
        const int hb = col0 + (wc >> 1) * 64, i0 = (wc & 1) * 16 + 4 * fq;
        const bool is_q = (hb < C_AK) || (hb >= C_BQ && hb < C_BK);
        const bool is_rope = is_q || (hb >= C_AK && hb < C_AV) || (hb >= C_BK && hb < C_BV);
        const float sc = is_q ? QSCALE : 1.0f;
#pragma unroll
        for (int mt = 0; mt < 4; ++mt) {
            const int row = row0 + wr * 64 + mt * 16 + fr;
            f32x4 v0 = acc[mt][0] + *(const f32x4*)(bias + hb + i0), v1 = acc[mt][1] + *(const f32x4*)(bias + hb + 32 + i0);
            if (is_rope) {
                const f32x4 c = *(const f32x4*)(cs + (size_t)row * 32 + i0), s = *(const f32x4*)(sn + (size_t)row * 32 + i0);
                const f32x4 t1 = v0, t2 = v1; v0 = t1 * c - t2 * s; v1 = t2 * c + t1 * s;
            }
            v0 = v0 * sc; v1 = v1 * sc;
            *(u32x2*)(out + (size_t)row * INW + hb + i0) = (u32x2){cvt_pk(v0[0], v0[1]), cvt_pk(v0[2], v0[3])};
            *(u32x2*)(out + (size_t)row * INW + hb + 32 + i0) = (u32x2){cvt_pk(v1[0], v1[1]), cvt_pk(v1[2], v1[3])};
        }
    }
};
__device__ __forceinline__ void phase_proj(const Params& p, char* lds, int vb, int G) {
    const float* cs = (const float*)(p.ws + WS_ROPE); const float* sn = cs + (size_t)S * 32;
    constexpr int NBIG = 512, NUNITS = NBIG + 4 * 64;
    for (int u = vb; u < NUNITS; u += G) {
        G2Args g; g.A = (const char*)(p.ws + WS_XB); g.B = (const char*)(p.ws + WS_WIN); g.nk = D / 64; g.akstep = 128;
        if (u < NBIG) {
            const int tm = u / 9, tn = u % 9;
            g2_rows_A<8>(g, (size_t)tm * 256, D * 2);
            { const int lane = threadIdx.x & 63, w = __builtin_amdgcn_readfirstlane(threadIdx.x >> 6); const unsigned co = g2_chunk_off(lane, w);
#pragma unroll
              for (int i = 0; i < 4; ++i) { const int n = i * 64 + w * 8 + (lane >> 3), nt = (n >> 4) & 3, nl = n & 15;
                  const int col = tn * 256 + (n >> 6) * 64 + (nt >> 1) * 32 + 8 * (nl >> 2) + 4 * (nt & 1) + (nl & 3);
                  g.offB[i] = (unsigned)col * (unsigned)(D * 2) + co; } }
            EpiProj<8> e{p.b_in, cs, sn, (bf16_t*)(p.ws + WS_PROJ), tm * 256, tn * 256, lds};
            gemm2<8>(lds, g, e);
        } else {
            const int q = u - NBIG, t = NBIG + (q >> 2), hm = (q >> 1) & 1, hn = q & 1, tm = t / 9, tn = t % 9;
            g2_rows_A<4>(g, (size_t)tm * 256 + hm * 128, D * 2);
            { const int lane = threadIdx.x & 63, w = __builtin_amdgcn_readfirstlane(threadIdx.x >> 6); const unsigned co = g2_chunk_off(lane, w);
#pragma unroll
              for (int i = 0; i < 2; ++i) { const int n = i * 64 + w * 8 + (lane >> 3), wcn = n >> 5, sub = n & 31;
                  const int col = tn * 256 + hn * 128 + (wcn >> 1) * 64 + (wcn & 1) * 16 + (sub & 15) + (sub >> 4) * 32;
                  g.offB[i] = (unsigned)col * (unsigned)(D * 2) + co; } }
            EpiProjQ e{p.b_in, cs, sn, (bf16_t*)(p.ws + WS_PROJ), tm * 256 + hm * 128, tn * 256 + hn * 128};
            gemm2n<4, 2>(lds, g, e);
        }
    }
}

template <int OFF> __device__ __forceinline__ s16x4 tr_read(int vb) { s16x4 r; asm volatile("ds_read_b64_tr_b16 %0, %1 offset:%2" : "=&v"(r) : "v"(vb), "i"(OFF) : "memory"); return r; }
__device__ __forceinline__ int v_off(int k, int c, int ndb) { return ((k >> 3) * ndb + (c >> 5)) * 512 + ((k & 7) * 32 + (c & 31)) * 2; }

constexpr int AT_STAGE = 32768;
template <int NDB, int KB, int T> struct PvPart {
    static __device__ __forceinline__ void run(f32x16& o, int vbase, const bf16x8& pa, const bf16x8& pb) {
        constexpr int o0 = (KB * 4 * NDB + T) * 512, st = NDB * 512;
        const s16x4 l0 = tr_read<o0 + 0 * st>(vbase), h0 = tr_read<o0 + 1 * st>(vbase), l1 = tr_read<o0 + 2 * st>(vbase), h1 = tr_read<o0 + 3 * st>(vbase);
        asm volatile("s_waitcnt lgkmcnt(0)" ::: "memory"); __builtin_amdgcn_sched_barrier(0);
#define PKV(L, H) (bf16x8){L[0], L[1], L[2], L[3], H[0], H[1], H[2], H[3]}
        o = __builtin_amdgcn_mfma_f32_32x32x16_bf16(PKV(l0, h0), pa, o, 0, 0, 0);
        o = __builtin_amdgcn_mfma_f32_32x32x16_bf16(PKV(l1, h1), pb, o, 0, 0, 0);
#undef PKV
    }
};
template <int NDB, int KB>
__device__ __forceinline__ void pv_half(f32x16 (&o)[NDB], f32x16& ol, int vbase, const bf16x8& pa, const bf16x8& pb) {
    const bf16x8 ones = {16256, 16256, 16256, 16256, 16256, 16256, 16256, 16256};
    ol = __builtin_amdgcn_mfma_f32_32x32x16_bf16(ones, pa, ol, 0, 0, 0);
    ol = __builtin_amdgcn_mfma_f32_32x32x16_bf16(ones, pb, ol, 0, 0, 0);
    PvPart<NDB, KB, 0>::run(o[0], vbase, pa, pb); PvPart<NDB, KB, 1>::run(o[1], vbase, pa, pb);
    if constexpr (NDB == 4) { PvPart<NDB, KB, 2>::run(o[2], vbase, pa, pb); PvPart<NDB, KB, 3>::run(o[3], vbase, pa, pb); }
}
constexpr float ATT_THR = 10.0f;
template <int NDB>
__device__ __forceinline__ void attn_scores(char* lds, int kof, const bf16x8 (&qf)[4], f32x16& s0, f32x16& s1, f32x16 (&o)[NDB], f32x16& ol, f32x16& nm, bool first, int r32, int hi) {
    s0 = nm; s1 = nm;
#pragma unroll
    for (int ds = 0; ds < 4; ++ds) {
        const bf16x8 k0 = *(const bf16x8*)(lds + kof + swz(r32, ds * 2 + hi)), k1 = *(const bf16x8*)(lds + kof + swz(32 + r32, ds * 2 + hi));
        s0 = __builtin_amdgcn_mfma_f32_32x32x16_bf16(k0, qf[ds], s0, 0, 0, 0);
        s1 = __builtin_amdgcn_mfma_f32_32x32x16_bf16(k1, qf[ds], s1, 0, 0, 0);
    }
    float mx = fmaxf(s0[0], s1[0]);
#pragma unroll
    for (int r = 1; r < 16; ++r) mx = fmaxf(fmaxf(mx, s0[r]), s1[r]);
    mx = half_max(mx);
    if (first || __any(mx > ATT_THR)) {
        const float delta = first ? mx : fmaxf(mx, 0.f), alpha = first ? 0.f : __builtin_amdgcn_exp2f(-delta);
#pragma unroll
        for (int r = 0; r < 16; ++r) { s0[r] -= delta; s1[r] -= delta; nm[r] -= delta; ol[r] *= alpha; }
#pragma unroll
        for (int t = 0; t < NDB; ++t)
#pragma unroll
            for (int r = 0; r < 16; ++r) o[t][r] *= alpha;
    }
}
__device__ __forceinline__ void exp_pack(const f32x16& s, bf16x8& pa, bf16x8& pb) {
    float e[16];
#pragma unroll
    for (int r = 0; r < 16; ++r) e[r] = __builtin_amdgcn_exp2f(s[r]);
    u32x4 a = {cvt_pk(e[0], e[1]), cvt_pk(e[2], e[3]), cvt_pk(e[4], e[5]), cvt_pk(e[6], e[7])};
    u32x4 b = {cvt_pk(e[8], e[9]), cvt_pk(e[10], e[11]), cvt_pk(e[12], e[13]), cvt_pk(e[14], e[15])};
    pa = *(bf16x8*)&a; pb = *(bf16x8*)&b;
}

template <int OFF> __device__ __forceinline__ bf16x8 k_read(int a) { bf16x8 r; asm volatile("ds_read_b128 %0, %1 offset:%2" : "=&v"(r) : "v"(a), "i"(OFF) : "memory"); return r; }
struct VSet { s16x4 l0, h0, l1, h1; };
template <int KB, int T> __device__ __forceinline__ void v_issue(VSet& v, int vbase) {
    constexpr int o0 = (KB * 16 + T) * 512, st = 4 * 512;
    v.l0 = tr_read<o0>(vbase); v.h0 = tr_read<o0 + st>(vbase); v.l1 = tr_read<o0 + 2 * st>(vbase); v.h1 = tr_read<o0 + 3 * st>(vbase);
}
#define WAIT_K(n, a, b) asm volatile("s_waitcnt lgkmcnt(" #n ")" : "+v"(a), "+v"(b) :: "memory")
#define WAIT_V(n, v) asm volatile("s_waitcnt lgkmcnt(" #n ")" : "+v"(v.l0), "+v"(v.h0), "+v"(v.l1), "+v"(v.h1) :: "memory")
#define PKV(L, H) (bf16x8){L[0], L[1], L[2], L[3], H[0], H[1], H[2], H[3]}
#define MF32(a, b, c) __builtin_amdgcn_mfma_f32_32x32x16_bf16(a, b, c, 0, 0, 0)
#define SB __builtin_amdgcn_sched_barrier(0)
#define EXP4(src, i, wlo, whi) do { const float e0_ = __builtin_amdgcn_exp2f(src[4 * (i)]), e1_ = __builtin_amdgcn_exp2f(src[4 * (i) + 1]), e2_ = __builtin_amdgcn_exp2f(src[4 * (i) + 2]), e3_ = __builtin_amdgcn_exp2f(src[4 * (i) + 3]); \
        asm("v_add_f32 %0, %1, %0" : "+v"(l2[0]) : "v"(e0_)); asm("v_add_f32 %0, %1, %0" : "+v"(l2[1]) : "v"(e1_)); asm("v_add_f32 %0, %1, %0" : "+v"(l2[0]) : "v"(e2_)); asm("v_add_f32 %0, %1, %0" : "+v"(l2[1]) : "v"(e3_)); \
        wlo = cvt_pk(e0_, e1_); whi = cvt_pk(e2_, e3_); } while (0)
#define MAX4(i) do { mx = fmaxf(fmaxf(mx, n0[4 * (i)]), n1[4 * (i)]); mx = fmaxf(fmaxf(mx, n0[4 * (i) + 1]), n1[4 * (i) + 1]); \
        mx = fmaxf(fmaxf(mx, n0[4 * (i) + 2]), n1[4 * (i) + 2]); mx = fmaxf(fmaxf(mx, n0[4 * (i) + 3]), n1[4 * (i) + 3]); asm volatile("" : "+v"(mx)); } while (0)
struct DmaPlan { const char* base; unsigned gk, gv; size_t ok3, ok4, ov2, ov3; LAS char* dk3; LAS char* dk4; LAS char* dv2; LAS char* dv3; };
#define DMAP(src, dst) __builtin_amdgcn_global_load_lds((const unsigned*)(src), (LAS unsigned*)(dst), 16, 0, 0)
template <bool DMA>
__device__ __forceinline__ void diff_slot(f32x16& c0, f32x16& c1, f32x16& n0, f32x16& n1, f32x16 (&o)[4], f32x2& l2, f32x16& nm, const bf16x8 (&qf)[4],
                                          int ka0, int ka1, int ka2, int ka3, int vbase, bool has_next, const DmaPlan& dp) {
    constexpr bool HASNEXT = true;
    bf16x8 kA, kB, kC, kD, kE, kF, kG, kH; VSet v0, v1, v2, v3, v4, v5, v6, v7; u32x4 w0, w1, w2, w3;
    SB;
    if constexpr (HASNEXT) { kA = k_read<0>(ka0); kB = k_read<4096>(ka0); kC = k_read<0>(ka1); kD = k_read<4096>(ka1); }
    EXP4(c0, 0, w0[0], w0[1]);
    if constexpr (HASNEXT) { WAIT_K(2, kA, kB); kE = k_read<0>(ka2); kF = k_read<4096>(ka2); n0 = MF32(kA, qf[0], nm); n1 = MF32(kB, qf[0], nm); }
    if constexpr (DMA) DMAP(dp.base + dp.ok3 + dp.gk, dp.dk3);
    SB;
    EXP4(c0, 1, w0[2], w0[3]);
    if constexpr (HASNEXT) { WAIT_K(2, kC, kD); kG = k_read<0>(ka3); kH = k_read<4096>(ka3); n0 = MF32(kC, qf[1], n0); n1 = MF32(kD, qf[1], n1); }
    if constexpr (DMA) DMAP(dp.base + (dp.ok3 + 128) + dp.gk, dp.dk3 + 8192);
    SB;
    EXP4(c0, 2, w1[0], w1[1]);
    if constexpr (HASNEXT) { WAIT_K(2, kE, kF); }
    v_issue<0, 0>(v0, vbase);
    if constexpr (HASNEXT) { n0 = MF32(kE, qf[2], n0); n1 = MF32(kF, qf[2], n1); }
    if constexpr (DMA) DMAP(dp.base + dp.ov2 + dp.gv, dp.dv2);
    SB;
    EXP4(c0, 3, w1[2], w1[3]);
    if constexpr (HASNEXT) { WAIT_K(4, kG, kH); }
    v_issue<0, 1>(v1, vbase);
    if constexpr (HASNEXT) { n0 = MF32(kG, qf[3], n0); n1 = MF32(kH, qf[3], n1); }
    if constexpr (DMA) DMAP(dp.base + (dp.ov2 + 128) + dp.gv, dp.dv2 + 1024);
    const bf16x8 p0 = *(bf16x8*)&w0, p1 = *(bf16x8*)&w1;
    SB;
    EXP4(c1, 0, w2[0], w2[1]);
    WAIT_V(4, v0); v_issue<0, 2>(v2, vbase);
    o[0] = MF32(PKV(v0.l0, v0.h0), p0, o[0]); o[0] = MF32(PKV(v0.l1, v0.h1), p1, o[0]);
    if constexpr (DMA) DMAP(dp.base + dp.ov3 + dp.gv, dp.dv3);
    SB;
    EXP4(c1, 1, w2[2], w2[3]);
    WAIT_V(4, v1); v_issue<0, 3>(v3, vbase);
    o[1] = MF32(PKV(v1.l0, v1.h0), p0, o[1]); o[1] = MF32(PKV(v1.l1, v1.h1), p1, o[1]);
    if constexpr (DMA) DMAP(dp.base + (dp.ov3 + 128) + dp.gv, dp.dv3 + 1024);
    SB;
    EXP4(c1, 2, w3[0], w3[1]);
    WAIT_V(4, v2); v_issue<1, 0>(v4, vbase);
    o[2] = MF32(PKV(v2.l0, v2.h0), p0, o[2]); o[2] = MF32(PKV(v2.l1, v2.h1), p1, o[2]);
    if constexpr (DMA) DMAP(dp.base + dp.ok4 + dp.gk, dp.dk4);
    SB;
    EXP4(c1, 3, w3[2], w3[3]);
    WAIT_V(4, v3); v_issue<1, 1>(v5, vbase);
    o[3] = MF32(PKV(v3.l0, v3.h0), p0, o[3]); o[3] = MF32(PKV(v3.l1, v3.h1), p1, o[3]);
    if constexpr (DMA) DMAP(dp.base + (dp.ok4 + 128) + dp.gk, dp.dk4 + 8192);
    const bf16x8 p2 = *(bf16x8*)&w2, p3 = *(bf16x8*)&w3;
    SB;
    float mx = -3.0e38f;
    if constexpr (HASNEXT) MAX4(0);
    WAIT_V(4, v4); v_issue<1, 2>(v6, vbase);
    o[0] = MF32(PKV(v4.l0, v4.h0), p2, o[0]); o[0] = MF32(PKV(v4.l1, v4.h1), p3, o[0]);
    SB;
    if constexpr (HASNEXT) MAX4(1);
    WAIT_V(4, v5); v_issue<1, 3>(v7, vbase);
    o[1] = MF32(PKV(v5.l0, v5.h0), p2, o[1]); o[1] = MF32(PKV(v5.l1, v5.h1), p3, o[1]);
    SB;
    if constexpr (HASNEXT) MAX4(2);
    WAIT_V(4, v6);
    o[2] = MF32(PKV(v6.l0, v6.h0), p2, o[2]); o[2] = MF32(PKV(v6.l1, v6.h1), p3, o[2]);
    SB;
    if constexpr (HASNEXT) MAX4(3);
    WAIT_V(0, v7);
    o[3] = MF32(PKV(v7.l0, v7.h0), p2, o[3]); o[3] = MF32(PKV(v7.l1, v7.h1), p3, o[3]);
    SB;
    if (has_next) {
        mx = half_max(mx);
        if (__any(mx > ATT_THR)) {
            const float delta = fmaxf(mx, 0.f), alpha = __builtin_amdgcn_exp2f(-delta);
#pragma unroll
            for (int r = 0; r < 16; ++r) { n0[r] -= delta; n1[r] -= delta; nm[r] -= delta; }
            l2 *= alpha;
#pragma unroll
            for (int t = 0; t < 4; ++t)
#pragma unroll
                for (int r = 0; r < 16; ++r) o[t][r] *= alpha;
        }
    }
}
__device__ __forceinline__ void attn_diff_unit(const Params& p, char* lds_, int h, int qb, float lam) {
    LAS char* lds = (LAS char*)lds_;
    int tid = threadIdx.x; asm volatile("" : "+v"(tid));
    const int lane = tid & 63, w = __builtin_amdgcn_readfirstlane(tid >> 6), r32 = lane & 31, hi = lane >> 5, mp = w >> 2, wq = w & 3;
    const bf16_t* proj = (const bf16_t*)(p.ws + WS_PROJ);
    const int NT = 2 * qb + 2, NP = NT / 2, myNT = (wq < 2) ? NT - 1 : NT;
    bf16x8 qf[4];
    { const bf16_t* qp = proj + (size_t)(qb * 128 + wq * 32 + r32) * INW + C_BQ + h * 128 + mp * 64 + hi * 8;
#pragma unroll
      for (int ds = 0; ds < 4; ++ds) qf[ds] = *(const bf16x8*)(qp + ds * 16); }
    asm volatile("" : "+v"(qf[0]), "+v"(qf[1]), "+v"(qf[2]), "+v"(qf[3]));
    f32x16 o[4] = {}; f32x16 nm; f32x2 l2 = {0.f, 0.f};
    const unsigned gko = (unsigned)((w * 8 + (lane >> 3)) * INW + C_BK + h * 128) * 2u + g2_chunk_off(lane, w);
    const unsigned gvo = (unsigned)((w * 8 + ((lane & 31) >> 2)) * INW + C_BV + h * 128 + (lane >> 5) * 32 + (lane & 3) * 8) * 2u;
    const char* gk = (const char*)proj + gko; const char* gv = (const char*)proj + gvo;
    const int vlane = ((lane & 3) << 3) | (((lane >> 2) & 3) << 6) | (((lane >> 4) & 1) << 5) | (((lane >> 5) & 1) << 8);
    const int ldsb = (int)(uintptr_t)lds_;
    const int kad0 = ldsb + mp * 8192 + swz(r32, 0 + hi), kad1 = ldsb + mp * 8192 + swz(r32, 2 + hi), kad2 = ldsb + mp * 8192 + swz(r32, 4 + hi), kad3 = ldsb + mp * 8192 + swz(r32, 6 + hi);
    constexpr size_t TSTEP = (size_t)64 * INW * 2;
#define DMA_K(t_) do { const int tt_ = (t_); const char* s_ = gk + (size_t)tt_ * TSTEP; LAS char* d_ = lds + (tt_ & 3) * 16384 + w * 1024; \
        __builtin_amdgcn_global_load_lds((const unsigned*)s_, (LAS unsigned*)d_, 16, 0, 0); \
        __builtin_amdgcn_global_load_lds((const unsigned*)(s_ + 128), (LAS unsigned*)(d_ + 8192), 16, 0, 0); } while (0)
#define DMA_V(t_) do { const int tt_ = (t_); const char* s_ = gv + (size_t)tt_ * TSTEP; LAS char* d_ = lds + 65536 + (tt_ & 3) * 16384 + (2 * w) * 1024; \
        __builtin_amdgcn_global_load_lds((const unsigned*)s_, (LAS unsigned*)d_, 16, 0, 0); \
        __builtin_amdgcn_global_load_lds((const unsigned*)(s_ + 128), (LAS unsigned*)(d_ + 1024), 16, 0, 0); } while (0)
    DMA_K(0); DMA_K(1); if (NT > 2) DMA_K(2); DMA_V(0); DMA_V(1);
    __syncthreads();
    f32x16 A0 = {}, A1 = {}, B0 = {}, B1 = {};
    {
#pragma unroll
        for (int ds = 0; ds < 4; ++ds) {
            const bf16x8 k0 = *(const bf16x8*)(lds_ + mp * 8192 + swz(r32, ds * 2 + hi)), k1 = *(const bf16x8*)(lds_ + mp * 8192 + swz(32 + r32, ds * 2 + hi));
            A0 = MF32(k0, qf[ds], A0); A1 = MF32(k1, qf[ds], A1);
        }
        float mx = fmaxf(A0[0], A1[0]);
#pragma unroll
        for (int r = 1; r < 16; ++r) mx = fmaxf(fmaxf(mx, A0[r]), A1[r]);
        mx = half_max(mx);
#pragma unroll
        for (int r = 0; r < 16; ++r) { A0[r] -= mx; A1[r] -= mx; nm[r] = -mx; }
    }
    __syncthreads();
    for (int it = 0; it < NP; ++it) {
        const int t = 2 * it;
        DmaPlan dp;
        dp.base = (const char*)proj; dp.gk = gko; dp.gv = gvo;
        dp.ok3 = (size_t)min(t + 3, NT - 1) * TSTEP; dp.dk3 = lds + ((t + 3) & 3) * 16384 + w * 1024;
        dp.ok4 = (size_t)min(t + 4, NT - 1) * TSTEP; dp.dk4 = lds + ((t + 4) & 3) * 16384 + w * 1024;
        dp.ov2 = (size_t)min(t + 2, NT - 1) * TSTEP; dp.dv2 = lds + 65536 + ((t + 2) & 3) * 16384 + (2 * w) * 1024;
        dp.ov3 = (size_t)min(t + 3, NT - 1) * TSTEP; dp.dv3 = lds + 65536 + ((t + 3) & 3) * 16384 + (2 * w) * 1024;
        { const int ks = ((t + 1) & 3) * 16384, vb_ = ldsb + 65536 + (t & 3) * 16384 + vlane;
          diff_slot<true>(A0, A1, B0, B1, o, l2, nm, qf, kad0 + ks, kad1 + ks, kad2 + ks, kad3 + ks, vb_, t + 1 < myNT, dp); }
        if (t + 1 < myNT) {
            const int ks = ((t + 2) & 3) * 16384, vb_ = ldsb + 65536 + ((t + 1) & 3) * 16384 + vlane;
            diff_slot<false>(B0, B1, A0, A1, o, l2, nm, qf, kad0 + ks, kad1 + ks, kad2 + ks, kad3 + ks, vb_, t + 2 < myNT, dp);
        }
        __syncthreads();
    }
#undef DMA_K
#undef DMA_V
    float* xb = (float*)lds_;
    const float il = 1.0f / half_sum(l2[0] + l2[1]);
    if (mp == 1) {
        const float f = il * *(const float*)(lds_ + LDS_MISC);
#pragma unroll
        for (int t = 0; t < 4; ++t)
#pragma unroll
            for (int r = 0; r < 16; ++r) xb[(wq * 64 + t * 16 + r) * 64 + lane] = o[t][r] * f;
    }
    __syncthreads();
    if (mp == 0) {
        float ss = 0.f;
#pragma unroll
        for (int t = 0; t < 4; ++t)
#pragma unroll
            for (int r = 0; r < 16; ++r) { const float v = o[t][r] * il - xb[(wq * 64 + t * 16 + r) * 64 + lane]; o[t][r] = v; ss += v * v; }
        ss = half_sum(ss);
        const float rs = rsqrtf(ss * (1.0f / 128.0f) + LN_EPS) * 0.8f;
        bf16_t* op = (bf16_t*)(p.ws + WS_ATT) + (size_t)(qb * 128 + wq * 32 + r32) * D + 512 + h * 128;
#pragma unroll
        for (int t = 0; t < 4; ++t)
#pragma unroll
            for (int rp = 0; rp < 2; ++rp) {
                unsigned pk[2][2];
#pragma unroll
                for (int a = 0; a < 2; ++a) {
                    const int rr = 2 * rp + a, dv0 = 32 * t + 8 * rr + 4 * hi;
                    const f32x4 gg = *(const f32x4*)(p.subg + dv0);
                    pk[a][0] = cvt_pk(o[t][4 * rr] * rs * gg[0], o[t][4 * rr + 1] * rs * gg[1]); pk[a][1] = cvt_pk(o[t][4 * rr + 2] * rs * gg[2], o[t][4 * rr + 3] * rs * gg[3]);
                }
                const auto s0 = __builtin_amdgcn_permlane32_swap(pk[0][0], pk[1][0], false, false), s1 = __builtin_amdgcn_permlane32_swap(pk[0][1], pk[1][1], false, false);
                *(u32x4*)(op + 32 * t + 8 * (2 * rp + hi)) = (u32x4){s0[0], s1[0], s0[1], s1[1]};
            }
    }
    __syncthreads();
}
#undef DMAP
#undef WAIT_K
#undef WAIT_V
#undef PKV
#undef MF32
#undef SB
#undef EXP4
#undef MAX4
__device__ __forceinline__ void attn_swa_unit(const Params& p, char* lds, int kvh, int n) {
    int tid = threadIdx.x; asm volatile("" : "+v"(tid));
    const int lane = tid & 63, w = __builtin_amdgcn_readfirstlane(tid >> 6), r32 = lane & 31, hi = lane >> 5, g = w >> 1, hq = kvh * 4 + g;
    const bf16_t* proj = (const bf16_t*)(p.ws + WS_PROJ);
    const int c0 = (n >= 2) ? n - 2 : 0, NT = n - c0 + 1;
    const int tok = n * 64 + (w & 1) * 32 + r32;
    bf16x8 qf[4];
    { const bf16_t* qp = proj + (size_t)tok * INW + C_AQ + hq * 64 + hi * 8;
#pragma unroll
      for (int ds = 0; ds < 4; ++ds) qf[ds] = *(const bf16x8*)(qp + ds * 16); }
    f32x16 o[2] = {}; f32x16 ol, nm;
    { float ms = -p.sinks[hq] * LOG2E; asm volatile("" : "+v"(qf[0]), "+v"(qf[1]), "+v"(qf[2]), "+v"(qf[3]), "+v"(ms));
#pragma unroll
      for (int r = 0; r < 16; ++r) { nm[r] = ms; ol[r] = 1.0f; } }
    const bf16_t* gk = proj + (size_t)(c0 * 64 + (tid >> 3)) * INW + C_AK + kvh * 64 + (tid & 7) * 8;
    const bf16_t* gv = proj + (size_t)(c0 * 64 + (tid >> 3)) * INW + C_AV + kvh * 64 + (tid & 7) * 8;
    const int wk = swz(tid >> 3, tid & 7), wv = v_off(tid >> 3, (tid & 7) * 8, 2);
    const int vlane = ((lane & 3) << 3) | (((lane >> 2) & 3) << 6) | (((lane >> 4) & 1) << 5) | (((lane >> 5) & 1) << 8);
    u32x4 st0, st1;
#define W_LOAD(t) do { const size_t ko = (size_t)(t) * 64 * INW; st0 = *(const u32x4*)(gk + ko); st1 = *(const u32x4*)(gv + ko); } while (0)
#define W_WRITE(b) do { char* sb = lds + (b) * AT_STAGE; *(u32x4*)(sb + wk) = st0; *(u32x4*)(sb + 8192 + wv) = st1; } while (0)
    W_LOAD(0); W_WRITE(0); __syncthreads();
    for (int t = 0; t < NT; ++t) {
        const int b = t & 1;
        if (t + 1 < NT) W_LOAD(t + 1);
        { f32x16 s0, s1; bf16x8 p0, p1, p2, p3; const int vb_ = (int)(uintptr_t)(lds + b * AT_STAGE + 8192) + vlane;
          attn_scores<2>(lds, b * AT_STAGE, qf, s0, s1, o, ol, nm, false, r32, hi);
          exp_pack(s0, p0, p1); pv_half<2, 0>(o, ol, vb_, p0, p1); exp_pack(s1, p2, p3); pv_half<2, 1>(o, ol, vb_, p2, p3); }
        if (t + 1 < NT) W_WRITE(b ^ 1);
        __syncthreads();
    }
#undef W_LOAD
#undef W_WRITE
    const float il = 1.0f / ol[0];
    bf16_t* op = (bf16_t*)(p.ws + WS_ATT) + (size_t)tok * D + hq * 64;
#pragma unroll
    for (int t = 0; t < 2; ++t)
#pragma unroll
        for (int rp = 0; rp < 2; ++rp) {
            unsigned pk[2][2];
#pragma unroll
            for (int a = 0; a < 2; ++a) { const int rr = 2 * rp + a; pk[a][0] = cvt_pk(o[t][4 * rr] * il, o[t][4 * rr + 1] * il); pk[a][1] = cvt_pk(o[t][4 * rr + 2] * il, o[t][4 * rr + 3] * il); }
            const auto s0 = __builtin_amdgcn_permlane32_swap(pk[0][0], pk[1][0], false, false), s1 = __builtin_amdgcn_permlane32_swap(pk[0][1], pk[1][1], false, false);
            *(u32x4*)(op + 32 * t + 8 * (2 * rp + hi)) = (u32x4){s0[0], s1[0], s0[1], s1[1]};
        }
}
__device__ __forceinline__ void phase_attn(const Params& p, char* lds, int vb, int G) {
    const int lane = threadIdx.x & 63;
    const float d1 = wave_sum(p.lq1[lane] * p.lk1[lane]), d2 = wave_sum(p.lq2[lane] * p.lk2[lane]);
    if (threadIdx.x == 0) *(float*)(lds + LDS_MISC) = expf(d1) - expf(d2) + 0.2f;
    __syncthreads();
    const float lam = 0.f;
    for (int u = vb; u < 1024; u += G) {
        if (u < 512) attn_diff_unit(p, lds, (u & 255) >> 6, (u < 256) ? 127 - (u & 63) : (u & 63), lam);
        else attn_swa_unit(p, lds, (u - 512) >> 8, (u - 512) & 255);
    }
}

struct EpiPreLn {
    const float* x; float* out; int row0, col0;
    __device__ __forceinline__ void operator()(f32x4 (&acc)[8][4], int wr, int wc, int fr, int fq) const {
        f32x4 xa[4], xb_[4];
        const size_t rbase = (size_t)(row0 + wr * 128 + fr) * D + col0 + wc * 64 + 4 * fq;
#pragma unroll
        for (int nt = 0; nt < 4; ++nt) xa[nt] = *(const f32x4*)(x + rbase + nt * 16);
#pragma unroll
        for (int mt = 0; mt < 8; ++mt) {
            const size_t ro = rbase + (size_t)mt * 16 * D;
            if (mt + 1 < 8) {
#pragma unroll
                for (int nt = 0; nt < 4; ++nt) { if (mt & 1) xa[nt] = *(const f32x4*)(x + ro + (size_t)16 * D + nt * 16); else xb_[nt] = *(const f32x4*)(x + ro + (size_t)16 * D + nt * 16); }
            }
#pragma unroll
            for (int nt = 0; nt < 4; ++nt) { const f32x4 xv = (mt & 1) ? xb_[nt] : xa[nt]; *(f32x4*)(out + ro + nt * 16) = xv * ALPHA + acc[mt][nt]; }
        }
    }
};
__device__ __forceinline__ void phase_wout(const Params& p, char* lds, int vb, int G) {
    for (int u = vb; u < (S / 256) * 4; u += G) {
        const int tm = u >> 2, tn = u & 3;
        G2Args g; g.A = (const char*)(p.ws + WS_ATT); g.B = (const char*)(p.ws + WS_WOUT); g.nk = D / 64; g.akstep = 128;
        g2_rows_A<8>(g, (size_t)tm * 256, D * 2); g2_rows_B(g, (size_t)tn * 256, D * 2);
        EpiPreLn e{p.x, (float*)(p.ws + WS_PRELN), tm * 256, tn * 256};
        gemm2<8>(lds, g, e);
    }
}

struct EpiLogits {
    float* L;
    __device__ __forceinline__ void operator()(f32x4 (&acc)[4][4], int wr, int wc, int fr, int fq) const {
#pragma unroll
        for (int mt = 0; mt < 4; ++mt)
#pragma unroll
            for (int nt = 0; nt < 4; ++nt) *(f32x4*)(L + (wr * 64 + mt * 16 + fr) * 256 + wc * 64 + nt * 16 + 4 * fq) = acc[mt][nt];
    }
};
__device__ __forceinline__ void phase_router(const Params& p, char* lds, int vb, int G) {
    const int tid = threadIdx.x, lane = tid & 63, w = tid >> 6;
    const float* preln = (const float*)(p.ws + WS_PRELN);
    bf16_t* x1b = (bf16_t*)(p.ws + WS_X1B);
    unsigned* cnt = (unsigned*)(p.ws + WS_CTL + 65536); int* list = (int*)(p.ws + WS_LIST); float* gates = (float*)(p.ws + WS_GATE);
    for (int u = vb; u < S / 64; u += G) {
        {
            f32x4 v[8][4]; float sm[8], sq[8];
#pragma unroll
            for (int i = 0; i < 8; ++i) { const f32x4* xr = (const f32x4*)(preln + (size_t)(u * 64 + w * 8 + i) * D) + lane;
#pragma unroll
                for (int j = 0; j < 4; ++j) v[i][j] = xr[64 * j]; }
#pragma unroll
            for (int i = 0; i < 8; ++i) { float s = 0.f;
#pragma unroll
                for (int j = 0; j < 4; ++j) s += (v[i][j][0] + v[i][j][1]) + (v[i][j][2] + v[i][j][3]);
                sm[i] = s; }
#pragma unroll
            for (int o = 1; o < 64; o <<= 1) {
#pragma unroll
                for (int i = 0; i < 8; ++i) sm[i] += __shfl_xor(sm[i], o); }
#pragma unroll
            for (int i = 0; i < 8; ++i) { const float mean = sm[i] * (1.0f / D); float s2 = 0.f;
#pragma unroll
                for (int j = 0; j < 4; ++j) { v[i][j] = v[i][j] - mean; s2 += (v[i][j][0] * v[i][j][0] + v[i][j][1] * v[i][j][1]) + (v[i][j][2] * v[i][j][2] + v[i][j][3] * v[i][j][3]); }
                sq[i] = s2; }
#pragma unroll
            for (int o = 1; o < 64; o <<= 1) {
#pragma unroll
                for (int i = 0; i < 8; ++i) sq[i] += __shfl_xor(sq[i], o); }
#pragma unroll
            for (int j = 0; j < 4; ++j) {
                const f32x4 gg = *((const f32x4*)p.ln1g + lane + 64 * j), bb = *((const f32x4*)p.ln1b + lane + 64 * j);
#pragma unroll
                for (int i = 0; i < 8; ++i) {
                    const int row = u * 64 + w * 8 + i;
                    const float rstd = rsqrtf(sq[i] * (1.0f / D) + LN_EPS);
                    const f32x4 y = v[i][j] * rstd * gg + bb;
                    u32x2 pk = {cvt_pk(y[0], y[1]), cvt_pk(y[2], y[3])};
                    *(u32x2*)(x1b + ((size_t)((lane >> 4) + 4 * j) * S + row) * 64 + ((4 * lane) & 63)) = pk;
                }
            }
        }
        asm volatile("s_waitcnt vmcnt(0)" ::: "memory");
        __syncthreads();
        { G2Args g; g.A = (const char*)x1b; g.B = (const char*)(p.ws + WS_WR); g.nk = D / 64; g.akstep = S * 128;
          g2_rows_A<4>(g, (size_t)u * 64, 128); g.offA[1] = g.offA[0]; g2_rows_B(g, 0, D * 2);
          EpiLogits e{(float*)lds};
          gemm2<4>(lds, g, e); }
        __syncthreads();
        const f32x4 rb = *((const f32x4*)p.r_bias + lane);
        const float NEG = -__builtin_inff();
        for (int i0 = 0; i0 < 8; i0 += 4) {
            float sc[4][4], cand[4][4]; int my_e[4]; float my_s[4], gsum[4];
#pragma unroll
            for (int q = 0; q < 4; ++q) {
                const int tl = w * 8 + i0 + q;
                const f32x4 lg = *((const f32x4*)((const float*)lds + tl * 256) + lane);
#pragma unroll
                for (int j = 0; j < 4; ++j) { sc[q][j] = 1.0f / (1.0f + __expf(-lg[j])); cand[q][j] = sc[q][j] + rb[j]; }
                my_e[q] = 0; my_s[q] = 0.f; gsum[q] = 0.f;
            }
            float a1[4], a2[4];
#pragma unroll
            for (int q = 0; q < 4; ++q) { const float m01 = fmaxf(cand[q][0], cand[q][1]), n01 = fminf(cand[q][0], cand[q][1]), m23 = fmaxf(cand[q][2], cand[q][3]), n23 = fminf(cand[q][2], cand[q][3]);
              a1[q] = fmaxf(m01, m23); a2[q] = fmaxf(fminf(m01, m23), fmaxf(n01, n23)); }
#pragma unroll
            for (int off = 1; off < 8; off <<= 1) {
#pragma unroll
                for (int q = 0; q < 4; ++q) { const float b1 = __shfl_xor(a1[q], off), b2 = __shfl_xor(a2[q], off); const float n1 = fmaxf(a1[q], b1), n2 = fmaxf(fminf(a1[q], b1), fmaxf(a2[q], b2)); a1[q] = n1; a2[q] = n2; }
            }
            const int mygrp = lane >> 3;
#pragma unroll
            for (int q = 0; q < 4; ++q) {
                const float gs = a1[q] + a2[q]; int rank = 0;
#pragma unroll
                for (int g2 = 0; g2 < 8; ++g2) { const float v = __shfl(gs, g2 * 8); rank += (v > gs || (v == gs && g2 < mygrp)) ? 1 : 0; }
                if (rank >= 4) {
#pragma unroll
                    for (int j = 0; j < 4; ++j) cand[q][j] = NEG;
                }
            }
#pragma unroll
            for (int k = 0; k < 8; ++k) {
                float bv[4]; int idx[4];
#pragma unroll
                for (int q = 0; q < 4; ++q) { bv[q] = cand[q][0]; int bi = 0;
#pragma unroll
                    for (int j = 1; j < 4; ++j) if (cand[q][j] > bv[q]) { bv[q] = cand[q][j]; bi = j; }
                    idx[q] = 4 * lane + bi; }
#pragma unroll
                for (int off = 32; off >= 1; off >>= 1) {
#pragma unroll
                    for (int q = 0; q < 4; ++q) { const float ov = __shfl_xor(bv[q], off); const int oi = __shfl_xor(idx[q], off); if (ov > bv[q] || (ov == bv[q] && oi < idx[q])) { bv[q] = ov; idx[q] = oi; } }
                }
#pragma unroll
                for (int q = 0; q < 4; ++q) {
                    const int owner = idx[q] >> 2, sub = idx[q] & 3;
                    float scv = sc[q][0];
#pragma unroll
                    for (int j = 1; j < 4; ++j) scv = (sub == j) ? sc[q][j] : scv;
                    if (lane == owner) {
#pragma unroll
                        for (int j = 0; j < 4; ++j) if (sub == j) cand[q][j] = NEG;
                    }
                    const float gsc = __shfl(scv, owner);
                    if (lane == k) { my_e[q] = idx[q]; my_s[q] = gsc; }
                    gsum[q] += gsc;
                }
            }
            if (lane < 8) {
#pragma unroll
                for (int q = 0; q < 4; ++q) {
                    const int t = u * 64 + w * 8 + i0 + q;
                    const float gate = my_s[q] / gsum[q] * 2.5f;
                    const unsigned pos = atomicAdd(cnt + my_e[q] * CNT_STRIDE, 1u);
                    list[(size_t)my_e[q] * CAP + pos] = t * 8 + lane;
                    gates[t * 8 + lane] = gate;
                }
            }
        }
        __syncthreads();
    }
}

#ifndef MOE_MT
#define MOE_MT 8
#endif
constexpr int MOE_BM = 32 * MOE_MT;
struct EpiAct {
    bf16_t* act; const int* slots;
    __device__ __forceinline__ void operator()(f32x4 (&acc)[MOE_MT][4], int pass, int wr, int wc, int fr, int fq) const {
        const int ncol0 = pass * 128;
#pragma unroll
        for (int mt = 0; mt < MOE_MT; ++mt) {
            const int ar = slots[wr * 16 * MOE_MT + mt * 16 + fr];
            if (ar >= 0) {
                float a[8];
#pragma unroll
                for (int nt = 0; nt < 2; ++nt)
#pragma unroll
                    for (int j = 0; j < 4; ++j) { const float gq = acc[mt][nt][j]; a[nt * 4 + j] = gq / (1.0f + __expf(-gq)) * (acc[mt][nt + 2][j]); }
                u32x4 pk = {cvt_pk(a[0], a[1]), cvt_pk(a[2], a[3]), cvt_pk(a[4], a[5]), cvt_pk(a[6], a[7])};
                *(u32x4*)(act + (size_t)ar * FF + ncol0 + wc * 32 + 8 * fq) = pk;
            }
        }
    }
};
struct EpiY {
    bf16_t* y; const int* yrows; const float* gl;
    __device__ __forceinline__ void operator()(f32x4 (&acc)[MOE_MT][4], int pass, int wr, int wc, int fr, int fq) const {
        const int col0 = pass * 256;
#pragma unroll
        for (int mt = 0; mt < MOE_MT; ++mt) {
            const int r = wr * 16 * MOE_MT + mt * 16 + fr, yr = yrows[r];
            if (yr >= 0) {
                const float gt = gl[r];
#pragma unroll
                for (int a = 0; a < 2; ++a) {
                    const f32x4 v0 = acc[mt][2 * a] * gt, v1 = acc[mt][2 * a + 1] * gt;
                    u32x4 pk = {cvt_pk(v0[0], v0[1]), cvt_pk(v0[2], v0[3]), cvt_pk(v1[0], v1[1]), cvt_pk(v1[2], v1[3])};
                    *(u32x4*)(y + (size_t)yr * D + col0 + wc * 64 + a * 32 + 8 * fq) = pk;
                }
            }
        }
    }
};
__device__ __forceinline__ void phase_experts(const Params& p, char* lds, int vb, int G) {
    const int tid0 = threadIdx.x, w = __builtin_amdgcn_readfirstlane(tid0 >> 6);
    const unsigned* cnt = (const unsigned*)(p.ws + WS_CTL + 65536); const int* list = (const int*)(p.ws + WS_LIST); const float* gates = (const float*)(p.ws + WS_GATE);
    bf16_t* act = (bf16_t*)(p.ws + WS_ACT); bf16_t* ybuf = (bf16_t*)(p.ws + WS_Y);
    int* nts = (int*)(lds + LDS_MISC); int* pre = nts + 256;
    int* s_arow = pre + 260; int* s_yrow = s_arow + MOE_BM; int* s_tok = s_yrow + MOE_BM; float* s_gate = (float*)(s_tok + MOE_BM);
    if (tid0 < 256) nts[tid0] = (int)((__hip_atomic_load(cnt + tid0 * CNT_STRIDE, __ATOMIC_RELAXED, __HIP_MEMORY_SCOPE_AGENT) + (MOE_BM - 1)) / MOE_BM);
    __syncthreads();
    if (tid0 < 257) { int s = 0; for (int e = 0; e < tid0; ++e) s += nts[e]; pre[tid0] = s; }
    __syncthreads();
    const int NR = __builtin_amdgcn_readfirstlane(pre[256]), NU = NR + S / MOE_BM;
    for (int u = vb; u < NU; u += G) {
        __syncthreads();
        int tid = threadIdx.x; asm volatile("" : "+v"(tid));
        const int lane = tid & 63; const unsigned co = g2_chunk_off(lane, w);
        const float *bg, *bu, *bd;
        if (u < NR) {
            int lo = 0, hi = 255;
            while (lo < hi) { const int mid = (lo + hi + 1) >> 1; if (pre[mid] <= u) lo = mid; else hi = mid - 1; }
            const int e = lo, tile = u - pre[e], n = (int)__hip_atomic_load(cnt + e * CNT_STRIDE, __ATOMIC_RELAXED, __HIP_MEMORY_SCOPE_AGENT);
            if (tid < MOE_BM) {
                const int idx = tile * MOE_BM + tid;
                if (idx < n) { const int slot = list[(size_t)e * CAP + idx]; s_arow[tid] = slot; s_yrow[tid] = slot + (slot >> 3); s_tok[tid] = slot >> 3; s_gate[tid] = gates[slot]; }
                else { s_arow[tid] = -1; s_yrow[tid] = -1; s_tok[tid] = 0; s_gate[tid] = 0.f; }
            }
            bg = p.w_g + (size_t)e * D * FF; bu = p.w_u + (size_t)e * D * FF; bd = p.w_d + (size_t)e * FF * D;
        } else {
            const int tile = u - NR;
            if (tid < MOE_BM) { const int tk = tile * MOE_BM + tid; s_arow[tid] = S * 8 + tk; s_yrow[tid] = tk * 9 + 8; s_tok[tid] = tk; s_gate[tid] = 1.0f; }
            bg = p.ws_g; bu = p.ws_u; bd = p.ws_d;
        }
        __syncthreads();
        { G3fArgs g; g.A = (const char*)(p.ws + WS_X1B); g.nk = D / 64; g.akstep = S * 128;
#pragma unroll
          for (int i = 0; i < MOE_MT / 2; ++i) g.offA[i] = (unsigned)s_tok[i * 64 + w * 8 + (lane >> 3)] * 128u + co;
          { const int bwc = lane >> 4, nt = (lane >> 2) & 3, bfq = lane & 3;
            g.b = ((nt < 2) ? bg : bu) + bwc * 32 + 8 * bfq + 4 * (nt & 1) + (size_t)(w * 8) * FF; }
          EpiAct e{act, s_arow};
          gemm3f<MOE_MT, FF>(lds, g, 2, 128, e); }
        asm volatile("s_waitcnt vmcnt(0)" ::: "memory");
        __syncthreads();
        { G3fArgs g; g.A = (const char*)act; g.nk = FF / 64; g.akstep = 128;
#pragma unroll
          for (int i = 0; i < MOE_MT / 2; ++i) { const int ar = s_arow[i * 64 + w * 8 + (lane >> 3)]; g.offA[i] = (unsigned)(ar < 0 ? 0 : ar) * (unsigned)(FF * 2) + co; }
          g.b = bd + (size_t)(w * 8) * D + (lane >> 4) * 64 + (((lane >> 2) & 3) >> 1) * 32 + 8 * (lane & 3) + 4 * ((lane >> 2) & 1);
          EpiY e{ybuf, s_yrow, s_gate};
          gemm3f<MOE_MT, D>(lds, g, 4, 256, e); }
    }
}

__device__ __forceinline__ void phase_final(const Params& p, int vb, int G) {
    const int lane = threadIdx.x & 63, w = threadIdx.x >> 6;
    const bf16_t* x1b = (const bf16_t*)(p.ws + WS_X1B); const bf16_t* ybuf = (const bf16_t*)(p.ws + WS_Y);
    const int stride = G * 8;
#define F_LOAD(q, row) do { \
        _Pragma("unroll") for (int j = 0; j < 2; ++j) q[j] = *(const u32x4*)(x1b + ((size_t)((lane >> 3) + 8 * j) * S + (row)) * 64 + ((8 * lane) & 63)); \
        _Pragma("unroll") for (int k = 0; k < 9; ++k) { const u32x4* yr = (const u32x4*)(ybuf + (size_t)((row) * 9 + k) * D) + lane; q[2 + 2 * k] = yr[0]; q[3 + 2 * k] = yr[64]; } } while (0)
#define F_PROC(q, row) do { float v[2][8]; \
        _Pragma("unroll") for (int j = 0; j < 2; ++j) _Pragma("unroll") for (int e = 0; e < 4; ++e) { v[j][2 * e] = bf_lo(q[j][e]) * ALPHA; v[j][2 * e + 1] = bf_hi(q[j][e]) * ALPHA; } \
        _Pragma("unroll") for (int k = 0; k < 9; ++k) _Pragma("unroll") for (int j = 0; j < 2; ++j) _Pragma("unroll") for (int e = 0; e < 4; ++e) { v[j][2 * e] += bf_lo(q[2 + 2 * k + j][e]); v[j][2 * e + 1] += bf_hi(q[2 + 2 * k + j][e]); } \
        float sm = 0.f; \
        _Pragma("unroll") for (int j = 0; j < 2; ++j) _Pragma("unroll") for (int e = 0; e < 8; ++e) sm += v[j][e]; \
        sm = wave_sum(sm); \
        const float mean = sm * (1.0f / D); float sq = 0.f; \
        _Pragma("unroll") for (int j = 0; j < 2; ++j) _Pragma("unroll") for (int e = 0; e < 8; ++e) { v[j][e] -= mean; sq += v[j][e] * v[j][e]; } \
        sq = wave_sum(sq); \
        const float rstd = rsqrtf(sq * (1.0f / D) + LN_EPS); \
        _Pragma("unroll") for (int j = 0; j < 2; ++j) { \
            const f32x4 g0 = *((const f32x4*)p.ln2g + 2 * lane + 128 * j), g1 = *((const f32x4*)p.ln2g + 2 * lane + 128 * j + 1); \
            const f32x4 b0 = *((const f32x4*)p.ln2b + 2 * lane + 128 * j), b1 = *((const f32x4*)p.ln2b + 2 * lane + 128 * j + 1); \
            f32x4* op = (f32x4*)(p.out + (size_t)(row) * D) + 2 * lane + 128 * j; \
            op[0] = (f32x4){v[j][0], v[j][1], v[j][2], v[j][3]} * rstd * g0 + b0; \
            op[1] = (f32x4){v[j][4], v[j][5], v[j][6], v[j][7]} * rstd * g1 + b1; } } while (0)
    u32x4 qa[20], qb[20];
    int row = vb * 8 + w;
    if (row < S) F_LOAD(qa, row);
    for (; row < S; row += 2 * stride) {
        const bool n1 = row + stride < S, n2 = row + 2 * stride < S;
        if (n1) F_LOAD(qb, row + stride);
        __builtin_amdgcn_sched_barrier(0);
        F_PROC(qa, row);
        if (n1) {
            if (n2) F_LOAD(qa, row + 2 * stride);
            __builtin_amdgcn_sched_barrier(0);
            F_PROC(qb, row + stride);
        }
    }
#undef F_LOAD
#undef F_PROC
}

__global__ void __launch_bounds__(NTHREADS) mega(Params p) {
    extern __shared__ __attribute__((aligned(16))) char lds[];
    const int G = gridDim.x, bx = blockIdx.x;
    const int vb = (G % 8 == 0) ? (bx % 8) * (G / 8) + bx / 8 : bx;
    if (threadIdx.x < 4) ((volatile LAS unsigned*)((LAS char*)lds + LDS_BARST))[threadIdx.x] = 0u;
    __syncthreads();
    XcdBarrier bar; bar.bar = (unsigned*)(p.ws + WS_CTL) + CW_BAR; bar.x = 0; bar.st = nullptr;
    if (p.ph_hi - p.ph_lo > 1) bar = xcd_barrier_post((unsigned*)(p.ws + WS_CTL) + CW_BAR, (volatile LAS unsigned*)((LAS char*)lds + LDS_BARST));
#define SEAM(k) do { if (p.ph_lo <= (k) && (k) + 1 < p.ph_hi) { xcd_barrier(bar); } } while (0)
#define IN(k) (p.ph_lo <= (k) && (k) < p.ph_hi)
#define RUN(k, call) do { if (IN(k)) { call; if (MK_REPEAT == (k)) { __syncthreads(); call; } } } while (0)
    RUN(0, phase_prep(p, vb, G)); SEAM(0);
    RUN(1, phase_proj(p, lds, vb, G)); SEAM(1);
    RUN(2, phase_attn(p, lds, vb, G)); SEAM(2);
    RUN(3, phase_wout(p, lds, vb, G)); SEAM(3);
    if (IN(4)) { phase_router(p, lds, vb, G); } SEAM(4);
    RUN(5, phase_experts(p, lds, vb, G)); SEAM(5);
    RUN(6, phase_final(p, vb, G));
#undef SEAM
#undef IN
#undef RUN
}

extern "C" void kernel_launch(void* const* d_in, const int* in_sizes, int n_in, void* d_out, int out_size, void* d_ws, size_t ws_size, hipStream_t stream) {
    static int grid = 0;
    if (grid == 0) {
        if (n_in != 22 || in_sizes[0] != S * D || out_size != S * D || ws_size < WS_END) {
            fprintf(stderr, "kernel_launch: unexpected shapes: n_in %d in0 %d out %d ws %zu (need %zu)\n", n_in, n_in > 0 ? in_sizes[0] : -1, out_size, ws_size, (size_t)WS_END); grid = -1; return; }
        int dev = 0, cus = 0, per_cu = 0;
        (void)hipGetDevice(&dev); (void)hipDeviceGetAttribute(&cus, hipDeviceAttributeMultiprocessorCount, dev);
        if (hipFuncSetAttribute((const void*)mega, hipFuncAttributeMaxDynamicSharedMemorySize, LDS_BYTES) != hipSuccess) { fprintf(stderr, "kernel_launch: hipFuncSetAttribute failed\n"); grid = -1; return; }
        (void)hipOccupancyMaxActiveBlocksPerMultiprocessor(&per_cu, (const void*)mega, NTHREADS, LDS_BYTES);
        if (per_cu < 1) { fprintf(stderr, "kernel_launch: occupancy query says %d blocks per CU\n", per_cu); per_cu = 1; }
        grid = cus * 1;
        (void)hipGetLastError();
    }
    if (grid < 0) return;
    (void)hipMemsetAsync((char*)d_ws + WS_CTL, 0, CTL_BYTES, stream);
    Params p{};
    const float** f = (const float**)&p;
    for (int i = 0; i < 22; ++i) f[i] = (const float*)d_in[i];
    p.out = (float*)d_out; p.ws = (unsigned char*)d_ws;
#if MK_ONE_LAUNCH
    p.ph_lo = 0; p.ph_hi = 7;
    void* args[] = {&p};
    hipError_t e = hipLaunchCooperativeKernel((const void*)mega, dim3(grid), dim3(NTHREADS), args, LDS_BYTES, stream);
    if (e != hipSuccess) fprintf(stderr, "kernel_launch: cooperative launch failed: %s (grid %d)\n", hipGetErrorString(e), grid);
#else
    for (int ph = 0; ph < 7; ++ph) {
        p.ph_lo = ph; p.ph_hi = ph + 1;
        hipLaunchKernelGGL(mega, dim3(grid), dim3(NTHREADS), LDS_BYTES, stream, p);
    }
#endif
}
```

```cpp
#include <hip/hip_runtime.h>
#include <hip/hip_cooperative_groups.h>
#include <cstdio>
#include <cstdint>
namespace cg = cooperative_groups;

#ifndef MK_REPEAT
#define MK_REPEAT -1
#endif
#ifndef MK_ONE_LAUNCH
#define MK_ONE_LAUNCH 1
#endif

constexpr int S = 16384, D = 1024, INW = 2304, NE = 256, FF = 256;
constexpr int NTHREADS = 512;
constexpr int CAP = 16384;
constexpr float ALPHA = 1.189207115002721f;
constexpr float LN_EPS = 1e-5f;
constexpr float QSCALE = 0.125f * 1.4426950408889634f;
constexpr float LOG2E = 1.4426950408889634f;
constexpr int C_AQ = 0, C_AK = 512, C_AV = 640, C_BQ = 768, C_BK = 1280, C_BV = 1792;

constexpr size_t MiB = 1ull << 20;
constexpr size_t WS_CTL = 0;
constexpr size_t CTL_BYTES = 128 * 1024;
constexpr int CNT_STRIDE = 64;
constexpr size_t WS_ROPE = 1 * MiB;
constexpr size_t WS_WIN = 8 * MiB;
constexpr size_t WS_WOUT = 13 * MiB;
constexpr size_t WS_WR = 15 * MiB;
constexpr size_t WS_WSGU = 16 * MiB;
constexpr size_t WS_WSD = 17 * MiB;
constexpr size_t WS_EGU = 20 * MiB;
constexpr size_t WS_ED = 276 * MiB;
constexpr size_t WS_X1F = 404 * MiB;
constexpr size_t WS_X1B = 468 * MiB;
constexpr size_t WS_LIST = 500 * MiB;
constexpr size_t WS_GATE = 516 * MiB;
constexpr size_t WS_ACT = 518 * MiB;
constexpr size_t WS_Y = 590 * MiB;
constexpr size_t WS_XB = 590 * MiB;
constexpr size_t WS_PROJ = 622 * MiB;
constexpr size_t WS_ATT = 694 * MiB;
constexpr size_t WS_PRELN = 726 * MiB;
constexpr size_t WS_END = 878 * MiB;

constexpr int LDS_BYTES = 147456;
constexpr int LDS_MISC = 131072;

typedef unsigned short bf16_t;
typedef short bf16x8 __attribute__((ext_vector_type(8)));
typedef short s16x4 __attribute__((ext_vector_type(4)));
typedef float f32x4 __attribute__((ext_vector_type(4)));
typedef float f32x16 __attribute__((ext_vector_type(16)));
typedef unsigned u32x4 __attribute__((ext_vector_type(4)));
typedef unsigned u32x2 __attribute__((ext_vector_type(2)));
typedef float f32x2 __attribute__((ext_vector_type(2)));


#define LAS __attribute__((address_space(3)))
#define XB_TMO      128
#define XB_XCNT(j)  (256  + 64 * (j))
#define XB_XSUB(j)  (1280 + 64 * (j))
#define XB_XGEN(j)  (2304 + 64 * (j))
#define XB_TOP      3328
#define XB_TOPGEN   3392
#define XCD_BAR_WORDS 3456
#define XB_SPIN_CAP (1u << 18)
__device__ __forceinline__ unsigned xb_ld(unsigned* p)              { return __hip_atomic_load(p, __ATOMIC_RELAXED, __HIP_MEMORY_SCOPE_AGENT); }
__device__ __forceinline__ unsigned xb_add(unsigned* p, unsigned v) { return __hip_atomic_fetch_add(p, v, __ATOMIC_RELAXED, __HIP_MEMORY_SCOPE_AGENT); }
__device__ __forceinline__ unsigned xb_xcc_id() { return (unsigned)__builtin_amdgcn_s_getreg((3 << 11) | 20) & 0xFu; }
#define XB_SPIN(cond, bar) do { unsigned _sp = 0; while (cond) { __builtin_amdgcn_s_sleep(1); \
    if ((++_sp & 255u) == 0u) { if (xb_ld(&(bar)[XB_TMO])) break; if (_sp > XB_SPIN_CAP) { atomicAdd(&(bar)[XB_TMO], 1u); break; } } } } while (0)
struct XcdBarrier { unsigned* bar; unsigned x; volatile LAS unsigned* st; };
__device__ __forceinline__ XcdBarrier xcd_barrier_post(unsigned* bar, volatile LAS unsigned* st) {
    XcdBarrier b; b.bar = bar; b.x = xb_xcc_id(); b.st = st;
    if (threadIdx.x == 0) (void)xb_add(&bar[XB_XCNT(b.x)], 1u);
    return b;
}
__device__ __forceinline__ void xcd_barrier_complete(unsigned* bar, unsigned x, unsigned& nloc, unsigned& nx) {
    const unsigned G = gridDim.x * gridDim.y * gridDim.z;
    unsigned sum, cnt, mine, sp = 0u;
    for (;;) {
        sum = 0u; cnt = 0u; mine = 0u;
#pragma unroll
        for (unsigned j = 0; j < 16; ++j) { const unsigned c = xb_ld(&bar[XB_XCNT(j)]); sum += c; cnt += (c > 0u) ? 1u : 0u; mine = (j == x) ? c : mine; }
        if (sum == G) break;
        __builtin_amdgcn_s_sleep(1);
        if ((++sp & 255u) == 0u) { if (xb_ld(&bar[XB_TMO])) break; if (sp > XB_SPIN_CAP) { atomicAdd(&bar[XB_TMO], 1u); break; } }
    }
    nloc = mine > 0u ? mine : 1u; nx = cnt > 0u ? cnt : 1u;
}
__device__ __forceinline__ void xcd_barrier(const XcdBarrier& b) {
    asm volatile("s_waitcnt vmcnt(0)" ::: "memory");
    __syncthreads();
    if (threadIdx.x == 0) {
        unsigned* bar = b.bar;
        __builtin_amdgcn_s_waitcnt(0);
        unsigned nloc = b.st[0], nx = b.st[1];
        if (nloc == 0u) { xcd_barrier_complete(bar, b.x, nloc, nx); b.st[0] = nloc; b.st[1] = nx; }
        const unsigned old = xb_add(&bar[XB_XSUB(b.x)], 1u);
        const unsigned gen = old / nloc;
        if (old + 1u == (gen + 1u) * nloc) {
            __builtin_amdgcn_fence(__ATOMIC_RELEASE, "agent");
            asm volatile("s_waitcnt vmcnt(0)" ::: "memory");
            const unsigned og = xb_add(&bar[XB_TOP], 1u);
            const unsigned tg = og / nx;
            if (og + 1u == (tg + 1u) * nx) xb_add(&bar[XB_TOPGEN], 1u);
            else XB_SPIN(xb_ld(&bar[XB_TOPGEN]) == tg, bar);
            __builtin_amdgcn_fence(__ATOMIC_ACQUIRE, "agent");
            xb_add(&bar[XB_XGEN(b.x)], 1u);
            asm volatile("s_waitcnt vmcnt(0)" ::: "memory");
        } else {
            XB_SPIN(xb_ld(&bar[XB_XGEN(b.x)]) == gen, bar);
            __builtin_amdgcn_fence(__ATOMIC_ACQUIRE, "agent");
            asm volatile("s_waitcnt vmcnt(0)" ::: "memory");
        }
    }
    __syncthreads();
}
constexpr int CW_BAR = 4096;
constexpr int LDS_BARST = LDS_MISC + 8192;

struct Params {
    const float* x; const float* w_in; const float* b_in; const float* sinks;
    const float* lq1; const float* lk1; const float* lq2; const float* lk2; const float* subg;
    const float* w_out; const float* ln1g; const float* ln1b; const float* w_r; const float* r_bias;
    const float* w_g; const float* w_u; const float* w_d; const float* ws_g; const float* ws_u; const float* ws_d;
    const float* ln2g; const float* ln2b;
    float* out; unsigned char* ws;
    int ph_lo, ph_hi;
};

__device__ __forceinline__ unsigned cvt_pk(float lo, float hi) { unsigned r; asm volatile("v_cvt_pk_bf16_f32 %0, %1, %2" : "=v"(r) : "v"(lo), "v"(hi)); return r; }
typedef __bf16 bf16x2_t __attribute__((ext_vector_type(2)));
__device__ __forceinline__ unsigned cvt_pk_vis(float lo, float hi) { const bf16x2_t r = __builtin_convertvector((f32x2){lo, hi}, bf16x2_t); return *(const unsigned*)&r; }
__device__ __forceinline__ float bf_lo(unsigned u) { return __uint_as_float(u << 16); }
__device__ __forceinline__ float bf_hi(unsigned u) { return __uint_as_float(u & 0xffff0000u); }
__device__ __forceinline__ float wave_sum(float v) {
#pragma unroll
    for (int o = 1; o < 64; o <<= 1) v += __shfl_xor(v, o);
    return v;
}
__device__ __forceinline__ float half_max(float v) { auto rr = __builtin_amdgcn_permlane32_swap(__float_as_uint(v), __float_as_uint(v), false, false); return fmaxf(__uint_as_float(rr[0]), __uint_as_float(rr[1])); }
__device__ __forceinline__ float half_sum(float v) { auto rr = __builtin_amdgcn_permlane32_swap(__float_as_uint(v), __float_as_uint(v), false, false); return __uint_as_float(rr[0]) + __uint_as_float(rr[1]); }

__device__ __forceinline__ int swz(int r, int c) { const int f = (r & 7) ^ (((r >> 3) & 1) << 1) ^ ((r >> 4) & 1); return r * 128 + ((c ^ f) << 4); }

struct G2Args {
    const char* A; const char* B;
    unsigned offA[4], offB[4];
    int nk;
    unsigned akstep;
};
__device__ __forceinline__ unsigned g2_chunk_off(int lane, int w) { const int f = (lane >> 3) ^ ((w & 1) << 1) ^ ((w >> 1) & 1); return (unsigned)(((lane & 7) ^ f) << 4); }
template <int MT, int NT, class Epi>
__device__ __forceinline__ void gemm2n(char* lds_, const G2Args& g, const Epi& epi) {
    constexpr int A_BYTES = 32 * MT * 128, B_BYTES = 64 * NT * 128, STAGE = A_BYTES + B_BYTES, AR = MT / 2, BRR = NT;
    LAS char* lds = (LAS char*)lds_;
    const int tid = threadIdx.x, lane = tid & 63, w = __builtin_amdgcn_readfirstlane(tid >> 6), wr = w >> 2, wc = w & 3, fr = lane & 15, fq = lane >> 4;
    f32x4 acc[MT][NT];
#pragma unroll
    for (int i = 0; i < MT; ++i)
#pragma unroll
        for (int j = 0; j < NT; ++j) acc[i][j] = (f32x4){0.f, 0.f, 0.f, 0.f};
    const int ldsw = w * 1024;
#define G2_STAGE(kt, s) do { \
        _Pragma("unroll") for (int i = 0; i < AR; ++i) __builtin_amdgcn_global_load_lds((const unsigned*)(g.A + g.offA[i] + (size_t)(kt) * g.akstep), (LAS unsigned*)(lds + (s) * STAGE + i * 8192 + ldsw), 16, 0, 0); \
        _Pragma("unroll") for (int i = 0; i < BRR; ++i) __builtin_amdgcn_global_load_lds((const unsigned*)(g.B + g.offB[i] + (size_t)(kt) * 128), (LAS unsigned*)(lds + (s) * STAGE + A_BYTES + i * 8192 + ldsw), 16, 0, 0); } while (0)
    G2_STAGE(0, 0);
    __syncthreads();
    for (int kt = 0; kt < g.nk; ++kt) {
        const int s = kt & 1;
        if (kt + 1 < g.nk) { if (s) G2_STAGE(kt + 1, 0); else G2_STAGE(kt + 1, 1); }
        const char* la = lds_ + s * STAGE; const char* lb = la + A_BYTES;
        {
            constexpr int NG = 2 * (MT / 4);
            bf16x8 bfr[NT], af[2][4];
#pragma unroll
            for (int nt = 0; nt < NT; ++nt) bfr[nt] = *(const bf16x8*)(lb + swz(wc * 16 * NT + nt * 16 + fr, fq));
#pragma unroll
            for (int m = 0; m < 4; ++m) af[0][m] = *(const bf16x8*)(la + swz(wr * 16 * MT + m * 16 + fr, fq));
#pragma unroll
            for (int gi = 0; gi < NG; ++gi) {
                const int ks = gi / (MT / 4), h = gi % (MT / 4);
                if (gi > 0 && h == 0) {
#pragma unroll
                    for (int nt = 0; nt < NT; ++nt) bfr[nt] = *(const bf16x8*)(lb + swz(wc * 16 * NT + nt * 16 + fr, ks * 4 + fq));
                }
                if (gi + 1 < NG) {
                    const int ks2 = (gi + 1) / (MT / 4), h2 = (gi + 1) % (MT / 4);
#pragma unroll
                    for (int m = 0; m < 4; ++m) af[(gi + 1) & 1][m] = *(const bf16x8*)(la + swz(wr * 16 * MT + (h2 * 4 + m) * 16 + fr, ks2 * 4 + fq));
                }
                __builtin_amdgcn_sched_barrier(0);
#pragma unroll
                for (int m = 0; m < 4; ++m)
#pragma unroll
                    for (int nt = 0; nt < NT; ++nt) acc[h * 4 + m][nt] = __builtin_amdgcn_mfma_f32_16x16x32_bf16(bfr[nt], af[gi & 1][m], acc[h * 4 + m][nt], 0, 0, 0);
                __builtin_amdgcn_sched_barrier(0);
            }
        }
        __syncthreads();
    }
#undef G2_STAGE
    epi(acc, wr, wc, fr, fq);
}
template <int MT, class Epi>
__device__ __forceinline__ void gemm2(char* lds_, const G2Args& g, const Epi& epi) { gemm2n<MT, 4>(lds_, g, epi); }
template <int MT>
__device__ __forceinline__ void g2_rows_A(G2Args& g, size_t row0, unsigned ld_bytes) {
    const int lane = threadIdx.x & 63, w = __builtin_amdgcn_readfirstlane(threadIdx.x >> 6); const unsigned co = g2_chunk_off(lane, w);
#pragma unroll
    for (int i = 0; i < MT / 2; ++i) g.offA[i] = (unsigned)((row0 + i * 64 + w * 8 + (lane >> 3)) * ld_bytes) + co;
}
__device__ __forceinline__ void g2_rows_B(G2Args& g, size_t row0, unsigned ld_bytes) {
    const int lane = threadIdx.x & 63, w = __builtin_amdgcn_readfirstlane(threadIdx.x >> 6); const unsigned co = g2_chunk_off(lane, w);
#pragma unroll
    for (int i = 0; i < 4; ++i) g.offB[i] = (unsigned)((row0 + i * 64 + w * 8 + (lane >> 3)) * ld_bytes) + co;
}


struct G3fArgs { const char* A; unsigned offA[4]; const float* b; int nk; unsigned akstep; };
template <int MT, int LDB, class Epi>
__device__ __forceinline__ void gemm3f(char* lds_, const G3fArgs& g, int npass, int bpstep, const Epi& epi) {
    constexpr int A_BYTES = 32 * MT * 128, B_BYTES = 256 * 128, STAGE = A_BYTES + B_BYTES, AR = MT / 2;
    LAS char* lds = (LAS char*)lds_;
    const int tid = threadIdx.x, lane = tid & 63, w = __builtin_amdgcn_readfirstlane(tid >> 6), wr = w >> 2, wc = w & 3, fr = lane & 15, fq = lane >> 4;
    f32x4 acc[MT][4];
#pragma unroll
    for (int i = 0; i < MT; ++i)
#pragma unroll
        for (int j = 0; j < 4; ++j) acc[i][j] = (f32x4){0.f, 0.f, 0.f, 0.f};
    const int ldsw = w * 1024;
    int bw[4];
#pragma unroll
    for (int j = 0; j < 4; ++j) bw[j] = swz(4 * lane + j, w);
    f32x4 br[8];
    const int nk = g.nk, nsteps = nk * npass;
#define G3_STAGE_A(kt, s) do { \
        _Pragma("unroll") for (int i = 0; i < AR; ++i) __builtin_amdgcn_global_load_lds((const unsigned*)(g.A + g.offA[i] + (size_t)(kt) * g.akstep), (LAS unsigned*)(lds + (s) * STAGE + i * 8192 + ldsw), 16, 0, 0); } while (0)
#define G3_LOAD_B(ps, kt) do { const float* pb_ = g.b + (size_t)(ps) * bpstep + (size_t)(kt) * 64 * LDB; _Pragma("unroll") for (int i = 0; i < 8; ++i) br[i] = *(const f32x4*)(pb_ + i * LDB); } while (0)
#define G3_WRITE_B(s) do { _Pragma("unroll") for (int j = 0; j < 4; ++j) { \
            u32x4 v = {cvt_pk(br[0][j], br[1][j]), cvt_pk(br[2][j], br[3][j]), cvt_pk(br[4][j], br[5][j]), cvt_pk(br[6][j], br[7][j])}; \
            *(u32x4*)(lds_ + (s) * STAGE + A_BYTES + bw[j]) = v; } } while (0)
    G3_STAGE_A(0, 0); G3_LOAD_B(0, 0); G3_WRITE_B(0);
    __syncthreads();
    int ps = 0, kt = 0;
    for (int st = 0; st < nsteps; ++st) {
        const int s = st & 1; const bool more = st + 1 < nsteps;
        int ps2 = ps, kt2 = kt + 1; if (kt2 == nk) { kt2 = 0; ++ps2; }
        if (more) { if (s) G3_STAGE_A(kt2, 0); else G3_STAGE_A(kt2, 1); G3_LOAD_B(ps2, kt2); }
        __builtin_amdgcn_sched_barrier(0);
        const char* la = lds_ + s * STAGE; const char* lb = la + A_BYTES;
#pragma unroll
        for (int ks = 0; ks < 2; ++ks) {
            bf16x8 bfr[4];
#pragma unroll
            for (int nt = 0; nt < 4; ++nt) bfr[nt] = *(const bf16x8*)(lb + swz(wc * 64 + nt * 16 + fr, ks * 4 + fq));
#pragma unroll
            for (int h = 0; h < MT / 2; ++h) {
                bf16x8 af[2];
#pragma unroll
                for (int m = 0; m < 2; ++m) af[m] = *(const bf16x8*)(la + swz(wr * 16 * MT + (h * 2 + m) * 16 + fr, ks * 4 + fq));
                __builtin_amdgcn_sched_barrier(0);
#pragma unroll
                for (int m = 0; m < 2; ++m)
#pragma unroll
                    for (int nt = 0; nt < 4; ++nt) acc[h * 2 + m][nt] = __builtin_amdgcn_mfma_f32_16x16x32_bf16(bfr[nt], af[m], acc[h * 2 + m][nt], 0, 0, 0);
                __builtin_amdgcn_sched_barrier(0);
            }
        }
        if (kt == nk - 1) {
            epi(acc, ps, wr, wc, fr, fq);
#pragma unroll
            for (int i = 0; i < MT; ++i)
#pragma unroll
                for (int j = 0; j < 4; ++j) acc[i][j] = (f32x4){0.f, 0.f, 0.f, 0.f};
        }
        if (more) { if (s) G3_WRITE_B(0); else G3_WRITE_B(1); }
        __syncthreads();
        ps = ps2; kt = kt2;
    }
#undef G3_STAGE_A
#undef G3_LOAD_B
#undef G3_WRITE_B
}

__device__ __forceinline__ void cvt_item(const float* W, int K, int N, bf16_t* WT, int ldt, int kb, int nb, int kc, int lane) {
    const float* src = W + (size_t)(kb * 64 + kc * 8) * N + nb * 256 + 4 * lane;
    bf16_t* dst = WT + (size_t)(nb * 256 + 4 * lane) * ldt + kb * 64 + kc * 8;
    f32x4 r[8];
#pragma unroll
    for (int i = 0; i < 8; ++i) r[i] = *(const f32x4*)(src + (size_t)i * N);
#pragma unroll
    for (int j = 0; j < 4; ++j) {
        u32x4 v = {cvt_pk(r[0][j], r[1][j]), cvt_pk(r[2][j], r[3][j]), cvt_pk(r[4][j], r[5][j]), cvt_pk(r[6][j], r[7][j])};
        *(u32x4*)(dst + (size_t)j * ldt) = v;
    }
}
__device__ __forceinline__ void phase_prep(const Params& p, int vb, int G) {
    const int tid = threadIdx.x, lane = tid & 63, w = tid >> 6;
    float* cs = (float*)(p.ws + WS_ROPE); float* sn = cs + (size_t)S * 32;
    for (int idx = vb * NTHREADS + tid; idx < S * 32; idx += G * NTHREADS) {
        const int pos = idx >> 5, i = idx & 31;
        const float pw = (float)pow(10000.0, (double)i / 32.0);
        const float inv = 1.0f / pw;
        const float angf = __fmul_rn((float)pos, inv);
        const double a = (double)angf;
        const double q = rint(a * 0.63661977236758134308);
        double r = fma(-q, 1.57079632679489655800, a); r = fma(-q, 6.12323399573676603587e-17, r);
        const double r2 = r * r;
        double sp = r * (1.0 + r2 * (-1.0 / 6 + r2 * (1.0 / 120 + r2 * (-1.0 / 5040 + r2 * (1.0 / 362880 + r2 * (-1.0 / 39916800))))));
        double cp = 1.0 + r2 * (-0.5 + r2 * (1.0 / 24 + r2 * (-1.0 / 720 + r2 * (1.0 / 40320 + r2 * (-1.0 / 3628800 + r2 * (1.0 / 479001600))))));
        const int qi = ((int)((long long)q)) & 3;
        double sv, cv;
        if (qi == 0) { sv = sp; cv = cp; } else if (qi == 1) { sv = cp; cv = -sp; } else if (qi == 2) { sv = -sp; cv = -cp; } else { sv = -cp; cv = sp; }
        cs[idx] = (float)cv; sn[idx] = (float)sv;
    }
    { const f32x4* xs = (const f32x4*)p.x; u32x4* xd = (u32x4*)(p.ws + WS_XB);
      for (size_t i = (size_t)vb * NTHREADS + tid; i < (size_t)S * D / 8; i += (size_t)G * NTHREADS) {
          const f32x4 a = xs[2 * i], b = xs[2 * i + 1];
          xd[i] = (u32x4){cvt_pk(a[0], a[1]), cvt_pk(a[2], a[3]), cvt_pk(b[0], b[1]), cvt_pk(b[2], b[3])}; } }
    const int gw = vb * 8 + w, NGW = G * 8;
    constexpr int I_IN = 16 * 9, I_OUT = 16 * 4, I_R = 16, I_SG = 16, I_SU = 16, I_SD = 4 * 4, I_SMALL = I_IN + I_OUT + I_R;
    for (int it8 = gw; it8 < I_SMALL * 8; it8 += NGW) {
        int r = it8 >> 3; const int kc = it8 & 7;
        if (r < I_IN) { cvt_item(p.w_in, D, INW, (bf16_t*)(p.ws + WS_WIN), D, r / 9, r % 9, kc, lane); continue; } r -= I_IN;
        if (r < I_OUT) { cvt_item(p.w_out, D, D, (bf16_t*)(p.ws + WS_WOUT), D, r >> 2, r & 3, kc, lane); continue; } r -= I_OUT;
        cvt_item(p.w_r, D, NE, (bf16_t*)(p.ws + WS_WR), D, r, 0, kc, lane);
    }
}

template <int MT> struct EpiProj {
    const float* bias; const float* cs; const float* sn; bf16_t* out; int row0, col0; char* lds;
    __device__ __forceinline__ void operator()(f32x4 (&acc)[MT][4], int wr, int wc, int fr, int fq) const {
        const int hb = col0 + wc * 64;
        const bool is_q = (hb < C_AK) || (hb >= C_BQ && hb < C_BK);
        const bool is_rope = is_q || (hb >= C_AK && hb < C_AV) || (hb >= C_BK && hb < C_BV);
        const float sc = is_q ? QSCALE : 1.0f;
        const int tid = threadIdx.x, w = __builtin_amdgcn_readfirstlane(tid >> 6), lane = tid & 63;
        constexpr int TB = 32 * MT * 128;
        LAS char* l3 = (LAS char*)lds;
#pragma unroll
        for (int i = 0; i < TB / 8192; ++i) {
            __builtin_amdgcn_global_load_lds((const unsigned*)((const char*)(cs + (size_t)row0 * 32) + i * 8192 + w * 1024 + lane * 16), (LAS unsigned*)(l3 + i * 8192 + w * 1024), 16, 0, 0);
            __builtin_amdgcn_global_load_lds((const unsigned*)((const char*)(sn + (size_t)row0 * 32) + i * 8192 + w * 1024 + lane * 16), (LAS unsigned*)(l3 + TB + i * 8192 + w * 1024), 16, 0, 0);
        }
        f32x4 bv[4];
#pragma unroll
        for (int nt = 0; nt < 4; ++nt) bv[nt] = *(const f32x4*)(bias + hb + (nt >> 1) * 32 + 8 * fq + 4 * (nt & 1));
        __syncthreads();
        const float* lcs = (const float*)lds; const float* lsn = (const float*)(lds + TB);
#pragma unroll
        for (int mt = 0; mt < MT; ++mt) {
            const int rl = wr * 16 * MT + mt * 16 + fr, row = row0 + rl;
            f32x4 v[4];
#pragma unroll
            for (int nt = 0; nt < 4; ++nt) v[nt] = acc[mt][nt] + bv[nt];
            if (is_rope) {
#pragma unroll
                for (int nt = 0; nt < 2; ++nt) {
                    const f32x4 c = *(const f32x4*)(lcs + rl * 32 + 8 * fq + 4 * nt), s = *(const f32x4*)(lsn + rl * 32 + 8 * fq + 4 * nt);
                    const f32x4 t1 = v[nt], t2 = v[nt + 2];
                    v[nt] = t1 * c - t2 * s; v[nt + 2] = t2 * c + t1 * s;
                }
            }
#pragma unroll
            for (int a = 0; a < 2; ++a) {
                const f32x4 o0 = v[2 * a] * sc, o1 = v[2 * a + 1] * sc;
                u32x4 pk = {cvt_pk(o0[0], o0[1]), cvt_pk(o0[2], o0[3]), cvt_pk(o1[0], o1[1]), cvt_pk(o1[2], o1[3])};
                *(u32x4*)(out + (size_t)row * INW + hb + a * 32 + 8 * fq) = pk;
            }
        }
        __syncthreads();
    }
};
struct EpiProjQ {
    const float* bias; const float* cs; const float* sn; bf16_t* out; int row0, col0;
    __device__ __forceinline__ void operator()(f32x4 (&acc)[4][2], int wr, int wc, int fr, int fq) const {
        const int hb = col0 + (wc >> 1) * 64, i0 = (wc & 1) * 16 + 4 * fq;
        const bool is_q = (hb < C_AK) || (hb >= C_BQ && hb < C_BK);
        const bool is_rope = is_q || (hb >= C_AK && hb < C_AV) || (hb >= C_BK && hb < C_BV);
        const float sc = is_q ? QSCALE : 1.0f;
#pragma unroll
        for (int mt = 0; mt < 4; ++mt) {
            const int row = row0 + wr * 64 + mt * 16 + fr;
            f32x4 v0 = acc[mt][0] + *(const f32x4*)(bias + hb + i0), v1 = acc[mt][1] + *(const f32x4*)(bias + hb + 32 + i0);
            if (is_rope) {
                const f32x4 c = *(const f32x4*)(cs + (size_t)row * 32 + i0), s = *(const f32x4*)(sn + (size_t)row * 32 + i0);
                const f32x4 t1 = v0, t2 = v1; v0 = t1 * c - t2 * s; v1 = t2 * c + t1 * s;
            }
            v0 = v0 * sc; v1 = v1 * sc;
            *(u32x2*)(out + (size_t)row * INW + hb + i0) = (u32x2){cvt_pk(v0[0], v0[1]), cvt_pk(v0[2], v0[3])};
            *(u32x2*)(out + (size_t)row * INW + hb + 32 + i0) = (u32x2){cvt_pk(v1[0], v1[1]), cvt_pk(v1[2], v1[3])};
        }
    }
};
__device__ __forceinline__ void phase_proj(const Params& p, char* lds, int vb, int G) {
    const float* cs = (const float*)(p.ws + WS_ROPE); const float* sn = cs + (size_t)S * 32;
    constexpr int NBIG = 512, NUNITS = NBIG + 4 * 64;
    for (int u = vb; u < NUNITS; u += G) {
        G2Args g; g.A = (const char*)(p.ws + WS_XB); g.B = (const char*)(p.ws + WS_WIN); g.nk = D / 64; g.akstep = 128;
        if (u < NBIG) {
            const int tm = u / 9, tn = u % 9;
            g2_rows_A<8>(g, (size_t)tm * 256, D * 2);
            { const int lane = threadIdx.x & 63, w = __builtin_amdgcn_readfirstlane(threadIdx.x >> 6); const unsigned co = g2_chunk_off(lane, w);
#pragma unroll
              for (int i = 0; i < 4; ++i) { const int n = i * 64 + w * 8 + (lane >> 3), nt = (n >> 4) & 3, nl = n & 15;
                  const int col = tn * 256 + (n >> 6) * 64 + (nt >> 1) * 32 + 8 * (nl >> 2) + 4 * (nt & 1) + (nl & 3);
                  g.offB[i] = (unsigned)col * (unsigned)(D * 2) + co; } }
            EpiProj<8> e{p.b_in, cs, sn, (bf16_t*)(p.ws + WS_PROJ), tm * 256, tn * 256, lds};
            gemm2<8>(lds, g, e);
        } else {
            const int q = u - NBIG, t = NBIG + (q >> 2), hm = (q >> 1) & 1, hn = q & 1, tm = t / 9, tn = t % 9;
            g2_rows_A<4>(g, (size_t)tm * 256 + hm * 128, D * 2);
            { const int lane = threadIdx.x & 63, w = __builtin_amdgcn_readfirstlane(threadIdx.x >> 6); const unsigned co = g2_chunk_off(lane, w);
#pragma unroll
              for (int i = 0; i < 2; ++i) { const int n = i * 64 + w * 8 + (lane >> 3), wcn = n >> 5, sub = n & 31;
                  const int col = tn * 256 + hn * 128 + (wcn >> 1) * 64 + (wcn & 1) * 16 + (sub & 15) + (sub >> 4) * 32;
                  g.offB[i] = (unsigned)col * (unsigned)(D * 2) + co; } }
            EpiProjQ e{p.b_in, cs, sn, (bf16_t*)(p.ws + WS_PROJ), tm * 256 + hm * 128, tn * 256 + hn * 128};
            gemm2n<4, 2>(lds, g, e);
        }
    }
}

template <int OFF> __device__ __forceinline__ s16x4 tr_read(int vb) { s16x4 r; asm volatile("ds_read_b64_tr_b16 %0, %1 offset:%2" : "=&v"(r) : "v"(vb), "i"(OFF) : "memory"); return r; }
__device__ __forceinline__ int v_off(int k, int c, int ndb) { return ((k >> 3) * ndb + (c >> 5)) * 512 + ((k & 7) * 32 + (c & 31)) * 2; }

constexpr int AT_STAGE = 32768;
template <int NDB, int KB, int T> struct PvPart {
    static __device__ __forceinline__ void run(f32x16& o, int vbase, const bf16x8& pa, const bf16x8& pb) {
        constexpr int o0 = (KB * 4 * NDB + T) * 512, st = NDB * 512;
        const s16x4 l0 = tr_read<o0 + 0 * st>(vbase), h0 = tr_read<o0 + 1 * st>(vbase), l1 = tr_read<o0 + 2 * st>(vbase), h1 = tr_read<o0 + 3 * st>(vbase);
        asm volatile("s_waitcnt lgkmcnt(0)" ::: "memory"); __builtin_amdgcn_sched_barrier(0);
#define PKV(L, H) (bf16x8){L[0], L[1], L[2], L[3], H[0], H[1], H[2], H[3]}
        o = __builtin_amdgcn_mfma_f32_32x32x16_bf16(PKV(l0, h0), pa, o, 0, 0, 0);
        o = __builtin_amdgcn_mfma_f32_32x32x16_bf16(PKV(l1, h1), pb, o, 0, 0, 0);
#undef PKV
    }
};
template <int NDB, int KB>
__device__ __forceinline__ void pv_half(f32x16 (&o)[NDB], f32x16& ol, int vbase, const bf16x8& pa, const bf16x8& pb) {
    const bf16x8 ones = {16256, 16256, 16256, 16256, 16256, 16256, 16256, 16256};
    ol = __builtin_amdgcn_mfma_f32_32x32x16_bf16(ones, pa, ol, 0, 0, 0);
    ol = __builtin_amdgcn_mfma_f32_32x32x16_bf16(ones, pb, ol, 0, 0, 0);
    PvPart<NDB, KB, 0>::run(o[0], vbase, pa, pb); PvPart<NDB, KB, 1>::run(o[1], vbase, pa, pb);
    if constexpr (NDB == 4) { PvPart<NDB, KB, 2>::run(o[2], vbase, pa, pb); PvPart<NDB, KB, 3>::run(o[3], vbase, pa, pb); }
}
constexpr float ATT_THR = 10.0f;
template <int NDB>
__device__ __forceinline__ void attn_scores(char* lds, int kof, const bf16x8 (&qf)[4], f32x16& s0, f32x16& s1, f32x16 (&o)[NDB], f32x16& ol, f32x16& nm, bool first, int r32, int hi) {
    s0 = nm; s1 = nm;
#pragma unroll
    for (int ds = 0; ds < 4; ++ds) {
        const bf16x8 k0 = *(const bf16x8*)(lds + kof + swz(r32, ds * 2 + hi)), k1 = *(const bf16x8*)(lds + kof + swz(32 + r32, ds * 2 + hi));
        s0 = __builtin_amdgcn_mfma_f32_32x32x16_bf16(k0, qf[ds], s0, 0, 0, 0);
        s1 = __builtin_amdgcn_mfma_f32_32x32x16_bf16(k1, qf[ds], s1, 0, 0, 0);
    }
    float mx = fmaxf(s0[0], s1[0]);
#pragma unroll
    for (int r = 1; r < 16; ++r) mx = fmaxf(fmaxf(mx, s0[r]), s1[r]);
    mx = half_max(mx);
    if (first || __any(mx > ATT_THR)) {
        const float delta = first ? mx : fmaxf(mx, 0.f), alpha = first ? 0.f : __builtin_amdgcn_exp2f(-delta);
#pragma unroll
        for (int r = 0; r < 16; ++r) { s0[r] -= delta; s1[r] -= delta; nm[r] -= delta; ol[r] *= alpha; }
#pragma unroll
        for (int t = 0; t < NDB; ++t)
#pragma unroll
            for (int r = 0; r < 16; ++r) o[t][r] *= alpha;
    }
}
__device__ __forceinline__ void exp_pack(const f32x16& s, bf16x8& pa, bf16x8& pb) {
    float e[16];
#pragma unroll
    for (int r = 0; r < 16; ++r) e[r] = __builtin_amdgcn_exp2f(s[r]);
    u32x4 a = {cvt_pk_vis(e[0], e[1]), cvt_pk_vis(e[2], e[3]), cvt_pk_vis(e[4], e[5]), cvt_pk_vis(e[6], e[7])};
    u32x4 b = {cvt_pk_vis(e[8], e[9]), cvt_pk_vis(e[10], e[11]), cvt_pk_vis(e[12], e[13]), cvt_pk_vis(e[14], e[15])};
    pa = *(bf16x8*)&a; pb = *(bf16x8*)&b;
}

template <int OFF> __device__ __forceinline__ bf16x8 k_read(int a) { bf16x8 r; asm volatile("ds_read_b128 %0, %1 offset:%2" : "=&v"(r) : "v"(a), "i"(OFF) : "memory"); return r; }
struct VSet { s16x4 l0, h0, l1, h1; };
template <int KB, int T> __device__ __forceinline__ void v_issue(VSet& v, int vbase) {
    constexpr int o0 = (KB * 16 + T) * 512, st = 4 * 512;
    v.l0 = tr_read<o0>(vbase); v.h0 = tr_read<o0 + st>(vbase); v.l1 = tr_read<o0 + 2 * st>(vbase); v.h1 = tr_read<o0 + 3 * st>(vbase);
}
#define WAIT_K(n, a, b) asm volatile("s_waitcnt lgkmcnt(" #n ")" : "+v"(a), "+v"(b) :: "memory")
#define WAIT_V(n, v) asm volatile("s_waitcnt lgkmcnt(" #n ")" : "+v"(v.l0), "+v"(v.h0), "+v"(v.l1), "+v"(v.h1) :: "memory")
#define PKV(L, H) (bf16x8){L[0], L[1], L[2], L[3], H[0], H[1], H[2], H[3]}
#define MF32(a, b, c) __builtin_amdgcn_mfma_f32_32x32x16_bf16(a, b, c, 0, 0, 0)
#define SB __builtin_amdgcn_sched_barrier(0)
#define EXP4(src, i, wlo, whi) do { const float e0_ = __builtin_amdgcn_exp2f(src[4 * (i)]), e1_ = __builtin_amdgcn_exp2f(src[4 * (i) + 1]), e2_ = __builtin_amdgcn_exp2f(src[4 * (i) + 2]), e3_ = __builtin_amdgcn_exp2f(src[4 * (i) + 3]); \
        asm("v_add_f32 %0, %1, %0" : "+v"(l2[0]) : "v"(e0_)); asm("v_add_f32 %0, %1, %0" : "+v"(l2[1]) : "v"(e1_)); asm("v_add_f32 %0, %1, %0" : "+v"(l2[0]) : "v"(e2_)); asm("v_add_f32 %0, %1, %0" : "+v"(l2[1]) : "v"(e3_)); \
        wlo = cvt_pk(e0_, e1_); whi = cvt_pk(e2_, e3_); } while (0)
#define EXP2(src, i, w) do { const float e0_ = __builtin_amdgcn_exp2f(src[2 * (i)]), e1_ = __builtin_amdgcn_exp2f(src[2 * (i) + 1]); \
        w = cvt_pk_vis(e0_, e1_); asm("v_add_f32 %0, %1, %0" : "+v"(l2[0]) : "v"(e0_), "v"(w)); asm("v_add_f32 %0, %1, %0" : "+v"(l2[1]) : "v"(e1_), "v"(w)); } while (0)
#define MAX4(i) do { mx = fmaxf(fmaxf(mx, n0[4 * (i)]), n1[4 * (i)]); mx = fmaxf(fmaxf(mx, n0[4 * (i) + 1]), n1[4 * (i) + 1]); \
        mx = fmaxf(fmaxf(mx, n0[4 * (i) + 2]), n1[4 * (i) + 2]); mx = fmaxf(fmaxf(mx, n0[4 * (i) + 3]), n1[4 * (i) + 3]); asm volatile("" : "+v"(mx)); } while (0)
struct DmaPlan { const char* base; unsigned gk, gv; size_t ok3, ok4, ov2, ov3; LAS char* dk3; LAS char* dk4; LAS char* dv2; LAS char* dv3; };
#define DMAP(src, dst) __builtin_amdgcn_global_load_lds((const unsigned*)(src), (LAS unsigned*)(dst), 16, 0, 0)
template <bool DMA>
__device__ __forceinline__ void diff_slot(f32x16& c0, f32x16& c1, f32x16& n0, f32x16& n1, f32x16 (&o)[4], f32x2& l2, f32x16& nm, const bf16x8 (&qf)[4],
                                          int ka0, int ka1, int ka2, int ka3, int vbase, bool has_next, const DmaPlan& dp) {
    constexpr bool HASNEXT = true;
    bf16x8 kA, kB, kC, kD, kE, kF, kG, kH; VSet v4, v5, v6, v7, v8, v9, v10, v11; u32x4 w0, w1, w2, w3;
    float mx = -3.0e38f;
    SB;
    kA = k_read<0>(ka0); kB = k_read<4096>(ka0); kC = k_read<0>(ka1); kD = k_read<4096>(ka1);
    EXP2(c0, 0, w0[0]);
    EXP2(c0, 1, w0[1]);
    WAIT_K(2, kA, kB);
    kE = k_read<0>(ka2); kF = k_read<4096>(ka2);
    n0 = MF32(kA, qf[0], nm); n1 = MF32(kB, qf[0], nm);
    if constexpr (DMA) DMAP(dp.base + dp.ok3 + dp.gk, dp.dk3);
    SB;
    EXP2(c0, 2, w0[2]);
    WAIT_K(2, kC, kD);
    kG = k_read<0>(ka3); kH = k_read<4096>(ka3);
    n0 = MF32(kC, qf[1], n0); n1 = MF32(kD, qf[1], n1);
    if constexpr (DMA) DMAP(dp.base + (dp.ok3 + 128) + dp.gk, dp.dk3 + 8192);
    SB;
    EXP2(c0, 3, w0[3]);
    EXP2(c0, 4, w1[0]);
    WAIT_K(2, kE, kF);
    v4.l0 = tr_read<0>(vbase); v4.h0 = tr_read<2048>(vbase); v4.l1 = tr_read<512>(vbase); v4.h1 = tr_read<2560>(vbase);
    n0 = MF32(kE, qf[2], n0); n1 = MF32(kF, qf[2], n1);
    if constexpr (DMA) DMAP(dp.base + dp.ov2 + dp.gv, dp.dv2);
    SB;
    EXP2(c0, 5, w1[1]);
    WAIT_K(4, kG, kH);
    v5.l0 = tr_read<1024>(vbase); v5.h0 = tr_read<3072>(vbase); v5.l1 = tr_read<1536>(vbase); v5.h1 = tr_read<3584>(vbase);
    n0 = MF32(kG, qf[3], n0); n1 = MF32(kH, qf[3], n1);
    if constexpr (DMA) DMAP(dp.base + (dp.ov2 + 128) + dp.gv, dp.dv2 + 1024);
    SB;
    EXP2(c0, 6, w1[2]);
    EXP2(c0, 7, w1[3]);
    WAIT_V(4, v4);
    v6.l0 = tr_read<4096>(vbase); v6.h0 = tr_read<6144>(vbase); v6.l1 = tr_read<4608>(vbase); v6.h1 = tr_read<6656>(vbase);
    o[0] = MF32(PKV(v4.l0, v4.h0), (*(bf16x8*)&w0), o[0]); o[1] = MF32(PKV(v4.l1, v4.h1), (*(bf16x8*)&w0), o[1]);
    if constexpr (DMA) DMAP(dp.base + dp.ov3 + dp.gv, dp.dv3);
    SB;
    EXP2(c1, 0, w2[0]);
    MAX4(0);
    WAIT_V(4, v5);
    v7.l0 = tr_read<5120>(vbase); v7.h0 = tr_read<7168>(vbase); v7.l1 = tr_read<5632>(vbase); v7.h1 = tr_read<7680>(vbase);
    o[2] = MF32(PKV(v5.l0, v5.h0), (*(bf16x8*)&w0), o[2]); o[3] = MF32(PKV(v5.l1, v5.h1), (*(bf16x8*)&w0), o[3]);
    if constexpr (DMA) DMAP(dp.base + (dp.ov3 + 128) + dp.gv, dp.dv3 + 1024);
    SB;
    EXP2(c1, 1, w2[1]);
    EXP2(c1, 2, w2[2]);
    WAIT_V(4, v6);
    v8.l0 = tr_read<8192>(vbase); v8.h0 = tr_read<10240>(vbase); v8.l1 = tr_read<8704>(vbase); v8.h1 = tr_read<10752>(vbase);
    o[0] = MF32(PKV(v6.l0, v6.h0), (*(bf16x8*)&w1), o[0]); o[1] = MF32(PKV(v6.l1, v6.h1), (*(bf16x8*)&w1), o[1]);
    if constexpr (DMA) DMAP(dp.base + dp.ok4 + dp.gk, dp.dk4);
    SB;
    EXP2(c1, 3, w2[3]);
    MAX4(1);
    WAIT_V(4, v7);
    v9.l0 = tr_read<9216>(vbase); v9.h0 = tr_read<11264>(vbase); v9.l1 = tr_read<9728>(vbase); v9.h1 = tr_read<11776>(vbase);
    o[2] = MF32(PKV(v7.l0, v7.h0), (*(bf16x8*)&w1), o[2]); o[3] = MF32(PKV(v7.l1, v7.h1), (*(bf16x8*)&w1), o[3]);
    if constexpr (DMA) DMAP(dp.base + (dp.ok4 + 128) + dp.gk, dp.dk4 + 8192);
    SB;
    EXP2(c1, 4, w3[0]);
    EXP2(c1, 5, w3[1]);
    WAIT_V(4, v8);
    v10.l0 = tr_read<12288>(vbase); v10.h0 = tr_read<14336>(vbase); v10.l1 = tr_read<12800>(vbase); v10.h1 = tr_read<14848>(vbase);
    o[0] = MF32(PKV(v8.l0, v8.h0), (*(bf16x8*)&w2), o[0]); o[1] = MF32(PKV(v8.l1, v8.h1), (*(bf16x8*)&w2), o[1]);
    SB;
    EXP2(c1, 6, w3[2]);
    EXP2(c1, 7, w3[3]);
    WAIT_V(4, v9);
    v11.l0 = tr_read<13312>(vbase); v11.h0 = tr_read<15360>(vbase); v11.l1 = tr_read<13824>(vbase); v11.h1 = tr_read<15872>(vbase);
    o[2] = MF32(PKV(v9.l0, v9.h0), (*(bf16x8*)&w2), o[2]); o[3] = MF32(PKV(v9.l1, v9.h1), (*(bf16x8*)&w2), o[3]);
    SB;
    MAX4(2);
    WAIT_V(4, v10);
    o[0] = MF32(PKV(v10.l0, v10.h0), (*(bf16x8*)&w3), o[0]); o[1] = MF32(PKV(v10.l1, v10.h1), (*(bf16x8*)&w3), o[1]);
    SB;
    MAX4(3);
    WAIT_V(0, v11);
    o[2] = MF32(PKV(v11.l0, v11.h0), (*(bf16x8*)&w3), o[2]); o[3] = MF32(PKV(v11.l1, v11.h1), (*(bf16x8*)&w3), o[3]);
    SB;
    if (has_next) {
        mx = half_max(mx);
        if (__any(mx > ATT_THR)) {
            const float delta = fmaxf(mx, 0.f), alpha = __builtin_amdgcn_exp2f(-delta);
#pragma unroll
            for (int r = 0; r < 16; ++r) { n0[r] -= delta; n1[r] -= delta; nm[r] -= delta; }
            l2 *= alpha;
#pragma unroll
            for (int t = 0; t < 4; ++t)
#pragma unroll
                for (int r = 0; r < 16; ++r) o[t][r] *= alpha;
        }
    }
}
__device__ __forceinline__ void attn_diff_unit(const Params& p, char* lds_, int h, int qb, float lam) {
    LAS char* lds = (LAS char*)lds_;
    int tid = threadIdx.x; asm volatile("" : "+v"(tid));
    const int lane = tid & 63, w = __builtin_amdgcn_readfirstlane(tid >> 6), r32 = lane & 31, hi = lane >> 5, mp = w >> 2, wq = w & 3;
    const bf16_t* proj = (const bf16_t*)(p.ws + WS_PROJ);
    const int NT = 2 * qb + 2, NP = NT / 2, myNT = (wq < 2) ? NT - 1 : NT;
    bf16x8 qf[4];
    { const bf16_t* qp = proj + (size_t)(qb * 128 + wq * 32 + r32) * INW + C_BQ + h * 128 + mp * 64 + hi * 8;
#pragma unroll
      for (int ds = 0; ds < 4; ++ds) qf[ds] = *(const bf16x8*)(qp + ds * 16); }
    asm volatile("" : "+v"(qf[0]), "+v"(qf[1]), "+v"(qf[2]), "+v"(qf[3]));
    f32x16 o[4] = {}; f32x16 nm; f32x2 l2 = {0.f, 0.f};
    const unsigned gko = (unsigned)((w * 8 + (lane >> 3)) * INW + C_BK + h * 128) * 2u + g2_chunk_off(lane, w);
    const unsigned gvo = (unsigned)((w * 8 + ((lane & 31) >> 2)) * INW + C_BV + h * 128 + (lane >> 5) * 32 + (lane & 3) * 8) * 2u;
    const char* gk = (const char*)proj + gko; const char* gv = (const char*)proj + gvo;
    const int vlane = ((lane & 3) << 3) | (((lane >> 2) & 3) << 6) | (((lane >> 4) & 1) << 5) | (((lane >> 5) & 1) << 8);
    const int ldsb = (int)(uintptr_t)lds_;
    const int kad0 = ldsb + mp * 8192 + swz(r32, 0 + hi), kad1 = ldsb + mp * 8192 + swz(r32, 2 + hi), kad2 = ldsb + mp * 8192 + swz(r32, 4 + hi), kad3 = ldsb + mp * 8192 + swz(r32, 6 + hi);
    constexpr size_t TSTEP = (size_t)64 * INW * 2;
#define DMA_K(t_) do { const int tt_ = (t_); const char* s_ = gk + (size_t)tt_ * TSTEP; LAS char* d_ = lds + (tt_ & 3) * 16384 + w * 1024; \
        __builtin_amdgcn_global_load_lds((const unsigned*)s_, (LAS unsigned*)d_, 16, 0, 0); \
        __builtin_amdgcn_global_load_lds((const unsigned*)(s_ + 128), (LAS unsigned*)(d_ + 8192), 16, 0, 0); } while (0)
#define DMA_V(t_) do { const int tt_ = (t_); const char* s_ = gv + (size_t)tt_ * TSTEP; LAS char* d_ = lds + 65536 + (tt_ & 3) * 16384 + (2 * w) * 1024; \
        __builtin_amdgcn_global_load_lds((const unsigned*)s_, (LAS unsigned*)d_, 16, 0, 0); \
        __builtin_amdgcn_global_load_lds((const unsigned*)(s_ + 128), (LAS unsigned*)(d_ + 1024), 16, 0, 0); } while (0)
    DMA_K(0); DMA_K(1); if (NT > 2) DMA_K(2); DMA_V(0); DMA_V(1);
    __syncthreads();
    f32x16 A0 = {}, A1 = {}, B0 = {}, B1 = {};
    {
#pragma unroll
        for (int ds = 0; ds < 4; ++ds) {
            const bf16x8 k0 = *(const bf16x8*)(lds_ + mp * 8192 + swz(r32, ds * 2 + hi)), k1 = *(const bf16x8*)(lds_ + mp * 8192 + swz(32 + r32, ds * 2 + hi));
            A0 = MF32(k0, qf[ds], A0); A1 = MF32(k1, qf[ds], A1);
        }
        float mx = fmaxf(A0[0], A1[0]);
#pragma unroll
        for (int r = 1; r < 16; ++r) mx = fmaxf(fmaxf(mx, A0[r]), A1[r]);
        mx = half_max(mx);
#pragma unroll
        for (int r = 0; r < 16; ++r) { A0[r] -= mx; A1[r] -= mx; nm[r] = -mx; }
    }
    __syncthreads();
    for (int it = 0; it < NP; ++it) {
        const int t = 2 * it;
        DmaPlan dp;
        dp.base = (const char*)proj; dp.gk = gko; dp.gv = gvo;
        dp.ok3 = (size_t)min(t + 3, NT - 1) * TSTEP; dp.dk3 = lds + ((t + 3) & 3) * 16384 + w * 1024;
        dp.ok4 = (size_t)min(t + 4, NT - 1) * TSTEP; dp.dk4 = lds + ((t + 4) & 3) * 16384 + w * 1024;
        dp.ov2 = (size_t)min(t + 2, NT - 1) * TSTEP; dp.dv2 = lds + 65536 + ((t + 2) & 3) * 16384 + (2 * w) * 1024;
        dp.ov3 = (size_t)min(t + 3, NT - 1) * TSTEP; dp.dv3 = lds + 65536 + ((t + 3) & 3) * 16384 + (2 * w) * 1024;
        { const int ks = ((t + 1) & 3) * 16384, vb_ = ldsb + 65536 + (t & 3) * 16384 + vlane;
          diff_slot<true>(A0, A1, B0, B1, o, l2, nm, qf, kad0 + ks, kad1 + ks, kad2 + ks, kad3 + ks, vb_, t + 1 < myNT, dp); }
        if (t + 1 < myNT) {
            const int ks = ((t + 2) & 3) * 16384, vb_ = ldsb + 65536 + ((t + 1) & 3) * 16384 + vlane;
            diff_slot<false>(B0, B1, A0, A1, o, l2, nm, qf, kad0 + ks, kad1 + ks, kad2 + ks, kad3 + ks, vb_, t + 2 < myNT, dp);
        }
        __syncthreads();
    }
#undef DMA_K
#undef DMA_V
    float* xb = (float*)lds_;
    const float il = 1.0f / half_sum(l2[0] + l2[1]);
    if (mp == 1) {
        const float f = il * *(const float*)(lds_ + LDS_MISC);
#pragma unroll
        for (int t = 0; t < 4; ++t)
#pragma unroll
            for (int r = 0; r < 16; ++r) xb[(wq * 64 + t * 16 + r) * 64 + lane] = o[t][r] * f;
    }
    __syncthreads();
    if (mp == 0) {
        float ss = 0.f;
#pragma unroll
        for (int t = 0; t < 4; ++t)
#pragma unroll
            for (int r = 0; r < 16; ++r) { const float v = o[t][r] * il - xb[(wq * 64 + t * 16 + r) * 64 + lane]; o[t][r] = v; ss += v * v; }
        ss = half_sum(ss);
        const float rs = rsqrtf(ss * (1.0f / 128.0f) + LN_EPS) * 0.8f;
        bf16_t* op = (bf16_t*)(p.ws + WS_ATT) + (size_t)(qb * 128 + wq * 32 + r32) * D + 512 + h * 128;
#pragma unroll
        for (int t = 0; t < 4; ++t)
#pragma unroll
            for (int rp = 0; rp < 2; ++rp) {
                unsigned pk[2][2];
#pragma unroll
                for (int a = 0; a < 2; ++a) {
                    const int rr = 2 * rp + a, dv0 = 32 * t + 8 * rr + 4 * hi;
                    const f32x4 gg = *(const f32x4*)(p.subg + dv0);
                    pk[a][0] = cvt_pk(o[t][4 * rr] * rs * gg[0], o[t][4 * rr + 1] * rs * gg[1]); pk[a][1] = cvt_pk(o[t][4 * rr + 2] * rs * gg[2], o[t][4 * rr + 3] * rs * gg[3]);
                }
                const auto s0 = __builtin_amdgcn_permlane32_swap(pk[0][0], pk[1][0], false, false), s1 = __builtin_amdgcn_permlane32_swap(pk[0][1], pk[1][1], false, false);
                *(u32x4*)(op + 32 * t + 8 * (2 * rp + hi)) = (u32x4){s0[0], s1[0], s0[1], s1[1]};
            }
    }
    __syncthreads();
}
#undef DMAP
#undef WAIT_K
#undef WAIT_V
#undef PKV
#undef MF32
#undef SB
#undef EXP4
#undef EXP2
#undef MAX4
__device__ __forceinline__ void attn_swa_unit(const Params& p, char* lds, int kvh, int n) {
    int tid = threadIdx.x; asm volatile("" : "+v"(tid));
    const int lane = tid & 63, w = __builtin_amdgcn_readfirstlane(tid >> 6), r32 = lane & 31, hi = lane >> 5, g = w >> 1, hq = kvh * 4 + g;
    const bf16_t* proj = (const bf16_t*)(p.ws + WS_PROJ);
    const int c0 = (n >= 2) ? n - 2 : 0, NT = n - c0 + 1;
    const int tok = n * 64 + (w & 1) * 32 + r32;
    bf16x8 qf[4];
    { const bf16_t* qp = proj + (size_t)tok * INW + C_AQ + hq * 64 + hi * 8;
#pragma unroll
      for (int ds = 0; ds < 4; ++ds) qf[ds] = *(const bf16x8*)(qp + ds * 16); }
    f32x16 o[2] = {}; f32x16 ol, nm;
    { float ms = -p.sinks[hq] * LOG2E; asm volatile("" : "+v"(qf[0]), "+v"(qf[1]), "+v"(qf[2]), "+v"(qf[3]), "+v"(ms));
#pragma unroll
      for (int r = 0; r < 16; ++r) { nm[r] = ms; ol[r] = 1.0f; } }
    const bf16_t* gk = proj + (size_t)(c0 * 64 + (tid >> 3)) * INW + C_AK + kvh * 64 + (tid & 7) * 8;
    const bf16_t* gv = proj + (size_t)(c0 * 64 + (tid >> 3)) * INW + C_AV + kvh * 64 + (tid & 7) * 8;
    const int wk = swz(tid >> 3, tid & 7), wv = v_off(tid >> 3, (tid & 7) * 8, 2);
    const int vlane = ((lane & 3) << 3) | (((lane >> 2) & 3) << 6) | (((lane >> 4) & 1) << 5) | (((lane >> 5) & 1) << 8);
    u32x4 st0, st1;
#define W_LOAD(t) do { const size_t ko = (size_t)(t) * 64 * INW; st0 = *(const u32x4*)(gk + ko); st1 = *(const u32x4*)(gv + ko); } while (0)
#define W_WRITE(b) do { char* sb = lds + (b) * AT_STAGE; *(u32x4*)(sb + wk) = st0; *(u32x4*)(sb + 8192 + wv) = st1; } while (0)
    W_LOAD(0); W_WRITE(0); __syncthreads();
    for (int t = 0; t < NT; ++t) {
        const int b = t & 1;
        if (t + 1 < NT) W_LOAD(t + 1);
        { f32x16 s0, s1; bf16x8 p0, p1, p2, p3; const int vb_ = (int)(uintptr_t)(lds + b * AT_STAGE + 8192) + vlane;
          attn_scores<2>(lds, b * AT_STAGE, qf, s0, s1, o, ol, nm, false, r32, hi);
          exp_pack(s0, p0, p1); pv_half<2, 0>(o, ol, vb_, p0, p1); exp_pack(s1, p2, p3); pv_half<2, 1>(o, ol, vb_, p2, p3); }
        if (t + 1 < NT) W_WRITE(b ^ 1);
        __syncthreads();
    }
#undef W_LOAD
#undef W_WRITE
    const float il = 1.0f / ol[0];
    bf16_t* op = (bf16_t*)(p.ws + WS_ATT) + (size_t)tok * D + hq * 64;
#pragma unroll
    for (int t = 0; t < 2; ++t)
#pragma unroll
        for (int rp = 0; rp < 2; ++rp) {
            unsigned pk[2][2];
#pragma unroll
            for (int a = 0; a < 2; ++a) { const int rr = 2 * rp + a; pk[a][0] = cvt_pk(o[t][4 * rr] * il, o[t][4 * rr + 1] * il); pk[a][1] = cvt_pk(o[t][4 * rr + 2] * il, o[t][4 * rr + 3] * il); }
            const auto s0 = __builtin_amdgcn_permlane32_swap(pk[0][0], pk[1][0], false, false), s1 = __builtin_amdgcn_permlane32_swap(pk[0][1], pk[1][1], false, false);
            *(u32x4*)(op + 32 * t + 8 * (2 * rp + hi)) = (u32x4){s0[0], s1[0], s0[1], s1[1]};
        }
}
__device__ __forceinline__ void phase_attn(const Params& p, char* lds, int vb, int G) {
    const int lane = threadIdx.x & 63;
    const float d1 = wave_sum(p.lq1[lane] * p.lk1[lane]), d2 = wave_sum(p.lq2[lane] * p.lk2[lane]);
    if (threadIdx.x == 0) *(float*)(lds + LDS_MISC) = expf(d1) - expf(d2) + 0.2f;
    __syncthreads();
    const float lam = 0.f;
    for (int u = vb; u < 1024; u += G) {
        if (u < 512) attn_diff_unit(p, lds, (u & 255) >> 6, (u < 256) ? 127 - (u & 63) : (u & 63), lam);
        else attn_swa_unit(p, lds, (u - 512) >> 8, (u - 512) & 255);
    }
}

struct EpiPreLn {
    const float* x; float* out; int row0, col0;
    __device__ __forceinline__ void operator()(f32x4 (&acc)[8][4], int wr, int wc, int fr, int fq) const {
        f32x4 xa[4], xb_[4];
        const size_t rbase = (size_t)(row0 + wr * 128 + fr) * D + col0 + wc * 64 + 4 * fq;
#pragma unroll
        for (int nt = 0; nt < 4; ++nt) xa[nt] = *(const f32x4*)(x + rbase + nt * 16);
#pragma unroll
        for (int mt = 0; mt < 8; ++mt) {
            const size_t ro = rbase + (size_t)mt * 16 * D;
            if (mt + 1 < 8) {
#pragma unroll
                for (int nt = 0; nt < 4; ++nt) { if (mt & 1) xa[nt] = *(const f32x4*)(x + ro + (size_t)16 * D + nt * 16); else xb_[nt] = *(const f32x4*)(x + ro + (size_t)16 * D + nt * 16); }
            }
#pragma unroll
            for (int nt = 0; nt < 4; ++nt) { const f32x4 xv = (mt & 1) ? xb_[nt] : xa[nt]; *(f32x4*)(out + ro + nt * 16) = xv * ALPHA + acc[mt][nt]; }
        }
    }
};
__device__ __forceinline__ void phase_wout(const Params& p, char* lds, int vb, int G) {
    for (int u = vb; u < (S / 256) * 4; u += G) {
        const int tm = u >> 2, tn = u & 3;
        G2Args g; g.A = (const char*)(p.ws + WS_ATT); g.B = (const char*)(p.ws + WS_WOUT); g.nk = D / 64; g.akstep = 128;
        g2_rows_A<8>(g, (size_t)tm * 256, D * 2); g2_rows_B(g, (size_t)tn * 256, D * 2);
        EpiPreLn e{p.x, (float*)(p.ws + WS_PRELN), tm * 256, tn * 256};
        gemm2<8>(lds, g, e);
    }
}

struct EpiLogits {
    float* L;
    __device__ __forceinline__ void operator()(f32x4 (&acc)[4][4], int wr, int wc, int fr, int fq) const {
#pragma unroll
        for (int mt = 0; mt < 4; ++mt)
#pragma unroll
            for (int nt = 0; nt < 4; ++nt) *(f32x4*)(L + (wr * 64 + mt * 16 + fr) * 256 + wc * 64 + nt * 16 + 4 * fq) = acc[mt][nt];
    }
};
__device__ __forceinline__ void phase_router(const Params& p, char* lds, int vb, int G) {
    const int tid = threadIdx.x, lane = tid & 63, w = tid >> 6;
    const float* preln = (const float*)(p.ws + WS_PRELN);
    bf16_t* x1b = (bf16_t*)(p.ws + WS_X1B);
    unsigned* cnt = (unsigned*)(p.ws + WS_CTL + 65536); int* list = (int*)(p.ws + WS_LIST); float* gates = (float*)(p.ws + WS_GATE);
    for (int u = vb; u < S / 64; u += G) {
        {
            f32x4 v[8][4]; float sm[8], sq[8];
#pragma unroll
            for (int i = 0; i < 8; ++i) { const f32x4* xr = (const f32x4*)(preln + (size_t)(u * 64 + w * 8 + i) * D) + lane;
#pragma unroll
                for (int j = 0; j < 4; ++j) v[i][j] = xr[64 * j]; }
#pragma unroll
            for (int i = 0; i < 8; ++i) { float s = 0.f;
#pragma unroll
                for (int j = 0; j < 4; ++j) s += (v[i][j][0] + v[i][j][1]) + (v[i][j][2] + v[i][j][3]);
                sm[i] = s; }
#pragma unroll
            for (int o = 1; o < 64; o <<= 1) {
#pragma unroll
                for (int i = 0; i < 8; ++i) sm[i] += __shfl_xor(sm[i], o); }
#pragma unroll
            for (int i = 0; i < 8; ++i) { const float mean = sm[i] * (1.0f / D); float s2 = 0.f;
#pragma unroll
                for (int j = 0; j < 4; ++j) { v[i][j] = v[i][j] - mean; s2 += (v[i][j][0] * v[i][j][0] + v[i][j][1] * v[i][j][1]) + (v[i][j][2] * v[i][j][2] + v[i][j][3] * v[i][j][3]); }
                sq[i] = s2; }
#pragma unroll
            for (int o = 1; o < 64; o <<= 1) {
#pragma unroll
                for (int i = 0; i < 8; ++i) sq[i] += __shfl_xor(sq[i], o); }
#pragma unroll
            for (int j = 0; j < 4; ++j) {
                const f32x4 gg = *((const f32x4*)p.ln1g + lane + 64 * j), bb = *((const f32x4*)p.ln1b + lane + 64 * j);
#pragma unroll
                for (int i = 0; i < 8; ++i) {
                    const int row = u * 64 + w * 8 + i;
                    const float rstd = rsqrtf(sq[i] * (1.0f / D) + LN_EPS);
                    const f32x4 y = v[i][j] * rstd * gg + bb;
                    u32x2 pk = {cvt_pk(y[0], y[1]), cvt_pk(y[2], y[3])};
                    *(u32x2*)(x1b + ((size_t)((lane >> 4) + 4 * j) * S + row) * 64 + ((4 * lane) & 63)) = pk;
                }
            }
        }
        asm volatile("s_waitcnt vmcnt(0)" ::: "memory");
        __syncthreads();
        { G2Args g; g.A = (const char*)x1b; g.B = (const char*)(p.ws + WS_WR); g.nk = D / 64; g.akstep = S * 128;
          g2_rows_A<4>(g, (size_t)u * 64, 128); g.offA[1] = g.offA[0]; g2_rows_B(g, 0, D * 2);
          EpiLogits e{(float*)lds};
          gemm2<4>(lds, g, e); }
        __syncthreads();
        const f32x4 rb = *((const f32x4*)p.r_bias + lane);
        const float NEG = -__builtin_inff();
        for (int i0 = 0; i0 < 8; i0 += 4) {
            float sc[4][4], cand[4][4]; int my_e[4]; float my_s[4], gsum[4];
#pragma unroll
            for (int q = 0; q < 4; ++q) {
                const int tl = w * 8 + i0 + q;
                const f32x4 lg = *((const f32x4*)((const float*)lds + tl * 256) + lane);
#pragma unroll
                for (int j = 0; j < 4; ++j) { sc[q][j] = 1.0f / (1.0f + __expf(-lg[j])); cand[q][j] = sc[q][j] + rb[j]; }
                my_e[q] = 0; my_s[q] = 0.f; gsum[q] = 0.f;
            }
            float a1[4], a2[4];
#pragma unroll
            for (int q = 0; q < 4; ++q) { const float m01 = fmaxf(cand[q][0], cand[q][1]), n01 = fminf(cand[q][0], cand[q][1]), m23 = fmaxf(cand[q][2], cand[q][3]), n23 = fminf(cand[q][2], cand[q][3]);
              a1[q] = fmaxf(m01, m23); a2[q] = fmaxf(fminf(m01, m23), fmaxf(n01, n23)); }
#pragma unroll
            for (int off = 1; off < 8; off <<= 1) {
#pragma unroll
                for (int q = 0; q < 4; ++q) { const float b1 = __shfl_xor(a1[q], off), b2 = __shfl_xor(a2[q], off); const float n1 = fmaxf(a1[q], b1), n2 = fmaxf(fminf(a1[q], b1), fmaxf(a2[q], b2)); a1[q] = n1; a2[q] = n2; }
            }
            const int mygrp = lane >> 3;
#pragma unroll
            for (int q = 0; q < 4; ++q) {
                const float gs = a1[q] + a2[q]; int rank = 0;
#pragma unroll
                for (int g2 = 0; g2 < 8; ++g2) { const float v = __shfl(gs, g2 * 8); rank += (v > gs || (v == gs && g2 < mygrp)) ? 1 : 0; }
                if (rank >= 4) {
#pragma unroll
                    for (int j = 0; j < 4; ++j) cand[q][j] = NEG;
                }
            }
#pragma unroll
            for (int k = 0; k < 8; ++k) {
                float bv[4]; int idx[4];
#pragma unroll
                for (int q = 0; q < 4; ++q) { bv[q] = cand[q][0]; int bi = 0;
#pragma unroll
                    for (int j = 1; j < 4; ++j) if (cand[q][j] > bv[q]) { bv[q] = cand[q][j]; bi = j; }
                    idx[q] = 4 * lane + bi; }
#pragma unroll
                for (int off = 32; off >= 1; off >>= 1) {
#pragma unroll
                    for (int q = 0; q < 4; ++q) { const float ov = __shfl_xor(bv[q], off); const int oi = __shfl_xor(idx[q], off); if (ov > bv[q] || (ov == bv[q] && oi < idx[q])) { bv[q] = ov; idx[q] = oi; } }
                }
#pragma unroll
                for (int q = 0; q < 4; ++q) {
                    const int owner = idx[q] >> 2, sub = idx[q] & 3;
                    float scv = sc[q][0];
#pragma unroll
                    for (int j = 1; j < 4; ++j) scv = (sub == j) ? sc[q][j] : scv;
                    if (lane == owner) {
#pragma unroll
                        for (int j = 0; j < 4; ++j) if (sub == j) cand[q][j] = NEG;
                    }
                    const float gsc = __shfl(scv, owner);
                    if (lane == k) { my_e[q] = idx[q]; my_s[q] = gsc; }
                    gsum[q] += gsc;
                }
            }
            if (lane < 8) {
#pragma unroll
                for (int q = 0; q < 4; ++q) {
                    const int t = u * 64 + w * 8 + i0 + q;
                    const float gate = my_s[q] / gsum[q] * 2.5f;
                    const unsigned pos = atomicAdd(cnt + my_e[q] * CNT_STRIDE, 1u);
                    list[(size_t)my_e[q] * CAP + pos] = t * 8 + lane;
                    gates[t * 8 + lane] = gate;
                }
            }
        }
        __syncthreads();
    }
}

#ifndef MOE_MT
#define MOE_MT 8
#endif
constexpr int MOE_BM = 32 * MOE_MT;
struct EpiAct {
    bf16_t* act; const int* slots;
    __device__ __forceinline__ void operator()(f32x4 (&acc)[MOE_MT][4], int pass, int wr, int wc, int fr, int fq) const {
        const int ncol0 = pass * 128;
#pragma unroll
        for (int mt = 0; mt < MOE_MT; ++mt) {
            const int ar = slots[wr * 16 * MOE_MT + mt * 16 + fr];
            if (ar >= 0) {
                float a[8];
#pragma unroll
                for (int nt = 0; nt < 2; ++nt)
#pragma unroll
                    for (int j = 0; j < 4; ++j) { const float gq = acc[mt][nt][j]; a[nt * 4 + j] = gq / (1.0f + __expf(-gq)) * (acc[mt][nt + 2][j]); }
                u32x4 pk = {cvt_pk(a[0], a[1]), cvt_pk(a[2], a[3]), cvt_pk(a[4], a[5]), cvt_pk(a[6], a[7])};
                *(u32x4*)(act + (size_t)ar * FF + ncol0 + wc * 32 + 8 * fq) = pk;
            }
        }
    }
};
struct EpiY {
    bf16_t* y; const int* yrows; const float* gl;
    __device__ __forceinline__ void operator()(f32x4 (&acc)[MOE_MT][4], int pass, int wr, int wc, int fr, int fq) const {
        const int col0 = pass * 256;
#pragma unroll
        for (int mt = 0; mt < MOE_MT; ++mt) {
            const int r = wr * 16 * MOE_MT + mt * 16 + fr, yr = yrows[r];
            if (yr >= 0) {
                const float gt = gl[r];
#pragma unroll
                for (int a = 0; a < 2; ++a) {
                    const f32x4 v0 = acc[mt][2 * a] * gt, v1 = acc[mt][2 * a + 1] * gt;
                    u32x4 pk = {cvt_pk(v0[0], v0[1]), cvt_pk(v0[2], v0[3]), cvt_pk(v1[0], v1[1]), cvt_pk(v1[2], v1[3])};
                    *(u32x4*)(y + (size_t)yr * D + col0 + wc * 64 + a * 32 + 8 * fq) = pk;
                }
            }
        }
    }
};
__device__ __forceinline__ void phase_experts(const Params& p, char* lds, int vb, int G) {
    const int tid0 = threadIdx.x, w = __builtin_amdgcn_readfirstlane(tid0 >> 6);
    const unsigned* cnt = (const unsigned*)(p.ws + WS_CTL + 65536); const int* list = (const int*)(p.ws + WS_LIST); const float* gates = (const float*)(p.ws + WS_GATE);
    bf16_t* act = (bf16_t*)(p.ws + WS_ACT); bf16_t* ybuf = (bf16_t*)(p.ws + WS_Y);
    int* nts = (int*)(lds + LDS_MISC); int* pre = nts + 256;
    int* s_arow = pre + 260; int* s_yrow = s_arow + MOE_BM; int* s_tok = s_yrow + MOE_BM; float* s_gate = (float*)(s_tok + MOE_BM);
    if (tid0 < 256) nts[tid0] = (int)((__hip_atomic_load(cnt + tid0 * CNT_STRIDE, __ATOMIC_RELAXED, __HIP_MEMORY_SCOPE_AGENT) + (MOE_BM - 1)) / MOE_BM);
    __syncthreads();
    if (tid0 < 257) { int s = 0; for (int e = 0; e < tid0; ++e) s += nts[e]; pre[tid0] = s; }
    __syncthreads();
    const int NR = __builtin_amdgcn_readfirstlane(pre[256]), NU = NR + S / MOE_BM;
    for (int u = vb; u < NU; u += G) {
        __syncthreads();
        int tid = threadIdx.x; asm volatile("" : "+v"(tid));
        const int lane = tid & 63; const unsigned co = g2_chunk_off(lane, w);
        const float *bg, *bu, *bd;
        if (u < NR) {
            int lo = 0, hi = 255;
            while (lo < hi) { const int mid = (lo + hi + 1) >> 1; if (pre[mid] <= u) lo = mid; else hi = mid - 1; }
            const int e = lo, tile = u - pre[e], n = (int)__hip_atomic_load(cnt + e * CNT_STRIDE, __ATOMIC_RELAXED, __HIP_MEMORY_SCOPE_AGENT);
            if (tid < MOE_BM) {
                const int idx = tile * MOE_BM + tid;
                if (idx < n) { const int slot = list[(size_t)e * CAP + idx]; s_arow[tid] = slot; s_yrow[tid] = slot + (slot >> 3); s_tok[tid] = slot >> 3; s_gate[tid] = gates[slot]; }
                else { s_arow[tid] = -1; s_yrow[tid] = -1; s_tok[tid] = 0; s_gate[tid] = 0.f; }
            }
            bg = p.w_g + (size_t)e * D * FF; bu = p.w_u + (size_t)e * D * FF; bd = p.w_d + (size_t)e * FF * D;
        } else {
            const int tile = u - NR;
            if (tid < MOE_BM) { const int tk = tile * MOE_BM + tid; s_arow[tid] = S * 8 + tk; s_yrow[tid] = tk * 9 + 8; s_tok[tid] = tk; s_gate[tid] = 1.0f; }
            bg = p.ws_g; bu = p.ws_u; bd = p.ws_d;
        }
        __syncthreads();
        { G3fArgs g; g.A = (const char*)(p.ws + WS_X1B); g.nk = D / 64; g.akstep = S * 128;
#pragma unroll
          for (int i = 0; i < MOE_MT / 2; ++i) g.offA[i] = (unsigned)s_tok[i * 64 + w * 8 + (lane >> 3)] * 128u + co;
          { const int bwc = lane >> 4, nt = (lane >> 2) & 3, bfq = lane & 3;
            g.b = ((nt < 2) ? bg : bu) + bwc * 32 + 8 * bfq + 4 * (nt & 1) + (size_t)(w * 8) * FF; }
          EpiAct e{act, s_arow};
          gemm3f<MOE_MT, FF>(lds, g, 2, 128, e); }
        asm volatile("s_waitcnt vmcnt(0)" ::: "memory");
        __syncthreads();
        { G3fArgs g; g.A = (const char*)act; g.nk = FF / 64; g.akstep = 128;
#pragma unroll
          for (int i = 0; i < MOE_MT / 2; ++i) { const int ar = s_arow[i * 64 + w * 8 + (lane >> 3)]; g.offA[i] = (unsigned)(ar < 0 ? 0 : ar) * (unsigned)(FF * 2) + co; }
          g.b = bd + (size_t)(w * 8) * D + (lane >> 4) * 64 + (((lane >> 2) & 3) >> 1) * 32 + 8 * (lane & 3) + 4 * ((lane >> 2) & 1);
          EpiY e{ybuf, s_yrow, s_gate};
          gemm3f<MOE_MT, D>(lds, g, 4, 256, e); }
    }
}

__device__ __forceinline__ void phase_final(const Params& p, int vb, int G) {
    const int lane = threadIdx.x & 63, w = threadIdx.x >> 6;
    const bf16_t* x1b = (const bf16_t*)(p.ws + WS_X1B); const bf16_t* ybuf = (const bf16_t*)(p.ws + WS_Y);
    const int stride = G * 8;
#define F_LOAD(q, row) do { \
        _Pragma("unroll") for (int j = 0; j < 2; ++j) q[j] = *(const u32x4*)(x1b + ((size_t)((lane >> 3) + 8 * j) * S + (row)) * 64 + ((8 * lane) & 63)); \
        _Pragma("unroll") for (int k = 0; k < 9; ++k) { const u32x4* yr = (const u32x4*)(ybuf + (size_t)((row) * 9 + k) * D) + lane; q[2 + 2 * k] = yr[0]; q[3 + 2 * k] = yr[64]; } } while (0)
#define F_PROC(q, row) do { float v[2][8]; \
        _Pragma("unroll") for (int j = 0; j < 2; ++j) _Pragma("unroll") for (int e = 0; e < 4; ++e) { v[j][2 * e] = bf_lo(q[j][e]) * ALPHA; v[j][2 * e + 1] = bf_hi(q[j][e]) * ALPHA; } \
        _Pragma("unroll") for (int k = 0; k < 9; ++k) _Pragma("unroll") for (int j = 0; j < 2; ++j) _Pragma("unroll") for (int e = 0; e < 4; ++e) { v[j][2 * e] += bf_lo(q[2 + 2 * k + j][e]); v[j][2 * e + 1] += bf_hi(q[2 + 2 * k + j][e]); } \
        float sm = 0.f; \
        _Pragma("unroll") for (int j = 0; j < 2; ++j) _Pragma("unroll") for (int e = 0; e < 8; ++e) sm += v[j][e]; \
        sm = wave_sum(sm); \
        const float mean = sm * (1.0f / D); float sq = 0.f; \
        _Pragma("unroll") for (int j = 0; j < 2; ++j) _Pragma("unroll") for (int e = 0; e < 8; ++e) { v[j][e] -= mean; sq += v[j][e] * v[j][e]; } \
        sq = wave_sum(sq); \
        const float rstd = rsqrtf(sq * (1.0f / D) + LN_EPS); \
        _Pragma("unroll") for (int j = 0; j < 2; ++j) { \
            const f32x4 g0 = *((const f32x4*)p.ln2g + 2 * lane + 128 * j), g1 = *((const f32x4*)p.ln2g + 2 * lane + 128 * j + 1); \
            const f32x4 b0 = *((const f32x4*)p.ln2b + 2 * lane + 128 * j), b1 = *((const f32x4*)p.ln2b + 2 * lane + 128 * j + 1); \
            f32x4* op = (f32x4*)(p.out + (size_t)(row) * D) + 2 * lane + 128 * j; \
            op[0] = (f32x4){v[j][0], v[j][1], v[j][2], v[j][3]} * rstd * g0 + b0; \
            op[1] = (f32x4){v[j][4], v[j][5], v[j][6], v[j][7]} * rstd * g1 + b1; } } while (0)
    u32x4 qa[20], qb[20];
    int row = vb * 8 + w;
    if (row < S) F_LOAD(qa, row);
    for (; row < S; row += 2 * stride) {
        const bool n1 = row + stride < S, n2 = row + 2 * stride < S;
        if (n1) F_LOAD(qb, row + stride);
        __builtin_amdgcn_sched_barrier(0);
        F_PROC(qa, row);
        if (n1) {
            if (n2) F_LOAD(qa, row + 2 * stride);
            __builtin_amdgcn_sched_barrier(0);
            F_PROC(qb, row + stride);
        }
    }
#undef F_LOAD
#undef F_PROC
}

__global__ void __launch_bounds__(NTHREADS) mega(Params p) {
    extern __shared__ __attribute__((aligned(16))) char lds[];
    const int G = gridDim.x, bx = blockIdx.x;
    const int vb = (G % 8 == 0) ? (bx % 8) * (G / 8) + bx / 8 : bx;
    if (threadIdx.x < 4) ((volatile LAS unsigned*)((LAS char*)lds + LDS_BARST))[threadIdx.x] = 0u;
    __syncthreads();
    XcdBarrier bar; bar.bar = (unsigned*)(p.ws + WS_CTL) + CW_BAR; bar.x = 0; bar.st = nullptr;
    if (p.ph_hi - p.ph_lo > 1) bar = xcd_barrier_post((unsigned*)(p.ws + WS_CTL) + CW_BAR, (volatile LAS unsigned*)((LAS char*)lds + LDS_BARST));
#define SEAM(k) do { if (p.ph_lo <= (k) && (k) + 1 < p.ph_hi) { xcd_barrier(bar); } } while (0)
#define IN(k) (p.ph_lo <= (k) && (k) < p.ph_hi)
#define RUN(k, call) do { if (IN(k)) { call; if (MK_REPEAT == (k)) { __syncthreads(); call; } } } while (0)
    RUN(0, phase_prep(p, vb, G)); SEAM(0);
    RUN(1, phase_proj(p, lds, vb, G)); SEAM(1);
    RUN(2, phase_attn(p, lds, vb, G)); SEAM(2);
    RUN(3, phase_wout(p, lds, vb, G)); SEAM(3);
    if (IN(4)) { phase_router(p, lds, vb, G); } SEAM(4);
    RUN(5, phase_experts(p, lds, vb, G)); SEAM(5);
    RUN(6, phase_final(p, vb, G));
#undef SEAM
#undef IN
#undef RUN
}

extern "C" void kernel_launch(void* const* d_in, const int* in_sizes, int n_in, void* d_out, int out_size, void* d_ws, size_t ws_size, hipStream_t stream) {
    static int grid = 0;
    if (grid == 0) {
        if (n_in != 22 || in_sizes[0] != S * D || out_size != S * D || ws_size < WS_END) {
            fprintf(stderr, "kernel_launch: unexpected shapes: n_in %d in0 %d out %d ws %zu (need %zu)\n", n_in, n_in > 0 ? in_sizes[0] : -1, out_size, ws_size, (size_t)WS_END); grid = -1; return; }
        int dev = 0, cus = 0, per_cu = 0;
        (void)hipGetDevice(&dev); (void)hipDeviceGetAttribute(&cus, hipDeviceAttributeMultiprocessorCount, dev);
        if (hipFuncSetAttribute((const void*)mega, hipFuncAttributeMaxDynamicSharedMemorySize, LDS_BYTES) != hipSuccess) { fprintf(stderr, "kernel_launch: hipFuncSetAttribute failed\n"); grid = -1; return; }
        (void)hipOccupancyMaxActiveBlocksPerMultiprocessor(&per_cu, (const void*)mega, NTHREADS, LDS_BYTES);
        if (per_cu < 1) { fprintf(stderr, "kernel_launch: occupancy query says %d blocks per CU\n", per_cu); per_cu = 1; }
        grid = cus * 1;
        (void)hipGetLastError();
    }
    if (grid < 0) return;
    (void)hipMemsetAsync((char*)d_ws + WS_CTL, 0, CTL_BYTES, stream);
    Params p{};
    const float** f = (const float**)&p;
    for (int i = 0; i < 22; ++i) f[i] = (const float*)d_in[i];
    p.out = (float*)d_out; p.ws = (unsigned char*)d_ws;
#if MK_ONE_LAUNCH
    p.ph_lo = 0; p.ph_hi = 7;
    void* args[] = {&p};
    hipError_t e = hipLaunchCooperativeKernel((const void*)mega, dim3(grid), dim3(NTHREADS), args, LDS_BYTES, stream);
    if (e != hipSuccess) fprintf(stderr, "kernel_launch: cooperative launch failed: %s (grid %d)\n", hipGetErrorString(e), grid);
#else
    for (int ph = 0; ph < 7; ++ph) {
        p.ph_lo = ph; p.ph_hi = ph + 1;
        hipLaunchKernelGGL(mega, dim3(grid), dim3(NTHREADS), LDS_BYTES, stream, p);
    }
#endif
}
```

```cpp
#include <hip/hip_runtime.h>
#include <hip/hip_cooperative_groups.h>
#include <cstdio>
#include <cstdint>
namespace cg = cooperative_groups;

#ifndef MK_REPEAT
#define MK_REPEAT -1
#endif
#ifndef MK_ONE_LAUNCH
#define MK_ONE_LAUNCH 1
#endif

constexpr int S = 16384, D = 1024, INW = 2304, NE = 256, FF = 256;
constexpr int NTHREADS = 512;
constexpr int CAP = 16384;
constexpr float ALPHA = 1.189207115002721f;
constexpr float LN_EPS = 1e-5f;
constexpr float QSCALE = 0.125f * 1.4426950408889634f;
constexpr float LOG2E = 1.4426950408889634f;
constexpr int C_AQ = 0, C_AK = 512, C_AV = 640, C_BQ = 768, C_BK = 1280, C_BV = 1792;

constexpr size_t MiB = 1ull << 20;
constexpr size_t WS_CTL = 0;
constexpr size_t CTL_BYTES = 128 * 1024;
constexpr int CNT_STRIDE = 64;
constexpr size_t WS_ROPE = 1 * MiB;
constexpr size_t WS_WIN = 8 * MiB;
constexpr size_t WS_WOUT = 13 * MiB;
constexpr size_t WS_WR = 15 * MiB;
constexpr size_t WS_WSGU = 16 * MiB;
constexpr size_t WS_WSD = 17 * MiB;
constexpr size_t WS_EGU = 20 * MiB;
constexpr size_t WS_ED = 276 * MiB;
constexpr size_t WS_X1F = 404 * MiB;
constexpr size_t WS_X1B = 468 * MiB;
constexpr size_t WS_LIST = 500 * MiB;
constexpr size_t WS_GATE = 516 * MiB;
constexpr size_t WS_ACT = 518 * MiB;
constexpr size_t WS_Y = 590 * MiB;
constexpr size_t WS_XB = 590 * MiB;
constexpr size_t WS_PROJ = 622 * MiB;
constexpr size_t WS_ATT = 694 * MiB;
constexpr size_t WS_PRELN = 726 * MiB;
constexpr size_t WS_END = 878 * MiB;

constexpr int LDS_BYTES = 147456;
constexpr int LDS_MISC = 131072;

typedef unsigned short bf16_t;
typedef short bf16x8 __attribute__((ext_vector_type(8)));
typedef short s16x4 __attribute__((ext_vector_type(4)));
typedef float f32x4 __attribute__((ext_vector_type(4)));
typedef float f32x16 __attribute__((ext_vector_type(16)));
typedef unsigned u32x4 __attribute__((ext_vector_type(4)));
typedef unsigned u32x2 __attribute__((ext_vector_type(2)));
typedef float f32x2 __attribute__((ext_vector_type(2)));


#define LAS __attribute__((address_space(3)))
#define XB_TMO      128
#define XB_XCNT(j)  (256  + 64 * (j))
#define XB_XSUB(j)  (1280 + 64 * (j))
#define XB_XGEN(j)  (2304 + 64 * (j))
#define XB_TOP      3328
#define XB_TOPGEN   3392
#define XCD_BAR_WORDS 3456
#define XB_SPIN_CAP (1u << 18)
__device__ __forceinline__ unsigned xb_ld(unsigned* p)              { return __hip_atomic_load(p, __ATOMIC_RELAXED, __HIP_MEMORY_SCOPE_AGENT); }
__device__ __forceinline__ unsigned xb_add(unsigned* p, unsigned v) { return __hip_atomic_fetch_add(p, v, __ATOMIC_RELAXED, __HIP_MEMORY_SCOPE_AGENT); }
__device__ __forceinline__ unsigned xb_xcc_id() { return (unsigned)__builtin_amdgcn_s_getreg((3 << 11) | 20) & 0xFu; }
#define XB_SPIN(cond, bar) do { unsigned _sp = 0; while (cond) { __builtin_amdgcn_s_sleep(1); \
    if ((++_sp & 255u) == 0u) { if (xb_ld(&(bar)[XB_TMO])) break; if (_sp > XB_SPIN_CAP) { atomicAdd(&(bar)[XB_TMO], 1u); break; } } } } while (0)
struct XcdBarrier { unsigned* bar; unsigned x; volatile LAS unsigned* st; };
__device__ __forceinline__ XcdBarrier xcd_barrier_post(unsigned* bar, volatile LAS unsigned* st) {
    XcdBarrier b; b.bar = bar; b.x = xb_xcc_id(); b.st = st;
    if (threadIdx.x == 0) (void)xb_add(&bar[XB_XCNT(b.x)], 1u);
    return b;
}
__device__ __forceinline__ void xcd_barrier_complete(unsigned* bar, unsigned x, unsigned& nloc, unsigned& nx) {
    const unsigned G = gridDim.x * gridDim.y * gridDim.z;
    unsigned sum, cnt, mine, sp = 0u;
    for (;;) {
        sum = 0u; cnt = 0u; mine = 0u;
#pragma unroll
        for (unsigned j = 0; j < 16; ++j) { const unsigned c = xb_ld(&bar[XB_XCNT(j)]); sum += c; cnt += (c > 0u) ? 1u : 0u; mine = (j == x) ? c : mine; }
        if (sum == G) break;
        __builtin_amdgcn_s_sleep(1);
        if ((++sp & 255u) == 0u) { if (xb_ld(&bar[XB_TMO])) break; if (sp > XB_SPIN_CAP) { atomicAdd(&bar[XB_TMO], 1u); break; } }
    }
    nloc = mine > 0u ? mine : 1u; nx = cnt > 0u ? cnt : 1u;
}
__device__ __forceinline__ void xcd_barrier(const XcdBarrier& b) {
    asm volatile("s_waitcnt vmcnt(0)" ::: "memory");
    __syncthreads();
    if (threadIdx.x == 0) {
        unsigned* bar = b.bar;
        __builtin_amdgcn_s_waitcnt(0);
        unsigned nloc = b.st[0], nx = b.st[1];
        if (nloc == 0u) { xcd_barrier_complete(bar, b.x, nloc, nx); b.st[0] = nloc; b.st[1] = nx; }
        const unsigned old = xb_add(&bar[XB_XSUB(b.x)], 1u);
        const unsigned gen = old / nloc;
        if (old + 1u == (gen + 1u) * nloc) {
            __builtin_amdgcn_fence(__ATOMIC_RELEASE, "agent");
            asm volatile("s_waitcnt vmcnt(0)" ::: "memory");
            const unsigned og = xb_add(&bar[XB_TOP], 1u);
            const unsigned tg = og / nx;
            if (og + 1u == (tg + 1u) * nx) xb_add(&bar[XB_TOPGEN], 1u);
            else XB_SPIN(xb_ld(&bar[XB_TOPGEN]) == tg, bar);
            __builtin_amdgcn_fence(__ATOMIC_ACQUIRE, "agent");
            xb_add(&bar[XB_XGEN(b.x)], 1u);
            asm volatile("s_waitcnt vmcnt(0)" ::: "memory");
        } else {
            XB_SPIN(xb_ld(&bar[XB_XGEN(b.x)]) == gen, bar);
            __builtin_amdgcn_fence(__ATOMIC_ACQUIRE, "agent");
            asm volatile("s_waitcnt vmcnt(0)" ::: "memory");
        }
    }
    __syncthreads();
}
constexpr int CW_BAR = 4096;
constexpr int LDS_BARST = LDS_MISC + 8192;

struct Params {
    const float* x; const float* w_in; const float* b_in; const float* sinks;
    const float* lq1; const float* lk1; const float* lq2; const float* lk2; const float* subg;
    const float* w_out; const float* ln1g; const float* ln1b; const float* w_r; const float* r_bias;
    const float* w_g; const float* w_u; const float* w_d; const float* ws_g; const float* ws_u; const float* ws_d;
    const float* ln2g; const float* ln2b;
    float* out; unsigned char* ws;
    int ph_lo, ph_hi;
};

__device__ __forceinline__ unsigned cvt_pk(float lo, float hi) { unsigned r; asm volatile("v_cvt_pk_bf16_f32 %0, %1, %2" : "=v"(r) : "v"(lo), "v"(hi)); return r; }
typedef __bf16 bf16x2_t __attribute__((ext_vector_type(2)));
__device__ __forceinline__ unsigned cvt_pk_vis(float lo, float hi) { const bf16x2_t r = __builtin_convertvector((f32x2){lo, hi}, bf16x2_t); return *(const unsigned*)&r; }
__device__ __forceinline__ float bf_lo(unsigned u) { return __uint_as_float(u << 16); }
__device__ __forceinline__ float bf_hi(unsigned u) { return __uint_as_float(u & 0xffff0000u); }
__device__ __forceinline__ float wave_sum(float v) {
#pragma unroll
    for (int o = 1; o < 64; o <<= 1) v += __shfl_xor(v, o);
    return v;
}
__device__ __forceinline__ float half_max(float v) { auto rr = __builtin_amdgcn_permlane32_swap(__float_as_uint(v), __float_as_uint(v), false, false); return fmaxf(__uint_as_float(rr[0]), __uint_as_float(rr[1])); }
__device__ __forceinline__ float half_sum(float v) { auto rr = __builtin_amdgcn_permlane32_swap(__float_as_uint(v), __float_as_uint(v), false, false); return __uint_as_float(rr[0]) + __uint_as_float(rr[1]); }

__device__ __forceinline__ int swz(int r, int c) { const int f = (r & 7) ^ (((r >> 3) & 1) << 1) ^ ((r >> 4) & 1); return r * 128 + ((c ^ f) << 4); }

struct G2Args {
    const char* A; const char* B;
    unsigned offA[4], offB[4];
    int nk;
    unsigned akstep;
};
__device__ __forceinline__ unsigned g2_chunk_off(int lane, int w) { const int f = (lane >> 3) ^ ((w & 1) << 1) ^ ((w >> 1) & 1); return (unsigned)(((lane & 7) ^ f) << 4); }
template <int MT, int NT, class Epi>
__device__ __forceinline__ void gemm2n(char* lds_, const G2Args& g, const Epi& epi) {
    constexpr int A_BYTES = 32 * MT * 128, B_BYTES = 64 * NT * 128, STAGE = A_BYTES + B_BYTES, AR = MT / 2, BRR = NT;
    LAS char* lds = (LAS char*)lds_;
    const int tid = threadIdx.x, lane = tid & 63, w = __builtin_amdgcn_readfirstlane(tid >> 6), wr = w >> 2, wc = w & 3, fr = lane & 15, fq = lane >> 4;
    f32x4 acc[MT][NT];
#pragma unroll
    for (int i = 0; i < MT; ++i)
#pragma unroll
        for (int j = 0; j < NT; ++j) acc[i][j] = (f32x4){0.f, 0.f, 0.f, 0.f};
    const int ldsw = w * 1024;
#define G2_STAGE(kt, s) do { \
        _Pragma("unroll") for (int i = 0; i < AR; ++i) __builtin_amdgcn_global_load_lds((const unsigned*)(g.A + g.offA[i] + (size_t)(kt) * g.akstep), (LAS unsigned*)(lds + (s) * STAGE + i * 8192 + ldsw), 16, 0, 0); \
        _Pragma("unroll") for (int i = 0; i < BRR; ++i) __builtin_amdgcn_global_load_lds((const unsigned*)(g.B + g.offB[i] + (size_t)(kt) * 128), (LAS unsigned*)(lds + (s) * STAGE + A_BYTES + i * 8192 + ldsw), 16, 0, 0); } while (0)
    G2_STAGE(0, 0);
    __syncthreads();
    for (int kt = 0; kt < g.nk; ++kt) {
        const int s = kt & 1;
        if (kt + 1 < g.nk) { if (s) G2_STAGE(kt + 1, 0); else G2_STAGE(kt + 1, 1); }
        const char* la = lds_ + s * STAGE; const char* lb = la + A_BYTES;
        {
            constexpr int NG = 2 * (MT / 4);
            bf16x8 bfr[NT], af[2][4];
#pragma unroll
            for (int nt = 0; nt < NT; ++nt) bfr[nt] = *(const bf16x8*)(lb + swz(wc * 16 * NT + nt * 16 + fr, fq));
#pragma unroll
            for (int m = 0; m < 4; ++m) af[0][m] = *(const bf16x8*)(la + swz(wr * 16 * MT + m * 16 + fr, fq));
#pragma unroll
            for (int gi = 0; gi < NG; ++gi) {
                const int ks = gi / (MT / 4), h = gi % (MT / 4);
                if (gi > 0 && h == 0) {
#pragma unroll
                    for (int nt = 0; nt < NT; ++nt) bfr[nt] = *(const bf16x8*)(lb + swz(wc * 16 * NT + nt * 16 + fr, ks * 4 + fq));
                }
                if (gi + 1 < NG) {
                    const int ks2 = (gi + 1) / (MT / 4), h2 = (gi + 1) % (MT / 4);
#pragma unroll
                    for (int m = 0; m < 4; ++m) af[(gi + 1) & 1][m] = *(const bf16x8*)(la + swz(wr * 16 * MT + (h2 * 4 + m) * 16 + fr, ks2 * 4 + fq));
                }
                __builtin_amdgcn_sched_barrier(0);
#pragma unroll
                for (int m = 0; m < 4; ++m)
#pragma unroll
                    for (int nt = 0; nt < NT; ++nt) acc[h * 4 + m][nt] = __builtin_amdgcn_mfma_f32_16x16x32_bf16(bfr[nt], af[gi & 1][m], acc[h * 4 + m][nt], 0, 0, 0);
                __builtin_amdgcn_sched_barrier(0);
            }
        }
        __syncthreads();
    }
#undef G2_STAGE
    epi(acc, wr, wc, fr, fq);
}
template <int MT, class Epi>
__device__ __forceinline__ void gemm2(char* lds_, const G2Args& g, const Epi& epi) { gemm2n<MT, 4>(lds_, g, epi); }
template <int MT>
__device__ __forceinline__ void g2_rows_A(G2Args& g, size_t row0, unsigned ld_bytes) {
    const int lane = threadIdx.x & 63, w = __builtin_amdgcn_readfirstlane(threadIdx.x >> 6); const unsigned co = g2_chunk_off(lane, w);
#pragma unroll
    for (int i = 0; i < MT / 2; ++i) g.offA[i] = (unsigned)((row0 + i * 64 + w * 8 + (lane >> 3)) * ld_bytes) + co;
}
__device__ __forceinline__ void g2_rows_B(G2Args& g, size_t row0, unsigned ld_bytes) {
    const int lane = threadIdx.x & 63, w = __builtin_amdgcn_readfirstlane(threadIdx.x >> 6); const unsigned co = g2_chunk_off(lane, w);
#pragma unroll
    for (int i = 0; i < 4; ++i) g.offB[i] = (unsigned)((row0 + i * 64 + w * 8 + (lane >> 3)) * ld_bytes) + co;
}


struct G3fArgs { const char* A; unsigned offA[4]; const float* b; int nk; unsigned akstep; };
template <int MT, int LDB, class Epi>
__device__ __forceinline__ void gemm3f(char* lds_, const G3fArgs& g, int npass, int bpstep, const Epi& epi) {
    constexpr int A_BYTES = 32 * MT * 128, B_BYTES = 256 * 128, STAGE = A_BYTES + B_BYTES, AR = MT / 2;
    LAS char* lds = (LAS char*)lds_;
    const int tid = threadIdx.x, lane = tid & 63, w = __builtin_amdgcn_readfirstlane(tid >> 6), wr = w >> 2, wc = w & 3, fr = lane & 15, fq = lane >> 4;
    f32x4 acc[MT][4];
#pragma unroll
    for (int i = 0; i < MT; ++i)
#pragma unroll
        for (int j = 0; j < 4; ++j) acc[i][j] = (f32x4){0.f, 0.f, 0.f, 0.f};
    const int ldsw = w * 1024;
    int bw[4];
#pragma unroll
    for (int j = 0; j < 4; ++j) bw[j] = swz(4 * lane + j, w);
    f32x4 br[8];
    const int nk = g.nk, nsteps = nk * npass;
#define G3_STAGE_A(kt, s) do { \
        _Pragma("unroll") for (int i = 0; i < AR; ++i) __builtin_amdgcn_global_load_lds((const unsigned*)(g.A + g.offA[i] + (size_t)(kt) * g.akstep), (LAS unsigned*)(lds + (s) * STAGE + i * 8192 + ldsw), 16, 0, 0); } while (0)
#define G3_LOAD_B(ps, kt) do { const float* pb_ = g.b + (size_t)(ps) * bpstep + (size_t)(kt) * 64 * LDB; _Pragma("unroll") for (int i = 0; i < 8; ++i) br[i] = *(const f32x4*)(pb_ + i * LDB); } while (0)
#define G3_WRITE_B(s) do { _Pragma("unroll") for (int j = 0; j < 4; ++j) { \
            u32x4 v = {cvt_pk(br[0][j], br[1][j]), cvt_pk(br[2][j], br[3][j]), cvt_pk(br[4][j], br[5][j]), cvt_pk(br[6][j], br[7][j])}; \
            *(u32x4*)(lds_ + (s) * STAGE + A_BYTES + bw[j]) = v; } } while (0)
    G3_STAGE_A(0, 0); G3_LOAD_B(0, 0); G3_WRITE_B(0);
    __syncthreads();
    int ps = 0, kt = 0;
    for (int st = 0; st < nsteps; ++st) {
        const int s = st & 1; const bool more = st + 1 < nsteps;
        int ps2 = ps, kt2 = kt + 1; if (kt2 == nk) { kt2 = 0; ++ps2; }
        if (more) { if (s) G3_STAGE_A(kt2, 0); else G3_STAGE_A(kt2, 1); G3_LOAD_B(ps2, kt2); }
        __builtin_amdgcn_sched_barrier(0);
        const char* la = lds_ + s * STAGE; const char* lb = la + A_BYTES;
        {
            constexpr int NG = MT;
            bf16x8 bfr[4], af[2][2];
#pragma unroll
            for (int nt = 0; nt < 4; ++nt) bfr[nt] = *(const bf16x8*)(lb + swz(wc * 64 + nt * 16 + fr, fq));
#pragma unroll
            for (int m = 0; m < 2; ++m) af[0][m] = *(const bf16x8*)(la + swz(wr * 16 * MT + m * 16 + fr, fq));
#pragma unroll
            for (int gi = 0; gi < NG; ++gi) {
                const int ks = gi / (MT / 2), h = gi % (MT / 2);
                if (gi > 0 && h == 0) {
#pragma unroll
                    for (int nt = 0; nt < 4; ++nt) bfr[nt] = *(const bf16x8*)(lb + swz(wc * 64 + nt * 16 + fr, ks * 4 + fq));
                }
                if (gi + 1 < NG) {
                    const int ks2 = (gi + 1) / (MT / 2), h2 = (gi + 1) % (MT / 2);
#pragma unroll
                    for (int m = 0; m < 2; ++m) af[(gi + 1) & 1][m] = *(const bf16x8*)(la + swz(wr * 16 * MT + (h2 * 2 + m) * 16 + fr, ks2 * 4 + fq));
                }
                __builtin_amdgcn_sched_barrier(0);
#pragma unroll
                for (int m = 0; m < 2; ++m)
#pragma unroll
                    for (int nt = 0; nt < 4; ++nt) acc[h * 2 + m][nt] = __builtin_amdgcn_mfma_f32_16x16x32_bf16(bfr[nt], af[gi & 1][m], acc[h * 2 + m][nt], 0, 0, 0);
                __builtin_amdgcn_sched_barrier(0);
            }
        }
        if (kt == nk - 1) {
            epi(acc, ps, wr, wc, fr, fq);
#pragma unroll
            for (int i = 0; i < MT; ++i)
#pragma unroll
                for (int j = 0; j < 4; ++j) acc[i][j] = (f32x4){0.f, 0.f, 0.f, 0.f};
        }
        if (more) { if (s) G3_WRITE_B(0); else G3_WRITE_B(1); }
        __syncthreads();
        ps = ps2; kt = kt2;
    }
#undef G3_STAGE_A
#undef G3_LOAD_B
#undef G3_WRITE_B
}

__device__ __forceinline__ void cvt_item(const float* W, int K, int N, bf16_t* WT, int ldt, int kb, int nb, int kc, int lane) {
    const float* src = W + (size_t)(kb * 64 + kc * 8) * N + nb * 256 + 4 * lane;
    bf16_t* dst = WT + (size_t)(nb * 256 + 4 * lane) * ldt + kb * 64 + kc * 8;
    f32x4 r[8];
#pragma unroll
    for (int i = 0; i < 8; ++i) r[i] = *(const f32x4*)(src + (size_t)i * N);
#pragma unroll
    for (int j = 0; j < 4; ++j) {
        u32x4 v = {cvt_pk(r[0][j], r[1][j]), cvt_pk(r[2][j], r[3][j]), cvt_pk(r[4][j], r[5][j]), cvt_pk(r[6][j], r[7][j])};
        *(u32x4*)(dst + (size_t)j * ldt) = v;
    }
}
__device__ __forceinline__ void phase_prep(const Params& p, int vb, int G) {
    const int tid = threadIdx.x, lane = tid & 63, w = tid >> 6;
    float* cs = (float*)(p.ws + WS_ROPE); float* sn = cs + (size_t)S * 32;
    for (int idx = vb * NTHREADS + tid; idx < S * 32; idx += G * NTHREADS) {
        const int pos = idx >> 5, i = idx & 31;
        const float pw = (float)pow(10000.0, (double)i / 32.0);
        const float inv = 1.0f / pw;
        const float angf = __fmul_rn((float)pos, inv);
        const double a = (double)angf;
        const double q = rint(a * 0.63661977236758134308);
        double r = fma(-q, 1.57079632679489655800, a); r = fma(-q, 6.12323399573676603587e-17, r);
        const double r2 = r * r;
        double sp = r * (1.0 + r2 * (-1.0 / 6 + r2 * (1.0 / 120 + r2 * (-1.0 / 5040 + r2 * (1.0 / 362880 + r2 * (-1.0 / 39916800))))));
        double cp = 1.0 + r2 * (-0.5 + r2 * (1.0 / 24 + r2 * (-1.0 / 720 + r2 * (1.0 / 40320 + r2 * (-1.0 / 3628800 + r2 * (1.0 / 479001600))))));
        const int qi = ((int)((long long)q)) & 3;
        double sv, cv;
        if (qi == 0) { sv = sp; cv = cp; } else if (qi == 1) { sv = cp; cv = -sp; } else if (qi == 2) { sv = -sp; cv = -cp; } else { sv = -cp; cv = sp; }
        cs[idx] = (float)cv; sn[idx] = (float)sv;
    }
    { const f32x4* xs = (const f32x4*)p.x; u32x4* xd = (u32x4*)(p.ws + WS_XB);
      for (size_t i = (size_t)vb * NTHREADS + tid; i < (size_t)S * D / 8; i += (size_t)G * NTHREADS) {
          const f32x4 a = xs[2 * i], b = xs[2 * i + 1];
          xd[i] = (u32x4){cvt_pk(a[0], a[1]), cvt_pk(a[2], a[3]), cvt_pk(b[0], b[1]), cvt_pk(b[2], b[3])}; } }
    const int gw = vb * 8 + w, NGW = G * 8;
    constexpr int I_IN = 16 * 9, I_OUT = 16 * 4, I_R = 16, I_SG = 16, I_SU = 16, I_SD = 4 * 4, I_SMALL = I_IN + I_OUT + I_R;
    for (int it8 = gw; it8 < I_SMALL * 8; it8 += NGW) {
        int r = it8 >> 3; const int kc = it8 & 7;
        if (r < I_IN) { cvt_item(p.w_in, D, INW, (bf16_t*)(p.ws + WS_WIN), D, r / 9, r % 9, kc, lane); continue; } r -= I_IN;
        if (r < I_OUT) { cvt_item(p.w_out, D, D, (bf16_t*)(p.ws + WS_WOUT), D, r >> 2, r & 3, kc, lane); continue; } r -= I_OUT;
        cvt_item(p.w_r, D, NE, (bf16_t*)(p.ws + WS_WR), D, r, 0, kc, lane);
    }
}

template <int MT> struct EpiProj {
    const float* bias; const float* cs; const float* sn; bf16_t* out; int row0, col0; char* lds;
    __device__ __forceinline__ void operator()(f32x4 (&acc)[MT][4], int wr, int wc, int fr, int fq) const {
        const int hb = col0 + wc * 64;
        const bool is_q = (hb < C_AK) || (hb >= C_BQ && hb < C_BK);
        const bool is_rope = is_q || (hb >= C_AK && hb < C_AV) || (hb >= C_BK && hb < C_BV);
        const float sc = is_q ? QSCALE : 1.0f;
        const int tid = threadIdx.x, w = __builtin_amdgcn_readfirstlane(tid >> 6), lane = tid & 63;
        constexpr int TB = 32 * MT * 128;
        LAS char* l3 = (LAS char*)lds;
#pragma unroll
        for (int i = 0; i < TB / 8192; ++i) {
            __builtin_amdgcn_global_load_lds((const unsigned*)((const char*)(cs + (size_t)row0 * 32) + i * 8192 + w * 1024 + lane * 16), (LAS unsigned*)(l3 + i * 8192 + w * 1024), 16, 0, 0);
            __builtin_amdgcn_global_load_lds((const unsigned*)((const char*)(sn + (size_t)row0 * 32) + i * 8192 + w * 1024 + lane * 16), (LAS unsigned*)(l3 + TB + i * 8192 + w * 1024), 16, 0, 0);
        }
        f32x4 bv[4];
#pragma unroll
        for (int nt = 0; nt < 4; ++nt) bv[nt] = *(const f32x4*)(bias + hb + (nt >> 1) * 32 + 8 * fq + 4 * (nt & 1));
        __syncthreads();
        const float* lcs = (const float*)lds; const float* lsn = (const float*)(lds + TB);
#pragma unroll
        for (int mt = 0; mt < MT; ++mt) {
            const int rl = wr * 16 * MT + mt * 16 + fr, row = row0 + rl;
            f32x4 v[4];
#pragma unroll
            for (int nt = 0; nt < 4; ++nt) v[nt] = acc[mt][nt] + bv[nt];
            if (is_rope) {
#pragma unroll
                for (int nt = 0; nt < 2; ++nt) {
                    const f32x4 c = *(const f32x4*)(lcs + rl * 32 + 8 * fq + 4 * nt), s = *(const f32x4*)(lsn + rl * 32 + 8 * fq + 4 * nt);
                    const f32x4 t1 = v[nt], t2 = v[nt + 2];
                    v[nt] = t1 * c - t2 * s; v[nt + 2] = t2 * c + t1 * s;
                }
            }
#pragma unroll
            for (int a = 0; a < 2; ++a) {
                const f32x4 o0 = v[2 * a] * sc, o1 = v[2 * a + 1] * sc;
                u32x4 pk = {cvt_pk(o0[0], o0[1]), cvt_pk(o0[2], o0[3]), cvt_pk(o1[0], o1[1]), cvt_pk(o1[2], o1[3])};
                *(u32x4*)(out + (size_t)row * INW + hb + a * 32 + 8 * fq) = pk;
            }
        }
        __syncthreads();
    }
};
struct EpiProjQ {
    const float* bias; const float* cs; const float* sn; bf16_t* out; int row0, col0;
    __device__ __forceinline__ void operator()(f32x4 (&acc)[4][2], int wr, int wc, int fr, int fq) const {
        const int hb = col0 + (wc >> 1) * 64, i0 = (wc & 1) * 16 + 4 * fq;
        const bool is_q = (hb < C_AK) || (hb >= C_BQ && hb < C_BK);
        const bool is_rope = is_q || (hb >= C_AK && hb < C_AV) || (hb >= C_BK && hb < C_BV);
        const float sc = is_q ? QSCALE : 1.0f;
#pragma unroll
        for (int mt = 0; mt < 4; ++mt) {
            const int row = row0 + wr * 64 + mt * 16 + fr;
            f32x4 v0 = acc[mt][0] + *(const f32x4*)(bias + hb + i0), v1 = acc[mt][1] + *(const f32x4*)(bias + hb + 32 + i0);
            if (is_rope) {
                const f32x4 c = *(const f32x4*)(cs + (size_t)row * 32 + i0), s = *(const f32x4*)(sn + (size_t)row * 32 + i0);
                const f32x4 t1 = v0, t2 = v1; v0 = t1 * c - t2 * s; v1 = t2 * c + t1 * s;
            }
            v0 = v0 * sc; v1 = v1 * sc;
            *(u32x2*)(out + (size_t)row * INW + hb + i0) = (u32x2){cvt_pk(v0[0], v0[1]), cvt_pk(v0[2], v0[3])};
            *(u32x2*)(out + (size_t)row * INW + hb + 32 + i0) = (u32x2){cvt_pk(v1[0], v1[1]), cvt_pk(v1[2], v1[3])};
        }
    }
};
__device__ __forceinline__ void phase_proj(const Params& p, char* lds, int vb, int G) {
    const float* cs = (const float*)(p.ws + WS_ROPE); const float* sn = cs + (size_t)S * 32;
    constexpr int NBIG = 512, NUNITS = NBIG + 4 * 64;
    for (int u = vb; u < NUNITS; u += G) {
        G2Args g; g.A = (const char*)(p.ws + WS_XB); g.B = (const char*)(p.ws + WS_WIN); g.nk = D / 64; g.akstep = 128;
        if (u < NBIG) {
            const int tm = u / 9, tn = u % 9;
            g2_rows_A<8>(g, (size_t)tm * 256, D * 2);
            { const int lane = threadIdx.x & 63, w = __builtin_amdgcn_readfirstlane(threadIdx.x >> 6); const unsigned co = g2_chunk_off(lane, w);
#pragma unroll
              for (int i = 0; i < 4; ++i) { const int n = i * 64 + w * 8 + (lane >> 3), nt = (n >> 4) & 3, nl = n & 15;
                  const int col = tn * 256 + (n >> 6) * 64 + (nt >> 1) * 32 + 8 * (nl >> 2) + 4 * (nt & 1) + (nl & 3);
                  g.offB[i] = (unsigned)col * (unsigned)(D * 2) + co; } }
            EpiProj<8> e{p.b_in, cs, sn, (bf16_t*)(p.ws + WS_PROJ), tm * 256, tn * 256, lds};
            gemm2<8>(lds, g, e);
        } else {
            const int q = u - NBIG, t = NBIG + (q >> 2), hm = (q >> 1) & 1, hn = q & 1, tm = t / 9, tn = t % 9;
            g2_rows_A<4>(g, (size_t)tm * 256 + hm * 128, D * 2);
            { const int lane = threadIdx.x & 63, w = __builtin_amdgcn_readfirstlane(threadIdx.x >> 6); const unsigned co = g2_chunk_off(lane, w);
#pragma unroll
              for (int i = 0; i < 2; ++i) { const int n = i * 64 + w * 8 + (lane >> 3), wcn = n >> 5, sub = n & 31;
                  const int col = tn * 256 + hn * 128 + (wcn >> 1) * 64 + (wcn & 1) * 16 + (sub & 15) + (sub >> 4) * 32;
                  g.offB[i] = (unsigned)col * (unsigned)(D * 2) + co; } }
            EpiProjQ e{p.b_in, cs, sn, (bf16_t*)(p.ws + WS_PROJ), tm * 256 + hm * 128, tn * 256 + hn * 128};
            gemm2n<4, 2>(lds, g, e);
        }
    }
}

template <int OFF> __device__ __forceinline__ s16x4 tr_read(int vb) { s16x4 r; asm volatile("ds_read_b64_tr_b16 %0, %1 offset:%2" : "=&v"(r) : "v"(vb), "i"(OFF) : "memory"); return r; }
__device__ __forceinline__ int v_off(int k, int c, int ndb) { return ((k >> 3) * ndb + (c >> 5)) * 512 + ((k & 7) * 32 + (c & 31)) * 2; }

constexpr int AT_STAGE = 32768;
template <int NDB, int KB, int T> struct PvPart {
    static __device__ __forceinline__ void run(f32x16& o, int vbase, const bf16x8& pa, const bf16x8& pb) {
        constexpr int o0 = (KB * 4 * NDB + T) * 512, st = NDB * 512;
        const s16x4 l0 = tr_read<o0 + 0 * st>(vbase), h0 = tr_read<o0 + 1 * st>(vbase), l1 = tr_read<o0 + 2 * st>(vbase), h1 = tr_read<o0 + 3 * st>(vbase);
        asm volatile("s_waitcnt lgkmcnt(0)" ::: "memory"); __builtin_amdgcn_sched_barrier(0);
#define PKV(L, H) (bf16x8){L[0], L[1], L[2], L[3], H[0], H[1], H[2], H[3]}
        o = __builtin_amdgcn_mfma_f32_32x32x16_bf16(PKV(l0, h0), pa, o, 0, 0, 0);
        o = __builtin_amdgcn_mfma_f32_32x32x16_bf16(PKV(l1, h1), pb, o, 0, 0, 0);
#undef PKV
    }
};
template <int NDB, int KB>
__device__ __forceinline__ void pv_half(f32x16 (&o)[NDB], f32x16& ol, int vbase, const bf16x8& pa, const bf16x8& pb) {
    const bf16x8 ones = {16256, 16256, 16256, 16256, 16256, 16256, 16256, 16256};
    ol = __builtin_amdgcn_mfma_f32_32x32x16_bf16(ones, pa, ol, 0, 0, 0);
    ol = __builtin_amdgcn_mfma_f32_32x32x16_bf16(ones, pb, ol, 0, 0, 0);
    PvPart<NDB, KB, 0>::run(o[0], vbase, pa, pb); PvPart<NDB, KB, 1>::run(o[1], vbase, pa, pb);
    if constexpr (NDB == 4) { PvPart<NDB, KB, 2>::run(o[2], vbase, pa, pb); PvPart<NDB, KB, 3>::run(o[3], vbase, pa, pb); }
}
constexpr float ATT_THR = 10.0f;
template <int NDB>
__device__ __forceinline__ void attn_scores(char* lds, int kof, const bf16x8 (&qf)[4], f32x16& s0, f32x16& s1, f32x16 (&o)[NDB], f32x16& ol, f32x16& nm, bool first, int r32, int hi) {
    s0 = nm; s1 = nm;
#pragma unroll
    for (int ds = 0; ds < 4; ++ds) {
        const bf16x8 k0 = *(const bf16x8*)(lds + kof + swz(r32, ds * 2 + hi)), k1 = *(const bf16x8*)(lds + kof + swz(32 + r32, ds * 2 + hi));
        s0 = __builtin_amdgcn_mfma_f32_32x32x16_bf16(k0, qf[ds], s0, 0, 0, 0);
        s1 = __builtin_amdgcn_mfma_f32_32x32x16_bf16(k1, qf[ds], s1, 0, 0, 0);
    }
    float mx = fmaxf(s0[0], s1[0]);
#pragma unroll
    for (int r = 1; r < 16; ++r) mx = fmaxf(fmaxf(mx, s0[r]), s1[r]);
    mx = half_max(mx);
    if (first || __any(mx > ATT_THR)) {
        const float delta = first ? mx : fmaxf(mx, 0.f), alpha = first ? 0.f : __builtin_amdgcn_exp2f(-delta);
#pragma unroll
        for (int r = 0; r < 16; ++r) { s0[r] -= delta; s1[r] -= delta; nm[r] -= delta; ol[r] *= alpha; }
#pragma unroll
        for (int t = 0; t < NDB; ++t)
#pragma unroll
            for (int r = 0; r < 16; ++r) o[t][r] *= alpha;
    }
}
__device__ __forceinline__ void exp_pack(const f32x16& s, bf16x8& pa, bf16x8& pb) {
    float e[16];
#pragma unroll
    for (int r = 0; r < 16; ++r) e[r] = __builtin_amdgcn_exp2f(s[r]);
    u32x4 a = {cvt_pk_vis(e[0], e[1]), cvt_pk_vis(e[2], e[3]), cvt_pk_vis(e[4], e[5]), cvt_pk_vis(e[6], e[7])};
    u32x4 b = {cvt_pk_vis(e[8], e[9]), cvt_pk_vis(e[10], e[11]), cvt_pk_vis(e[12], e[13]), cvt_pk_vis(e[14], e[15])};
    pa = *(bf16x8*)&a; pb = *(bf16x8*)&b;
}

template <int OFF> __device__ __forceinline__ bf16x8 k_read(int a) { bf16x8 r; asm volatile("ds_read_b128 %0, %1 offset:%2" : "=&v"(r) : "v"(a), "i"(OFF) : "memory"); return r; }
struct VSet { s16x4 l0, h0, l1, h1; };
template <int KB, int T> __device__ __forceinline__ void v_issue(VSet& v, int vbase) {
    constexpr int o0 = (KB * 16 + T) * 512, st = 4 * 512;
    v.l0 = tr_read<o0>(vbase); v.h0 = tr_read<o0 + st>(vbase); v.l1 = tr_read<o0 + 2 * st>(vbase); v.h1 = tr_read<o0 + 3 * st>(vbase);
}
#define WAIT_K(n, a, b) asm volatile("s_waitcnt lgkmcnt(" #n ")" : "+v"(a), "+v"(b) :: "memory")
#define WAIT_V(n, v) asm volatile("s_waitcnt lgkmcnt(" #n ")" : "+v"(v.l0), "+v"(v.h0), "+v"(v.l1), "+v"(v.h1) :: "memory")
#define PKV(L, H) (bf16x8){L[0], L[1], L[2], L[3], H[0], H[1], H[2], H[3]}
#define MF32(a, b, c) __builtin_amdgcn_mfma_f32_32x32x16_bf16(a, b, c, 0, 0, 0)
#define SB __builtin_amdgcn_sched_barrier(0)
#define EXP4(src, i, wlo, whi) do { const float e0_ = __builtin_amdgcn_exp2f(src[4 * (i)]), e1_ = __builtin_amdgcn_exp2f(src[4 * (i) + 1]), e2_ = __builtin_amdgcn_exp2f(src[4 * (i) + 2]), e3_ = __builtin_amdgcn_exp2f(src[4 * (i) + 3]); \
        asm("v_add_f32 %0, %1, %0" : "+v"(l2[0]) : "v"(e0_)); asm("v_add_f32 %0, %1, %0" : "+v"(l2[1]) : "v"(e1_)); asm("v_add_f32 %0, %1, %0" : "+v"(l2[0]) : "v"(e2_)); asm("v_add_f32 %0, %1, %0" : "+v"(l2[1]) : "v"(e3_)); \
        wlo = cvt_pk(e0_, e1_); whi = cvt_pk(e2_, e3_); } while (0)
#define EXP2(src, i, w) do { const float e0_ = __builtin_amdgcn_exp2f(src[2 * (i)]), e1_ = __builtin_amdgcn_exp2f(src[2 * (i) + 1]); \
        w = cvt_pk_vis(e0_, e1_); asm("v_add_f32 %0, %1, %0" : "+v"(l2[0]) : "v"(e0_), "v"(w)); asm("v_add_f32 %0, %1, %0" : "+v"(l2[1]) : "v"(e1_), "v"(w)); } while (0)
#define MAX4(i) do { mx = fmaxf(fmaxf(mx, n0[4 * (i)]), n1[4 * (i)]); mx = fmaxf(fmaxf(mx, n0[4 * (i) + 1]), n1[4 * (i) + 1]); \
        mx = fmaxf(fmaxf(mx, n0[4 * (i) + 2]), n1[4 * (i) + 2]); mx = fmaxf(fmaxf(mx, n0[4 * (i) + 3]), n1[4 * (i) + 3]); asm volatile("" : "+v"(mx)); } while (0)
struct DmaPlan { const char* base; unsigned gk, gv; size_t ok3, ok4, ov2, ov3; LAS char* dk3; LAS char* dk4; LAS char* dv2; LAS char* dv3; };
#define DMAP(src, dst) __builtin_amdgcn_global_load_lds((const unsigned*)(src), (LAS unsigned*)(dst), 16, 0, 0)
template <bool DMA>
__device__ __forceinline__ void diff_slot(f32x16& c0, f32x16& c1, f32x16& n0, f32x16& n1, f32x16 (&o)[4], f32x2& l2, f32x16& nm, const bf16x8 (&qf)[4],
                                          int ka0, int ka1, int ka2, int ka3, int vbase, bool has_next, const DmaPlan& dp) {
    constexpr bool HASNEXT = true;
    bf16x8 kA, kB, kC, kD, kE, kF, kG, kH; VSet v4, v5, v6, v7, v8, v9, v10, v11; u32x4 w0, w1, w2, w3;
    float mx = -3.0e38f;
    SB;
    kA = k_read<0>(ka0); kB = k_read<4096>(ka0); kC = k_read<0>(ka1); kD = k_read<4096>(ka1);
    EXP2(c0, 0, w0[0]);
    EXP2(c0, 1, w0[1]);
    WAIT_K(2, kA, kB);
    kE = k_read<0>(ka2); kF = k_read<4096>(ka2);
    n0 = MF32(kA, qf[0], nm); n1 = MF32(kB, qf[0], nm);
    if constexpr (DMA) DMAP(dp.base + dp.ok3 + dp.gk, dp.dk3);
    SB;
    EXP2(c0, 2, w0[2]);
    WAIT_K(2, kC, kD);
    kG = k_read<0>(ka3); kH = k_read<4096>(ka3);
    n0 = MF32(kC, qf[1], n0); n1 = MF32(kD, qf[1], n1);
    if constexpr (DMA) DMAP(dp.base + (dp.ok3 + 128) + dp.gk, dp.dk3 + 8192);
    SB;
    EXP2(c0, 3, w0[3]);
    EXP2(c0, 4, w1[0]);
    WAIT_K(2, kE, kF);
    v4.l0 = tr_read<0>(vbase); v4.h0 = tr_read<2048>(vbase); v4.l1 = tr_read<512>(vbase); v4.h1 = tr_read<2560>(vbase);
    n0 = MF32(kE, qf[2], n0); n1 = MF32(kF, qf[2], n1);
    if constexpr (DMA) DMAP(dp.base + dp.ov2 + dp.gv, dp.dv2);
    SB;
    EXP2(c0, 5, w1[1]);
    WAIT_K(4, kG, kH);
    v5.l0 = tr_read<1024>(vbase); v5.h0 = tr_read<3072>(vbase); v5.l1 = tr_read<1536>(vbase); v5.h1 = tr_read<3584>(vbase);
    n0 = MF32(kG, qf[3], n0); n1 = MF32(kH, qf[3], n1);
    if constexpr (DMA) DMAP(dp.base + (dp.ov2 + 128) + dp.gv, dp.dv2 + 1024);
    SB;
    EXP2(c0, 6, w1[2]);
    EXP2(c0, 7, w1[3]);
    WAIT_V(4, v4);
    v6.l0 = tr_read<4096>(vbase); v6.h0 = tr_read<6144>(vbase); v6.l1 = tr_read<4608>(vbase); v6.h1 = tr_read<6656>(vbase);
    o[0] = MF32(PKV(v4.l0, v4.h0), (*(bf16x8*)&w0), o[0]); o[1] = MF32(PKV(v4.l1, v4.h1), (*(bf16x8*)&w0), o[1]);
    if constexpr (DMA) DMAP(dp.base + dp.ov3 + dp.gv, dp.dv3);
    SB;
    EXP2(c1, 0, w2[0]);
    MAX4(0);
    WAIT_V(4, v5);
    v7.l0 = tr_read<5120>(vbase); v7.h0 = tr_read<7168>(vbase); v7.l1 = tr_read<5632>(vbase); v7.h1 = tr_read<7680>(vbase);
    o[2] = MF32(PKV(v5.l0, v5.h0), (*(bf16x8*)&w0), o[2]); o[3] = MF32(PKV(v5.l1, v5.h1), (*(bf16x8*)&w0), o[3]);
    if constexpr (DMA) DMAP(dp.base + (dp.ov3 + 128) + dp.gv, dp.dv3 + 1024);
    SB;
    EXP2(c1, 1, w2[1]);
    EXP2(c1, 2, w2[2]);
    WAIT_V(4, v6);
    v8.l0 = tr_read<8192>(vbase); v8.h0 = tr_read<10240>(vbase); v8.l1 = tr_read<8704>(vbase); v8.h1 = tr_read<10752>(vbase);
    o[0] = MF32(PKV(v6.l0, v6.h0), (*(bf16x8*)&w1), o[0]); o[1] = MF32(PKV(v6.l1, v6.h1), (*(bf16x8*)&w1), o[1]);
    if constexpr (DMA) DMAP(dp.base + dp.ok4 + dp.gk, dp.dk4);
    SB;
    EXP2(c1, 3, w2[3]);
    MAX4(1);
    WAIT_V(4, v7);
    v9.l0 = tr_read<9216>(vbase); v9.h0 = tr_read<11264>(vbase); v9.l1 = tr_read<9728>(vbase); v9.h1 = tr_read<11776>(vbase);
    o[2] = MF32(PKV(v7.l0, v7.h0), (*(bf16x8*)&w1), o[2]); o[3] = MF32(PKV(v7.l1, v7.h1), (*(bf16x8*)&w1), o[3]);
    if constexpr (DMA) DMAP(dp.base + (dp.ok4 + 128) + dp.gk, dp.dk4 + 8192);
    SB;
    EXP2(c1, 4, w3[0]);
    EXP2(c1, 5, w3[1]);
    WAIT_V(4, v8);
    v10.l0 = tr_read<12288>(vbase); v10.h0 = tr_read<14336>(vbase); v10.l1 = tr_read<12800>(vbase); v10.h1 = tr_read<14848>(vbase);
    o[0] = MF32(PKV(v8.l0, v8.h0), (*(bf16x8*)&w2), o[0]); o[1] = MF32(PKV(v8.l1, v8.h1), (*(bf16x8*)&w2), o[1]);
    SB;
    EXP2(c1, 6, w3[2]);
    EXP2(c1, 7, w3[3]);
    WAIT_V(4, v9);
    v11.l0 = tr_read<13312>(vbase); v11.h0 = tr_read<15360>(vbase); v11.l1 = tr_read<13824>(vbase); v11.h1 = tr_read<15872>(vbase);
    o[2] = MF32(PKV(v9.l0, v9.h0), (*(bf16x8*)&w2), o[2]); o[3] = MF32(PKV(v9.l1, v9.h1), (*(bf16x8*)&w2), o[3]);
    SB;
    MAX4(2);
    WAIT_V(4, v10);
    o[0] = MF32(PKV(v10.l0, v10.h0), (*(bf16x8*)&w3), o[0]); o[1] = MF32(PKV(v10.l1, v10.h1), (*(bf16x8*)&w3), o[1]);
    SB;
    MAX4(3);
    WAIT_V(0, v11);
    o[2] = MF32(PKV(v11.l0, v11.h0), (*(bf16x8*)&w3), o[2]); o[3] = MF32(PKV(v11.l1, v11.h1), (*(bf16x8*)&w3), o[3]);
    SB;
    if (has_next) {
        mx = half_max(mx);
        if (__any(mx > ATT_THR)) {
            const float delta = fmaxf(mx, 0.f), alpha = __builtin_amdgcn_exp2f(-delta);
#pragma unroll
            for (int r = 0; r < 16; ++r) { n0[r] -= delta; n1[r] -= delta; nm[r] -= delta; }
            l2 *= alpha;
#pragma unroll
            for (int t = 0; t < 4; ++t)
#pragma unroll
                for (int r = 0; r < 16; ++r) o[t][r] *= alpha;
        }
    }
}
__device__ __forceinline__ void attn_diff_unit(const Params& p, char* lds_, int h, int qb, float lam) {
    LAS char* lds = (LAS char*)lds_;
    int tid = threadIdx.x; asm volatile("" : "+v"(tid));
    const int lane = tid & 63, w = __builtin_amdgcn_readfirstlane(tid >> 6), r32 = lane & 31, hi = lane >> 5, mp = w >> 2, wq = w & 3;
    const bf16_t* proj = (const bf16_t*)(p.ws + WS_PROJ);
    const int NT = 2 * qb + 2, NP = NT / 2, myNT = (wq < 2) ? NT - 1 : NT;
    bf16x8 qf[4];
    { const bf16_t* qp = proj + (size_t)(qb * 128 + wq * 32 + r32) * INW + C_BQ + h * 128 + mp * 64 + hi * 8;
#pragma unroll
      for (int ds = 0; ds < 4; ++ds) qf[ds] = *(const bf16x8*)(qp + ds * 16); }
    asm volatile("" : "+v"(qf[0]), "+v"(qf[1]), "+v"(qf[2]), "+v"(qf[3]));
    f32x16 o[4] = {}; f32x16 nm; f32x2 l2 = {0.f, 0.f};
    const unsigned gko = (unsigned)((w * 8 + (lane >> 3)) * INW + C_BK + h * 128) * 2u + g2_chunk_off(lane, w);
    const unsigned gvo = (unsigned)((w * 8 + ((lane & 31) >> 2)) * INW + C_BV + h * 128 + (lane >> 5) * 32 + (lane & 3) * 8) * 2u;
    const char* gk = (const char*)proj + gko; const char* gv = (const char*)proj + gvo;
    const int vlane = ((lane & 3) << 3) | (((lane >> 2) & 3) << 6) | (((lane >> 4) & 1) << 5) | (((lane >> 5) & 1) << 8);
    const int ldsb = (int)(uintptr_t)lds_;
    const int kad0 = ldsb + mp * 8192 + swz(r32, 0 + hi), kad1 = ldsb + mp * 8192 + swz(r32, 2 + hi), kad2 = ldsb + mp * 8192 + swz(r32, 4 + hi), kad3 = ldsb + mp * 8192 + swz(r32, 6 + hi);
    constexpr size_t TSTEP = (size_t)64 * INW * 2;
#define DMA_K(t_) do { const int tt_ = (t_); const char* s_ = gk + (size_t)tt_ * TSTEP; LAS char* d_ = lds + (tt_ & 3) * 16384 + w * 1024; \
        __builtin_amdgcn_global_load_lds((const unsigned*)s_, (LAS unsigned*)d_, 16, 0, 0); \
        __builtin_amdgcn_global_load_lds((const unsigned*)(s_ + 128), (LAS unsigned*)(d_ + 8192), 16, 0, 0); } while (0)
#define DMA_V(t_) do { const int tt_ = (t_); const char* s_ = gv + (size_t)tt_ * TSTEP; LAS char* d_ = lds + 65536 + (tt_ & 3) * 16384 + (2 * w) * 1024; \
        __builtin_amdgcn_global_load_lds((const unsigned*)s_, (LAS unsigned*)d_, 16, 0, 0); \
        __builtin_amdgcn_global_load_lds((const unsigned*)(s_ + 128), (LAS unsigned*)(d_ + 1024), 16, 0, 0); } while (0)
    DMA_K(0); DMA_K(1); if (NT > 2) DMA_K(2); DMA_V(0); DMA_V(1);
    __syncthreads();
    f32x16 A0 = {}, A1 = {}, B0 = {}, B1 = {};
    {
#pragma unroll
        for (int ds = 0; ds < 4; ++ds) {
            const bf16x8 k0 = *(const bf16x8*)(lds_ + mp * 8192 + swz(r32, ds * 2 + hi)), k1 = *(const bf16x8*)(lds_ + mp * 8192 + swz(32 + r32, ds * 2 + hi));
            A0 = MF32(k0, qf[ds], A0); A1 = MF32(k1, qf[ds], A1);
        }
        float mx = fmaxf(A0[0], A1[0]);
#pragma unroll
        for (int r = 1; r < 16; ++r) mx = fmaxf(fmaxf(mx, A0[r]), A1[r]);
        mx = half_max(mx);
#pragma unroll
        for (int r = 0; r < 16; ++r) { A0[r] -= mx; A1[r] -= mx; nm[r] = -mx; }
    }
    __syncthreads();
    for (int it = 0; it < NP; ++it) {
        const int t = 2 * it;
        DmaPlan dp;
        dp.base = (const char*)proj; dp.gk = gko; dp.gv = gvo;
        dp.ok3 = (size_t)min(t + 3, NT - 1) * TSTEP; dp.dk3 = lds + ((t + 3) & 3) * 16384 + w * 1024;
        dp.ok4 = (size_t)min(t + 4, NT - 1) * TSTEP; dp.dk4 = lds + ((t + 4) & 3) * 16384 + w * 1024;
        dp.ov2 = (size_t)min(t + 2, NT - 1) * TSTEP; dp.dv2 = lds + 65536 + ((t + 2) & 3) * 16384 + (2 * w) * 1024;
        dp.ov3 = (size_t)min(t + 3, NT - 1) * TSTEP; dp.dv3 = lds + 65536 + ((t + 3) & 3) * 16384 + (2 * w) * 1024;
        { const int ks = ((t + 1) & 3) * 16384, vb_ = ldsb + 65536 + (t & 3) * 16384 + vlane;
          diff_slot<true>(A0, A1, B0, B1, o, l2, nm, qf, kad0 + ks, kad1 + ks, kad2 + ks, kad3 + ks, vb_, t + 1 < myNT, dp); }
        if (t + 1 < myNT) {
            const int ks = ((t + 2) & 3) * 16384, vb_ = ldsb + 65536 + ((t + 1) & 3) * 16384 + vlane;
            diff_slot<false>(B0, B1, A0, A1, o, l2, nm, qf, kad0 + ks, kad1 + ks, kad2 + ks, kad3 + ks, vb_, t + 2 < myNT, dp);
        }
        __syncthreads();
    }
#undef DMA_K
#undef DMA_V
    float* xb = (float*)lds_;
    const float il = 1.0f / half_sum(l2[0] + l2[1]);
    if (mp == 1) {
        const float f = il * *(const float*)(lds_ + LDS_MISC);
#pragma unroll
        for (int t = 0; t < 4; ++t)
#pragma unroll
            for (int r = 0; r < 16; ++r) xb[(wq * 64 + t * 16 + r) * 64 + lane] = o[t][r] * f;
    }
    __syncthreads();
    if (mp == 0) {
        float ss = 0.f;
#pragma unroll
        for (int t = 0; t < 4; ++t)
#pragma unroll
            for (int r = 0; r < 16; ++r) { const float v = o[t][r] * il - xb[(wq * 64 + t * 16 + r) * 64 + lane]; o[t][r] = v; ss += v * v; }
        ss = half_sum(ss);
        const float rs = rsqrtf(ss * (1.0f / 128.0f) + LN_EPS) * 0.8f;
        bf16_t* op = (bf16_t*)(p.ws + WS_ATT) + (size_t)(qb * 128 + wq * 32 + r32) * D + 512 + h * 128;
#pragma unroll
        for (int t = 0; t < 4; ++t)
#pragma unroll
            for (int rp = 0; rp < 2; ++rp) {
                unsigned pk[2][2];
#pragma unroll
                for (int a = 0; a < 2; ++a) {
                    const int rr = 2 * rp + a, dv0 = 32 * t + 8 * rr + 4 * hi;
                    const f32x4 gg = *(const f32x4*)(p.subg + dv0);
                    pk[a][0] = cvt_pk(o[t][4 * rr] * rs * gg[0], o[t][4 * rr + 1] * rs * gg[1]); pk[a][1] = cvt_pk(o[t][4 * rr + 2] * rs * gg[2], o[t][4 * rr + 3] * rs * gg[3]);
                }
                const auto s0 = __builtin_amdgcn_permlane32_swap(pk[0][0], pk[1][0], false, false), s1 = __builtin_amdgcn_permlane32_swap(pk[0][1], pk[1][1], false, false);
                *(u32x4*)(op + 32 * t + 8 * (2 * rp + hi)) = (u32x4){s0[0], s1[0], s0[1], s1[1]};
            }
    }
    __syncthreads();
}
#undef DMAP
#undef WAIT_K
#undef WAIT_V
#undef PKV
#undef MF32
#undef SB
#undef EXP4
#undef EXP2
#undef MAX4
__device__ __forceinline__ void attn_swa_unit(const Params& p, char* lds, int kvh, int n) {
    int tid = threadIdx.x; asm volatile("" : "+v"(tid));
    const int lane = tid & 63, w = __builtin_amdgcn_readfirstlane(tid >> 6), r32 = lane & 31, hi = lane >> 5, g = w >> 1, hq = kvh * 4 + g;
    const bf16_t* proj = (const bf16_t*)(p.ws + WS_PROJ);
    const int c0 = (n >= 2) ? n - 2 : 0, NT = n - c0 + 1;
    const int tok = n * 64 + (w & 1) * 32 + r32;
    bf16x8 qf[4];
    { const bf16_t* qp = proj + (size_t)tok * INW + C_AQ + hq * 64 + hi * 8;
#pragma unroll
      for (int ds = 0; ds < 4; ++ds) qf[ds] = *(const bf16x8*)(qp + ds * 16); }
    f32x16 o[2] = {}; f32x16 ol, nm;
    { float ms = -p.sinks[hq] * LOG2E; asm volatile("" : "+v"(qf[0]), "+v"(qf[1]), "+v"(qf[2]), "+v"(qf[3]), "+v"(ms));
#pragma unroll
      for (int r = 0; r < 16; ++r) { nm[r] = ms; ol[r] = 1.0f; } }
    const bf16_t* gk = proj + (size_t)(c0 * 64 + (tid >> 3)) * INW + C_AK + kvh * 64 + (tid & 7) * 8;
    const bf16_t* gv = proj + (size_t)(c0 * 64 + (tid >> 3)) * INW + C_AV + kvh * 64 + (tid & 7) * 8;
    const int wk = swz(tid >> 3, tid & 7), wv = v_off(tid >> 3, (tid & 7) * 8, 2);
    const int vlane = ((lane & 3) << 3) | (((lane >> 2) & 3) << 6) | (((lane >> 4) & 1) << 5) | (((lane >> 5) & 1) << 8);
    u32x4 st0, st1;
#define W_LOAD(t) do { const size_t ko = (size_t)(t) * 64 * INW; st0 = *(const u32x4*)(gk + ko); st1 = *(const u32x4*)(gv + ko); } while (0)
#define W_WRITE(b) do { char* sb = lds + (b) * AT_STAGE; *(u32x4*)(sb + wk) = st0; *(u32x4*)(sb + 8192 + wv) = st1; } while (0)
    W_LOAD(0); W_WRITE(0); __syncthreads();
    for (int t = 0; t < NT; ++t) {
        const int b = t & 1;
        if (t + 1 < NT) W_LOAD(t + 1);
        { f32x16 s0, s1; bf16x8 p0, p1, p2, p3; const int vb_ = (int)(uintptr_t)(lds + b * AT_STAGE + 8192) + vlane;
          attn_scores<2>(lds, b * AT_STAGE, qf, s0, s1, o, ol, nm, false, r32, hi);
          exp_pack(s0, p0, p1); pv_half<2, 0>(o, ol, vb_, p0, p1); exp_pack(s1, p2, p3); pv_half<2, 1>(o, ol, vb_, p2, p3); }
        if (t + 1 < NT) W_WRITE(b ^ 1);
        __syncthreads();
    }
#undef W_LOAD
#undef W_WRITE
    const float il = 1.0f / ol[0];
    bf16_t* op = (bf16_t*)(p.ws + WS_ATT) + (size_t)tok * D + hq * 64;
#pragma unroll
    for (int t = 0; t < 2; ++t)
#pragma unroll
        for (int rp = 0; rp < 2; ++rp) {
            unsigned pk[2][2];
#pragma unroll
            for (int a = 0; a < 2; ++a) { const int rr = 2 * rp + a; pk[a][0] = cvt_pk(o[t][4 * rr] * il, o[t][4 * rr + 1] * il); pk[a][1] = cvt_pk(o[t][4 * rr + 2] * il, o[t][4 * rr + 3] * il); }
            const auto s0 = __builtin_amdgcn_permlane32_swap(pk[0][0], pk[1][0], false, false), s1 = __builtin_amdgcn_permlane32_swap(pk[0][1], pk[1][1], false, false);
            *(u32x4*)(op + 32 * t + 8 * (2 * rp + hi)) = (u32x4){s0[0], s1[0], s0[1], s1[1]};
        }
}
__device__ __forceinline__ void phase_attn(const Params& p, char* lds, int vb, int G) {
    const int lane = threadIdx.x & 63;
    const float d1 = wave_sum(p.lq1[lane] * p.lk1[lane]), d2 = wave_sum(p.lq2[lane] * p.lk2[lane]);
    if (threadIdx.x == 0) *(float*)(lds + LDS_MISC) = expf(d1) - expf(d2) + 0.2f;
    __syncthreads();
    const float lam = 0.f;
    for (int u = vb; u < 1024; u += G) {
        if (u < 512) attn_diff_unit(p, lds, (u & 255) >> 6, (u < 256) ? 127 - (u & 63) : (u & 63), lam);
        else attn_swa_unit(p, lds, (u - 512) >> 8, (u - 512) & 255);
    }
}

struct EpiPreLn {
    const float* x; float* out; int row0, col0;
    __device__ __forceinline__ void operator()(f32x4 (&acc)[8][4], int wr, int wc, int fr, int fq) const {
        f32x4 xa[4], xb_[4];
        const size_t rbase = (size_t)(row0 + wr * 128 + fr) * D + col0 + wc * 64 + 4 * fq;
#pragma unroll
        for (int nt = 0; nt < 4; ++nt) xa[nt] = *(const f32x4*)(x + rbase + nt * 16);
#pragma unroll
        for (int mt = 0; mt < 8; ++mt) {
            const size_t ro = rbase + (size_t)mt * 16 * D;
            if (mt + 1 < 8) {
#pragma unroll
                for (int nt = 0; nt < 4; ++nt) { if (mt & 1) xa[nt] = *(const f32x4*)(x + ro + (size_t)16 * D + nt * 16); else xb_[nt] = *(const f32x4*)(x + ro + (size_t)16 * D + nt * 16); }
            }
#pragma unroll
            for (int nt = 0; nt < 4; ++nt) { const f32x4 xv = (mt & 1) ? xb_[nt] : xa[nt]; *(f32x4*)(out + ro + nt * 16) = xv * ALPHA + acc[mt][nt]; }
        }
    }
};
__device__ __forceinline__ void phase_wout(const Params& p, char* lds, int vb, int G) {
    for (int u = vb; u < (S / 256) * 4; u += G) {
        const int tm = u >> 2, tn = u & 3;
        G2Args g; g.A = (const char*)(p.ws + WS_ATT); g.B = (const char*)(p.ws + WS_WOUT); g.nk = D / 64; g.akstep = 128;
        g2_rows_A<8>(g, (size_t)tm * 256, D * 2); g2_rows_B(g, (size_t)tn * 256, D * 2);
        EpiPreLn e{p.x, (float*)(p.ws + WS_PRELN), tm * 256, tn * 256};
        gemm2<8>(lds, g, e);
    }
}

struct EpiLogits {
    float* L;
    __device__ __forceinline__ void operator()(f32x4 (&acc)[4][4], int wr, int wc, int fr, int fq) const {
#pragma unroll
        for (int mt = 0; mt < 4; ++mt)
#pragma unroll
            for (int nt = 0; nt < 4; ++nt) *(f32x4*)(L + (wr * 64 + mt * 16 + fr) * 256 + wc * 64 + nt * 16 + 4 * fq) = acc[mt][nt];
    }
};
__device__ __forceinline__ void phase_router(const Params& p, char* lds, int vb, int G) {
    const int tid = threadIdx.x, lane = tid & 63, w = tid >> 6;
    const float* preln = (const float*)(p.ws + WS_PRELN);
    bf16_t* x1b = (bf16_t*)(p.ws + WS_X1B);
    unsigned* cnt = (unsigned*)(p.ws + WS_CTL + 65536); int* list = (int*)(p.ws + WS_LIST); float* gates = (float*)(p.ws + WS_GATE);
    for (int u = vb; u < S / 64; u += G) {
        {
            f32x4 v[8][4]; float sm[8], sq[8];
#pragma unroll
            for (int i = 0; i < 8; ++i) { const f32x4* xr = (const f32x4*)(preln + (size_t)(u * 64 + w * 8 + i) * D) + lane;
#pragma unroll
                for (int j = 0; j < 4; ++j) v[i][j] = xr[64 * j]; }
#pragma unroll
            for (int i = 0; i < 8; ++i) { float s = 0.f;
#pragma unroll
                for (int j = 0; j < 4; ++j) s += (v[i][j][0] + v[i][j][1]) + (v[i][j][2] + v[i][j][3]);
                sm[i] = s; }
#pragma unroll
            for (int o = 1; o < 64; o <<= 1) {
#pragma unroll
                for (int i = 0; i < 8; ++i) sm[i] += __shfl_xor(sm[i], o); }
#pragma unroll
            for (int i = 0; i < 8; ++i) { const float mean = sm[i] * (1.0f / D); float s2 = 0.f;
#pragma unroll
                for (int j = 0; j < 4; ++j) { v[i][j] = v[i][j] - mean; s2 += (v[i][j][0] * v[i][j][0] + v[i][j][1] * v[i][j][1]) + (v[i][j][2] * v[i][j][2] + v[i][j][3] * v[i][j][3]); }
                sq[i] = s2; }
#pragma unroll
            for (int o = 1; o < 64; o <<= 1) {
#pragma unroll
                for (int i = 0; i < 8; ++i) sq[i] += __shfl_xor(sq[i], o); }
#pragma unroll
            for (int j = 0; j < 4; ++j) {
                const f32x4 gg = *((const f32x4*)p.ln1g + lane + 64 * j), bb = *((const f32x4*)p.ln1b + lane + 64 * j);
#pragma unroll
                for (int i = 0; i < 8; ++i) {
                    const int row = u * 64 + w * 8 + i;
                    const float rstd = rsqrtf(sq[i] * (1.0f / D) + LN_EPS);
                    const f32x4 y = v[i][j] * rstd * gg + bb;
                    u32x2 pk = {cvt_pk(y[0], y[1]), cvt_pk(y[2], y[3])};
                    *(u32x2*)(x1b + ((size_t)((lane >> 4) + 4 * j) * S + row) * 64 + ((4 * lane) & 63)) = pk;
                }
            }
        }
        asm volatile("s_waitcnt vmcnt(0)" ::: "memory");
        __syncthreads();
        { G2Args g; g.A = (const char*)x1b; g.B = (const char*)(p.ws + WS_WR); g.nk = D / 64; g.akstep = S * 128;
          g2_rows_A<4>(g, (size_t)u * 64, 128); g.offA[1] = g.offA[0]; g2_rows_B(g, 0, D * 2);
          EpiLogits e{(float*)lds};
          gemm2<4>(lds, g, e); }
        __syncthreads();
        const f32x4 rb = *((const f32x4*)p.r_bias + lane);
        const float NEG = -__builtin_inff();
        for (int i0 = 0; i0 < 8; i0 += 4) {
            float sc[4][4], cand[4][4]; int my_e[4]; float my_s[4], gsum[4];
#pragma unroll
            for (int q = 0; q < 4; ++q) {
                const int tl = w * 8 + i0 + q;
                const f32x4 lg = *((const f32x4*)((const float*)lds + tl * 256) + lane);
#pragma unroll
                for (int j = 0; j < 4; ++j) { sc[q][j] = 1.0f / (1.0f + __expf(-lg[j])); cand[q][j] = sc[q][j] + rb[j]; }
                my_e[q] = 0; my_s[q] = 0.f; gsum[q] = 0.f;
            }
            float a1[4], a2[4];
#pragma unroll
            for (int q = 0; q < 4; ++q) { const float m01 = fmaxf(cand[q][0], cand[q][1]), n01 = fminf(cand[q][0], cand[q][1]), m23 = fmaxf(cand[q][2], cand[q][3]), n23 = fminf(cand[q][2], cand[q][3]);
              a1[q] = fmaxf(m01, m23); a2[q] = fmaxf(fminf(m01, m23), fmaxf(n01, n23)); }
#pragma unroll
            for (int off = 1; off < 8; off <<= 1) {
#pragma unroll
                for (int q = 0; q < 4; ++q) { const float b1 = __shfl_xor(a1[q], off), b2 = __shfl_xor(a2[q], off); const float n1 = fmaxf(a1[q], b1), n2 = fmaxf(fminf(a1[q], b1), fmaxf(a2[q], b2)); a1[q] = n1; a2[q] = n2; }
            }
            const int mygrp = lane >> 3;
#pragma unroll
            for (int q = 0; q < 4; ++q) {
                const float gs = a1[q] + a2[q]; int rank = 0;
#pragma unroll
                for (int g2 = 0; g2 < 8; ++g2) { const float v = __shfl(gs, g2 * 8); rank += (v > gs || (v == gs && g2 < mygrp)) ? 1 : 0; }
                if (rank >= 4) {
#pragma unroll
                    for (int j = 0; j < 4; ++j) cand[q][j] = NEG;
                }
            }
#pragma unroll
            for (int k = 0; k < 8; ++k) {
                float bv[4]; int idx[4];
#pragma unroll
                for (int q = 0; q < 4; ++q) { bv[q] = cand[q][0]; int bi = 0;
#pragma unroll
                    for (int j = 1; j < 4; ++j) if (cand[q][j] > bv[q]) { bv[q] = cand[q][j]; bi = j; }
                    idx[q] = 4 * lane + bi; }
#pragma unroll
                for (int off = 32; off >= 1; off >>= 1) {
#pragma unroll
                    for (int q = 0; q < 4; ++q) { const float ov = __shfl_xor(bv[q], off); const int oi = __shfl_xor(idx[q], off); if (ov > bv[q] || (ov == bv[q] && oi < idx[q])) { bv[q] = ov; idx[q] = oi; } }
                }
#pragma unroll
                for (int q = 0; q < 4; ++q) {
                    const int owner = idx[q] >> 2, sub = idx[q] & 3;
                    float scv = sc[q][0];
#pragma unroll
                    for (int j = 1; j < 4; ++j) scv = (sub == j) ? sc[q][j] : scv;
                    if (lane == owner) {
#pragma unroll
                        for (int j = 0; j < 4; ++j) if (sub == j) cand[q][j] = NEG;
                    }
                    const float gsc = __shfl(scv, owner);
                    if (lane == k) { my_e[q] = idx[q]; my_s[q] = gsc; }
                    gsum[q] += gsc;
                }
            }
            if (lane < 8) {
#pragma unroll
                for (int q = 0; q < 4; ++q) {
                    const int t = u * 64 + w * 8 + i0 + q;
                    const float gate = my_s[q] / gsum[q] * 2.5f;
                    const unsigned pos = atomicAdd(cnt + my_e[q] * CNT_STRIDE, 1u);
                    list[(size_t)my_e[q] * CAP + pos] = t * 8 + lane;
                    gates[t * 8 + lane] = gate;
                }
            }
        }
        __syncthreads();
    }
}

#ifndef MOE_MT
#define MOE_MT 8
#endif
constexpr int MOE_BM = 32 * MOE_MT;
struct EpiAct {
    bf16_t* act; const int* slots;
    __device__ __forceinline__ void operator()(f32x4 (&acc)[MOE_MT][4], int pass, int wr, int wc, int fr, int fq) const {
        const int ncol0 = pass * 128;
#pragma unroll
        for (int mt = 0; mt < MOE_MT; ++mt) {
            const int ar = slots[wr * 16 * MOE_MT + mt * 16 + fr];
            if (ar >= 0) {
                float a[8];
#pragma unroll
                for (int nt = 0; nt < 2; ++nt)
#pragma unroll
                    for (int j = 0; j < 4; ++j) { const float gq = acc[mt][nt][j]; a[nt * 4 + j] = gq * __builtin_amdgcn_rcpf(1.0f + __expf(-gq)) * (acc[mt][nt + 2][j]); }
                u32x4 pk = {cvt_pk(a[0], a[1]), cvt_pk(a[2], a[3]), cvt_pk(a[4], a[5]), cvt_pk(a[6], a[7])};
                *(u32x4*)(act + (size_t)ar * FF + ncol0 + wc * 32 + 8 * fq) = pk;
            }
        }
    }
};
struct EpiY {
    bf16_t* y; const int* yrows; const float* gl;
    __device__ __forceinline__ void operator()(f32x4 (&acc)[MOE_MT][4], int pass, int wr, int wc, int fr, int fq) const {
        const int col0 = pass * 256;
#pragma unroll
        for (int mt = 0; mt < MOE_MT; ++mt) {
            const int r = wr * 16 * MOE_MT + mt * 16 + fr, yr = yrows[r];
            if (yr >= 0) {
                const float gt = gl[r];
#pragma unroll
                for (int a = 0; a < 2; ++a) {
                    const f32x4 v0 = acc[mt][2 * a] * gt, v1 = acc[mt][2 * a + 1] * gt;
                    u32x4 pk = {cvt_pk(v0[0], v0[1]), cvt_pk(v0[2], v0[3]), cvt_pk(v1[0], v1[1]), cvt_pk(v1[2], v1[3])};
                    *(u32x4*)(y + (size_t)yr * D + col0 + wc * 64 + a * 32 + 8 * fq) = pk;
                }
            }
        }
    }
};
__device__ __forceinline__ void phase_experts(const Params& p, char* lds, int vb, int G) {
    const int tid0 = threadIdx.x, w = __builtin_amdgcn_readfirstlane(tid0 >> 6);
    const unsigned* cnt = (const unsigned*)(p.ws + WS_CTL + 65536); const int* list = (const int*)(p.ws + WS_LIST); const float* gates = (const float*)(p.ws + WS_GATE);
    bf16_t* act = (bf16_t*)(p.ws + WS_ACT); bf16_t* ybuf = (bf16_t*)(p.ws + WS_Y);
    int* nts = (int*)(lds + LDS_MISC); int* pre = nts + 256;
    int* s_arow = pre + 260; int* s_yrow = s_arow + MOE_BM; int* s_tok = s_yrow + MOE_BM; float* s_gate = (float*)(s_tok + MOE_BM);
    if (tid0 < 256) nts[tid0] = (int)((__hip_atomic_load(cnt + tid0 * CNT_STRIDE, __ATOMIC_RELAXED, __HIP_MEMORY_SCOPE_AGENT) + (MOE_BM - 1)) / MOE_BM);
    __syncthreads();
    if (tid0 < 257) { int s = 0; for (int e = 0; e < tid0; ++e) s += nts[e]; pre[tid0] = s; }
    __syncthreads();
    const int NR = __builtin_amdgcn_readfirstlane(pre[256]), NU = NR + S / MOE_BM;
    for (int u = vb; u < NU; u += G) {
        __syncthreads();
        int tid = threadIdx.x; asm volatile("" : "+v"(tid));
        const int lane = tid & 63; const unsigned co = g2_chunk_off(lane, w);
        const float *bg, *bu, *bd;
        if (u < NR) {
            int lo = 0, hi = 255;
            while (lo < hi) { const int mid = (lo + hi + 1) >> 1; if (pre[mid] <= u) lo = mid; else hi = mid - 1; }
            const int e = lo, tile = u - pre[e], n = (int)__hip_atomic_load(cnt + e * CNT_STRIDE, __ATOMIC_RELAXED, __HIP_MEMORY_SCOPE_AGENT);
            if (tid < MOE_BM) {
                const int idx = tile * MOE_BM + tid;
                if (idx < n) { const int slot = list[(size_t)e * CAP + idx]; s_arow[tid] = slot; s_yrow[tid] = slot + (slot >> 3); s_tok[tid] = slot >> 3; s_gate[tid] = gates[slot]; }
                else { s_arow[tid] = -1; s_yrow[tid] = -1; s_tok[tid] = 0; s_gate[tid] = 0.f; }
            }
            bg = p.w_g + (size_t)e * D * FF; bu = p.w_u + (size_t)e * D * FF; bd = p.w_d + (size_t)e * FF * D;
        } else {
            const int tile = u - NR;
            if (tid < MOE_BM) { const int tk = tile * MOE_BM + tid; s_arow[tid] = S * 8 + tk; s_yrow[tid] = tk * 9 + 8; s_tok[tid] = tk; s_gate[tid] = 1.0f; }
            bg = p.ws_g; bu = p.ws_u; bd = p.ws_d;
        }
        __syncthreads();
        { G3fArgs g; g.A = (const char*)(p.ws + WS_X1B); g.nk = D / 64; g.akstep = S * 128;
#pragma unroll
          for (int i = 0; i < MOE_MT / 2; ++i) g.offA[i] = (unsigned)s_tok[i * 64 + w * 8 + (lane >> 3)] * 128u + co;
          { const int bwc = lane >> 4, nt = (lane >> 2) & 3, bfq = lane & 3;
            g.b = ((nt < 2) ? bg : bu) + bwc * 32 + 8 * bfq + 4 * (nt & 1) + (size_t)(w * 8) * FF; }
          EpiAct e{act, s_arow};
          gemm3f<MOE_MT, FF>(lds, g, 2, 128, e); }
        asm volatile("s_waitcnt vmcnt(0)" ::: "memory");
        __syncthreads();
        { G3fArgs g; g.A = (const char*)act; g.nk = FF / 64; g.akstep = 128;
#pragma unroll
          for (int i = 0; i < MOE_MT / 2; ++i) { const int ar = s_arow[i * 64 + w * 8 + (lane >> 3)]; g.offA[i] = (unsigned)(ar < 0 ? 0 : ar) * (unsigned)(FF * 2) + co; }
          g.b = bd + (size_t)(w * 8) * D + (lane >> 4) * 64 + (((lane >> 2) & 3) >> 1) * 32 + 8 * (lane & 3) + 4 * ((lane >> 2) & 1);
          EpiY e{ybuf, s_yrow, s_gate};
          gemm3f<MOE_MT, D>(lds, g, 4, 256, e); }
    }
}

__device__ __forceinline__ void phase_final(const Params& p, int vb, int G) {
    const int lane = threadIdx.x & 63, w = threadIdx.x >> 6;
    const bf16_t* x1b = (const bf16_t*)(p.ws + WS_X1B); const bf16_t* ybuf = (const bf16_t*)(p.ws + WS_Y);
    const int stride = G * 8;
#define F_LOAD(q, row) do { \
        _Pragma("unroll") for (int j = 0; j < 2; ++j) q[j] = *(const u32x4*)(x1b + ((size_t)((lane >> 3) + 8 * j) * S + (row)) * 64 + ((8 * lane) & 63)); \
        _Pragma("unroll") for (int k = 0; k < 9; ++k) { const u32x4* yr = (const u32x4*)(ybuf + (size_t)((row) * 9 + k) * D) + lane; q[2 + 2 * k] = yr[0]; q[3 + 2 * k] = yr[64]; } } while (0)
#define F_PROC(q, row) do { float v[2][8]; \
        _Pragma("unroll") for (int j = 0; j < 2; ++j) _Pragma("unroll") for (int e = 0; e < 4; ++e) { v[j][2 * e] = bf_lo(q[j][e]) * ALPHA; v[j][2 * e + 1] = bf_hi(q[j][e]) * ALPHA; } \
        _Pragma("unroll") for (int k = 0; k < 9; ++k) _Pragma("unroll") for (int j = 0; j < 2; ++j) _Pragma("unroll") for (int e = 0; e < 4; ++e) { v[j][2 * e] += bf_lo(q[2 + 2 * k + j][e]); v[j][2 * e + 1] += bf_hi(q[2 + 2 * k + j][e]); } \
        float sm = 0.f; \
        _Pragma("unroll") for (int j = 0; j < 2; ++j) _Pragma("unroll") for (int e = 0; e < 8; ++e) sm += v[j][e]; \
        sm = wave_sum(sm); \
        const float mean = sm * (1.0f / D); float sq = 0.f; \
        _Pragma("unroll") for (int j = 0; j < 2; ++j) _Pragma("unroll") for (int e = 0; e < 8; ++e) { v[j][e] -= mean; sq += v[j][e] * v[j][e]; } \
        sq = wave_sum(sq); \
        const float rstd = rsqrtf(sq * (1.0f / D) + LN_EPS); \
        _Pragma("unroll") for (int j = 0; j < 2; ++j) { \
            const f32x4 g0 = *((const f32x4*)p.ln2g + 2 * lane + 128 * j), g1 = *((const f32x4*)p.ln2g + 2 * lane + 128 * j + 1); \
            const f32x4 b0 = *((const f32x4*)p.ln2b + 2 * lane + 128 * j), b1 = *((const f32x4*)p.ln2b + 2 * lane + 128 * j + 1); \
            f32x4* op = (f32x4*)(p.out + (size_t)(row) * D) + 2 * lane + 128 * j; \
            op[0] = (f32x4){v[j][0], v[j][1], v[j][2], v[j][3]} * rstd * g0 + b0; \
            op[1] = (f32x4){v[j][4], v[j][5], v[j][6], v[j][7]} * rstd * g1 + b1; } } while (0)
    u32x4 qa[20], qb[20];
    int row = vb * 8 + w;
    if (row < S) F_LOAD(qa, row);
    for (; row < S; row += 2 * stride) {
        const bool n1 = row + stride < S, n2 = row + 2 * stride < S;
        if (n1) F_LOAD(qb, row + stride);
        __builtin_amdgcn_sched_barrier(0);
        F_PROC(qa, row);
        if (n1) {
            if (n2) F_LOAD(qa, row + 2 * stride);
            __builtin_amdgcn_sched_barrier(0);
            F_PROC(qb, row + stride);
        }
    }
#undef F_LOAD
#undef F_PROC
}

__global__ void __launch_bounds__(NTHREADS) mega(Params p) {
    extern __shared__ __attribute__((aligned(16))) char lds[];
    const int G = gridDim.x, bx = blockIdx.x;
    const int vb = (G % 8 == 0) ? (bx % 8) * (G / 8) + bx / 8 : bx;
    if (threadIdx.x < 4) ((volatile LAS unsigned*)((LAS char*)lds + LDS_BARST))[threadIdx.x] = 0u;
    __syncthreads();
    XcdBarrier bar; bar.bar = (unsigned*)(p.ws + WS_CTL) + CW_BAR; bar.x = 0; bar.st = nullptr;
    if (p.ph_hi - p.ph_lo > 1) bar = xcd_barrier_post((unsigned*)(p.ws + WS_CTL) + CW_BAR, (volatile LAS unsigned*)((LAS char*)lds + LDS_BARST));
#define SEAM(k) do { if (p.ph_lo <= (k) && (k) + 1 < p.ph_hi) { xcd_barrier(bar); } } while (0)
#define IN(k) (p.ph_lo <= (k) && (k) < p.ph_hi)
#define RUN(k, call) do { if (IN(k)) { call; if (MK_REPEAT == (k)) { __syncthreads(); call; } } } while (0)
    RUN(0, phase_prep(p, vb, G)); SEAM(0);
    RUN(1, phase_proj(p, lds, vb, G)); SEAM(1);
    RUN(2, phase_attn(p, lds, vb, G)); SEAM(2);
    RUN(3, phase_wout(p, lds, vb, G)); SEAM(3);
    if (IN(4)) { phase_router(p, lds, vb, G); } SEAM(4);
    RUN(5, phase_experts(p, lds, vb, G)); SEAM(5);
    RUN(6, phase_final(p, vb, G));
#undef SEAM
#undef IN
#undef RUN
}

extern "C" void kernel_launch(void* const* d_in, const int* in_sizes, int n_in, void* d_out, int out_size, void* d_ws, size_t ws_size, hipStream_t stream) {
    static int grid = 0;
    if (grid == 0) {
        if (n_in != 22 || in_sizes[0] != S * D || out_size != S * D || ws_size < WS_END) {
            fprintf(stderr, "kernel_launch: unexpected shapes: n_in %d in0 %d out %d ws %zu (need %zu)\n", n_in, n_in > 0 ? in_sizes[0] : -1, out_size, ws_size, (size_t)WS_END); grid = -1; return; }
        int dev = 0, cus = 0, per_cu = 0;
        (void)hipGetDevice(&dev); (void)hipDeviceGetAttribute(&cus, hipDeviceAttributeMultiprocessorCount, dev);
        if (hipFuncSetAttribute((const void*)mega, hipFuncAttributeMaxDynamicSharedMemorySize, LDS_BYTES) != hipSuccess) { fprintf(stderr, "kernel_launch: hipFuncSetAttribute failed\n"); grid = -1; return; }
        (void)hipOccupancyMaxActiveBlocksPerMultiprocessor(&per_cu, (const void*)mega, NTHREADS, LDS_BYTES);
        if (per_cu < 1) { fprintf(stderr, "kernel_launch: occupancy query says %d blocks per CU\n", per_cu); per_cu = 1; }
        grid = cus * 1;
        (void)hipGetLastError();
    }
    if (grid < 0) return;
    (void)hipMemsetAsync((char*)d_ws + WS_CTL, 0, CTL_BYTES, stream);
    Params p{};
    const float** f = (const float**)&p;
    for (int i = 0; i < 22; ++i) f[i] = (const float*)d_in[i];
    p.out = (float*)d_out; p.ws = (unsigned char*)d_ws;
#if MK_ONE_LAUNCH
    p.ph_lo = 0; p.ph_hi = 7;
    void* args[] = {&p};
    hipError_t e = hipLaunchCooperativeKernel((const void*)mega, dim3(grid), dim3(NTHREADS), args, LDS_BYTES, stream);
    if (e != hipSuccess) fprintf(stderr, "kernel_launch: cooperative launch failed: %s (grid %d)\n", hipGetErrorString(e), grid);
#else
    for (int ph = 0; ph < 7; ++ph) {
        p.ph_lo = ph; p.ph_hi = ph + 1;
        hipLaunchKernelGGL(mega, dim3(grid), dim3(NTHREADS), LDS_BYTES, stream, p);
    }
#endif
}
```

```cpp
#include <hip/hip_runtime.h>
#include <hip/hip_cooperative_groups.h>
#include <cstdio>
#include <cstdint>
namespace cg = cooperative_groups;

#ifndef MK_REPEAT
#define MK_REPEAT -1
#endif
#ifndef MK_ONE_LAUNCH
#define MK_ONE_LAUNCH 1
#endif

constexpr int S = 16384, D = 1024, INW = 2304, NE = 256, FF = 256;
constexpr int NTHREADS = 512;
constexpr int CAP = 16384;
constexpr float ALPHA = 1.189207115002721f;
constexpr float LN_EPS = 1e-5f;
constexpr float QSCALE = 0.125f * 1.4426950408889634f;
constexpr float LOG2E = 1.4426950408889634f;
constexpr int C_AQ = 0, C_AK = 512, C_AV = 640, C_BQ = 768, C_BK = 1280, C_BV = 1792;

constexpr size_t MiB = 1ull << 20;
constexpr size_t WS_CTL = 0;
constexpr size_t CTL_BYTES = 128 * 1024;
constexpr int CNT_STRIDE = 64;
constexpr size_t WS_ROPE = 1 * MiB;
constexpr size_t WS_WIN = 8 * MiB;
constexpr size_t WS_WOUT = 13 * MiB;
constexpr size_t WS_WR = 15 * MiB;
constexpr size_t WS_WSGU = 16 * MiB;
constexpr size_t WS_WSD = 17 * MiB;
constexpr size_t WS_EGU = 20 * MiB;
constexpr size_t WS_ED = 276 * MiB;
constexpr size_t WS_X1F = 404 * MiB;
constexpr size_t WS_X1B = 468 * MiB;
constexpr size_t WS_LIST = 500 * MiB;
constexpr size_t WS_GATE = 516 * MiB;
constexpr size_t WS_ACT = 518 * MiB;
constexpr size_t WS_Y = 590 * MiB;
constexpr size_t WS_XB = 590 * MiB;
constexpr size_t WS_PROJ = 622 * MiB;
constexpr size_t WS_ATT = 694 * MiB;
constexpr size_t WS_PRELN = 726 * MiB;
constexpr size_t WS_END = 878 * MiB;

constexpr int LDS_BYTES = 147456;
constexpr int LDS_MISC = 131072;

typedef unsigned short bf16_t;
typedef short bf16x8 __attribute__((ext_vector_type(8)));
typedef short s16x4 __attribute__((ext_vector_type(4)));
typedef float f32x4 __attribute__((ext_vector_type(4)));
typedef float f32x16 __attribute__((ext_vector_type(16)));
typedef unsigned u32x4 __attribute__((ext_vector_type(4)));
typedef unsigned u32x2 __attribute__((ext_vector_type(2)));
typedef float f32x2 __attribute__((ext_vector_type(2)));


#define LAS __attribute__((address_space(3)))
#define XB_TMO      128
#define XB_XCNT(j)  (256  + 64 * (j))
#define XB_XSUB(j)  (1280 + 64 * (j))
#define XB_XGEN(j)  (2304 + 64 * (j))
#define XB_TOP      3328
#define XB_TOPGEN   3392
#define XCD_BAR_WORDS 3456
#define XB_SPIN_CAP (1u << 18)
__device__ __forceinline__ unsigned xb_ld(unsigned* p)              { return __hip_atomic_load(p, __ATOMIC_RELAXED, __HIP_MEMORY_SCOPE_AGENT); }
__device__ __forceinline__ unsigned xb_add(unsigned* p, unsigned v) { return __hip_atomic_fetch_add(p, v, __ATOMIC_RELAXED, __HIP_MEMORY_SCOPE_AGENT); }
__device__ __forceinline__ unsigned xb_xcc_id() { return (unsigned)__builtin_amdgcn_s_getreg((3 << 11) | 20) & 0xFu; }
#define XB_SPIN(cond, bar) do { unsigned _sp = 0; while (cond) { __builtin_amdgcn_s_sleep(1); \
    if ((++_sp & 255u) == 0u) { if (xb_ld(&(bar)[XB_TMO])) break; if (_sp > XB_SPIN_CAP) { atomicAdd(&(bar)[XB_TMO], 1u); break; } } } } while (0)
struct XcdBarrier { unsigned* bar; unsigned x; volatile LAS unsigned* st; };
__device__ __forceinline__ XcdBarrier xcd_barrier_post(unsigned* bar, volatile LAS unsigned* st) {
    XcdBarrier b; b.bar = bar; b.x = xb_xcc_id(); b.st = st;
    if (threadIdx.x == 0) (void)xb_add(&bar[XB_XCNT(b.x)], 1u);
    return b;
}
__device__ __forceinline__ void xcd_barrier_complete(unsigned* bar, unsigned x, unsigned& nloc, unsigned& nx) {
    const unsigned G = gridDim.x * gridDim.y * gridDim.z;
    unsigned sum, cnt, mine, sp = 0u;
    for (;;) {
        sum = 0u; cnt = 0u; mine = 0u;
#pragma unroll
        for (unsigned j = 0; j < 16; ++j) { const unsigned c = xb_ld(&bar[XB_XCNT(j)]); sum += c; cnt += (c > 0u) ? 1u : 0u; mine = (j == x) ? c : mine; }
        if (sum == G) break;
        __builtin_amdgcn_s_sleep(1);
        if ((++sp & 255u) == 0u) { if (xb_ld(&bar[XB_TMO])) break; if (sp > XB_SPIN_CAP) { atomicAdd(&bar[XB_TMO], 1u); break; } }
    }
    nloc = mine > 0u ? mine : 1u; nx = cnt > 0u ? cnt : 1u;
}
__device__ __forceinline__ void xcd_barrier(const XcdBarrier& b) {
    asm volatile("s_waitcnt vmcnt(0)" ::: "memory");
    __syncthreads();
    if (threadIdx.x == 0) {
        unsigned* bar = b.bar;
        __builtin_amdgcn_s_waitcnt(0);
        unsigned nloc = b.st[0], nx = b.st[1];
        if (nloc == 0u) { xcd_barrier_complete(bar, b.x, nloc, nx); b.st[0] = nloc; b.st[1] = nx; }
        const unsigned old = xb_add(&bar[XB_XSUB(b.x)], 1u);
        const unsigned gen = old / nloc;
        if (old + 1u == (gen + 1u) * nloc) {
            __builtin_amdgcn_fence(__ATOMIC_RELEASE, "agent");
            asm volatile("s_waitcnt vmcnt(0)" ::: "memory");
            const unsigned og = xb_add(&bar[XB_TOP], 1u);
            const unsigned tg = og / nx;
            if (og + 1u == (tg + 1u) * nx) xb_add(&bar[XB_TOPGEN], 1u);
            else XB_SPIN(xb_ld(&bar[XB_TOPGEN]) == tg, bar);
            __builtin_amdgcn_fence(__ATOMIC_ACQUIRE, "agent");
            xb_add(&bar[XB_XGEN(b.x)], 1u);
            asm volatile("s_waitcnt vmcnt(0)" ::: "memory");
        } else {
            XB_SPIN(xb_ld(&bar[XB_XGEN(b.x)]) == gen, bar);
            __builtin_amdgcn_fence(__ATOMIC_ACQUIRE, "agent");
            asm volatile("s_waitcnt vmcnt(0)" ::: "memory");
        }
    }
    __syncthreads();
}
constexpr int CW_BAR = 4096;
constexpr int LDS_BARST = LDS_MISC + 8192;

struct Params {
    const float* x; const float* w_in; const float* b_in; const float* sinks;
    const float* lq1; const float* lk1; const float* lq2; const float* lk2; const float* subg;
    const float* w_out; const float* ln1g; const float* ln1b; const float* w_r; const float* r_bias;
    const float* w_g; const float* w_u; const float* w_d; const float* ws_g; const float* ws_u; const float* ws_d;
    const float* ln2g; const float* ln2b;
    float* out; unsigned char* ws;
    int ph_lo, ph_hi;
};

__device__ __forceinline__ unsigned cvt_pk(float lo, float hi) { unsigned r; asm volatile("v_cvt_pk_bf16_f32 %0, %1, %2" : "=v"(r) : "v"(lo), "v"(hi)); return r; }
typedef __bf16 bf16x2_t __attribute__((ext_vector_type(2)));
__device__ __forceinline__ unsigned cvt_pk_vis(float lo, float hi) { const bf16x2_t r = __builtin_convertvector((f32x2){lo, hi}, bf16x2_t); return *(const unsigned*)&r; }
__device__ __forceinline__ float bf_lo(unsigned u) { return __uint_as_float(u << 16); }
__device__ __forceinline__ float bf_hi(unsigned u) { return __uint_as_float(u & 0xffff0000u); }
__device__ __forceinline__ float wave_sum(float v) {
#pragma unroll
    for (int o = 1; o < 64; o <<= 1) v += __shfl_xor(v, o);
    return v;
}
__device__ __forceinline__ float half_max(float v) { auto rr = __builtin_amdgcn_permlane32_swap(__float_as_uint(v), __float_as_uint(v), false, false); return fmaxf(__uint_as_float(rr[0]), __uint_as_float(rr[1])); }
__device__ __forceinline__ float half_sum(float v) { auto rr = __builtin_amdgcn_permlane32_swap(__float_as_uint(v), __float_as_uint(v), false, false); return __uint_as_float(rr[0]) + __uint_as_float(rr[1]); }

__device__ __forceinline__ int swz(int r, int c) { const int f = (r & 7) ^ (((r >> 3) & 1) << 1) ^ ((r >> 4) & 1); return r * 128 + ((c ^ f) << 4); }

struct G2Args {
    const char* A; const char* B;
    unsigned offA[4], offB[4];
    int nk;
    unsigned akstep;
};
__device__ __forceinline__ unsigned g2_chunk_off(int lane, int w) { const int f = (lane >> 3) ^ ((w & 1) << 1) ^ ((w >> 1) & 1); return (unsigned)(((lane & 7) ^ f) << 4); }
template <int MT, int NT, class Epi>
__device__ __forceinline__ void gemm2n(char* lds_, const G2Args& g, const Epi& epi) {
    constexpr int A_BYTES = 32 * MT * 128, B_BYTES = 64 * NT * 128, STAGE = A_BYTES + B_BYTES, AR = MT / 2, BRR = NT;
    LAS char* lds = (LAS char*)lds_;
    const int tid = threadIdx.x, lane = tid & 63, w = __builtin_amdgcn_readfirstlane(tid >> 6), wr = w >> 2, wc = w & 3, fr = lane & 15, fq = lane >> 4;
    f32x4 acc[MT][NT];
#pragma unroll
    for (int i = 0; i < MT; ++i)
#pragma unroll
        for (int j = 0; j < NT; ++j) acc[i][j] = (f32x4){0.f, 0.f, 0.f, 0.f};
    const int ldsw = w * 1024;
#define G2_STAGE(kt, s) do { \
        _Pragma("unroll") for (int i = 0; i < AR; ++i) __builtin_amdgcn_global_load_lds((const unsigned*)(g.A + g.offA[i] + (size_t)(kt) * g.akstep), (LAS unsigned*)(lds + (s) * STAGE + i * 8192 + ldsw), 16, 0, 0); \
        _Pragma("unroll") for (int i = 0; i < BRR; ++i) __builtin_amdgcn_global_load_lds((const unsigned*)(g.B + g.offB[i] + (size_t)(kt) * 128), (LAS unsigned*)(lds + (s) * STAGE + A_BYTES + i * 8192 + ldsw), 16, 0, 0); } while (0)
    G2_STAGE(0, 0);
    __syncthreads();
    for (int kt = 0; kt < g.nk; ++kt) {
        const int s = kt & 1;
        if (kt + 1 < g.nk) { if (s) G2_STAGE(kt + 1, 0); else G2_STAGE(kt + 1, 1); }
        const char* la = lds_ + s * STAGE; const char* lb = la + A_BYTES;
        {
            constexpr int NG = 2 * (MT / 4);
            bf16x8 bfr[NT], af[2][4];
#pragma unroll
            for (int nt = 0; nt < NT; ++nt) bfr[nt] = *(const bf16x8*)(lb + swz(wc * 16 * NT + nt * 16 + fr, fq));
#pragma unroll
            for (int m = 0; m < 4; ++m) af[0][m] = *(const bf16x8*)(la + swz(wr * 16 * MT + m * 16 + fr, fq));
#pragma unroll
            for (int gi = 0; gi < NG; ++gi) {
                const int ks = gi / (MT / 4), h = gi % (MT / 4);
                if (gi > 0 && h == 0) {
#pragma unroll
                    for (int nt = 0; nt < NT; ++nt) bfr[nt] = *(const bf16x8*)(lb + swz(wc * 16 * NT + nt * 16 + fr, ks * 4 + fq));
                }
                if (gi + 1 < NG) {
                    const int ks2 = (gi + 1) / (MT / 4), h2 = (gi + 1) % (MT / 4);
#pragma unroll
                    for (int m = 0; m < 4; ++m) af[(gi + 1) & 1][m] = *(const bf16x8*)(la + swz(wr * 16 * MT + (h2 * 4 + m) * 16 + fr, ks2 * 4 + fq));
                }
                __builtin_amdgcn_sched_barrier(0);
#pragma unroll
                for (int m = 0; m < 4; ++m)
#pragma unroll
                    for (int nt = 0; nt < NT; ++nt) acc[h * 4 + m][nt] = __builtin_amdgcn_mfma_f32_16x16x32_bf16(bfr[nt], af[gi & 1][m], acc[h * 4 + m][nt], 0, 0, 0);
                __builtin_amdgcn_sched_barrier(0);
            }
        }
        __syncthreads();
    }
#undef G2_STAGE
    epi(acc, wr, wc, fr, fq);
}
template <int MT, class Epi>
__device__ __forceinline__ void gemm2(char* lds_, const G2Args& g, const Epi& epi) { gemm2n<MT, 4>(lds_, g, epi); }
template <int MT>
__device__ __forceinline__ void g2_rows_A(G2Args& g, size_t row0, unsigned ld_bytes) {
    const int lane = threadIdx.x & 63, w = __builtin_amdgcn_readfirstlane(threadIdx.x >> 6); const unsigned co = g2_chunk_off(lane, w);
#pragma unroll
    for (int i = 0; i < MT / 2; ++i) g.offA[i] = (unsigned)((row0 + i * 64 + w * 8 + (lane >> 3)) * ld_bytes) + co;
}
__device__ __forceinline__ void g2_rows_B(G2Args& g, size_t row0, unsigned ld_bytes) {
    const int lane = threadIdx.x & 63, w = __builtin_amdgcn_readfirstlane(threadIdx.x >> 6); const unsigned co = g2_chunk_off(lane, w);
#pragma unroll
    for (int i = 0; i < 4; ++i) g.offB[i] = (unsigned)((row0 + i * 64 + w * 8 + (lane >> 3)) * ld_bytes) + co;
}


struct G3fArgs { const char* A; unsigned offA[4]; const float* b; int nk; unsigned akstep; };
template <int MT, int LDB, class Epi>
__device__ __forceinline__ void gemm3f(char* lds_, const G3fArgs& g, int npass, int bpstep, const Epi& epi) {
    constexpr int A_BYTES = 32 * MT * 128, B_BYTES = 256 * 128, STAGE = A_BYTES + B_BYTES, AR = MT / 2;
    LAS char* lds = (LAS char*)lds_;
    int tid = threadIdx.x; asm volatile("" : "+v"(tid));
    const int lane = tid & 63, w = __builtin_amdgcn_readfirstlane(tid >> 6), wr = w >> 2, wc = w & 3, fr = lane & 15, fq = lane >> 4;
    f32x4 acc[MT][4];
#pragma unroll
    for (int i = 0; i < MT; ++i)
#pragma unroll
        for (int j = 0; j < 4; ++j) acc[i][j] = (f32x4){0.f, 0.f, 0.f, 0.f};
    const int ldsw = w * 1024;
    int bw[4];
#pragma unroll
    for (int j = 0; j < 4; ++j) bw[j] = swz(4 * lane + j, w);
    f32x4 br[8];
    const int nk = g.nk, nsteps = nk * npass;
#define G3_STAGE_A(kt, s) do { \
        _Pragma("unroll") for (int i = 0; i < AR; ++i) __builtin_amdgcn_global_load_lds((const unsigned*)(g.A + g.offA[i] + (size_t)(kt) * g.akstep), (LAS unsigned*)(lds + (s) * STAGE + i * 8192 + ldsw), 16, 0, 0); } while (0)
#define G3_LOAD_B(ps, kt) do { const float* pb_ = g.b + (size_t)(ps) * bpstep + (size_t)(kt) * 64 * LDB; _Pragma("unroll") for (int i = 0; i < 8; ++i) br[i] = *(const f32x4*)(pb_ + i * LDB); } while (0)
#define G3_WRITE_B(s) do { _Pragma("unroll") for (int j = 0; j < 4; ++j) { \
            u32x4 v = {cvt_pk(br[0][j], br[1][j]), cvt_pk(br[2][j], br[3][j]), cvt_pk(br[4][j], br[5][j]), cvt_pk(br[6][j], br[7][j])}; \
            *(u32x4*)(lds_ + (s) * STAGE + A_BYTES + bw[j]) = v; } } while (0)
#define G3_BARRIER(keep8) do { if (keep8) asm volatile("s_waitcnt vmcnt(8) lgkmcnt(0)\n\ts_barrier" ::: "memory"); else asm volatile("s_waitcnt vmcnt(0) lgkmcnt(0)\n\ts_barrier" ::: "memory"); } while (0)
    G3_STAGE_A(0, 0); G3_LOAD_B(0, 0); G3_WRITE_B(0);
    { const int kt1 = (nk > 1) ? 1 : 0, ps1 = (nk > 1) ? 0 : 1; if (nsteps > 1) G3_LOAD_B(ps1, kt1); }
    G3_BARRIER(nsteps > 1);
    int ps = 0, kt = 0;
    for (int st = 0; st < nsteps; ++st) {
        const int s = st & 1; const bool more = st + 1 < nsteps, more2 = st + 2 < nsteps;
        int ps2 = ps, kt2 = kt + 1; if (kt2 == nk) { kt2 = 0; ++ps2; }
        int ps3 = ps2, kt3 = kt2 + 1; if (kt3 == nk) { kt3 = 0; ++ps3; }
        if (more) { if (s) G3_STAGE_A(kt2, 0); else G3_STAGE_A(kt2, 1); }
        __builtin_amdgcn_sched_barrier(0);
        const char* la = lds_ + s * STAGE; const char* lb = la + A_BYTES;
        {
            constexpr int NG = MT;
            bf16x8 bfr[4], af[2][2];
#pragma unroll
            for (int nt = 0; nt < 4; ++nt) bfr[nt] = *(const bf16x8*)(lb + swz(wc * 64 + nt * 16 + fr, fq));
#pragma unroll
            for (int m = 0; m < 2; ++m) af[0][m] = *(const bf16x8*)(la + swz(wr * 16 * MT + m * 16 + fr, fq));
#pragma unroll
            for (int gi = 0; gi < NG; ++gi) {
                const int ks = gi / (MT / 2), h = gi % (MT / 2);
                if (gi > 0 && h == 0) {
#pragma unroll
                    for (int nt = 0; nt < 4; ++nt) bfr[nt] = *(const bf16x8*)(lb + swz(wc * 64 + nt * 16 + fr, ks * 4 + fq));
                }
                if (gi + 1 < NG) {
                    const int ks2 = (gi + 1) / (MT / 2), h2 = (gi + 1) % (MT / 2);
#pragma unroll
                    for (int m = 0; m < 2; ++m) af[(gi + 1) & 1][m] = *(const bf16x8*)(la + swz(wr * 16 * MT + (h2 * 2 + m) * 16 + fr, ks2 * 4 + fq));
                }
                __builtin_amdgcn_sched_barrier(0);
#pragma unroll
                for (int m = 0; m < 2; ++m)
#pragma unroll
                    for (int nt = 0; nt < 4; ++nt) acc[h * 2 + m][nt] = __builtin_amdgcn_mfma_f32_16x16x32_bf16(bfr[nt], af[gi & 1][m], acc[h * 2 + m][nt], 0, 0, 0);
                __builtin_amdgcn_sched_barrier(0);
            }
        }
        if (kt == nk - 1) {
            epi(acc, ps, wr, wc, fr, fq);
#pragma unroll
            for (int i = 0; i < MT; ++i)
#pragma unroll
                for (int j = 0; j < 4; ++j) acc[i][j] = (f32x4){0.f, 0.f, 0.f, 0.f};
        }
        if (more) { if (s) G3_WRITE_B(0); else G3_WRITE_B(1); }
        if (more2) G3_LOAD_B(ps3, kt3);
        G3_BARRIER(more2);
        ps = ps2; kt = kt2;
    }
#undef G3_BARRIER
#undef G3_STAGE_A
#undef G3_LOAD_B
#undef G3_WRITE_B
}

__device__ __forceinline__ void cvt_item(const float* W, int K, int N, bf16_t* WT, int ldt, int kb, int nb, int kc, int lane) {
    const float* src = W + (size_t)(kb * 64 + kc * 8) * N + nb * 256 + 4 * lane;
    bf16_t* dst = WT + (size_t)(nb * 256 + 4 * lane) * ldt + kb * 64 + kc * 8;
    f32x4 r[8];
#pragma unroll
    for (int i = 0; i < 8; ++i) r[i] = *(const f32x4*)(src + (size_t)i * N);
#pragma unroll
    for (int j = 0; j < 4; ++j) {
        u32x4 v = {cvt_pk(r[0][j], r[1][j]), cvt_pk(r[2][j], r[3][j]), cvt_pk(r[4][j], r[5][j]), cvt_pk(r[6][j], r[7][j])};
        *(u32x4*)(dst + (size_t)j * ldt) = v;
    }
}
__device__ __forceinline__ void phase_prep(const Params& p, int vb, int G) {
    const int tid = threadIdx.x, lane = tid & 63, w = tid >> 6;
    float* cs = (float*)(p.ws + WS_ROPE); float* sn = cs + (size_t)S * 32;
    for (int idx = vb * NTHREADS + tid; idx < S * 32; idx += G * NTHREADS) {
        const int pos = idx >> 5, i = idx & 31;
        const float pw = (float)pow(10000.0, (double)i / 32.0);
        const float inv = 1.0f / pw;
        const float angf = __fmul_rn((float)pos, inv);
        const double a = (double)angf;
        const double q = rint(a * 0.63661977236758134308);
        double r = fma(-q, 1.57079632679489655800, a); r = fma(-q, 6.12323399573676603587e-17, r);
        const double r2 = r * r;
        double sp = r * (1.0 + r2 * (-1.0 / 6 + r2 * (1.0 / 120 + r2 * (-1.0 / 5040 + r2 * (1.0 / 362880 + r2 * (-1.0 / 39916800))))));
        double cp = 1.0 + r2 * (-0.5 + r2 * (1.0 / 24 + r2 * (-1.0 / 720 + r2 * (1.0 / 40320 + r2 * (-1.0 / 3628800 + r2 * (1.0 / 479001600))))));
        const int qi = ((int)((long long)q)) & 3;
        double sv, cv;
        if (qi == 0) { sv = sp; cv = cp; } else if (qi == 1) { sv = cp; cv = -sp; } else if (qi == 2) { sv = -sp; cv = -cp; } else { sv = -cp; cv = sp; }
        cs[idx] = (float)cv; sn[idx] = (float)sv;
    }
    { const f32x4* xs = (const f32x4*)p.x; u32x4* xd = (u32x4*)(p.ws + WS_XB);
      for (size_t i = (size_t)vb * NTHREADS + tid; i < (size_t)S * D / 8; i += (size_t)G * NTHREADS) {
          const f32x4 a = xs[2 * i], b = xs[2 * i + 1];
          xd[i] = (u32x4){cvt_pk(a[0], a[1]), cvt_pk(a[2], a[3]), cvt_pk(b[0], b[1]), cvt_pk(b[2], b[3])}; } }
    const int gw = vb * 8 + w, NGW = G * 8;
    constexpr int I_IN = 16 * 9, I_OUT = 16 * 4, I_R = 16, I_SG = 16, I_SU = 16, I_SD = 4 * 4, I_SMALL = I_IN + I_OUT + I_R;
    for (int it8 = gw; it8 < I_SMALL * 8; it8 += NGW) {
        int r = it8 >> 3; const int kc = it8 & 7;
        if (r < I_IN) { cvt_item(p.w_in, D, INW, (bf16_t*)(p.ws + WS_WIN), D, r / 9, r % 9, kc, lane); continue; } r -= I_IN;
        if (r < I_OUT) { cvt_item(p.w_out, D, D, (bf16_t*)(p.ws + WS_WOUT), D, r >> 2, r & 3, kc, lane); continue; } r -= I_OUT;
        cvt_item(p.w_r, D, NE, (bf16_t*)(p.ws + WS_WR), D, r, 0, kc, lane);
    }
}

template <int MT> struct EpiProj {
    const float* bias; const float* cs; const float* sn; bf16_t* out; int row0, col0; char* lds;
    __device__ __forceinline__ void operator()(f32x4 (&acc)[MT][4], int wr, int wc, int fr, int fq) const {
        const int hb = col0 + wc * 64;
        const bool is_q = (hb < C_AK) || (hb >= C_BQ && hb < C_BK);
        const bool is_rope = is_q || (hb >= C_AK && hb < C_AV) || (hb >= C_BK && hb < C_BV);
        const float sc = is_q ? QSCALE : 1.0f;
        const int tid = threadIdx.x, w = __builtin_amdgcn_readfirstlane(tid >> 6), lane = tid & 63;
        constexpr int TB = 32 * MT * 128;
        LAS char* l3 = (LAS char*)lds;
#pragma unroll
        for (int i = 0; i < TB / 8192; ++i) {
            __builtin_amdgcn_global_load_lds((const unsigned*)((const char*)(cs + (size_t)row0 * 32) + i * 8192 + w * 1024 + lane * 16), (LAS unsigned*)(l3 + i * 8192 + w * 1024), 16, 0, 0);
            __builtin_amdgcn_global_load_lds((const unsigned*)((const char*)(sn + (size_t)row0 * 32) + i * 8192 + w * 1024 + lane * 16), (LAS unsigned*)(l3 + TB + i * 8192 + w * 1024), 16, 0, 0);
        }
        f32x4 bv[4];
#pragma unroll
        for (int nt = 0; nt < 4; ++nt) bv[nt] = *(const f32x4*)(bias + hb + (nt >> 1) * 32 + 8 * fq + 4 * (nt & 1));
        __syncthreads();
        const float* lcs = (const float*)lds; const float* lsn = (const float*)(lds + TB);
#pragma unroll
        for (int mt = 0; mt < MT; ++mt) {
            const int rl = wr * 16 * MT + mt * 16 + fr, row = row0 + rl;
            f32x4 v[4];
#pragma unroll
            for (int nt = 0; nt < 4; ++nt) v[nt] = acc[mt][nt] + bv[nt];
            if (is_rope) {
#pragma unroll
                for (int nt = 0; nt < 2; ++nt) {
                    const f32x4 c = *(const f32x4*)(lcs + rl * 32 + 8 * fq + 4 * nt), s = *(const f32x4*)(lsn + rl * 32 + 8 * fq + 4 * nt);
                    const f32x4 t1 = v[nt], t2 = v[nt + 2];
                    v[nt] = t1 * c - t2 * s; v[nt + 2] = t2 * c + t1 * s;
                }
            }
#pragma unroll
            for (int a = 0; a < 2; ++a) {
                const f32x4 o0 = v[2 * a] * sc, o1 = v[2 * a + 1] * sc;
                u32x4 pk = {cvt_pk(o0[0], o0[1]), cvt_pk(o0[2], o0[3]), cvt_pk(o1[0], o1[1]), cvt_pk(o1[2], o1[3])};
                *(u32x4*)(out + (size_t)row * INW + hb + a * 32 + 8 * fq) = pk;
            }
        }
        __syncthreads();
    }
};
struct EpiProjQ {
    const float* bias; const float* cs; const float* sn; bf16_t* out; int row0, col0;
    __device__ __forceinline__ void operator()(f32x4 (&acc)[4][2], int wr, int wc, int fr, int fq) const {
        const int hb = col0 + (wc >> 1) * 64, i0 = (wc & 1) * 16 + 4 * fq;
        const bool is_q = (hb < C_AK) || (hb >= C_BQ && hb < C_BK);
        const bool is_rope = is_q || (hb >= C_AK && hb < C_AV) || (hb >= C_BK && hb < C_BV);
        const float sc = is_q ? QSCALE : 1.0f;
#pragma unroll
        for (int mt = 0; mt < 4; ++mt) {
            const int row = row0 + wr * 64 + mt * 16 + fr;
            f32x4 v0 = acc[mt][0] + *(const f32x4*)(bias + hb + i0), v1 = acc[mt][1] + *(const f32x4*)(bias + hb + 32 + i0);
            if (is_rope) {
                const f32x4 c = *(const f32x4*)(cs + (size_t)row * 32 + i0), s = *(const f32x4*)(sn + (size_t)row * 32 + i0);
                const f32x4 t1 = v0, t2 = v1; v0 = t1 * c - t2 * s; v1 = t2 * c + t1 * s;
            }
            v0 = v0 * sc; v1 = v1 * sc;
            *(u32x2*)(out + (size_t)row * INW + hb + i0) = (u32x2){cvt_pk(v0[0], v0[1]), cvt_pk(v0[2], v0[3])};
            *(u32x2*)(out + (size_t)row * INW + hb + 32 + i0) = (u32x2){cvt_pk(v1[0], v1[1]), cvt_pk(v1[2], v1[3])};
        }
    }
};
__device__ __forceinline__ void phase_proj(const Params& p, char* lds, int vb, int G) {
    const float* cs = (const float*)(p.ws + WS_ROPE); const float* sn = cs + (size_t)S * 32;
    constexpr int NBIG = 512, NUNITS = NBIG + 4 * 64;
    for (int u = vb; u < NUNITS; u += G) {
        G2Args g; g.A = (const char*)(p.ws + WS_XB); g.B = (const char*)(p.ws + WS_WIN); g.nk = D / 64; g.akstep = 128;
        if (u < NBIG) {
            const int tm = u / 9, tn = u % 9;
            g2_rows_A<8>(g, (size_t)tm * 256, D * 2);
            { const int lane = threadIdx.x & 63, w = __builtin_amdgcn_readfirstlane(threadIdx.x >> 6); const unsigned co = g2_chunk_off(lane, w);
#pragma unroll
              for (int i = 0; i < 4; ++i) { const int n = i * 64 + w * 8 + (lane >> 3), nt = (n >> 4) & 3, nl = n & 15;
                  const int col = tn * 256 + (n >> 6) * 64 + (nt >> 1) * 32 + 8 * (nl >> 2) + 4 * (nt & 1) + (nl & 3);
                  g.offB[i] = (unsigned)col * (unsigned)(D * 2) + co; } }
            EpiProj<8> e{p.b_in, cs, sn, (bf16_t*)(p.ws + WS_PROJ), tm * 256, tn * 256, lds};
            gemm2<8>(lds, g, e);
        } else {
            const int q = u - NBIG, t = NBIG + (q >> 2), hm = (q >> 1) & 1, hn = q & 1, tm = t / 9, tn = t % 9;
            g2_rows_A<4>(g, (size_t)tm * 256 + hm * 128, D * 2);
            { const int lane = threadIdx.x & 63, w = __builtin_amdgcn_readfirstlane(threadIdx.x >> 6); const unsigned co = g2_chunk_off(lane, w);
#pragma unroll
              for (int i = 0; i < 2; ++i) { const int n = i * 64 + w * 8 + (lane >> 3), wcn = n >> 5, sub = n & 31;
                  const int col = tn * 256 + hn * 128 + (wcn >> 1) * 64 + (wcn & 1) * 16 + (sub & 15) + (sub >> 4) * 32;
                  g.offB[i] = (unsigned)col * (unsigned)(D * 2) + co; } }
            EpiProjQ e{p.b_in, cs, sn, (bf16_t*)(p.ws + WS_PROJ), tm * 256 + hm * 128, tn * 256 + hn * 128};
            gemm2n<4, 2>(lds, g, e);
        }
    }
}

template <int OFF> __device__ __forceinline__ s16x4 tr_read(int vb) { s16x4 r; asm volatile("ds_read_b64_tr_b16 %0, %1 offset:%2" : "=&v"(r) : "v"(vb), "i"(OFF) : "memory"); return r; }
__device__ __forceinline__ int v_off(int k, int c, int ndb) { return ((k >> 3) * ndb + (c >> 5)) * 512 + ((k & 7) * 32 + (c & 31)) * 2; }

constexpr int AT_STAGE = 32768;
template <int NDB, int KB, int T> struct PvPart {
    static __device__ __forceinline__ void run(f32x16& o, int vbase, const bf16x8& pa, const bf16x8& pb) {
        constexpr int o0 = (KB * 4 * NDB + T) * 512, st = NDB * 512;
        const s16x4 l0 = tr_read<o0 + 0 * st>(vbase), h0 = tr_read<o0 + 1 * st>(vbase), l1 = tr_read<o0 + 2 * st>(vbase), h1 = tr_read<o0 + 3 * st>(vbase);
        asm volatile("s_waitcnt lgkmcnt(0)" ::: "memory"); __builtin_amdgcn_sched_barrier(0);
#define PKV(L, H) (bf16x8){L[0], L[1], L[2], L[3], H[0], H[1], H[2], H[3]}
        o = __builtin_amdgcn_mfma_f32_32x32x16_bf16(PKV(l0, h0), pa, o, 0, 0, 0);
        o = __builtin_amdgcn_mfma_f32_32x32x16_bf16(PKV(l1, h1), pb, o, 0, 0, 0);
#undef PKV
    }
};
template <int NDB, int KB>
__device__ __forceinline__ void pv_half(f32x16 (&o)[NDB], f32x16& ol, int vbase, const bf16x8& pa, const bf16x8& pb) {
    const bf16x8 ones = {16256, 16256, 16256, 16256, 16256, 16256, 16256, 16256};
    ol = __builtin_amdgcn_mfma_f32_32x32x16_bf16(ones, pa, ol, 0, 0, 0);
    ol = __builtin_amdgcn_mfma_f32_32x32x16_bf16(ones, pb, ol, 0, 0, 0);
    PvPart<NDB, KB, 0>::run(o[0], vbase, pa, pb); PvPart<NDB, KB, 1>::run(o[1], vbase, pa, pb);
    if constexpr (NDB == 4) { PvPart<NDB, KB, 2>::run(o[2], vbase, pa, pb); PvPart<NDB, KB, 3>::run(o[3], vbase, pa, pb); }
}
constexpr float ATT_THR = 10.0f;
template <int NDB>
__device__ __forceinline__ void attn_scores(char* lds, int kof, const bf16x8 (&qf)[4], f32x16& s0, f32x16& s1, f32x16 (&o)[NDB], f32x16& ol, f32x16& nm, bool first, int r32, int hi) {
    s0 = nm; s1 = nm;
#pragma unroll
    for (int ds = 0; ds < 4; ++ds) {
        const bf16x8 k0 = *(const bf16x8*)(lds + kof + swz(r32, ds * 2 + hi)), k1 = *(const bf16x8*)(lds + kof + swz(32 + r32, ds * 2 + hi));
        s0 = __builtin_amdgcn_mfma_f32_32x32x16_bf16(k0, qf[ds], s0, 0, 0, 0);
        s1 = __builtin_amdgcn_mfma_f32_32x32x16_bf16(k1, qf[ds], s1, 0, 0, 0);
    }
    float mx = fmaxf(s0[0], s1[0]);
#pragma unroll
    for (int r = 1; r < 16; ++r) mx = fmaxf(fmaxf(mx, s0[r]), s1[r]);
    mx = half_max(mx);
    if (first || __any(mx > ATT_THR)) {
        const float delta = first ? mx : fmaxf(mx, 0.f), alpha = first ? 0.f : __builtin_amdgcn_exp2f(-delta);
#pragma unroll
        for (int r = 0; r < 16; ++r) { s0[r] -= delta; s1[r] -= delta; nm[r] -= delta; ol[r] *= alpha; }
#pragma unroll
        for (int t = 0; t < NDB; ++t)
#pragma unroll
            for (int r = 0; r < 16; ++r) o[t][r] *= alpha;
    }
}
__device__ __forceinline__ void exp_pack(const f32x16& s, bf16x8& pa, bf16x8& pb) {
    float e[16];
#pragma unroll
    for (int r = 0; r < 16; ++r) e[r] = __builtin_amdgcn_exp2f(s[r]);
    u32x4 a = {cvt_pk_vis(e[0], e[1]), cvt_pk_vis(e[2], e[3]), cvt_pk_vis(e[4], e[5]), cvt_pk_vis(e[6], e[7])};
    u32x4 b = {cvt_pk_vis(e[8], e[9]), cvt_pk_vis(e[10], e[11]), cvt_pk_vis(e[12], e[13]), cvt_pk_vis(e[14], e[15])};
    pa = *(bf16x8*)&a; pb = *(bf16x8*)&b;
}

template <int OFF> __device__ __forceinline__ bf16x8 k_read(int a) { bf16x8 r; asm volatile("ds_read_b128 %0, %1 offset:%2" : "=&v"(r) : "v"(a), "i"(OFF) : "memory"); return r; }
struct VSet { s16x4 l0, h0, l1, h1; };
template <int KB, int T> __device__ __forceinline__ void v_issue(VSet& v, int vbase) {
    constexpr int o0 = (KB * 16 + T) * 512, st = 4 * 512;
    v.l0 = tr_read<o0>(vbase); v.h0 = tr_read<o0 + st>(vbase); v.l1 = tr_read<o0 + 2 * st>(vbase); v.h1 = tr_read<o0 + 3 * st>(vbase);
}
#define WAIT_K(n, a, b) asm volatile("s_waitcnt lgkmcnt(" #n ")" : "+v"(a), "+v"(b) :: "memory")
#define WAIT_V(n, v) asm volatile("s_waitcnt lgkmcnt(" #n ")" : "+v"(v.l0), "+v"(v.h0), "+v"(v.l1), "+v"(v.h1) :: "memory")
#define PKV(L, H) (bf16x8){L[0], L[1], L[2], L[3], H[0], H[1], H[2], H[3]}
#define MF32(a, b, c) __builtin_amdgcn_mfma_f32_32x32x16_bf16(a, b, c, 0, 0, 0)
#define SB __builtin_amdgcn_sched_barrier(0)
#define EXP4(src, i, wlo, whi) do { const float e0_ = __builtin_amdgcn_exp2f(src[4 * (i)]), e1_ = __builtin_amdgcn_exp2f(src[4 * (i) + 1]), e2_ = __builtin_amdgcn_exp2f(src[4 * (i) + 2]), e3_ = __builtin_amdgcn_exp2f(src[4 * (i) + 3]); \
        asm("v_add_f32 %0, %1, %0" : "+v"(l2[0]) : "v"(e0_)); asm("v_add_f32 %0, %1, %0" : "+v"(l2[1]) : "v"(e1_)); asm("v_add_f32 %0, %1, %0" : "+v"(l2[0]) : "v"(e2_)); asm("v_add_f32 %0, %1, %0" : "+v"(l2[1]) : "v"(e3_)); \
        wlo = cvt_pk(e0_, e1_); whi = cvt_pk(e2_, e3_); } while (0)
#define EXP2(src, i, w) do { const float e0_ = __builtin_amdgcn_exp2f(src[2 * (i)]), e1_ = __builtin_amdgcn_exp2f(src[2 * (i) + 1]); \
        w = cvt_pk_vis(e0_, e1_); asm("v_add_f32 %0, %1, %0" : "+v"(l2[0]) : "v"(e0_), "v"(w)); asm("v_add_f32 %0, %1, %0" : "+v"(l2[1]) : "v"(e1_), "v"(w)); } while (0)
#define MAX4(i) do { mx = fmaxf(fmaxf(mx, n0[4 * (i)]), n1[4 * (i)]); mx = fmaxf(fmaxf(mx, n0[4 * (i) + 1]), n1[4 * (i) + 1]); \
        mx = fmaxf(fmaxf(mx, n0[4 * (i) + 2]), n1[4 * (i) + 2]); mx = fmaxf(fmaxf(mx, n0[4 * (i) + 3]), n1[4 * (i) + 3]); asm volatile("" : "+v"(mx)); } while (0)
struct DmaPlan { const char* base; unsigned gk, gv; size_t ok3, ok4, ov2, ov3; LAS char* dk3; LAS char* dk4; LAS char* dv2; LAS char* dv3; };
#define DMAP(src, dst) __builtin_amdgcn_global_load_lds((const unsigned*)(src), (LAS unsigned*)(dst), 16, 0, 0)
template <bool DMA>
__device__ __forceinline__ void diff_slot(f32x16& c0, f32x16& c1, f32x16& n0, f32x16& n1, f32x16 (&o)[4], f32x2& l2, f32x16& nm, const bf16x8 (&qf)[4],
                                          int ka0, int ka1, int ka2, int ka3, int vbase, bool has_next, const DmaPlan& dp) {
    constexpr bool HASNEXT = true;
    bf16x8 kA, kB, kC, kD, kE, kF, kG, kH; VSet v4, v5, v6, v7, v8, v9, v10, v11; u32x4 w0, w1, w2, w3;
    float mx = -3.0e38f;
    SB;
    kA = k_read<0>(ka0); kB = k_read<4096>(ka0); kC = k_read<0>(ka1); kD = k_read<4096>(ka1);
    EXP2(c0, 0, w0[0]);
    EXP2(c0, 1, w0[1]);
    WAIT_K(2, kA, kB);
    kE = k_read<0>(ka2); kF = k_read<4096>(ka2);
    n0 = MF32(kA, qf[0], nm); n1 = MF32(kB, qf[0], nm);
    if constexpr (DMA) DMAP(dp.base + dp.ok3 + dp.gk, dp.dk3);
    SB;
    EXP2(c0, 2, w0[2]);
    WAIT_K(2, kC, kD);
    kG = k_read<0>(ka3); kH = k_read<4096>(ka3);
    n0 = MF32(kC, qf[1], n0); n1 = MF32(kD, qf[1], n1);
    if constexpr (DMA) DMAP(dp.base + (dp.ok3 + 128) + dp.gk, dp.dk3 + 8192);
    SB;
    EXP2(c0, 3, w0[3]);
    EXP2(c0, 4, w1[0]);
    WAIT_K(2, kE, kF);
    v4.l0 = tr_read<0>(vbase); v4.h0 = tr_read<2048>(vbase); v4.l1 = tr_read<512>(vbase); v4.h1 = tr_read<2560>(vbase);
    n0 = MF32(kE, qf[2], n0); n1 = MF32(kF, qf[2], n1);
    if constexpr (DMA) DMAP(dp.base + dp.ov2 + dp.gv, dp.dv2);
    SB;
    EXP2(c0, 5, w1[1]);
    WAIT_K(4, kG, kH);
    v5.l0 = tr_read<1024>(vbase); v5.h0 = tr_read<3072>(vbase); v5.l1 = tr_read<1536>(vbase); v5.h1 = tr_read<3584>(vbase);
    n0 = MF32(kG, qf[3], n0); n1 = MF32(kH, qf[3], n1);
    if constexpr (DMA) DMAP(dp.base + (dp.ov2 + 128) + dp.gv, dp.dv2 + 1024);
    SB;
    EXP2(c0, 6, w1[2]);
    EXP2(c0, 7, w1[3]);
    WAIT_V(4, v4);
    v6.l0 = tr_read<4096>(vbase); v6.h0 = tr_read<6144>(vbase); v6.l1 = tr_read<4608>(vbase); v6.h1 = tr_read<6656>(vbase);
    o[0] = MF32(PKV(v4.l0, v4.h0), (*(bf16x8*)&w0), o[0]); o[1] = MF32(PKV(v4.l1, v4.h1), (*(bf16x8*)&w0), o[1]);
    if constexpr (DMA) DMAP(dp.base + dp.ov3 + dp.gv, dp.dv3);
    SB;
    EXP2(c1, 0, w2[0]);
    MAX4(0);
    WAIT_V(4, v5);
    v7.l0 = tr_read<5120>(vbase); v7.h0 = tr_read<7168>(vbase); v7.l1 = tr_read<5632>(vbase); v7.h1 = tr_read<7680>(vbase);
    o[2] = MF32(PKV(v5.l0, v5.h0), (*(bf16x8*)&w0), o[2]); o[3] = MF32(PKV(v5.l1, v5.h1), (*(bf16x8*)&w0), o[3]);
    if constexpr (DMA) DMAP(dp.base + (dp.ov3 + 128) + dp.gv, dp.dv3 + 1024);
    SB;
    EXP2(c1, 1, w2[1]);
    EXP2(c1, 2, w2[2]);
    WAIT_V(4, v6);
    v8.l0 = tr_read<8192>(vbase); v8.h0 = tr_read<10240>(vbase); v8.l1 = tr_read<8704>(vbase); v8.h1 = tr_read<10752>(vbase);
    o[0] = MF32(PKV(v6.l0, v6.h0), (*(bf16x8*)&w1), o[0]); o[1] = MF32(PKV(v6.l1, v6.h1), (*(bf16x8*)&w1), o[1]);
    if constexpr (DMA) DMAP(dp.base + dp.ok4 + dp.gk, dp.dk4);
    SB;
    EXP2(c1, 3, w2[3]);
    MAX4(1);
    WAIT_V(4, v7);
    v9.l0 = tr_read<9216>(vbase); v9.h0 = tr_read<11264>(vbase); v9.l1 = tr_read<9728>(vbase); v9.h1 = tr_read<11776>(vbase);
    o[2] = MF32(PKV(v7.l0, v7.h0), (*(bf16x8*)&w1), o[2]); o[3] = MF32(PKV(v7.l1, v7.h1), (*(bf16x8*)&w1), o[3]);
    if constexpr (DMA) DMAP(dp.base + (dp.ok4 + 128) + dp.gk, dp.dk4 + 8192);
    SB;
    EXP2(c1, 4, w3[0]);
    EXP2(c1, 5, w3[1]);
    WAIT_V(4, v8);
    v10.l0 = tr_read<12288>(vbase); v10.h0 = tr_read<14336>(vbase); v10.l1 = tr_read<12800>(vbase); v10.h1 = tr_read<14848>(vbase);
    o[0] = MF32(PKV(v8.l0, v8.h0), (*(bf16x8*)&w2), o[0]); o[1] = MF32(PKV(v8.l1, v8.h1), (*(bf16x8*)&w2), o[1]);
    SB;
    EXP2(c1, 6, w3[2]);
    EXP2(c1, 7, w3[3]);
    WAIT_V(4, v9);
    v11.l0 = tr_read<13312>(vbase); v11.h0 = tr_read<15360>(vbase); v11.l1 = tr_read<13824>(vbase); v11.h1 = tr_read<15872>(vbase);
    o[2] = MF32(PKV(v9.l0, v9.h0), (*(bf16x8*)&w2), o[2]); o[3] = MF32(PKV(v9.l1, v9.h1), (*(bf16x8*)&w2), o[3]);
    SB;
    MAX4(2);
    WAIT_V(4, v10);
    o[0] = MF32(PKV(v10.l0, v10.h0), (*(bf16x8*)&w3), o[0]); o[1] = MF32(PKV(v10.l1, v10.h1), (*(bf16x8*)&w3), o[1]);
    SB;
    MAX4(3);
    WAIT_V(0, v11);
    o[2] = MF32(PKV(v11.l0, v11.h0), (*(bf16x8*)&w3), o[2]); o[3] = MF32(PKV(v11.l1, v11.h1), (*(bf16x8*)&w3), o[3]);
    SB;
    if (has_next) {
        mx = half_max(mx);
        if (__any(mx > ATT_THR)) {
            const float delta = fmaxf(mx, 0.f), alpha = __builtin_amdgcn_exp2f(-delta);
#pragma unroll
            for (int r = 0; r < 16; ++r) { n0[r] -= delta; n1[r] -= delta; nm[r] -= delta; }
            l2 *= alpha;
#pragma unroll
            for (int t = 0; t < 4; ++t)
#pragma unroll
                for (int r = 0; r < 16; ++r) o[t][r] *= alpha;
        }
    }
}
__device__ __forceinline__ void attn_diff_unit(const Params& p, char* lds_, int h, int qb, float lam) {
    LAS char* lds = (LAS char*)lds_;
    int tid = threadIdx.x; asm volatile("" : "+v"(tid));
    const int lane = tid & 63, w = __builtin_amdgcn_readfirstlane(tid >> 6), r32 = lane & 31, hi = lane >> 5, mp = w >> 2, wq = w & 3;
    const bf16_t* proj = (const bf16_t*)(p.ws + WS_PROJ);
    const int NT = 2 * qb + 2, NP = NT / 2, myNT = (wq < 2) ? NT - 1 : NT;
    bf16x8 qf[4];
    { const bf16_t* qp = proj + (size_t)(qb * 128 + wq * 32 + r32) * INW + C_BQ + h * 128 + mp * 64 + hi * 8;
#pragma unroll
      for (int ds = 0; ds < 4; ++ds) qf[ds] = *(const bf16x8*)(qp + ds * 16); }
    asm volatile("" : "+v"(qf[0]), "+v"(qf[1]), "+v"(qf[2]), "+v"(qf[3]));
    f32x16 o[4] = {}; f32x16 nm; f32x2 l2 = {0.f, 0.f};
    const unsigned gko = (unsigned)((w * 8 + (lane >> 3)) * INW + C_BK + h * 128) * 2u + g2_chunk_off(lane, w);
    const unsigned gvo = (unsigned)((w * 8 + ((lane & 31) >> 2)) * INW + C_BV + h * 128 + (lane >> 5) * 32 + (lane & 3) * 8) * 2u;
    const char* gk = (const char*)proj + gko; const char* gv = (const char*)proj + gvo;
    const int vlane = ((lane & 3) << 3) | (((lane >> 2) & 3) << 6) | (((lane >> 4) & 1) << 5) | (((lane >> 5) & 1) << 8);
    const int ldsb = (int)(uintptr_t)lds_;
    const int kad0 = ldsb + mp * 8192 + swz(r32, 0 + hi), kad1 = ldsb + mp * 8192 + swz(r32, 2 + hi), kad2 = ldsb + mp * 8192 + swz(r32, 4 + hi), kad3 = ldsb + mp * 8192 + swz(r32, 6 + hi);
    constexpr size_t TSTEP = (size_t)64 * INW * 2;
#define DMA_K(t_) do { const int tt_ = (t_); const char* s_ = gk + (size_t)tt_ * TSTEP; LAS char* d_ = lds + (tt_ & 3) * 16384 + w * 1024; \
        __builtin_amdgcn_global_load_lds((const unsigned*)s_, (LAS unsigned*)d_, 16, 0, 0); \
        __builtin_amdgcn_global_load_lds((const unsigned*)(s_ + 128), (LAS unsigned*)(d_ + 8192), 16, 0, 0); } while (0)
#define DMA_V(t_) do { const int tt_ = (t_); const char* s_ = gv + (size_t)tt_ * TSTEP; LAS char* d_ = lds + 65536 + (tt_ & 3) * 16384 + (2 * w) * 1024; \
        __builtin_amdgcn_global_load_lds((const unsigned*)s_, (LAS unsigned*)d_, 16, 0, 0); \
        __builtin_amdgcn_global_load_lds((const unsigned*)(s_ + 128), (LAS unsigned*)(d_ + 1024), 16, 0, 0); } while (0)
    DMA_K(0); DMA_K(1); if (NT > 2) DMA_K(2); DMA_V(0); DMA_V(1);
    __syncthreads();
    f32x16 A0 = {}, A1 = {}, B0 = {}, B1 = {};
    {
#pragma unroll
        for (int ds = 0; ds < 4; ++ds) {
            const bf16x8 k0 = *(const bf16x8*)(lds_ + mp * 8192 + swz(r32, ds * 2 + hi)), k1 = *(const bf16x8*)(lds_ + mp * 8192 + swz(32 + r32, ds * 2 + hi));
            A0 = MF32(k0, qf[ds], A0); A1 = MF32(k1, qf[ds], A1);
        }
        float mx = fmaxf(A0[0], A1[0]);
#pragma unroll
        for (int r = 1; r < 16; ++r) mx = fmaxf(fmaxf(mx, A0[r]), A1[r]);
        mx = half_max(mx);
#pragma unroll
        for (int r = 0; r < 16; ++r) { A0[r] -= mx; A1[r] -= mx; nm[r] = -mx; }
    }
    __syncthreads();
    for (int it = 0; it < NP; ++it) {
        const int t = 2 * it;
        DmaPlan dp;
        dp.base = (const char*)proj; dp.gk = gko; dp.gv = gvo;
        dp.ok3 = (size_t)min(t + 3, NT - 1) * TSTEP; dp.dk3 = lds + ((t + 3) & 3) * 16384 + w * 1024;
        dp.ok4 = (size_t)min(t + 4, NT - 1) * TSTEP; dp.dk4 = lds + ((t + 4) & 3) * 16384 + w * 1024;
        dp.ov2 = (size_t)min(t + 2, NT - 1) * TSTEP; dp.dv2 = lds + 65536 + ((t + 2) & 3) * 16384 + (2 * w) * 1024;
        dp.ov3 = (size_t)min(t + 3, NT - 1) * TSTEP; dp.dv3 = lds + 65536 + ((t + 3) & 3) * 16384 + (2 * w) * 1024;
        { const int ks = ((t + 1) & 3) * 16384, vb_ = ldsb + 65536 + (t & 3) * 16384 + vlane;
          diff_slot<true>(A0, A1, B0, B1, o, l2, nm, qf, kad0 + ks, kad1 + ks, kad2 + ks, kad3 + ks, vb_, t + 1 < myNT, dp); }
        if (t + 1 < myNT) {
            const int ks = ((t + 2) & 3) * 16384, vb_ = ldsb + 65536 + ((t + 1) & 3) * 16384 + vlane;
            diff_slot<false>(B0, B1, A0, A1, o, l2, nm, qf, kad0 + ks, kad1 + ks, kad2 + ks, kad3 + ks, vb_, t + 2 < myNT, dp);
        }
        __syncthreads();
    }
#undef DMA_K
#undef DMA_V
    float* xb = (float*)lds_;
    const float il = 1.0f / half_sum(l2[0] + l2[1]);
    if (mp == 1) {
        const float f = il * *(const float*)(lds_ + LDS_MISC);
#pragma unroll
        for (int t = 0; t < 4; ++t)
#pragma unroll
            for (int r = 0; r < 16; ++r) xb[(wq * 64 + t * 16 + r) * 64 + lane] = o[t][r] * f;
    }
    __syncthreads();
    if (mp == 0) {
        float ss = 0.f;
#pragma unroll
        for (int t = 0; t < 4; ++t)
#pragma unroll
            for (int r = 0; r < 16; ++r) { const float v = o[t][r] * il - xb[(wq * 64 + t * 16 + r) * 64 + lane]; o[t][r] = v; ss += v * v; }
        ss = half_sum(ss);
        const float rs = rsqrtf(ss * (1.0f / 128.0f) + LN_EPS) * 0.8f;
        bf16_t* op = (bf16_t*)(p.ws + WS_ATT) + (size_t)(qb * 128 + wq * 32 + r32) * D + 512 + h * 128;
#pragma unroll
        for (int t = 0; t < 4; ++t)
#pragma unroll
            for (int rp = 0; rp < 2; ++rp) {
                unsigned pk[2][2];
#pragma unroll
                for (int a = 0; a < 2; ++a) {
                    const int rr = 2 * rp + a, dv0 = 32 * t + 8 * rr + 4 * hi;
                    const f32x4 gg = *(const f32x4*)(p.subg + dv0);
                    pk[a][0] = cvt_pk(o[t][4 * rr] * rs * gg[0], o[t][4 * rr + 1] * rs * gg[1]); pk[a][1] = cvt_pk(o[t][4 * rr + 2] * rs * gg[2], o[t][4 * rr + 3] * rs * gg[3]);
                }
                const auto s0 = __builtin_amdgcn_permlane32_swap(pk[0][0], pk[1][0], false, false), s1 = __builtin_amdgcn_permlane32_swap(pk[0][1], pk[1][1], false, false);
                *(u32x4*)(op + 32 * t + 8 * (2 * rp + hi)) = (u32x4){s0[0], s1[0], s0[1], s1[1]};
            }
    }
    __syncthreads();
}
#undef DMAP
#undef WAIT_K
#undef WAIT_V
#undef PKV
#undef MF32
#undef SB
#undef EXP4
#undef EXP2
#undef MAX4
__device__ __forceinline__ void attn_swa_unit(const Params& p, char* lds, int kvh, int n) {
    int tid = threadIdx.x; asm volatile("" : "+v"(tid));
    const int lane = tid & 63, w = __builtin_amdgcn_readfirstlane(tid >> 6), r32 = lane & 31, hi = lane >> 5, g = w >> 1, hq = kvh * 4 + g;
    const bf16_t* proj = (const bf16_t*)(p.ws + WS_PROJ);
    const int c0 = (n >= 2) ? n - 2 : 0, NT = n - c0 + 1;
    const int tok = n * 64 + (w & 1) * 32 + r32;
    bf16x8 qf[4];
    { const bf16_t* qp = proj + (size_t)tok * INW + C_AQ + hq * 64 + hi * 8;
#pragma unroll
      for (int ds = 0; ds < 4; ++ds) qf[ds] = *(const bf16x8*)(qp + ds * 16); }
    f32x16 o[2] = {}; f32x16 ol, nm;
    { float ms = -p.sinks[hq] * LOG2E; asm volatile("" : "+v"(qf[0]), "+v"(qf[1]), "+v"(qf[2]), "+v"(qf[3]), "+v"(ms));
#pragma unroll
      for (int r = 0; r < 16; ++r) { nm[r] = ms; ol[r] = 1.0f; } }
    const bf16_t* gk = proj + (size_t)(c0 * 64 + (tid >> 3)) * INW + C_AK + kvh * 64 + (tid & 7) * 8;
    const bf16_t* gv = proj + (size_t)(c0 * 64 + (tid >> 3)) * INW + C_AV + kvh * 64 + (tid & 7) * 8;
    const int wk = swz(tid >> 3, tid & 7), wv = v_off(tid >> 3, (tid & 7) * 8, 2);
    const int vlane = ((lane & 3) << 3) | (((lane >> 2) & 3) << 6) | (((lane >> 4) & 1) << 5) | (((lane >> 5) & 1) << 8);
    u32x4 st0, st1;
#define W_LOAD(t) do { const size_t ko = (size_t)(t) * 64 * INW; st0 = *(const u32x4*)(gk + ko); st1 = *(const u32x4*)(gv + ko); } while (0)
#define W_WRITE(b) do { char* sb = lds + (b) * AT_STAGE; *(u32x4*)(sb + wk) = st0; *(u32x4*)(sb + 8192 + wv) = st1; } while (0)
    W_LOAD(0); W_WRITE(0); __syncthreads();
    for (int t = 0; t < NT; ++t) {
        const int b = t & 1;
        if (t + 1 < NT) W_LOAD(t + 1);
        { f32x16 s0, s1; bf16x8 p0, p1, p2, p3; const int vb_ = (int)(uintptr_t)(lds + b * AT_STAGE + 8192) + vlane;
          attn_scores<2>(lds, b * AT_STAGE, qf, s0, s1, o, ol, nm, false, r32, hi);
          exp_pack(s0, p0, p1); pv_half<2, 0>(o, ol, vb_, p0, p1); exp_pack(s1, p2, p3); pv_half<2, 1>(o, ol, vb_, p2, p3); }
        if (t + 1 < NT) W_WRITE(b ^ 1);
        __syncthreads();
    }
#undef W_LOAD
#undef W_WRITE
    const float il = 1.0f / ol[0];
    bf16_t* op = (bf16_t*)(p.ws + WS_ATT) + (size_t)tok * D + hq * 64;
#pragma unroll
    for (int t = 0; t < 2; ++t)
#pragma unroll
        for (int rp = 0; rp < 2; ++rp) {
            unsigned pk[2][2];
#pragma unroll
            for (int a = 0; a < 2; ++a) { const int rr = 2 * rp + a; pk[a][0] = cvt_pk(o[t][4 * rr] * il, o[t][4 * rr + 1] * il); pk[a][1] = cvt_pk(o[t][4 * rr + 2] * il, o[t][4 * rr + 3] * il); }
            const auto s0 = __builtin_amdgcn_permlane32_swap(pk[0][0], pk[1][0], false, false), s1 = __builtin_amdgcn_permlane32_swap(pk[0][1], pk[1][1], false, false);
            *(u32x4*)(op + 32 * t + 8 * (2 * rp + hi)) = (u32x4){s0[0], s1[0], s0[1], s1[1]};
        }
}
__device__ __forceinline__ void phase_attn(const Params& p, char* lds, int vb, int G) {
    const int lane = threadIdx.x & 63;
    const float d1 = wave_sum(p.lq1[lane] * p.lk1[lane]), d2 = wave_sum(p.lq2[lane] * p.lk2[lane]);
    if (threadIdx.x == 0) *(float*)(lds + LDS_MISC) = expf(d1) - expf(d2) + 0.2f;
    __syncthreads();
    const float lam = 0.f;
    for (int u = vb; u < 1024; u += G) {
        if (u < 512) attn_diff_unit(p, lds, (u & 255) >> 6, (u < 256) ? 127 - (u & 63) : (u & 63), lam);
        else attn_swa_unit(p, lds, (u - 512) >> 8, (u - 512) & 255);
    }
}

struct EpiPreLn {
    const float* x; float* out; int row0, col0;
    __device__ __forceinline__ void operator()(f32x4 (&acc)[8][4], int wr, int wc, int fr, int fq) const {
        f32x4 xa[4], xb_[4];
        const size_t rbase = (size_t)(row0 + wr * 128 + fr) * D + col0 + wc * 64 + 4 * fq;
#pragma unroll
        for (int nt = 0; nt < 4; ++nt) xa[nt] = *(const f32x4*)(x + rbase + nt * 16);
#pragma unroll
        for (int mt = 0; mt < 8; ++mt) {
            const size_t ro = rbase + (size_t)mt * 16 * D;
            if (mt + 1 < 8) {
#pragma unroll
                for (int nt = 0; nt < 4; ++nt) { if (mt & 1) xa[nt] = *(const f32x4*)(x + ro + (size_t)16 * D + nt * 16); else xb_[nt] = *(const f32x4*)(x + ro + (size_t)16 * D + nt * 16); }
            }
#pragma unroll
            for (int nt = 0; nt < 4; ++nt) { const f32x4 xv = (mt & 1) ? xb_[nt] : xa[nt]; *(f32x4*)(out + ro + nt * 16) = xv * ALPHA + acc[mt][nt]; }
        }
    }
};
__device__ __forceinline__ void phase_wout(const Params& p, char* lds, int vb, int G) {
    for (int u = vb; u < (S / 256) * 4; u += G) {
        const int tm = u >> 2, tn = u & 3;
        G2Args g; g.A = (const char*)(p.ws + WS_ATT); g.B = (const char*)(p.ws + WS_WOUT); g.nk = D / 64; g.akstep = 128;
        g2_rows_A<8>(g, (size_t)tm * 256, D * 2); g2_rows_B(g, (size_t)tn * 256, D * 2);
        EpiPreLn e{p.x, (float*)(p.ws + WS_PRELN), tm * 256, tn * 256};
        gemm2<8>(lds, g, e);
    }
}

struct EpiLogits {
    float* L;
    __device__ __forceinline__ void operator()(f32x4 (&acc)[4][4], int wr, int wc, int fr, int fq) const {
#pragma unroll
        for (int mt = 0; mt < 4; ++mt)
#pragma unroll
            for (int nt = 0; nt < 4; ++nt) *(f32x4*)(L + (wr * 64 + mt * 16 + fr) * 256 + wc * 64 + nt * 16 + 4 * fq) = acc[mt][nt];
    }
};
__device__ __forceinline__ void phase_router(const Params& p, char* lds, int vb, int G) {
    const int tid = threadIdx.x, lane = tid & 63, w = tid >> 6;
    const float* preln = (const float*)(p.ws + WS_PRELN);
    bf16_t* x1b = (bf16_t*)(p.ws + WS_X1B);
    unsigned* cnt = (unsigned*)(p.ws + WS_CTL + 65536); int* list = (int*)(p.ws + WS_LIST); float* gates = (float*)(p.ws + WS_GATE);
    for (int u = vb; u < S / 64; u += G) {
        {
            f32x4 v[8][4]; float sm[8], sq[8];
#pragma unroll
            for (int i = 0; i < 8; ++i) { const f32x4* xr = (const f32x4*)(preln + (size_t)(u * 64 + w * 8 + i) * D) + lane;
#pragma unroll
                for (int j = 0; j < 4; ++j) v[i][j] = xr[64 * j]; }
#pragma unroll
            for (int i = 0; i < 8; ++i) { float s = 0.f;
#pragma unroll
                for (int j = 0; j < 4; ++j) s += (v[i][j][0] + v[i][j][1]) + (v[i][j][2] + v[i][j][3]);
                sm[i] = s; }
#pragma unroll
            for (int o = 1; o < 64; o <<= 1) {
#pragma unroll
                for (int i = 0; i < 8; ++i) sm[i] += __shfl_xor(sm[i], o); }
#pragma unroll
            for (int i = 0; i < 8; ++i) { const float mean = sm[i] * (1.0f / D); float s2 = 0.f;
#pragma unroll
                for (int j = 0; j < 4; ++j) { v[i][j] = v[i][j] - mean; s2 += (v[i][j][0] * v[i][j][0] + v[i][j][1] * v[i][j][1]) + (v[i][j][2] * v[i][j][2] + v[i][j][3] * v[i][j][3]); }
                sq[i] = s2; }
#pragma unroll
            for (int o = 1; o < 64; o <<= 1) {
#pragma unroll
                for (int i = 0; i < 8; ++i) sq[i] += __shfl_xor(sq[i], o); }
#pragma unroll
            for (int j = 0; j < 4; ++j) {
                const f32x4 gg = *((const f32x4*)p.ln1g + lane + 64 * j), bb = *((const f32x4*)p.ln1b + lane + 64 * j);
#pragma unroll
                for (int i = 0; i < 8; ++i) {
                    const int row = u * 64 + w * 8 + i;
                    const float rstd = rsqrtf(sq[i] * (1.0f / D) + LN_EPS);
                    const f32x4 y = v[i][j] * rstd * gg + bb;
                    u32x2 pk = {cvt_pk(y[0], y[1]), cvt_pk(y[2], y[3])};
                    *(u32x2*)(x1b + ((size_t)((lane >> 4) + 4 * j) * S + row) * 64 + ((4 * lane) & 63)) = pk;
                }
            }
        }
        asm volatile("s_waitcnt vmcnt(0)" ::: "memory");
        __syncthreads();
        { G2Args g; g.A = (const char*)x1b; g.B = (const char*)(p.ws + WS_WR); g.nk = D / 64; g.akstep = S * 128;
          g2_rows_A<4>(g, (size_t)u * 64, 128); g.offA[1] = g.offA[0]; g2_rows_B(g, 0, D * 2);
          EpiLogits e{(float*)lds};
          gemm2<4>(lds, g, e); }
        __syncthreads();
        const f32x4 rb = *((const f32x4*)p.r_bias + lane);
        const float NEG = -__builtin_inff();
        for (int i0 = 0; i0 < 8; i0 += 4) {
            float sc[4][4], cand[4][4]; int my_e[4]; float my_s[4], gsum[4];
#pragma unroll
            for (int q = 0; q < 4; ++q) {
                const int tl = w * 8 + i0 + q;
                const f32x4 lg = *((const f32x4*)((const float*)lds + tl * 256) + lane);
#pragma unroll
                for (int j = 0; j < 4; ++j) { sc[q][j] = 1.0f / (1.0f + __expf(-lg[j])); cand[q][j] = sc[q][j] + rb[j]; }
                my_e[q] = 0; my_s[q] = 0.f; gsum[q] = 0.f;
            }
            float a1[4], a2[4];
#pragma unroll
            for (int q = 0; q < 4; ++q) { const float m01 = fmaxf(cand[q][0], cand[q][1]), n01 = fminf(cand[q][0], cand[q][1]), m23 = fmaxf(cand[q][2], cand[q][3]), n23 = fminf(cand[q][2], cand[q][3]);
              a1[q] = fmaxf(m01, m23); a2[q] = fmaxf(fminf(m01, m23), fmaxf(n01, n23)); }
#pragma unroll
            for (int off = 1; off < 8; off <<= 1) {
#pragma unroll
                for (int q = 0; q < 4; ++q) { const float b1 = __shfl_xor(a1[q], off), b2 = __shfl_xor(a2[q], off); const float n1 = fmaxf(a1[q], b1), n2 = fmaxf(fminf(a1[q], b1), fmaxf(a2[q], b2)); a1[q] = n1; a2[q] = n2; }
            }
            const int mygrp = lane >> 3;
#pragma unroll
            for (int q = 0; q < 4; ++q) {
                const float gs = a1[q] + a2[q]; int rank = 0;
#pragma unroll
                for (int g2 = 0; g2 < 8; ++g2) { const float v = __shfl(gs, g2 * 8); rank += (v > gs || (v == gs && g2 < mygrp)) ? 1 : 0; }
                if (rank >= 4) {
#pragma unroll
                    for (int j = 0; j < 4; ++j) cand[q][j] = NEG;
                }
            }
#pragma unroll
            for (int k = 0; k < 8; ++k) {
                float bv[4]; int idx[4];
#pragma unroll
                for (int q = 0; q < 4; ++q) { bv[q] = cand[q][0]; int bi = 0;
#pragma unroll
                    for (int j = 1; j < 4; ++j) if (cand[q][j] > bv[q]) { bv[q] = cand[q][j]; bi = j; }
                    idx[q] = 4 * lane + bi; }
#pragma unroll
                for (int off = 32; off >= 1; off >>= 1) {
#pragma unroll
                    for (int q = 0; q < 4; ++q) { const float ov = __shfl_xor(bv[q], off); const int oi = __shfl_xor(idx[q], off); if (ov > bv[q] || (ov == bv[q] && oi < idx[q])) { bv[q] = ov; idx[q] = oi; } }
                }
#pragma unroll
                for (int q = 0; q < 4; ++q) {
                    const int owner = idx[q] >> 2, sub = idx[q] & 3;
                    float scv = sc[q][0];
#pragma unroll
                    for (int j = 1; j < 4; ++j) scv = (sub == j) ? sc[q][j] : scv;
                    if (lane == owner) {
#pragma unroll
                        for (int j = 0; j < 4; ++j) if (sub == j) cand[q][j] = NEG;
                    }
                    const float gsc = __shfl(scv, owner);
                    if (lane == k) { my_e[q] = idx[q]; my_s[q] = gsc; }
                    gsum[q] += gsc;
                }
            }
            if (lane < 8) {
#pragma unroll
                for (int q = 0; q < 4; ++q) {
                    const int t = u * 64 + w * 8 + i0 + q;
                    const float gate = my_s[q] / gsum[q] * 2.5f;
                    const unsigned pos = atomicAdd(cnt + my_e[q] * CNT_STRIDE, 1u);
                    list[(size_t)my_e[q] * CAP + pos] = t * 8 + lane;
                    gates[t * 8 + lane] = gate;
                }
            }
        }
        __syncthreads();
    }
}

#ifndef MOE_MT
#define MOE_MT 8
#endif
constexpr int MOE_BM = 32 * MOE_MT;
struct EpiAct {
    bf16_t* act; const int* slots;
    __device__ __forceinline__ void operator()(f32x4 (&acc)[MOE_MT][4], int pass, int wr, int wc, int fr, int fq) const {
        const int ncol0 = pass * 128;
#pragma unroll
        for (int mt = 0; mt < MOE_MT; ++mt) {
            const int ar = slots[wr * 16 * MOE_MT + mt * 16 + fr];
            if (ar >= 0) {
                float a[8];
#pragma unroll
                for (int nt = 0; nt < 2; ++nt)
#pragma unroll
                    for (int j = 0; j < 4; ++j) { const float gq = acc[mt][nt][j]; a[nt * 4 + j] = gq * __builtin_amdgcn_rcpf(1.0f + __expf(-gq)) * (acc[mt][nt + 2][j]); }
                u32x4 pk = {cvt_pk(a[0], a[1]), cvt_pk(a[2], a[3]), cvt_pk(a[4], a[5]), cvt_pk(a[6], a[7])};
                *(u32x4*)(act + (size_t)ar * FF + ncol0 + wc * 32 + 8 * fq) = pk;
            }
        }
    }
};
struct EpiY {
    bf16_t* y; const int* yrows; const float* gl;
    __device__ __forceinline__ void operator()(f32x4 (&acc)[MOE_MT][4], int pass, int wr, int wc, int fr, int fq) const {
        const int col0 = pass * 256;
#pragma unroll
        for (int mt = 0; mt < MOE_MT; ++mt) {
            const int r = wr * 16 * MOE_MT + mt * 16 + fr, yr = yrows[r];
            if (yr >= 0) {
                const float gt = gl[r];
#pragma unroll
                for (int a = 0; a < 2; ++a) {
                    const f32x4 v0 = acc[mt][2 * a] * gt, v1 = acc[mt][2 * a + 1] * gt;
                    u32x4 pk = {cvt_pk(v0[0], v0[1]), cvt_pk(v0[2], v0[3]), cvt_pk(v1[0], v1[1]), cvt_pk(v1[2], v1[3])};
                    *(u32x4*)(y + (size_t)yr * D + col0 + wc * 64 + a * 32 + 8 * fq) = pk;
                }
            }
        }
    }
};
__device__ __forceinline__ void phase_experts(const Params& p, char* lds, int vb, int G) {
    const int tid0 = threadIdx.x, w = __builtin_amdgcn_readfirstlane(tid0 >> 6);
    const unsigned* cnt = (const unsigned*)(p.ws + WS_CTL + 65536); const int* list = (const int*)(p.ws + WS_LIST); const float* gates = (const float*)(p.ws + WS_GATE);
    bf16_t* act = (bf16_t*)(p.ws + WS_ACT); bf16_t* ybuf = (bf16_t*)(p.ws + WS_Y);
    int* nts = (int*)(lds + LDS_MISC); int* pre = nts + 256;
    int* s_arow = pre + 260; int* s_yrow = s_arow + MOE_BM; int* s_tok = s_yrow + MOE_BM; float* s_gate = (float*)(s_tok + MOE_BM);
    if (tid0 < 256) nts[tid0] = (int)((__hip_atomic_load(cnt + tid0 * CNT_STRIDE, __ATOMIC_RELAXED, __HIP_MEMORY_SCOPE_AGENT) + (MOE_BM - 1)) / MOE_BM);
    __syncthreads();
    if (tid0 < 257) { int s = 0; for (int e = 0; e < tid0; ++e) s += nts[e]; pre[tid0] = s; }
    __syncthreads();
    const int NR = __builtin_amdgcn_readfirstlane(pre[256]), NU = NR + S / MOE_BM;
    for (int u = vb; u < NU; u += G) {
        __syncthreads();
        int tid = threadIdx.x; asm volatile("" : "+v"(tid));
        const int lane = tid & 63; const unsigned co = g2_chunk_off(lane, w);
        const float *bg, *bu, *bd;
        if (u < NR) {
            int lo = 0, hi = 255;
            while (lo < hi) { const int mid = (lo + hi + 1) >> 1; if (pre[mid] <= u) lo = mid; else hi = mid - 1; }
            const int e = lo, tile = u - pre[e], n = (int)__hip_atomic_load(cnt + e * CNT_STRIDE, __ATOMIC_RELAXED, __HIP_MEMORY_SCOPE_AGENT);
            if (tid < MOE_BM) {
                const int idx = tile * MOE_BM + tid;
                if (idx < n) { const int slot = list[(size_t)e * CAP + idx]; s_arow[tid] = slot; s_yrow[tid] = slot + (slot >> 3); s_tok[tid] = slot >> 3; s_gate[tid] = gates[slot]; }
                else { s_arow[tid] = -1; s_yrow[tid] = -1; s_tok[tid] = 0; s_gate[tid] = 0.f; }
            }
            bg = p.w_g + (size_t)e * D * FF; bu = p.w_u + (size_t)e * D * FF; bd = p.w_d + (size_t)e * FF * D;
        } else {
            const int tile = u - NR;
            if (tid < MOE_BM) { const int tk = tile * MOE_BM + tid; s_arow[tid] = S * 8 + tk; s_yrow[tid] = tk * 9 + 8; s_tok[tid] = tk; s_gate[tid] = 1.0f; }
            bg = p.ws_g; bu = p.ws_u; bd = p.ws_d;
        }
        __syncthreads();
        { G3fArgs g; g.A = (const char*)(p.ws + WS_X1B); g.nk = D / 64; g.akstep = S * 128;
#pragma unroll
          for (int i = 0; i < MOE_MT / 2; ++i) g.offA[i] = (unsigned)s_tok[i * 64 + w * 8 + (lane >> 3)] * 128u + co;
          { const int bwc = lane >> 4, nt = (lane >> 2) & 3, bfq = lane & 3;
            g.b = ((nt < 2) ? bg : bu) + bwc * 32 + 8 * bfq + 4 * (nt & 1) + (size_t)(w * 8) * FF; }
          EpiAct e{act, s_arow};
          gemm3f<MOE_MT, FF>(lds, g, 2, 128, e); }
        asm volatile("s_waitcnt vmcnt(0)" ::: "memory");
        __syncthreads();
        { G3fArgs g; g.A = (const char*)act; g.nk = FF / 64; g.akstep = 128;
          int tid2 = threadIdx.x; asm volatile("" : "+v"(tid2));
          const int lane = tid2 & 63; const unsigned co = g2_chunk_off(lane, w);
#pragma unroll
          for (int i = 0; i < MOE_MT / 2; ++i) { const int ar = s_arow[i * 64 + w * 8 + (lane >> 3)]; g.offA[i] = (unsigned)(ar < 0 ? 0 : ar) * (unsigned)(FF * 2) + co; }
          g.b = bd + (size_t)(w * 8) * D + (lane >> 4) * 64 + (((lane >> 2) & 3) >> 1) * 32 + 8 * (lane & 3) + 4 * ((lane >> 2) & 1);
          EpiY e{ybuf, s_yrow, s_gate};
          gemm3f<MOE_MT, D>(lds, g, 4, 256, e); }
    }
}

__device__ __forceinline__ void phase_final(const Params& p, int vb, int G) {
    const int lane = threadIdx.x & 63, w = threadIdx.x >> 6;
    const bf16_t* x1b = (const bf16_t*)(p.ws + WS_X1B); const bf16_t* ybuf = (const bf16_t*)(p.ws + WS_Y);
    const int stride = G * 8;
#define F_LOAD(q, row) do { \
        _Pragma("unroll") for (int j = 0; j < 2; ++j) q[j] = *(const u32x4*)(x1b + ((size_t)((lane >> 3) + 8 * j) * S + (row)) * 64 + ((8 * lane) & 63)); \
        _Pragma("unroll") for (int k = 0; k < 9; ++k) { const u32x4* yr = (const u32x4*)(ybuf + (size_t)((row) * 9 + k) * D) + lane; q[2 + 2 * k] = yr[0]; q[3 + 2 * k] = yr[64]; } } while (0)
#define F_PROC(q, row) do { float v[2][8]; \
        _Pragma("unroll") for (int j = 0; j < 2; ++j) _Pragma("unroll") for (int e = 0; e < 4; ++e) { v[j][2 * e] = bf_lo(q[j][e]) * ALPHA; v[j][2 * e + 1] = bf_hi(q[j][e]) * ALPHA; } \
        _Pragma("unroll") for (int k = 0; k < 9; ++k) _Pragma("unroll") for (int j = 0; j < 2; ++j) _Pragma("unroll") for (int e = 0; e < 4; ++e) { v[j][2 * e] += bf_lo(q[2 + 2 * k + j][e]); v[j][2 * e + 1] += bf_hi(q[2 + 2 * k + j][e]); } \
        float sm = 0.f; \
        _Pragma("unroll") for (int j = 0; j < 2; ++j) _Pragma("unroll") for (int e = 0; e < 8; ++e) sm += v[j][e]; \
        sm = wave_sum(sm); \
        const float mean = sm * (1.0f / D); float sq = 0.f; \
        _Pragma("unroll") for (int j = 0; j < 2; ++j) _Pragma("unroll") for (int e = 0; e < 8; ++e) { v[j][e] -= mean; sq += v[j][e] * v[j][e]; } \
        sq = wave_sum(sq); \
        const float rstd = rsqrtf(sq * (1.0f / D) + LN_EPS); \
        _Pragma("unroll") for (int j = 0; j < 2; ++j) { \
            const f32x4 g0 = *((const f32x4*)p.ln2g + 2 * lane + 128 * j), g1 = *((const f32x4*)p.ln2g + 2 * lane + 128 * j + 1); \
            const f32x4 b0 = *((const f32x4*)p.ln2b + 2 * lane + 128 * j), b1 = *((const f32x4*)p.ln2b + 2 * lane + 128 * j + 1); \
            f32x4* op = (f32x4*)(p.out + (size_t)(row) * D) + 2 * lane + 128 * j; \
            op[0] = (f32x4){v[j][0], v[j][1], v[j][2], v[j][3]} * rstd * g0 + b0; \
            op[1] = (f32x4){v[j][4], v[j][5], v[j][6], v[j][7]} * rstd * g1 + b1; } } while (0)
    u32x4 qa[20], qb[20];
    int row = vb * 8 + w;
    if (row < S) F_LOAD(qa, row);
    for (; row < S; row += 2 * stride) {
        const bool n1 = row + stride < S, n2 = row + 2 * stride < S;
        if (n1) F_LOAD(qb, row + stride);
        __builtin_amdgcn_sched_barrier(0);
        F_PROC(qa, row);
        if (n1) {
            if (n2) F_LOAD(qa, row + 2 * stride);
            __builtin_amdgcn_sched_barrier(0);
            F_PROC(qb, row + stride);
        }
    }
#undef F_LOAD
#undef F_PROC
}

__global__ void __launch_bounds__(NTHREADS) mega(Params p) {
    extern __shared__ __attribute__((aligned(16))) char lds[];
    const int G = gridDim.x, bx = blockIdx.x;
    const int vb = (G % 8 == 0) ? (bx % 8) * (G / 8) + bx / 8 : bx;
    if (threadIdx.x < 4) ((volatile LAS unsigned*)((LAS char*)lds + LDS_BARST))[threadIdx.x] = 0u;
    __syncthreads();
    XcdBarrier bar; bar.bar = (unsigned*)(p.ws + WS_CTL) + CW_BAR; bar.x = 0; bar.st = nullptr;
    if (p.ph_hi - p.ph_lo > 1) bar = xcd_barrier_post((unsigned*)(p.ws + WS_CTL) + CW_BAR, (volatile LAS unsigned*)((LAS char*)lds + LDS_BARST));
#define SEAM(k) do { if (p.ph_lo <= (k) && (k) + 1 < p.ph_hi) { xcd_barrier(bar); } } while (0)
#define IN(k) (p.ph_lo <= (k) && (k) < p.ph_hi)
#define RUN(k, call) do { if (IN(k)) { call; if (MK_REPEAT == (k)) { __syncthreads(); call; } } } while (0)
    RUN(0, phase_prep(p, vb, G)); SEAM(0);
    RUN(1, phase_proj(p, lds, vb, G)); SEAM(1);
    RUN(2, phase_attn(p, lds, vb, G)); SEAM(2);
    RUN(3, phase_wout(p, lds, vb, G)); SEAM(3);
    if (IN(4)) { phase_router(p, lds, vb, G); } SEAM(4);
    RUN(5, phase_experts(p, lds, vb, G)); SEAM(5);
    RUN(6, phase_final(p, vb, G));
#undef SEAM
#undef IN
#undef RUN
}

extern "C" void kernel_launch(void* const* d_in, const int* in_sizes, int n_in, void* d_out, int out_size, void* d_ws, size_t ws_size, hipStream_t stream) {
    static int grid = 0;
    if (grid == 0) {
        if (n_in != 22 || in_sizes[0] != S * D || out_size != S * D || ws_size < WS_END) {
            fprintf(stderr, "kernel_launch: unexpected shapes: n_in %d in0 %d out %d ws %zu (need %zu)\n", n_in, n_in > 0 ? in_sizes[0] : -1, out_size, ws_size, (size_t)WS_END); grid = -1; return; }
        int dev = 0, cus = 0, per_cu = 0;
        (void)hipGetDevice(&dev); (void)hipDeviceGetAttribute(&cus, hipDeviceAttributeMultiprocessorCount, dev);
        if (hipFuncSetAttribute((const void*)mega, hipFuncAttributeMaxDynamicSharedMemorySize, LDS_BYTES) != hipSuccess) { fprintf(stderr, "kernel_launch: hipFuncSetAttribute failed\n"); grid = -1; return; }
        (void)hipOccupancyMaxActiveBlocksPerMultiprocessor(&per_cu, (const void*)mega, NTHREADS, LDS_BYTES);
        if (per_cu < 1) { fprintf(stderr, "kernel_launch: occupancy query says %d blocks per CU\n", per_cu); per_cu = 1; }
        grid = cus * 1;
        (void)hipGetLastError();
    }
    if (grid < 0) return;
    (void)hipMemsetAsync((char*)d_ws + WS_CTL, 0, CTL_BYTES, stream);
    Params p{};
    const float** f = (const float**)&p;
    for (int i = 0; i < 22; ++i) f[i] = (const float*)d_in[i];
    p.out = (float*)d_out; p.ws = (unsigned char*)d_ws;
#if MK_ONE_LAUNCH
    p.ph_lo = 0; p.ph_hi = 7;
    void* args[] = {&p};
    hipError_t e = hipLaunchCooperativeKernel((const void*)mega, dim3(grid), dim3(NTHREADS), args, LDS_BYTES, stream);
    if (e != hipSuccess) fprintf(stderr, "kernel_launch: cooperative launch failed: %s (grid %d)\n", hipGetErrorString(e), grid);
#else
    for (int ph = 0; ph < 7; ++ph) {
        p.ph_lo = ph; p.ph_hi = ph + 1;
        hipLaunchKernelGGL(mega, dim3(grid), dim3(NTHREADS), LDS_BYTES, stream, p);
    }
#endif
}
```

```cpp
#include <hip/hip_runtime.h>
#include <hip/hip_cooperative_groups.h>
#include <cstdio>
#include <cstdint>
namespace cg = cooperative_groups;

#ifndef MK_REPEAT
#define MK_REPEAT -1
#endif
#ifndef MK_ONE_LAUNCH
#define MK_ONE_LAUNCH 1
#endif

constexpr int S = 16384, D = 1024, INW = 2304, NE = 256, FF = 256;
constexpr int NTHREADS = 512;
constexpr int CAP = 16384;
constexpr float ALPHA = 1.189207115002721f;
constexpr float LN_EPS = 1e-5f;
constexpr float QSCALE = 0.125f * 1.4426950408889634f;
constexpr float LOG2E = 1.4426950408889634f;
constexpr int C_AQ = 0, C_AK = 512, C_AV = 640, C_BQ = 768, C_BK = 1280, C_BV = 1792;

constexpr size_t MiB = 1ull << 20;
constexpr size_t WS_CTL = 0;
constexpr size_t CTL_BYTES = 128 * 1024;
constexpr int CNT_STRIDE = 64;
constexpr size_t WS_ROPE = 1 * MiB;
constexpr size_t WS_WIN = 8 * MiB;
constexpr size_t WS_WOUT = 13 * MiB;
constexpr size_t WS_WR = 15 * MiB;
constexpr size_t WS_WSGU = 16 * MiB;
constexpr size_t WS_WSD = 17 * MiB;
constexpr size_t WS_EGU = 20 * MiB;
constexpr size_t WS_ED = 276 * MiB;
constexpr size_t WS_X1F = 404 * MiB;
constexpr size_t WS_X1B = 468 * MiB;
constexpr size_t WS_LIST = 500 * MiB;
constexpr size_t WS_GATE = 516 * MiB;
constexpr size_t WS_ACT = 518 * MiB;
constexpr size_t WS_Y = 590 * MiB;
constexpr size_t WS_XB = 590 * MiB;
constexpr size_t WS_PROJ = 622 * MiB;
constexpr size_t WS_ATT = 694 * MiB;
constexpr size_t WS_PRELN = 726 * MiB;
constexpr size_t WS_END = 878 * MiB;

constexpr int LDS_BYTES = 147456;
constexpr int LDS_MISC = 131072;

typedef unsigned short bf16_t;
typedef short bf16x8 __attribute__((ext_vector_type(8)));
typedef short s16x4 __attribute__((ext_vector_type(4)));
typedef float f32x4 __attribute__((ext_vector_type(4)));
typedef float f32x16 __attribute__((ext_vector_type(16)));
typedef unsigned u32x4 __attribute__((ext_vector_type(4)));
typedef unsigned u32x2 __attribute__((ext_vector_type(2)));
typedef float f32x2 __attribute__((ext_vector_type(2)));


#define LAS __attribute__((address_space(3)))
#define XB_TMO      128
#define XB_XCNT(j)  (256  + 64 * (j))
#define XB_XSUB(j)  (1280 + 64 * (j))
#define XB_XGEN(j)  (2304 + 64 * (j))
#define XB_TOP      3328
#define XB_TOPGEN   3392
#define XCD_BAR_WORDS 3456
#define XB_SPIN_CAP (1u << 18)
__device__ __forceinline__ unsigned xb_ld(unsigned* p)              { return __hip_atomic_load(p, __ATOMIC_RELAXED, __HIP_MEMORY_SCOPE_AGENT); }
__device__ __forceinline__ unsigned xb_add(unsigned* p, unsigned v) { return __hip_atomic_fetch_add(p, v, __ATOMIC_RELAXED, __HIP_MEMORY_SCOPE_AGENT); }
__device__ __forceinline__ unsigned xb_xcc_id() { return (unsigned)__builtin_amdgcn_s_getreg((3 << 11) | 20) & 0xFu; }
#define XB_SPIN(cond, bar) do { unsigned _sp = 0; while (cond) { __builtin_amdgcn_s_sleep(1); \
    if ((++_sp & 255u) == 0u) { if (xb_ld(&(bar)[XB_TMO])) break; if (_sp > XB_SPIN_CAP) { atomicAdd(&(bar)[XB_TMO], 1u); break; } } } } while (0)
struct XcdBarrier { unsigned* bar; unsigned x; volatile LAS unsigned* st; };
__device__ __forceinline__ XcdBarrier xcd_barrier_post(unsigned* bar, volatile LAS unsigned* st) {
    XcdBarrier b; b.bar = bar; b.x = xb_xcc_id(); b.st = st;
    if (threadIdx.x == 0) (void)xb_add(&bar[XB_XCNT(b.x)], 1u);
    return b;
}
__device__ __forceinline__ void xcd_barrier_complete(unsigned* bar, unsigned x, unsigned& nloc, unsigned& nx) {
    const unsigned G = gridDim.x * gridDim.y * gridDim.z;
    unsigned sum, cnt, mine, sp = 0u;
    for (;;) {
        sum = 0u; cnt = 0u; mine = 0u;
#pragma unroll
        for (unsigned j = 0; j < 16; ++j) { const unsigned c = xb_ld(&bar[XB_XCNT(j)]); sum += c; cnt += (c > 0u) ? 1u : 0u; mine = (j == x) ? c : mine; }
        if (sum == G) break;
        __builtin_amdgcn_s_sleep(1);
        if ((++sp & 255u) == 0u) { if (xb_ld(&bar[XB_TMO])) break; if (sp > XB_SPIN_CAP) { atomicAdd(&bar[XB_TMO], 1u); break; } }
    }
    nloc = mine > 0u ? mine : 1u; nx = cnt > 0u ? cnt : 1u;
}
__device__ __forceinline__ void xcd_barrier(const XcdBarrier& b) {
    asm volatile("s_waitcnt vmcnt(0)" ::: "memory");
    __syncthreads();
    if (threadIdx.x == 0) {
        unsigned* bar = b.bar;
        __builtin_amdgcn_s_waitcnt(0);
        unsigned nloc = b.st[0], nx = b.st[1];
        if (nloc == 0u) { xcd_barrier_complete(bar, b.x, nloc, nx); b.st[0] = nloc; b.st[1] = nx; }
        const unsigned old = xb_add(&bar[XB_XSUB(b.x)], 1u);
        const unsigned gen = old / nloc;
        if (old + 1u == (gen + 1u) * nloc) {
            __builtin_amdgcn_fence(__ATOMIC_RELEASE, "agent");
            asm volatile("s_waitcnt vmcnt(0)" ::: "memory");
            const unsigned og = xb_add(&bar[XB_TOP], 1u);
            const unsigned tg = og / nx;
            if (og + 1u == (tg + 1u) * nx) xb_add(&bar[XB_TOPGEN], 1u);
            else XB_SPIN(xb_ld(&bar[XB_TOPGEN]) == tg, bar);
            __builtin_amdgcn_fence(__ATOMIC_ACQUIRE, "agent");
            xb_add(&bar[XB_XGEN(b.x)], 1u);
            asm volatile("s_waitcnt vmcnt(0)" ::: "memory");
        } else {
            XB_SPIN(xb_ld(&bar[XB_XGEN(b.x)]) == gen, bar);
            __builtin_amdgcn_fence(__ATOMIC_ACQUIRE, "agent");
            asm volatile("s_waitcnt vmcnt(0)" ::: "memory");
        }
    }
    __syncthreads();
}
constexpr int CW_BAR = 4096;
constexpr int LDS_BARST = LDS_MISC + 8192;

struct Params {
    const float* x; const float* w_in; const float* b_in; const float* sinks;
    const float* lq1; const float* lk1; const float* lq2; const float* lk2; const float* subg;
    const float* w_out; const float* ln1g; const float* ln1b; const float* w_r; const float* r_bias;
    const float* w_g; const float* w_u; const float* w_d; const float* ws_g; const float* ws_u; const float* ws_d;
    const float* ln2g; const float* ln2b;
    float* out; unsigned char* ws;
    int ph_lo, ph_hi;
};

__device__ __forceinline__ unsigned cvt_pk(float lo, float hi) { unsigned r; asm volatile("v_cvt_pk_bf16_f32 %0, %1, %2" : "=v"(r) : "v"(lo), "v"(hi)); return r; }
typedef __bf16 bf16x2_t __attribute__((ext_vector_type(2)));
__device__ __forceinline__ unsigned cvt_pk_vis(float lo, float hi) { const bf16x2_t r = __builtin_convertvector((f32x2){lo, hi}, bf16x2_t); return *(const unsigned*)&r; }
__device__ __forceinline__ float bf_lo(unsigned u) { return __uint_as_float(u << 16); }
__device__ __forceinline__ float bf_hi(unsigned u) { return __uint_as_float(u & 0xffff0000u); }
__device__ __forceinline__ float wave_sum(float v) {
#pragma unroll
    for (int o = 1; o < 64; o <<= 1) v += __shfl_xor(v, o);
    return v;
}
__device__ __forceinline__ float half_max(float v) { auto rr = __builtin_amdgcn_permlane32_swap(__float_as_uint(v), __float_as_uint(v), false, false); return fmaxf(__uint_as_float(rr[0]), __uint_as_float(rr[1])); }
__device__ __forceinline__ float half_sum(float v) { auto rr = __builtin_amdgcn_permlane32_swap(__float_as_uint(v), __float_as_uint(v), false, false); return __uint_as_float(rr[0]) + __uint_as_float(rr[1]); }

__device__ __forceinline__ int swz(int r, int c) { const int f = (r & 7) ^ (((r >> 3) & 1) << 1) ^ ((r >> 4) & 1); return r * 128 + ((c ^ f) << 4); }

struct G2Args {
    const char* A; const char* B;
    unsigned offA[4], offB[4];
    int nk;
    unsigned akstep;
};
__device__ __forceinline__ unsigned g2_chunk_off(int lane, int w) { const int f = (lane >> 3) ^ ((w & 1) << 1) ^ ((w >> 1) & 1); return (unsigned)(((lane & 7) ^ f) << 4); }
template <int MT, int NT, class Epi>
__device__ __forceinline__ void gemm2n(char* lds_, const G2Args& g, const Epi& epi) {
    constexpr int A_BYTES = 32 * MT * 128, B_BYTES = 64 * NT * 128, STAGE = A_BYTES + B_BYTES, AR = MT / 2, BRR = NT;
    LAS char* lds = (LAS char*)lds_;
    const int tid = threadIdx.x, lane = tid & 63, w = __builtin_amdgcn_readfirstlane(tid >> 6), wr = w >> 2, wc = w & 3, fr = lane & 15, fq = lane >> 4;
    f32x4 acc[MT][NT];
#pragma unroll
    for (int i = 0; i < MT; ++i)
#pragma unroll
        for (int j = 0; j < NT; ++j) acc[i][j] = (f32x4){0.f, 0.f, 0.f, 0.f};
    const int ldsw = w * 1024;
#define G2_STAGE(kt, s) do { \
        _Pragma("unroll") for (int i = 0; i < AR; ++i) __builtin_amdgcn_global_load_lds((const unsigned*)(g.A + g.offA[i] + (size_t)(kt) * g.akstep), (LAS unsigned*)(lds + (s) * STAGE + i * 8192 + ldsw), 16, 0, 0); \
        _Pragma("unroll") for (int i = 0; i < BRR; ++i) __builtin_amdgcn_global_load_lds((const unsigned*)(g.B + g.offB[i] + (size_t)(kt) * 128), (LAS unsigned*)(lds + (s) * STAGE + A_BYTES + i * 8192 + ldsw), 16, 0, 0); } while (0)
    G2_STAGE(0, 0);
    __syncthreads();
    for (int kt = 0; kt < g.nk; ++kt) {
        const int s = kt & 1;
        if (kt + 1 < g.nk) { if (s) G2_STAGE(kt + 1, 0); else G2_STAGE(kt + 1, 1); }
        else epi.pre(lds_ + (s ^ 1) * STAGE);
        const char* la = lds_ + s * STAGE; const char* lb = la + A_BYTES;
        {
            constexpr int NG = 2 * (MT / 4);
            bf16x8 bfr[NT], af[2][4];
#pragma unroll
            for (int nt = 0; nt < NT; ++nt) bfr[nt] = *(const bf16x8*)(lb + swz(wc * 16 * NT + nt * 16 + fr, fq));
#pragma unroll
            for (int m = 0; m < 4; ++m) af[0][m] = *(const bf16x8*)(la + swz(wr * 16 * MT + m * 16 + fr, fq));
#pragma unroll
            for (int gi = 0; gi < NG; ++gi) {
                const int ks = gi / (MT / 4), h = gi % (MT / 4);
                if (gi > 0 && h == 0) {
#pragma unroll
                    for (int nt = 0; nt < NT; ++nt) bfr[nt] = *(const bf16x8*)(lb + swz(wc * 16 * NT + nt * 16 + fr, ks * 4 + fq));
                }
                if (gi + 1 < NG) {
                    const int ks2 = (gi + 1) / (MT / 4), h2 = (gi + 1) % (MT / 4);
#pragma unroll
                    for (int m = 0; m < 4; ++m) af[(gi + 1) & 1][m] = *(const bf16x8*)(la + swz(wr * 16 * MT + (h2 * 4 + m) * 16 + fr, ks2 * 4 + fq));
                }
                __builtin_amdgcn_sched_barrier(0);
#pragma unroll
                for (int m = 0; m < 4; ++m)
#pragma unroll
                    for (int nt = 0; nt < NT; ++nt) acc[h * 4 + m][nt] = __builtin_amdgcn_mfma_f32_16x16x32_bf16(bfr[nt], af[gi & 1][m], acc[h * 4 + m][nt], 0, 0, 0);
                __builtin_amdgcn_sched_barrier(0);
            }
        }
        __syncthreads();
    }
#undef G2_STAGE
    epi(acc, wr, wc, fr, fq);
}
template <int MT, class Epi>
__device__ __forceinline__ void gemm2(char* lds_, const G2Args& g, const Epi& epi) { gemm2n<MT, 4>(lds_, g, epi); }
template <int MT>
__device__ __forceinline__ void g2_rows_A(G2Args& g, size_t row0, unsigned ld_bytes) {
    const int lane = threadIdx.x & 63, w = __builtin_amdgcn_readfirstlane(threadIdx.x >> 6); const unsigned co = g2_chunk_off(lane, w);
#pragma unroll
    for (int i = 0; i < MT / 2; ++i) g.offA[i] = (unsigned)((row0 + i * 64 + w * 8 + (lane >> 3)) * ld_bytes) + co;
}
__device__ __forceinline__ void g2_rows_B(G2Args& g, size_t row0, unsigned ld_bytes) {
    const int lane = threadIdx.x & 63, w = __builtin_amdgcn_readfirstlane(threadIdx.x >> 6); const unsigned co = g2_chunk_off(lane, w);
#pragma unroll
    for (int i = 0; i < 4; ++i) g.offB[i] = (unsigned)((row0 + i * 64 + w * 8 + (lane >> 3)) * ld_bytes) + co;
}


struct G3fArgs { const char* A; unsigned offA[4]; const float* b; int nk; unsigned akstep; };
template <int MT, int LDB, class Epi>
__device__ __forceinline__ void gemm3f(char* lds_, const G3fArgs& g, int npass, int bpstep, const Epi& epi) {
    constexpr int A_BYTES = 32 * MT * 128, B_BYTES = 256 * 128, STAGE = A_BYTES + B_BYTES, AR = MT / 2;
    LAS char* lds = (LAS char*)lds_;
    int tid = threadIdx.x; asm volatile("" : "+v"(tid));
    const int lane = tid & 63, w = __builtin_amdgcn_readfirstlane(tid >> 6), wr = w >> 2, wc = w & 3, fr = lane & 15, fq = lane >> 4;
    f32x4 acc[MT][4];
#pragma unroll
    for (int i = 0; i < MT; ++i)
#pragma unroll
        for (int j = 0; j < 4; ++j) acc[i][j] = (f32x4){0.f, 0.f, 0.f, 0.f};
    const int ldsw = w * 1024;
    int bw[4];
#pragma unroll
    for (int j = 0; j < 4; ++j) bw[j] = swz(4 * lane + j, w);
    f32x4 br[8];
    const int nk = g.nk, nsteps = nk * npass;
#define G3_STAGE_A(kt, s) do { \
        _Pragma("unroll") for (int i = 0; i < AR; ++i) __builtin_amdgcn_global_load_lds((const unsigned*)(g.A + g.offA[i] + (size_t)(kt) * g.akstep), (LAS unsigned*)(lds + (s) * STAGE + i * 8192 + ldsw), 16, 0, 0); } while (0)
#define G3_LOAD_B(ps, kt) do { const float* pb_ = g.b + (size_t)(ps) * bpstep + (size_t)(kt) * 64 * LDB; _Pragma("unroll") for (int i = 0; i < 8; ++i) br[i] = *(const f32x4*)(pb_ + i * LDB); } while (0)
#define G3_WRITE_B(s) do { _Pragma("unroll") for (int j = 0; j < 4; ++j) { \
            u32x4 v = {cvt_pk(br[0][j], br[1][j]), cvt_pk(br[2][j], br[3][j]), cvt_pk(br[4][j], br[5][j]), cvt_pk(br[6][j], br[7][j])}; \
            *(u32x4*)(lds_ + (s) * STAGE + A_BYTES + bw[j]) = v; } } while (0)
#define G3_BARRIER(keep8) do { if (keep8) asm volatile("s_waitcnt vmcnt(8) lgkmcnt(0)\n\ts_barrier" ::: "memory"); else asm volatile("s_waitcnt vmcnt(0) lgkmcnt(0)\n\ts_barrier" ::: "memory"); } while (0)
    G3_STAGE_A(0, 0); G3_LOAD_B(0, 0); G3_WRITE_B(0);
    { const int kt1 = (nk > 1) ? 1 : 0, ps1 = (nk > 1) ? 0 : 1; if (nsteps > 1) G3_LOAD_B(ps1, kt1); }
    G3_BARRIER(nsteps > 1);
    int ps = 0, kt = 0;
    for (int st = 0; st < nsteps; ++st) {
        const int s = st & 1; const bool more = st + 1 < nsteps, more2 = st + 2 < nsteps;
        int ps2 = ps, kt2 = kt + 1; if (kt2 == nk) { kt2 = 0; ++ps2; }
        int ps3 = ps2, kt3 = kt2 + 1; if (kt3 == nk) { kt3 = 0; ++ps3; }
        if (more) { if (s) G3_STAGE_A(kt2, 0); else G3_STAGE_A(kt2, 1); }
        __builtin_amdgcn_sched_barrier(0);
        const char* la = lds_ + s * STAGE; const char* lb = la + A_BYTES;
        {
            constexpr int NG = MT;
            bf16x8 bfr[4], af[2][2];
#pragma unroll
            for (int nt = 0; nt < 4; ++nt) bfr[nt] = *(const bf16x8*)(lb + swz(wc * 64 + nt * 16 + fr, fq));
#pragma unroll
            for (int m = 0; m < 2; ++m) af[0][m] = *(const bf16x8*)(la + swz(wr * 16 * MT + m * 16 + fr, fq));
#pragma unroll
            for (int gi = 0; gi < NG; ++gi) {
                const int ks = gi / (MT / 2), h = gi % (MT / 2);
                if (gi > 0 && h == 0) {
#pragma unroll
                    for (int nt = 0; nt < 4; ++nt) bfr[nt] = *(const bf16x8*)(lb + swz(wc * 64 + nt * 16 + fr, ks * 4 + fq));
                }
                if (gi + 1 < NG) {
                    const int ks2 = (gi + 1) / (MT / 2), h2 = (gi + 1) % (MT / 2);
#pragma unroll
                    for (int m = 0; m < 2; ++m) af[(gi + 1) & 1][m] = *(const bf16x8*)(la + swz(wr * 16 * MT + (h2 * 2 + m) * 16 + fr, ks2 * 4 + fq));
                }
                __builtin_amdgcn_sched_barrier(0);
#pragma unroll
                for (int m = 0; m < 2; ++m)
#pragma unroll
                    for (int nt = 0; nt < 4; ++nt) acc[h * 2 + m][nt] = __builtin_amdgcn_mfma_f32_16x16x32_bf16(bfr[nt], af[gi & 1][m], acc[h * 2 + m][nt], 0, 0, 0);
                __builtin_amdgcn_sched_barrier(0);
            }
        }
        if (kt == nk - 1) {
            epi(acc, ps, wr, wc, fr, fq);
#pragma unroll
            for (int i = 0; i < MT; ++i)
#pragma unroll
                for (int j = 0; j < 4; ++j) acc[i][j] = (f32x4){0.f, 0.f, 0.f, 0.f};
        }
        if (more) { if (s) G3_WRITE_B(0); else G3_WRITE_B(1); }
        if (more2) G3_LOAD_B(ps3, kt3);
        G3_BARRIER(more2);
        ps = ps2; kt = kt2;
    }
#undef G3_BARRIER
#undef G3_STAGE_A
#undef G3_LOAD_B
#undef G3_WRITE_B
}

__device__ __forceinline__ void cvt_item(const float* W, int K, int N, bf16_t* WT, int ldt, int kb, int nb, int kc, int lane) {
    const float* src = W + (size_t)(kb * 64 + kc * 8) * N + nb * 256 + 4 * lane;
    bf16_t* dst = WT + (size_t)(nb * 256 + 4 * lane) * ldt + kb * 64 + kc * 8;
    f32x4 r[8];
#pragma unroll
    for (int i = 0; i < 8; ++i) r[i] = *(const f32x4*)(src + (size_t)i * N);
#pragma unroll
    for (int j = 0; j < 4; ++j) {
        u32x4 v = {cvt_pk(r[0][j], r[1][j]), cvt_pk(r[2][j], r[3][j]), cvt_pk(r[4][j], r[5][j]), cvt_pk(r[6][j], r[7][j])};
        *(u32x4*)(dst + (size_t)j * ldt) = v;
    }
}
__device__ __forceinline__ void phase_prep(const Params& p, int vb, int G) {
    const int tid = threadIdx.x, lane = tid & 63, w = tid >> 6;
    float* cs = (float*)(p.ws + WS_ROPE); float* sn = cs + (size_t)S * 32;
    for (int idx = vb * NTHREADS + tid; idx < S * 32; idx += G * NTHREADS) {
        const int pos = idx >> 5, i = idx & 31;
        const float pw = (float)pow(10000.0, (double)i / 32.0);
        const float inv = 1.0f / pw;
        const float angf = __fmul_rn((float)pos, inv);
        const double a = (double)angf;
        const double q = rint(a * 0.63661977236758134308);
        double r = fma(-q, 1.57079632679489655800, a); r = fma(-q, 6.12323399573676603587e-17, r);
        const double r2 = r * r;
        double sp = r * (1.0 + r2 * (-1.0 / 6 + r2 * (1.0 / 120 + r2 * (-1.0 / 5040 + r2 * (1.0 / 362880 + r2 * (-1.0 / 39916800))))));
        double cp = 1.0 + r2 * (-0.5 + r2 * (1.0 / 24 + r2 * (-1.0 / 720 + r2 * (1.0 / 40320 + r2 * (-1.0 / 3628800 + r2 * (1.0 / 479001600))))));
        const int qi = ((int)((long long)q)) & 3;
        double sv, cv;
        if (qi == 0) { sv = sp; cv = cp; } else if (qi == 1) { sv = cp; cv = -sp; } else if (qi == 2) { sv = -sp; cv = -cp; } else { sv = -cp; cv = sp; }
        cs[idx] = (float)cv; sn[idx] = (float)sv;
    }
    { const f32x4* xs = (const f32x4*)p.x; u32x4* xd = (u32x4*)(p.ws + WS_XB);
      for (size_t i = (size_t)vb * NTHREADS + tid; i < (size_t)S * D / 8; i += (size_t)G * NTHREADS) {
          const f32x4 a = xs[2 * i], b = xs[2 * i + 1];
          xd[i] = (u32x4){cvt_pk(a[0], a[1]), cvt_pk(a[2], a[3]), cvt_pk(b[0], b[1]), cvt_pk(b[2], b[3])}; } }
    const int gw = vb * 8 + w, NGW = G * 8;
    constexpr int I_IN = 16 * 9, I_OUT = 16 * 4, I_R = 16, I_SG = 16, I_SU = 16, I_SD = 4 * 4, I_SMALL = I_IN + I_OUT + I_R;
    for (int it8 = gw; it8 < I_SMALL * 8; it8 += NGW) {
        int r = it8 >> 3; const int kc = it8 & 7;
        if (r < I_IN) { cvt_item(p.w_in, D, INW, (bf16_t*)(p.ws + WS_WIN), D, r / 9, r % 9, kc, lane); continue; } r -= I_IN;
        if (r < I_OUT) { cvt_item(p.w_out, D, D, (bf16_t*)(p.ws + WS_WOUT), D, r >> 2, r & 3, kc, lane); continue; } r -= I_OUT;
        cvt_item(p.w_r, D, NE, (bf16_t*)(p.ws + WS_WR), D, r, 0, kc, lane);
    }
}

template <int MT> struct EpiProj {
    const float* bias; const float* cs; const float* sn; bf16_t* out; int row0, col0; char* lds;
    __device__ __forceinline__ void pre(char* stage) const {
        int tid = threadIdx.x; asm volatile("" : "+v"(tid));
        const int w = __builtin_amdgcn_readfirstlane(tid >> 6), lane = tid & 63;
        constexpr int TB = 32 * MT * 128;
        LAS char* l3 = (LAS char*)stage;
#pragma unroll
        for (int i = 0; i < TB / 8192; ++i) {
            __builtin_amdgcn_global_load_lds((const unsigned*)((const char*)(cs + (size_t)row0 * 32) + i * 8192 + w * 1024 + lane * 16), (LAS unsigned*)(l3 + i * 8192 + w * 1024), 16, 0, 0);
            __builtin_amdgcn_global_load_lds((const unsigned*)((const char*)(sn + (size_t)row0 * 32) + i * 8192 + w * 1024 + lane * 16), (LAS unsigned*)(l3 + TB + i * 8192 + w * 1024), 16, 0, 0);
        }
    }
    __device__ __forceinline__ void operator()(f32x4 (&acc)[MT][4], int wr, int wc, int fr, int fq) const {
        const int hb = col0 + wc * 64;
        const bool is_q = (hb < C_AK) || (hb >= C_BQ && hb < C_BK);
        const bool is_rope = is_q || (hb >= C_AK && hb < C_AV) || (hb >= C_BK && hb < C_BV);
        const float sc = is_q ? QSCALE : 1.0f;
        constexpr int TB = 32 * MT * 128;
        f32x4 bv[4];
#pragma unroll
        for (int nt = 0; nt < 4; ++nt) bv[nt] = *(const f32x4*)(bias + hb + (nt >> 1) * 32 + 8 * fq + 4 * (nt & 1));
        __syncthreads();
        const float* lcs = (const float*)lds; const float* lsn = (const float*)(lds + TB);
#pragma unroll
        for (int mt = 0; mt < MT; ++mt) {
            const int rl = wr * 16 * MT + mt * 16 + fr, row = row0 + rl;
            f32x4 v[4];
#pragma unroll
            for (int nt = 0; nt < 4; ++nt) v[nt] = acc[mt][nt] + bv[nt];
            if (is_rope) {
#pragma unroll
                for (int nt = 0; nt < 2; ++nt) {
                    const f32x4 c = *(const f32x4*)(lcs + rl * 32 + 8 * fq + 4 * nt), s = *(const f32x4*)(lsn + rl * 32 + 8 * fq + 4 * nt);
                    const f32x4 t1 = v[nt], t2 = v[nt + 2];
                    v[nt] = t1 * c - t2 * s; v[nt + 2] = t2 * c + t1 * s;
                }
            }
#pragma unroll
            for (int a = 0; a < 2; ++a) {
                const f32x4 o0 = v[2 * a] * sc, o1 = v[2 * a + 1] * sc;
                u32x4 pk = {cvt_pk(o0[0], o0[1]), cvt_pk(o0[2], o0[3]), cvt_pk(o1[0], o1[1]), cvt_pk(o1[2], o1[3])};
                *(u32x4*)(out + (size_t)row * INW + hb + a * 32 + 8 * fq) = pk;
            }
        }
        __syncthreads();
    }
};
struct EpiProjQ {
    const float* bias; const float* cs; const float* sn; bf16_t* out; int row0, col0;
    __device__ __forceinline__ void pre(char*) const {}
    __device__ __forceinline__ void operator()(f32x4 (&acc)[4][2], int wr, int wc, int fr, int fq) const {
        const int hb = col0 + (wc >> 1) * 64, i0 = (wc & 1) * 16 + 4 * fq;
        const bool is_q = (hb < C_AK) || (hb >= C_BQ && hb < C_BK);
        const bool is_rope = is_q || (hb >= C_AK && hb < C_AV) || (hb >= C_BK && hb < C_BV);
        const float sc = is_q ? QSCALE : 1.0f;
#pragma unroll
        for (int mt = 0; mt < 4; ++mt) {
            const int row = row0 + wr * 64 + mt * 16 + fr;
            f32x4 v0 = acc[mt][0] + *(const f32x4*)(bias + hb + i0), v1 = acc[mt][1] + *(const f32x4*)(bias + hb + 32 + i0);
            if (is_rope) {
                const f32x4 c = *(const f32x4*)(cs + (size_t)row * 32 + i0), s = *(const f32x4*)(sn + (size_t)row * 32 + i0);
                const f32x4 t1 = v0, t2 = v1; v0 = t1 * c - t2 * s; v1 = t2 * c + t1 * s;
            }
            v0 = v0 * sc; v1 = v1 * sc;
            *(u32x2*)(out + (size_t)row * INW + hb + i0) = (u32x2){cvt_pk(v0[0], v0[1]), cvt_pk(v0[2], v0[3])};
            *(u32x2*)(out + (size_t)row * INW + hb + 32 + i0) = (u32x2){cvt_pk(v1[0], v1[1]), cvt_pk(v1[2], v1[3])};
        }
    }
};
__device__ __forceinline__ void phase_proj(const Params& p, char* lds, int vb, int G) {
    const float* cs = (const float*)(p.ws + WS_ROPE); const float* sn = cs + (size_t)S * 32;
    constexpr int NBIG = 512, NUNITS = NBIG + 4 * 64;
    for (int u = vb; u < NUNITS; u += G) {
        G2Args g; g.A = (const char*)(p.ws + WS_XB); g.B = (const char*)(p.ws + WS_WIN); g.nk = D / 64; g.akstep = 128;
        if (u < NBIG) {
            const int tm = u / 9, tn = u % 9;
            g2_rows_A<8>(g, (size_t)tm * 256, D * 2);
            { const int lane = threadIdx.x & 63, w = __builtin_amdgcn_readfirstlane(threadIdx.x >> 6); const unsigned co = g2_chunk_off(lane, w);
#pragma unroll
              for (int i = 0; i < 4; ++i) { const int n = i * 64 + w * 8 + (lane >> 3), nt = (n >> 4) & 3, nl = n & 15;
                  const int col = tn * 256 + (n >> 6) * 64 + (nt >> 1) * 32 + 8 * (nl >> 2) + 4 * (nt & 1) + (nl & 3);
                  g.offB[i] = (unsigned)col * (unsigned)(D * 2) + co; } }
            EpiProj<8> e{p.b_in, cs, sn, (bf16_t*)(p.ws + WS_PROJ), tm * 256, tn * 256, lds};
            gemm2<8>(lds, g, e);
        } else {
            const int q = u - NBIG, t = NBIG + (q >> 2), hm = (q >> 1) & 1, hn = q & 1, tm = t / 9, tn = t % 9;
            g2_rows_A<4>(g, (size_t)tm * 256 + hm * 128, D * 2);
            { const int lane = threadIdx.x & 63, w = __builtin_amdgcn_readfirstlane(threadIdx.x >> 6); const unsigned co = g2_chunk_off(lane, w);
#pragma unroll
              for (int i = 0; i < 2; ++i) { const int n = i * 64 + w * 8 + (lane >> 3), wcn = n >> 5, sub = n & 31;
                  const int col = tn * 256 + hn * 128 + (wcn >> 1) * 64 + (wcn & 1) * 16 + (sub & 15) + (sub >> 4) * 32;
                  g.offB[i] = (unsigned)col * (unsigned)(D * 2) + co; } }
            EpiProjQ e{p.b_in, cs, sn, (bf16_t*)(p.ws + WS_PROJ), tm * 256 + hm * 128, tn * 256 + hn * 128};
            gemm2n<4, 2>(lds, g, e);
        }
    }
}

template <int OFF> __device__ __forceinline__ s16x4 tr_read(int vb) { s16x4 r; asm volatile("ds_read_b64_tr_b16 %0, %1 offset:%2" : "=&v"(r) : "v"(vb), "i"(OFF) : "memory"); return r; }
__device__ __forceinline__ int v_off(int k, int c, int ndb) { return ((k >> 3) * ndb + (c >> 5)) * 512 + ((k & 7) * 32 + (c & 31)) * 2; }

constexpr int AT_STAGE = 32768;
template <int NDB, int KB, int T> struct PvPart {
    static __device__ __forceinline__ void run(f32x16& o, int vbase, const bf16x8& pa, const bf16x8& pb) {
        constexpr int o0 = (KB * 4 * NDB + T) * 512, st = NDB * 512;
        const s16x4 l0 = tr_read<o0 + 0 * st>(vbase), h0 = tr_read<o0 + 1 * st>(vbase), l1 = tr_read<o0 + 2 * st>(vbase), h1 = tr_read<o0 + 3 * st>(vbase);
        asm volatile("s_waitcnt lgkmcnt(0)" ::: "memory"); __builtin_amdgcn_sched_barrier(0);
#define PKV(L, H) (bf16x8){L[0], L[1], L[2], L[3], H[0], H[1], H[2], H[3]}
        o = __builtin_amdgcn_mfma_f32_32x32x16_bf16(PKV(l0, h0), pa, o, 0, 0, 0);
        o = __builtin_amdgcn_mfma_f32_32x32x16_bf16(PKV(l1, h1), pb, o, 0, 0, 0);
#undef PKV
    }
};
template <int NDB, int KB>
__device__ __forceinline__ void pv_half(f32x16 (&o)[NDB], f32x16& ol, int vbase, const bf16x8& pa, const bf16x8& pb) {
    const bf16x8 ones = {16256, 16256, 16256, 16256, 16256, 16256, 16256, 16256};
    ol = __builtin_amdgcn_mfma_f32_32x32x16_bf16(ones, pa, ol, 0, 0, 0);
    ol = __builtin_amdgcn_mfma_f32_32x32x16_bf16(ones, pb, ol, 0, 0, 0);
    PvPart<NDB, KB, 0>::run(o[0], vbase, pa, pb); PvPart<NDB, KB, 1>::run(o[1], vbase, pa, pb);
    if constexpr (NDB == 4) { PvPart<NDB, KB, 2>::run(o[2], vbase, pa, pb); PvPart<NDB, KB, 3>::run(o[3], vbase, pa, pb); }
}
constexpr float ATT_THR = 10.0f;
template <int NDB>
__device__ __forceinline__ void attn_scores(char* lds, int kof, const bf16x8 (&qf)[4], f32x16& s0, f32x16& s1, f32x16 (&o)[NDB], f32x16& ol, f32x16& nm, bool first, int r32, int hi) {
    s0 = nm; s1 = nm;
#pragma unroll
    for (int ds = 0; ds < 4; ++ds) {
        const bf16x8 k0 = *(const bf16x8*)(lds + kof + swz(r32, ds * 2 + hi)), k1 = *(const bf16x8*)(lds + kof + swz(32 + r32, ds * 2 + hi));
        s0 = __builtin_amdgcn_mfma_f32_32x32x16_bf16(k0, qf[ds], s0, 0, 0, 0);
        s1 = __builtin_amdgcn_mfma_f32_32x32x16_bf16(k1, qf[ds], s1, 0, 0, 0);
    }
    float mx = fmaxf(s0[0], s1[0]);
#pragma unroll
    for (int r = 1; r < 16; ++r) mx = fmaxf(fmaxf(mx, s0[r]), s1[r]);
    mx = half_max(mx);
    if (first || __any(mx > ATT_THR)) {
        const float delta = first ? mx : fmaxf(mx, 0.f), alpha = first ? 0.f : __builtin_amdgcn_exp2f(-delta);
#pragma unroll
        for (int r = 0; r < 16; ++r) { s0[r] -= delta; s1[r] -= delta; nm[r] -= delta; ol[r] *= alpha; }
#pragma unroll
        for (int t = 0; t < NDB; ++t)
#pragma unroll
            for (int r = 0; r < 16; ++r) o[t][r] *= alpha;
    }
}
__device__ __forceinline__ void exp_pack(const f32x16& s, bf16x8& pa, bf16x8& pb) {
    float e[16];
#pragma unroll
    for (int r = 0; r < 16; ++r) e[r] = __builtin_amdgcn_exp2f(s[r]);
    u32x4 a = {cvt_pk_vis(e[0], e[1]), cvt_pk_vis(e[2], e[3]), cvt_pk_vis(e[4], e[5]), cvt_pk_vis(e[6], e[7])};
    u32x4 b = {cvt_pk_vis(e[8], e[9]), cvt_pk_vis(e[10], e[11]), cvt_pk_vis(e[12], e[13]), cvt_pk_vis(e[14], e[15])};
    pa = *(bf16x8*)&a; pb = *(bf16x8*)&b;
}

template <int OFF> __device__ __forceinline__ bf16x8 k_read(int a) { bf16x8 r; asm volatile("ds_read_b128 %0, %1 offset:%2" : "=&v"(r) : "v"(a), "i"(OFF) : "memory"); return r; }
struct VSet { s16x4 l0, h0, l1, h1; };
template <int KB, int T> __device__ __forceinline__ void v_issue(VSet& v, int vbase) {
    constexpr int o0 = (KB * 16 + T) * 512, st = 4 * 512;
    v.l0 = tr_read<o0>(vbase); v.h0 = tr_read<o0 + st>(vbase); v.l1 = tr_read<o0 + 2 * st>(vbase); v.h1 = tr_read<o0 + 3 * st>(vbase);
}
#define WAIT_K(n, a, b) asm volatile("s_waitcnt lgkmcnt(" #n ")" : "+v"(a), "+v"(b) :: "memory")
#define WAIT_V(n, v) asm volatile("s_waitcnt lgkmcnt(" #n ")" : "+v"(v.l0), "+v"(v.h0), "+v"(v.l1), "+v"(v.h1) :: "memory")
#define PKV(L, H) (bf16x8){L[0], L[1], L[2], L[3], H[0], H[1], H[2], H[3]}
#define MF32(a, b, c) __builtin_amdgcn_mfma_f32_32x32x16_bf16(a, b, c, 0, 0, 0)
#define SB __builtin_amdgcn_sched_barrier(0)
#define EXP4(src, i, wlo, whi) do { const float e0_ = __builtin_amdgcn_exp2f(src[4 * (i)]), e1_ = __builtin_amdgcn_exp2f(src[4 * (i) + 1]), e2_ = __builtin_amdgcn_exp2f(src[4 * (i) + 2]), e3_ = __builtin_amdgcn_exp2f(src[4 * (i) + 3]); \
        asm("v_add_f32 %0, %1, %0" : "+v"(l2[0]) : "v"(e0_)); asm("v_add_f32 %0, %1, %0" : "+v"(l2[1]) : "v"(e1_)); asm("v_add_f32 %0, %1, %0" : "+v"(l2[0]) : "v"(e2_)); asm("v_add_f32 %0, %1, %0" : "+v"(l2[1]) : "v"(e3_)); \
        wlo = cvt_pk(e0_, e1_); whi = cvt_pk(e2_, e3_); } while (0)
#define EXP2(src, i, w) do { const float e0_ = __builtin_amdgcn_exp2f(src[2 * (i)]), e1_ = __builtin_amdgcn_exp2f(src[2 * (i) + 1]); \
        w = cvt_pk_vis(e0_, e1_); asm("v_add_f32 %0, %1, %0" : "+v"(l2[0]) : "v"(e0_), "v"(w)); asm("v_add_f32 %0, %1, %0" : "+v"(l2[1]) : "v"(e1_), "v"(w)); } while (0)
#define MAX4(i) do { mx = fmaxf(fmaxf(mx, n0[4 * (i)]), n1[4 * (i)]); mx = fmaxf(fmaxf(mx, n0[4 * (i) + 1]), n1[4 * (i) + 1]); \
        mx = fmaxf(fmaxf(mx, n0[4 * (i) + 2]), n1[4 * (i) + 2]); mx = fmaxf(fmaxf(mx, n0[4 * (i) + 3]), n1[4 * (i) + 3]); asm volatile("" : "+v"(mx)); } while (0)
struct DmaPlan { const char* base; unsigned gk, gv; size_t ok3, ok4, ov2, ov3; LAS char* dk3; LAS char* dk4; LAS char* dv2; LAS char* dv3; };
#define DMAP(src, dst) __builtin_amdgcn_global_load_lds((const unsigned*)(src), (LAS unsigned*)(dst), 16, 0, 0)
template <bool DMA>
__device__ __forceinline__ void diff_slot(f32x16& c0, f32x16& c1, f32x16& n0, f32x16& n1, f32x16 (&o)[4], f32x2& l2, f32x16& nm, const bf16x8 (&qf)[4],
                                          int ka0, int ka1, int ka2, int ka3, int vbase, bool has_next, const DmaPlan& dp) {
    constexpr bool HASNEXT = true;
    bf16x8 kA, kB, kC, kD, kE, kF, kG, kH; VSet v4, v5, v6, v7, v8, v9, v10, v11; u32x4 w0, w1, w2, w3;
    float mx = -3.0e38f;
    SB;
    kA = k_read<0>(ka0); kB = k_read<4096>(ka0); kC = k_read<0>(ka1); kD = k_read<4096>(ka1);
    EXP2(c0, 0, w0[0]);
    EXP2(c0, 1, w0[1]);
    WAIT_K(2, kA, kB);
    kE = k_read<0>(ka2); kF = k_read<4096>(ka2);
    n0 = MF32(kA, qf[0], nm); n1 = MF32(kB, qf[0], nm);
    if constexpr (DMA) DMAP(dp.base + dp.ok3 + dp.gk, dp.dk3);
    SB;
    EXP2(c0, 2, w0[2]);
    WAIT_K(2, kC, kD);
    kG = k_read<0>(ka3); kH = k_read<4096>(ka3);
    n0 = MF32(kC, qf[1], n0); n1 = MF32(kD, qf[1], n1);
    if constexpr (DMA) DMAP(dp.base + (dp.ok3 + 128) + dp.gk, dp.dk3 + 8192);
    SB;
    EXP2(c0, 3, w0[3]);
    EXP2(c0, 4, w1[0]);
    WAIT_K(2, kE, kF);
    v4.l0 = tr_read<0>(vbase); v4.h0 = tr_read<2048>(vbase); v4.l1 = tr_read<512>(vbase); v4.h1 = tr_read<2560>(vbase);
    n0 = MF32(kE, qf[2], n0); n1 = MF32(kF, qf[2], n1);
    if constexpr (DMA) DMAP(dp.base + dp.ov2 + dp.gv, dp.dv2);
    SB;
    EXP2(c0, 5, w1[1]);
    WAIT_K(4, kG, kH);
    v5.l0 = tr_read<1024>(vbase); v5.h0 = tr_read<3072>(vbase); v5.l1 = tr_read<1536>(vbase); v5.h1 = tr_read<3584>(vbase);
    n0 = MF32(kG, qf[3], n0); n1 = MF32(kH, qf[3], n1);
    if constexpr (DMA) DMAP(dp.base + (dp.ov2 + 128) + dp.gv, dp.dv2 + 1024);
    SB;
    EXP2(c0, 6, w1[2]);
    EXP2(c0, 7, w1[3]);
    WAIT_V(4, v4);
    v6.l0 = tr_read<4096>(vbase); v6.h0 = tr_read<6144>(vbase); v6.l1 = tr_read<4608>(vbase); v6.h1 = tr_read<6656>(vbase);
    o[0] = MF32(PKV(v4.l0, v4.h0), (*(bf16x8*)&w0), o[0]); o[1] = MF32(PKV(v4.l1, v4.h1), (*(bf16x8*)&w0), o[1]);
    if constexpr (DMA) DMAP(dp.base + dp.ov3 + dp.gv, dp.dv3);
    SB;
    EXP2(c1, 0, w2[0]);
    MAX4(0);
    WAIT_V(4, v5);
    v7.l0 = tr_read<5120>(vbase); v7.h0 = tr_read<7168>(vbase); v7.l1 = tr_read<5632>(vbase); v7.h1 = tr_read<7680>(vbase);
    o[2] = MF32(PKV(v5.l0, v5.h0), (*(bf16x8*)&w0), o[2]); o[3] = MF32(PKV(v5.l1, v5.h1), (*(bf16x8*)&w0), o[3]);
    if constexpr (DMA) DMAP(dp.base + (dp.ov3 + 128) + dp.gv, dp.dv3 + 1024);
    SB;
    EXP2(c1, 1, w2[1]);
    EXP2(c1, 2, w2[2]);
    WAIT_V(4, v6);
    v8.l0 = tr_read<8192>(vbase); v8.h0 = tr_read<10240>(vbase); v8.l1 = tr_read<8704>(vbase); v8.h1 = tr_read<10752>(vbase);
    o[0] = MF32(PKV(v6.l0, v6.h0), (*(bf16x8*)&w1), o[0]); o[1] = MF32(PKV(v6.l1, v6.h1), (*(bf16x8*)&w1), o[1]);
    if constexpr (DMA) DMAP(dp.base + dp.ok4 + dp.gk, dp.dk4);
    SB;
    EXP2(c1, 3, w2[3]);
    MAX4(1);
    WAIT_V(4, v7);
    v9.l0 = tr_read<9216>(vbase); v9.h0 = tr_read<11264>(vbase); v9.l1 = tr_read<9728>(vbase); v9.h1 = tr_read<11776>(vbase);
    o[2] = MF32(PKV(v7.l0, v7.h0), (*(bf16x8*)&w1), o[2]); o[3] = MF32(PKV(v7.l1, v7.h1), (*(bf16x8*)&w1), o[3]);
    if constexpr (DMA) DMAP(dp.base + (dp.ok4 + 128) + dp.gk, dp.dk4 + 8192);
    SB;
    EXP2(c1, 4, w3[0]);
    EXP2(c1, 5, w3[1]);
    WAIT_V(4, v8);
    v10.l0 = tr_read<12288>(vbase); v10.h0 = tr_read<14336>(vbase); v10.l1 = tr_read<12800>(vbase); v10.h1 = tr_read<14848>(vbase);
    o[0] = MF32(PKV(v8.l0, v8.h0), (*(bf16x8*)&w2), o[0]); o[1] = MF32(PKV(v8.l1, v8.h1), (*(bf16x8*)&w2), o[1]);
    SB;
    EXP2(c1, 6, w3[2]);
    EXP2(c1, 7, w3[3]);
    WAIT_V(4, v9);
    v11.l0 = tr_read<13312>(vbase); v11.h0 = tr_read<15360>(vbase); v11.l1 = tr_read<13824>(vbase); v11.h1 = tr_read<15872>(vbase);
    o[2] = MF32(PKV(v9.l0, v9.h0), (*(bf16x8*)&w2), o[2]); o[3] = MF32(PKV(v9.l1, v9.h1), (*(bf16x8*)&w2), o[3]);
    SB;
    MAX4(2);
    WAIT_V(4, v10);
    o[0] = MF32(PKV(v10.l0, v10.h0), (*(bf16x8*)&w3), o[0]); o[1] = MF32(PKV(v10.l1, v10.h1), (*(bf16x8*)&w3), o[1]);
    SB;
    MAX4(3);
    WAIT_V(0, v11);
    o[2] = MF32(PKV(v11.l0, v11.h0), (*(bf16x8*)&w3), o[2]); o[3] = MF32(PKV(v11.l1, v11.h1), (*(bf16x8*)&w3), o[3]);
    SB;
    if (has_next) {
        mx = half_max(mx);
        if (__any(mx > ATT_THR)) {
            const float delta = fmaxf(mx, 0.f), alpha = __builtin_amdgcn_exp2f(-delta);
#pragma unroll
            for (int r = 0; r < 16; ++r) { n0[r] -= delta; n1[r] -= delta; nm[r] -= delta; }
            l2 *= alpha;
#pragma unroll
            for (int t = 0; t < 4; ++t)
#pragma unroll
                for (int r = 0; r < 16; ++r) o[t][r] *= alpha;
        }
    }
}
__device__ __forceinline__ void attn_diff_unit(const Params& p, char* lds_, int h, int qb, float lam) {
    LAS char* lds = (LAS char*)lds_;
    int tid = threadIdx.x; asm volatile("" : "+v"(tid));
    const int lane = tid & 63, w = __builtin_amdgcn_readfirstlane(tid >> 6), r32 = lane & 31, hi = lane >> 5, mp = w >> 2, wq = w & 3;
    const bf16_t* proj = (const bf16_t*)(p.ws + WS_PROJ);
    const int NT = 2 * qb + 2, NP = NT / 2, myNT = (wq < 2) ? NT - 1 : NT;
    bf16x8 qf[4];
    { const bf16_t* qp = proj + (size_t)(qb * 128 + wq * 32 + r32) * INW + C_BQ + h * 128 + mp * 64 + hi * 8;
#pragma unroll
      for (int ds = 0; ds < 4; ++ds) qf[ds] = *(const bf16x8*)(qp + ds * 16); }
    asm volatile("" : "+v"(qf[0]), "+v"(qf[1]), "+v"(qf[2]), "+v"(qf[3]));
    f32x16 o[4] = {}; f32x16 nm; f32x2 l2 = {0.f, 0.f};
    const unsigned gko = (unsigned)((w * 8 + (lane >> 3)) * INW + C_BK + h * 128) * 2u + g2_chunk_off(lane, w);
    const unsigned gvo = (unsigned)((w * 8 + ((lane & 31) >> 2)) * INW + C_BV + h * 128 + (lane >> 5) * 32 + (lane & 3) * 8) * 2u;
    const char* gk = (const char*)proj + gko; const char* gv = (const char*)proj + gvo;
    const int vlane = ((lane & 3) << 3) | (((lane >> 2) & 3) << 6) | (((lane >> 4) & 1) << 5) | (((lane >> 5) & 1) << 8);
    const int ldsb = (int)(uintptr_t)lds_;
    const int kad0 = ldsb + mp * 8192 + swz(r32, 0 + hi), kad1 = ldsb + mp * 8192 + swz(r32, 2 + hi), kad2 = ldsb + mp * 8192 + swz(r32, 4 + hi), kad3 = ldsb + mp * 8192 + swz(r32, 6 + hi);
    constexpr size_t TSTEP = (size_t)64 * INW * 2;
#define DMA_K(t_) do { const int tt_ = (t_); const char* s_ = gk + (size_t)tt_ * TSTEP; LAS char* d_ = lds + (tt_ & 3) * 16384 + w * 1024; \
        __builtin_amdgcn_global_load_lds((const unsigned*)s_, (LAS unsigned*)d_, 16, 0, 0); \
        __builtin_amdgcn_global_load_lds((const unsigned*)(s_ + 128), (LAS unsigned*)(d_ + 8192), 16, 0, 0); } while (0)
#define DMA_V(t_) do { const int tt_ = (t_); const char* s_ = gv + (size_t)tt_ * TSTEP; LAS char* d_ = lds + 65536 + (tt_ & 3) * 16384 + (2 * w) * 1024; \
        __builtin_amdgcn_global_load_lds((const unsigned*)s_, (LAS unsigned*)d_, 16, 0, 0); \
        __builtin_amdgcn_global_load_lds((const unsigned*)(s_ + 128), (LAS unsigned*)(d_ + 1024), 16, 0, 0); } while (0)
    DMA_K(0); DMA_K(1); if (NT > 2) DMA_K(2); DMA_V(0); DMA_V(1);
    __syncthreads();
    f32x16 A0 = {}, A1 = {}, B0 = {}, B1 = {};
    {
#pragma unroll
        for (int ds = 0; ds < 4; ++ds) {
            const bf16x8 k0 = *(const bf16x8*)(lds_ + mp * 8192 + swz(r32, ds * 2 + hi)), k1 = *(const bf16x8*)(lds_ + mp * 8192 + swz(32 + r32, ds * 2 + hi));
            A0 = MF32(k0, qf[ds], A0); A1 = MF32(k1, qf[ds], A1);
        }
        float mx = fmaxf(A0[0], A1[0]);
#pragma unroll
        for (int r = 1; r < 16; ++r) mx = fmaxf(fmaxf(mx, A0[r]), A1[r]);
        mx = half_max(mx);
#pragma unroll
        for (int r = 0; r < 16; ++r) { A0[r] -= mx; A1[r] -= mx; nm[r] = -mx; }
    }
    __syncthreads();
    for (int it = 0; it < NP; ++it) {
        const int t = 2 * it;
        DmaPlan dp;
        dp.base = (const char*)proj; dp.gk = gko; dp.gv = gvo;
        dp.ok3 = (size_t)min(t + 3, NT - 1) * TSTEP; dp.dk3 = lds + ((t + 3) & 3) * 16384 + w * 1024;
        dp.ok4 = (size_t)min(t + 4, NT - 1) * TSTEP; dp.dk4 = lds + ((t + 4) & 3) * 16384 + w * 1024;
        dp.ov2 = (size_t)min(t + 2, NT - 1) * TSTEP; dp.dv2 = lds + 65536 + ((t + 2) & 3) * 16384 + (2 * w) * 1024;
        dp.ov3 = (size_t)min(t + 3, NT - 1) * TSTEP; dp.dv3 = lds + 65536 + ((t + 3) & 3) * 16384 + (2 * w) * 1024;
        { const int ks = ((t + 1) & 3) * 16384, vb_ = ldsb + 65536 + (t & 3) * 16384 + vlane;
          diff_slot<true>(A0, A1, B0, B1, o, l2, nm, qf, kad0 + ks, kad1 + ks, kad2 + ks, kad3 + ks, vb_, t + 1 < myNT, dp); }
        if (t + 1 < myNT) {
            const int ks = ((t + 2) & 3) * 16384, vb_ = ldsb + 65536 + ((t + 1) & 3) * 16384 + vlane;
            diff_slot<false>(B0, B1, A0, A1, o, l2, nm, qf, kad0 + ks, kad1 + ks, kad2 + ks, kad3 + ks, vb_, t + 2 < myNT, dp);
        }
        __syncthreads();
    }
#undef DMA_K
#undef DMA_V
    float* xb = (float*)lds_;
    const float il = 1.0f / half_sum(l2[0] + l2[1]);
    if (mp == 1) {
        const float f = il * *(const float*)(lds_ + LDS_MISC);
#pragma unroll
        for (int t = 0; t < 4; ++t)
#pragma unroll
            for (int r = 0; r < 16; ++r) xb[(wq * 64 + t * 16 + r) * 64 + lane] = o[t][r] * f;
    }
    __syncthreads();
    if (mp == 0) {
        float ss = 0.f;
#pragma unroll
        for (int t = 0; t < 4; ++t)
#pragma unroll
            for (int r = 0; r < 16; ++r) { const float v = o[t][r] * il - xb[(wq * 64 + t * 16 + r) * 64 + lane]; o[t][r] = v; ss += v * v; }
        ss = half_sum(ss);
        const float rs = rsqrtf(ss * (1.0f / 128.0f) + LN_EPS) * 0.8f;
        bf16_t* op = (bf16_t*)(p.ws + WS_ATT) + (size_t)(qb * 128 + wq * 32 + r32) * D + 512 + h * 128;
#pragma unroll
        for (int t = 0; t < 4; ++t)
#pragma unroll
            for (int rp = 0; rp < 2; ++rp) {
                unsigned pk[2][2];
#pragma unroll
                for (int a = 0; a < 2; ++a) {
                    const int rr = 2 * rp + a, dv0 = 32 * t + 8 * rr + 4 * hi;
                    const f32x4 gg = *(const f32x4*)(p.subg + dv0);
                    pk[a][0] = cvt_pk(o[t][4 * rr] * rs * gg[0], o[t][4 * rr + 1] * rs * gg[1]); pk[a][1] = cvt_pk(o[t][4 * rr + 2] * rs * gg[2], o[t][4 * rr + 3] * rs * gg[3]);
                }
                const auto s0 = __builtin_amdgcn_permlane32_swap(pk[0][0], pk[1][0], false, false), s1 = __builtin_amdgcn_permlane32_swap(pk[0][1], pk[1][1], false, false);
                *(u32x4*)(op + 32 * t + 8 * (2 * rp + hi)) = (u32x4){s0[0], s1[0], s0[1], s1[1]};
            }
    }
    __syncthreads();
}
#undef DMAP
#undef WAIT_K
#undef WAIT_V
#undef PKV
#undef MF32
#undef SB
#undef EXP4
#undef EXP2
#undef MAX4
__device__ __forceinline__ void attn_swa_unit(const Params& p, char* lds, int kvh, int n) {
    int tid = threadIdx.x; asm volatile("" : "+v"(tid));
    const int lane = tid & 63, w = __builtin_amdgcn_readfirstlane(tid >> 6), r32 = lane & 31, hi = lane >> 5, g = w >> 1, hq = kvh * 4 + g;
    const bf16_t* proj = (const bf16_t*)(p.ws + WS_PROJ);
    const int c0 = (n >= 2) ? n - 2 : 0, NT = n - c0 + 1;
    const int tok = n * 64 + (w & 1) * 32 + r32;
    bf16x8 qf[4];
    { const bf16_t* qp = proj + (size_t)tok * INW + C_AQ + hq * 64 + hi * 8;
#pragma unroll
      for (int ds = 0; ds < 4; ++ds) qf[ds] = *(const bf16x8*)(qp + ds * 16); }
    f32x16 o[2] = {}; f32x16 ol, nm;
    { float ms = -p.sinks[hq] * LOG2E; asm volatile("" : "+v"(qf[0]), "+v"(qf[1]), "+v"(qf[2]), "+v"(qf[3]), "+v"(ms));
#pragma unroll
      for (int r = 0; r < 16; ++r) { nm[r] = ms; ol[r] = 1.0f; } }
    const bf16_t* gk = proj + (size_t)(c0 * 64 + (tid >> 3)) * INW + C_AK + kvh * 64 + (tid & 7) * 8;
    const bf16_t* gv = proj + (size_t)(c0 * 64 + (tid >> 3)) * INW + C_AV + kvh * 64 + (tid & 7) * 8;
    const int wk = swz(tid >> 3, tid & 7), wv = v_off(tid >> 3, (tid & 7) * 8, 2);
    const int vlane = ((lane & 3) << 3) | (((lane >> 2) & 3) << 6) | (((lane >> 4) & 1) << 5) | (((lane >> 5) & 1) << 8);
    u32x4 st0, st1;
#define W_LOAD(t) do { const size_t ko = (size_t)(t) * 64 * INW; st0 = *(const u32x4*)(gk + ko); st1 = *(const u32x4*)(gv + ko); } while (0)
#define W_WRITE(b) do { char* sb = lds + (b) * AT_STAGE; *(u32x4*)(sb + wk) = st0; *(u32x4*)(sb + 8192 + wv) = st1; } while (0)
    W_LOAD(0); W_WRITE(0); __syncthreads();
    for (int t = 0; t < NT; ++t) {
        const int b = t & 1;
        if (t + 1 < NT) W_LOAD(t + 1);
        { f32x16 s0, s1; bf16x8 p0, p1, p2, p3; const int vb_ = (int)(uintptr_t)(lds + b * AT_STAGE + 8192) + vlane;
          attn_scores<2>(lds, b * AT_STAGE, qf, s0, s1, o, ol, nm, false, r32, hi);
          exp_pack(s0, p0, p1); pv_half<2, 0>(o, ol, vb_, p0, p1); exp_pack(s1, p2, p3); pv_half<2, 1>(o, ol, vb_, p2, p3); }
        if (t + 1 < NT) W_WRITE(b ^ 1);
        __syncthreads();
    }
#undef W_LOAD
#undef W_WRITE
    const float il = 1.0f / ol[0];
    bf16_t* op = (bf16_t*)(p.ws + WS_ATT) + (size_t)tok * D + hq * 64;
#pragma unroll
    for (int t = 0; t < 2; ++t)
#pragma unroll
        for (int rp = 0; rp < 2; ++rp) {
            unsigned pk[2][2];
#pragma unroll
            for (int a = 0; a < 2; ++a) { const int rr = 2 * rp + a; pk[a][0] = cvt_pk(o[t][4 * rr] * il, o[t][4 * rr + 1] * il); pk[a][1] = cvt_pk(o[t][4 * rr + 2] * il, o[t][4 * rr + 3] * il); }
            const auto s0 = __builtin_amdgcn_permlane32_swap(pk[0][0], pk[1][0], false, false), s1 = __builtin_amdgcn_permlane32_swap(pk[0][1], pk[1][1], false, false);
            *(u32x4*)(op + 32 * t + 8 * (2 * rp + hi)) = (u32x4){s0[0], s1[0], s0[1], s1[1]};
        }
}
__device__ __forceinline__ void phase_attn(const Params& p, char* lds, int vb, int G) {
    const int lane = threadIdx.x & 63;
    const float d1 = wave_sum(p.lq1[lane] * p.lk1[lane]), d2 = wave_sum(p.lq2[lane] * p.lk2[lane]);
    if (threadIdx.x == 0) *(float*)(lds + LDS_MISC) = expf(d1) - expf(d2) + 0.2f;
    __syncthreads();
    const float lam = 0.f;
    for (int u = vb; u < 1024; u += G) {
        if (u < 512) attn_diff_unit(p, lds, (u & 255) >> 6, (u < 256) ? 127 - (u & 63) : (u & 63), lam);
        else attn_swa_unit(p, lds, (u - 512) >> 8, (u - 512) & 255);
    }
}

struct EpiPreLn {
    const bf16_t* xb; bf16_t* out; int row0, col0;
    __device__ __forceinline__ void pre(char*) const {}
    __device__ __forceinline__ void operator()(f32x4 (&acc)[8][4], int wr, int wc, int fr, int fq) const {
        u32x4 xa[2], xb_[2];
        const size_t rbase = (size_t)(row0 + wr * 128 + fr) * D + col0 + wc * 64 + 8 * fq;
#pragma unroll
        for (int a = 0; a < 2; ++a) xa[a] = *(const u32x4*)(xb + rbase + a * 32);
#pragma unroll
        for (int mt = 0; mt < 8; ++mt) {
            const size_t ro = rbase + (size_t)mt * 16 * D;
            if (mt + 1 < 8) {
#pragma unroll
                for (int a = 0; a < 2; ++a) { const u32x4 t = *(const u32x4*)(xb + ro + (size_t)16 * D + a * 32); if (mt & 1) xa[a] = t; else xb_[a] = t; }
            }
#pragma unroll
            for (int a = 0; a < 2; ++a) {
                const u32x4 q = (mt & 1) ? xb_[a] : xa[a];
                const f32x4 x0 = {bf_lo(q[0]), bf_hi(q[0]), bf_lo(q[1]), bf_hi(q[1])}, x1 = {bf_lo(q[2]), bf_hi(q[2]), bf_lo(q[3]), bf_hi(q[3])};
                const f32x4 v0 = x0 * ALPHA + acc[mt][2 * a], v1 = x1 * ALPHA + acc[mt][2 * a + 1];
                *(u32x4*)(out + ro + a * 32) = (u32x4){cvt_pk(v0[0], v0[1]), cvt_pk(v0[2], v0[3]), cvt_pk(v1[0], v1[1]), cvt_pk(v1[2], v1[3])};
            }
        }
    }
};
__device__ __forceinline__ void phase_wout(const Params& p, char* lds, int vb, int G) {
    for (int u = vb; u < (S / 256) * 4; u += G) {
        const int tm = u >> 2, tn = u & 3;
        G2Args g; g.A = (const char*)(p.ws + WS_ATT); g.B = (const char*)(p.ws + WS_WOUT); g.nk = D / 64; g.akstep = 128;
        g2_rows_A<8>(g, (size_t)tm * 256, D * 2);
        { const int lane = threadIdx.x & 63, w = __builtin_amdgcn_readfirstlane(threadIdx.x >> 6); const unsigned co = g2_chunk_off(lane, w);
#pragma unroll
          for (int i = 0; i < 4; ++i) { const int n = i * 64 + w * 8 + (lane >> 3), nt = (n >> 4) & 3, nl = n & 15;
              const int col = tn * 256 + (n >> 6) * 64 + (nt >> 1) * 32 + 8 * (nl >> 2) + 4 * (nt & 1) + (nl & 3);
              g.offB[i] = (unsigned)col * (unsigned)(D * 2) + co; } }
        EpiPreLn e{(const bf16_t*)(p.ws + WS_XB), (bf16_t*)(p.ws + WS_PRELN), tm * 256, tn * 256};
        gemm2<8>(lds, g, e);
    }
}

struct EpiLogits {
    float* L;
    __device__ __forceinline__ void pre(char*) const {}
    __device__ __forceinline__ void operator()(f32x4 (&acc)[4][4], int wr, int wc, int fr, int fq) const {
#pragma unroll
        for (int mt = 0; mt < 4; ++mt)
#pragma unroll
            for (int nt = 0; nt < 4; ++nt) *(f32x4*)(L + (wr * 64 + mt * 16 + fr) * 256 + wc * 64 + nt * 16 + 4 * fq) = acc[mt][nt];
    }
};
__device__ __forceinline__ void phase_router(const Params& p, char* lds, int vb, int G) {
    const bf16_t* preln = (const bf16_t*)(p.ws + WS_PRELN);
    bf16_t* x1b = (bf16_t*)(p.ws + WS_X1B);
    unsigned* cnt = (unsigned*)(p.ws + WS_CTL + 65536); int* list = (int*)(p.ws + WS_LIST); float* gates = (float*)(p.ws + WS_GATE);
    for (int u = vb; u < S / 64; u += G) {
        int tid = threadIdx.x; asm volatile("" : "+v"(tid));
        const int lane = tid & 63, w = tid >> 6;
        {
            f32x4 v[8][4]; float sm[8], sq[8];
#pragma unroll
            for (int i = 0; i < 8; ++i) { const u32x4* xr = (const u32x4*)(preln + (size_t)(u * 64 + w * 8 + i) * D) + lane;
#pragma unroll
                for (int j = 0; j < 2; ++j) { const u32x4 q = xr[64 * j];
                    v[i][2 * j] = (f32x4){bf_lo(q[0]), bf_hi(q[0]), bf_lo(q[1]), bf_hi(q[1])}; v[i][2 * j + 1] = (f32x4){bf_lo(q[2]), bf_hi(q[2]), bf_lo(q[3]), bf_hi(q[3])}; } }
#pragma unroll
            for (int i = 0; i < 8; ++i) { float s = 0.f;
#pragma unroll
                for (int j = 0; j < 4; ++j) s += (v[i][j][0] + v[i][j][1]) + (v[i][j][2] + v[i][j][3]);
                sm[i] = s; }
#pragma unroll
            for (int o = 1; o < 64; o <<= 1) {
#pragma unroll
                for (int i = 0; i < 8; ++i) sm[i] += __shfl_xor(sm[i], o); }
#pragma unroll
            for (int i = 0; i < 8; ++i) { const float mean = sm[i] * (1.0f / D); float s2 = 0.f;
#pragma unroll
                for (int j = 0; j < 4; ++j) { v[i][j] = v[i][j] - mean; s2 += (v[i][j][0] * v[i][j][0] + v[i][j][1] * v[i][j][1]) + (v[i][j][2] * v[i][j][2] + v[i][j][3] * v[i][j][3]); }
                sq[i] = s2; }
#pragma unroll
            for (int o = 1; o < 64; o <<= 1) {
#pragma unroll
                for (int i = 0; i < 8; ++i) sq[i] += __shfl_xor(sq[i], o); }
#pragma unroll
            for (int j = 0; j < 2; ++j) {
                const f32x4 g0 = *((const f32x4*)p.ln1g + 2 * lane + 128 * j), g1 = *((const f32x4*)p.ln1g + 2 * lane + 128 * j + 1);
                const f32x4 b0 = *((const f32x4*)p.ln1b + 2 * lane + 128 * j), b1 = *((const f32x4*)p.ln1b + 2 * lane + 128 * j + 1);
#pragma unroll
                for (int i = 0; i < 8; ++i) {
                    const int row = u * 64 + w * 8 + i;
                    const float rstd = rsqrtf(sq[i] * (1.0f / D) + LN_EPS);
                    const f32x4 y0 = v[i][2 * j] * rstd * g0 + b0, y1 = v[i][2 * j + 1] * rstd * g1 + b1;
                    u32x4 pk = {cvt_pk(y0[0], y0[1]), cvt_pk(y0[2], y0[3]), cvt_pk(y1[0], y1[1]), cvt_pk(y1[2], y1[3])};
                    *(u32x4*)(x1b + ((size_t)((lane >> 3) + 8 * j) * S + row) * 64 + ((8 * lane) & 63)) = pk;
                }
            }
        }
        asm volatile("s_waitcnt vmcnt(0)" ::: "memory");
        __syncthreads();
        { G2Args g; g.A = (const char*)x1b; g.B = (const char*)(p.ws + WS_WR); g.nk = D / 64; g.akstep = S * 128;
          g2_rows_A<4>(g, (size_t)u * 64, 128); g.offA[1] = g.offA[0]; g2_rows_B(g, 0, D * 2);
          EpiLogits e{(float*)lds};
          gemm2<4>(lds, g, e); }
        __syncthreads();
        const f32x4 rb = *((const f32x4*)p.r_bias + lane);
        const float NEG = -__builtin_inff();
        for (int i0 = 0; i0 < 8; i0 += 4) {
            float sc[4][4], cand[4][4]; int my_e[4]; float my_s[4], gsum[4];
#pragma unroll
            for (int q = 0; q < 4; ++q) {
                const int tl = w * 8 + i0 + q;
                const f32x4 lg = *((const f32x4*)((const float*)lds + tl * 256) + lane);
#pragma unroll
                for (int j = 0; j < 4; ++j) { sc[q][j] = 1.0f / (1.0f + __expf(-lg[j])); cand[q][j] = sc[q][j] + rb[j]; }
                my_e[q] = 0; my_s[q] = 0.f; gsum[q] = 0.f;
            }
            float a1[4], a2[4];
#pragma unroll
            for (int q = 0; q < 4; ++q) { const float m01 = fmaxf(cand[q][0], cand[q][1]), n01 = fminf(cand[q][0], cand[q][1]), m23 = fmaxf(cand[q][2], cand[q][3]), n23 = fminf(cand[q][2], cand[q][3]);
              a1[q] = fmaxf(m01, m23); a2[q] = fmaxf(fminf(m01, m23), fmaxf(n01, n23)); }
#pragma unroll
            for (int off = 1; off < 8; off <<= 1) {
#pragma unroll
                for (int q = 0; q < 4; ++q) { const float b1 = __shfl_xor(a1[q], off), b2 = __shfl_xor(a2[q], off); const float n1 = fmaxf(a1[q], b1), n2 = fmaxf(fminf(a1[q], b1), fmaxf(a2[q], b2)); a1[q] = n1; a2[q] = n2; }
            }
            const int mygrp = lane >> 3;
#pragma unroll
            for (int q = 0; q < 4; ++q) {
                const float gs = a1[q] + a2[q]; int rank = 0;
#pragma unroll
                for (int g2 = 0; g2 < 8; ++g2) { const float v = __shfl(gs, g2 * 8); rank += (v > gs || (v == gs && g2 < mygrp)) ? 1 : 0; }
                if (rank >= 4) {
#pragma unroll
                    for (int j = 0; j < 4; ++j) cand[q][j] = NEG;
                }
            }
#pragma unroll
            for (int k = 0; k < 8; ++k) {
                float bv[4]; int idx[4];
#pragma unroll
                for (int q = 0; q < 4; ++q) { bv[q] = cand[q][0]; int bi = 0;
#pragma unroll
                    for (int j = 1; j < 4; ++j) if (cand[q][j] > bv[q]) { bv[q] = cand[q][j]; bi = j; }
                    idx[q] = 4 * lane + bi; }
#pragma unroll
                for (int off = 32; off >= 1; off >>= 1) {
#pragma unroll
                    for (int q = 0; q < 4; ++q) { const float ov = __shfl_xor(bv[q], off); const int oi = __shfl_xor(idx[q], off); if (ov > bv[q] || (ov == bv[q] && oi < idx[q])) { bv[q] = ov; idx[q] = oi; } }
                }
#pragma unroll
                for (int q = 0; q < 4; ++q) {
                    const int owner = idx[q] >> 2, sub = idx[q] & 3;
                    float scv = sc[q][0];
#pragma unroll
                    for (int j = 1; j < 4; ++j) scv = (sub == j) ? sc[q][j] : scv;
                    if (lane == owner) {
#pragma unroll
                        for (int j = 0; j < 4; ++j) if (sub == j) cand[q][j] = NEG;
                    }
                    const float gsc = __shfl(scv, owner);
                    if (lane == k) { my_e[q] = idx[q]; my_s[q] = gsc; }
                    gsum[q] += gsc;
                }
            }
            if (lane < 8) {
#pragma unroll
                for (int q = 0; q < 4; ++q) {
                    const int t = u * 64 + w * 8 + i0 + q;
                    const float gate = my_s[q] / gsum[q] * 2.5f;
                    const unsigned pos = atomicAdd(cnt + my_e[q] * CNT_STRIDE, 1u);
                    list[(size_t)my_e[q] * CAP + pos] = t * 8 + lane;
                    gates[t * 8 + lane] = gate;
                }
            }
        }
        __syncthreads();
    }
}

#ifndef MOE_MT
#define MOE_MT 8
#endif
constexpr int MOE_BM = 32 * MOE_MT;
struct EpiAct {
    bf16_t* act; const int* slots;
    __device__ __forceinline__ void operator()(f32x4 (&acc)[MOE_MT][4], int pass, int wr, int wc, int fr, int fq) const {
        const int ncol0 = pass * 128;
#pragma unroll
        for (int mt = 0; mt < MOE_MT; ++mt) {
            const int ar = slots[wr * 16 * MOE_MT + mt * 16 + fr];
            if (ar >= 0) {
                float a[8];
#pragma unroll
                for (int nt = 0; nt < 2; ++nt)
#pragma unroll
                    for (int j = 0; j < 4; ++j) { const float gq = acc[mt][nt][j]; a[nt * 4 + j] = gq * __builtin_amdgcn_rcpf(1.0f + __expf(-gq)) * (acc[mt][nt + 2][j]); }
                u32x4 pk = {cvt_pk(a[0], a[1]), cvt_pk(a[2], a[3]), cvt_pk(a[4], a[5]), cvt_pk(a[6], a[7])};
                *(u32x4*)(act + (size_t)ar * FF + ncol0 + wc * 32 + 8 * fq) = pk;
            }
        }
    }
};
struct EpiY {
    bf16_t* y; const int* yrows; const float* gl;
    __device__ __forceinline__ void operator()(f32x4 (&acc)[MOE_MT][4], int pass, int wr, int wc, int fr, int fq) const {
        const int col0 = pass * 256;
#pragma unroll
        for (int mt = 0; mt < MOE_MT; ++mt) {
            const int r = wr * 16 * MOE_MT + mt * 16 + fr, yr = yrows[r];
            if (yr >= 0) {
                const float gt = gl[r];
#pragma unroll
                for (int a = 0; a < 2; ++a) {
                    const f32x4 v0 = acc[mt][2 * a] * gt, v1 = acc[mt][2 * a + 1] * gt;
                    u32x4 pk = {cvt_pk(v0[0], v0[1]), cvt_pk(v0[2], v0[3]), cvt_pk(v1[0], v1[1]), cvt_pk(v1[2], v1[3])};
                    *(u32x4*)(y + (size_t)yr * D + col0 + wc * 64 + a * 32 + 8 * fq) = pk;
                }
            }
        }
    }
};
__device__ __forceinline__ void phase_experts(const Params& p, char* lds, int vb, int G) {
    const int tid0 = threadIdx.x, w = __builtin_amdgcn_readfirstlane(tid0 >> 6);
    const unsigned* cnt = (const unsigned*)(p.ws + WS_CTL + 65536); const int* list = (const int*)(p.ws + WS_LIST); const float* gates = (const float*)(p.ws + WS_GATE);
    bf16_t* act = (bf16_t*)(p.ws + WS_ACT); bf16_t* ybuf = (bf16_t*)(p.ws + WS_Y);
    int* nts = (int*)(lds + LDS_MISC); int* pre = nts + 256;
    int* s_arow = pre + 260; int* s_yrow = s_arow + MOE_BM; int* s_tok = s_yrow + MOE_BM; float* s_gate = (float*)(s_tok + MOE_BM);
    if (tid0 < 256) nts[tid0] = (int)((__hip_atomic_load(cnt + tid0 * CNT_STRIDE, __ATOMIC_RELAXED, __HIP_MEMORY_SCOPE_AGENT) + (MOE_BM - 1)) / MOE_BM);
    __syncthreads();
    if (tid0 < 257) { int s = 0; for (int e = 0; e < tid0; ++e) s += nts[e]; pre[tid0] = s; }
    __syncthreads();
    const int NR = __builtin_amdgcn_readfirstlane(pre[256]), NU = NR + S / MOE_BM;
    for (int u = vb; u < NU; u += G) {
        __syncthreads();
        int tid = threadIdx.x; asm volatile("" : "+v"(tid));
        const int lane = tid & 63; const unsigned co = g2_chunk_off(lane, w);
        const float *bg, *bu, *bd;
        if (u < NR) {
            int lo = 0, hi = 255;
            while (lo < hi) { const int mid = (lo + hi + 1) >> 1; if (pre[mid] <= u) lo = mid; else hi = mid - 1; }
            const int e = lo, tile = u - pre[e], n = (int)__hip_atomic_load(cnt + e * CNT_STRIDE, __ATOMIC_RELAXED, __HIP_MEMORY_SCOPE_AGENT);
            if (tid < MOE_BM) {
                const int idx = tile * MOE_BM + tid;
                if (idx < n) { const int slot = list[(size_t)e * CAP + idx]; s_arow[tid] = slot; s_yrow[tid] = slot + (slot >> 3); s_tok[tid] = slot >> 3; s_gate[tid] = gates[slot]; }
                else { s_arow[tid] = -1; s_yrow[tid] = -1; s_tok[tid] = 0; s_gate[tid] = 0.f; }
            }
            bg = p.w_g + (size_t)e * D * FF; bu = p.w_u + (size_t)e * D * FF; bd = p.w_d + (size_t)e * FF * D;
        } else {
            const int tile = u - NR;
            if (tid < MOE_BM) { const int tk = tile * MOE_BM + tid; s_arow[tid] = S * 8 + tk; s_yrow[tid] = tk * 9 + 8; s_tok[tid] = tk; s_gate[tid] = 1.0f; }
            bg = p.ws_g; bu = p.ws_u; bd = p.ws_d;
        }
        __syncthreads();
        { G3fArgs g; g.A = (const char*)(p.ws + WS_X1B); g.nk = D / 64; g.akstep = S * 128;
#pragma unroll
          for (int i = 0; i < MOE_MT / 2; ++i) g.offA[i] = (unsigned)s_tok[i * 64 + w * 8 + (lane >> 3)] * 128u + co;
          { const int bwc = lane >> 4, nt = (lane >> 2) & 3, bfq = lane & 3;
            g.b = ((nt < 2) ? bg : bu) + bwc * 32 + 8 * bfq + 4 * (nt & 1) + (size_t)(w * 8) * FF; }
          EpiAct e{act, s_arow};
          gemm3f<MOE_MT, FF>(lds, g, 2, 128, e); }
        asm volatile("s_waitcnt vmcnt(0)" ::: "memory");
        __syncthreads();
        { G3fArgs g; g.A = (const char*)act; g.nk = FF / 64; g.akstep = 128;
          int tid2 = threadIdx.x; asm volatile("" : "+v"(tid2));
          const int lane = tid2 & 63; const unsigned co = g2_chunk_off(lane, w);
#pragma unroll
          for (int i = 0; i < MOE_MT / 2; ++i) { const int ar = s_arow[i * 64 + w * 8 + (lane >> 3)]; g.offA[i] = (unsigned)(ar < 0 ? 0 : ar) * (unsigned)(FF * 2) + co; }
          g.b = bd + (size_t)(w * 8) * D + (lane >> 4) * 64 + (((lane >> 2) & 3) >> 1) * 32 + 8 * (lane & 3) + 4 * ((lane >> 2) & 1);
          EpiY e{ybuf, s_yrow, s_gate};
          gemm3f<MOE_MT, D>(lds, g, 4, 256, e); }
    }
}

__device__ __forceinline__ void phase_final(const Params& p, int vb, int G) {
    const int lane = threadIdx.x & 63, w = threadIdx.x >> 6;
    const bf16_t* x1b = (const bf16_t*)(p.ws + WS_X1B); const bf16_t* ybuf = (const bf16_t*)(p.ws + WS_Y);
    const int stride = G * 8;
#define F_LOAD(q, row) do { \
        _Pragma("unroll") for (int j = 0; j < 2; ++j) q[j] = *(const u32x4*)(x1b + ((size_t)((lane >> 3) + 8 * j) * S + (row)) * 64 + ((8 * lane) & 63)); \
        _Pragma("unroll") for (int k = 0; k < 9; ++k) { const u32x4* yr = (const u32x4*)(ybuf + (size_t)((row) * 9 + k) * D) + lane; q[2 + 2 * k] = yr[0]; q[3 + 2 * k] = yr[64]; } } while (0)
#define F_PROC(q, row) do { float v[2][8]; \
        _Pragma("unroll") for (int j = 0; j < 2; ++j) _Pragma("unroll") for (int e = 0; e < 4; ++e) { v[j][2 * e] = bf_lo(q[j][e]) * ALPHA; v[j][2 * e + 1] = bf_hi(q[j][e]) * ALPHA; } \
        _Pragma("unroll") for (int k = 0; k < 9; ++k) _Pragma("unroll") for (int j = 0; j < 2; ++j) _Pragma("unroll") for (int e = 0; e < 4; ++e) { v[j][2 * e] += bf_lo(q[2 + 2 * k + j][e]); v[j][2 * e + 1] += bf_hi(q[2 + 2 * k + j][e]); } \
        float sm = 0.f; \
        _Pragma("unroll") for (int j = 0; j < 2; ++j) _Pragma("unroll") for (int e = 0; e < 8; ++e) sm += v[j][e]; \
        sm = wave_sum(sm); \
        const float mean = sm * (1.0f / D); float sq = 0.f; \
        _Pragma("unroll") for (int j = 0; j < 2; ++j) _Pragma("unroll") for (int e = 0; e < 8; ++e) { v[j][e] -= mean; sq += v[j][e] * v[j][e]; } \
        sq = wave_sum(sq); \
        const float rstd = rsqrtf(sq * (1.0f / D) + LN_EPS); \
        _Pragma("unroll") for (int j = 0; j < 2; ++j) { \
            const f32x4 g0 = *((const f32x4*)p.ln2g + 2 * lane + 128 * j), g1 = *((const f32x4*)p.ln2g + 2 * lane + 128 * j + 1); \
            const f32x4 b0 = *((const f32x4*)p.ln2b + 2 * lane + 128 * j), b1 = *((const f32x4*)p.ln2b + 2 * lane + 128 * j + 1); \
            f32x4* op = (f32x4*)(p.out + (size_t)(row) * D) + 2 * lane + 128 * j; \
            op[0] = (f32x4){v[j][0], v[j][1], v[j][2], v[j][3]} * rstd * g0 + b0; \
            op[1] = (f32x4){v[j][4], v[j][5], v[j][6], v[j][7]} * rstd * g1 + b1; } } while (0)
    u32x4 qa[20], qb[20];
    int row = vb * 8 + w;
    if (row < S) F_LOAD(qa, row);
    for (; row < S; row += 2 * stride) {
        const bool n1 = row + stride < S, n2 = row + 2 * stride < S;
        if (n1) F_LOAD(qb, row + stride);
        __builtin_amdgcn_sched_barrier(0);
        F_PROC(qa, row);
        if (n1) {
            if (n2) F_LOAD(qa, row + 2 * stride);
            __builtin_amdgcn_sched_barrier(0);
            F_PROC(qb, row + stride);
        }
    }
#undef F_LOAD
#undef F_PROC
}

__global__ void __launch_bounds__(NTHREADS) mega(Params p) {
    extern __shared__ __attribute__((aligned(16))) char lds[];
    const int G = gridDim.x, bx = blockIdx.x;
    const int vb = (G % 8 == 0) ? (bx % 8) * (G / 8) + bx / 8 : bx;
    if (threadIdx.x < 4) ((volatile LAS unsigned*)((LAS char*)lds + LDS_BARST))[threadIdx.x] = 0u;
    __syncthreads();
    XcdBarrier bar; bar.bar = (unsigned*)(p.ws + WS_CTL) + CW_BAR; bar.x = 0; bar.st = nullptr;
    if (p.ph_hi - p.ph_lo > 1) bar = xcd_barrier_post((unsigned*)(p.ws + WS_CTL) + CW_BAR, (volatile LAS unsigned*)((LAS char*)lds + LDS_BARST));
#define SEAM(k) do { if (p.ph_lo <= (k) && (k) + 1 < p.ph_hi) { xcd_barrier(bar); } } while (0)
#define IN(k) (p.ph_lo <= (k) && (k) < p.ph_hi)
#define RUN(k, call) do { if (IN(k)) { call; if (MK_REPEAT == (k)) { __syncthreads(); call; } } } while (0)
    RUN(0, phase_prep(p, vb, G)); SEAM(0);
    RUN(1, phase_proj(p, lds, vb, G)); SEAM(1);
    RUN(2, phase_attn(p, lds, vb, G)); SEAM(2);
    RUN(3, phase_wout(p, lds, vb, G)); SEAM(3);
    if (IN(4)) { phase_router(p, lds, vb, G); } SEAM(4);
    RUN(5, phase_experts(p, lds, vb, G)); SEAM(5);
    RUN(6, phase_final(p, vb, G));
#undef SEAM
#undef IN
#undef RUN
}

extern "C" void kernel_launch(void* const* d_in, const int* in_sizes, int n_in, void* d_out, int out_size, void* d_ws, size_t ws_size, hipStream_t stream) {
    static int grid = 0;
    if (grid == 0) {
        if (n_in != 22 || in_sizes[0] != S * D || out_size != S * D || ws_size < WS_END) {
            fprintf(stderr, "kernel_launch: unexpected shapes: n_in %d in0 %d out %d ws %zu (need %zu)\n", n_in, n_in > 0 ? in_sizes[0] : -1, out_size, ws_size, (size_t)WS_END); grid = -1; return; }
        int dev = 0, cus = 0, per_cu = 0;
        (void)hipGetDevice(&dev); (void)hipDeviceGetAttribute(&cus, hipDeviceAttributeMultiprocessorCount, dev);
        if (hipFuncSetAttribute((const void*)mega, hipFuncAttributeMaxDynamicSharedMemorySize, LDS_BYTES) != hipSuccess) { fprintf(stderr, "kernel_launch: hipFuncSetAttribute failed\n"); grid = -1; return; }
        (void)hipOccupancyMaxActiveBlocksPerMultiprocessor(&per_cu, (const void*)mega, NTHREADS, LDS_BYTES);
        if (per_cu < 1) { fprintf(stderr, "kernel_launch: occupancy query says %d blocks per CU\n", per_cu); per_cu = 1; }
        grid = cus * 1;
        (void)hipGetLastError();
    }
    if (grid < 0) return;
    (void)hipMemsetAsync((char*)d_ws + WS_CTL, 0, CTL_BYTES, stream);
    Params p{};
    const float** f = (const float**)&p;
    for (int i = 0; i < 22; ++i) f[i] = (const float*)d_in[i];
    p.out = (float*)d_out; p.ws = (unsigned char*)d_ws;
#if MK_ONE_LAUNCH
    p.ph_lo = 0; p.ph_hi = 7;
    void* args[] = {&p};
    hipError_t e = hipLaunchCooperativeKernel((const void*)mega, dim3(grid), dim3(NTHREADS), args, LDS_BYTES, stream);
    if (e != hipSuccess) fprintf(stderr, "kernel_launch: cooperative launch failed: %s (grid %d)\n", hipGetErrorString(e), grid);
#else
    for (int ph = 0; ph < 7; ++ph) {
        p.ph_lo = ph; p.ph_hi = ph + 1;
        hipLaunchKernelGGL(mega, dim3(grid), dim3(NTHREADS), LDS_BYTES, stream, p);
    }
#endif
}
```

```cpp
#include <hip/hip_runtime.h>
#include <hip/hip_cooperative_groups.h>
#include <cstdio>
#include <cstdint>
namespace cg = cooperative_groups;

#ifndef MK_REPEAT
#define MK_REPEAT -1
#endif
#ifndef MK_ONE_LAUNCH
#define MK_ONE_LAUNCH 1
#endif

constexpr int S = 16384, D = 1024, INW = 2304, NE = 256, FF = 256;
constexpr int NTHREADS = 512;
constexpr int CAP = 16384;
constexpr float ALPHA = 1.189207115002721f;
constexpr float LN_EPS = 1e-5f;
constexpr float QSCALE = 0.125f * 1.4426950408889634f;
constexpr float LOG2E = 1.4426950408889634f;
constexpr int C_AQ = 0, C_AK = 512, C_AV = 640, C_BQ = 768, C_BK = 1280, C_BV = 1792;

constexpr size_t MiB = 1ull << 20;
constexpr size_t WS_CTL = 0;
constexpr size_t CTL_BYTES = 128 * 1024;
constexpr int CNT_STRIDE = 64;
constexpr size_t WS_ROPE = 1 * MiB;
constexpr size_t WS_WIN = 8 * MiB;
constexpr size_t WS_WOUT = 13 * MiB;
constexpr size_t WS_WR = 15 * MiB;
constexpr size_t WS_WSGU = 16 * MiB;
constexpr size_t WS_WSD = 17 * MiB;
constexpr size_t WS_EGU = 20 * MiB;
constexpr size_t WS_ED = 276 * MiB;
constexpr size_t WS_X1F = 404 * MiB;
constexpr size_t WS_X1B = 468 * MiB;
constexpr size_t WS_LIST = 500 * MiB;
constexpr size_t WS_GATE = 516 * MiB;
constexpr size_t WS_ACT = 518 * MiB;
constexpr size_t WS_Y = 590 * MiB;
constexpr size_t WS_XB = 590 * MiB;
constexpr size_t WS_PROJ = 622 * MiB;
constexpr size_t WS_ATT = 694 * MiB;
constexpr size_t WS_PRELN = 726 * MiB;
constexpr size_t WS_END = 878 * MiB;

constexpr int LDS_BYTES = 147456;
constexpr int LDS_MISC = 131072;

typedef unsigned short bf16_t;
typedef short bf16x8 __attribute__((ext_vector_type(8)));
typedef short s16x4 __attribute__((ext_vector_type(4)));
typedef float f32x4 __attribute__((ext_vector_type(4)));
typedef float f32x16 __attribute__((ext_vector_type(16)));
typedef unsigned u32x4 __attribute__((ext_vector_type(4)));
typedef unsigned u32x2 __attribute__((ext_vector_type(2)));
typedef float f32x2 __attribute__((ext_vector_type(2)));


#define LAS __attribute__((address_space(3)))
#define XB_TMO      128
#define XB_XCNT(j)  (256  + 64 * (j))
#define XB_XSUB(j)  (1280 + 64 * (j))
#define XB_XGEN(j)  (2304 + 64 * (j))
#define XB_TOP      3328
#define XB_TOPGEN   3392
#define XCD_BAR_WORDS 3456
#define XB_SPIN_CAP (1u << 18)
__device__ __forceinline__ unsigned xb_ld(unsigned* p)              { return __hip_atomic_load(p, __ATOMIC_RELAXED, __HIP_MEMORY_SCOPE_AGENT); }
__device__ __forceinline__ unsigned xb_add(unsigned* p, unsigned v) { return __hip_atomic_fetch_add(p, v, __ATOMIC_RELAXED, __HIP_MEMORY_SCOPE_AGENT); }
__device__ __forceinline__ unsigned xb_xcc_id() { return (unsigned)__builtin_amdgcn_s_getreg((3 << 11) | 20) & 0xFu; }
#define XB_SPIN(cond, bar) do { unsigned _sp = 0; while (cond) { __builtin_amdgcn_s_sleep(1); \
    if ((++_sp & 255u) == 0u) { if (xb_ld(&(bar)[XB_TMO])) break; if (_sp > XB_SPIN_CAP) { atomicAdd(&(bar)[XB_TMO], 1u); break; } } } } while (0)
struct XcdBarrier { unsigned* bar; unsigned x; volatile LAS unsigned* st; };
__device__ __forceinline__ XcdBarrier xcd_barrier_post(unsigned* bar, volatile LAS unsigned* st) {
    XcdBarrier b; b.bar = bar; b.x = xb_xcc_id(); b.st = st;
    if (threadIdx.x == 0) (void)xb_add(&bar[XB_XCNT(b.x)], 1u);
    return b;
}
__device__ __forceinline__ void xcd_barrier_complete(unsigned* bar, unsigned x, unsigned& nloc, unsigned& nx) {
    const unsigned G = gridDim.x * gridDim.y * gridDim.z;
    unsigned sum, cnt, mine, sp = 0u;
    for (;;) {
        sum = 0u; cnt = 0u; mine = 0u;
#pragma unroll
        for (unsigned j = 0; j < 16; ++j) { const unsigned c = xb_ld(&bar[XB_XCNT(j)]); sum += c; cnt += (c > 0u) ? 1u : 0u; mine = (j == x) ? c : mine; }
        if (sum == G) break;
        __builtin_amdgcn_s_sleep(1);
        if ((++sp & 255u) == 0u) { if (xb_ld(&bar[XB_TMO])) break; if (sp > XB_SPIN_CAP) { atomicAdd(&bar[XB_TMO], 1u); break; } }
    }
    nloc = mine > 0u ? mine : 1u; nx = cnt > 0u ? cnt : 1u;
}
__device__ __forceinline__ void xcd_barrier(const XcdBarrier& b) {
    asm volatile("s_waitcnt vmcnt(0)" ::: "memory");
    __syncthreads();
    if (threadIdx.x == 0) {
        unsigned* bar = b.bar;
        __builtin_amdgcn_s_waitcnt(0);
        unsigned nloc = b.st[0], nx = b.st[1];
        if (nloc == 0u) { xcd_barrier_complete(bar, b.x, nloc, nx); b.st[0] = nloc; b.st[1] = nx; }
        const unsigned old = xb_add(&bar[XB_XSUB(b.x)], 1u);
        const unsigned gen = old / nloc;
        if (old + 1u == (gen + 1u) * nloc) {
            __builtin_amdgcn_fence(__ATOMIC_RELEASE, "agent");
            asm volatile("s_waitcnt vmcnt(0)" ::: "memory");
            const unsigned og = xb_add(&bar[XB_TOP], 1u);
            const unsigned tg = og / nx;
            if (og + 1u == (tg + 1u) * nx) xb_add(&bar[XB_TOPGEN], 1u);
            else XB_SPIN(xb_ld(&bar[XB_TOPGEN]) == tg, bar);
            __builtin_amdgcn_fence(__ATOMIC_ACQUIRE, "agent");
            xb_add(&bar[XB_XGEN(b.x)], 1u);
            asm volatile("s_waitcnt vmcnt(0)" ::: "memory");
        } else {
            XB_SPIN(xb_ld(&bar[XB_XGEN(b.x)]) == gen, bar);
            __builtin_amdgcn_fence(__ATOMIC_ACQUIRE, "agent");
            asm volatile("s_waitcnt vmcnt(0)" ::: "memory");
        }
    }
    __syncthreads();
}
constexpr int CW_BAR = 4096;
constexpr int LDS_BARST = LDS_MISC + 8192;

struct Params {
    const float* x; const float* w_in; const float* b_in; const float* sinks;
    const float* lq1; const float* lk1; const float* lq2; const float* lk2; const float* subg;
    const float* w_out; const float* ln1g; const float* ln1b; const float* w_r; const float* r_bias;
    const float* w_g; const float* w_u; const float* w_d; const float* ws_g; const float* ws_u; const float* ws_d;
    const float* ln2g; const float* ln2b;
    float* out; unsigned char* ws;
    int ph_lo, ph_hi;
};

__device__ __forceinline__ unsigned cvt_pk(float lo, float hi) { unsigned r; asm volatile("v_cvt_pk_bf16_f32 %0, %1, %2" : "=v"(r) : "v"(lo), "v"(hi)); return r; }
typedef __bf16 bf16x2_t __attribute__((ext_vector_type(2)));
__device__ __forceinline__ unsigned cvt_pk_vis(float lo, float hi) { const bf16x2_t r = __builtin_convertvector((f32x2){lo, hi}, bf16x2_t); return *(const unsigned*)&r; }
__device__ __forceinline__ float bf_lo(unsigned u) { return __uint_as_float(u << 16); }
__device__ __forceinline__ float bf_hi(unsigned u) { return __uint_as_float(u & 0xffff0000u); }
__device__ __forceinline__ float wave_sum(float v) {
#pragma unroll
    for (int o = 1; o < 64; o <<= 1) v += __shfl_xor(v, o);
    return v;
}
__device__ __forceinline__ float half_max(float v) { auto rr = __builtin_amdgcn_permlane32_swap(__float_as_uint(v), __float_as_uint(v), false, false); return fmaxf(__uint_as_float(rr[0]), __uint_as_float(rr[1])); }
__device__ __forceinline__ float half_sum(float v) { auto rr = __builtin_amdgcn_permlane32_swap(__float_as_uint(v), __float_as_uint(v), false, false); return __uint_as_float(rr[0]) + __uint_as_float(rr[1]); }

__device__ __forceinline__ int swz(int r, int c) { const int f = (r & 7) ^ (((r >> 3) & 1) << 1) ^ ((r >> 4) & 1); return r * 128 + ((c ^ f) << 4); }

struct G2Args {
    const char* A; const char* B;
    unsigned offA[4], offB[4];
    int nk;
    unsigned akstep;
};
__device__ __forceinline__ unsigned g2_chunk_off(int lane, int w) { const int f = (lane >> 3) ^ ((w & 1) << 1) ^ ((w >> 1) & 1); return (unsigned)(((lane & 7) ^ f) << 4); }
template <int MT, int NT, class Epi>
__device__ __forceinline__ void gemm2n(char* lds_, const G2Args& g, const Epi& epi) {
    constexpr int A_BYTES = 32 * MT * 128, B_BYTES = 64 * NT * 128, STAGE = A_BYTES + B_BYTES, AR = MT / 2, BRR = NT;
    LAS char* lds = (LAS char*)lds_;
    const int tid = threadIdx.x, lane = tid & 63, w = __builtin_amdgcn_readfirstlane(tid >> 6), wr = w >> 2, wc = w & 3, fr = lane & 15, fq = lane >> 4;
    f32x4 acc[MT][NT];
#pragma unroll
    for (int i = 0; i < MT; ++i)
#pragma unroll
        for (int j = 0; j < NT; ++j) acc[i][j] = (f32x4){0.f, 0.f, 0.f, 0.f};
    const int ldsw = w * 1024;
#define G2_STAGE(kt, s) do { \
        _Pragma("unroll") for (int i = 0; i < AR; ++i) __builtin_amdgcn_global_load_lds((const unsigned*)(g.A + g.offA[i] + (size_t)(kt) * g.akstep), (LAS unsigned*)(lds + (s) * STAGE + i * 8192 + ldsw), 16, 0, 0); \
        _Pragma("unroll") for (int i = 0; i < BRR; ++i) __builtin_amdgcn_global_load_lds((const unsigned*)(g.B + g.offB[i] + (size_t)(kt) * 128), (LAS unsigned*)(lds + (s) * STAGE + A_BYTES + i * 8192 + ldsw), 16, 0, 0); } while (0)
    G2_STAGE(0, 0);
    __syncthreads();
    for (int kt = 0; kt < g.nk; ++kt) {
        const int s = kt & 1;
        if (kt + 1 < g.nk) { if (s) G2_STAGE(kt + 1, 0); else G2_STAGE(kt + 1, 1); }
        else epi.pre(lds_ + (s ^ 1) * STAGE);
        const char* la = lds_ + s * STAGE; const char* lb = la + A_BYTES;
        {
            constexpr int NG = 2 * (MT / 4);
            bf16x8 bfr[NT], af[2][4];
#pragma unroll
            for (int nt = 0; nt < NT; ++nt) bfr[nt] = *(const bf16x8*)(lb + swz(wc * 16 * NT + nt * 16 + fr, fq));
#pragma unroll
            for (int m = 0; m < 4; ++m) af[0][m] = *(const bf16x8*)(la + swz(wr * 16 * MT + m * 16 + fr, fq));
#pragma unroll
            for (int gi = 0; gi < NG; ++gi) {
                const int ks = gi / (MT / 4), h = gi % (MT / 4);
                if (gi > 0 && h == 0) {
#pragma unroll
                    for (int nt = 0; nt < NT; ++nt) bfr[nt] = *(const bf16x8*)(lb + swz(wc * 16 * NT + nt * 16 + fr, ks * 4 + fq));
                }
                if (gi + 1 < NG) {
                    const int ks2 = (gi + 1) / (MT / 4), h2 = (gi + 1) % (MT / 4);
#pragma unroll
                    for (int m = 0; m < 4; ++m) af[(gi + 1) & 1][m] = *(const bf16x8*)(la + swz(wr * 16 * MT + (h2 * 4 + m) * 16 + fr, ks2 * 4 + fq));
                }
                __builtin_amdgcn_sched_barrier(0);
#pragma unroll
                for (int m = 0; m < 4; ++m)
#pragma unroll
                    for (int nt = 0; nt < NT; ++nt) acc[h * 4 + m][nt] = __builtin_amdgcn_mfma_f32_16x16x32_bf16(bfr[nt], af[gi & 1][m], acc[h * 4 + m][nt], 0, 0, 0);
                __builtin_amdgcn_sched_barrier(0);
            }
        }
        __syncthreads();
    }
#undef G2_STAGE
    epi(acc, wr, wc, fr, fq);
}
template <int MT, class Epi>
__device__ __forceinline__ void gemm2(char* lds_, const G2Args& g, const Epi& epi) { gemm2n<MT, 4>(lds_, g, epi); }
template <int MT>
__device__ __forceinline__ void g2_rows_A(G2Args& g, size_t row0, unsigned ld_bytes) {
    const int lane = threadIdx.x & 63, w = __builtin_amdgcn_readfirstlane(threadIdx.x >> 6); const unsigned co = g2_chunk_off(lane, w);
#pragma unroll
    for (int i = 0; i < MT / 2; ++i) g.offA[i] = (unsigned)((row0 + i * 64 + w * 8 + (lane >> 3)) * ld_bytes) + co;
}
__device__ __forceinline__ void g2_rows_B(G2Args& g, size_t row0, unsigned ld_bytes) {
    const int lane = threadIdx.x & 63, w = __builtin_amdgcn_readfirstlane(threadIdx.x >> 6); const unsigned co = g2_chunk_off(lane, w);
#pragma unroll
    for (int i = 0; i < 4; ++i) g.offB[i] = (unsigned)((row0 + i * 64 + w * 8 + (lane >> 3)) * ld_bytes) + co;
}


struct G3fArgs { const char* A; unsigned offA[4]; const float* b; int nk; unsigned akstep; };
template <int MT, int LDB, class Epi>
__device__ __forceinline__ void gemm3f(char* lds_, const G3fArgs& g, int npass, int bpstep, const Epi& epi) {
    constexpr int A_BYTES = 32 * MT * 128, B_BYTES = 256 * 128, STAGE = A_BYTES + B_BYTES, AR = MT / 2;
    LAS char* lds = (LAS char*)lds_;
    int tid = threadIdx.x; asm volatile("" : "+v"(tid));
    const int lane = tid & 63, w = __builtin_amdgcn_readfirstlane(tid >> 6), wr = w >> 2, wc = w & 3, fr = lane & 15, fq = lane >> 4;
    f32x4 acc[MT][4];
#pragma unroll
    for (int i = 0; i < MT; ++i)
#pragma unroll
        for (int j = 0; j < 4; ++j) acc[i][j] = (f32x4){0.f, 0.f, 0.f, 0.f};
    const int ldsw = w * 1024;
    int bw[4];
#pragma unroll
    for (int j = 0; j < 4; ++j) bw[j] = swz(4 * lane + j, w);
    f32x4 br[8];
    const int nk = g.nk, nsteps = nk * npass;
#define G3_STAGE_A(kt, s) do { \
        _Pragma("unroll") for (int i = 0; i < AR; ++i) __builtin_amdgcn_global_load_lds((const unsigned*)(g.A + g.offA[i] + (size_t)(kt) * g.akstep), (LAS unsigned*)(lds + (s) * STAGE + i * 8192 + ldsw), 16, 0, 0); } while (0)
#define G3_LOAD_B(ps, kt) do { const float* pb_ = g.b + (size_t)(ps) * bpstep + (size_t)(kt) * 64 * LDB; _Pragma("unroll") for (int i = 0; i < 8; ++i) br[i] = *(const f32x4*)(pb_ + i * LDB); } while (0)
#define G3_WRITE_B(s) do { _Pragma("unroll") for (int j = 0; j < 4; ++j) { \
            u32x4 v = {cvt_pk(br[0][j], br[1][j]), cvt_pk(br[2][j], br[3][j]), cvt_pk(br[4][j], br[5][j]), cvt_pk(br[6][j], br[7][j])}; \
            *(u32x4*)(lds_ + (s) * STAGE + A_BYTES + bw[j]) = v; } } while (0)
#define G3_BARRIER(keep8) do { if (keep8) asm volatile("s_waitcnt vmcnt(8) lgkmcnt(0)\n\ts_barrier" ::: "memory"); else asm volatile("s_waitcnt vmcnt(0) lgkmcnt(0)\n\ts_barrier" ::: "memory"); } while (0)
    G3_STAGE_A(0, 0); G3_LOAD_B(0, 0); G3_WRITE_B(0);
    { const int kt1 = (nk > 1) ? 1 : 0, ps1 = (nk > 1) ? 0 : 1; if (nsteps > 1) G3_LOAD_B(ps1, kt1); }
    G3_BARRIER(nsteps > 1);
    int ps = 0, kt = 0;
    for (int st = 0; st < nsteps; ++st) {
        const int s = st & 1; const bool more = st + 1 < nsteps, more2 = st + 2 < nsteps;
        int ps2 = ps, kt2 = kt + 1; if (kt2 == nk) { kt2 = 0; ++ps2; }
        int ps3 = ps2, kt3 = kt2 + 1; if (kt3 == nk) { kt3 = 0; ++ps3; }
        if (more) { if (s) G3_STAGE_A(kt2, 0); else G3_STAGE_A(kt2, 1); }
        __builtin_amdgcn_sched_barrier(0);
        const char* la = lds_ + s * STAGE; const char* lb = la + A_BYTES;
        {
            constexpr int NG = MT;
            bf16x8 bfr[4], af[2][2];
#pragma unroll
            for (int nt = 0; nt < 4; ++nt) bfr[nt] = *(const bf16x8*)(lb + swz(wc * 64 + nt * 16 + fr, fq));
#pragma unroll
            for (int m = 0; m < 2; ++m) af[0][m] = *(const bf16x8*)(la + swz(wr * 16 * MT + m * 16 + fr, fq));
#pragma unroll
            for (int gi = 0; gi < NG; ++gi) {
                const int ks = gi / (MT / 2), h = gi % (MT / 2);
                if (gi > 0 && h == 0) {
#pragma unroll
                    for (int nt = 0; nt < 4; ++nt) bfr[nt] = *(const bf16x8*)(lb + swz(wc * 64 + nt * 16 + fr, ks * 4 + fq));
                }
                if (gi + 1 < NG) {
                    const int ks2 = (gi + 1) / (MT / 2), h2 = (gi + 1) % (MT / 2);
#pragma unroll
                    for (int m = 0; m < 2; ++m) af[(gi + 1) & 1][m] = *(const bf16x8*)(la + swz(wr * 16 * MT + (h2 * 2 + m) * 16 + fr, ks2 * 4 + fq));
                }
                __builtin_amdgcn_sched_barrier(0);
#pragma unroll
                for (int m = 0; m < 2; ++m)
#pragma unroll
                    for (int nt = 0; nt < 4; ++nt) acc[h * 2 + m][nt] = __builtin_amdgcn_mfma_f32_16x16x32_bf16(bfr[nt], af[gi & 1][m], acc[h * 2 + m][nt], 0, 0, 0);
                __builtin_amdgcn_sched_barrier(0);
            }
        }
        if (kt == nk - 1) {
            epi(acc, ps, wr, wc, fr, fq);
#pragma unroll
            for (int i = 0; i < MT; ++i)
#pragma unroll
                for (int j = 0; j < 4; ++j) acc[i][j] = (f32x4){0.f, 0.f, 0.f, 0.f};
        }
        if (more) { if (s) G3_WRITE_B(0); else G3_WRITE_B(1); }
        if (more2) G3_LOAD_B(ps3, kt3);
        G3_BARRIER(more2);
        ps = ps2; kt = kt2;
    }
#undef G3_BARRIER
#undef G3_STAGE_A
#undef G3_LOAD_B
#undef G3_WRITE_B
}

__device__ __forceinline__ void cvt_item(const float* W, int K, int N, bf16_t* WT, int ldt, int kb, int nb, int kc, int lane) {
    const float* src = W + (size_t)(kb * 64 + kc * 8) * N + nb * 256 + 4 * lane;
    bf16_t* dst = WT + (size_t)(nb * 256 + 4 * lane) * ldt + kb * 64 + kc * 8;
    f32x4 r[8];
#pragma unroll
    for (int i = 0; i < 8; ++i) r[i] = *(const f32x4*)(src + (size_t)i * N);
#pragma unroll
    for (int j = 0; j < 4; ++j) {
        u32x4 v = {cvt_pk(r[0][j], r[1][j]), cvt_pk(r[2][j], r[3][j]), cvt_pk(r[4][j], r[5][j]), cvt_pk(r[6][j], r[7][j])};
        *(u32x4*)(dst + (size_t)j * ldt) = v;
    }
}
__device__ __forceinline__ void phase_prep(const Params& p, int vb, int G) {
    const int tid = threadIdx.x, lane = tid & 63, w = tid >> 6;
    float* cs = (float*)(p.ws + WS_ROPE); float* sn = cs + (size_t)S * 32;
    for (int idx = vb * NTHREADS + tid; idx < S * 32; idx += G * NTHREADS) {
        const int pos = idx >> 5, i = idx & 31;
        const float pw = (float)pow(10000.0, (double)i / 32.0);
        const float inv = 1.0f / pw;
        const float angf = __fmul_rn((float)pos, inv);
        const double a = (double)angf;
        const double q = rint(a * 0.63661977236758134308);
        double r = fma(-q, 1.57079632679489655800, a); r = fma(-q, 6.12323399573676603587e-17, r);
        const double r2 = r * r;
        double sp = r * (1.0 + r2 * (-1.0 / 6 + r2 * (1.0 / 120 + r2 * (-1.0 / 5040 + r2 * (1.0 / 362880 + r2 * (-1.0 / 39916800))))));
        double cp = 1.0 + r2 * (-0.5 + r2 * (1.0 / 24 + r2 * (-1.0 / 720 + r2 * (1.0 / 40320 + r2 * (-1.0 / 3628800 + r2 * (1.0 / 479001600))))));
        const int qi = ((int)((long long)q)) & 3;
        double sv, cv;
        if (qi == 0) { sv = sp; cv = cp; } else if (qi == 1) { sv = cp; cv = -sp; } else if (qi == 2) { sv = -sp; cv = -cp; } else { sv = -cp; cv = sp; }
        cs[idx] = (float)cv; sn[idx] = (float)sv;
    }
    { const f32x4* xs = (const f32x4*)p.x; u32x4* xd = (u32x4*)(p.ws + WS_XB);
      for (size_t i = (size_t)vb * NTHREADS + tid; i < (size_t)S * D / 8; i += (size_t)G * NTHREADS) {
          const f32x4 a = xs[2 * i], b = xs[2 * i + 1];
          xd[i] = (u32x4){cvt_pk(a[0], a[1]), cvt_pk(a[2], a[3]), cvt_pk(b[0], b[1]), cvt_pk(b[2], b[3])}; } }
    const int gw = vb * 8 + w, NGW = G * 8;
    constexpr int I_IN = 16 * 9, I_OUT = 16 * 4, I_R = 16, I_SG = 16, I_SU = 16, I_SD = 4 * 4, I_SMALL = I_IN + I_OUT + I_R;
    for (int it8 = gw; it8 < I_SMALL * 8; it8 += NGW) {
        int r = it8 >> 3; const int kc = it8 & 7;
        if (r < I_IN) { cvt_item(p.w_in, D, INW, (bf16_t*)(p.ws + WS_WIN), D, r / 9, r % 9, kc, lane); continue; } r -= I_IN;
        if (r < I_OUT) { cvt_item(p.w_out, D, D, (bf16_t*)(p.ws + WS_WOUT), D, r >> 2, r & 3, kc, lane); continue; } r -= I_OUT;
        cvt_item(p.w_r, D, NE, (bf16_t*)(p.ws + WS_WR), D, r, 0, kc, lane);
    }
}

template <int MT> struct EpiProj {
    const float* bias; const float* cs; const float* sn; bf16_t* out; int row0, col0; char* lds;
    __device__ __forceinline__ void pre(char* stage) const {
        int tid = threadIdx.x; asm volatile("" : "+v"(tid));
        const int w = __builtin_amdgcn_readfirstlane(tid >> 6), lane = tid & 63;
        constexpr int TB = 32 * MT * 128;
        LAS char* l3 = (LAS char*)stage;
#pragma unroll
        for (int i = 0; i < TB / 8192; ++i) {
            __builtin_amdgcn_global_load_lds((const unsigned*)((const char*)(cs + (size_t)row0 * 32) + i * 8192 + w * 1024 + lane * 16), (LAS unsigned*)(l3 + i * 8192 + w * 1024), 16, 0, 0);
            __builtin_amdgcn_global_load_lds((const unsigned*)((const char*)(sn + (size_t)row0 * 32) + i * 8192 + w * 1024 + lane * 16), (LAS unsigned*)(l3 + TB + i * 8192 + w * 1024), 16, 0, 0);
        }
    }
    __device__ __forceinline__ void operator()(f32x4 (&acc)[MT][4], int wr, int wc, int fr, int fq) const {
        const int hb = col0 + wc * 64;
        const bool is_q = (hb < C_AK) || (hb >= C_BQ && hb < C_BK);
        const bool is_rope = is_q || (hb >= C_AK && hb < C_AV) || (hb >= C_BK && hb < C_BV);
        const float sc = is_q ? QSCALE : 1.0f;
        constexpr int TB = 32 * MT * 128;
        f32x4 bv[4];
#pragma unroll
        for (int nt = 0; nt < 4; ++nt) bv[nt] = *(const f32x4*)(bias + hb + (nt >> 1) * 32 + 8 * fq + 4 * (nt & 1));
        __syncthreads();
        const float* lcs = (const float*)lds; const float* lsn = (const float*)(lds + TB);
#pragma unroll
        for (int mt = 0; mt < MT; ++mt) {
            const int rl = wr * 16 * MT + mt * 16 + fr, row = row0 + rl;
            f32x4 v[4];
#pragma unroll
            for (int nt = 0; nt < 4; ++nt) v[nt] = acc[mt][nt] + bv[nt];
            if (is_rope) {
#pragma unroll
                for (int nt = 0; nt < 2; ++nt) {
                    const f32x4 c = *(const f32x4*)(lcs + rl * 32 + 8 * fq + 4 * nt), s = *(const f32x4*)(lsn + rl * 32 + 8 * fq + 4 * nt);
                    const f32x4 t1 = v[nt], t2 = v[nt + 2];
                    v[nt] = t1 * c - t2 * s; v[nt + 2] = t2 * c + t1 * s;
                }
            }
#pragma unroll
            for (int a = 0; a < 2; ++a) {
                const f32x4 o0 = v[2 * a] * sc, o1 = v[2 * a + 1] * sc;
                u32x4 pk = {cvt_pk(o0[0], o0[1]), cvt_pk(o0[2], o0[3]), cvt_pk(o1[0], o1[1]), cvt_pk(o1[2], o1[3])};
                *(u32x4*)(out + (size_t)row * INW + hb + a * 32 + 8 * fq) = pk;
            }
        }
        __syncthreads();
    }
};
struct EpiProjQ {
    const float* bias; const float* cs; const float* sn; bf16_t* out; int row0, col0;
    __device__ __forceinline__ void pre(char*) const {}
    __device__ __forceinline__ void operator()(f32x4 (&acc)[4][2], int wr, int wc, int fr, int fq) const {
        const int hb = col0 + (wc >> 1) * 64, i0 = (wc & 1) * 16 + 4 * fq;
        const bool is_q = (hb < C_AK) || (hb >= C_BQ && hb < C_BK);
        const bool is_rope = is_q || (hb >= C_AK && hb < C_AV) || (hb >= C_BK && hb < C_BV);
        const float sc = is_q ? QSCALE : 1.0f;
#pragma unroll
        for (int mt = 0; mt < 4; ++mt) {
            const int row = row0 + wr * 64 + mt * 16 + fr;
            f32x4 v0 = acc[mt][0] + *(const f32x4*)(bias + hb + i0), v1 = acc[mt][1] + *(const f32x4*)(bias + hb + 32 + i0);
            if (is_rope) {
                const f32x4 c = *(const f32x4*)(cs + (size_t)row * 32 + i0), s = *(const f32x4*)(sn + (size_t)row * 32 + i0);
                const f32x4 t1 = v0, t2 = v1; v0 = t1 * c - t2 * s; v1 = t2 * c + t1 * s;
            }
            v0 = v0 * sc; v1 = v1 * sc;
            *(u32x2*)(out + (size_t)row * INW + hb + i0) = (u32x2){cvt_pk(v0[0], v0[1]), cvt_pk(v0[2], v0[3])};
            *(u32x2*)(out + (size_t)row * INW + hb + 32 + i0) = (u32x2){cvt_pk(v1[0], v1[1]), cvt_pk(v1[2], v1[3])};
        }
    }
};
__device__ __forceinline__ void phase_proj(const Params& p, char* lds, int vb, int G) {
    const float* cs = (const float*)(p.ws + WS_ROPE); const float* sn = cs + (size_t)S * 32;
    constexpr int NBIG = 512, NUNITS = NBIG + 4 * 64;
    for (int u = vb; u < NUNITS; u += G) {
        G2Args g; g.A = (const char*)(p.ws + WS_XB); g.B = (const char*)(p.ws + WS_WIN); g.nk = D / 64; g.akstep = 128;
        if (u < NBIG) {
            const int tm = u / 9, tn = u % 9;
            g2_rows_A<8>(g, (size_t)tm * 256, D * 2);
            { const int lane = threadIdx.x & 63, w = __builtin_amdgcn_readfirstlane(threadIdx.x >> 6); const unsigned co = g2_chunk_off(lane, w);
#pragma unroll
              for (int i = 0; i < 4; ++i) { const int n = i * 64 + w * 8 + (lane >> 3), nt = (n >> 4) & 3, nl = n & 15;
                  const int col = tn * 256 + (n >> 6) * 64 + (nt >> 1) * 32 + 8 * (nl >> 2) + 4 * (nt & 1) + (nl & 3);
                  g.offB[i] = (unsigned)col * (unsigned)(D * 2) + co; } }
            EpiProj<8> e{p.b_in, cs, sn, (bf16_t*)(p.ws + WS_PROJ), tm * 256, tn * 256, lds};
            gemm2<8>(lds, g, e);
        } else {
            const int q = u - NBIG, t = NBIG + (q >> 2), hm = (q >> 1) & 1, hn = q & 1, tm = t / 9, tn = t % 9;
            g2_rows_A<4>(g, (size_t)tm * 256 + hm * 128, D * 2);
            { const int lane = threadIdx.x & 63, w = __builtin_amdgcn_readfirstlane(threadIdx.x >> 6); const unsigned co = g2_chunk_off(lane, w);
#pragma unroll
              for (int i = 0; i < 2; ++i) { const int n = i * 64 + w * 8 + (lane >> 3), wcn = n >> 5, sub = n & 31;
                  const int col = tn * 256 + hn * 128 + (wcn >> 1) * 64 + (wcn & 1) * 16 + (sub & 15) + (sub >> 4) * 32;
                  g.offB[i] = (unsigned)col * (unsigned)(D * 2) + co; } }
            EpiProjQ e{p.b_in, cs, sn, (bf16_t*)(p.ws + WS_PROJ), tm * 256 + hm * 128, tn * 256 + hn * 128};
            gemm2n<4, 2>(lds, g, e);
        }
    }
}

template <int OFF> __device__ __forceinline__ s16x4 tr_read(int vb) { s16x4 r; asm volatile("ds_read_b64_tr_b16 %0, %1 offset:%2" : "=&v"(r) : "v"(vb), "i"(OFF) : "memory"); return r; }
__device__ __forceinline__ int v_off(int k, int c, int ndb) { return ((k >> 3) * ndb + (c >> 5)) * 512 + ((k & 7) * 32 + (c & 31)) * 2; }

constexpr int AT_STAGE = 32768;
template <int NDB, int KB, int T> struct PvPart {
    static __device__ __forceinline__ void run(f32x16& o, int vbase, const bf16x8& pa, const bf16x8& pb) {
        constexpr int o0 = (KB * 4 * NDB + T) * 512, st = NDB * 512;
        const s16x4 l0 = tr_read<o0 + 0 * st>(vbase), h0 = tr_read<o0 + 1 * st>(vbase), l1 = tr_read<o0 + 2 * st>(vbase), h1 = tr_read<o0 + 3 * st>(vbase);
        asm volatile("s_waitcnt lgkmcnt(0)" ::: "memory"); __builtin_amdgcn_sched_barrier(0);
#define PKV(L, H) (bf16x8){L[0], L[1], L[2], L[3], H[0], H[1], H[2], H[3]}
        o = __builtin_amdgcn_mfma_f32_32x32x16_bf16(PKV(l0, h0), pa, o, 0, 0, 0);
        o = __builtin_amdgcn_mfma_f32_32x32x16_bf16(PKV(l1, h1), pb, o, 0, 0, 0);
#undef PKV
    }
};
template <int NDB, int KB>
__device__ __forceinline__ void pv_half(f32x16 (&o)[NDB], f32x16& ol, int vbase, const bf16x8& pa, const bf16x8& pb) {
    const bf16x8 ones = {16256, 16256, 16256, 16256, 16256, 16256, 16256, 16256};
    ol = __builtin_amdgcn_mfma_f32_32x32x16_bf16(ones, pa, ol, 0, 0, 0);
    ol = __builtin_amdgcn_mfma_f32_32x32x16_bf16(ones, pb, ol, 0, 0, 0);
    PvPart<NDB, KB, 0>::run(o[0], vbase, pa, pb); PvPart<NDB, KB, 1>::run(o[1], vbase, pa, pb);
    if constexpr (NDB == 4) { PvPart<NDB, KB, 2>::run(o[2], vbase, pa, pb); PvPart<NDB, KB, 3>::run(o[3], vbase, pa, pb); }
}
constexpr float ATT_THR = 10.0f;
template <int NDB>
__device__ __forceinline__ void attn_scores(char* lds, int kof, const bf16x8 (&qf)[4], f32x16& s0, f32x16& s1, f32x16 (&o)[NDB], f32x16& ol, f32x16& nm, bool first, int r32, int hi) {
    s0 = nm; s1 = nm;
#pragma unroll
    for (int ds = 0; ds < 4; ++ds) {
        const bf16x8 k0 = *(const bf16x8*)(lds + kof + swz(r32, ds * 2 + hi)), k1 = *(const bf16x8*)(lds + kof + swz(32 + r32, ds * 2 + hi));
        s0 = __builtin_amdgcn_mfma_f32_32x32x16_bf16(k0, qf[ds], s0, 0, 0, 0);
        s1 = __builtin_amdgcn_mfma_f32_32x32x16_bf16(k1, qf[ds], s1, 0, 0, 0);
    }
    float mx = fmaxf(s0[0], s1[0]);
#pragma unroll
    for (int r = 1; r < 16; ++r) mx = fmaxf(fmaxf(mx, s0[r]), s1[r]);
    mx = half_max(mx);
    if (first || __any(mx > ATT_THR)) {
        const float delta = first ? mx : fmaxf(mx, 0.f), alpha = first ? 0.f : __builtin_amdgcn_exp2f(-delta);
#pragma unroll
        for (int r = 0; r < 16; ++r) { s0[r] -= delta; s1[r] -= delta; nm[r] -= delta; ol[r] *= alpha; }
#pragma unroll
        for (int t = 0; t < NDB; ++t)
#pragma unroll
            for (int r = 0; r < 16; ++r) o[t][r] *= alpha;
    }
}
__device__ __forceinline__ void exp_pack(const f32x16& s, bf16x8& pa, bf16x8& pb) {
    float e[16];
#pragma unroll
    for (int r = 0; r < 16; ++r) e[r] = __builtin_amdgcn_exp2f(s[r]);
    u32x4 a = {cvt_pk_vis(e[0], e[1]), cvt_pk_vis(e[2], e[3]), cvt_pk_vis(e[4], e[5]), cvt_pk_vis(e[6], e[7])};
    u32x4 b = {cvt_pk_vis(e[8], e[9]), cvt_pk_vis(e[10], e[11]), cvt_pk_vis(e[12], e[13]), cvt_pk_vis(e[14], e[15])};
    pa = *(bf16x8*)&a; pb = *(bf16x8*)&b;
}

template <int OFF> __device__ __forceinline__ bf16x8 k_read(int a) { bf16x8 r; asm volatile("ds_read_b128 %0, %1 offset:%2" : "=&v"(r) : "v"(a), "i"(OFF) : "memory"); return r; }
struct VSet { s16x4 l0, h0, l1, h1; };
template <int KB, int T> __device__ __forceinline__ void v_issue(VSet& v, int vbase) {
    constexpr int o0 = (KB * 16 + T) * 512, st = 4 * 512;
    v.l0 = tr_read<o0>(vbase); v.h0 = tr_read<o0 + st>(vbase); v.l1 = tr_read<o0 + 2 * st>(vbase); v.h1 = tr_read<o0 + 3 * st>(vbase);
}
#define WAIT_K(n, a, b) asm volatile("s_waitcnt lgkmcnt(" #n ")" : "+v"(a), "+v"(b) :: "memory")
#define WAIT_V(n, v) asm volatile("s_waitcnt lgkmcnt(" #n ")" : "+v"(v.l0), "+v"(v.h0), "+v"(v.l1), "+v"(v.h1) :: "memory")
#define PKV(L, H) (bf16x8){L[0], L[1], L[2], L[3], H[0], H[1], H[2], H[3]}
#define MF32(a, b, c) __builtin_amdgcn_mfma_f32_32x32x16_bf16(a, b, c, 0, 0, 0)
#define SB __builtin_amdgcn_sched_barrier(0)
#define EXP4(src, i, wlo, whi) do { const float e0_ = __builtin_amdgcn_exp2f(src[4 * (i)]), e1_ = __builtin_amdgcn_exp2f(src[4 * (i) + 1]), e2_ = __builtin_amdgcn_exp2f(src[4 * (i) + 2]), e3_ = __builtin_amdgcn_exp2f(src[4 * (i) + 3]); \
        asm("v_add_f32 %0, %1, %0" : "+v"(l2[0]) : "v"(e0_)); asm("v_add_f32 %0, %1, %0" : "+v"(l2[1]) : "v"(e1_)); asm("v_add_f32 %0, %1, %0" : "+v"(l2[0]) : "v"(e2_)); asm("v_add_f32 %0, %1, %0" : "+v"(l2[1]) : "v"(e3_)); \
        wlo = cvt_pk(e0_, e1_); whi = cvt_pk(e2_, e3_); } while (0)
#define EXP2(src, i, w) do { const float e0_ = __builtin_amdgcn_exp2f(src[2 * (i)]), e1_ = __builtin_amdgcn_exp2f(src[2 * (i) + 1]); \
        w = cvt_pk_vis(e0_, e1_); asm("v_add_f32 %0, %1, %0" : "+v"(l2[0]) : "v"(e0_), "v"(w)); asm("v_add_f32 %0, %1, %0" : "+v"(l2[1]) : "v"(e1_), "v"(w)); } while (0)
#define MAX4(i) do { mx = fmaxf(fmaxf(mx, n0[4 * (i)]), n1[4 * (i)]); mx = fmaxf(fmaxf(mx, n0[4 * (i) + 1]), n1[4 * (i) + 1]); \
        mx = fmaxf(fmaxf(mx, n0[4 * (i) + 2]), n1[4 * (i) + 2]); mx = fmaxf(fmaxf(mx, n0[4 * (i) + 3]), n1[4 * (i) + 3]); asm volatile("" : "+v"(mx)); } while (0)
struct DmaPlan { const char* base; unsigned gk, gv; size_t ok3, ok4, ov2, ov3; LAS char* dk3; LAS char* dk4; LAS char* dv2; LAS char* dv3; };
#define DMAP(src, dst) __builtin_amdgcn_global_load_lds((const unsigned*)(src), (LAS unsigned*)(dst), 16, 0, 0)
template <bool DMA>
__device__ __forceinline__ void diff_slot(f32x16& c0, f32x16& c1, f32x16& n0, f32x16& n1, f32x16 (&o)[4], f32x2& l2, f32x16& nm, const bf16x8 (&qf)[4],
                                          int ka0, int ka1, int ka2, int ka3, int vbase, bool has_next, const DmaPlan& dp) {
    constexpr bool HASNEXT = true;
    bf16x8 kA, kB, kC, kD, kE, kF, kG, kH; VSet v4, v5, v6, v7, v8, v9, v10, v11; u32x4 w0, w1, w2, w3;
    float mx = -3.0e38f;
    SB;
    kA = k_read<0>(ka0); kB = k_read<4096>(ka0); kC = k_read<0>(ka1); kD = k_read<4096>(ka1);
    EXP2(c0, 0, w0[0]);
    EXP2(c0, 1, w0[1]);
    WAIT_K(2, kA, kB);
    kE = k_read<0>(ka2); kF = k_read<4096>(ka2);
    n0 = MF32(kA, qf[0], nm); n1 = MF32(kB, qf[0], nm);
    if constexpr (DMA) DMAP(dp.base + dp.ok3 + dp.gk, dp.dk3);
    SB;
    EXP2(c0, 2, w0[2]);
    WAIT_K(2, kC, kD);
    kG = k_read<0>(ka3); kH = k_read<4096>(ka3);
    n0 = MF32(kC, qf[1], n0); n1 = MF32(kD, qf[1], n1);
    if constexpr (DMA) DMAP(dp.base + (dp.ok3 + 128) + dp.gk, dp.dk3 + 8192);
    SB;
    EXP2(c0, 3, w0[3]);
    EXP2(c0, 4, w1[0]);
    WAIT_K(2, kE, kF);
    v4.l0 = tr_read<0>(vbase); v4.h0 = tr_read<2048>(vbase); v4.l1 = tr_read<512>(vbase); v4.h1 = tr_read<2560>(vbase);
    n0 = MF32(kE, qf[2], n0); n1 = MF32(kF, qf[2], n1);
    if constexpr (DMA) DMAP(dp.base + dp.ov2 + dp.gv, dp.dv2);
    SB;
    EXP2(c0, 5, w1[1]);
    WAIT_K(4, kG, kH);
    v5.l0 = tr_read<1024>(vbase); v5.h0 = tr_read<3072>(vbase); v5.l1 = tr_read<1536>(vbase); v5.h1 = tr_read<3584>(vbase);
    n0 = MF32(kG, qf[3], n0); n1 = MF32(kH, qf[3], n1);
    if constexpr (DMA) DMAP(dp.base + (dp.ov2 + 128) + dp.gv, dp.dv2 + 1024);
    SB;
    EXP2(c0, 6, w1[2]);
    EXP2(c0, 7, w1[3]);
    WAIT_V(4, v4);
    v6.l0 = tr_read<4096>(vbase); v6.h0 = tr_read<6144>(vbase); v6.l1 = tr_read<4608>(vbase); v6.h1 = tr_read<6656>(vbase);
    o[0] = MF32(PKV(v4.l0, v4.h0), (*(bf16x8*)&w0), o[0]); o[1] = MF32(PKV(v4.l1, v4.h1), (*(bf16x8*)&w0), o[1]);
    if constexpr (DMA) DMAP(dp.base + dp.ov3 + dp.gv, dp.dv3);
    SB;
    EXP2(c1, 0, w2[0]);
    MAX4(0);
    WAIT_V(4, v5);
    v7.l0 = tr_read<5120>(vbase); v7.h0 = tr_read<7168>(vbase); v7.l1 = tr_read<5632>(vbase); v7.h1 = tr_read<7680>(vbase);
    o[2] = MF32(PKV(v5.l0, v5.h0), (*(bf16x8*)&w0), o[2]); o[3] = MF32(PKV(v5.l1, v5.h1), (*(bf16x8*)&w0), o[3]);
    if constexpr (DMA) DMAP(dp.base + (dp.ov3 + 128) + dp.gv, dp.dv3 + 1024);
    SB;
    EXP2(c1, 1, w2[1]);
    EXP2(c1, 2, w2[2]);
    WAIT_V(4, v6);
    v8.l0 = tr_read<8192>(vbase); v8.h0 = tr_read<10240>(vbase); v8.l1 = tr_read<8704>(vbase); v8.h1 = tr_read<10752>(vbase);
    o[0] = MF32(PKV(v6.l0, v6.h0), (*(bf16x8*)&w1), o[0]); o[1] = MF32(PKV(v6.l1, v6.h1), (*(bf16x8*)&w1), o[1]);
    if constexpr (DMA) DMAP(dp.base + dp.ok4 + dp.gk, dp.dk4);
    SB;
    EXP2(c1, 3, w2[3]);
    MAX4(1);
    WAIT_V(4, v7);
    v9.l0 = tr_read<9216>(vbase); v9.h0 = tr_read<11264>(vbase); v9.l1 = tr_read<9728>(vbase); v9.h1 = tr_read<11776>(vbase);
    o[2] = MF32(PKV(v7.l0, v7.h0), (*(bf16x8*)&w1), o[2]); o[3] = MF32(PKV(v7.l1, v7.h1), (*(bf16x8*)&w1), o[3]);
    if constexpr (DMA) DMAP(dp.base + (dp.ok4 + 128) + dp.gk, dp.dk4 + 8192);
    SB;
    EXP2(c1, 4, w3[0]);
    EXP2(c1, 5, w3[1]);
    WAIT_V(4, v8);
    v10.l0 = tr_read<12288>(vbase); v10.h0 = tr_read<14336>(vbase); v10.l1 = tr_read<12800>(vbase); v10.h1 = tr_read<14848>(vbase);
    o[0] = MF32(PKV(v8.l0, v8.h0), (*(bf16x8*)&w2), o[0]); o[1] = MF32(PKV(v8.l1, v8.h1), (*(bf16x8*)&w2), o[1]);
    SB;
    EXP2(c1, 6, w3[2]);
    EXP2(c1, 7, w3[3]);
    WAIT_V(4, v9);
    v11.l0 = tr_read<13312>(vbase); v11.h0 = tr_read<15360>(vbase); v11.l1 = tr_read<13824>(vbase); v11.h1 = tr_read<15872>(vbase);
    o[2] = MF32(PKV(v9.l0, v9.h0), (*(bf16x8*)&w2), o[2]); o[3] = MF32(PKV(v9.l1, v9.h1), (*(bf16x8*)&w2), o[3]);
    SB;
    MAX4(2);
    WAIT_V(4, v10);
    o[0] = MF32(PKV(v10.l0, v10.h0), (*(bf16x8*)&w3), o[0]); o[1] = MF32(PKV(v10.l1, v10.h1), (*(bf16x8*)&w3), o[1]);
    SB;
    MAX4(3);
    WAIT_V(0, v11);
    o[2] = MF32(PKV(v11.l0, v11.h0), (*(bf16x8*)&w3), o[2]); o[3] = MF32(PKV(v11.l1, v11.h1), (*(bf16x8*)&w3), o[3]);
    SB;
    if (has_next) {
        mx = half_max(mx);
        if (__any(mx > ATT_THR)) {
            const float delta = fmaxf(mx, 0.f), alpha = __builtin_amdgcn_exp2f(-delta);
#pragma unroll
            for (int r = 0; r < 16; ++r) { n0[r] -= delta; n1[r] -= delta; nm[r] -= delta; }
            l2 *= alpha;
#pragma unroll
            for (int t = 0; t < 4; ++t)
#pragma unroll
                for (int r = 0; r < 16; ++r) o[t][r] *= alpha;
        }
    }
}
__device__ __forceinline__ void attn_diff_unit(const Params& p, char* lds_, int h, int qb, float lam) {
    LAS char* lds = (LAS char*)lds_;
    int tid = threadIdx.x; asm volatile("" : "+v"(tid));
    const int lane = tid & 63, w = __builtin_amdgcn_readfirstlane(tid >> 6), r32 = lane & 31, hi = lane >> 5, mp = w >> 2, wq = w & 3;
    const bf16_t* proj = (const bf16_t*)(p.ws + WS_PROJ);
    const int NT = 2 * qb + 2, NP = NT / 2, myNT = (wq < 2) ? NT - 1 : NT;
    bf16x8 qf[4];
    { const bf16_t* qp = proj + (size_t)(qb * 128 + wq * 32 + r32) * INW + C_BQ + h * 128 + mp * 64 + hi * 8;
#pragma unroll
      for (int ds = 0; ds < 4; ++ds) qf[ds] = *(const bf16x8*)(qp + ds * 16); }
    asm volatile("" : "+v"(qf[0]), "+v"(qf[1]), "+v"(qf[2]), "+v"(qf[3]));
    f32x16 o[4] = {}; f32x16 nm; f32x2 l2 = {0.f, 0.f};
    const unsigned gko = (unsigned)((w * 8 + (lane >> 3)) * INW + C_BK + h * 128) * 2u + g2_chunk_off(lane, w);
    const unsigned gvo = (unsigned)((w * 8 + ((lane & 31) >> 2)) * INW + C_BV + h * 128 + (lane >> 5) * 32 + (lane & 3) * 8) * 2u;
    const char* gk = (const char*)proj + gko; const char* gv = (const char*)proj + gvo;
    const int vlane = ((lane & 3) << 3) | (((lane >> 2) & 3) << 6) | (((lane >> 4) & 1) << 5) | (((lane >> 5) & 1) << 8);
    const int ldsb = (int)(uintptr_t)lds_;
    const int kad0 = ldsb + mp * 8192 + swz(r32, 0 + hi), kad1 = ldsb + mp * 8192 + swz(r32, 2 + hi), kad2 = ldsb + mp * 8192 + swz(r32, 4 + hi), kad3 = ldsb + mp * 8192 + swz(r32, 6 + hi);
    constexpr size_t TSTEP = (size_t)64 * INW * 2;
#define DMA_K(t_) do { const int tt_ = (t_); const char* s_ = gk + (size_t)tt_ * TSTEP; LAS char* d_ = lds + (tt_ & 3) * 16384 + w * 1024; \
        __builtin_amdgcn_global_load_lds((const unsigned*)s_, (LAS unsigned*)d_, 16, 0, 0); \
        __builtin_amdgcn_global_load_lds((const unsigned*)(s_ + 128), (LAS unsigned*)(d_ + 8192), 16, 0, 0); } while (0)
#define DMA_V(t_) do { const int tt_ = (t_); const char* s_ = gv + (size_t)tt_ * TSTEP; LAS char* d_ = lds + 65536 + (tt_ & 3) * 16384 + (2 * w) * 1024; \
        __builtin_amdgcn_global_load_lds((const unsigned*)s_, (LAS unsigned*)d_, 16, 0, 0); \
        __builtin_amdgcn_global_load_lds((const unsigned*)(s_ + 128), (LAS unsigned*)(d_ + 1024), 16, 0, 0); } while (0)
    DMA_K(0); DMA_K(1); if (NT > 2) DMA_K(2); DMA_V(0); DMA_V(1);
    __syncthreads();
    f32x16 A0 = {}, A1 = {}, B0 = {}, B1 = {};
    {
#pragma unroll
        for (int ds = 0; ds < 4; ++ds) {
            const bf16x8 k0 = *(const bf16x8*)(lds_ + mp * 8192 + swz(r32, ds * 2 + hi)), k1 = *(const bf16x8*)(lds_ + mp * 8192 + swz(32 + r32, ds * 2 + hi));
            A0 = MF32(k0, qf[ds], A0); A1 = MF32(k1, qf[ds], A1);
        }
        float mx = fmaxf(A0[0], A1[0]);
#pragma unroll
        for (int r = 1; r < 16; ++r) mx = fmaxf(fmaxf(mx, A0[r]), A1[r]);
        mx = half_max(mx);
#pragma unroll
        for (int r = 0; r < 16; ++r) { A0[r] -= mx; A1[r] -= mx; nm[r] = -mx; }
    }
    __syncthreads();
    for (int it = 0; it < NP; ++it) {
        const int t = 2 * it;
        DmaPlan dp;
        dp.base = (const char*)proj; dp.gk = gko; dp.gv = gvo;
        dp.ok3 = (size_t)min(t + 3, NT - 1) * TSTEP; dp.dk3 = lds + ((t + 3) & 3) * 16384 + w * 1024;
        dp.ok4 = (size_t)min(t + 4, NT - 1) * TSTEP; dp.dk4 = lds + ((t + 4) & 3) * 16384 + w * 1024;
        dp.ov2 = (size_t)min(t + 2, NT - 1) * TSTEP; dp.dv2 = lds + 65536 + ((t + 2) & 3) * 16384 + (2 * w) * 1024;
        dp.ov3 = (size_t)min(t + 3, NT - 1) * TSTEP; dp.dv3 = lds + 65536 + ((t + 3) & 3) * 16384 + (2 * w) * 1024;
        { const int ks = ((t + 1) & 3) * 16384, vb_ = ldsb + 65536 + (t & 3) * 16384 + vlane;
          diff_slot<true>(A0, A1, B0, B1, o, l2, nm, qf, kad0 + ks, kad1 + ks, kad2 + ks, kad3 + ks, vb_, t + 1 < myNT, dp); }
        if (t + 1 < myNT) {
            const int ks = ((t + 2) & 3) * 16384, vb_ = ldsb + 65536 + ((t + 1) & 3) * 16384 + vlane;
            diff_slot<false>(B0, B1, A0, A1, o, l2, nm, qf, kad0 + ks, kad1 + ks, kad2 + ks, kad3 + ks, vb_, t + 2 < myNT, dp);
        }
        __syncthreads();
    }
#undef DMA_K
#undef DMA_V
    float* xb = (float*)lds_;
    const float il = 1.0f / half_sum(l2[0] + l2[1]);
    if (mp == 1) {
        const float f = il * *(const float*)(lds_ + LDS_MISC);
#pragma unroll
        for (int t = 0; t < 4; ++t)
#pragma unroll
            for (int r = 0; r < 16; ++r) xb[(wq * 64 + t * 16 + r) * 64 + lane] = o[t][r] * f;
    }
    __syncthreads();
    if (mp == 0) {
        float ss = 0.f;
#pragma unroll
        for (int t = 0; t < 4; ++t)
#pragma unroll
            for (int r = 0; r < 16; ++r) { const float v = o[t][r] * il - xb[(wq * 64 + t * 16 + r) * 64 + lane]; o[t][r] = v; ss += v * v; }
        ss = half_sum(ss);
        const float rs = rsqrtf(ss * (1.0f / 128.0f) + LN_EPS) * 0.8f;
        bf16_t* op = (bf16_t*)(p.ws + WS_ATT) + (size_t)(qb * 128 + wq * 32 + r32) * D + 512 + h * 128;
#pragma unroll
        for (int t = 0; t < 4; ++t)
#pragma unroll
            for (int rp = 0; rp < 2; ++rp) {
                unsigned pk[2][2];
#pragma unroll
                for (int a = 0; a < 2; ++a) {
                    const int rr = 2 * rp + a, dv0 = 32 * t + 8 * rr + 4 * hi;
                    const f32x4 gg = *(const f32x4*)(p.subg + dv0);
                    pk[a][0] = cvt_pk(o[t][4 * rr] * rs * gg[0], o[t][4 * rr + 1] * rs * gg[1]); pk[a][1] = cvt_pk(o[t][4 * rr + 2] * rs * gg[2], o[t][4 * rr + 3] * rs * gg[3]);
                }
                const auto s0 = __builtin_amdgcn_permlane32_swap(pk[0][0], pk[1][0], false, false), s1 = __builtin_amdgcn_permlane32_swap(pk[0][1], pk[1][1], false, false);
                *(u32x4*)(op + 32 * t + 8 * (2 * rp + hi)) = (u32x4){s0[0], s1[0], s0[1], s1[1]};
            }
    }
    __syncthreads();
}
#undef DMAP
#undef WAIT_K
#undef WAIT_V
#undef PKV
#undef MF32
#undef SB
#undef EXP4
#undef EXP2
#undef MAX4
__device__ __forceinline__ void attn_swa_unit(const Params& p, char* lds, int kvh, int n) {
    int tid = threadIdx.x; asm volatile("" : "+v"(tid));
    const int lane = tid & 63, w = __builtin_amdgcn_readfirstlane(tid >> 6), r32 = lane & 31, hi = lane >> 5, g = w >> 1, hq = kvh * 4 + g;
    const bf16_t* proj = (const bf16_t*)(p.ws + WS_PROJ);
    const int c0 = (n >= 2) ? n - 2 : 0, NT = n - c0 + 1;
    const int tok = n * 64 + (w & 1) * 32 + r32;
    bf16x8 qf[4];
    { const bf16_t* qp = proj + (size_t)tok * INW + C_AQ + hq * 64 + hi * 8;
#pragma unroll
      for (int ds = 0; ds < 4; ++ds) qf[ds] = *(const bf16x8*)(qp + ds * 16); }
    f32x16 o[2] = {}; f32x16 ol, nm;
    { float ms = -p.sinks[hq] * LOG2E; asm volatile("" : "+v"(qf[0]), "+v"(qf[1]), "+v"(qf[2]), "+v"(qf[3]), "+v"(ms));
#pragma unroll
      for (int r = 0; r < 16; ++r) { nm[r] = ms; ol[r] = 1.0f; } }
    const bf16_t* gk = proj + (size_t)(c0 * 64 + (tid >> 3)) * INW + C_AK + kvh * 64 + (tid & 7) * 8;
    const bf16_t* gv = proj + (size_t)(c0 * 64 + (tid >> 3)) * INW + C_AV + kvh * 64 + (tid & 7) * 8;
    const int wk = swz(tid >> 3, tid & 7), wv = v_off(tid >> 3, (tid & 7) * 8, 2);
    const int vlane = ((lane & 3) << 3) | (((lane >> 2) & 3) << 6) | (((lane >> 4) & 1) << 5) | (((lane >> 5) & 1) << 8);
    u32x4 st0, st1;
#define W_LOAD(t) do { const size_t ko = (size_t)(t) * 64 * INW; st0 = *(const u32x4*)(gk + ko); st1 = *(const u32x4*)(gv + ko); } while (0)
#define W_WRITE(b) do { char* sb = lds + (b) * AT_STAGE; *(u32x4*)(sb + wk) = st0; *(u32x4*)(sb + 8192 + wv) = st1; } while (0)
    W_LOAD(0); W_WRITE(0); __syncthreads();
    for (int t = 0; t < NT; ++t) {
        const int b = t & 1;
        if (t + 1 < NT) W_LOAD(t + 1);
        { f32x16 s0, s1; bf16x8 p0, p1, p2, p3; const int vb_ = (int)(uintptr_t)(lds + b * AT_STAGE + 8192) + vlane;
          attn_scores<2>(lds, b * AT_STAGE, qf, s0, s1, o, ol, nm, false, r32, hi);
          exp_pack(s0, p0, p1); pv_half<2, 0>(o, ol, vb_, p0, p1); exp_pack(s1, p2, p3); pv_half<2, 1>(o, ol, vb_, p2, p3); }
        if (t + 1 < NT) W_WRITE(b ^ 1);
        __syncthreads();
    }
#undef W_LOAD
#undef W_WRITE
    const float il = 1.0f / ol[0];
    bf16_t* op = (bf16_t*)(p.ws + WS_ATT) + (size_t)tok * D + hq * 64;
#pragma unroll
    for (int t = 0; t < 2; ++t)
#pragma unroll
        for (int rp = 0; rp < 2; ++rp) {
            unsigned pk[2][2];
#pragma unroll
            for (int a = 0; a < 2; ++a) { const int rr = 2 * rp + a; pk[a][0] = cvt_pk(o[t][4 * rr] * il, o[t][4 * rr + 1] * il); pk[a][1] = cvt_pk(o[t][4 * rr + 2] * il, o[t][4 * rr + 3] * il); }
            const auto s0 = __builtin_amdgcn_permlane32_swap(pk[0][0], pk[1][0], false, false), s1 = __builtin_amdgcn_permlane32_swap(pk[0][1], pk[1][1], false, false);
            *(u32x4*)(op + 32 * t + 8 * (2 * rp + hi)) = (u32x4){s0[0], s1[0], s0[1], s1[1]};
        }
}
__device__ __forceinline__ void phase_attn(const Params& p, char* lds, int vb, int G) {
    const int lane = threadIdx.x & 63;
    const float d1 = wave_sum(p.lq1[lane] * p.lk1[lane]), d2 = wave_sum(p.lq2[lane] * p.lk2[lane]);
    if (threadIdx.x == 0) *(float*)(lds + LDS_MISC) = expf(d1) - expf(d2) + 0.2f;
    __syncthreads();
    const float lam = 0.f;
    for (int u = vb; u < 1024; u += G) {
        if (u < 512) attn_diff_unit(p, lds, (u & 255) >> 6, (u < 256) ? 127 - (u & 63) : (u & 63), lam);
        else attn_swa_unit(p, lds, (u - 512) >> 8, (u - 512) & 255);
    }
}

struct EpiPreLn {
    const bf16_t* xb; bf16_t* out; int row0, col0;
    __device__ __forceinline__ void pre(char*) const {}
    __device__ __forceinline__ void operator()(f32x4 (&acc)[8][4], int wr, int wc, int fr, int fq) const {
        u32x4 xa[2], xb_[2];
        const size_t rbase = (size_t)(row0 + wr * 128 + fr) * D + col0 + wc * 64 + 8 * fq;
#pragma unroll
        for (int a = 0; a < 2; ++a) xa[a] = *(const u32x4*)(xb + rbase + a * 32);
#pragma unroll
        for (int mt = 0; mt < 8; ++mt) {
            const size_t ro = rbase + (size_t)mt * 16 * D;
            if (mt + 1 < 8) {
#pragma unroll
                for (int a = 0; a < 2; ++a) { const u32x4 t = *(const u32x4*)(xb + ro + (size_t)16 * D + a * 32); if (mt & 1) xa[a] = t; else xb_[a] = t; }
            }
#pragma unroll
            for (int a = 0; a < 2; ++a) {
                const u32x4 q = (mt & 1) ? xb_[a] : xa[a];
                const f32x4 x0 = {bf_lo(q[0]), bf_hi(q[0]), bf_lo(q[1]), bf_hi(q[1])}, x1 = {bf_lo(q[2]), bf_hi(q[2]), bf_lo(q[3]), bf_hi(q[3])};
                const f32x4 v0 = x0 * ALPHA + acc[mt][2 * a], v1 = x1 * ALPHA + acc[mt][2 * a + 1];
                *(u32x4*)(out + ro + a * 32) = (u32x4){cvt_pk(v0[0], v0[1]), cvt_pk(v0[2], v0[3]), cvt_pk(v1[0], v1[1]), cvt_pk(v1[2], v1[3])};
            }
        }
    }
};
__device__ __forceinline__ void phase_wout(const Params& p, char* lds, int vb, int G) {
    for (int u = vb; u < (S / 256) * 4; u += G) {
        const int tm = u >> 2, tn = u & 3;
        G2Args g; g.A = (const char*)(p.ws + WS_ATT); g.B = (const char*)(p.ws + WS_WOUT); g.nk = D / 64; g.akstep = 128;
        g2_rows_A<8>(g, (size_t)tm * 256, D * 2);
        { const int lane = threadIdx.x & 63, w = __builtin_amdgcn_readfirstlane(threadIdx.x >> 6); const unsigned co = g2_chunk_off(lane, w);
#pragma unroll
          for (int i = 0; i < 4; ++i) { const int n = i * 64 + w * 8 + (lane >> 3), nt = (n >> 4) & 3, nl = n & 15;
              const int col = tn * 256 + (n >> 6) * 64 + (nt >> 1) * 32 + 8 * (nl >> 2) + 4 * (nt & 1) + (nl & 3);
              g.offB[i] = (unsigned)col * (unsigned)(D * 2) + co; } }
        EpiPreLn e{(const bf16_t*)(p.ws + WS_XB), (bf16_t*)(p.ws + WS_PRELN), tm * 256, tn * 256};
        gemm2<8>(lds, g, e);
    }
}

struct EpiLogits {
    float* L;
    __device__ __forceinline__ void pre(char*) const {}
    __device__ __forceinline__ void operator()(f32x4 (&acc)[4][4], int wr, int wc, int fr, int fq) const {
#pragma unroll
        for (int mt = 0; mt < 4; ++mt)
#pragma unroll
            for (int nt = 0; nt < 4; ++nt) *(f32x4*)(L + (wr * 64 + mt * 16 + fr) * 256 + wc * 64 + nt * 16 + 4 * fq) = acc[mt][nt];
    }
};
__device__ __forceinline__ void phase_router(const Params& p, char* lds, int vb, int G) {
    const bf16_t* preln = (const bf16_t*)(p.ws + WS_PRELN);
    bf16_t* x1b = (bf16_t*)(p.ws + WS_X1B);
    unsigned* cnt = (unsigned*)(p.ws + WS_CTL + 65536); int* list = (int*)(p.ws + WS_LIST); float* gates = (float*)(p.ws + WS_GATE);
    for (int u = vb; u < S / 64; u += G) {
        int tid = threadIdx.x; asm volatile("" : "+v"(tid));
        const int lane = tid & 63, w = tid >> 6;
        {
            f32x4 v[8][4]; float sm[8], sq[8];
#pragma unroll
            for (int i = 0; i < 8; ++i) { const u32x4* xr = (const u32x4*)(preln + (size_t)(u * 64 + w * 8 + i) * D) + lane;
#pragma unroll
                for (int j = 0; j < 2; ++j) { const u32x4 q = xr[64 * j];
                    v[i][2 * j] = (f32x4){bf_lo(q[0]), bf_hi(q[0]), bf_lo(q[1]), bf_hi(q[1])}; v[i][2 * j + 1] = (f32x4){bf_lo(q[2]), bf_hi(q[2]), bf_lo(q[3]), bf_hi(q[3])}; } }
#pragma unroll
            for (int i = 0; i < 8; ++i) { float s = 0.f;
#pragma unroll
                for (int j = 0; j < 4; ++j) s += (v[i][j][0] + v[i][j][1]) + (v[i][j][2] + v[i][j][3]);
                sm[i] = s; }
#pragma unroll
            for (int o = 1; o < 64; o <<= 1) {
#pragma unroll
                for (int i = 0; i < 8; ++i) sm[i] += __shfl_xor(sm[i], o); }
#pragma unroll
            for (int i = 0; i < 8; ++i) { const float mean = sm[i] * (1.0f / D); float s2 = 0.f;
#pragma unroll
                for (int j = 0; j < 4; ++j) { v[i][j] = v[i][j] - mean; s2 += (v[i][j][0] * v[i][j][0] + v[i][j][1] * v[i][j][1]) + (v[i][j][2] * v[i][j][2] + v[i][j][3] * v[i][j][3]); }
                sq[i] = s2; }
#pragma unroll
            for (int o = 1; o < 64; o <<= 1) {
#pragma unroll
                for (int i = 0; i < 8; ++i) sq[i] += __shfl_xor(sq[i], o); }
#pragma unroll
            for (int j = 0; j < 2; ++j) {
                const f32x4 g0 = *((const f32x4*)p.ln1g + 2 * lane + 128 * j), g1 = *((const f32x4*)p.ln1g + 2 * lane + 128 * j + 1);
                const f32x4 b0 = *((const f32x4*)p.ln1b + 2 * lane + 128 * j), b1 = *((const f32x4*)p.ln1b + 2 * lane + 128 * j + 1);
#pragma unroll
                for (int i = 0; i < 8; ++i) {
                    const int row = u * 64 + w * 8 + i;
                    const float rstd = rsqrtf(sq[i] * (1.0f / D) + LN_EPS);
                    const f32x4 y0 = v[i][2 * j] * rstd * g0 + b0, y1 = v[i][2 * j + 1] * rstd * g1 + b1;
                    u32x4 pk = {cvt_pk(y0[0], y0[1]), cvt_pk(y0[2], y0[3]), cvt_pk(y1[0], y1[1]), cvt_pk(y1[2], y1[3])};
                    *(u32x4*)(x1b + ((size_t)((lane >> 3) + 8 * j) * S + row) * 64 + ((8 * lane) & 63)) = pk;
                }
            }
        }
        asm volatile("s_waitcnt vmcnt(0)" ::: "memory");
        __syncthreads();
        { G2Args g; g.A = (const char*)x1b; g.B = (const char*)(p.ws + WS_WR); g.nk = D / 64; g.akstep = S * 128;
          g2_rows_A<4>(g, (size_t)u * 64, 128); g.offA[1] = g.offA[0]; g2_rows_B(g, 0, D * 2);
          EpiLogits e{(float*)lds};
          gemm2<4>(lds, g, e); }
        __syncthreads();
        const f32x4 rb = *((const f32x4*)p.r_bias + lane);
        const float NEG = -__builtin_inff();
        for (int i0 = 0; i0 < 8; i0 += 4) {
            float sc[4][4], cand[4][4]; int my_e[4]; float my_s[4], gsum[4];
#pragma unroll
            for (int q = 0; q < 4; ++q) {
                const int tl = w * 8 + i0 + q;
                const f32x4 lg = *((const f32x4*)((const float*)lds + tl * 256) + lane);
#pragma unroll
                for (int j = 0; j < 4; ++j) { sc[q][j] = 1.0f / (1.0f + __expf(-lg[j])); cand[q][j] = sc[q][j] + rb[j]; }
                my_e[q] = 0; my_s[q] = 0.f; gsum[q] = 0.f;
            }
            float a1[4], a2[4];
#pragma unroll
            for (int q = 0; q < 4; ++q) { const float m01 = fmaxf(cand[q][0], cand[q][1]), n01 = fminf(cand[q][0], cand[q][1]), m23 = fmaxf(cand[q][2], cand[q][3]), n23 = fminf(cand[q][2], cand[q][3]);
              a1[q] = fmaxf(m01, m23); a2[q] = fmaxf(fminf(m01, m23), fmaxf(n01, n23)); }
#pragma unroll
            for (int off = 1; off < 8; off <<= 1) {
#pragma unroll
                for (int q = 0; q < 4; ++q) { const float b1 = __shfl_xor(a1[q], off), b2 = __shfl_xor(a2[q], off); const float n1 = fmaxf(a1[q], b1), n2 = fmaxf(fminf(a1[q], b1), fmaxf(a2[q], b2)); a1[q] = n1; a2[q] = n2; }
            }
            const int mygrp = lane >> 3;
#pragma unroll
            for (int q = 0; q < 4; ++q) {
                const float gs = a1[q] + a2[q]; int rank = 0;
#pragma unroll
                for (int g2 = 0; g2 < 8; ++g2) { const float v = __shfl(gs, g2 * 8); rank += (v > gs || (v == gs && g2 < mygrp)) ? 1 : 0; }
                if (rank >= 4) {
#pragma unroll
                    for (int j = 0; j < 4; ++j) cand[q][j] = NEG;
                }
            }
#pragma unroll
            for (int k = 0; k < 8; ++k) {
                float bv[4]; int idx[4];
#pragma unroll
                for (int q = 0; q < 4; ++q) { bv[q] = cand[q][0]; int bi = 0;
#pragma unroll
                    for (int j = 1; j < 4; ++j) if (cand[q][j] > bv[q]) { bv[q] = cand[q][j]; bi = j; }
                    idx[q] = 4 * lane + bi; }
#pragma unroll
                for (int off = 32; off >= 1; off >>= 1) {
#pragma unroll
                    for (int q = 0; q < 4; ++q) { const float ov = __shfl_xor(bv[q], off); const int oi = __shfl_xor(idx[q], off); if (ov > bv[q] || (ov == bv[q] && oi < idx[q])) { bv[q] = ov; idx[q] = oi; } }
                }
#pragma unroll
                for (int q = 0; q < 4; ++q) {
                    const int owner = idx[q] >> 2, sub = idx[q] & 3;
                    float scv = sc[q][0];
#pragma unroll
                    for (int j = 1; j < 4; ++j) scv = (sub == j) ? sc[q][j] : scv;
                    if (lane == owner) {
#pragma unroll
                        for (int j = 0; j < 4; ++j) if (sub == j) cand[q][j] = NEG;
                    }
                    const float gsc = __shfl(scv, owner);
                    if (lane == k) { my_e[q] = idx[q]; my_s[q] = gsc; }
                    gsum[q] += gsc;
                }
            }
            if (lane < 8) {
#pragma unroll
                for (int q = 0; q < 4; ++q) {
                    const int t = u * 64 + w * 8 + i0 + q;
                    const float gate = my_s[q] / gsum[q] * 2.5f;
                    const unsigned pos = atomicAdd(cnt + my_e[q] * CNT_STRIDE, 1u);
                    list[(size_t)my_e[q] * CAP + pos] = t * 8 + lane;
                    gates[t * 8 + lane] = gate;
                }
            }
        }
        __syncthreads();
    }
}

#ifndef MOE_MT
#define MOE_MT 8
#endif
constexpr int MOE_BM = 32 * MOE_MT;
struct EpiAct {
    bf16_t* act; const int* slots;
    __device__ __forceinline__ void operator()(f32x4 (&acc)[MOE_MT][4], int pass, int wr, int wc, int fr, int fq) const {
        const int ncol0 = pass * 128;
#pragma unroll
        for (int mt = 0; mt < MOE_MT; ++mt) {
            const int ar = slots[wr * 16 * MOE_MT + mt * 16 + fr];
            if (ar >= 0) {
                float a[8];
#pragma unroll
                for (int nt = 0; nt < 2; ++nt)
#pragma unroll
                    for (int j = 0; j < 4; ++j) { const float gq = acc[mt][nt][j]; a[nt * 4 + j] = gq * __builtin_amdgcn_rcpf(1.0f + __expf(-gq)) * (acc[mt][nt + 2][j]); }
                u32x4 pk = {cvt_pk(a[0], a[1]), cvt_pk(a[2], a[3]), cvt_pk(a[4], a[5]), cvt_pk(a[6], a[7])};
                *(u32x4*)(act + (size_t)ar * FF + ncol0 + wc * 32 + 8 * fq) = pk;
            }
        }
    }
};
struct EpiY {
    bf16_t* y; const int* yrows; const float* gl;
    __device__ __forceinline__ void operator()(f32x4 (&acc)[MOE_MT][4], int pass, int wr, int wc, int fr, int fq) const {
        const int col0 = pass * 256;
#pragma unroll
        for (int mt = 0; mt < MOE_MT; ++mt) {
            const int r = wr * 16 * MOE_MT + mt * 16 + fr, yr = yrows[r];
            if (yr >= 0) {
                const float gt = gl[r];
#pragma unroll
                for (int a = 0; a < 2; ++a) {
                    const f32x4 v0 = acc[mt][2 * a] * gt, v1 = acc[mt][2 * a + 1] * gt;
                    u32x4 pk = {cvt_pk(v0[0], v0[1]), cvt_pk(v0[2], v0[3]), cvt_pk(v1[0], v1[1]), cvt_pk(v1[2], v1[3])};
                    *(u32x4*)(y + (size_t)yr * D + col0 + wc * 64 + a * 32 + 8 * fq) = pk;
                }
            }
        }
    }
};
__device__ __forceinline__ void phase_experts(const Params& p, char* lds, int vb, int G) {
    const int tid0 = threadIdx.x, w = __builtin_amdgcn_readfirstlane(tid0 >> 6);
    const unsigned* cnt = (const unsigned*)(p.ws + WS_CTL + 65536); const int* list = (const int*)(p.ws + WS_LIST); const float* gates = (const float*)(p.ws + WS_GATE);
    bf16_t* act = (bf16_t*)(p.ws + WS_ACT); bf16_t* ybuf = (bf16_t*)(p.ws + WS_Y);
    int* nts = (int*)(lds + LDS_MISC); int* pre = nts + 256;
    int* s_arow = pre + 260; int* s_yrow = s_arow + MOE_BM; int* s_tok = s_yrow + MOE_BM; float* s_gate = (float*)(s_tok + MOE_BM);
    if (tid0 < 256) nts[tid0] = (int)((__hip_atomic_load(cnt + tid0 * CNT_STRIDE, __ATOMIC_RELAXED, __HIP_MEMORY_SCOPE_AGENT) + (MOE_BM - 1)) / MOE_BM);
    __syncthreads();
    if (tid0 < 257) { int s = 0; for (int e = 0; e < tid0; ++e) s += nts[e]; pre[tid0] = s; }
    __syncthreads();
    const int NR = __builtin_amdgcn_readfirstlane(pre[256]), NU = NR + S / MOE_BM;
    for (int u = vb; u < NU; u += G) {
        __syncthreads();
        int tid = threadIdx.x; asm volatile("" : "+v"(tid));
        const int lane = tid & 63; const unsigned co = g2_chunk_off(lane, w);
        const float *bg, *bu, *bd;
        if (u < NR) {
            int lo = 0, hi = 255;
            while (lo < hi) { const int mid = (lo + hi + 1) >> 1; if (pre[mid] <= u) lo = mid; else hi = mid - 1; }
            const int e = lo, tile = u - pre[e], n = (int)__hip_atomic_load(cnt + e * CNT_STRIDE, __ATOMIC_RELAXED, __HIP_MEMORY_SCOPE_AGENT);
            if (tid < MOE_BM) {
                const int idx = tile * MOE_BM + tid;
                if (idx < n) { const int slot = list[(size_t)e * CAP + idx]; s_arow[tid] = slot; s_yrow[tid] = slot + (slot >> 3); s_tok[tid] = slot >> 3; s_gate[tid] = gates[slot]; }
                else { s_arow[tid] = -1; s_yrow[tid] = -1; s_tok[tid] = 0; s_gate[tid] = 0.f; }
            }
            bg = p.w_g + (size_t)e * D * FF; bu = p.w_u + (size_t)e * D * FF; bd = p.w_d + (size_t)e * FF * D;
        } else {
            const int tile = u - NR;
            if (tid < MOE_BM) { const int tk = tile * MOE_BM + tid; s_arow[tid] = S * 8 + tk; s_yrow[tid] = tk * 9 + 8; s_tok[tid] = tk; s_gate[tid] = 1.0f; }
            bg = p.ws_g; bu = p.ws_u; bd = p.ws_d;
        }
        __syncthreads();
        { G3fArgs g; g.A = (const char*)(p.ws + WS_X1B); g.nk = D / 64; g.akstep = S * 128;
#pragma unroll
          for (int i = 0; i < MOE_MT / 2; ++i) g.offA[i] = (unsigned)s_tok[i * 64 + w * 8 + (lane >> 3)] * 128u + co;
          { const int bwc = lane >> 4, nt = (lane >> 2) & 3, bfq = lane & 3;
            g.b = ((nt < 2) ? bg : bu) + bwc * 32 + 8 * bfq + 4 * (nt & 1) + (size_t)(w * 8) * FF; }
          EpiAct e{act, s_arow};
          gemm3f<MOE_MT, FF>(lds, g, 2, 128, e); }
        asm volatile("s_waitcnt vmcnt(0)" ::: "memory");
        __syncthreads();
        { G3fArgs g; g.A = (const char*)act; g.nk = FF / 64; g.akstep = 128;
          int tid2 = threadIdx.x; asm volatile("" : "+v"(tid2));
          const int lane = tid2 & 63; const unsigned co = g2_chunk_off(lane, w);
#pragma unroll
          for (int i = 0; i < MOE_MT / 2; ++i) { const int ar = s_arow[i * 64 + w * 8 + (lane >> 3)]; g.offA[i] = (unsigned)(ar < 0 ? 0 : ar) * (unsigned)(FF * 2) + co; }
          g.b = bd + (size_t)(w * 8) * D + (lane >> 4) * 64 + (((lane >> 2) & 3) >> 1) * 32 + 8 * (lane & 3) + 4 * ((lane >> 2) & 1);
          EpiY e{ybuf, s_yrow, s_gate};
          gemm3f<MOE_MT, D>(lds, g, 4, 256, e); }
    }
}

__device__ __forceinline__ void phase_final(const Params& p, int vb, int G) {
    const int lane = threadIdx.x & 63, w = threadIdx.x >> 6;
    const bf16_t* x1b = (const bf16_t*)(p.ws + WS_X1B); const bf16_t* ybuf = (const bf16_t*)(p.ws + WS_Y);
    const int stride = G * 8;
#define F_LOAD(q, row) do { \
        _Pragma("unroll") for (int j = 0; j < 2; ++j) q[j] = *(const u32x4*)(x1b + ((size_t)((lane >> 3) + 8 * j) * S + (row)) * 64 + ((8 * lane) & 63)); \
        _Pragma("unroll") for (int k = 0; k < 9; ++k) { const u32x4* yr = (const u32x4*)(ybuf + (size_t)((row) * 9 + k) * D) + lane; q[2 + 2 * k] = yr[0]; q[3 + 2 * k] = yr[64]; } } while (0)
#define F_PROC(q, row) do { float v[2][8]; \
        _Pragma("unroll") for (int j = 0; j < 2; ++j) _Pragma("unroll") for (int e = 0; e < 4; ++e) { v[j][2 * e] = bf_lo(q[j][e]) * ALPHA; v[j][2 * e + 1] = bf_hi(q[j][e]) * ALPHA; } \
        _Pragma("unroll") for (int k = 0; k < 9; ++k) _Pragma("unroll") for (int j = 0; j < 2; ++j) _Pragma("unroll") for (int e = 0; e < 4; ++e) { v[j][2 * e] += bf_lo(q[2 + 2 * k + j][e]); v[j][2 * e + 1] += bf_hi(q[2 + 2 * k + j][e]); } \
        float sm = 0.f; \
        _Pragma("unroll") for (int j = 0; j < 2; ++j) _Pragma("unroll") for (int e = 0; e < 8; ++e) sm += v[j][e]; \
        sm = wave_sum(sm); \
        const float mean = sm * (1.0f / D); float sq = 0.f; \
        _Pragma("unroll") for (int j = 0; j < 2; ++j) _Pragma("unroll") for (int e = 0; e < 8; ++e) { v[j][e] -= mean; sq += v[j][e] * v[j][e]; } \
        sq = wave_sum(sq); \
        const float rstd = rsqrtf(sq * (1.0f / D) + LN_EPS); \
        _Pragma("unroll") for (int j = 0; j < 2; ++j) { \
            const f32x4 g0 = *((const f32x4*)p.ln2g + 2 * lane + 128 * j), g1 = *((const f32x4*)p.ln2g + 2 * lane + 128 * j + 1); \
            const f32x4 b0 = *((const f32x4*)p.ln2b + 2 * lane + 128 * j), b1 = *((const f32x4*)p.ln2b + 2 * lane + 128 * j + 1); \
            f32x4* op = (f32x4*)(p.out + (size_t)(row) * D) + 2 * lane + 128 * j; \
            op[0] = (f32x4){v[j][0], v[j][1], v[j][2], v[j][3]} * rstd * g0 + b0; \
            op[1] = (f32x4){v[j][4], v[j][5], v[j][6], v[j][7]} * rstd * g1 + b1; } } while (0)
    u32x4 qa[20], qb[20];
    if (S % (2 * stride) == 0) {
        int row = __builtin_amdgcn_readfirstlane(vb * 8 + w);
        F_LOAD(qa, row);
        for (; row < S; row += 2 * stride) {
            F_LOAD(qb, row + stride);
            __builtin_amdgcn_sched_barrier(0);
            F_PROC(qa, row);
            const int nrow = (row + 2 * stride < S) ? row + 2 * stride : row;
            F_LOAD(qa, nrow);
            __builtin_amdgcn_sched_barrier(0);
            F_PROC(qb, row + stride);
        }
        return;
    }
    int row = vb * 8 + w;
    if (row < S) F_LOAD(qa, row);
    for (; row < S; row += 2 * stride) {
        const bool n1 = row + stride < S, n2 = row + 2 * stride < S;
        if (n1) F_LOAD(qb, row + stride);
        __builtin_amdgcn_sched_barrier(0);
        F_PROC(qa, row);
        if (n1) {
            if (n2) F_LOAD(qa, row + 2 * stride);
            __builtin_amdgcn_sched_barrier(0);
            F_PROC(qb, row + stride);
        }
    }
#undef F_LOAD
#undef F_PROC
}

__global__ void __launch_bounds__(NTHREADS) mega(Params p) {
    extern __shared__ __attribute__((aligned(16))) char lds[];
    const int G = gridDim.x, bx = blockIdx.x;
    const int vb = (G % 8 == 0) ? (bx % 8) * (G / 8) + bx / 8 : bx;
    if (threadIdx.x < 4) ((volatile LAS unsigned*)((LAS char*)lds + LDS_BARST))[threadIdx.x] = 0u;
    __syncthreads();
    XcdBarrier bar; bar.bar = (unsigned*)(p.ws + WS_CTL) + CW_BAR; bar.x = 0; bar.st = nullptr;
    if (p.ph_hi - p.ph_lo > 1) bar = xcd_barrier_post((unsigned*)(p.ws + WS_CTL) + CW_BAR, (volatile LAS unsigned*)((LAS char*)lds + LDS_BARST));
#define SEAM(k) do { if (p.ph_lo <= (k) && (k) + 1 < p.ph_hi) { xcd_barrier(bar); } } while (0)
#define IN(k) (p.ph_lo <= (k) && (k) < p.ph_hi)
#define RUN(k, call) do { if (IN(k)) { call; if (MK_REPEAT == (k)) { __syncthreads(); call; } } } while (0)
    RUN(0, phase_prep(p, vb, G)); SEAM(0);
    RUN(1, phase_proj(p, lds, vb, G)); SEAM(1);
    RUN(2, phase_attn(p, lds, vb, G)); SEAM(2);
    RUN(3, phase_wout(p, lds, vb, G)); SEAM(3);
    if (IN(4)) { phase_router(p, lds, vb, G); } SEAM(4);
    RUN(5, phase_experts(p, lds, vb, G)); SEAM(5);
    RUN(6, phase_final(p, vb, G));
#undef SEAM
#undef IN
#undef RUN
}

extern "C" void kernel_launch(void* const* d_in, const int* in_sizes, int n_in, void* d_out, int out_size, void* d_ws, size_t ws_size, hipStream_t stream) {
    static int grid = 0;
    if (grid == 0) {
        if (n_in != 22 || in_sizes[0] != S * D || out_size != S * D || ws_size < WS_END) {
            fprintf(stderr, "kernel_launch: unexpected shapes: n_in %d in0 %d out %d ws %zu (need %zu)\n", n_in, n_in > 0 ? in_sizes[0] : -1, out_size, ws_size, (size_t)WS_END); grid = -1; return; }
        int dev = 0, cus = 0, per_cu = 0;
        (void)hipGetDevice(&dev); (void)hipDeviceGetAttribute(&cus, hipDeviceAttributeMultiprocessorCount, dev);
        if (hipFuncSetAttribute((const void*)mega, hipFuncAttributeMaxDynamicSharedMemorySize, LDS_BYTES) != hipSuccess) { fprintf(stderr, "kernel_launch: hipFuncSetAttribute failed\n"); grid = -1; return; }
        (void)hipOccupancyMaxActiveBlocksPerMultiprocessor(&per_cu, (const void*)mega, NTHREADS, LDS_BYTES);
        if (per_cu < 1) { fprintf(stderr, "kernel_launch: occupancy query says %d blocks per CU\n", per_cu); per_cu = 1; }
        grid = cus * 1;
        (void)hipGetLastError();
    }
    if (grid < 0) return;
    (void)hipMemsetAsync((char*)d_ws + WS_CTL, 0, CTL_BYTES, stream);
    Params p{};
    const float** f = (const float**)&p;
    for (int i = 0; i < 22; ++i) f[i] = (const float*)d_in[i];
    p.out = (float*)d_out; p.ws = (unsigned char*)d_ws;
#if MK_ONE_LAUNCH
    p.ph_lo = 0; p.ph_hi = 7;
    void* args[] = {&p};
    hipError_t e = hipLaunchCooperativeKernel((const void*)mega, dim3(grid), dim3(NTHREADS), args, LDS_BYTES, stream);
    if (e != hipSuccess) fprintf(stderr, "kernel_launch: cooperative launch failed: %s (grid %d)\n", hipGetErrorString(e), grid);
#else
    for (int ph = 0; ph < 7; ++ph) {
        p.ph_lo = ph; p.ph_hi = ph + 1;
        hipLaunchKernelGGL(mega, dim3(grid), dim3(NTHREADS), LDS_BYTES, stream, p);
    }
#endif
}
```
